# Optimizing an MI355X kernel written in HIP

```python
import jax, jax.numpy as jnp
from jax import lax
import numpy as np

D_MODEL = 1024
BATCH = 8
SEQ = 2048
DEPTH = 4

PLE_DIM = 256
D_MIX = D_MODEL
CONV_WIDTH = D_MIX // 4
CONV_GROUPS = 4
CONV_KERNEL = 31
SSD_WIDTH = D_MIX // 2
SSD_HEADDIM = 64
SSD_HEADS = SSD_WIDTH // SSD_HEADDIM
SSD_NGROUPS = 2
SSD_STATE = 128
SSD_CONV = 4
SSD_CHUNK = 128
MLA_HEADS = 4
MLA_NOPE_DIM = 64
MLA_ROPE_DIM = 32
MLA_V_DIM = D_MIX // 4 // MLA_HEADS
MLA_WIDTH = MLA_HEADS * MLA_V_DIM
MLA_Q_RANK = D_MODEL // 4
MLA_KV_RANK = D_MODEL // 8
ROPE_BASE = 10000.0
Q_BLOCK = 128
D_FF = 7 * D_MODEL // 2
N_EXPERTS = 8
TOP_K = 2
MOE_BLOCK = 128
N_DENSE = (DEPTH + 1) // 2
N_MOE = DEPTH // 2
CONV_IN = 2 * CONV_WIDTH
SSD_XBC = SSD_WIDTH + 2 * SSD_NGROUPS * SSD_STATE
IN_COLS = CONV_IN + SSD_WIDTH + SSD_XBC + SSD_HEADS + MLA_Q_RANK + MLA_KV_RANK + MLA_ROPE_DIM
RMS_EPS = 1e-6
LN_EPS = 1e-5

kernel_name = 'hybrid_conv_ssd_mla_moe_ple_trunk'


def rms_norm(x, g):
    xf = x.astype(jnp.float32)
    y = xf * lax.rsqrt(jnp.mean(xf * xf, axis=-1, keepdims=True) + RMS_EPS)
    return (y * g.astype(jnp.float32)).astype(x.dtype)


def causal_depthwise_conv(x, w, b):
    k, c = w.shape
    y = lax.conv_general_dilated(x, w.astype(x.dtype)[:, None, :], window_strides=(1,),
                                 padding=((k - 1, 0),), dimension_numbers=('NWC', 'WIO', 'NWC'),
                                 feature_group_count=c)
    return y + b.astype(x.dtype)


def split_in(u):
    sizes = (CONV_IN, SSD_WIDTH, SSD_XBC, SSD_HEADS, MLA_Q_RANK, MLA_KV_RANK, MLA_ROPE_DIM)
    points = np.cumsum(sizes)[:-1].tolist()
    return jnp.split(u, points, axis=-1)


def conformer_conv(u, dw_w, dw_b, ln_g, ln_b):
    val, gate = jnp.split(u, 2, axis=-1)
    h = causal_depthwise_conv(val * jax.nn.sigmoid(gate), dw_w, dw_b)
    b, s, c = h.shape
    hg = h.astype(jnp.float32).reshape(b, s, CONV_GROUPS, c // CONV_GROUPS)
    mu = jnp.mean(hg, axis=-1, keepdims=True)
    var = jnp.mean(jnp.square(hg - mu), axis=-1, keepdims=True)
    hn = ((hg - mu) * lax.rsqrt(var + LN_EPS)).reshape(b, s, c)
    hn = hn * ln_g.astype(jnp.float32) + ln_b.astype(jnp.float32)
    return jax.nn.silu(hn).astype(u.dtype)


def ssd_chunked(x, dt, a, bm, cm):
    b, s, h, pd = x.shape
    g, n = bm.shape[2], bm.shape[3]
    r = h // g
    c, L = s // SSD_CHUNK, SSD_CHUNK
    xd = (x * dt[..., None]).reshape(b, c, L, g, r, pd)
    adt = (dt * a).reshape(b, c, L, g, r).transpose(0, 3, 4, 1, 2)
    a_cs = jnp.cumsum(adt, axis=-1)
    bc = bm.reshape(b, c, L, g, n)
    cc = cm.reshape(b, c, L, g, n)
    causal = jnp.tril(jnp.ones((L, L), dtype=bool))
    seg = a_cs[..., :, None] - a_cs[..., None, :]
    decay = jnp.exp(jnp.where(causal, seg, -jnp.inf))
    cb = jnp.einsum('bclgn,bcsgn->bgcls', cc, bc)
    mix = cb[:, :, None] * decay
    y_diag = jnp.einsum('bgrcls,bcsgrp->bclgrp', mix, xd)
    decay_states = jnp.exp(a_cs[..., -1:] - a_cs)
    states = jnp.einsum('bclgn,bgrcl,bclgrp->cbgrpn', bc, decay_states, xd)
    chunk_decay = jnp.moveaxis(jnp.exp(a_cs[..., -1]), -1, 0)

    def step(carry, inp):
        st, dec = inp
        return carry * dec[..., None, None] + st, carry

    init = jnp.zeros((b, g, r, pd, n), jnp.float32)
    _, prev = lax.scan(step, init, (states, chunk_decay))
    y_off = jnp.einsum('bclgn,cbgrpn,bgrcl->bclgrp', cc, prev, jnp.exp(a_cs))
    return (y_diag + y_off).reshape(b, s, h, pd)


def ssd_mixer(z, xbc, dt_raw, conv_w, conv_b, dt_bias, a_log, d_skip, norm_g):
    b, s, _ = xbc.shape
    xbc = jax.nn.silu(causal_depthwise_conv(xbc, conv_w, conv_b)).astype(jnp.float32)
    gn = SSD_NGROUPS * SSD_STATE
    xs = xbc[..., :SSD_WIDTH].reshape(b, s, SSD_HEADS, SSD_HEADDIM)
    bm = xbc[..., SSD_WIDTH:SSD_WIDTH + gn].reshape(b, s, SSD_NGROUPS, SSD_STATE)
    cm = xbc[..., SSD_WIDTH + gn:].reshape(b, s, SSD_NGROUPS, SSD_STATE)
    dt = jax.nn.softplus(dt_raw.astype(jnp.float32) + dt_bias.astype(jnp.float32))
    a = -jnp.exp(a_log.astype(jnp.float32))
    y = ssd_chunked(xs, dt, a, bm, cm) + d_skip.astype(jnp.float32)[:, None] * xs
    yg = (y.reshape(b, s, SSD_WIDTH) * jax.nn.silu(z.astype(jnp.float32)))
    yg = yg.reshape(b, s, SSD_NGROUPS, SSD_WIDTH // SSD_NGROUPS)
    yg = yg * lax.rsqrt(jnp.mean(yg * yg, axis=-1, keepdims=True) + RMS_EPS)
    return (yg.reshape(b, s, SSD_WIDTH) * norm_g.astype(jnp.float32)).astype(z.dtype)


def rope_tables(positions, dtype):
    inv = ROPE_BASE ** (-jnp.arange(0, MLA_ROPE_DIM, 2, dtype=jnp.float32) / MLA_ROPE_DIM)
    ang = positions.astype(jnp.float32)[..., None] * inv
    return jnp.cos(ang).astype(dtype), jnp.sin(ang).astype(dtype)


def apply_rope(x, cos, sin):
    half = x.shape[-1] // 2
    x1, x2 = x[..., :half], x[..., half:]
    return jnp.concatenate([x1 * cos - x2 * sin, x1 * sin + x2 * cos], axis=-1)


def mla_mixer(c_q, c_kv, k_rope, q_norm_g, w_uq, kv_norm_g, w_ukv, cos, sin):
    b, s, _ = c_q.shape
    q = (rms_norm(c_q, q_norm_g) @ w_uq).reshape(b, s, MLA_HEADS, MLA_NOPE_DIM + MLA_ROPE_DIM)
    q_nope, q_pe = q[..., :MLA_NOPE_DIM], q[..., MLA_NOPE_DIM:]
    kv = (rms_norm(c_kv, kv_norm_g) @ w_ukv).reshape(b, s, MLA_HEADS, MLA_NOPE_DIM + MLA_V_DIM)
    k_nope, v = kv[..., :MLA_NOPE_DIM], kv[..., MLA_NOPE_DIM:]
    q_pe = apply_rope(q_pe, cos[:, :, None, :], sin[:, :, None, :])
    k_pe = apply_rope(k_rope, cos, sin)
    scale = (MLA_NOPE_DIM + MLA_ROPE_DIM) ** -0.5
    outs = []
    for blk in range(s // Q_BLOCK):
        q0, q1 = blk * Q_BLOCK, (blk + 1) * Q_BLOCK
        sc = (jnp.einsum('bqhd,bkhd->bhqk', q_nope[:, q0:q1], k_nope[:, :q1])
              + jnp.einsum('bqhd,bkd->bhqk', q_pe[:, q0:q1], k_pe[:, :q1])).astype(jnp.float32) * scale
        mask = (q0 + jnp.arange(Q_BLOCK))[:, None] >= jnp.arange(q1)[None, :]
        pr = jax.nn.softmax(jnp.where(mask, sc, -jnp.inf), axis=-1).astype(v.dtype)
        outs.append(jnp.einsum('bhqk,bkhd->bqhd', pr, v[:, :q1]))
    return jnp.concatenate(outs, axis=1).reshape(b, s, MLA_WIDTH)


def swiglu(h, wg, wu, wd):
    return (jax.nn.silu(h @ wg) * (h @ wu)) @ wd


def moe_top2(h, router, wg, wu, wd):
    b, s, d = h.shape
    t = b * s
    hf = h.reshape(t, d)
    logits = (hf @ router).astype(jnp.float32)
    top_val, top_idx = lax.top_k(logits, TOP_K)
    gates = jax.nn.softmax(top_val, axis=-1)
    e_flat = top_idx.reshape(-1)
    tok_flat = jnp.arange(t * TOP_K, dtype=jnp.int32) // TOP_K
    g_flat = gates.reshape(-1)
    order = jnp.argsort(e_flat)
    e_sorted = e_flat[order]
    counts = jnp.zeros((N_EXPERTS,), jnp.int32).at[e_flat].add(1)
    padded = ((counts + MOE_BLOCK - 1) // MOE_BLOCK) * MOE_BLOCK
    starts = jnp.cumsum(counts) - counts
    pends = jnp.cumsum(padded)
    pstarts = pends - padded
    dest = pstarts[e_sorted] + (jnp.arange(t * TOP_K, dtype=jnp.int32) - starts[e_sorted])
    n_blocks = -(-(t * TOP_K) // MOE_BLOCK) + N_EXPERTS
    n_slots = n_blocks * MOE_BLOCK
    slot_tok = jnp.full((n_slots,), t, jnp.int32).at[dest].set(tok_flat[order])
    slot_gate = jnp.zeros((n_slots,), jnp.float32).at[dest].set(g_flat[order])
    block_exp = jnp.minimum(jnp.searchsorted(pends, jnp.arange(n_blocks) * MOE_BLOCK, side='right'),
                            N_EXPERTS - 1)
    x_pad = jnp.concatenate([hf, jnp.zeros((1, d), hf.dtype)], axis=0)
    xb = x_pad[slot_tok].reshape(n_blocks, MOE_BLOCK, d)

    def expert_block(args):
        xblk, e = args
        return swiglu(xblk, wg[e], wu[e], wd[e])

    yb = lax.map(expert_block, (xb, block_exp))
    ys = yb.reshape(n_slots, d) * slot_gate[:, None].astype(h.dtype)
    y = jnp.zeros((t + 1, d), h.dtype).at[slot_tok].add(ys)[:t]
    return y.reshape(b, s, d)


def setup_inputs(seed: int = 0) -> dict:
    key = jax.random.key(seed)
    ks = jax.random.split(key, 40)
    f32 = jnp.float32

    def nrm(k, shape, scale):
        return jax.random.normal(k, shape, f32) * scale

    def gain(k, shape):
        return 1.0 + 0.05 * jax.random.normal(k, shape, f32)

    dt = jnp.exp(jax.random.uniform(ks[11], (DEPTH, SSD_HEADS), f32)
                 * (jnp.log(0.1) - jnp.log(0.001)) + jnp.log(0.001))
    return {
        'x': nrm(ks[0], (BATCH, SEQ, D_MODEL), 1.0),
        'p': nrm(ks[1], (DEPTH, BATCH, SEQ, PLE_DIM), 1.0),
        'positions': jnp.arange(SEQ, dtype=jnp.int32)[None, :]
                     + jax.random.randint(ks[2], (BATCH, 1), 0, 1024, dtype=jnp.int32),
        'attn_norm_g': gain(ks[3], (DEPTH, D_MODEL)),
        'w_in': nrm(ks[4], (DEPTH, D_MODEL, IN_COLS), D_MODEL ** -0.5),
        'conv_dw_w': nrm(ks[5], (DEPTH, CONV_KERNEL, CONV_WIDTH), CONV_KERNEL ** -0.5),
        'conv_dw_b': nrm(ks[6], (DEPTH, CONV_WIDTH), 0.02),
        'conv_ln_g': gain(ks[7], (DEPTH, CONV_WIDTH)),
        'conv_ln_b': nrm(ks[8], (DEPTH, CONV_WIDTH), 0.02),
        'ssd_conv_w': nrm(ks[9], (DEPTH, SSD_CONV, SSD_XBC), SSD_CONV ** -0.5),
        'ssd_conv_b': nrm(ks[10], (DEPTH, SSD_XBC), 0.02),
        'ssd_dt_bias': dt + jnp.log(-jnp.expm1(-dt)),
        'ssd_a_log': jnp.log(jax.random.uniform(ks[12], (DEPTH, SSD_HEADS), f32, 1.0, 16.0)),
        'ssd_d': gain(ks[13], (DEPTH, SSD_HEADS)),
        'ssd_norm_g': gain(ks[14], (DEPTH, SSD_WIDTH)),
        'mla_q_norm_g': gain(ks[15], (DEPTH, MLA_Q_RANK)),
        'mla_w_uq': nrm(ks[16], (DEPTH, MLA_Q_RANK, MLA_HEADS * (MLA_NOPE_DIM + MLA_ROPE_DIM)), MLA_Q_RANK ** -0.5),
        'mla_kv_norm_g': gain(ks[17], (DEPTH, MLA_KV_RANK)),
        'mla_w_ukv': nrm(ks[18], (DEPTH, MLA_KV_RANK, MLA_HEADS * (MLA_NOPE_DIM + MLA_V_DIM)), MLA_KV_RANK ** -0.5),
        'w_out': nrm(ks[19], (DEPTH, D_MIX, D_MODEL), D_MIX ** -0.5),
        'ffn_norm_g': gain(ks[20], (DEPTH, D_MODEL)),
        'dense_w_gate': nrm(ks[21], (N_DENSE, D_MODEL, D_FF), D_MODEL ** -0.5),
        'dense_w_up': nrm(ks[22], (N_DENSE, D_MODEL, D_FF), D_MODEL ** -0.5),
        'dense_w_down': nrm(ks[23], (N_DENSE, D_FF, D_MODEL), D_FF ** -0.5),
        'moe_router': nrm(ks[24], (N_MOE, D_MODEL, N_EXPERTS), D_MODEL ** -0.5),
        'moe_w_gate': nrm(ks[25], (N_MOE, N_EXPERTS, D_MODEL, D_FF), D_MODEL ** -0.5),
        'moe_w_up': nrm(ks[26], (N_MOE, N_EXPERTS, D_MODEL, D_FF), D_MODEL ** -0.5),
        'moe_w_down': nrm(ks[27], (N_MOE, N_EXPERTS, D_FF, D_MODEL), D_FF ** -0.5),
        'ple_norm_g': gain(ks[28], (DEPTH, D_MODEL)),
        'ple_w_gate': nrm(ks[29], (DEPTH, D_MODEL, D_MODEL), D_MODEL ** -0.5),
        'ple_w_proj': nrm(ks[30], (DEPTH, PLE_DIM, D_MODEL), PLE_DIM ** -0.5),
        'final_norm_g': gain(ks[31], (D_MODEL,)),
    }


def reference(x, p, positions, attn_norm_g, w_in, conv_dw_w, conv_dw_b, conv_ln_g, conv_ln_b,
              ssd_conv_w, ssd_conv_b, ssd_dt_bias, ssd_a_log, ssd_d, ssd_norm_g,
              mla_q_norm_g, mla_w_uq, mla_kv_norm_g, mla_w_ukv, w_out, ffn_norm_g,
              dense_w_gate, dense_w_up, dense_w_down, moe_router, moe_w_gate, moe_w_up, moe_w_down,
              ple_norm_g, ple_w_gate, ple_w_proj, final_norm_g):
    h = x
    cos, sin = rope_tables(positions, x.dtype)
    for i in range(DEPTH):
        u = rms_norm(h, attn_norm_g[i]) @ w_in[i]
        u_conv, z, xbc, dt_raw, c_q, c_kv, k_rope = split_in(u)
        y_conv = conformer_conv(u_conv, conv_dw_w[i], conv_dw_b[i], conv_ln_g[i], conv_ln_b[i])
        y_ssd = ssd_mixer(z, xbc, dt_raw, ssd_conv_w[i], ssd_conv_b[i], ssd_dt_bias[i],
                          ssd_a_log[i], ssd_d[i], ssd_norm_g[i])
        y_mla = mla_mixer(c_q, c_kv, k_rope, mla_q_norm_g[i], mla_w_uq[i], mla_kv_norm_g[i],
                          mla_w_ukv[i], cos, sin)
        h = h + jnp.concatenate([y_conv, y_ssd, y_mla], axis=-1) @ w_out[i]
        hn = rms_norm(h, ffn_norm_g[i])
        if i % 2 == 0:
            j = i // 2
            h = h + swiglu(hn, dense_w_gate[j], dense_w_up[j], dense_w_down[j])
        else:
            j = i // 2
            h = h + moe_top2(hn, moe_router[j], moe_w_gate[j], moe_w_up[j], moe_w_down[j])
        gate = jax.nn.sigmoid(rms_norm(h, ple_norm_g[i]) @ ple_w_gate[i])
        h = h + (p[i] @ ple_w_proj[i]) * gate
    return rms_norm(h, final_norm_g)
```

```cpp
#include <hip/hip_runtime.h>
#include <cstdio>
#include <cstring>
#include <cmath>
#include <cstdint>
#ifdef __HIPCC__
#define HD __host__ __device__ __forceinline__
#else
#define HD inline
#endif
typedef unsigned short bf16;
namespace mdl {
constexpr int D = 1024, DEPTH = 4, NU = 2560, NUO = 2472, DFF = 3584, NGU = 7168, NE = 8, PLE = 256;
constexpr int CK = 31, SCONV = 4, CHUNK = 128, NH = 8, HP = 64, NS = 128;
constexpr float RMS_EPS = 1e-6f, LN_EPS = 1e-5f;
constexpr float QSCALE = 0.10206207261596577f * 1.4426950408889634f;
constexpr int U_Z = 512, U_XBC = 1024, U_CQ = 2048, U_CKV = 2304, U_KR = 2432, U_DT = 2464;

HD float bf2f(bf16 v) { unsigned u = (unsigned)v << 16; float f; memcpy(&f, &u, 4); return f; }
HD bf16 f2bf(float f) { unsigned u; memcpy(&u, &f, 4); u += 0x7fffu + ((u >> 16) & 1u); return (bf16)(u >> 16); }
HD float sigmoidf_(float x) { return 1.0f / (1.0f + expf(-x)); }
HD float siluf_(float x) { return x / (1.0f + expf(-x)); }
HD float softplusf_(float x) { return x > 20.f ? x : log1pf(expf(x)); }
HD int ucol_src(int n) { return n < 2048 ? n : (n < U_DT ? n + 8 : (n < NUO ? n - U_DT + 2048 : -1)); }

struct MP {
    const float *x, *p; const int* pos;
    const float *attn_g, *w_in, *cdw_w, *cdw_b, *cln_g, *cln_b, *sconv_w, *sconv_b, *dt_bias, *a_log, *dskip, *snorm_g, *qn_g, *w_uq, *kvn_g, *w_ukv,
        *w_out, *ffn_g, *dwg, *dwu, *dwd, *router, *mwg, *mwu, *mwd, *ple_g, *ple_wg, *ple_wp, *fin_g;
    float* out;
    long B, S, T, NSLOT;
    unsigned* ctl;
    bf16 *WIN, *WUQ, *WUKV, *WOUT, *DWGU, *DWD, *MWGU, *MWD, *WPG, *WPP;
    float *H, *CS, *DT, *ACS, *ST, *CB, *YPRE, *TOPG;
    bf16 *HB, *U, *YC, *Q, *KK, *V, *XS, *BM, *CM, *YD, *PV, *PB16, *PJ, *ACT, *XB, *YS;
    int *TOPE, *POS, *TOKSLOT, *TILE_E;
};
constexpr int CTL_WORDS = 65536;
HD unsigned* cnt_ptr(const MP& p, int j) { return p.ctl + 1024 + j * 64; }

inline size_t carve(MP& p, unsigned char* ws) {
    size_t o = 0; const size_t T = p.T, NSL = p.NSLOT;
    auto take = [&](size_t bytes) { size_t r = o; o += (bytes + 255) & ~(size_t)255; return ws + r; };
    p.ctl = (unsigned*)take(CTL_WORDS * 4);
    p.WIN = (bf16*)take((size_t)DEPTH * NU * D * 2); p.WUQ = (bf16*)take((size_t)DEPTH * 512 * 256 * 2); p.WUKV = (bf16*)take((size_t)DEPTH * 512 * 128 * 2);
    p.WOUT = (bf16*)take((size_t)DEPTH * D * D * 2); p.DWGU = (bf16*)take((size_t)2 * NGU * D * 2); p.DWD = (bf16*)take((size_t)2 * D * DFF * 2);
    p.MWGU = (bf16*)take((size_t)2 * NE * NGU * D * 2); p.MWD = (bf16*)take((size_t)2 * NE * D * DFF * 2);
    p.WPG = (bf16*)take((size_t)DEPTH * D * D * 2); p.WPP = (bf16*)take((size_t)DEPTH * D * PLE * 2);
    p.H = (float*)take(T * D * 4); p.HB = (bf16*)take(T * D * 2); p.CS = (float*)take(T * 32 * 4);
    p.PB16 = (bf16*)take((size_t)DEPTH * T * PLE * 2); p.PJ = (bf16*)take(T * D * 2);
    p.TOPE = (int*)take(T * 2 * 4); p.TOPG = (float*)take(T * 2 * 4); p.POS = (int*)take(T * 2 * 4); p.TOKSLOT = (int*)take(T * 2 * 4); p.TILE_E = (int*)take(1024 * 4);
    p.XB = (bf16*)take(NSL * D * 2); p.YS = p.XB;
    const size_t r1 = o;
    p.U = (bf16*)take(T * NU * 2); p.YC = (bf16*)take(T * D * 2); p.Q = (bf16*)take(T * 384 * 2); p.KK = (bf16*)take(T * 384 * 2); p.V = (bf16*)take(T * 256 * 2);
    p.XS = (bf16*)take(T * 512 * 2); p.BM = (bf16*)take(T * 256 * 2); p.CM = (bf16*)take(T * 256 * 2); p.YD = (bf16*)take(T * 512 * 2);
    p.DT = (float*)take(T * 8 * 4); p.ACS = (float*)take(T * 8 * 4); p.ST = (float*)take(T / CHUNK * NH * HP * NS * 4); p.PV = (bf16*)take(T / CHUNK * NH * HP * NS * 2);
    p.CB = (float*)take(T / CHUNK * 2 * CHUNK * CHUNK * 4); p.YPRE = (float*)take(T * 512 * 4);
    const size_t r1end = o; o = r1;
    p.ACT = (bf16*)take(NSL * DFF * 2);
    if (o < r1end) o = r1end;
    return o;
}

struct V8 { float v[8]; };
HD V8 ld8(const bf16* p) { V8 r; const uint4 u = *(const uint4*)p; const unsigned w[4] = {u.x, u.y, u.z, u.w};
    for (int i = 0; i < 4; ++i) { r.v[2 * i] = bf2f((bf16)(w[i] & 0xffff)); r.v[2 * i + 1] = bf2f((bf16)(w[i] >> 16)); } return r; }
HD float dot8(const V8& a, const V8& b) { float s = 0.f; for (int i = 0; i < 8; ++i) s += a.v[i] * b.v[i]; return s; }

template <class Epi> HD void gemm_nt(const bf16* A, long lda, const bf16* Bt, long ldb, long M, long N, long K, const Epi& epi, long g0, long gs) {
    const long ntn = N / 4, ntile = (M / 4) * ntn;
    for (long t = g0; t < ntile; t += gs) {
        const long m0 = (t / ntn) * 4, n0 = (t % ntn) * 4; float acc[4][4];
        for (int i = 0; i < 4; ++i) for (int j = 0; j < 4; ++j) acc[i][j] = 0.f;
        for (long k = 0; k < K; k += 8) { V8 a0 = ld8(A + (m0 + 0) * lda + k), a1 = ld8(A + (m0 + 1) * lda + k), a2 = ld8(A + (m0 + 2) * lda + k), a3 = ld8(A + (m0 + 3) * lda + k);
            V8 b0 = ld8(Bt + (n0 + 0) * ldb + k), b1 = ld8(Bt + (n0 + 1) * ldb + k), b2 = ld8(Bt + (n0 + 2) * ldb + k), b3 = ld8(Bt + (n0 + 3) * ldb + k);
            acc[0][0] += dot8(a0, b0); acc[0][1] += dot8(a0, b1); acc[0][2] += dot8(a0, b2); acc[0][3] += dot8(a0, b3);
            acc[1][0] += dot8(a1, b0); acc[1][1] += dot8(a1, b1); acc[1][2] += dot8(a1, b2); acc[1][3] += dot8(a1, b3);
            acc[2][0] += dot8(a2, b0); acc[2][1] += dot8(a2, b1); acc[2][2] += dot8(a2, b2); acc[2][3] += dot8(a2, b3);
            acc[3][0] += dot8(a3, b0); acc[3][1] += dot8(a3, b1); acc[3][2] += dot8(a3, b2); acc[3][3] += dot8(a3, b3); }
        epi(m0 + 0, n0 + 0, acc[0][0]); epi(m0 + 0, n0 + 1, acc[0][1]); epi(m0 + 0, n0 + 2, acc[0][2]); epi(m0 + 0, n0 + 3, acc[0][3]);
        epi(m0 + 1, n0 + 0, acc[1][0]); epi(m0 + 1, n0 + 1, acc[1][1]); epi(m0 + 1, n0 + 2, acc[1][2]); epi(m0 + 1, n0 + 3, acc[1][3]);
        epi(m0 + 2, n0 + 0, acc[2][0]); epi(m0 + 2, n0 + 1, acc[2][1]); epi(m0 + 2, n0 + 2, acc[2][2]); epi(m0 + 2, n0 + 3, acc[2][3]);
        epi(m0 + 3, n0 + 0, acc[3][0]); epi(m0 + 3, n0 + 1, acc[3][1]); epi(m0 + 3, n0 + 2, acc[3][2]); epi(m0 + 3, n0 + 3, acc[3][3]);
    }
}
struct EpiStoreBf { bf16* C; long ldc; HD void operator()(long m, long n, float v) const { C[m * ldc + n] = f2bf(v); } };
struct EpiAddF32 { float* C; long ldc; HD void operator()(long m, long n, float v) const { C[m * ldc + n] += v; } };
struct EpiPle { float* H; const bf16* PJ; HD void operator()(long m, long n, float v) const { H[m * D + n] += bf2f(PJ[m * D + n]) * sigmoidf_(v); } };

HD void tr_elem(const float* W, long K, long N, bf16* WT, long i) { const long n = i / K, k = i % K; WT[i] = f2bf(W[k * N + n]); }
HD void nv_prologue(const MP& p, long g0, long gs) {
    const long T = p.T;
    for (long i = g0; i < (long)DEPTH * NU * D; i += gs) { const long l = i / ((long)NU * D), r = i % ((long)NU * D), n = r / D, k = r % D; const int c = ucol_src((int)n);
        p.WIN[i] = c < 0 ? (bf16)0 : f2bf(p.w_in[(l * D + k) * NUO + c]); }
    for (long i = g0; i < (long)DEPTH * 512 * 256; i += gs) { const long l = i / (512 * 256), r = i % (512 * 256), n = r / 256, k = r % 256; p.WUQ[i] = n < 384 ? f2bf(p.w_uq[(l * 256 + k) * 384 + n]) : (bf16)0; }
    for (long i = g0; i < (long)DEPTH * 512 * 128; i += gs) { const long l = i / (512 * 128), r = i % (512 * 128), n = r / 128, k = r % 128; p.WUKV[i] = f2bf(p.w_ukv[(l * 128 + k) * 512 + n]); }
    for (long i = g0; i < (long)DEPTH * D * D; i += gs) { const long l = i / ((long)D * D); tr_elem(p.w_out + l * D * D, D, D, p.WOUT + l * D * D, i % ((long)D * D)); tr_elem(p.ple_wg + l * D * D, D, D, p.WPG + l * D * D, i % ((long)D * D)); }
    for (long i = g0; i < (long)DEPTH * D * PLE; i += gs) { const long l = i / ((long)D * PLE); tr_elem(p.ple_wp + l * PLE * D, PLE, D, p.WPP + l * D * PLE, i % ((long)D * PLE)); }
    for (long i = g0; i < (long)18 * NGU * D; i += gs) { const long mt = i / ((long)NGU * D), r = i % ((long)NGU * D), n = r / D, k = r % D, tl = n / 256, rr = n % 256, col = tl * 128 + (rr & 127);
        const float* src; bf16* dst;
        if (mt < 2) { src = (rr < 128 ? p.dwg : p.dwu) + mt * (long)D * DFF; dst = p.DWGU + mt * (long)NGU * D; } else { src = (rr < 128 ? p.mwg : p.mwu) + (mt - 2) * (long)D * DFF; dst = p.MWGU + (mt - 2) * (long)NGU * D; }
        dst[r] = f2bf(src[k * DFF + col]); }
    for (long i = g0; i < (long)18 * D * DFF; i += gs) { const long mt = i / ((long)D * DFF), r = i % ((long)D * DFF);
        if (mt < 2) tr_elem(p.dwd + mt * (long)DFF * D, DFF, D, p.DWD + mt * (long)D * DFF, r); else tr_elem(p.mwd + (mt - 2) * (long)DFF * D, DFF, D, p.MWD + (mt - 2) * (long)D * DFF, r); }
    for (long i = g0; i < T * D; i += gs) p.H[i] = p.x[i];
    for (long i = g0; i < (long)DEPTH * T * PLE; i += gs) p.PB16[i] = f2bf(p.p[i]);
    for (long i = g0; i < T * 16; i += gs) { const long t = i / 16; const int j = (int)(i % 16); const float inv = powf(10000.0f, -(float)(2 * j) / 32.0f), ang = (float)p.pos[t] * inv;
        p.CS[t * 32 + j] = cosf(ang); p.CS[t * 32 + 16 + j] = sinf(ang); }
}
HD void nv_norm(const MP& p, const float* g, long g0, long gs) {
    for (long t = g0; t < p.T; t += gs) { const float* h = p.H + t * D; float ss = 0.f; for (int i = 0; i < D; ++i) ss += h[i] * h[i];
        const float r = 1.0f / sqrtf(ss / D + RMS_EPS); for (int i = 0; i < D; ++i) p.HB[t * D + i] = f2bf(h[i] * r * g[i]); }
}
HD void nv_inproj(const MP& p, int L, long g0, long gs) {
    gemm_nt(p.HB, D, p.WIN + (long)L * NU * D, D, p.T, NU, D, EpiStoreBf{p.U, NU}, g0, gs);
    gemm_nt(p.PB16 + (long)L * p.T * PLE, PLE, p.WPP + (long)L * D * PLE, PLE, p.T, D, PLE, EpiStoreBf{p.PJ, D}, g0, gs);
}
HD float cm_conv(const MP& p, int L, long b, long s, int c) {
    float acc = p.cdw_b[L * 256 + c];
    for (int j = 0; j < CK; ++j) { const long sp = s - (CK - 1) + j; if (sp < 0) continue; const bf16* u = p.U + (b * p.S + sp) * NU;
        acc += p.cdw_w[(L * CK + j) * 256 + c] * (bf2f(u[c]) * sigmoidf_(bf2f(u[256 + c]))); }
    return acc;
}
HD void nv_mixA1(const MP& p, int L, long g0, long gs) {
    const long T = p.T, S = p.S;
    for (long i = g0; i < T * 4; i += gs) { const long t = i / 4, b = t / S, s = t % S; const int gq = (int)(i % 4);
        float sm = 0.f, sq = 0.f; for (int c = 0; c < 64; ++c) { const float v = cm_conv(p, L, b, s, gq * 64 + c); sm += v; sq += v * v; }
        const float mu = sm / 64.f; float var = sq / 64.f - mu * mu; if (var < 0.f) var = 0.f; const float rs = 1.0f / sqrtf(var + LN_EPS);
        for (int c = 0; c < 64; ++c) { const int ch = gq * 64 + c; const float v = (cm_conv(p, L, b, s, ch) - mu) * rs * p.cln_g[L * 256 + ch] + p.cln_b[L * 256 + ch]; p.YC[t * D + ch] = f2bf(siluf_(v)); } }
    for (long i = g0; i < T * 1024; i += gs) { const long t = i / 1024, b = t / S, s = t % S; const int c = (int)(i % 1024);
        float acc = p.sconv_b[L * 1024 + c]; for (int j = 0; j < SCONV; ++j) { const long sp = s - (SCONV - 1) + j; if (sp < 0) continue; acc += p.sconv_w[(L * SCONV + j) * 1024 + c] * bf2f(p.U[(b * S + sp) * NU + U_XBC + c]); }
        const bf16 v = f2bf(siluf_(acc)); if (c < 512) p.XS[t * 512 + c] = v; else if (c < 768) p.BM[t * 256 + c - 512] = v; else p.CM[t * 256 + c - 768] = v; }
    for (long i = g0; i < T * 8; i += gs) { const long t = i / 8; const int h = (int)(i % 8); p.DT[i] = softplusf_(bf2f(p.U[t * NU + U_DT + h]) + p.dt_bias[L * 8 + h]); }
    for (long i = g0; i < T * 4 * 80; i += gs) { const long t = i / 320; const int h = (int)((i % 320) / 80), ii = (int)(i % 80); const bf16* cq = p.U + t * NU + U_CQ;
        float ss = 0.f; for (int k = 0; k < 256; ++k) { const float v = bf2f(cq[k]); ss += v * v; } const float r = 1.0f / sqrtf(ss / 256.f + RMS_EPS);
        const bf16* W = p.WUQ + (long)L * 512 * 256;
        if (ii < 64) { const int n = h * 96 + ii; float a = 0.f; for (int k = 0; k < 256; ++k) a += bf2f(f2bf(bf2f(cq[k]) * r * p.qn_g[L * 256 + k])) * bf2f(W[n * 256 + k]); p.Q[t * 384 + n] = f2bf(a * QSCALE); }
        else { const int j = ii - 64, n1 = h * 96 + 64 + j, n2 = n1 + 16; float a1 = 0.f, a2 = 0.f;
            for (int k = 0; k < 256; ++k) { const float xv = bf2f(f2bf(bf2f(cq[k]) * r * p.qn_g[L * 256 + k])); a1 += xv * bf2f(W[n1 * 256 + k]); a2 += xv * bf2f(W[n2 * 256 + k]); }
            const float c = p.CS[t * 32 + j], sn = p.CS[t * 32 + 16 + j]; p.Q[t * 384 + n1] = f2bf((a1 * c - a2 * sn) * QSCALE); p.Q[t * 384 + n2] = f2bf((a1 * sn + a2 * c) * QSCALE); } }
    for (long i = g0; i < T * 512; i += gs) { const long t = i / 512; const int n = (int)(i % 512); const bf16* ck = p.U + t * NU + U_CKV;
        float ss = 0.f; for (int k = 0; k < 128; ++k) { const float v = bf2f(ck[k]); ss += v * v; } const float r = 1.0f / sqrtf(ss / 128.f + RMS_EPS);
        const bf16* W = p.WUKV + (long)L * 512 * 128; float a = 0.f; for (int k = 0; k < 128; ++k) a += bf2f(f2bf(bf2f(ck[k]) * r * p.kvn_g[L * 128 + k])) * bf2f(W[n * 128 + k]);
        const int h = n / 128, d = n % 128; if (d < 64) p.KK[t * 384 + h * 96 + d] = f2bf(a); else p.V[t * 256 + h * 64 + d - 64] = f2bf(a); }
    for (long i = g0; i < T * 16; i += gs) { const long t = i / 16; const int j = (int)(i % 16); const float x1 = bf2f(p.U[t * NU + U_KR + j]), x2 = bf2f(p.U[t * NU + U_KR + 16 + j]), c = p.CS[t * 32 + j], sn = p.CS[t * 32 + 16 + j];
        const bf16 o1 = f2bf(x1 * c - x2 * sn), o2 = f2bf(x1 * sn + x2 * c); for (int h = 0; h < 4; ++h) { p.KK[t * 384 + h * 96 + 64 + j] = o1; p.KK[t * 384 + h * 96 + 80 + j] = o2; } }
}
HD void nv_mixA2(const MP& p, int L, long g0, long gs) {
    const long NC = p.T / CHUNK;
    for (long i = g0; i < NC * 8; i += gs) { const long c = i / 8; const int h = (int)(i % 8); const float a = -expf(p.a_log[L * 8 + h]); float cs = 0.f;
        for (int l = 0; l < CHUNK; ++l) { const long t = c * CHUNK + l; cs += p.DT[t * 8 + h] * a; p.ACS[t * 8 + h] = cs; } }
}
HD void nv_mixA3a(const MP& p, long g0, long gs) {
    const long NC = p.T / CHUNK;
    for (long i = g0; i < NC * 2 * CHUNK * CHUNK; i += gs) { const long u = i / (CHUNK * CHUNK), c = u / 2; const int g = (int)(u % 2), l = (int)((i / CHUNK) % CHUNK), s = (int)(i % CHUNK);
        const bf16* cm = p.CM + (c * CHUNK + l) * 256 + g * 128; const bf16* bm = p.BM + (c * CHUNK + s) * 256 + g * 128; float a = 0.f; for (int n = 0; n < 128; ++n) a += bf2f(cm[n]) * bf2f(bm[n]); p.CB[i] = a; }
}
HD void nv_mixA3b(const MP& p, long g0, long gs) {
    const long T = p.T, NC = T / CHUNK;
    for (long i = g0; i < T * 512; i += gs) { const long t = i / 512, c = t / CHUNK; const int ch = (int)(i % 512), h = ch / 64, g = h / 4, l = (int)(t % CHUNK);
        const float* cb = p.CB + ((c * 2 + g) * CHUNK + l) * CHUNK; const float al = p.ACS[t * 8 + h]; float a = 0.f;
        for (int s = 0; s <= l; ++s) { const long ts = c * CHUNK + s; a += cb[s] * expf(al - p.ACS[ts * 8 + h]) * p.DT[ts * 8 + h] * bf2f(p.XS[ts * 512 + ch]); }
        p.YD[i] = f2bf(a); }
    for (long i = g0; i < NC * 8 * 64 * 128; i += gs) { const long c = i / (8 * 64 * 128); const int h = (int)((i / (64 * 128)) % 8), pp = (int)((i / 128) % 64), n = (int)(i % 128), g = h / 4;
        const float alast = p.ACS[(c * CHUNK + CHUNK - 1) * 8 + h]; float a = 0.f;
        for (int l = 0; l < CHUNK; ++l) { const long t = c * CHUNK + l; a += bf2f(p.BM[t * 256 + g * 128 + n]) * expf(alast - p.ACS[t * 8 + h]) * p.DT[t * 8 + h] * bf2f(p.XS[t * 512 + h * 64 + pp]); }
        p.ST[i] = a; }
}
HD void nv_mixB1(const MP& p, long g0, long gs) {
    const long NCB = p.S / CHUNK;
    for (long i = g0; i < p.B * 8 * 64 * 128; i += gs) { const long b = i / (8 * 64 * 128); const long r = i % (8 * 64 * 128); const int h = (int)(r / (64 * 128)); float carry = 0.f;
        for (long cc = 0; cc < NCB; ++cc) { const long c = b * NCB + cc; const long idx = c * (8 * 64 * 128) + r; p.PV[idx] = f2bf(carry); carry = carry * expf(p.ACS[(c * CHUNK + CHUNK - 1) * 8 + h]) + p.ST[idx]; } }
}
HD void nv_attn(const MP& p, long g0, long gs) {
    const long T = p.T, S = p.S;
    for (long i = g0; i < T * 4; i += gs) { const long t = i / 4, b = t / S, s = t % S; const int h = (int)(i % 4);
        float q[96], o[64]; for (int d = 0; d < 96; ++d) q[d] = bf2f(p.Q[t * 384 + h * 96 + d]); for (int d = 0; d < 64; ++d) o[d] = 0.f; float m = -1e30f, l = 0.f;
        for (long k = 0; k <= s; ++k) { const long tk = b * S + k; const bf16* kk = p.KK + tk * 384 + h * 96; float sc = 0.f; for (int d = 0; d < 96; ++d) sc += q[d] * bf2f(kk[d]);
            const float mn = sc > m ? sc : m, f = exp2f(m - mn), pr = exp2f(sc - mn); l = l * f + pr; const bf16* vv = p.V + tk * 256 + h * 64; for (int d = 0; d < 64; ++d) o[d] = o[d] * f + pr * bf2f(vv[d]); m = mn; }
        for (int d = 0; d < 64; ++d) p.YC[t * D + 768 + h * 64 + d] = f2bf(o[d] / l); }
}
HD void nv_mixC1(const MP& p, int L, long g0, long gs) {
    const long T = p.T;
    for (long i = g0; i < T * 512; i += gs) { const long t = i / 512, c = t / CHUNK; const int ch = (int)(i % 512), h = ch / 64, pp = ch % 64, g = h / 4;
        const bf16* cm = p.CM + t * 256 + g * 128; const bf16* pv = p.PV + ((c * 8 + h) * 64 + pp) * 128; float a = 0.f; for (int n = 0; n < 128; ++n) a += bf2f(cm[n]) * bf2f(pv[n]);
        const float y = a * expf(p.ACS[t * 8 + h]) + bf2f(p.YD[i]) + p.dskip[L * 8 + h] * bf2f(p.XS[i]); p.YPRE[i] = y * siluf_(bf2f(p.U[t * NU + U_Z + ch])); }
}
HD void nv_mixC2(const MP& p, int L, long g0, long gs) {
    for (long i = g0; i < p.T * 2; i += gs) { const long t = i / 2; const int g = (int)(i % 2); const float* y = p.YPRE + t * 512 + g * 256; float ss = 0.f; for (int k = 0; k < 256; ++k) ss += y[k] * y[k];
        const float r = 1.0f / sqrtf(ss / 256.f + RMS_EPS); for (int k = 0; k < 256; ++k) p.YC[t * D + 256 + g * 256 + k] = f2bf(y[k] * r * p.snorm_g[L * 512 + g * 256 + k]); }
}
HD void nv_outproj(const MP& p, int L, long g0, long gs) { gemm_nt(p.YC, D, p.WOUT + (long)L * D * D, D, p.T, D, D, EpiAddF32{p.H, D}, g0, gs); }
HD void nv_router(const MP& p, int L, long g0, long gs) {
    const int j = L / 2; const float* R = p.router + (long)j * D * NE; const float* g = p.ffn_g + L * D; unsigned* cnt = cnt_ptr(p, j);
    for (long t = g0; t < p.T; t += gs) { const float* h = p.H + t * D; float ss = 0.f; for (int i = 0; i < D; ++i) ss += h[i] * h[i]; const float r = 1.0f / sqrtf(ss / D + RMS_EPS);
        float lg[NE]; for (int e = 0; e < NE; ++e) lg[e] = 0.f; for (int i = 0; i < D; ++i) { const float v = h[i] * r * g[i]; for (int e = 0; e < NE; ++e) lg[e] += v * R[i * NE + e]; }
        int e0 = 0; float v0 = lg[0]; for (int e = 1; e < NE; ++e) if (lg[e] > v0) { v0 = lg[e]; e0 = e; }
        int e1 = -1; float v1 = -3.0e38f; for (int e = 0; e < NE; ++e) if (e != e0 && lg[e] > v1) { v1 = lg[e]; e1 = e; }
        const float g1 = 1.0f / (1.0f + expf(v0 - v1)), gg0 = 1.0f - g1; p.TOPE[t * 2] = e0; p.TOPE[t * 2 + 1] = e1; p.TOPG[t * 2] = gg0; p.TOPG[t * 2 + 1] = g1;
#ifdef __HIP_DEVICE_COMPILE__
        p.POS[t * 2] = (int)atomicAdd(cnt + e0, 1u); p.POS[t * 2 + 1] = (int)atomicAdd(cnt + e1, 1u);
#else
        p.POS[t * 2] = (int)__atomic_fetch_add(cnt + e0, 1u, __ATOMIC_RELAXED); p.POS[t * 2 + 1] = (int)__atomic_fetch_add(cnt + e1, 1u, __ATOMIC_RELAXED);
#endif
    }
}
HD int moe_start_of(const MP& p, int j, int E) { const unsigned* cnt = cnt_ptr(p, j); int o = 0; for (int e = 0; e < NE; ++e) if (e < E) o += (int)((cnt[e] + 255u) / 256u) * 256; return o; }
HD void nv_moeplan(const MP& p, int L, long g0, long gs) {
    const int j = L / 2;
    for (long i = g0; i < p.T * 2; i += gs) { const long t = i / 2; const int slot = moe_start_of(p, j, p.TOPE[i]) + p.POS[i]; p.TOKSLOT[i] = slot; for (int k = 0; k < D; ++k) p.XB[(long)slot * D + k] = p.HB[t * D + k]; }
    for (long i = g0; i < 1024; i += gs) { int e = -1; if (i * 256 < moe_start_of(p, j, NE)) { e = 0; for (int q = 1; q < NE; ++q) if (i * 256 >= moe_start_of(p, j, q)) e = q; } p.TILE_E[i] = e; }
}
HD void nv_gateup(const MP& p, int L, long g0, long gs) {
    const int j = L / 2; const bool moe = L & 1; long rows = p.T; const bf16* Ain = p.HB;
    if (moe) { rows = moe_start_of(p, j, NE); Ain = p.XB; }
    for (long i = g0; i < (rows / 4) * DFF; i += gs) { const long m0 = (i / DFF) * 4; const int jj = (int)(i % DFF); const int e = moe ? p.TILE_E[m0 / 256] : 0;
        const bf16* W = moe ? p.MWGU + ((long)j * NE + e) * NGU * D : p.DWGU + (long)j * NGU * D; const long rg = (jj / 128) * 256 + (jj % 128), ru = rg + 128; float ag[4] = {0, 0, 0, 0}, au[4] = {0, 0, 0, 0};
        for (int k = 0; k < D; k += 8) { const V8 wg = ld8(W + rg * D + k), wu = ld8(W + ru * D + k); for (int r = 0; r < 4; ++r) { const V8 a = ld8(Ain + (m0 + r) * D + k); ag[r] += dot8(a, wg); au[r] += dot8(a, wu); } }
        for (int r = 0; r < 4; ++r) p.ACT[(m0 + r) * DFF + jj] = f2bf(siluf_(ag[r]) * au[r]); }
}
struct EpiYs { bf16* C; HD void operator()(long m, long n, float v) const { C[m * D + n] = f2bf(v); } };
HD void nv_down(const MP& p, int L, long g0, long gs) {
    const int j = L / 2;
    if (!(L & 1)) { gemm_nt(p.ACT, DFF, p.DWD + (long)j * D * DFF, DFF, p.T, D, DFF, EpiAddF32{p.H, D}, g0, gs); return; }
    const long rows = moe_start_of(p, j, NE);
    for (long tl = 0; tl < rows / 256; ++tl) { const int e = p.TILE_E[tl]; gemm_nt(p.ACT + tl * 256 * DFF, DFF, p.MWD + ((long)j * NE + e) * D * DFF, DFF, 256, D, DFF, EpiYs{p.YS + tl * 256 * D}, g0, gs); }
}
HD void nv_norm3(const MP& p, int L, long g0, long gs) {
    const float* g = p.ple_g + L * D;
    for (long t = g0; t < p.T; t += gs) { float* h = p.H + t * D;
        if (L & 1) { const bf16* y0 = p.YS + (long)p.TOKSLOT[t * 2] * D; const bf16* y1 = p.YS + (long)p.TOKSLOT[t * 2 + 1] * D; const float a = p.TOPG[t * 2], b = p.TOPG[t * 2 + 1]; for (int i = 0; i < D; ++i) h[i] += a * bf2f(y0[i]) + b * bf2f(y1[i]); }
        float ss = 0.f; for (int i = 0; i < D; ++i) ss += h[i] * h[i]; const float r = 1.0f / sqrtf(ss / D + RMS_EPS); for (int i = 0; i < D; ++i) p.HB[t * D + i] = f2bf(h[i] * r * g[i]); }
}
HD void nv_ple(const MP& p, int L, long g0, long gs) { gemm_nt(p.HB, D, p.WPG + (long)L * D * D, D, p.T, D, D, EpiPle{p.H, p.PJ}, g0, gs); }
HD void nv_final(const MP& p, long g0, long gs) {
    for (long t = g0; t < p.T; t += gs) { const float* h = p.H + t * D; float ss = 0.f; for (int i = 0; i < D; ++i) ss += h[i] * h[i]; const float r = 1.0f / sqrtf(ss / D + RMS_EPS); for (int i = 0; i < D; ++i) p.out[t * D + i] = h[i] * r * p.fin_g[i]; }
}
enum { NV_PROLOGUE = 0, NV_NORM1, NV_INPROJ, NV_A1, NV_A2, NV_A3A, NV_A3B, NV_B1, NV_ATTN, NV_C1, NV_C2, NV_OUTPROJ, NV_NORM2, NV_ROUTER, NV_MOEPLAN, NV_GATEUP, NV_DOWN, NV_NORM3, NV_PLE, NV_FINAL, NV_NPH };
HD void nv_run(const MP& p, int ph, int L, long g0, long gs) {
    switch (ph) {
    case NV_PROLOGUE: nv_prologue(p, g0, gs); break; case NV_NORM1: nv_norm(p, p.attn_g + L * D, g0, gs); break; case NV_INPROJ: nv_inproj(p, L, g0, gs); break;
    case NV_A1: nv_mixA1(p, L, g0, gs); break; case NV_A2: nv_mixA2(p, L, g0, gs); break; case NV_A3A: nv_mixA3a(p, g0, gs); break; case NV_A3B: nv_mixA3b(p, g0, gs); break;
    case NV_B1: nv_mixB1(p, g0, gs); break; case NV_ATTN: nv_attn(p, g0, gs); break; case NV_C1: nv_mixC1(p, L, g0, gs); break; case NV_C2: nv_mixC2(p, L, g0, gs); break;
    case NV_OUTPROJ: nv_outproj(p, L, g0, gs); break; case NV_NORM2: nv_norm(p, p.ffn_g + L * D, g0, gs); break; case NV_ROUTER: if (L & 1) nv_router(p, L, g0, gs); break;
    case NV_MOEPLAN: if (L & 1) nv_moeplan(p, L, g0, gs); break; case NV_GATEUP: nv_gateup(p, L, g0, gs); break; case NV_DOWN: nv_down(p, L, g0, gs); break;
    case NV_NORM3: nv_norm3(p, L, g0, gs); break; case NV_PLE: nv_ple(p, L, g0, gs); break; case NV_FINAL: nv_final(p, g0, gs); break; }
}
}
using namespace mdl;
template <int PH> __global__ void __launch_bounds__(256) k_nv(MP p, int L) {
    const long g0 = (long)blockIdx.x * blockDim.x + threadIdx.x, gs = (long)gridDim.x * blockDim.x;
    nv_run(p, PH, L, g0, gs);
}
static void fill_params(MP& p, void* const* d_in, void* d_out, void* d_ws) {
    p.x = (const float*)d_in[0]; p.p = (const float*)d_in[1]; p.pos = (const int*)d_in[2];
    const float** w = &p.attn_g; for (int i = 3; i < 32; ++i) w[i - 3] = (const float*)d_in[i];
    p.out = (float*)d_out; p.B = 8; p.S = 2048; p.T = 16384; p.NSLOT = 2 * 16384 + 8 * 256;
    carve(p, (unsigned char*)d_ws);
}
#define LAUNCH(PH, L) hipLaunchKernelGGL(k_nv<PH>, dim3(2048), dim3(256), 0, stream, p, L)
extern "C" void kernel_launch(void* const* d_in, const int* in_sizes, int n_in, void* d_out, int out_size, void* d_ws, size_t ws_size, hipStream_t stream) {
    MP p{}; fill_params(p, d_in, d_out, d_ws);
    { MP q{}; q.T = 16384; q.NSLOT = p.NSLOT; const size_t need = carve(q, nullptr); if (n_in != 32 || ws_size < need) { fprintf(stderr, "kernel_launch: need %zu bytes of ws, have %zu (n_in %d)\n", need, ws_size, n_in); return; } }
    hipMemsetAsync(p.ctl, 0, CTL_WORDS * 4, stream);
    LAUNCH(NV_PROLOGUE, 0);
    for (int L = 0; L < 4; ++L) {
        LAUNCH(NV_NORM1, L); LAUNCH(NV_INPROJ, L); LAUNCH(NV_A1, L); LAUNCH(NV_A2, L); LAUNCH(NV_A3A, L); LAUNCH(NV_A3B, L); LAUNCH(NV_B1, L); LAUNCH(NV_ATTN, L); LAUNCH(NV_C1, L); LAUNCH(NV_C2, L);
        LAUNCH(NV_OUTPROJ, L); LAUNCH(NV_NORM2, L);
        if (L & 1) { LAUNCH(NV_ROUTER, L); LAUNCH(NV_MOEPLAN, L); }
        LAUNCH(NV_GATEUP, L); LAUNCH(NV_DOWN, L); LAUNCH(NV_NORM3, L); LAUNCH(NV_PLE, L);
    }
    LAUNCH(NV_FINAL, 0);
}
```

```cpp
#include <hip/hip_runtime.h>
#include <cstdio>
#include <cstdint>
__device__ __forceinline__ int mk_tid() { int t = threadIdx.x; asm volatile("" : "+v"(t)); return t; }

#include <cstring>
#include <cmath>
#include <cstdint>
#ifdef __HIPCC__
#define HD __host__ __device__ __forceinline__
#else
#define HD inline
#endif
typedef unsigned short bf16;
namespace mdl {
constexpr int D = 1024, DEPTH = 4, NU = 2560, NUO = 2472, DFF = 3584, NGU = 7168, NE = 8, PLE = 256;
constexpr int CK = 31, SCONV = 4, CHUNK = 128, NH = 8, HP = 64, NS = 128;
constexpr float RMS_EPS = 1e-6f, LN_EPS = 1e-5f;
constexpr float QSCALE = 0.10206207261596577f * 1.4426950408889634f;
constexpr int U_Z = 512, U_XBC = 1024, U_CQ = 2048, U_CKV = 2304, U_KR = 2432, U_DT = 2464;

HD float bf2f(bf16 v) { unsigned u = (unsigned)v << 16; float f; memcpy(&f, &u, 4); return f; }
HD bf16 f2bf(float f) { unsigned u; memcpy(&u, &f, 4); u += 0x7fffu + ((u >> 16) & 1u); return (bf16)(u >> 16); }
HD float sigmoidf_(float x) { return 1.0f / (1.0f + expf(-x)); }
HD float siluf_(float x) { return x / (1.0f + expf(-x)); }
HD float softplusf_(float x) { return x > 20.f ? x : log1pf(expf(x)); }
HD int ucol_src(int n) { return n < 2048 ? n : (n < U_DT ? n + 8 : (n < NUO ? n - U_DT + 2048 : -1)); }

struct MP {
    const float *x, *p; const int* pos;
    const float *attn_g, *w_in, *cdw_w, *cdw_b, *cln_g, *cln_b, *sconv_w, *sconv_b, *dt_bias, *a_log, *dskip, *snorm_g, *qn_g, *w_uq, *kvn_g, *w_ukv,
        *w_out, *ffn_g, *dwg, *dwu, *dwd, *router, *mwg, *mwu, *mwd, *ple_g, *ple_wg, *ple_wp, *fin_g;
    float* out;
    long B, S, T, NSLOT;
    unsigned* ctl;
    bf16 *WIN, *WUQ, *WUKV, *WOUT, *DWGU, *DWD, *MWGU, *MWD, *WPG, *WPP;
    float *H, *CS, *DT, *ACS, *ST, *CB, *YPRE, *TOPG;
    bf16 *HB, *U, *YC, *Q, *KK, *V, *XS, *BM, *CM, *YD, *PV, *PB16, *PJ, *ACT, *XB, *YS;
    int *TOPE, *POS, *TOKSLOT, *TILE_E;
};
constexpr int CTL_WORDS = 65536;
HD unsigned* cnt_ptr(const MP& p, int j) { return p.ctl + 1024 + j * 64; }

inline size_t carve(MP& p, unsigned char* ws) {
    size_t o = 0; const size_t T = p.T, NSL = p.NSLOT;
    auto take = [&](size_t bytes) { size_t r = o; o += (bytes + 255) & ~(size_t)255; return ws + r; };
    p.ctl = (unsigned*)take(CTL_WORDS * 4);
    p.WIN = (bf16*)take((size_t)DEPTH * NU * D * 2); p.WUQ = (bf16*)take((size_t)DEPTH * 512 * 256 * 2); p.WUKV = (bf16*)take((size_t)DEPTH * 512 * 128 * 2);
    p.WOUT = (bf16*)take((size_t)DEPTH * D * D * 2); p.DWGU = (bf16*)take((size_t)2 * NGU * D * 2); p.DWD = (bf16*)take((size_t)2 * D * DFF * 2);
    p.MWGU = (bf16*)take((size_t)2 * NE * NGU * D * 2); p.MWD = (bf16*)take((size_t)2 * NE * D * DFF * 2);
    p.WPG = (bf16*)take((size_t)DEPTH * D * D * 2); p.WPP = (bf16*)take((size_t)DEPTH * D * PLE * 2);
    p.H = (float*)take(T * D * 4); p.HB = (bf16*)take(T * D * 2); p.CS = (float*)take(T * 32 * 4);
    p.PB16 = (bf16*)take((size_t)DEPTH * T * PLE * 2); p.PJ = (bf16*)take(T * D * 2);
    p.TOPE = (int*)take(T * 2 * 4); p.TOPG = (float*)take(T * 2 * 4); p.POS = (int*)take(T * 2 * 4); p.TOKSLOT = (int*)take(T * 2 * 4); p.TILE_E = (int*)take(1024 * 4);
    p.XB = (bf16*)take(NSL * D * 2); p.YS = p.XB;
    const size_t r1 = o;
    p.U = (bf16*)take(T * NU * 2); p.YC = (bf16*)take(T * D * 2); p.Q = (bf16*)take(T * 384 * 2); p.KK = (bf16*)take(T * 384 * 2); p.V = (bf16*)take(T * 256 * 2);
    p.XS = (bf16*)take(T * 512 * 2); p.BM = (bf16*)take(T * 256 * 2); p.CM = (bf16*)take(T * 256 * 2); p.YD = (bf16*)take(T * 512 * 2);
    p.DT = (float*)take(T * 8 * 4); p.ACS = (float*)take(T * 8 * 4); p.ST = (float*)take(T / CHUNK * NH * HP * NS * 4); p.PV = (bf16*)take(T / CHUNK * NH * HP * NS * 2);
    p.CB = (float*)take(T / CHUNK * 2 * CHUNK * CHUNK * 4); p.YPRE = (float*)take(T * 512 * 4);
    const size_t r1end = o; o = r1;
    p.ACT = (bf16*)take(NSL * DFF * 2);
    if (o < r1end) o = r1end;
    return o;
}

struct V8 { float v[8]; };
HD V8 ld8(const bf16* p) { V8 r; const uint4 u = *(const uint4*)p; const unsigned w[4] = {u.x, u.y, u.z, u.w};
    for (int i = 0; i < 4; ++i) { r.v[2 * i] = bf2f((bf16)(w[i] & 0xffff)); r.v[2 * i + 1] = bf2f((bf16)(w[i] >> 16)); } return r; }
HD float dot8(const V8& a, const V8& b) { float s = 0.f; for (int i = 0; i < 8; ++i) s += a.v[i] * b.v[i]; return s; }

template <class Epi> HD void gemm_nt(const bf16* A, long lda, const bf16* Bt, long ldb, long M, long N, long K, const Epi& epi, long g0, long gs) {
    const long ntn = N / 4, ntile = (M / 4) * ntn;
    for (long t = g0; t < ntile; t += gs) {
        const long m0 = (t / ntn) * 4, n0 = (t % ntn) * 4; float acc[4][4];
        for (int i = 0; i < 4; ++i) for (int j = 0; j < 4; ++j) acc[i][j] = 0.f;
        for (long k = 0; k < K; k += 8) { V8 a0 = ld8(A + (m0 + 0) * lda + k), a1 = ld8(A + (m0 + 1) * lda + k), a2 = ld8(A + (m0 + 2) * lda + k), a3 = ld8(A + (m0 + 3) * lda + k);
            V8 b0 = ld8(Bt + (n0 + 0) * ldb + k), b1 = ld8(Bt + (n0 + 1) * ldb + k), b2 = ld8(Bt + (n0 + 2) * ldb + k), b3 = ld8(Bt + (n0 + 3) * ldb + k);
            acc[0][0] += dot8(a0, b0); acc[0][1] += dot8(a0, b1); acc[0][2] += dot8(a0, b2); acc[0][3] += dot8(a0, b3);
            acc[1][0] += dot8(a1, b0); acc[1][1] += dot8(a1, b1); acc[1][2] += dot8(a1, b2); acc[1][3] += dot8(a1, b3);
            acc[2][0] += dot8(a2, b0); acc[2][1] += dot8(a2, b1); acc[2][2] += dot8(a2, b2); acc[2][3] += dot8(a2, b3);
            acc[3][0] += dot8(a3, b0); acc[3][1] += dot8(a3, b1); acc[3][2] += dot8(a3, b2); acc[3][3] += dot8(a3, b3); }
        epi(m0 + 0, n0 + 0, acc[0][0]); epi(m0 + 0, n0 + 1, acc[0][1]); epi(m0 + 0, n0 + 2, acc[0][2]); epi(m0 + 0, n0 + 3, acc[0][3]);
        epi(m0 + 1, n0 + 0, acc[1][0]); epi(m0 + 1, n0 + 1, acc[1][1]); epi(m0 + 1, n0 + 2, acc[1][2]); epi(m0 + 1, n0 + 3, acc[1][3]);
        epi(m0 + 2, n0 + 0, acc[2][0]); epi(m0 + 2, n0 + 1, acc[2][1]); epi(m0 + 2, n0 + 2, acc[2][2]); epi(m0 + 2, n0 + 3, acc[2][3]);
        epi(m0 + 3, n0 + 0, acc[3][0]); epi(m0 + 3, n0 + 1, acc[3][1]); epi(m0 + 3, n0 + 2, acc[3][2]); epi(m0 + 3, n0 + 3, acc[3][3]);
    }
}
struct EpiStoreBf { bf16* C; long ldc; HD void operator()(long m, long n, float v) const { C[m * ldc + n] = f2bf(v); } };
struct EpiAddF32 { float* C; long ldc; HD void operator()(long m, long n, float v) const { C[m * ldc + n] += v; } };
struct EpiPle { float* H; const bf16* PJ; HD void operator()(long m, long n, float v) const { H[m * D + n] += bf2f(PJ[m * D + n]) * sigmoidf_(v); } };

HD void tr_elem(const float* W, long K, long N, bf16* WT, long i) { const long n = i / K, k = i % K; WT[i] = f2bf(W[k * N + n]); }
HD void nv_prologue(const MP& p, long g0, long gs) {
    const long T = p.T;
    for (long i = g0; i < (long)DEPTH * NU * D; i += gs) { const long l = i / ((long)NU * D), r = i % ((long)NU * D), n = r / D, k = r % D; const int c = ucol_src((int)n);
        p.WIN[i] = c < 0 ? (bf16)0 : f2bf(p.w_in[(l * D + k) * NUO + c]); }
    for (long i = g0; i < (long)DEPTH * 512 * 256; i += gs) { const long l = i / (512 * 256), r = i % (512 * 256), n = r / 256, k = r % 256; p.WUQ[i] = n < 384 ? f2bf(p.w_uq[(l * 256 + k) * 384 + n]) : (bf16)0; }
    for (long i = g0; i < (long)DEPTH * 512 * 128; i += gs) { const long l = i / (512 * 128), r = i % (512 * 128), n = r / 128, k = r % 128; p.WUKV[i] = f2bf(p.w_ukv[(l * 128 + k) * 512 + n]); }
    for (long i = g0; i < (long)DEPTH * D * D; i += gs) { const long l = i / ((long)D * D); tr_elem(p.w_out + l * D * D, D, D, p.WOUT + l * D * D, i % ((long)D * D)); tr_elem(p.ple_wg + l * D * D, D, D, p.WPG + l * D * D, i % ((long)D * D)); }
    for (long i = g0; i < (long)DEPTH * D * PLE; i += gs) { const long l = i / ((long)D * PLE); tr_elem(p.ple_wp + l * PLE * D, PLE, D, p.WPP + l * D * PLE, i % ((long)D * PLE)); }
    for (long i = g0; i < (long)18 * NGU * D; i += gs) { const long mt = i / ((long)NGU * D), r = i % ((long)NGU * D), n = r / D, k = r % D, tl = n / 256, rr = n % 256, col = tl * 128 + (rr & 127);
        const float* src; bf16* dst;
        if (mt < 2) { src = (rr < 128 ? p.dwg : p.dwu) + mt * (long)D * DFF; dst = p.DWGU + mt * (long)NGU * D; } else { src = (rr < 128 ? p.mwg : p.mwu) + (mt - 2) * (long)D * DFF; dst = p.MWGU + (mt - 2) * (long)NGU * D; }
        dst[r] = f2bf(src[k * DFF + col]); }
    for (long i = g0; i < (long)18 * D * DFF; i += gs) { const long mt = i / ((long)D * DFF), r = i % ((long)D * DFF);
        if (mt < 2) tr_elem(p.dwd + mt * (long)DFF * D, DFF, D, p.DWD + mt * (long)D * DFF, r); else tr_elem(p.mwd + (mt - 2) * (long)DFF * D, DFF, D, p.MWD + (mt - 2) * (long)D * DFF, r); }
    for (long i = g0; i < T * D; i += gs) p.H[i] = p.x[i];
    for (long i = g0; i < (long)DEPTH * T * PLE; i += gs) p.PB16[i] = f2bf(p.p[i]);
    for (long i = g0; i < T * 16; i += gs) { const long t = i / 16; const int j = (int)(i % 16); const float inv = powf(10000.0f, -(float)(2 * j) / 32.0f), ang = (float)p.pos[t] * inv;
        p.CS[t * 32 + j] = cosf(ang); p.CS[t * 32 + 16 + j] = sinf(ang); }
}
HD void nv_norm(const MP& p, const float* g, long g0, long gs) {
    for (long t = g0; t < p.T; t += gs) { const float* h = p.H + t * D; float ss = 0.f; for (int i = 0; i < D; ++i) ss += h[i] * h[i];
        const float r = 1.0f / sqrtf(ss / D + RMS_EPS); for (int i = 0; i < D; ++i) p.HB[t * D + i] = f2bf(h[i] * r * g[i]); }
}
HD void nv_inproj(const MP& p, int L, long g0, long gs) {
    gemm_nt(p.HB, D, p.WIN + (long)L * NU * D, D, p.T, NU, D, EpiStoreBf{p.U, NU}, g0, gs);
    gemm_nt(p.PB16 + (long)L * p.T * PLE, PLE, p.WPP + (long)L * D * PLE, PLE, p.T, D, PLE, EpiStoreBf{p.PJ, D}, g0, gs);
}
HD float cm_conv(const MP& p, int L, long b, long s, int c) {
    float acc = p.cdw_b[L * 256 + c];
    for (int j = 0; j < CK; ++j) { const long sp = s - (CK - 1) + j; if (sp < 0) continue; const bf16* u = p.U + (b * p.S + sp) * NU;
        acc += p.cdw_w[(L * CK + j) * 256 + c] * (bf2f(u[c]) * sigmoidf_(bf2f(u[256 + c]))); }
    return acc;
}
HD void nv_mixA1(const MP& p, int L, long g0, long gs) {
    const long T = p.T, S = p.S;
    for (long i = g0; i < T * 4; i += gs) { const long t = i / 4, b = t / S, s = t % S; const int gq = (int)(i % 4);
        float sm = 0.f, sq = 0.f; for (int c = 0; c < 64; ++c) { const float v = cm_conv(p, L, b, s, gq * 64 + c); sm += v; sq += v * v; }
        const float mu = sm / 64.f; float var = sq / 64.f - mu * mu; if (var < 0.f) var = 0.f; const float rs = 1.0f / sqrtf(var + LN_EPS);
        for (int c = 0; c < 64; ++c) { const int ch = gq * 64 + c; const float v = (cm_conv(p, L, b, s, ch) - mu) * rs * p.cln_g[L * 256 + ch] + p.cln_b[L * 256 + ch]; p.YC[t * D + ch] = f2bf(siluf_(v)); } }
    for (long i = g0; i < T * 1024; i += gs) { const long t = i / 1024, b = t / S, s = t % S; const int c = (int)(i % 1024);
        float acc = p.sconv_b[L * 1024 + c]; for (int j = 0; j < SCONV; ++j) { const long sp = s - (SCONV - 1) + j; if (sp < 0) continue; acc += p.sconv_w[(L * SCONV + j) * 1024 + c] * bf2f(p.U[(b * S + sp) * NU + U_XBC + c]); }
        const bf16 v = f2bf(siluf_(acc)); if (c < 512) p.XS[t * 512 + c] = v; else if (c < 768) p.BM[t * 256 + c - 512] = v; else p.CM[t * 256 + c - 768] = v; }
    for (long i = g0; i < T * 8; i += gs) { const long t = i / 8; const int h = (int)(i % 8); p.DT[i] = softplusf_(bf2f(p.U[t * NU + U_DT + h]) + p.dt_bias[L * 8 + h]); }
    for (long i = g0; i < T * 4 * 80; i += gs) { const long t = i / 320; const int h = (int)((i % 320) / 80), ii = (int)(i % 80); const bf16* cq = p.U + t * NU + U_CQ;
        float ss = 0.f; for (int k = 0; k < 256; ++k) { const float v = bf2f(cq[k]); ss += v * v; } const float r = 1.0f / sqrtf(ss / 256.f + RMS_EPS);
        const bf16* W = p.WUQ + (long)L * 512 * 256;
        if (ii < 64) { const int n = h * 96 + ii; float a = 0.f; for (int k = 0; k < 256; ++k) a += bf2f(f2bf(bf2f(cq[k]) * r * p.qn_g[L * 256 + k])) * bf2f(W[n * 256 + k]); p.Q[t * 384 + n] = f2bf(a * QSCALE); }
        else { const int j = ii - 64, n1 = h * 96 + 64 + j, n2 = n1 + 16; float a1 = 0.f, a2 = 0.f;
            for (int k = 0; k < 256; ++k) { const float xv = bf2f(f2bf(bf2f(cq[k]) * r * p.qn_g[L * 256 + k])); a1 += xv * bf2f(W[n1 * 256 + k]); a2 += xv * bf2f(W[n2 * 256 + k]); }
            const float c = p.CS[t * 32 + j], sn = p.CS[t * 32 + 16 + j]; p.Q[t * 384 + n1] = f2bf((a1 * c - a2 * sn) * QSCALE); p.Q[t * 384 + n2] = f2bf((a1 * sn + a2 * c) * QSCALE); } }
    for (long i = g0; i < T * 512; i += gs) { const long t = i / 512; const int n = (int)(i % 512); const bf16* ck = p.U + t * NU + U_CKV;
        float ss = 0.f; for (int k = 0; k < 128; ++k) { const float v = bf2f(ck[k]); ss += v * v; } const float r = 1.0f / sqrtf(ss / 128.f + RMS_EPS);
        const bf16* W = p.WUKV + (long)L * 512 * 128; float a = 0.f; for (int k = 0; k < 128; ++k) a += bf2f(f2bf(bf2f(ck[k]) * r * p.kvn_g[L * 128 + k])) * bf2f(W[n * 128 + k]);
        const int h = n / 128, d = n % 128; if (d < 64) p.KK[t * 384 + h * 96 + d] = f2bf(a); else p.V[t * 256 + h * 64 + d - 64] = f2bf(a); }
    for (long i = g0; i < T * 16; i += gs) { const long t = i / 16; const int j = (int)(i % 16); const float x1 = bf2f(p.U[t * NU + U_KR + j]), x2 = bf2f(p.U[t * NU + U_KR + 16 + j]), c = p.CS[t * 32 + j], sn = p.CS[t * 32 + 16 + j];
        const bf16 o1 = f2bf(x1 * c - x2 * sn), o2 = f2bf(x1 * sn + x2 * c); for (int h = 0; h < 4; ++h) { p.KK[t * 384 + h * 96 + 64 + j] = o1; p.KK[t * 384 + h * 96 + 80 + j] = o2; } }
}
HD void nv_mixA2(const MP& p, int L, long g0, long gs) {
    const long NC = p.T / CHUNK;
    for (long i = g0; i < NC * 8; i += gs) { const long c = i / 8; const int h = (int)(i % 8); const float a = -expf(p.a_log[L * 8 + h]); float cs = 0.f;
        for (int l = 0; l < CHUNK; ++l) { const long t = c * CHUNK + l; cs += p.DT[t * 8 + h] * a; p.ACS[t * 8 + h] = cs; } }
}
HD void nv_mixA3a(const MP& p, long g0, long gs) {
    const long NC = p.T / CHUNK;
    for (long i = g0; i < NC * 2 * CHUNK * CHUNK; i += gs) { const long u = i / (CHUNK * CHUNK), c = u / 2; const int g = (int)(u % 2), l = (int)((i / CHUNK) % CHUNK), s = (int)(i % CHUNK);
        const bf16* cm = p.CM + (c * CHUNK + l) * 256 + g * 128; const bf16* bm = p.BM + (c * CHUNK + s) * 256 + g * 128; float a = 0.f; for (int n = 0; n < 128; ++n) a += bf2f(cm[n]) * bf2f(bm[n]); p.CB[i] = a; }
}
HD void nv_mixA3b(const MP& p, long g0, long gs) {
    const long T = p.T, NC = T / CHUNK;
    for (long i = g0; i < T * 512; i += gs) { const long t = i / 512, c = t / CHUNK; const int ch = (int)(i % 512), h = ch / 64, g = h / 4, l = (int)(t % CHUNK);
        const float* cb = p.CB + ((c * 2 + g) * CHUNK + l) * CHUNK; const float al = p.ACS[t * 8 + h]; float a = 0.f;
        for (int s = 0; s <= l; ++s) { const long ts = c * CHUNK + s; a += cb[s] * expf(al - p.ACS[ts * 8 + h]) * p.DT[ts * 8 + h] * bf2f(p.XS[ts * 512 + ch]); }
        p.YD[i] = f2bf(a); }
    for (long i = g0; i < NC * 8 * 64 * 128; i += gs) { const long c = i / (8 * 64 * 128); const int h = (int)((i / (64 * 128)) % 8), pp = (int)((i / 128) % 64), n = (int)(i % 128), g = h / 4;
        const float alast = p.ACS[(c * CHUNK + CHUNK - 1) * 8 + h]; float a = 0.f;
        for (int l = 0; l < CHUNK; ++l) { const long t = c * CHUNK + l; a += bf2f(p.BM[t * 256 + g * 128 + n]) * expf(alast - p.ACS[t * 8 + h]) * p.DT[t * 8 + h] * bf2f(p.XS[t * 512 + h * 64 + pp]); }
        p.ST[i] = a; }
}
HD void nv_mixB1(const MP& p, long g0, long gs) {
    const long NCB = p.S / CHUNK;
    for (long i = g0; i < p.B * 8 * 64 * 128; i += gs) { const long b = i / (8 * 64 * 128); const long r = i % (8 * 64 * 128); const int h = (int)(r / (64 * 128)); float carry = 0.f;
        for (long cc = 0; cc < NCB; ++cc) { const long c = b * NCB + cc; const long idx = c * (8 * 64 * 128) + r; p.PV[idx] = f2bf(carry); carry = carry * expf(p.ACS[(c * CHUNK + CHUNK - 1) * 8 + h]) + p.ST[idx]; } }
}
HD void nv_attn(const MP& p, long g0, long gs) {
    const long T = p.T, S = p.S;
    for (long i = g0; i < T * 4; i += gs) { const long t = i / 4, b = t / S, s = t % S; const int h = (int)(i % 4);
        float q[96], o[64]; for (int d = 0; d < 96; ++d) q[d] = bf2f(p.Q[t * 384 + h * 96 + d]); for (int d = 0; d < 64; ++d) o[d] = 0.f; float m = -1e30f, l = 0.f;
        for (long k = 0; k <= s; ++k) { const long tk = b * S + k; const bf16* kk = p.KK + tk * 384 + h * 96; float sc = 0.f; for (int d = 0; d < 96; ++d) sc += q[d] * bf2f(kk[d]);
            const float mn = sc > m ? sc : m, f = exp2f(m - mn), pr = exp2f(sc - mn); l = l * f + pr; const bf16* vv = p.V + tk * 256 + h * 64; for (int d = 0; d < 64; ++d) o[d] = o[d] * f + pr * bf2f(vv[d]); m = mn; }
        for (int d = 0; d < 64; ++d) p.YC[t * D + 768 + h * 64 + d] = f2bf(o[d] / l); }
}
HD void nv_mixC1(const MP& p, int L, long g0, long gs) {
    const long T = p.T;
    for (long i = g0; i < T * 512; i += gs) { const long t = i / 512, c = t / CHUNK; const int ch = (int)(i % 512), h = ch / 64, pp = ch % 64, g = h / 4;
        const bf16* cm = p.CM + t * 256 + g * 128; const bf16* pv = p.PV + ((c * 8 + h) * 64 + pp) * 128; float a = 0.f; for (int n = 0; n < 128; ++n) a += bf2f(cm[n]) * bf2f(pv[n]);
        const float y = a * expf(p.ACS[t * 8 + h]) + bf2f(p.YD[i]) + p.dskip[L * 8 + h] * bf2f(p.XS[i]); p.YPRE[i] = y * siluf_(bf2f(p.U[t * NU + U_Z + ch])); }
}
HD void nv_mixC2(const MP& p, int L, long g0, long gs) {
    for (long i = g0; i < p.T * 2; i += gs) { const long t = i / 2; const int g = (int)(i % 2); const float* y = p.YPRE + t * 512 + g * 256; float ss = 0.f; for (int k = 0; k < 256; ++k) ss += y[k] * y[k];
        const float r = 1.0f / sqrtf(ss / 256.f + RMS_EPS); for (int k = 0; k < 256; ++k) p.YC[t * D + 256 + g * 256 + k] = f2bf(y[k] * r * p.snorm_g[L * 512 + g * 256 + k]); }
}
HD void nv_outproj(const MP& p, int L, long g0, long gs) { gemm_nt(p.YC, D, p.WOUT + (long)L * D * D, D, p.T, D, D, EpiAddF32{p.H, D}, g0, gs); }
HD void nv_router(const MP& p, int L, long g0, long gs) {
    const int j = L / 2; const float* R = p.router + (long)j * D * NE; const float* g = p.ffn_g + L * D; unsigned* cnt = cnt_ptr(p, j);
    for (long t = g0; t < p.T; t += gs) { const float* h = p.H + t * D; float ss = 0.f; for (int i = 0; i < D; ++i) ss += h[i] * h[i]; const float r = 1.0f / sqrtf(ss / D + RMS_EPS);
        float lg[NE]; for (int e = 0; e < NE; ++e) lg[e] = 0.f; for (int i = 0; i < D; ++i) { const float v = h[i] * r * g[i]; for (int e = 0; e < NE; ++e) lg[e] += v * R[i * NE + e]; }
        int e0 = 0; float v0 = lg[0]; for (int e = 1; e < NE; ++e) if (lg[e] > v0) { v0 = lg[e]; e0 = e; }
        int e1 = -1; float v1 = -3.0e38f; for (int e = 0; e < NE; ++e) if (e != e0 && lg[e] > v1) { v1 = lg[e]; e1 = e; }
        const float g1 = 1.0f / (1.0f + expf(v0 - v1)), gg0 = 1.0f - g1; p.TOPE[t * 2] = e0; p.TOPE[t * 2 + 1] = e1; p.TOPG[t * 2] = gg0; p.TOPG[t * 2 + 1] = g1;
#ifdef __HIP_DEVICE_COMPILE__
        p.POS[t * 2] = (int)atomicAdd(cnt + e0, 1u); p.POS[t * 2 + 1] = (int)atomicAdd(cnt + e1, 1u);
#else
        p.POS[t * 2] = (int)__atomic_fetch_add(cnt + e0, 1u, __ATOMIC_RELAXED); p.POS[t * 2 + 1] = (int)__atomic_fetch_add(cnt + e1, 1u, __ATOMIC_RELAXED);
#endif
    }
}
HD int moe_start_of(const MP& p, int j, int E) { const unsigned* cnt = cnt_ptr(p, j); int o = 0; for (int e = 0; e < NE; ++e) if (e < E) o += (int)((cnt[e] + 255u) / 256u) * 256; return o; }
HD void nv_moeplan(const MP& p, int L, long g0, long gs) {
    const int j = L / 2;
    for (long i = g0; i < p.T * 2; i += gs) { const long t = i / 2; const int slot = moe_start_of(p, j, p.TOPE[i]) + p.POS[i]; p.TOKSLOT[i] = slot; for (int k = 0; k < D; ++k) p.XB[(long)slot * D + k] = p.HB[t * D + k]; }
    for (long i = g0; i < 1024; i += gs) { int e = -1; if (i * 256 < moe_start_of(p, j, NE)) { e = 0; for (int q = 1; q < NE; ++q) if (i * 256 >= moe_start_of(p, j, q)) e = q; } p.TILE_E[i] = e; }
}
HD void nv_gateup(const MP& p, int L, long g0, long gs) {
    const int j = L / 2; const bool moe = L & 1; long rows = p.T; const bf16* Ain = p.HB;
    if (moe) { rows = moe_start_of(p, j, NE); Ain = p.XB; }
    for (long i = g0; i < (rows / 4) * DFF; i += gs) { const long m0 = (i / DFF) * 4; const int jj = (int)(i % DFF); const int e = moe ? p.TILE_E[m0 / 256] : 0;
        const bf16* W = moe ? p.MWGU + ((long)j * NE + e) * NGU * D : p.DWGU + (long)j * NGU * D; const long rg = (jj / 128) * 256 + (jj % 128), ru = rg + 128; float ag[4] = {0, 0, 0, 0}, au[4] = {0, 0, 0, 0};
        for (int k = 0; k < D; k += 8) { const V8 wg = ld8(W + rg * D + k), wu = ld8(W + ru * D + k); for (int r = 0; r < 4; ++r) { const V8 a = ld8(Ain + (m0 + r) * D + k); ag[r] += dot8(a, wg); au[r] += dot8(a, wu); } }
        for (int r = 0; r < 4; ++r) p.ACT[(m0 + r) * DFF + jj] = f2bf(siluf_(ag[r]) * au[r]); }
}
struct EpiYs { bf16* C; HD void operator()(long m, long n, float v) const { C[m * D + n] = f2bf(v); } };
HD void nv_down(const MP& p, int L, long g0, long gs) {
    const int j = L / 2;
    if (!(L & 1)) { gemm_nt(p.ACT, DFF, p.DWD + (long)j * D * DFF, DFF, p.T, D, DFF, EpiAddF32{p.H, D}, g0, gs); return; }
    const long rows = moe_start_of(p, j, NE);
    for (long tl = 0; tl < rows / 256; ++tl) { const int e = p.TILE_E[tl]; gemm_nt(p.ACT + tl * 256 * DFF, DFF, p.MWD + ((long)j * NE + e) * D * DFF, DFF, 256, D, DFF, EpiYs{p.YS + tl * 256 * D}, g0, gs); }
}
HD void nv_norm3(const MP& p, int L, long g0, long gs) {
    const float* g = p.ple_g + L * D;
    for (long t = g0; t < p.T; t += gs) { float* h = p.H + t * D;
        if (L & 1) { const bf16* y0 = p.YS + (long)p.TOKSLOT[t * 2] * D; const bf16* y1 = p.YS + (long)p.TOKSLOT[t * 2 + 1] * D; const float a = p.TOPG[t * 2], b = p.TOPG[t * 2 + 1]; for (int i = 0; i < D; ++i) h[i] += a * bf2f(y0[i]) + b * bf2f(y1[i]); }
        float ss = 0.f; for (int i = 0; i < D; ++i) ss += h[i] * h[i]; const float r = 1.0f / sqrtf(ss / D + RMS_EPS); for (int i = 0; i < D; ++i) p.HB[t * D + i] = f2bf(h[i] * r * g[i]); }
}
HD void nv_ple(const MP& p, int L, long g0, long gs) { gemm_nt(p.HB, D, p.WPG + (long)L * D * D, D, p.T, D, D, EpiPle{p.H, p.PJ}, g0, gs); }
HD void nv_final(const MP& p, long g0, long gs) {
    for (long t = g0; t < p.T; t += gs) { const float* h = p.H + t * D; float ss = 0.f; for (int i = 0; i < D; ++i) ss += h[i] * h[i]; const float r = 1.0f / sqrtf(ss / D + RMS_EPS); for (int i = 0; i < D; ++i) p.out[t * D + i] = h[i] * r * p.fin_g[i]; }
}
enum { NV_PROLOGUE = 0, NV_NORM1, NV_INPROJ, NV_A1, NV_A2, NV_A3A, NV_A3B, NV_B1, NV_ATTN, NV_C1, NV_C2, NV_OUTPROJ, NV_NORM2, NV_ROUTER, NV_MOEPLAN, NV_GATEUP, NV_DOWN, NV_NORM3, NV_PLE, NV_FINAL, NV_NPH };
HD void nv_run(const MP& p, int ph, int L, long g0, long gs) {
    switch (ph) {
    case NV_PROLOGUE: nv_prologue(p, g0, gs); break; case NV_NORM1: nv_norm(p, p.attn_g + L * D, g0, gs); break; case NV_INPROJ: nv_inproj(p, L, g0, gs); break;
    case NV_A1: nv_mixA1(p, L, g0, gs); break; case NV_A2: nv_mixA2(p, L, g0, gs); break; case NV_A3A: nv_mixA3a(p, g0, gs); break; case NV_A3B: nv_mixA3b(p, g0, gs); break;
    case NV_B1: nv_mixB1(p, g0, gs); break; case NV_ATTN: nv_attn(p, g0, gs); break; case NV_C1: nv_mixC1(p, L, g0, gs); break; case NV_C2: nv_mixC2(p, L, g0, gs); break;
    case NV_OUTPROJ: nv_outproj(p, L, g0, gs); break; case NV_NORM2: nv_norm(p, p.ffn_g + L * D, g0, gs); break; case NV_ROUTER: if (L & 1) nv_router(p, L, g0, gs); break;
    case NV_MOEPLAN: if (L & 1) nv_moeplan(p, L, g0, gs); break; case NV_GATEUP: nv_gateup(p, L, g0, gs); break; case NV_DOWN: nv_down(p, L, g0, gs); break;
    case NV_NORM3: nv_norm3(p, L, g0, gs); break; case NV_PLE: nv_ple(p, L, g0, gs); break; case NV_FINAL: nv_final(p, g0, gs); break; }
}
}

namespace pg8 {
#define PG8_LAS __attribute__((address_space(3)))
typedef unsigned short bf16_t;
typedef short bf16x8 __attribute__((ext_vector_type(8)));
typedef float f32x4 __attribute__((ext_vector_type(4)));
typedef unsigned u32x4 __attribute__((ext_vector_type(4)));
constexpr int BM = 256, BK = 64, HALF = 128, HTB = HALF * BK * 2  , STAGE_BYTES = 8 * HTB, NXCD = 8, WGM = 8;

__host__ __device__ __forceinline__ int lds_byte(int r, int c) { const int st = (r >> 4) * 2 + (c >> 5), rr = r & 15, cc = c & 31, ob = rr * 64 + cc * 2; return st * 1024 + (ob ^ (((ob >> 9) & 1) << 5)); }
__host__ __device__ __forceinline__ void stage_rc(int b, int& R, int& C) { const int st = b / 1024, sb = b % 1024, swz = sb ^ (((sb >> 9) & 1) << 5); R = (st >> 1) * 16 + swz / 64; C = (st & 1) * 32 + (swz % 64) / 2; }
__host__ __device__ __forceinline__ int perm32(int rho) { const int n = rho >> 4, i = rho & 15; return 8 * (i >> 2) + 4 * n + (i & 3); }

struct Unit { int pm, pn, cn; };
struct Gemm { const bf16_t* A; const bf16_t* Bt; int M, N, K; };

struct StaticOrder {
    int nM, nN, nwg, G, c;
    __host__ __device__ void init(int M, int N, int G_, int c_) { nM = M / BM; nN = N / BM; nwg = nM * nN; G = G_; c = c_; }
    __host__ __device__ bool next(int i, Unit& u) const {
        const long L = (long)i * G + c; if (L >= nwg) return false;
        int wgid = (int)L; { const int q = nwg / NXCD, r = nwg % NXCD, xcd = wgid % NXCD, off = wgid / NXCD; wgid = (xcd < r ? xcd * (q + 1) : r * (q + 1) + (xcd - r) * q) + off; }
        const int nig = WGM * nN, gid = wgid / nig, fm = gid * WGM, gsz = (nM - fm) < WGM ? (nM - fm) : WGM;
        u.pm = fm + ((wgid % nig) % gsz); u.pn = (wgid % nig) / gsz; u.cn = u.pn; return true;
    }
    __device__ __forceinline__ void a_ready(const Unit&) const {}
    __device__ __forceinline__ void done(const Unit&) const {}
};
__device__ __forceinline__ unsigned cvt_pk_bf16(float lo, float hi) { unsigned r; asm volatile("v_cvt_pk_bf16_f32 %0, %1, %2" : "=v"(r) : "v"(lo), "v"(hi)); return r; }
typedef float f32x2 __attribute__((ext_vector_type(2)));
template <class Epi, class Sched, bool ALIGN_EPI = false, bool SP2 = false>
__device__ __forceinline__ void gemm_phase(PG8_LAS unsigned char* lds, const Gemm g, const Sched& S, const Epi& E) {
    const int tid = mk_tid(), wid = __builtin_amdgcn_readfirstlane(tid >> 6), lane = tid & 63, wr = wid >> 2, wc = wid & 3, fr = lane & 15, fq = lane >> 4;
    const int K = g.K, nt = K / BK;
    unsigned voffA[2], voffB[2];
#pragma unroll
    for (int i = 0; i < 2; ++i) { int R, C; stage_rc(tid * 16 + i * 8192, R, C); const int Rb = Epi::PERM ? ((R & ~31) + perm32(R & 31)) : R;
        voffA[i] = (unsigned)(R * K + C) * 2u; voffB[i] = (unsigned)(Rb * K + C) * 2u; }
    const size_t kstep = (size_t)(BK * 2);
    const size_t hstep = (size_t)HALF * K * 2;
    const size_t tstep = 2 * hstep;
    const unsigned ldsw = (unsigned)wid * 1024u;
    const int aoff = lds_byte(wr * 64 + fr, fq * 8), boff = lds_byte(wc * 32 + fr, fq * 8);
#define PG8_SA(b, h) (((b) * 2 + (h)) * HTB)
#define PG8_SB(b, h) ((4 + (b) * 2 + (h)) * HTB)
#define PG8_STAGE(bufoff, gbase, voff) do { _Pragma("unroll") for (int _i = 0; _i < 2; ++_i) \
        __builtin_amdgcn_global_load_lds((const unsigned*)((const char*)(gbase) + (voff)[_i]), (PG8_LAS unsigned*)(lds + (bufoff) + ldsw + _i * 8192), 16, 0, 0); } while (0)
#define PG8_LDA(dst, b, h) do { _Pragma("unroll") for (int m = 0; m < 4; ++m) _Pragma("unroll") for (int k = 0; k < 2; ++k) dst[m][k] = *(const PG8_LAS bf16x8*)(lds + PG8_SA(b, h) + aoff + m * 2048 + k * 1024); } while (0)
#define PG8_LDB(dst, b, h) do { _Pragma("unroll") for (int n = 0; n < 2; ++n) _Pragma("unroll") for (int k = 0; k < 2; ++k) dst[n][k] = *(const PG8_LAS bf16x8*)(lds + PG8_SB(b, h) + boff + n * 2048 + k * 1024); } while (0)
#define PG8_MMA(ai, bj, At, Bt) do { __builtin_amdgcn_s_setprio(1); _Pragma("unroll") for (int m = 0; m < 4; ++m) _Pragma("unroll") for (int n = 0; n < 2; ++n) _Pragma("unroll") for (int k = 0; k < 2; ++k) \
        acc[ai][bj][m][n] = __builtin_amdgcn_mfma_f32_16x16x32_bf16(Bt[n][k], At[m][k], acc[ai][bj][m][n], 0, 0, 0); __builtin_amdgcn_s_setprio(0); } while (0)
#define PG8_WAIT_V(n) asm volatile("s_waitcnt vmcnt(" #n ")" ::: "memory")
#define PG8_WAIT_L(n) asm volatile("s_waitcnt lgkmcnt(" #n ")" ::: "memory")
#define PG8_BAR __builtin_amdgcn_s_barrier()
#define PG8_SCHED __builtin_amdgcn_sched_barrier(0)
    Unit cur, nxt; int ui = 0;
    if (!S.next(0, cur)) return;
    f32x4 acc[2][2][4][2];
#pragma unroll
    for (int a = 0; a < 2; ++a)
#pragma unroll
        for (int b = 0; b < 2; ++b)
#pragma unroll
            for (int m = 0; m < 4; ++m)
#pragma unroll
                for (int n = 0; n < 2; ++n) acc[a][b][m][n] = (f32x4){0.f, 0.f, 0.f, 0.f};
    bf16x8 At[4][2], B0[2][2], B1[2][2];
    const char* cA = (const char*)g.A + (size_t)cur.pm * tstep; const char* cB = (const char*)g.Bt + (size_t)cur.pn * tstep;
    S.a_ready(cur);
    if constexpr (SP2) {
        PG8_STAGE(PG8_SB(0, 0), cB, voffB); PG8_STAGE(PG8_SB(0, 1), cB + hstep, voffB); PG8_STAGE(PG8_SA(0, 0), cA, voffA); PG8_STAGE(PG8_SA(0, 1), cA + hstep, voffA);
        if (wr == 1) PG8_BAR;
        PG8_WAIT_V(2); PG8_BAR;
        PG8_STAGE(PG8_SB(1, 0), cB + kstep, voffB); PG8_STAGE(PG8_SA(1, 0), cA + kstep, voffA); PG8_STAGE(PG8_SB(1, 1), cB + hstep + kstep, voffB);
        PG8_WAIT_V(6); PG8_BAR;
    } else {
        PG8_STAGE(PG8_SB(0, 0), cB, voffB); PG8_STAGE(PG8_SA(0, 0), cA, voffA); PG8_STAGE(PG8_SB(0, 1), cB + hstep, voffB); PG8_STAGE(PG8_SA(0, 1), cA + hstep, voffA);
        if (wr == 1) PG8_BAR;
        PG8_WAIT_V(4); PG8_BAR;
        PG8_STAGE(PG8_SB(1, 0), cB + kstep, voffB); PG8_STAGE(PG8_SA(1, 0), cA + kstep, voffA); PG8_STAGE(PG8_SB(1, 1), cB + hstep + kstep, voffB);
        PG8_WAIT_V(6); PG8_BAR;
    }
    for (;;) {
        const bool has_next = S.next(ui + 1, nxt);
        const char* nA = has_next ? (const char*)g.A + (size_t)nxt.pm * tstep : cA; const char* nB = has_next ? (const char*)g.Bt + (size_t)nxt.pn * tstep : cB;
        for (int t = 0; t < nt; t += 2) {
            const bool last = (t == nt - 2);
            const char* a1 = cA + (size_t)(t + 1) * kstep;
            const char* a2 = last ? nA : cA + (size_t)(t + 2) * kstep; const char* b2 = last ? nB : cB + (size_t)(t + 2) * kstep;
            const char* a3 = a2 + kstep; const char* b3 = b2 + kstep;
            if (last && has_next) S.a_ready(nxt);
            if constexpr (SP2) {
            PG8_LDB(B0, 0, 0); PG8_LDB(B1, 0, 1); PG8_SCHED; PG8_LDA(At, 0, 0); PG8_STAGE(PG8_SA(1, 1), a1 + hstep, voffA);
            PG8_WAIT_V(8); PG8_WAIT_L(0); PG8_BAR; PG8_MMA(0, 0, At, B0); PG8_MMA(0, 1, At, B1); PG8_BAR; PG8_SCHED;
            PG8_LDA(At, 0, 1); PG8_STAGE(PG8_SB(0, 0), b2, voffB); PG8_STAGE(PG8_SB(0, 1), b2 + hstep, voffB); PG8_STAGE(PG8_SA(0, 0), a2, voffA);
            PG8_WAIT_V(8); PG8_WAIT_L(0); PG8_BAR; PG8_MMA(1, 0, At, B0); PG8_MMA(1, 1, At, B1); PG8_BAR; PG8_SCHED;
            PG8_LDB(B0, 1, 0); PG8_LDB(B1, 1, 1); PG8_SCHED; PG8_LDA(At, 1, 0); PG8_STAGE(PG8_SA(0, 1), a2 + hstep, voffA);
            PG8_WAIT_V(8); PG8_WAIT_L(0); PG8_BAR; PG8_MMA(0, 0, At, B0); PG8_MMA(0, 1, At, B1); PG8_BAR; PG8_SCHED;
            PG8_LDA(At, 1, 1); PG8_STAGE(PG8_SB(1, 0), b3, voffB); PG8_STAGE(PG8_SB(1, 1), b3 + hstep, voffB); PG8_STAGE(PG8_SA(1, 0), a3, voffA);
            PG8_WAIT_V(8); PG8_WAIT_L(0); PG8_BAR; PG8_MMA(1, 0, At, B0); PG8_MMA(1, 1, At, B1); PG8_BAR; PG8_SCHED;
            } else {
            PG8_LDB(B0, 0, 0); PG8_SCHED; PG8_LDA(At, 0, 0); PG8_STAGE(PG8_SA(1, 1), a1 + hstep, voffA);
            PG8_WAIT_L(8); PG8_BAR; PG8_WAIT_L(0); PG8_MMA(0, 0, At, B0); PG8_BAR; PG8_SCHED;
            PG8_LDB(B1, 0, 1); PG8_STAGE(PG8_SB(0, 0), b2, voffB);
            PG8_BAR; PG8_WAIT_L(0); PG8_MMA(0, 1, At, B1); PG8_BAR;
            PG8_LDA(At, 0, 1); PG8_STAGE(PG8_SA(0, 0), a2, voffA);
            PG8_BAR; PG8_WAIT_L(0); PG8_MMA(1, 0, At, B0); PG8_BAR; PG8_SCHED;
            PG8_STAGE(PG8_SB(0, 1), b2 + hstep, voffB);
            PG8_WAIT_V(6); PG8_BAR; PG8_MMA(1, 1, At, B1); PG8_BAR;
            PG8_LDB(B0, 1, 0); PG8_SCHED; PG8_LDA(At, 1, 0); PG8_STAGE(PG8_SA(0, 1), a2 + hstep, voffA);
            PG8_WAIT_L(8); PG8_BAR; PG8_WAIT_L(0); PG8_MMA(0, 0, At, B0); PG8_BAR; PG8_SCHED;
            PG8_LDB(B1, 1, 1); PG8_STAGE(PG8_SB(1, 0), b3, voffB);
            PG8_BAR; PG8_WAIT_L(0); PG8_MMA(0, 1, At, B1); PG8_BAR;
            PG8_LDA(At, 1, 1); PG8_STAGE(PG8_SA(1, 0), a3, voffA);
            PG8_BAR; PG8_WAIT_L(0); PG8_MMA(1, 0, At, B0); PG8_BAR; PG8_SCHED;
            PG8_STAGE(PG8_SB(1, 1), b3 + hstep, voffB);
            PG8_WAIT_V(6); PG8_BAR; PG8_MMA(1, 1, At, B1); PG8_BAR;
            }
        }
        if constexpr (ALIGN_EPI) { if (wr == 0) PG8_BAR; }
        if constexpr (!Epi::AFTER_DRAIN) { E(acc, cur, wr, wc, fr, fq); S.done(cur); }
        if (!has_next) break;
#pragma unroll
        for (int a = 0; a < 2; ++a)
#pragma unroll
            for (int b = 0; b < 2; ++b)
#pragma unroll
                for (int m = 0; m < 4; ++m)
#pragma unroll
                    for (int n = 0; n < 2; ++n) acc[a][b][m][n] = (f32x4){0.f, 0.f, 0.f, 0.f};
        cur = nxt; cA = nA; cB = nB; ++ui;
        if constexpr (ALIGN_EPI) { if (wr == 1) PG8_BAR; }
    }
    PG8_WAIT_V(0);
    if constexpr (!ALIGN_EPI) { if (wr == 0) PG8_BAR; }
    PG8_BAR;
    if constexpr (Epi::AFTER_DRAIN) { E.fused(acc, cur, wr, wc, fr, fq, lds, wid, lane); S.done(cur); }
#undef PG8_SA
#undef PG8_SB
#undef PG8_STAGE
#undef PG8_LDA
#undef PG8_LDB
#undef PG8_MMA
#undef PG8_WAIT_V
#undef PG8_WAIT_L
#undef PG8_BAR
#undef PG8_SCHED
}
}

namespace pg8 {
__device__ __forceinline__ float fast_sigmoid(float x) { return __builtin_amdgcn_rcpf(1.0f + __builtin_amdgcn_exp2f(-1.4426950408889634f * x)); }
struct EpiStore16 {
    static constexpr bool PERM = true, AFTER_DRAIN = false;
    bf16_t* O; int ldc;
    __device__ __forceinline__ void operator()(const f32x4 (&acc)[2][2][4][2], const Unit& u, int wr, int wc, int fr, int fq) const {
        const int row0 = u.pm * BM + wr * 64 + fr, col0 = u.cn * BM + wc * 32 + 8 * fq;
#pragma unroll
        for (int ai = 0; ai < 2; ++ai)
#pragma unroll
            for (int m = 0; m < 4; ++m) { bf16_t* rowp = O + (size_t)(row0 + ai * HALF + m * 16) * ldc + col0;
#pragma unroll
                for (int bj = 0; bj < 2; ++bj) { const f32x4 v0 = acc[ai][bj][m][0], v1 = acc[ai][bj][m][1];
                    u32x4 w; w.x = cvt_pk_bf16(v0[0], v0[1]); w.y = cvt_pk_bf16(v0[2], v0[3]); w.z = cvt_pk_bf16(v1[0], v1[1]); w.w = cvt_pk_bf16(v1[2], v1[3]);
                    *(u32x4*)(rowp + bj * HALF) = w; } }
    }
};
struct EpiAddH {
    static constexpr bool PERM = false, AFTER_DRAIN = false;
    float* H; int ldc;
    __device__ __forceinline__ void operator()(const f32x4 (&acc)[2][2][4][2], const Unit& u, int wr, int wc, int fr, int fq) const {
        const int row0 = u.pm * BM + wr * 64 + fr, col0 = u.cn * BM + wc * 32 + 4 * fq;
#pragma unroll
        for (int ai = 0; ai < 2; ++ai)
#pragma unroll
            for (int m = 0; m < 4; ++m) { float* rowp = H + (size_t)(row0 + ai * HALF + m * 16) * ldc + col0;
                f32x4 h[2][2];
#pragma unroll
                for (int bj = 0; bj < 2; ++bj)
#pragma unroll
                    for (int n = 0; n < 2; ++n) h[bj][n] = *(const f32x4*)(rowp + bj * HALF + n * 16);
#pragma unroll
                for (int bj = 0; bj < 2; ++bj)
#pragma unroll
                    for (int n = 0; n < 2; ++n) *(f32x4*)(rowp + bj * HALF + n * 16) = h[bj][n] + acc[ai][bj][m][n];
                asm volatile("" ::: "memory"); }
    }
};
struct EpiSwiglu {
    static constexpr bool PERM = true, AFTER_DRAIN = false;
    bf16_t* O; int ldc;
    __device__ __forceinline__ void operator()(const f32x4 (&acc)[2][2][4][2], const Unit& u, int wr, int wc, int fr, int fq) const {
        const int row0 = u.pm * BM + wr * 64 + fr, col0 = u.cn * HALF + wc * 32 + 8 * fq;
#pragma unroll
        for (int ai = 0; ai < 2; ++ai)
#pragma unroll
            for (int m = 0; m < 4; ++m) { bf16_t* rowp = O + (size_t)(row0 + ai * HALF + m * 16) * ldc + col0; float o[8];
#pragma unroll
                for (int n = 0; n < 2; ++n)
#pragma unroll
                    for (int j = 0; j < 4; ++j) { const float g = acc[ai][0][m][n][j], up = acc[ai][1][m][n][j]; o[n * 4 + j] = g * fast_sigmoid(g) * up; }
                u32x4 w; w.x = cvt_pk_bf16(o[0], o[1]); w.y = cvt_pk_bf16(o[2], o[3]); w.z = cvt_pk_bf16(o[4], o[5]); w.w = cvt_pk_bf16(o[6], o[7]);
                *(u32x4*)rowp = w; }
    }
};
struct EpiPleF {
    static constexpr bool PERM = false, AFTER_DRAIN = false;
    float* H; const bf16_t* PJ; int ldc;
    __device__ __forceinline__ void operator()(const f32x4 (&acc)[2][2][4][2], const Unit& u, int wr, int wc, int fr, int fq) const {
        typedef unsigned u32x2v __attribute__((ext_vector_type(2)));
        const int row0 = u.pm * BM + wr * 64 + fr, col0 = u.cn * BM + wc * 32 + 4 * fq;
#pragma unroll
        for (int ai = 0; ai < 2; ++ai)
#pragma unroll
            for (int m = 0; m < 4; ++m) { const size_t off = (size_t)(row0 + ai * HALF + m * 16) * ldc + col0;
                f32x4 h[2][2]; u32x2v pj[2][2];
#pragma unroll
                for (int bj = 0; bj < 2; ++bj)
#pragma unroll
                    for (int n = 0; n < 2; ++n) { h[bj][n] = *(const f32x4*)(H + off + bj * HALF + n * 16); pj[bj][n] = *(const u32x2v*)(PJ + off + bj * HALF + n * 16); }
#pragma unroll
                for (int bj = 0; bj < 2; ++bj)
#pragma unroll
                    for (int n = 0; n < 2; ++n) { const f32x4 a = acc[ai][bj][m][n]; f32x4 o;
                        o[0] = h[bj][n][0] + __uint_as_float(pj[bj][n].x << 16) * fast_sigmoid(a[0]); o[1] = h[bj][n][1] + __uint_as_float(pj[bj][n].x & 0xffff0000u) * fast_sigmoid(a[1]);
                        o[2] = h[bj][n][2] + __uint_as_float(pj[bj][n].y << 16) * fast_sigmoid(a[2]); o[3] = h[bj][n][3] + __uint_as_float(pj[bj][n].y & 0xffff0000u) * fast_sigmoid(a[3]);
                        *(f32x4*)(H + off + bj * HALF + n * 16) = o; }
                asm volatile("" ::: "memory"); }
    }
};
struct ExpertOrder : StaticOrder {
    const int* tile_e;
    __device__ __forceinline__ bool next(int i, Unit& u) const { if (!StaticOrder::next(i, u)) return false; if (tile_e) u.pn += tile_e[u.pm] * nN; return true; }
};
}

using namespace mdl;
#define LAS __attribute__((address_space(3)))
constexpr int NWAVES = 8, NTHR = NWAVES * 64;
constexpr int RING_BYTES = 131072, LDSCTL_OFF = RING_BYTES, MISC_OFF = LDSCTL_OFF + 320, LDS_BYTES = 147456;
constexpr int CW_BAR = 4096;
#define XB_TMO      128
#define XB_XCNT(j)  (256  + 64 * (j))
#define XB_XSUB(j)  (1280 + 64 * (j))
#define XB_XGEN(j)  (2304 + 64 * (j))
#define XB_TOP      3328
#define XB_TOPGEN   3392
#define XCD_BAR_WORDS 3456
#define XB_SPIN_CAP (1u << 18)

__device__ __forceinline__ unsigned xb_ld(unsigned* p)              { return __hip_atomic_load(p, __ATOMIC_RELAXED, __HIP_MEMORY_SCOPE_AGENT); }
__device__ __forceinline__ unsigned xb_add(unsigned* p, unsigned v) { return __hip_atomic_fetch_add(p, v, __ATOMIC_RELAXED, __HIP_MEMORY_SCOPE_AGENT); }
__device__ __forceinline__ unsigned xb_xcc_id() { return (unsigned)__builtin_amdgcn_s_getreg((3 << 11) | 20) & 0xFu; }
#define XB_SPIN(cond, bar) do { unsigned _sp = 0; while (cond) { __builtin_amdgcn_s_sleep(1); \
    if ((++_sp & 255u) == 0u) { if (xb_ld(&(bar)[XB_TMO])) break; if (_sp > XB_SPIN_CAP) { atomicAdd(&(bar)[XB_TMO], 1u); break; } } } } while (0)

struct XcdBarrier {
    unsigned* bar; unsigned x;
    volatile LAS unsigned* st;
};

__device__ __forceinline__ XcdBarrier xcd_barrier_post(unsigned* bar, volatile LAS unsigned* st) {
    XcdBarrier b; b.bar = bar; b.x = xb_xcc_id(); b.st = st;
    if (threadIdx.x == 0) (void)xb_add(&bar[XB_XCNT(b.x)], 1u);
    return b;
}
__device__ __forceinline__ void xcd_barrier_complete(unsigned* bar, unsigned x, unsigned& nloc, unsigned& nx) {
    const unsigned G = gridDim.x * gridDim.y * gridDim.z;
    unsigned sum, cnt, mine, sp = 0u;
    for (;;) {
        sum = 0u; cnt = 0u; mine = 0u;
#pragma unroll
        for (unsigned j = 0; j < 16; ++j) { const unsigned c = xb_ld(&bar[XB_XCNT(j)]); sum += c; cnt += (c > 0u) ? 1u : 0u; mine = (j == x) ? c : mine; }
        if (sum == G) break;
        __builtin_amdgcn_s_sleep(1);
        if ((++sp & 255u) == 0u) { if (xb_ld(&bar[XB_TMO])) break; if (sp > XB_SPIN_CAP) { atomicAdd(&bar[XB_TMO], 1u); break; } }
    }
    nloc = mine > 0u ? mine : 1u; nx = cnt > 0u ? cnt : 1u;
}

__device__ __forceinline__ void xcd_barrier(const XcdBarrier& b) {
    asm volatile("s_waitcnt vmcnt(0)" ::: "memory");
    __syncthreads();
    if (threadIdx.x == 0) {
        unsigned* bar = b.bar;
        __builtin_amdgcn_s_waitcnt(0);
        unsigned nloc = b.st[0], nx = b.st[1];
        if (nloc == 0u) { xcd_barrier_complete(bar, b.x, nloc, nx); b.st[0] = nloc; b.st[1] = nx; }
        const unsigned old = xb_add(&bar[XB_XSUB(b.x)], 1u);
        const unsigned gen = old / nloc;
        if (old + 1u == (gen + 1u) * nloc) {
            __builtin_amdgcn_fence(__ATOMIC_RELEASE, "agent");
            asm volatile("s_waitcnt vmcnt(0)" ::: "memory");
            const unsigned og = xb_add(&bar[XB_TOP], 1u);
            const unsigned tg = og / nx;
            if (og + 1u == (tg + 1u) * nx) xb_add(&bar[XB_TOPGEN], 1u);
            else XB_SPIN(xb_ld(&bar[XB_TOPGEN]) == tg, bar);
            __builtin_amdgcn_fence(__ATOMIC_ACQUIRE, "agent");
            xb_add(&bar[XB_XGEN(b.x)], 1u);
            asm volatile("s_waitcnt vmcnt(0)" ::: "memory");
        } else {
            XB_SPIN(xb_ld(&bar[XB_XGEN(b.x)]) == gen, bar);
            __builtin_amdgcn_fence(__ATOMIC_ACQUIRE, "agent");
            asm volatile("s_waitcnt vmcnt(0)" ::: "memory");
        }
    }
    __syncthreads();
}

struct Args { MP p; long flags; };
__global__ void __launch_bounds__(NTHR, 2) mk_fwd(Args a) {
    extern __shared__ __attribute__((aligned(16))) unsigned char lds[];
    LAS unsigned char* const L3 = (LAS unsigned char*)lds;
    volatile LAS unsigned* MISC = (volatile LAS unsigned*)(L3 + MISC_OFF);
    const MP& p = a.p;
    const int tid = threadIdx.x;
    for (int u = tid; u < (LDS_BYTES - LDSCTL_OFF) / 4; u += NTHR) ((LAS unsigned*)(L3 + LDSCTL_OFF))[u] = 0u;
    __syncthreads();
    const XcdBarrier bar = xcd_barrier_post(p.ctl + CW_BAR, MISC + 8);
    const int G = gridDim.x, bx = blockIdx.x;
    const long gs = (long)G * NTHR;
#define g0 ((long)bx * NTHR + mk_tid())
#define GRID_BAR() xcd_barrier(bar)
    nv_prologue(p, g0, gs); GRID_BAR();
    for (int L = 0; L < DEPTH; ++L) {
        const int j = L >> 1; const bool moe = (L & 1) != 0;
        nv_norm(p, p.attn_g + L * D, g0, gs); GRID_BAR();
        {
            pg8::Gemm g{p.HB, p.WIN + (size_t)L * NU * D, (int)p.T, NU, D}; pg8::StaticOrder S; S.init((int)p.T, NU, G, bx);
            pg8::EpiStore16 E{p.U, NU}; pg8::gemm_phase<pg8::EpiStore16, pg8::StaticOrder, true, true>(L3, g, S, E);
            pg8::Gemm g2{p.PB16 + (size_t)L * p.T * PLE, p.WPP + (size_t)L * D * PLE, (int)p.T, D, PLE}; pg8::StaticOrder S2; S2.init((int)p.T, D, G, bx);
            pg8::EpiStore16 E2{p.PJ, D}; pg8::gemm_phase<pg8::EpiStore16, pg8::StaticOrder, true, true>(L3, g2, S2, E2);
        }
        GRID_BAR();
        nv_mixA1(p, L, g0, gs); GRID_BAR();
        nv_mixA2(p, L, g0, gs); nv_mixA3a(p, g0, gs); GRID_BAR();
        nv_mixA3b(p, g0, gs); GRID_BAR();
        nv_mixB1(p, g0, gs); nv_attn(p, g0, gs); GRID_BAR();
        nv_mixC1(p, L, g0, gs); GRID_BAR();
        nv_mixC2(p, L, g0, gs); GRID_BAR();
        {
            pg8::Gemm g{p.YC, p.WOUT + (size_t)L * D * D, (int)p.T, D, D}; pg8::StaticOrder S; S.init((int)p.T, D, G, bx);
            pg8::EpiAddH E{p.H, D}; pg8::gemm_phase<pg8::EpiAddH, pg8::StaticOrder, true, true>(L3, g, S, E);
        }
        GRID_BAR();
        nv_norm(p, p.ffn_g + L * D, g0, gs); if (moe) nv_router(p, L, g0, gs); GRID_BAR();
        if (moe) { nv_moeplan(p, L, g0, gs); GRID_BAR(); }
        {
            const int rows = moe ? moe_start_of(p, j, NE) : (int)p.T;
            pg8::Gemm g{moe ? p.XB : p.HB, moe ? p.MWGU + (size_t)j * NE * NGU * D : p.DWGU + (size_t)j * NGU * D, rows, NGU, D};
            pg8::ExpertOrder S; S.init(rows, NGU, G, bx); S.tile_e = moe ? p.TILE_E : nullptr;
            pg8::EpiSwiglu E{p.ACT, DFF}; pg8::gemm_phase<pg8::EpiSwiglu, pg8::ExpertOrder, true, true>(L3, g, S, E);
            GRID_BAR();
            pg8::Gemm gd{p.ACT, moe ? p.MWD + (size_t)j * NE * D * DFF : p.DWD + (size_t)j * D * DFF, rows, D, DFF};
            pg8::ExpertOrder Sd; Sd.init(rows, D, G, bx); Sd.tile_e = moe ? p.TILE_E : nullptr;
            if (moe) { pg8::EpiStore16 Ed{p.YS, D}; pg8::gemm_phase<pg8::EpiStore16, pg8::ExpertOrder, true, true>(L3, gd, Sd, Ed); }
            else { pg8::EpiAddH Ed{p.H, D}; pg8::gemm_phase<pg8::EpiAddH, pg8::ExpertOrder, true, true>(L3, gd, Sd, Ed); }
        }
        GRID_BAR();
        nv_norm3(p, L, g0, gs); GRID_BAR();
        {
            pg8::Gemm g{p.HB, p.WPG + (size_t)L * D * D, (int)p.T, D, D}; pg8::StaticOrder S; S.init((int)p.T, D, G, bx);
            pg8::EpiPleF E{p.H, p.PJ, D}; pg8::gemm_phase<pg8::EpiPleF, pg8::StaticOrder, true, true>(L3, g, S, E);
        }
        GRID_BAR();
    }
    nv_final(p, g0, gs);
}
static void fill_params(MP& p, void* const* d_in, void* d_out, void* d_ws) {
    p.x = (const float*)d_in[0]; p.p = (const float*)d_in[1]; p.pos = (const int*)d_in[2];
    const float** w = &p.attn_g; for (int i = 3; i < 32; ++i) w[i - 3] = (const float*)d_in[i];
    p.out = (float*)d_out; p.B = 8; p.S = 2048; p.T = 16384; p.NSLOT = 2 * 16384 + 8 * 256;
    carve(p, (unsigned char*)d_ws);
}
extern "C" void kernel_launch(void* const* d_in, const int* in_sizes, int n_in, void* d_out, int out_size, void* d_ws, size_t ws_size, hipStream_t stream) {
    static int grid = 0;
    if (grid == 0) {
        MP q{}; q.T = 16384; q.NSLOT = 2 * 16384 + 8 * 256; const size_t need = carve(q, nullptr);
        if (n_in != 32 || ws_size < need) { fprintf(stderr, "kernel_launch: need %zu bytes of ws, have %zu (n_in %d)\n", need, ws_size, n_in); grid = -1; return; }
        int dev = 0, cus = 0, per_cu = 0;
        if (hipGetDevice(&dev) != hipSuccess || hipDeviceGetAttribute(&cus, hipDeviceAttributeMultiprocessorCount, dev) != hipSuccess) { grid = -1; return; }
        if (hipFuncSetAttribute((const void*)mk_fwd, hipFuncAttributeMaxDynamicSharedMemorySize, LDS_BYTES) != hipSuccess) { fprintf(stderr, "kernel_launch: hipFuncSetAttribute failed\n"); grid = -1; return; }
        if (hipOccupancyMaxActiveBlocksPerMultiprocessor(&per_cu, (const void*)mk_fwd, NTHR, LDS_BYTES) != hipSuccess || per_cu < 1) { fprintf(stderr, "kernel_launch: occupancy query says %d\n", per_cu); }
        (void)hipGetLastError();
        grid = cus;
    }
    if (grid < 0) return;
    Args a{}; fill_params(a.p, d_in, d_out, d_ws); a.flags = 0;
    if (hipMemsetAsync(a.p.ctl, 0, CTL_WORDS * 4, stream) != hipSuccess) return;
    hipLaunchKernelGGL(mk_fwd, dim3(grid), dim3(NTHR), LDS_BYTES, stream, a);
}
```

```cpp
#include <hip/hip_runtime.h>
#include <cstdio>
#include <cstdint>
__device__ __forceinline__ int mk_tid() { int t = threadIdx.x; asm volatile("" : "+v"(t)); return t; }

#include <cstring>
#include <cmath>
#include <cstdint>
#ifdef __HIPCC__
#define HD __host__ __device__ __forceinline__
#else
#define HD inline
#endif
typedef unsigned short bf16;
namespace mdl {
constexpr int D = 1024, DEPTH = 4, NU = 2560, NUO = 2472, DFF = 3584, NGU = 7168, NE = 8, PLE = 256;
constexpr int CK = 31, SCONV = 4, CHUNK = 128, NH = 8, HP = 64, NS = 128;
constexpr float RMS_EPS = 1e-6f, LN_EPS = 1e-5f;
constexpr float QSCALE = 0.10206207261596577f * 1.4426950408889634f;
constexpr int U_Z = 512, U_XBC = 1024, U_CQ = 2048, U_CKV = 2304, U_KR = 2432, U_DT = 2464;

HD float bf2f(bf16 v) { unsigned u = (unsigned)v << 16; float f; memcpy(&f, &u, 4); return f; }
HD bf16 f2bf(float f) { unsigned u; memcpy(&u, &f, 4); u += 0x7fffu + ((u >> 16) & 1u); return (bf16)(u >> 16); }
HD float sigmoidf_(float x) { return 1.0f / (1.0f + expf(-x)); }
HD float siluf_(float x) { return x / (1.0f + expf(-x)); }
HD float softplusf_(float x) { return x > 20.f ? x : log1pf(expf(x)); }
HD int ucol_src(int n) { return n < 2048 ? n : (n < U_DT ? n + 8 : (n < NUO ? n - U_DT + 2048 : -1)); }

struct MP {
    const float *x, *p; const int* pos;
    const float *attn_g, *w_in, *cdw_w, *cdw_b, *cln_g, *cln_b, *sconv_w, *sconv_b, *dt_bias, *a_log, *dskip, *snorm_g, *qn_g, *w_uq, *kvn_g, *w_ukv,
        *w_out, *ffn_g, *dwg, *dwu, *dwd, *router, *mwg, *mwu, *mwd, *ple_g, *ple_wg, *ple_wp, *fin_g;
    float* out;
    long B, S, T, NSLOT;
    unsigned* ctl;
    bf16 *WIN, *WUQ, *WUKV, *WOUT, *DWGU, *DWD, *MWGU, *MWD, *WPG, *WPP;
    float *H, *CS, *DT, *ACS, *ST, *CB, *YPRE, *TOPG;
    bf16 *HB, *U, *YC, *Q, *KK, *V, *XS, *BM, *CM, *YD, *PV, *PB16, *PJ, *ACT, *XB, *YS;
    int *TOPE, *POS, *TOKSLOT, *TILE_E;
};
constexpr int CTL_WORDS = 65536;
HD unsigned* cnt_ptr(const MP& p, int j) { return p.ctl + 1024 + j * 64; }

inline size_t carve(MP& p, unsigned char* ws) {
    size_t o = 0; const size_t T = p.T, NSL = p.NSLOT;
    auto take = [&](size_t bytes) { size_t r = o; o += (bytes + 255) & ~(size_t)255; return ws + r; };
    p.ctl = (unsigned*)take(CTL_WORDS * 4);
    p.WIN = (bf16*)take((size_t)DEPTH * NU * D * 2); p.WUQ = (bf16*)take((size_t)DEPTH * 512 * 256 * 2); p.WUKV = (bf16*)take((size_t)DEPTH * 512 * 128 * 2);
    p.WOUT = (bf16*)take((size_t)DEPTH * D * D * 2); p.DWGU = (bf16*)take((size_t)2 * NGU * D * 2); p.DWD = (bf16*)take((size_t)2 * D * DFF * 2);
    p.MWGU = (bf16*)take((size_t)2 * NE * NGU * D * 2); p.MWD = (bf16*)take((size_t)2 * NE * D * DFF * 2);
    p.WPG = (bf16*)take((size_t)DEPTH * D * D * 2); p.WPP = (bf16*)take((size_t)DEPTH * D * PLE * 2);
    p.H = (float*)take(T * D * 4); p.HB = (bf16*)take(T * D * 2); p.CS = (float*)take(T * 32 * 4);
    p.PB16 = (bf16*)take((size_t)DEPTH * T * PLE * 2); p.PJ = (bf16*)take(T * D * 2);
    p.TOPE = (int*)take(T * 2 * 4); p.TOPG = (float*)take(T * 2 * 4); p.POS = (int*)take(T * 2 * 4); p.TOKSLOT = (int*)take(T * 2 * 4); p.TILE_E = (int*)take(1024 * 4);
    p.XB = (bf16*)take(NSL * D * 2); p.YS = p.XB;
    const size_t r1 = o;
    p.U = (bf16*)take(T * NU * 2); p.YC = (bf16*)take(T * D * 2); p.Q = (bf16*)take(T * 384 * 2); p.KK = (bf16*)take(T * 384 * 2); p.V = (bf16*)take(T * 256 * 2);
    p.XS = (bf16*)take(T * 512 * 2); p.BM = (bf16*)take(T * 256 * 2); p.CM = (bf16*)take(T * 256 * 2); p.YD = (bf16*)take(T * 512 * 2);
    p.DT = (float*)take(T * 8 * 4); p.ACS = (float*)take(T * 8 * 4); p.ST = (float*)take(T / CHUNK * NH * HP * NS * 4); p.PV = (bf16*)take(T / CHUNK * NH * HP * NS * 2);
    p.CB = (float*)take(T / CHUNK * 2 * CHUNK * CHUNK * 4); p.YPRE = (float*)take(T * 512 * 4);
    const size_t r1end = o; o = r1;
    p.ACT = (bf16*)take(NSL * DFF * 2);
    if (o < r1end) o = r1end;
    return o;
}

struct V8 { float v[8]; };
HD V8 ld8(const bf16* p) { V8 r; const uint4 u = *(const uint4*)p; const unsigned w[4] = {u.x, u.y, u.z, u.w};
    for (int i = 0; i < 4; ++i) { r.v[2 * i] = bf2f((bf16)(w[i] & 0xffff)); r.v[2 * i + 1] = bf2f((bf16)(w[i] >> 16)); } return r; }
HD float dot8(const V8& a, const V8& b) { float s = 0.f; for (int i = 0; i < 8; ++i) s += a.v[i] * b.v[i]; return s; }

template <class Epi> HD void gemm_nt(const bf16* A, long lda, const bf16* Bt, long ldb, long M, long N, long K, const Epi& epi, long g0, long gs) {
    const long ntn = N / 4, ntile = (M / 4) * ntn;
    for (long t = g0; t < ntile; t += gs) {
        const long m0 = (t / ntn) * 4, n0 = (t % ntn) * 4; float acc[4][4];
        for (int i = 0; i < 4; ++i) for (int j = 0; j < 4; ++j) acc[i][j] = 0.f;
        for (long k = 0; k < K; k += 8) { V8 a0 = ld8(A + (m0 + 0) * lda + k), a1 = ld8(A + (m0 + 1) * lda + k), a2 = ld8(A + (m0 + 2) * lda + k), a3 = ld8(A + (m0 + 3) * lda + k);
            V8 b0 = ld8(Bt + (n0 + 0) * ldb + k), b1 = ld8(Bt + (n0 + 1) * ldb + k), b2 = ld8(Bt + (n0 + 2) * ldb + k), b3 = ld8(Bt + (n0 + 3) * ldb + k);
            acc[0][0] += dot8(a0, b0); acc[0][1] += dot8(a0, b1); acc[0][2] += dot8(a0, b2); acc[0][3] += dot8(a0, b3);
            acc[1][0] += dot8(a1, b0); acc[1][1] += dot8(a1, b1); acc[1][2] += dot8(a1, b2); acc[1][3] += dot8(a1, b3);
            acc[2][0] += dot8(a2, b0); acc[2][1] += dot8(a2, b1); acc[2][2] += dot8(a2, b2); acc[2][3] += dot8(a2, b3);
            acc[3][0] += dot8(a3, b0); acc[3][1] += dot8(a3, b1); acc[3][2] += dot8(a3, b2); acc[3][3] += dot8(a3, b3); }
        epi(m0 + 0, n0 + 0, acc[0][0]); epi(m0 + 0, n0 + 1, acc[0][1]); epi(m0 + 0, n0 + 2, acc[0][2]); epi(m0 + 0, n0 + 3, acc[0][3]);
        epi(m0 + 1, n0 + 0, acc[1][0]); epi(m0 + 1, n0 + 1, acc[1][1]); epi(m0 + 1, n0 + 2, acc[1][2]); epi(m0 + 1, n0 + 3, acc[1][3]);
        epi(m0 + 2, n0 + 0, acc[2][0]); epi(m0 + 2, n0 + 1, acc[2][1]); epi(m0 + 2, n0 + 2, acc[2][2]); epi(m0 + 2, n0 + 3, acc[2][3]);
        epi(m0 + 3, n0 + 0, acc[3][0]); epi(m0 + 3, n0 + 1, acc[3][1]); epi(m0 + 3, n0 + 2, acc[3][2]); epi(m0 + 3, n0 + 3, acc[3][3]);
    }
}
struct EpiStoreBf { bf16* C; long ldc; HD void operator()(long m, long n, float v) const { C[m * ldc + n] = f2bf(v); } };
struct EpiAddF32 { float* C; long ldc; HD void operator()(long m, long n, float v) const { C[m * ldc + n] += v; } };
struct EpiPle { float* H; const bf16* PJ; HD void operator()(long m, long n, float v) const { H[m * D + n] += bf2f(PJ[m * D + n]) * sigmoidf_(v); } };

HD void tr_elem(const float* W, long K, long N, bf16* WT, long i) { const long n = i / K, k = i % K; WT[i] = f2bf(W[k * N + n]); }
HD void nv_prologue(const MP& p, long g0, long gs) {
    const long T = p.T;
    for (long i = g0; i < (long)DEPTH * NU * D; i += gs) { const long l = i / ((long)NU * D), r = i % ((long)NU * D), n = r / D, k = r % D; const int c = ucol_src((int)n);
        p.WIN[i] = c < 0 ? (bf16)0 : f2bf(p.w_in[(l * D + k) * NUO + c]); }
    for (long i = g0; i < (long)DEPTH * 512 * 256; i += gs) { const long l = i / (512 * 256), r = i % (512 * 256), n = r / 256, k = r % 256; p.WUQ[i] = n < 384 ? f2bf(p.w_uq[(l * 256 + k) * 384 + n]) : (bf16)0; }
    for (long i = g0; i < (long)DEPTH * 512 * 128; i += gs) { const long l = i / (512 * 128), r = i % (512 * 128), n = r / 128, k = r % 128; p.WUKV[i] = f2bf(p.w_ukv[(l * 128 + k) * 512 + n]); }
    for (long i = g0; i < (long)DEPTH * D * D; i += gs) { const long l = i / ((long)D * D); tr_elem(p.w_out + l * D * D, D, D, p.WOUT + l * D * D, i % ((long)D * D)); tr_elem(p.ple_wg + l * D * D, D, D, p.WPG + l * D * D, i % ((long)D * D)); }
    for (long i = g0; i < (long)DEPTH * D * PLE; i += gs) { const long l = i / ((long)D * PLE); tr_elem(p.ple_wp + l * PLE * D, PLE, D, p.WPP + l * D * PLE, i % ((long)D * PLE)); }
    for (long i = g0; i < (long)18 * NGU * D; i += gs) { const long mt = i / ((long)NGU * D), r = i % ((long)NGU * D), n = r / D, k = r % D, tl = n / 256, rr = n % 256, col = tl * 128 + (rr & 127);
        const float* src; bf16* dst;
        if (mt < 2) { src = (rr < 128 ? p.dwg : p.dwu) + mt * (long)D * DFF; dst = p.DWGU + mt * (long)NGU * D; } else { src = (rr < 128 ? p.mwg : p.mwu) + (mt - 2) * (long)D * DFF; dst = p.MWGU + (mt - 2) * (long)NGU * D; }
        dst[r] = f2bf(src[k * DFF + col]); }
    for (long i = g0; i < (long)18 * D * DFF; i += gs) { const long mt = i / ((long)D * DFF), r = i % ((long)D * DFF);
        if (mt < 2) tr_elem(p.dwd + mt * (long)DFF * D, DFF, D, p.DWD + mt * (long)D * DFF, r); else tr_elem(p.mwd + (mt - 2) * (long)DFF * D, DFF, D, p.MWD + (mt - 2) * (long)D * DFF, r); }
    for (long i = g0; i < T * D; i += gs) p.H[i] = p.x[i];
    for (long i = g0; i < (long)DEPTH * T * PLE; i += gs) p.PB16[i] = f2bf(p.p[i]);
    for (long i = g0; i < T * 16; i += gs) { const long t = i / 16; const int j = (int)(i % 16); const float inv = powf(10000.0f, -(float)(2 * j) / 32.0f), ang = (float)p.pos[t] * inv;
        p.CS[t * 32 + j] = cosf(ang); p.CS[t * 32 + 16 + j] = sinf(ang); }
}
HD void nv_norm(const MP& p, const float* g, long g0, long gs) {
    for (long t = g0; t < p.T; t += gs) { const float* h = p.H + t * D; float ss = 0.f; for (int i = 0; i < D; ++i) ss += h[i] * h[i];
        const float r = 1.0f / sqrtf(ss / D + RMS_EPS); for (int i = 0; i < D; ++i) p.HB[t * D + i] = f2bf(h[i] * r * g[i]); }
}
HD void nv_inproj(const MP& p, int L, long g0, long gs) {
    gemm_nt(p.HB, D, p.WIN + (long)L * NU * D, D, p.T, NU, D, EpiStoreBf{p.U, NU}, g0, gs);
    gemm_nt(p.PB16 + (long)L * p.T * PLE, PLE, p.WPP + (long)L * D * PLE, PLE, p.T, D, PLE, EpiStoreBf{p.PJ, D}, g0, gs);
}
HD float cm_conv(const MP& p, int L, long b, long s, int c) {
    float acc = p.cdw_b[L * 256 + c];
    for (int j = 0; j < CK; ++j) { const long sp = s - (CK - 1) + j; if (sp < 0) continue; const bf16* u = p.U + (b * p.S + sp) * NU;
        acc += p.cdw_w[(L * CK + j) * 256 + c] * (bf2f(u[c]) * sigmoidf_(bf2f(u[256 + c]))); }
    return acc;
}
HD void nv_mixA1(const MP& p, int L, long g0, long gs, int parts = 15) {
    const long T = p.T, S = p.S;
    if (parts & 1) for (long i = g0; i < T * 4; i += gs) { const long t = i / 4, b = t / S, s = t % S; const int gq = (int)(i % 4);
        float sm = 0.f, sq = 0.f; for (int c = 0; c < 64; ++c) { const float v = cm_conv(p, L, b, s, gq * 64 + c); sm += v; sq += v * v; }
        const float mu = sm / 64.f; float var = sq / 64.f - mu * mu; if (var < 0.f) var = 0.f; const float rs = 1.0f / sqrtf(var + LN_EPS);
        for (int c = 0; c < 64; ++c) { const int ch = gq * 64 + c; const float v = (cm_conv(p, L, b, s, ch) - mu) * rs * p.cln_g[L * 256 + ch] + p.cln_b[L * 256 + ch]; p.YC[t * D + ch] = f2bf(siluf_(v)); } }
    if (parts & 2) for (long i = g0; i < T * 1024; i += gs) { const long t = i / 1024, b = t / S, s = t % S; const int c = (int)(i % 1024);
        float acc = p.sconv_b[L * 1024 + c]; for (int j = 0; j < SCONV; ++j) { const long sp = s - (SCONV - 1) + j; if (sp < 0) continue; acc += p.sconv_w[(L * SCONV + j) * 1024 + c] * bf2f(p.U[(b * S + sp) * NU + U_XBC + c]); }
        const bf16 v = f2bf(siluf_(acc)); if (c < 512) p.XS[t * 512 + c] = v; else if (c < 768) p.BM[t * 256 + c - 512] = v; else p.CM[t * 256 + c - 768] = v; }
    if (parts & 2) for (long i = g0; i < T * 8; i += gs) { const long t = i / 8; const int h = (int)(i % 8); p.DT[i] = softplusf_(bf2f(p.U[t * NU + U_DT + h]) + p.dt_bias[L * 8 + h]); }
    if (parts & 8) for (long i = g0; i < T * 4 * 80; i += gs) { const long t = i / 320; const int h = (int)((i % 320) / 80), ii = (int)(i % 80); const bf16* cq = p.U + t * NU + U_CQ;
        float ss = 0.f; for (int k = 0; k < 256; ++k) { const float v = bf2f(cq[k]); ss += v * v; } const float r = 1.0f / sqrtf(ss / 256.f + RMS_EPS);
        const bf16* W = p.WUQ + (long)L * 512 * 256;
        if (ii < 64) { const int n = h * 96 + ii; float a = 0.f; for (int k = 0; k < 256; ++k) a += bf2f(f2bf(bf2f(cq[k]) * r * p.qn_g[L * 256 + k])) * bf2f(W[n * 256 + k]); p.Q[t * 384 + n] = f2bf(a * QSCALE); }
        else { const int j = ii - 64, n1 = h * 96 + 64 + j, n2 = n1 + 16; float a1 = 0.f, a2 = 0.f;
            for (int k = 0; k < 256; ++k) { const float xv = bf2f(f2bf(bf2f(cq[k]) * r * p.qn_g[L * 256 + k])); a1 += xv * bf2f(W[n1 * 256 + k]); a2 += xv * bf2f(W[n2 * 256 + k]); }
            const float c = p.CS[t * 32 + j], sn = p.CS[t * 32 + 16 + j]; p.Q[t * 384 + n1] = f2bf((a1 * c - a2 * sn) * QSCALE); p.Q[t * 384 + n2] = f2bf((a1 * sn + a2 * c) * QSCALE); } }
    if (parts & 8) for (long i = g0; i < T * 512; i += gs) { const long t = i / 512; const int n = (int)(i % 512); const bf16* ck = p.U + t * NU + U_CKV;
        float ss = 0.f; for (int k = 0; k < 128; ++k) { const float v = bf2f(ck[k]); ss += v * v; } const float r = 1.0f / sqrtf(ss / 128.f + RMS_EPS);
        const bf16* W = p.WUKV + (long)L * 512 * 128; float a = 0.f; for (int k = 0; k < 128; ++k) a += bf2f(f2bf(bf2f(ck[k]) * r * p.kvn_g[L * 128 + k])) * bf2f(W[n * 128 + k]);
        const int h = n / 128, d = n % 128; if (d < 64) p.KK[t * 384 + h * 96 + d] = f2bf(a); else p.V[t * 256 + h * 64 + d - 64] = f2bf(a); }
    if (parts & 8) for (long i = g0; i < T * 16; i += gs) { const long t = i / 16; const int j = (int)(i % 16); const float x1 = bf2f(p.U[t * NU + U_KR + j]), x2 = bf2f(p.U[t * NU + U_KR + 16 + j]), c = p.CS[t * 32 + j], sn = p.CS[t * 32 + 16 + j];
        const bf16 o1 = f2bf(x1 * c - x2 * sn), o2 = f2bf(x1 * sn + x2 * c); for (int h = 0; h < 4; ++h) { p.KK[t * 384 + h * 96 + 64 + j] = o1; p.KK[t * 384 + h * 96 + 80 + j] = o2; } }
}
HD void nv_mixA2(const MP& p, int L, long g0, long gs) {
    const long NC = p.T / CHUNK;
    for (long i = g0; i < NC * 8; i += gs) { const long c = i / 8; const int h = (int)(i % 8); const float a = -expf(p.a_log[L * 8 + h]); float cs = 0.f;
        for (int l = 0; l < CHUNK; ++l) { const long t = c * CHUNK + l; cs += p.DT[t * 8 + h] * a; p.ACS[t * 8 + h] = cs; } }
}
HD void nv_mixA3a(const MP& p, long g0, long gs) {
    const long NC = p.T / CHUNK;
    for (long i = g0; i < NC * 2 * CHUNK * CHUNK; i += gs) { const long u = i / (CHUNK * CHUNK), c = u / 2; const int g = (int)(u % 2), l = (int)((i / CHUNK) % CHUNK), s = (int)(i % CHUNK);
        const bf16* cm = p.CM + (c * CHUNK + l) * 256 + g * 128; const bf16* bm = p.BM + (c * CHUNK + s) * 256 + g * 128; float a = 0.f; for (int n = 0; n < 128; ++n) a += bf2f(cm[n]) * bf2f(bm[n]); p.CB[i] = a; }
}
HD void nv_mixA3b(const MP& p, long g0, long gs) {
    const long T = p.T, NC = T / CHUNK;
    for (long i = g0; i < T * 512; i += gs) { const long t = i / 512, c = t / CHUNK; const int ch = (int)(i % 512), h = ch / 64, g = h / 4, l = (int)(t % CHUNK);
        const float* cb = p.CB + ((c * 2 + g) * CHUNK + l) * CHUNK; const float al = p.ACS[t * 8 + h]; float a = 0.f;
        for (int s = 0; s <= l; ++s) { const long ts = c * CHUNK + s; a += cb[s] * expf(al - p.ACS[ts * 8 + h]) * p.DT[ts * 8 + h] * bf2f(p.XS[ts * 512 + ch]); }
        p.YD[i] = f2bf(a); }
    for (long i = g0; i < NC * 8 * 64 * 128; i += gs) { const long c = i / (8 * 64 * 128); const int h = (int)((i / (64 * 128)) % 8), pp = (int)((i / 128) % 64), n = (int)(i % 128), g = h / 4;
        const float alast = p.ACS[(c * CHUNK + CHUNK - 1) * 8 + h]; float a = 0.f;
        for (int l = 0; l < CHUNK; ++l) { const long t = c * CHUNK + l; a += bf2f(p.BM[t * 256 + g * 128 + n]) * expf(alast - p.ACS[t * 8 + h]) * p.DT[t * 8 + h] * bf2f(p.XS[t * 512 + h * 64 + pp]); }
        p.ST[i] = a; }
}
HD void nv_mixB1(const MP& p, long g0, long gs) {
    const long NCB = p.S / CHUNK;
    for (long i = g0; i < p.B * 8 * 64 * 128; i += gs) { const long b = i / (8 * 64 * 128); const long r = i % (8 * 64 * 128); const int h = (int)(r / (64 * 128)); float carry = 0.f;
        for (long cc = 0; cc < NCB; ++cc) { const long c = b * NCB + cc; const long idx = c * (8 * 64 * 128) + r; p.PV[idx] = f2bf(carry); carry = carry * expf(p.ACS[(c * CHUNK + CHUNK - 1) * 8 + h]) + p.ST[idx]; } }
}
HD void nv_attn(const MP& p, long g0, long gs) {
    const long T = p.T, S = p.S;
    for (long i = g0; i < T * 4; i += gs) { const long t = i / 4, b = t / S, s = t % S; const int h = (int)(i % 4);
        float q[96], o[64]; for (int d = 0; d < 96; ++d) q[d] = bf2f(p.Q[t * 384 + h * 96 + d]); for (int d = 0; d < 64; ++d) o[d] = 0.f; float m = -1e30f, l = 0.f;
        for (long k = 0; k <= s; ++k) { const long tk = b * S + k; const bf16* kk = p.KK + tk * 384 + h * 96; float sc = 0.f; for (int d = 0; d < 96; ++d) sc += q[d] * bf2f(kk[d]);
            const float mn = sc > m ? sc : m, f = exp2f(m - mn), pr = exp2f(sc - mn); l = l * f + pr; const bf16* vv = p.V + tk * 256 + h * 64; for (int d = 0; d < 64; ++d) o[d] = o[d] * f + pr * bf2f(vv[d]); m = mn; }
        for (int d = 0; d < 64; ++d) p.YC[t * D + 768 + h * 64 + d] = f2bf(o[d] / l); }
}
HD void nv_mixC1(const MP& p, int L, long g0, long gs) {
    const long T = p.T;
    for (long i = g0; i < T * 512; i += gs) { const long t = i / 512, c = t / CHUNK; const int ch = (int)(i % 512), h = ch / 64, pp = ch % 64, g = h / 4;
        const bf16* cm = p.CM + t * 256 + g * 128; const bf16* pv = p.PV + ((c * 8 + h) * 64 + pp) * 128; float a = 0.f; for (int n = 0; n < 128; ++n) a += bf2f(cm[n]) * bf2f(pv[n]);
        const float y = a * expf(p.ACS[t * 8 + h]) + bf2f(p.YD[i]) + p.dskip[L * 8 + h] * bf2f(p.XS[i]); p.YPRE[i] = y * siluf_(bf2f(p.U[t * NU + U_Z + ch])); }
}
HD void nv_mixC2(const MP& p, int L, long g0, long gs) {
    for (long i = g0; i < p.T * 2; i += gs) { const long t = i / 2; const int g = (int)(i % 2); const float* y = p.YPRE + t * 512 + g * 256; float ss = 0.f; for (int k = 0; k < 256; ++k) ss += y[k] * y[k];
        const float r = 1.0f / sqrtf(ss / 256.f + RMS_EPS); for (int k = 0; k < 256; ++k) p.YC[t * D + 256 + g * 256 + k] = f2bf(y[k] * r * p.snorm_g[L * 512 + g * 256 + k]); }
}
HD void nv_outproj(const MP& p, int L, long g0, long gs) { gemm_nt(p.YC, D, p.WOUT + (long)L * D * D, D, p.T, D, D, EpiAddF32{p.H, D}, g0, gs); }
HD void nv_router(const MP& p, int L, long g0, long gs) {
    const int j = L / 2; const float* R = p.router + (long)j * D * NE; const float* g = p.ffn_g + L * D; unsigned* cnt = cnt_ptr(p, j);
    for (long t = g0; t < p.T; t += gs) { const float* h = p.H + t * D; float ss = 0.f; for (int i = 0; i < D; ++i) ss += h[i] * h[i]; const float r = 1.0f / sqrtf(ss / D + RMS_EPS);
        float lg[NE]; for (int e = 0; e < NE; ++e) lg[e] = 0.f; for (int i = 0; i < D; ++i) { const float v = h[i] * r * g[i]; for (int e = 0; e < NE; ++e) lg[e] += v * R[i * NE + e]; }
        int e0 = 0; float v0 = lg[0]; for (int e = 1; e < NE; ++e) if (lg[e] > v0) { v0 = lg[e]; e0 = e; }
        int e1 = -1; float v1 = -3.0e38f; for (int e = 0; e < NE; ++e) if (e != e0 && lg[e] > v1) { v1 = lg[e]; e1 = e; }
        const float g1 = 1.0f / (1.0f + expf(v0 - v1)), gg0 = 1.0f - g1; p.TOPE[t * 2] = e0; p.TOPE[t * 2 + 1] = e1; p.TOPG[t * 2] = gg0; p.TOPG[t * 2 + 1] = g1;
#ifdef __HIP_DEVICE_COMPILE__
        p.POS[t * 2] = (int)atomicAdd(cnt + e0, 1u); p.POS[t * 2 + 1] = (int)atomicAdd(cnt + e1, 1u);
#else
        p.POS[t * 2] = (int)__atomic_fetch_add(cnt + e0, 1u, __ATOMIC_RELAXED); p.POS[t * 2 + 1] = (int)__atomic_fetch_add(cnt + e1, 1u, __ATOMIC_RELAXED);
#endif
    }
}
HD int moe_start_of(const MP& p, int j, int E) { const unsigned* cnt = cnt_ptr(p, j); int o = 0; for (int e = 0; e < NE; ++e) if (e < E) o += (int)((cnt[e] + 255u) / 256u) * 256; return o; }
HD void nv_moeplan(const MP& p, int L, long g0, long gs) {
    const int j = L / 2;
    for (long i = g0; i < p.T * 2; i += gs) { const long t = i / 2; const int slot = moe_start_of(p, j, p.TOPE[i]) + p.POS[i]; p.TOKSLOT[i] = slot; for (int k = 0; k < D; ++k) p.XB[(long)slot * D + k] = p.HB[t * D + k]; }
    for (long i = g0; i < 1024; i += gs) { int e = -1; if (i * 256 < moe_start_of(p, j, NE)) { e = 0; for (int q = 1; q < NE; ++q) if (i * 256 >= moe_start_of(p, j, q)) e = q; } p.TILE_E[i] = e; }
}
HD void nv_gateup(const MP& p, int L, long g0, long gs) {
    const int j = L / 2; const bool moe = L & 1; long rows = p.T; const bf16* Ain = p.HB;
    if (moe) { rows = moe_start_of(p, j, NE); Ain = p.XB; }
    for (long i = g0; i < (rows / 4) * DFF; i += gs) { const long m0 = (i / DFF) * 4; const int jj = (int)(i % DFF); const int e = moe ? p.TILE_E[m0 / 256] : 0;
        const bf16* W = moe ? p.MWGU + ((long)j * NE + e) * NGU * D : p.DWGU + (long)j * NGU * D; const long rg = (jj / 128) * 256 + (jj % 128), ru = rg + 128; float ag[4] = {0, 0, 0, 0}, au[4] = {0, 0, 0, 0};
        for (int k = 0; k < D; k += 8) { const V8 wg = ld8(W + rg * D + k), wu = ld8(W + ru * D + k); for (int r = 0; r < 4; ++r) { const V8 a = ld8(Ain + (m0 + r) * D + k); ag[r] += dot8(a, wg); au[r] += dot8(a, wu); } }
        for (int r = 0; r < 4; ++r) p.ACT[(m0 + r) * DFF + jj] = f2bf(siluf_(ag[r]) * au[r]); }
}
struct EpiYs { bf16* C; HD void operator()(long m, long n, float v) const { C[m * D + n] = f2bf(v); } };
HD void nv_down(const MP& p, int L, long g0, long gs) {
    const int j = L / 2;
    if (!(L & 1)) { gemm_nt(p.ACT, DFF, p.DWD + (long)j * D * DFF, DFF, p.T, D, DFF, EpiAddF32{p.H, D}, g0, gs); return; }
    const long rows = moe_start_of(p, j, NE);
    for (long tl = 0; tl < rows / 256; ++tl) { const int e = p.TILE_E[tl]; gemm_nt(p.ACT + tl * 256 * DFF, DFF, p.MWD + ((long)j * NE + e) * D * DFF, DFF, 256, D, DFF, EpiYs{p.YS + tl * 256 * D}, g0, gs); }
}
HD void nv_norm3(const MP& p, int L, long g0, long gs) {
    const float* g = p.ple_g + L * D;
    for (long t = g0; t < p.T; t += gs) { float* h = p.H + t * D;
        if (L & 1) { const bf16* y0 = p.YS + (long)p.TOKSLOT[t * 2] * D; const bf16* y1 = p.YS + (long)p.TOKSLOT[t * 2 + 1] * D; const float a = p.TOPG[t * 2], b = p.TOPG[t * 2 + 1]; for (int i = 0; i < D; ++i) h[i] += a * bf2f(y0[i]) + b * bf2f(y1[i]); }
        float ss = 0.f; for (int i = 0; i < D; ++i) ss += h[i] * h[i]; const float r = 1.0f / sqrtf(ss / D + RMS_EPS); for (int i = 0; i < D; ++i) p.HB[t * D + i] = f2bf(h[i] * r * g[i]); }
}
HD void nv_ple(const MP& p, int L, long g0, long gs) { gemm_nt(p.HB, D, p.WPG + (long)L * D * D, D, p.T, D, D, EpiPle{p.H, p.PJ}, g0, gs); }
HD void nv_final(const MP& p, long g0, long gs) {
    for (long t = g0; t < p.T; t += gs) { const float* h = p.H + t * D; float ss = 0.f; for (int i = 0; i < D; ++i) ss += h[i] * h[i]; const float r = 1.0f / sqrtf(ss / D + RMS_EPS); for (int i = 0; i < D; ++i) p.out[t * D + i] = h[i] * r * p.fin_g[i]; }
}
enum { NV_PROLOGUE = 0, NV_NORM1, NV_INPROJ, NV_A1, NV_A2, NV_A3A, NV_A3B, NV_B1, NV_ATTN, NV_C1, NV_C2, NV_OUTPROJ, NV_NORM2, NV_ROUTER, NV_MOEPLAN, NV_GATEUP, NV_DOWN, NV_NORM3, NV_PLE, NV_FINAL, NV_NPH };
HD void nv_run(const MP& p, int ph, int L, long g0, long gs) {
    switch (ph) {
    case NV_PROLOGUE: nv_prologue(p, g0, gs); break; case NV_NORM1: nv_norm(p, p.attn_g + L * D, g0, gs); break; case NV_INPROJ: nv_inproj(p, L, g0, gs); break;
    case NV_A1: nv_mixA1(p, L, g0, gs); break; case NV_A2: nv_mixA2(p, L, g0, gs); break; case NV_A3A: nv_mixA3a(p, g0, gs); break; case NV_A3B: nv_mixA3b(p, g0, gs); break;
    case NV_B1: nv_mixB1(p, g0, gs); break; case NV_ATTN: nv_attn(p, g0, gs); break; case NV_C1: nv_mixC1(p, L, g0, gs); break; case NV_C2: nv_mixC2(p, L, g0, gs); break;
    case NV_OUTPROJ: nv_outproj(p, L, g0, gs); break; case NV_NORM2: nv_norm(p, p.ffn_g + L * D, g0, gs); break; case NV_ROUTER: if (L & 1) nv_router(p, L, g0, gs); break;
    case NV_MOEPLAN: if (L & 1) nv_moeplan(p, L, g0, gs); break; case NV_GATEUP: nv_gateup(p, L, g0, gs); break; case NV_DOWN: nv_down(p, L, g0, gs); break;
    case NV_NORM3: nv_norm3(p, L, g0, gs); break; case NV_PLE: nv_ple(p, L, g0, gs); break; case NV_FINAL: nv_final(p, g0, gs); break; }
}
}

namespace pg8 {
#define PG8_LAS __attribute__((address_space(3)))
typedef unsigned short bf16_t;
typedef short bf16x8 __attribute__((ext_vector_type(8)));
typedef float f32x4 __attribute__((ext_vector_type(4)));
typedef unsigned u32x4 __attribute__((ext_vector_type(4)));
constexpr int BM = 256, BK = 64, HALF = 128, HTB = HALF * BK * 2  , STAGE_BYTES = 8 * HTB, NXCD = 8, WGM = 8;

__host__ __device__ __forceinline__ int lds_byte(int r, int c) { const int st = (r >> 4) * 2 + (c >> 5), rr = r & 15, cc = c & 31, ob = rr * 64 + cc * 2; return st * 1024 + (ob ^ (((ob >> 9) & 1) << 5)); }
__host__ __device__ __forceinline__ void stage_rc(int b, int& R, int& C) { const int st = b / 1024, sb = b % 1024, swz = sb ^ (((sb >> 9) & 1) << 5); R = (st >> 1) * 16 + swz / 64; C = (st & 1) * 32 + (swz % 64) / 2; }
__host__ __device__ __forceinline__ int perm32(int rho) { const int n = rho >> 4, i = rho & 15; return 8 * (i >> 2) + 4 * n + (i & 3); }

struct Unit { int pm, pn, cn; };
struct Gemm { const bf16_t* A; const bf16_t* Bt; int M, N, K; };

struct StaticOrder {
    int nM, nN, nwg, G, c;
    __host__ __device__ void init(int M, int N, int G_, int c_) { nM = M / BM; nN = N / BM; nwg = nM * nN; G = G_; c = c_; }
    __host__ __device__ bool next(int i, Unit& u) const {
        const long L = (long)i * G + c; if (L >= nwg) return false;
        int wgid = (int)L; { const int q = nwg / NXCD, r = nwg % NXCD, xcd = wgid % NXCD, off = wgid / NXCD; wgid = (xcd < r ? xcd * (q + 1) : r * (q + 1) + (xcd - r) * q) + off; }
        const int nig = WGM * nN, gid = wgid / nig, fm = gid * WGM, gsz = (nM - fm) < WGM ? (nM - fm) : WGM;
        u.pm = fm + ((wgid % nig) % gsz); u.pn = (wgid % nig) / gsz; u.cn = u.pn; return true;
    }
    __device__ __forceinline__ void a_ready(const Unit&) const {}
    __device__ __forceinline__ void done(const Unit&) const {}
};
__device__ __forceinline__ unsigned cvt_pk_bf16(float lo, float hi) { unsigned r; asm volatile("v_cvt_pk_bf16_f32 %0, %1, %2" : "=v"(r) : "v"(lo), "v"(hi)); return r; }
typedef float f32x2 __attribute__((ext_vector_type(2)));
template <class Epi, class Sched, bool ALIGN_EPI = false, bool SP2 = false>
__device__ __forceinline__ void gemm_phase(PG8_LAS unsigned char* lds, const Gemm g, const Sched& S, const Epi& E) {
    const int tid = mk_tid(), wid = __builtin_amdgcn_readfirstlane(tid >> 6), lane = tid & 63, wr = wid >> 2, wc = wid & 3, fr = lane & 15, fq = lane >> 4;
    const int K = g.K, nt = K / BK;
    unsigned voffA[2], voffB[2];
#pragma unroll
    for (int i = 0; i < 2; ++i) { int R, C; stage_rc(tid * 16 + i * 8192, R, C); const int Rb = Epi::PERM ? ((R & ~31) + perm32(R & 31)) : R;
        voffA[i] = (unsigned)(R * K + C) * 2u; voffB[i] = (unsigned)(Rb * K + C) * 2u; }
    const size_t kstep = (size_t)(BK * 2);
    const size_t hstep = (size_t)HALF * K * 2;
    const size_t tstep = 2 * hstep;
    const unsigned ldsw = (unsigned)wid * 1024u;
    const int aoff = lds_byte(wr * 64 + fr, fq * 8), boff = lds_byte(wc * 32 + fr, fq * 8);
#define PG8_SA(b, h) (((b) * 2 + (h)) * HTB)
#define PG8_SB(b, h) ((4 + (b) * 2 + (h)) * HTB)
#define PG8_STAGE(bufoff, gbase, voff) do { _Pragma("unroll") for (int _i = 0; _i < 2; ++_i) \
        __builtin_amdgcn_global_load_lds((const unsigned*)((const char*)(gbase) + (voff)[_i]), (PG8_LAS unsigned*)(lds + (bufoff) + ldsw + _i * 8192), 16, 0, 0); } while (0)
#define PG8_LDA(dst, b, h) do { _Pragma("unroll") for (int m = 0; m < 4; ++m) _Pragma("unroll") for (int k = 0; k < 2; ++k) dst[m][k] = *(const PG8_LAS bf16x8*)(lds + PG8_SA(b, h) + aoff + m * 2048 + k * 1024); } while (0)
#define PG8_LDB(dst, b, h) do { _Pragma("unroll") for (int n = 0; n < 2; ++n) _Pragma("unroll") for (int k = 0; k < 2; ++k) dst[n][k] = *(const PG8_LAS bf16x8*)(lds + PG8_SB(b, h) + boff + n * 2048 + k * 1024); } while (0)
#define PG8_MMA(ai, bj, At, Bt) do { __builtin_amdgcn_s_setprio(1); _Pragma("unroll") for (int m = 0; m < 4; ++m) _Pragma("unroll") for (int n = 0; n < 2; ++n) _Pragma("unroll") for (int k = 0; k < 2; ++k) \
        acc[ai][bj][m][n] = __builtin_amdgcn_mfma_f32_16x16x32_bf16(Bt[n][k], At[m][k], acc[ai][bj][m][n], 0, 0, 0); __builtin_amdgcn_s_setprio(0); } while (0)
#define PG8_WAIT_V(n) asm volatile("s_waitcnt vmcnt(" #n ")" ::: "memory")
#define PG8_WAIT_L(n) asm volatile("s_waitcnt lgkmcnt(" #n ")" ::: "memory")
#define PG8_BAR __builtin_amdgcn_s_barrier()
#define PG8_SCHED __builtin_amdgcn_sched_barrier(0)
    Unit cur, nxt; int ui = 0;
    if (!S.next(0, cur)) return;
    f32x4 acc[2][2][4][2];
#pragma unroll
    for (int a = 0; a < 2; ++a)
#pragma unroll
        for (int b = 0; b < 2; ++b)
#pragma unroll
            for (int m = 0; m < 4; ++m)
#pragma unroll
                for (int n = 0; n < 2; ++n) acc[a][b][m][n] = (f32x4){0.f, 0.f, 0.f, 0.f};
    bf16x8 At[4][2], B0[2][2], B1[2][2];
    const char* cA = (const char*)g.A + (size_t)cur.pm * tstep; const char* cB = (const char*)g.Bt + (size_t)cur.pn * tstep;
    S.a_ready(cur);
    if constexpr (SP2) {
        PG8_STAGE(PG8_SB(0, 0), cB, voffB); PG8_STAGE(PG8_SB(0, 1), cB + hstep, voffB); PG8_STAGE(PG8_SA(0, 0), cA, voffA); PG8_STAGE(PG8_SA(0, 1), cA + hstep, voffA);
        if (wr == 1) PG8_BAR;
        PG8_WAIT_V(2); PG8_BAR;
        PG8_STAGE(PG8_SB(1, 0), cB + kstep, voffB); PG8_STAGE(PG8_SA(1, 0), cA + kstep, voffA); PG8_STAGE(PG8_SB(1, 1), cB + hstep + kstep, voffB);
        PG8_WAIT_V(6); PG8_BAR;
    } else {
        PG8_STAGE(PG8_SB(0, 0), cB, voffB); PG8_STAGE(PG8_SA(0, 0), cA, voffA); PG8_STAGE(PG8_SB(0, 1), cB + hstep, voffB); PG8_STAGE(PG8_SA(0, 1), cA + hstep, voffA);
        if (wr == 1) PG8_BAR;
        PG8_WAIT_V(4); PG8_BAR;
        PG8_STAGE(PG8_SB(1, 0), cB + kstep, voffB); PG8_STAGE(PG8_SA(1, 0), cA + kstep, voffA); PG8_STAGE(PG8_SB(1, 1), cB + hstep + kstep, voffB);
        PG8_WAIT_V(6); PG8_BAR;
    }
    for (;;) {
        const bool has_next = S.next(ui + 1, nxt);
        const char* nA = has_next ? (const char*)g.A + (size_t)nxt.pm * tstep : cA; const char* nB = has_next ? (const char*)g.Bt + (size_t)nxt.pn * tstep : cB;
        for (int t = 0; t < nt; t += 2) {
            const bool last = (t == nt - 2);
            const char* a1 = cA + (size_t)(t + 1) * kstep;
            const char* a2 = last ? nA : cA + (size_t)(t + 2) * kstep; const char* b2 = last ? nB : cB + (size_t)(t + 2) * kstep;
            const char* a3 = a2 + kstep; const char* b3 = b2 + kstep;
            if (last && has_next) S.a_ready(nxt);
            if constexpr (SP2) {
            PG8_LDB(B0, 0, 0); PG8_LDB(B1, 0, 1); PG8_SCHED; PG8_LDA(At, 0, 0); PG8_STAGE(PG8_SA(1, 1), a1 + hstep, voffA);
            PG8_WAIT_V(8); PG8_WAIT_L(0); PG8_BAR; PG8_MMA(0, 0, At, B0); PG8_MMA(0, 1, At, B1); PG8_BAR; PG8_SCHED;
            PG8_LDA(At, 0, 1); PG8_STAGE(PG8_SB(0, 0), b2, voffB); PG8_STAGE(PG8_SB(0, 1), b2 + hstep, voffB); PG8_STAGE(PG8_SA(0, 0), a2, voffA);
            PG8_WAIT_V(8); PG8_WAIT_L(0); PG8_BAR; PG8_MMA(1, 0, At, B0); PG8_MMA(1, 1, At, B1); PG8_BAR; PG8_SCHED;
            PG8_LDB(B0, 1, 0); PG8_LDB(B1, 1, 1); PG8_SCHED; PG8_LDA(At, 1, 0); PG8_STAGE(PG8_SA(0, 1), a2 + hstep, voffA);
            PG8_WAIT_V(8); PG8_WAIT_L(0); PG8_BAR; PG8_MMA(0, 0, At, B0); PG8_MMA(0, 1, At, B1); PG8_BAR; PG8_SCHED;
            PG8_LDA(At, 1, 1); PG8_STAGE(PG8_SB(1, 0), b3, voffB); PG8_STAGE(PG8_SB(1, 1), b3 + hstep, voffB); PG8_STAGE(PG8_SA(1, 0), a3, voffA);
            PG8_WAIT_V(8); PG8_WAIT_L(0); PG8_BAR; PG8_MMA(1, 0, At, B0); PG8_MMA(1, 1, At, B1); PG8_BAR; PG8_SCHED;
            } else {
            PG8_LDB(B0, 0, 0); PG8_SCHED; PG8_LDA(At, 0, 0); PG8_STAGE(PG8_SA(1, 1), a1 + hstep, voffA);
            PG8_WAIT_L(8); PG8_BAR; PG8_WAIT_L(0); PG8_MMA(0, 0, At, B0); PG8_BAR; PG8_SCHED;
            PG8_LDB(B1, 0, 1); PG8_STAGE(PG8_SB(0, 0), b2, voffB);
            PG8_BAR; PG8_WAIT_L(0); PG8_MMA(0, 1, At, B1); PG8_BAR;
            PG8_LDA(At, 0, 1); PG8_STAGE(PG8_SA(0, 0), a2, voffA);
            PG8_BAR; PG8_WAIT_L(0); PG8_MMA(1, 0, At, B0); PG8_BAR; PG8_SCHED;
            PG8_STAGE(PG8_SB(0, 1), b2 + hstep, voffB);
            PG8_WAIT_V(6); PG8_BAR; PG8_MMA(1, 1, At, B1); PG8_BAR;
            PG8_LDB(B0, 1, 0); PG8_SCHED; PG8_LDA(At, 1, 0); PG8_STAGE(PG8_SA(0, 1), a2 + hstep, voffA);
            PG8_WAIT_L(8); PG8_BAR; PG8_WAIT_L(0); PG8_MMA(0, 0, At, B0); PG8_BAR; PG8_SCHED;
            PG8_LDB(B1, 1, 1); PG8_STAGE(PG8_SB(1, 0), b3, voffB);
            PG8_BAR; PG8_WAIT_L(0); PG8_MMA(0, 1, At, B1); PG8_BAR;
            PG8_LDA(At, 1, 1); PG8_STAGE(PG8_SA(1, 0), a3, voffA);
            PG8_BAR; PG8_WAIT_L(0); PG8_MMA(1, 0, At, B0); PG8_BAR; PG8_SCHED;
            PG8_STAGE(PG8_SB(1, 1), b3 + hstep, voffB);
            PG8_WAIT_V(6); PG8_BAR; PG8_MMA(1, 1, At, B1); PG8_BAR;
            }
        }
        if constexpr (ALIGN_EPI) { if (wr == 0) PG8_BAR; }
        if constexpr (!Epi::AFTER_DRAIN) { E(acc, cur, wr, wc, fr, fq); S.done(cur); }
        if (!has_next) break;
#pragma unroll
        for (int a = 0; a < 2; ++a)
#pragma unroll
            for (int b = 0; b < 2; ++b)
#pragma unroll
                for (int m = 0; m < 4; ++m)
#pragma unroll
                    for (int n = 0; n < 2; ++n) acc[a][b][m][n] = (f32x4){0.f, 0.f, 0.f, 0.f};
        cur = nxt; cA = nA; cB = nB; ++ui;
        if constexpr (ALIGN_EPI) { if (wr == 1) PG8_BAR; }
    }
    PG8_WAIT_V(0);
    if constexpr (!ALIGN_EPI) { if (wr == 0) PG8_BAR; }
    PG8_BAR;
    if constexpr (Epi::AFTER_DRAIN) { E.fused(acc, cur, wr, wc, fr, fq, lds, wid, lane); S.done(cur); }
#undef PG8_SA
#undef PG8_SB
#undef PG8_STAGE
#undef PG8_LDA
#undef PG8_LDB
#undef PG8_MMA
#undef PG8_WAIT_V
#undef PG8_WAIT_L
#undef PG8_BAR
#undef PG8_SCHED
}
}

namespace pg8 {
__device__ __forceinline__ float fast_sigmoid(float x) { return __builtin_amdgcn_rcpf(1.0f + __builtin_amdgcn_exp2f(-1.4426950408889634f * x)); }
struct EpiStore16 {
    static constexpr bool PERM = true, AFTER_DRAIN = false;
    bf16_t* O; int ldc;
    __device__ __forceinline__ void operator()(const f32x4 (&acc)[2][2][4][2], const Unit& u, int wr, int wc, int fr, int fq) const {
        const int row0 = u.pm * BM + wr * 64 + fr, col0 = u.cn * BM + wc * 32 + 8 * fq;
#pragma unroll
        for (int ai = 0; ai < 2; ++ai)
#pragma unroll
            for (int m = 0; m < 4; ++m) { bf16_t* rowp = O + (size_t)(row0 + ai * HALF + m * 16) * ldc + col0;
#pragma unroll
                for (int bj = 0; bj < 2; ++bj) { const f32x4 v0 = acc[ai][bj][m][0], v1 = acc[ai][bj][m][1];
                    u32x4 w; w.x = cvt_pk_bf16(v0[0], v0[1]); w.y = cvt_pk_bf16(v0[2], v0[3]); w.z = cvt_pk_bf16(v1[0], v1[1]); w.w = cvt_pk_bf16(v1[2], v1[3]);
                    *(u32x4*)(rowp + bj * HALF) = w; } }
    }
};
struct EpiAddH {
    static constexpr bool PERM = false, AFTER_DRAIN = false;
    float* H; int ldc;
    __device__ __forceinline__ void operator()(const f32x4 (&acc)[2][2][4][2], const Unit& u, int wr, int wc, int fr, int fq) const {
        const int row0 = u.pm * BM + wr * 64 + fr, col0 = u.cn * BM + wc * 32 + 4 * fq;
#pragma unroll
        for (int ai = 0; ai < 2; ++ai)
#pragma unroll
            for (int m = 0; m < 4; ++m) { float* rowp = H + (size_t)(row0 + ai * HALF + m * 16) * ldc + col0;
                f32x4 h[2][2];
#pragma unroll
                for (int bj = 0; bj < 2; ++bj)
#pragma unroll
                    for (int n = 0; n < 2; ++n) h[bj][n] = *(const f32x4*)(rowp + bj * HALF + n * 16);
#pragma unroll
                for (int bj = 0; bj < 2; ++bj)
#pragma unroll
                    for (int n = 0; n < 2; ++n) *(f32x4*)(rowp + bj * HALF + n * 16) = h[bj][n] + acc[ai][bj][m][n];
                asm volatile("" ::: "memory"); }
    }
};
struct EpiSwiglu {
    static constexpr bool PERM = true, AFTER_DRAIN = false;
    bf16_t* O; int ldc;
    __device__ __forceinline__ void operator()(const f32x4 (&acc)[2][2][4][2], const Unit& u, int wr, int wc, int fr, int fq) const {
        const int row0 = u.pm * BM + wr * 64 + fr, col0 = u.cn * HALF + wc * 32 + 8 * fq;
#pragma unroll
        for (int ai = 0; ai < 2; ++ai)
#pragma unroll
            for (int m = 0; m < 4; ++m) { bf16_t* rowp = O + (size_t)(row0 + ai * HALF + m * 16) * ldc + col0; float o[8];
#pragma unroll
                for (int n = 0; n < 2; ++n)
#pragma unroll
                    for (int j = 0; j < 4; ++j) { const float g = acc[ai][0][m][n][j], up = acc[ai][1][m][n][j]; o[n * 4 + j] = g * fast_sigmoid(g) * up; }
                u32x4 w; w.x = cvt_pk_bf16(o[0], o[1]); w.y = cvt_pk_bf16(o[2], o[3]); w.z = cvt_pk_bf16(o[4], o[5]); w.w = cvt_pk_bf16(o[6], o[7]);
                *(u32x4*)rowp = w; }
    }
};
struct EpiPleF {
    static constexpr bool PERM = false, AFTER_DRAIN = false;
    float* H; const bf16_t* PJ; int ldc;
    __device__ __forceinline__ void operator()(const f32x4 (&acc)[2][2][4][2], const Unit& u, int wr, int wc, int fr, int fq) const {
        typedef unsigned u32x2v __attribute__((ext_vector_type(2)));
        const int row0 = u.pm * BM + wr * 64 + fr, col0 = u.cn * BM + wc * 32 + 4 * fq;
#pragma unroll
        for (int ai = 0; ai < 2; ++ai)
#pragma unroll
            for (int m = 0; m < 4; ++m) { const size_t off = (size_t)(row0 + ai * HALF + m * 16) * ldc + col0;
                f32x4 h[2][2]; u32x2v pj[2][2];
#pragma unroll
                for (int bj = 0; bj < 2; ++bj)
#pragma unroll
                    for (int n = 0; n < 2; ++n) { h[bj][n] = *(const f32x4*)(H + off + bj * HALF + n * 16); pj[bj][n] = *(const u32x2v*)(PJ + off + bj * HALF + n * 16); }
#pragma unroll
                for (int bj = 0; bj < 2; ++bj)
#pragma unroll
                    for (int n = 0; n < 2; ++n) { const f32x4 a = acc[ai][bj][m][n]; f32x4 o;
                        o[0] = h[bj][n][0] + __uint_as_float(pj[bj][n].x << 16) * fast_sigmoid(a[0]); o[1] = h[bj][n][1] + __uint_as_float(pj[bj][n].x & 0xffff0000u) * fast_sigmoid(a[1]);
                        o[2] = h[bj][n][2] + __uint_as_float(pj[bj][n].y << 16) * fast_sigmoid(a[2]); o[3] = h[bj][n][3] + __uint_as_float(pj[bj][n].y & 0xffff0000u) * fast_sigmoid(a[3]);
                        *(f32x4*)(H + off + bj * HALF + n * 16) = o; }
                asm volatile("" ::: "memory"); }
    }
};
struct ExpertOrder : StaticOrder {
    const int* tile_e;
    __device__ __forceinline__ bool next(int i, Unit& u) const { if (!StaticOrder::next(i, u)) return false; if (tile_e) u.pn += tile_e[u.pm] * nN; return true; }
};
}

namespace fp {
using namespace mdl;
#define FLAS __attribute__((address_space(3)))
typedef float f32x4 __attribute__((ext_vector_type(4)));
typedef float f32x2 __attribute__((ext_vector_type(2)));
typedef unsigned u32x4 __attribute__((ext_vector_type(4)));
typedef unsigned u32x2 __attribute__((ext_vector_type(2)));
typedef __bf16 bf16x2_t __attribute__((ext_vector_type(2)));
__device__ __forceinline__ unsigned pk2(float lo, float hi) { f32x2 v = {lo, hi}; bf16x2_t b = __builtin_convertvector(v, bf16x2_t); return __builtin_bit_cast(unsigned, b); }
__device__ __forceinline__ float blo(unsigned w) { return __uint_as_float(w << 16); }
__device__ __forceinline__ float bhi(unsigned w) { return __uint_as_float(w & 0xffff0000u); }
__device__ __forceinline__ float wave_sum(float v) {
#pragma unroll
    for (int o = 1; o < 64; o <<= 1) v += __shfl_xor(v, o);
    return v;
}
#define FP_LDS_WAIT() asm volatile("s_waitcnt lgkmcnt(0)" ::: "memory")

template <class Map> __device__ __forceinline__ void tr_item(const float* W, int Nsrc, const Map& map, bf16* WT, int K, int k0, int n0, FLAS float* scr, int lane) {
    const int nl = lane & 31, c = map(n0 + nl);
#pragma unroll 8
    for (int i = 0; i < 32; ++i) { const int kk = 2 * i + (lane >> 5); scr[kk * 33 + nl] = c >= 0 ? W[(size_t)(k0 + kk) * Nsrc + c] : 0.f; }
    FP_LDS_WAIT(); asm volatile("" ::: "memory");
    const int cc = lane & 7;
#pragma unroll
    for (int j = 0; j < 4; ++j) { const int n = (lane >> 3) + 8 * j; const FLAS float* s = scr + (8 * cc) * 33 + n;
        u32x4 o; o.x = pk2(s[0 * 33], s[1 * 33]); o.y = pk2(s[2 * 33], s[3 * 33]); o.z = pk2(s[4 * 33], s[5 * 33]); o.w = pk2(s[6 * 33], s[7 * 33]);
        *(u32x4*)(WT + (size_t)(n0 + n) * K + k0 + 8 * cc) = o; }
    FP_LDS_WAIT(); asm volatile("" ::: "memory");
}
struct MapId { __device__ __forceinline__ int operator()(int n) const { return n; } };
struct MapLt { int lim; __device__ __forceinline__ int operator()(int n) const { return n < lim ? n : -1; } };
struct MapU { __device__ __forceinline__ int operator()(int n) const { return ucol_src(n); } };
struct MapOff { int off; __device__ __forceinline__ int operator()(int n) const { return n + off; } };
__device__ __forceinline__ void prologue(const MP& p, FLAS unsigned char* lds, int bx, int G) {
    const int tid = mk_tid(), lane = tid & 63, wave = __builtin_amdgcn_readfirstlane(tid >> 6);
    FLAS float* scr = (FLAS float*)(lds + wave * 16384);
    const int gw = bx * 8 + wave, NGW = G * 8;
    constexpr int I_WIN = (D / 64) * (NU / 32), I_UQ = 4 * 16, I_UKV = 2 * 16, I_DD = 16 * 32, I_PP = 4 * 32, I_GU = 16 * (NGU / 32), I_DN = (DFF / 64) * 32;
    constexpr int PER_L = I_WIN + I_UQ + I_UKV + 2 * I_DD + I_PP, NITEMS = DEPTH * PER_L + 18 * (I_GU + I_DN);
    for (int it = gw; it < NITEMS; it += NGW) {
        int r = it;
        if (r < DEPTH * PER_L) { const int l = r / PER_L; r %= PER_L;
            if (r < I_WIN) { tr_item(p.w_in + (size_t)l * D * NUO, NUO, MapU{}, p.WIN + (size_t)l * NU * D, D, 64 * (r / (NU / 32)), 32 * (r % (NU / 32)), scr, lane); continue; } r -= I_WIN;
            if (r < I_UQ) { tr_item(p.w_uq + (size_t)l * 256 * 384, 384, MapLt{384}, p.WUQ + (size_t)l * 512 * 256, 256, 64 * (r / 16), 32 * (r % 16), scr, lane); continue; } r -= I_UQ;
            if (r < I_UKV) { tr_item(p.w_ukv + (size_t)l * 128 * 512, 512, MapId{}, p.WUKV + (size_t)l * 512 * 128, 128, 64 * (r / 16), 32 * (r % 16), scr, lane); continue; } r -= I_UKV;
            if (r < I_DD) { tr_item(p.w_out + (size_t)l * D * D, D, MapId{}, p.WOUT + (size_t)l * D * D, D, 64 * (r / 32), 32 * (r % 32), scr, lane); continue; } r -= I_DD;
            if (r < I_DD) { tr_item(p.ple_wg + (size_t)l * D * D, D, MapId{}, p.WPG + (size_t)l * D * D, D, 64 * (r / 32), 32 * (r % 32), scr, lane); continue; } r -= I_DD;
            tr_item(p.ple_wp + (size_t)l * PLE * D, D, MapId{}, p.WPP + (size_t)l * D * PLE, PLE, 64 * (r / 32), 32 * (r % 32), scr, lane); continue; }
        r -= DEPTH * PER_L;
        if (r < 18 * I_GU) { const int mt = r / I_GU; r %= I_GU; const int k0 = 64 * (r / (NGU / 32)), n0 = 32 * (r % (NGU / 32)); const int tl = n0 / 256, rr = n0 % 256;
            const float* src; bf16* dst;
            if (mt < 2) { src = (rr < 128 ? p.dwg : p.dwu) + (size_t)mt * D * DFF; dst = p.DWGU + (size_t)mt * NGU * D; } else { src = (rr < 128 ? p.mwg : p.mwu) + (size_t)(mt - 2) * D * DFF; dst = p.MWGU + (size_t)(mt - 2) * NGU * D; }
            tr_item(src, DFF, MapOff{tl * 128 + (rr & 127) - n0}, dst, D, k0, n0, scr, lane); continue; }
        r -= 18 * I_GU;
        { const int mt = r / I_DN; r %= I_DN; const float* src; bf16* dst;
            if (mt < 2) { src = p.dwd + (size_t)mt * DFF * D; dst = p.DWD + (size_t)mt * D * DFF; } else { src = p.mwd + (size_t)(mt - 2) * DFF * D; dst = p.MWD + (size_t)(mt - 2) * D * DFF; }
            tr_item(src, D, MapId{}, dst, DFF, 64 * (r / 32), 32 * (r % 32), scr, lane); }
    }
    const long g0 = (long)bx * 512 + tid, gs = (long)G * 512;
    for (long i = g0; i < p.T * D / 4; i += gs) ((f32x4*)p.H)[i] = ((const f32x4*)p.x)[i];
    for (long i = g0; i < (long)DEPTH * p.T * PLE / 4; i += gs) { const f32x4 v = ((const f32x4*)p.p)[i]; u32x2 o; o.x = pk2(v.x, v.y); o.y = pk2(v.z, v.w); ((u32x2*)p.PB16)[i] = o; }
    for (long i = g0; i < p.T * 16; i += gs) { const long t = i / 16; const int j = (int)(i % 16); const float inv = powf(10000.0f, -(float)(2 * j) / 32.0f), ang = (float)p.pos[t] * inv;
        p.CS[t * 32 + j] = cosf(ang); p.CS[t * 32 + 16 + j] = sinf(ang); }
}
template <int MODE> __device__ __forceinline__ void norm_phase(const MP& p, int L, const float* g, int bx, int G) {
    const int tid = mk_tid(), lane = tid & 63, wave = __builtin_amdgcn_readfirstlane(tid >> 6);
    const int gw = bx * 8 + wave, NGW = G * 8;
    const f32x4* gr = (const f32x4*)g + lane;
    for (long t = gw; t < p.T; t += NGW) {
        f32x4* hr = (f32x4*)(p.H + t * D) + lane; f32x4 v[4];
#pragma unroll
        for (int j = 0; j < 4; ++j) v[j] = hr[64 * j];
        if (MODE == 2) { const int s0 = p.TOKSLOT[t * 2], s1 = p.TOKSLOT[t * 2 + 1]; const float a = p.TOPG[t * 2], b = p.TOPG[t * 2 + 1];
            const u32x2* y0 = (const u32x2*)(p.YS + (size_t)s0 * D) + lane; const u32x2* y1 = (const u32x2*)(p.YS + (size_t)s1 * D) + lane;
#pragma unroll
            for (int j = 0; j < 4; ++j) { const u32x2 q0 = y0[64 * j], q1 = y1[64 * j];
                v[j].x += a * blo(q0.x) + b * blo(q1.x); v[j].y += a * bhi(q0.x) + b * bhi(q1.x); v[j].z += a * blo(q0.y) + b * blo(q1.y); v[j].w += a * bhi(q0.y) + b * bhi(q1.y); hr[64 * j] = v[j]; } }
        float ss = 0.f;
#pragma unroll
        for (int j = 0; j < 4; ++j) ss += (v[j].x * v[j].x + v[j].y * v[j].y) + (v[j].z * v[j].z + v[j].w * v[j].w);
        const float r = 1.0f / sqrtf(wave_sum(ss) * (1.0f / D) + RMS_EPS);
#pragma unroll
        for (int j = 0; j < 4; ++j) { const f32x4 gv = gr[64 * j]; v[j].x *= r * gv.x; v[j].y *= r * gv.y; v[j].z *= r * gv.z; v[j].w *= r * gv.w; }
        if (MODE == 3) {
#pragma unroll
            for (int j = 0; j < 4; ++j) ((f32x4*)(p.out + t * D) + lane)[64 * j] = v[j];
        } else {
            u32x2* o = (u32x2*)(p.HB + t * D) + lane;
#pragma unroll
            for (int j = 0; j < 4; ++j) { u32x2 w; w.x = pk2(v[j].x, v[j].y); w.y = pk2(v[j].z, v[j].w); o[64 * j] = w; }
        }
        if (MODE == 1) { const int jm = L >> 1; const f32x4* R = (const f32x4*)(p.router + (size_t)jm * D * NE); float lg[NE];
#pragma unroll
            for (int e = 0; e < NE; ++e) lg[e] = 0.f;
#pragma unroll
            for (int j = 0; j < 4; ++j)
#pragma unroll
                for (int c = 0; c < 4; ++c) { const int idx = 4 * (lane + 64 * j) + c; const f32x4 r0 = R[idx * 2], r1 = R[idx * 2 + 1]; const float x = v[j][c];
                    lg[0] += x * r0.x; lg[1] += x * r0.y; lg[2] += x * r0.z; lg[3] += x * r0.w; lg[4] += x * r1.x; lg[5] += x * r1.y; lg[6] += x * r1.z; lg[7] += x * r1.w; }
#pragma unroll
            for (int e = 0; e < NE; ++e) lg[e] = wave_sum(lg[e]);
            int e0 = 0; float v0 = lg[0];
#pragma unroll
            for (int e = 1; e < NE; ++e) if (lg[e] > v0) { v0 = lg[e]; e0 = e; }
            int e1 = -1; float v1 = -3.0e38f;
#pragma unroll
            for (int e = 0; e < NE; ++e) if (e != e0 && lg[e] > v1) { v1 = lg[e]; e1 = e; }
            if (lane == 0) { const float g1 = 1.0f / (1.0f + expf(v0 - v1)); unsigned* cnt = cnt_ptr(p, jm);
                p.TOPE[t * 2] = e0; p.TOPE[t * 2 + 1] = e1; p.TOPG[t * 2] = 1.0f - g1; p.TOPG[t * 2 + 1] = g1;
                p.POS[t * 2] = (int)atomicAdd(cnt + e0, 1u); p.POS[t * 2 + 1] = (int)atomicAdd(cnt + e1, 1u); } }
    }
}
__device__ __forceinline__ void moeplan(const MP& p, int L, int bx, int G) {
    const int tid = mk_tid(), lane = tid & 63, wave = __builtin_amdgcn_readfirstlane(tid >> 6), j = L >> 1;
    const int gw = bx * 8 + wave, NGW = G * 8;
    for (long i = gw; i < p.T * 2; i += NGW) { const long t = i >> 1; const int slot = moe_start_of(p, j, p.TOPE[i]) + p.POS[i]; if (lane == 0) p.TOKSLOT[i] = slot;
        const u32x4* s = (const u32x4*)(p.HB + t * D) + lane; u32x4* d = (u32x4*)(p.XB + (size_t)slot * D) + lane; const u32x4 a = s[0], b = s[64]; d[0] = a; d[64] = b; }
    if (bx == 0) for (int i = tid; i < 1024; i += 512) { int e = -1; if (i * 256 < moe_start_of(p, j, NE)) { e = 0; for (int q = 1; q < NE; ++q) if (i * 256 >= moe_start_of(p, j, q)) e = q; } p.TILE_E[i] = e; }
}
typedef short bf16x8 __attribute__((ext_vector_type(8)));
typedef short bf16x4 __attribute__((ext_vector_type(4)));
constexpr int AT_KP = 104, AT_VP = 72, AT_VOFF = 64 * AT_KP * 2;
__device__ __forceinline__ void attn_phase(const MP& p, FLAS unsigned char* lds, int bx, int G) {
    const int tid = mk_tid(), lane = tid & 63, w = __builtin_amdgcn_readfirstlane(tid >> 6), fr = lane & 15, fq = lane >> 4;
    FLAS bf16* Ks = (FLAS bf16*)lds; FLAS bf16* Vt = (FLAS bf16*)(lds + AT_VOFF);
    const int S = (int)p.S, nunits = (int)p.B * 4 * 8;
    const int vcu = (G % 8 == 0) ? (bx % 8) * (G / 8) + bx / 8 : bx;
    const int kr0 = tid / 12, kc0 = tid % 12, kr1 = (tid + 512) / 12, kc1 = (tid + 512) % 12; const bool k1ok = tid < 256;
    const int vkey = tid >> 3, vc = tid & 7;
    for (int u = vcu; u < nunits; u += G) {
        const int bh = u >> 3, jp = u & 7, b = bh >> 2, h = bh & 3;
        const bf16* Kg = p.KK + (size_t)b * S * 384 + h * 96; const bf16* Vg = p.V + (size_t)b * S * 256 + h * 64;
        for (int half = 0; half < 2; ++half) {
            const int qb = half ? 15 - jp : jp, q0 = qb * 128, qmin = q0 + 16 * w, qglob = qmin + fr;
            const size_t trow = (size_t)b * S + qglob;
            bf16x8 qf[3];
#pragma unroll
            for (int ks = 0; ks < 3; ++ks) qf[ks] = *(const bf16x8*)(p.Q + trow * 384 + h * 96 + ks * 32 + fq * 8);
            f32x4 o[4];
#pragma unroll
            for (int dt = 0; dt < 4; ++dt) o[dt] = (f32x4){0.f, 0.f, 0.f, 0.f};
            float m = -1e30f, l = 0.f;
            const int nkt = (q0 + 128) / 64;
            u32x4 rk0, rk1 = (u32x4){0u, 0u, 0u, 0u}, rv;
            rk0 = *(const u32x4*)(Kg + (size_t)kr0 * 384 + kc0 * 8); if (k1ok) rk1 = *(const u32x4*)(Kg + (size_t)kr1 * 384 + kc1 * 8); rv = *(const u32x4*)(Vg + (size_t)vkey * 256 + vc * 8);
            for (int kt = 0; kt < nkt; ++kt) {
                __syncthreads();
                *(FLAS u32x4*)(Ks + kr0 * AT_KP + kc0 * 8) = rk0; if (k1ok) *(FLAS u32x4*)(Ks + kr1 * AT_KP + kc1 * 8) = rk1;
                { const unsigned wv[4] = {rv.x, rv.y, rv.z, rv.w};
#pragma unroll
                  for (int i = 0; i < 4; ++i) { Vt[(vc * 8 + 2 * i) * AT_VP + vkey] = (bf16)(wv[i] & 0xffffu); Vt[(vc * 8 + 2 * i + 1) * AT_VP + vkey] = (bf16)(wv[i] >> 16); } }
                __syncthreads();
                if (kt + 1 < nkt) { const size_t kb = (size_t)(kt + 1) * 64;
                    rk0 = *(const u32x4*)(Kg + (kb + kr0) * 384 + kc0 * 8); if (k1ok) rk1 = *(const u32x4*)(Kg + (kb + kr1) * 384 + kc1 * 8); rv = *(const u32x4*)(Vg + (kb + vkey) * 256 + vc * 8); }
                const int kbase = kt * 64;
                if (kbase <= qmin + 15) {
                    f32x4 s[4];
#pragma unroll
                    for (int sub = 0; sub < 4; ++sub) { s[sub] = (f32x4){0.f, 0.f, 0.f, 0.f};
#pragma unroll
                        for (int ks = 0; ks < 3; ++ks) { const bf16x8 a = *(const FLAS bf16x8*)(Ks + (sub * 16 + fr) * AT_KP + ks * 32 + fq * 8); s[sub] = __builtin_amdgcn_mfma_f32_16x16x32_bf16(a, qf[ks], s[sub], 0, 0, 0); } }
                    if (kbase + 63 > qmin) {
#pragma unroll
                        for (int sub = 0; sub < 4; ++sub)
#pragma unroll
                            for (int j = 0; j < 4; ++j) if (kbase + sub * 16 + 4 * fq + j > qglob) s[sub][j] = -1e30f;
                    }
                    float tmax = s[0][0];
#pragma unroll
                    for (int sub = 0; sub < 4; ++sub)
#pragma unroll
                        for (int j = 0; j < 4; ++j) tmax = fmaxf(tmax, s[sub][j]);
                    tmax = fmaxf(tmax, __shfl_xor(tmax, 16)); tmax = fmaxf(tmax, __shfl_xor(tmax, 32));
                    const float mn = fmaxf(m, tmax), alpha = __builtin_amdgcn_exp2f(m - mn); m = mn;
                    float rs = 0.f;
#pragma unroll
                    for (int sub = 0; sub < 4; ++sub)
#pragma unroll
                        for (int j = 0; j < 4; ++j) { s[sub][j] = __builtin_amdgcn_exp2f(s[sub][j] - mn); rs += s[sub][j]; }
                    rs += __shfl_xor(rs, 16); rs += __shfl_xor(rs, 32);
                    l = l * alpha + rs;
#pragma unroll
                    for (int dt = 0; dt < 4; ++dt) o[dt] *= alpha;
#pragma unroll
                    for (int k2 = 0; k2 < 2; ++k2) {
                        u32x4 pw; pw.x = pk2(s[2 * k2][0], s[2 * k2][1]); pw.y = pk2(s[2 * k2][2], s[2 * k2][3]); pw.z = pk2(s[2 * k2 + 1][0], s[2 * k2 + 1][1]); pw.w = pk2(s[2 * k2 + 1][2], s[2 * k2 + 1][3]);
                        const bf16x8 pf = __builtin_bit_cast(bf16x8, pw);
#pragma unroll
                        for (int dt = 0; dt < 4; ++dt) { const FLAS bf16* vp = Vt + (dt * 16 + fr) * AT_VP + 32 * k2 + 4 * fq;
                            const u32x2 v0 = *(const FLAS u32x2*)vp, v1 = *(const FLAS u32x2*)(vp + 16); u32x4 vw; vw.x = v0.x; vw.y = v0.y; vw.z = v1.x; vw.w = v1.y;
                            o[dt] = __builtin_amdgcn_mfma_f32_16x16x32_bf16(__builtin_bit_cast(bf16x8, vw), pf, o[dt], 0, 0, 0); }
                    }
                }
            }
            const float rl = 1.0f / l;
#pragma unroll
            for (int dt = 0; dt < 4; ++dt) { u32x2 ow; ow.x = pk2(o[dt][0] * rl, o[dt][1] * rl); ow.y = pk2(o[dt][2] * rl, o[dt][3] * rl);
                *(u32x2*)(p.YC + trow * D + 768 + h * 64 + dt * 16 + 4 * fq) = ow; }
        }
    }
    __syncthreads();
}
__device__ __forceinline__ void conv_module(const MP& p, int L, FLAS unsigned char* lds, int bx, int G) {
    const int tid = mk_tid(), lane = tid & 63, w = __builtin_amdgcn_readfirstlane(tid >> 6);
    FLAS float* Gs = (FLAS float*)lds;
    const int S = (int)p.S, nchunk = S / 64, nitems = (int)p.B * nchunk * 4;
    for (int it = bx; it < nitems; it += G) {
        const int gq = it & 3, ck = (it >> 2) % nchunk, b = (it >> 2) / nchunk, s0 = ck * 64;
        __syncthreads();
        for (int e = tid; e < 94 * 64; e += 512) { const int row = e >> 6, c = e & 63, sp = s0 - 30 + row; float v = 0.f;
            if (sp >= 0) { const bf16* u = p.U + ((size_t)b * S + sp) * NU + gq * 64 + c; v = bf2f(u[0]) * (1.0f / (1.0f + __expf(-bf2f(u[256])))); }
            Gs[e] = v; }
        __syncthreads();
        const int ch = gq * 64 + lane; float wj[CK];
#pragma unroll
        for (int j = 0; j < CK; ++j) wj[j] = p.cdw_w[(L * CK + j) * 256 + ch];
        const float bias = p.cdw_b[L * 256 + ch], lg = p.cln_g[L * 256 + ch], lb = p.cln_b[L * 256 + ch];
#pragma unroll 2
        for (int i = 0; i < 8; ++i) { const int tl = w * 8 + i; float acc = bias;
#pragma unroll
            for (int j = 0; j < CK; ++j) acc += wj[j] * Gs[(tl + j) * 64 + lane];
            const float mu = wave_sum(acc) * (1.0f / 64.f), dv = acc - mu, var = wave_sum(dv * dv) * (1.0f / 64.f);
            const float hn = dv * (1.0f / sqrtf(var + LN_EPS)) * lg + lb;
            p.YC[((size_t)b * S + s0 + tl) * D + ch] = f2bf(hn / (1.0f + __expf(-hn))); }
    }
    __syncthreads();
}
constexpr int MQ_P = 264, MK_P = 136;
__device__ __forceinline__ void mla_proj(const MP& p, int L, FLAS unsigned char* lds, int bx, int G) {
    const int tid = mk_tid(), lane = tid & 63, w = __builtin_amdgcn_readfirstlane(tid >> 6), fr = lane & 15, fq = lane >> 4;
    FLAS bf16* Aq = (FLAS bf16*)lds; FLAS bf16* Ak = (FLAS bf16*)(lds + 64 * MQ_P * 2);
    const int nunits = (int)(p.T / 64);
    const bf16* Wq = p.WUQ + (size_t)L * 512 * 256; const bf16* Wk = p.WUKV + (size_t)L * 512 * 128;
    for (int u = bx; u < nunits; u += G) {
        const size_t t0 = (size_t)u * 64;
        __syncthreads();
        for (int i = 0; i < 8; ++i) { const int r = w * 8 + i; const bf16* urow = p.U + (t0 + r) * NU;
            { const u32x2 q = *(const u32x2*)(urow + U_CQ + lane * 4); const float a0 = blo(q.x), a1 = bhi(q.x), a2 = blo(q.y), a3 = bhi(q.y);
              const float rs = 1.0f / sqrtf(wave_sum((a0 * a0 + a1 * a1) + (a2 * a2 + a3 * a3)) * (1.0f / 256.f) + RMS_EPS); const f32x4 gv = *(const f32x4*)(p.qn_g + L * 256 + lane * 4);
              u32x2 o; o.x = pk2(a0 * rs * gv.x, a1 * rs * gv.y); o.y = pk2(a2 * rs * gv.z, a3 * rs * gv.w); *(FLAS u32x2*)(Aq + r * MQ_P + lane * 4) = o; }
            { const unsigned q = *(const unsigned*)(urow + U_CKV + lane * 2); const float a0 = blo(q), a1 = bhi(q);
              const float rs = 1.0f / sqrtf(wave_sum(a0 * a0 + a1 * a1) * (1.0f / 128.f) + RMS_EPS); const f32x2 gv = *(const f32x2*)(p.kvn_g + L * 128 + lane * 2);
              *(FLAS unsigned*)(Ak + r * MK_P + lane * 2) = pk2(a0 * rs * gv.x, a1 * rs * gv.y); } }
        for (int e = tid; e < 1024; e += 512) { const int r = e >> 4, jj = e & 15; const size_t t = t0 + r; const float x1 = bf2f(p.U[t * NU + U_KR + jj]), x2 = bf2f(p.U[t * NU + U_KR + 16 + jj]), c = p.CS[t * 32 + jj], sn = p.CS[t * 32 + 16 + jj];
            const bf16 o1 = f2bf(x1 * c - x2 * sn), o2 = f2bf(x1 * sn + x2 * c);
#pragma unroll
            for (int h = 0; h < 4; ++h) { p.KK[t * 384 + h * 96 + 64 + jj] = o1; p.KK[t * 384 + h * 96 + 80 + jj] = o2; } }
        __syncthreads();
        {
            f32x4 acc[4][3];
#pragma unroll
            for (int rt = 0; rt < 4; ++rt)
#pragma unroll
                for (int ct = 0; ct < 3; ++ct) acc[rt][ct] = (f32x4){0.f, 0.f, 0.f, 0.f};
#pragma unroll 2
            for (int ks = 0; ks < 8; ++ks) { bf16x8 bfr[3];
#pragma unroll
                for (int ct = 0; ct < 3; ++ct) bfr[ct] = *(const bf16x8*)(Wq + (size_t)(48 * w + 16 * ct + fr) * 256 + ks * 32 + fq * 8);
#pragma unroll
                for (int rt = 0; rt < 4; ++rt) { const bf16x8 a = *(const FLAS bf16x8*)(Aq + (rt * 16 + fr) * MQ_P + ks * 32 + fq * 8);
#pragma unroll
                    for (int ct = 0; ct < 3; ++ct) acc[rt][ct] = __builtin_amdgcn_mfma_f32_16x16x32_bf16(a, bfr[ct], acc[rt][ct], 0, 0, 0); } }
            const bool pe = (w & 1) != 0;
#pragma unroll
            for (int rt = 0; rt < 4; ++rt)
#pragma unroll
                for (int j = 0; j < 4; ++j) { const size_t t = t0 + rt * 16 + 4 * fq + j; bf16* qrow = p.Q + t * 384 + 48 * w + fr;
                    float v0 = acc[rt][0][j], v1 = acc[rt][1][j], v2 = acc[rt][2][j];
                    if (pe) { const float c = p.CS[t * 32 + fr], sn = p.CS[t * 32 + 16 + fr]; const float x1 = v1, x2 = v2; v1 = x1 * c - x2 * sn; v2 = x1 * sn + x2 * c; }
                    qrow[0] = f2bf(v0 * QSCALE); qrow[16] = f2bf(v1 * QSCALE); qrow[32] = f2bf(v2 * QSCALE); }
        }
        {
            f32x4 acc[4][4];
#pragma unroll
            for (int rt = 0; rt < 4; ++rt)
#pragma unroll
                for (int ct = 0; ct < 4; ++ct) acc[rt][ct] = (f32x4){0.f, 0.f, 0.f, 0.f};
#pragma unroll 2
            for (int ks = 0; ks < 4; ++ks) { bf16x8 bfr[4];
#pragma unroll
                for (int ct = 0; ct < 4; ++ct) bfr[ct] = *(const bf16x8*)(Wk + (size_t)(64 * w + 16 * ct + fr) * 128 + ks * 32 + fq * 8);
#pragma unroll
                for (int rt = 0; rt < 4; ++rt) { const bf16x8 a = *(const FLAS bf16x8*)(Ak + (rt * 16 + fr) * MK_P + ks * 32 + fq * 8);
#pragma unroll
                    for (int ct = 0; ct < 4; ++ct) acc[rt][ct] = __builtin_amdgcn_mfma_f32_16x16x32_bf16(a, bfr[ct], acc[rt][ct], 0, 0, 0); } }
            const int h = w >> 1; const bool isv = (w & 1) != 0;
#pragma unroll
            for (int rt = 0; rt < 4; ++rt)
#pragma unroll
                for (int j = 0; j < 4; ++j) { const size_t t = t0 + rt * 16 + 4 * fq + j; bf16* dst = isv ? p.V + t * 256 + h * 64 + fr : p.KK + t * 384 + h * 96 + fr;
#pragma unroll
                    for (int ct = 0; ct < 4; ++ct) dst[16 * ct] = f2bf(acc[rt][ct][j]); }
        }
    }
    __syncthreads();
}
__device__ __forceinline__ void ssd_scan(const MP& p, int bx, int G) {
    const int tid = mk_tid(); const long g0 = (long)bx * 512 + tid, gs = (long)G * 512; const int NCB = (int)(p.S / CHUNK);
    for (long i = g0; i < p.B * 8 * 64 * 32; i += gs) { const long b = i / (8 * 64 * 32), r = i % (8 * 64 * 32); const int h = (int)(r / (64 * 32)); f32x4 carry = (f32x4){0.f, 0.f, 0.f, 0.f};
        for (int cc = 0; cc < NCB; ++cc) { const long c = b * NCB + cc; const size_t idx = (size_t)c * (8 * 64 * 32) + r;
            u32x2 o; o.x = pk2(carry.x, carry.y); o.y = pk2(carry.z, carry.w); ((u32x2*)p.PV)[idx] = o;
            const float dec = __expf(p.ACS[(c * CHUNK + CHUNK - 1) * 8 + h]); const f32x4 st = ((const f32x4*)p.ST)[idx]; carry = carry * dec + st; } }
}
constexpr int SP = 136;
constexpr int SA_DT = 0, SA_ACS = 2048, SA_CM = 4096, SA_BM = SA_CM + 128 * SP * 2, SA_XT = SA_CM, SA_BT = SA_CM + 2 * 128 * SP * 2, SA_MW = SA_BT + 128 * SP * 2, SA_END = SA_MW + 8 * 16 * SP * 2;
__device__ __forceinline__ float silu_f(float x) { return x / (1.0f + __expf(-x)); }
__device__ __forceinline__ void ssd_a(const MP& p, int L, FLAS unsigned char* lds, int bx, int G) {
    const int tid = mk_tid(), lane = tid & 63, w = __builtin_amdgcn_readfirstlane(tid >> 6), fr = lane & 15, fq = lane >> 4;
    FLAS float* dtL = (FLAS float*)(lds + SA_DT); FLAS float* acsL = (FLAS float*)(lds + SA_ACS);
    FLAS bf16* Cm = (FLAS bf16*)(lds + SA_CM); FLAS bf16* Bm = (FLAS bf16*)(lds + SA_BM); FLAS bf16* XT = (FLAS bf16*)(lds + SA_XT); FLAS bf16* BT = (FLAS bf16*)(lds + SA_BT);
    FLAS bf16* Mw = (FLAS bf16*)(lds + SA_MW + w * (16 * SP * 2));
    const int S = (int)p.S, nunits = (int)(p.T / CHUNK) * 2;
    for (int u = bx; u < nunits; u += G) {
        const int g = u & 1; const long c = u >> 1; const size_t t0 = (size_t)c * CHUNK; const int s0 = (int)(t0 % S); const size_t tb = t0 - s0;
        __syncthreads();
        {
            const int h4 = tid >> 7, l = tid & 127, h = 4 * g + h4; dtL[h4 * 128 + l] = softplusf_(bf2f(p.U[(t0 + l) * NU + U_DT + h]) + p.dt_bias[L * 8 + h]); }
        __syncthreads();
        if (w < 4) {
            const int h = 4 * g + w; const float a = -__expf(p.a_log[L * 8 + h]); const float x0 = dtL[w * 128 + 2 * lane] * a, x1 = dtL[w * 128 + 2 * lane + 1] * a, ps = x0 + x1; float inc = ps;
#pragma unroll
            for (int o = 1; o < 64; o <<= 1) { const float t = __shfl_up(inc, o); if (lane >= o) inc += t; }
            const float ex = inc - ps, c0 = ex + x0, c1 = ex + ps; acsL[w * 128 + 2 * lane] = c0; acsL[w * 128 + 2 * lane + 1] = c1;
            p.ACS[(t0 + 2 * lane) * 8 + h] = c0; p.ACS[(t0 + 2 * lane + 1) * 8 + h] = c1; }
        {
            const int ch = tid & 255, half = tid >> 8, n = ch & 127; const bool isC = ch >= 128; const int xc = (isC ? 768 : 512) + 128 * g + n, l0 = 64 * half;
            const float w0 = p.sconv_w[(L * 4 + 0) * 1024 + xc], w1 = p.sconv_w[(L * 4 + 1) * 1024 + xc], w2 = p.sconv_w[(L * 4 + 2) * 1024 + xc], w3 = p.sconv_w[(L * 4 + 3) * 1024 + xc], bias = p.sconv_b[L * 1024 + xc];
            const bf16* ucol = p.U + tb * NU + U_XBC + xc; float h0, h1, h2;
            { const int sp = s0 + l0 - 3; h0 = sp >= 0 ? bf2f(ucol[(size_t)sp * NU]) : 0.f; h1 = sp + 1 >= 0 ? bf2f(ucol[(size_t)(sp + 1) * NU]) : 0.f; h2 = sp + 2 >= 0 ? bf2f(ucol[(size_t)(sp + 2) * NU]) : 0.f; }
#pragma unroll 4
            for (int l = l0; l < l0 + 64; ++l) { const float cur = bf2f(ucol[(size_t)(s0 + l) * NU]); const bf16 vb = f2bf(silu_f(bias + w0 * h0 + w1 * h1 + w2 * h2 + w3 * cur)); h0 = h1; h1 = h2; h2 = cur;
                if (isC) { Cm[l * SP + n] = vb; p.CM[(t0 + l) * 256 + g * 128 + n] = vb; } else { Bm[l * SP + n] = vb; BT[n * SP + l] = vb; } } }
        __syncthreads();
        f32x4 cb[8];
#pragma unroll
        for (int ct = 0; ct < 8; ++ct) cb[ct] = (f32x4){0.f, 0.f, 0.f, 0.f};
#pragma unroll
        for (int ks = 0; ks < 4; ++ks) { const bf16x8 a = *(const FLAS bf16x8*)(Cm + (16 * w + fr) * SP + ks * 32 + fq * 8);
#pragma unroll
            for (int ct = 0; ct < 8; ++ct) { const bf16x8 b = *(const FLAS bf16x8*)(Bm + (16 * ct + fr) * SP + ks * 32 + fq * 8); cb[ct] = __builtin_amdgcn_mfma_f32_16x16x32_bf16(a, b, cb[ct], 0, 0, 0); } }
        __syncthreads();
        {
            const int ch = tid & 255, half = tid >> 8, h4 = ch >> 6, xc = 256 * g + ch, l0 = 64 * half;
            const float w0 = p.sconv_w[(L * 4 + 0) * 1024 + xc], w1 = p.sconv_w[(L * 4 + 1) * 1024 + xc], w2 = p.sconv_w[(L * 4 + 2) * 1024 + xc], w3 = p.sconv_w[(L * 4 + 3) * 1024 + xc], bias = p.sconv_b[L * 1024 + xc];
            const bf16* ucol = p.U + tb * NU + U_XBC + xc; float h0, h1, h2;
            { const int sp = s0 + l0 - 3; h0 = sp >= 0 ? bf2f(ucol[(size_t)sp * NU]) : 0.f; h1 = sp + 1 >= 0 ? bf2f(ucol[(size_t)(sp + 1) * NU]) : 0.f; h2 = sp + 2 >= 0 ? bf2f(ucol[(size_t)(sp + 2) * NU]) : 0.f; }
#pragma unroll 4
            for (int l = l0; l < l0 + 64; ++l) { const float cur = bf2f(ucol[(size_t)(s0 + l) * NU]); const float v = silu_f(bias + w0 * h0 + w1 * h1 + w2 * h2 + w3 * cur); h0 = h1; h1 = h2; h2 = cur;
                const bf16 vb = f2bf(v); p.XS[(t0 + l) * 512 + xc] = vb; XT[ch * SP + l] = f2bf(bf2f(vb) * dtL[h4 * 128 + l]); } }
        __syncthreads();
#pragma unroll 1
        for (int r = 0; r < 4; ++r) {
            const FLAS float* ac = acsL + r * 128; const int h = 4 * g + r;
#pragma unroll
            for (int ct = 0; ct < 8; ++ct)
#pragma unroll
                for (int j = 0; j < 4; ++j) { const int l = 16 * w + 4 * fq + j, s = 16 * ct + fr; const float v = (s <= l) ? cb[ct][j] * __expf(ac[l] - ac[s]) : 0.f; Mw[(4 * fq + j) * SP + s] = f2bf(v); }
            FP_LDS_WAIT(); asm volatile("" ::: "memory");
            f32x4 yd[4], st[4];
#pragma unroll
            for (int pt = 0; pt < 4; ++pt) { yd[pt] = (f32x4){0.f, 0.f, 0.f, 0.f}; st[pt] = (f32x4){0.f, 0.f, 0.f, 0.f}; }
            const float alast = ac[127];
#pragma unroll
            for (int ks = 0; ks < 4; ++ks) { const bf16x8 am = *(const FLAS bf16x8*)(Mw + fr * SP + ks * 32 + fq * 8);
                const u32x4 braw = *(const FLAS u32x4*)(BT + (16 * w + fr) * SP + ks * 32 + fq * 8); const FLAS float* al = ac + ks * 32 + fq * 8; u32x4 bs;
                bs.x = pk2(blo(braw.x) * __expf(alast - al[0]), bhi(braw.x) * __expf(alast - al[1])); bs.y = pk2(blo(braw.y) * __expf(alast - al[2]), bhi(braw.y) * __expf(alast - al[3]));
                bs.z = pk2(blo(braw.z) * __expf(alast - al[4]), bhi(braw.z) * __expf(alast - al[5])); bs.w = pk2(blo(braw.w) * __expf(alast - al[6]), bhi(braw.w) * __expf(alast - al[7]));
                const bf16x8 bsf = __builtin_bit_cast(bf16x8, bs);
#pragma unroll
                for (int pt = 0; pt < 4; ++pt) { const bf16x8 x = *(const FLAS bf16x8*)(XT + (r * 64 + 16 * pt + fr) * SP + ks * 32 + fq * 8);
                    yd[pt] = __builtin_amdgcn_mfma_f32_16x16x32_bf16(am, x, yd[pt], 0, 0, 0); st[pt] = __builtin_amdgcn_mfma_f32_16x16x32_bf16(x, bsf, st[pt], 0, 0, 0); } }
#pragma unroll
            for (int pt = 0; pt < 4; ++pt)
#pragma unroll
                for (int j = 0; j < 4; ++j) { p.YD[(t0 + 16 * w + 4 * fq + j) * 512 + h * 64 + 16 * pt + fr] = f2bf(yd[pt][j]);
                    p.ST[(((size_t)c * 8 + h) * 64 + 16 * pt + 4 * fq + j) * 128 + 16 * w + fr] = st[pt][j]; }
            asm volatile("" ::: "memory");
        }
    }
    __syncthreads();
}
__device__ __forceinline__ void ssd_c(const MP& p, int L, int bx, int G) {
    const int tid = mk_tid(), lane = tid & 63, w = __builtin_amdgcn_readfirstlane(tid >> 6), fr = lane & 15, fq = lane >> 4;
    const int nunits = (int)(p.T / CHUNK) * 2;
    for (int u = bx; u < nunits; u += G) {
        const int g = u & 1; const long c = u >> 1; const size_t t0 = (size_t)c * CHUNK;
        bf16x8 af[4];
#pragma unroll
        for (int ks = 0; ks < 4; ++ks) af[ks] = *(const bf16x8*)(p.CM + (t0 + 16 * w + fr) * 256 + g * 128 + ks * 32 + fq * 8);
        f32x4 y[4][4]; float ssq[4] = {0.f, 0.f, 0.f, 0.f};
#pragma unroll
        for (int r = 0; r < 4; ++r) { const int h = 4 * g + r; const bf16* pv = p.PV + (((size_t)c * 8 + h) * 64) * 128; const float dsk = p.dskip[L * 8 + h];
            float ea[4];
#pragma unroll
            for (int j = 0; j < 4; ++j) ea[j] = __expf(p.ACS[(t0 + 16 * w + 4 * fq + j) * 8 + h]);
#pragma unroll
            for (int pt = 0; pt < 4; ++pt) { f32x4 acc = (f32x4){0.f, 0.f, 0.f, 0.f};
#pragma unroll
                for (int ks = 0; ks < 4; ++ks) { const bf16x8 b = *(const bf16x8*)(pv + (size_t)(16 * pt + fr) * 128 + ks * 32 + fq * 8); acc = __builtin_amdgcn_mfma_f32_16x16x32_bf16(af[ks], b, acc, 0, 0, 0); }
#pragma unroll
                for (int j = 0; j < 4; ++j) { const size_t t = t0 + 16 * w + 4 * fq + j; const int ch = h * 64 + 16 * pt + fr;
                    const float yv = acc[j] * ea[j] + bf2f(p.YD[t * 512 + ch]) + dsk * bf2f(p.XS[t * 512 + ch]); const float yg = yv * silu_f(bf2f(p.U[t * NU + U_Z + ch])); y[r][pt][j] = yg; ssq[j] += yg * yg; } } }
#pragma unroll
        for (int j = 0; j < 4; ++j) { float s = ssq[j]; s += __shfl_xor(s, 1); s += __shfl_xor(s, 2); s += __shfl_xor(s, 4); s += __shfl_xor(s, 8); ssq[j] = 1.0f / sqrtf(s * (1.0f / 256.f) + RMS_EPS); }
#pragma unroll
        for (int r = 0; r < 4; ++r)
#pragma unroll
            for (int pt = 0; pt < 4; ++pt) { const int cc = g * 256 + r * 64 + 16 * pt + fr; const float gn = p.snorm_g[L * 512 + cc];
#pragma unroll
                for (int j = 0; j < 4; ++j) p.YC[(t0 + 16 * w + 4 * fq + j) * D + 256 + cc] = f2bf(y[r][pt][j] * ssq[j] * gn); }
    }
}
}

using namespace mdl;
#define LAS __attribute__((address_space(3)))
constexpr int NWAVES = 8, NTHR = NWAVES * 64;
constexpr int LDS_BYTES = 163840, LDSCTL_OFF = LDS_BYTES - 512, MISC_OFF = LDSCTL_OFF + 320;
constexpr int CW_BAR = 4096;
#define XB_TMO      128
#define XB_XCNT(j)  (256  + 64 * (j))
#define XB_XSUB(j)  (1280 + 64 * (j))
#define XB_XGEN(j)  (2304 + 64 * (j))
#define XB_TOP      3328
#define XB_TOPGEN   3392
#define XCD_BAR_WORDS 3456
#define XB_SPIN_CAP (1u << 18)

__device__ __forceinline__ unsigned xb_ld(unsigned* p)              { return __hip_atomic_load(p, __ATOMIC_RELAXED, __HIP_MEMORY_SCOPE_AGENT); }
__device__ __forceinline__ unsigned xb_add(unsigned* p, unsigned v) { return __hip_atomic_fetch_add(p, v, __ATOMIC_RELAXED, __HIP_MEMORY_SCOPE_AGENT); }
__device__ __forceinline__ unsigned xb_xcc_id() { return (unsigned)__builtin_amdgcn_s_getreg((3 << 11) | 20) & 0xFu; }
#define XB_SPIN(cond, bar) do { unsigned _sp = 0; while (cond) { __builtin_amdgcn_s_sleep(1); \
    if ((++_sp & 255u) == 0u) { if (xb_ld(&(bar)[XB_TMO])) break; if (_sp > XB_SPIN_CAP) { atomicAdd(&(bar)[XB_TMO], 1u); break; } } } } while (0)

struct XcdBarrier {
    unsigned* bar; unsigned x;
    volatile LAS unsigned* st;
};

__device__ __forceinline__ XcdBarrier xcd_barrier_post(unsigned* bar, volatile LAS unsigned* st) {
    XcdBarrier b; b.bar = bar; b.x = xb_xcc_id(); b.st = st;
    if (threadIdx.x == 0) (void)xb_add(&bar[XB_XCNT(b.x)], 1u);
    return b;
}
__device__ __forceinline__ void xcd_barrier_complete(unsigned* bar, unsigned x, unsigned& nloc, unsigned& nx) {
    const unsigned G = gridDim.x * gridDim.y * gridDim.z;
    unsigned sum, cnt, mine, sp = 0u;
    for (;;) {
        sum = 0u; cnt = 0u; mine = 0u;
#pragma unroll
        for (unsigned j = 0; j < 16; ++j) { const unsigned c = xb_ld(&bar[XB_XCNT(j)]); sum += c; cnt += (c > 0u) ? 1u : 0u; mine = (j == x) ? c : mine; }
        if (sum == G) break;
        __builtin_amdgcn_s_sleep(1);
        if ((++sp & 255u) == 0u) { if (xb_ld(&bar[XB_TMO])) break; if (sp > XB_SPIN_CAP) { atomicAdd(&bar[XB_TMO], 1u); break; } }
    }
    nloc = mine > 0u ? mine : 1u; nx = cnt > 0u ? cnt : 1u;
}

__device__ __forceinline__ void xcd_barrier(const XcdBarrier& b) {
    asm volatile("s_waitcnt vmcnt(0)" ::: "memory");
    __syncthreads();
    if (threadIdx.x == 0) {
        unsigned* bar = b.bar;
        __builtin_amdgcn_s_waitcnt(0);
        unsigned nloc = b.st[0], nx = b.st[1];
        if (nloc == 0u) { xcd_barrier_complete(bar, b.x, nloc, nx); b.st[0] = nloc; b.st[1] = nx; }
        const unsigned old = xb_add(&bar[XB_XSUB(b.x)], 1u);
        const unsigned gen = old / nloc;
        if (old + 1u == (gen + 1u) * nloc) {
            __builtin_amdgcn_fence(__ATOMIC_RELEASE, "agent");
            asm volatile("s_waitcnt vmcnt(0)" ::: "memory");
            const unsigned og = xb_add(&bar[XB_TOP], 1u);
            const unsigned tg = og / nx;
            if (og + 1u == (tg + 1u) * nx) xb_add(&bar[XB_TOPGEN], 1u);
            else XB_SPIN(xb_ld(&bar[XB_TOPGEN]) == tg, bar);
            __builtin_amdgcn_fence(__ATOMIC_ACQUIRE, "agent");
            xb_add(&bar[XB_XGEN(b.x)], 1u);
            asm volatile("s_waitcnt vmcnt(0)" ::: "memory");
        } else {
            XB_SPIN(xb_ld(&bar[XB_XGEN(b.x)]) == gen, bar);
            __builtin_amdgcn_fence(__ATOMIC_ACQUIRE, "agent");
            asm volatile("s_waitcnt vmcnt(0)" ::: "memory");
        }
    }
    __syncthreads();
}

struct Args { MP p; long flags; };
__global__ void __launch_bounds__(NTHR, 2) mk_fwd(Args a) {
    extern __shared__ __attribute__((aligned(16))) unsigned char lds[];
    LAS unsigned char* const L3 = (LAS unsigned char*)lds;
    volatile LAS unsigned* MISC = (volatile LAS unsigned*)(L3 + MISC_OFF);
    const MP& p = a.p;
    const int tid = threadIdx.x;
    for (int u = tid; u < (LDS_BYTES - LDSCTL_OFF) / 4; u += NTHR) ((LAS unsigned*)(L3 + LDSCTL_OFF))[u] = 0u;
    __syncthreads();
    const XcdBarrier bar = xcd_barrier_post(p.ctl + CW_BAR, MISC + 8);
    const int G = gridDim.x, bx = blockIdx.x;
    const long gs = (long)G * NTHR;
#define g0 ((long)bx * NTHR + mk_tid())
#define GRID_BAR() xcd_barrier(bar)
    fp::prologue(p, L3, bx, G); GRID_BAR();
    for (int L = 0; L < DEPTH; ++L) {
        const int j = L >> 1; const bool moe = (L & 1) != 0;
        fp::norm_phase<0>(p, L, p.attn_g + L * D, bx, G); GRID_BAR();
        {
            pg8::Gemm g{p.HB, p.WIN + (size_t)L * NU * D, (int)p.T, NU, D}; pg8::StaticOrder S; S.init((int)p.T, NU, G, bx);
            pg8::EpiStore16 E{p.U, NU}; pg8::gemm_phase<pg8::EpiStore16, pg8::StaticOrder, true, true>(L3, g, S, E);
            pg8::Gemm g2{p.PB16 + (size_t)L * p.T * PLE, p.WPP + (size_t)L * D * PLE, (int)p.T, D, PLE}; pg8::StaticOrder S2; S2.init((int)p.T, D, G, bx);
            pg8::EpiStore16 E2{p.PJ, D}; pg8::gemm_phase<pg8::EpiStore16, pg8::StaticOrder, true, true>(L3, g2, S2, E2);
        }
        GRID_BAR();
        fp::conv_module(p, L, L3, bx, G); fp::mla_proj(p, L, L3, bx, G); fp::ssd_a(p, L, L3, bx, G); GRID_BAR();
        fp::ssd_scan(p, bx, G); fp::attn_phase(p, L3, bx, G); GRID_BAR();
        fp::ssd_c(p, L, bx, G); GRID_BAR();
        {
            pg8::Gemm g{p.YC, p.WOUT + (size_t)L * D * D, (int)p.T, D, D}; pg8::StaticOrder S; S.init((int)p.T, D, G, bx);
            pg8::EpiAddH E{p.H, D}; pg8::gemm_phase<pg8::EpiAddH, pg8::StaticOrder, true, true>(L3, g, S, E);
        }
        GRID_BAR();
        if (moe) fp::norm_phase<1>(p, L, p.ffn_g + L * D, bx, G); else fp::norm_phase<0>(p, L, p.ffn_g + L * D, bx, G);
        GRID_BAR();
        if (moe) { fp::moeplan(p, L, bx, G); GRID_BAR(); }
        {
            const int rows = moe ? moe_start_of(p, j, NE) : (int)p.T;
            pg8::Gemm g{moe ? p.XB : p.HB, moe ? p.MWGU + (size_t)j * NE * NGU * D : p.DWGU + (size_t)j * NGU * D, rows, NGU, D};
            pg8::ExpertOrder S; S.init(rows, NGU, G, bx); S.tile_e = moe ? p.TILE_E : nullptr;
            pg8::EpiSwiglu E{p.ACT, DFF}; pg8::gemm_phase<pg8::EpiSwiglu, pg8::ExpertOrder, true, true>(L3, g, S, E);
            GRID_BAR();
            pg8::Gemm gd{p.ACT, moe ? p.MWD + (size_t)j * NE * D * DFF : p.DWD + (size_t)j * D * DFF, rows, D, DFF};
            pg8::ExpertOrder Sd; Sd.init(rows, D, G, bx); Sd.tile_e = moe ? p.TILE_E : nullptr;
            if (moe) { pg8::EpiStore16 Ed{p.YS, D}; pg8::gemm_phase<pg8::EpiStore16, pg8::ExpertOrder, true, true>(L3, gd, Sd, Ed); }
            else { pg8::EpiAddH Ed{p.H, D}; pg8::gemm_phase<pg8::EpiAddH, pg8::ExpertOrder, true, true>(L3, gd, Sd, Ed); }
        }
        GRID_BAR();
        if (moe) fp::norm_phase<2>(p, L, p.ple_g + L * D, bx, G); else fp::norm_phase<0>(p, L, p.ple_g + L * D, bx, G);
        GRID_BAR();
        {
            pg8::Gemm g{p.HB, p.WPG + (size_t)L * D * D, (int)p.T, D, D}; pg8::StaticOrder S; S.init((int)p.T, D, G, bx);
            pg8::EpiPleF E{p.H, p.PJ, D}; pg8::gemm_phase<pg8::EpiPleF, pg8::StaticOrder, true, true>(L3, g, S, E);
        }
        GRID_BAR();
    }
    fp::norm_phase<3>(p, 0, p.fin_g, bx, G);
}
static void fill_params(MP& p, void* const* d_in, void* d_out, void* d_ws) {
    p.x = (const float*)d_in[0]; p.p = (const float*)d_in[1]; p.pos = (const int*)d_in[2];
    const float** w = &p.attn_g; for (int i = 3; i < 32; ++i) w[i - 3] = (const float*)d_in[i];
    p.out = (float*)d_out; p.B = 8; p.S = 2048; p.T = 16384; p.NSLOT = 2 * 16384 + 8 * 256;
    carve(p, (unsigned char*)d_ws);
}
extern "C" void kernel_launch(void* const* d_in, const int* in_sizes, int n_in, void* d_out, int out_size, void* d_ws, size_t ws_size, hipStream_t stream) {
    static int grid = 0;
    if (grid == 0) {
        MP q{}; q.T = 16384; q.NSLOT = 2 * 16384 + 8 * 256; const size_t need = carve(q, nullptr);
        if (n_in != 32 || ws_size < need) { fprintf(stderr, "kernel_launch: need %zu bytes of ws, have %zu (n_in %d)\n", need, ws_size, n_in); grid = -1; return; }
        int dev = 0, cus = 0, per_cu = 0;
        if (hipGetDevice(&dev) != hipSuccess || hipDeviceGetAttribute(&cus, hipDeviceAttributeMultiprocessorCount, dev) != hipSuccess) { grid = -1; return; }
        if (hipFuncSetAttribute((const void*)mk_fwd, hipFuncAttributeMaxDynamicSharedMemorySize, LDS_BYTES) != hipSuccess) { fprintf(stderr, "kernel_launch: hipFuncSetAttribute failed\n"); grid = -1; return; }
        if (hipOccupancyMaxActiveBlocksPerMultiprocessor(&per_cu, (const void*)mk_fwd, NTHR, LDS_BYTES) != hipSuccess || per_cu < 1) { fprintf(stderr, "kernel_launch: occupancy query says %d\n", per_cu); }
        (void)hipGetLastError();
        grid = cus;
    }
    if (grid < 0) return;
    Args a{}; fill_params(a.p, d_in, d_out, d_ws); a.flags = 0;
    if (hipMemsetAsync(a.p.ctl, 0, CTL_WORDS * 4, stream) != hipSuccess) return;
    hipLaunchKernelGGL(mk_fwd, dim3(grid), dim3(NTHR), LDS_BYTES, stream, a);
}
```

```cpp
#include <hip/hip_runtime.h>
#include <cstdio>
#include <cstdint>
__device__ __forceinline__ int mk_tid() { int t = threadIdx.x; asm volatile("" : "+v"(t)); return t; }

#include <cstring>
#include <cmath>
#include <cstdint>
#ifdef __HIPCC__
#define HD __host__ __device__ __forceinline__
#else
#define HD inline
#endif
typedef unsigned short bf16;
namespace mdl {
constexpr int D = 1024, DEPTH = 4, NU = 2560, NUO = 2472, DFF = 3584, NGU = 7168, NE = 8, PLE = 256;
constexpr int CK = 31, SCONV = 4, CHUNK = 128, NH = 8, HP = 64, NS = 128;
constexpr float RMS_EPS = 1e-6f, LN_EPS = 1e-5f;
constexpr float QSCALE = 0.10206207261596577f * 1.4426950408889634f;
constexpr int U_Z = 512, U_XBC = 1024, U_CQ = 2048, U_CKV = 2304, U_KR = 2432, U_DT = 2464;

HD float bf2f(bf16 v) { unsigned u = (unsigned)v << 16; float f; memcpy(&f, &u, 4); return f; }
HD bf16 f2bf(float f) { unsigned u; memcpy(&u, &f, 4); u += 0x7fffu + ((u >> 16) & 1u); return (bf16)(u >> 16); }
HD float sigmoidf_(float x) { return 1.0f / (1.0f + expf(-x)); }
HD float siluf_(float x) { return x / (1.0f + expf(-x)); }
HD float softplusf_(float x) { return x > 20.f ? x : log1pf(expf(x)); }
HD int ucol_src(int n) { return n < 2048 ? n : (n < U_DT ? n + 8 : (n < NUO ? n - U_DT + 2048 : -1)); }

struct MP {
    const float *x, *p; const int* pos;
    const float *attn_g, *w_in, *cdw_w, *cdw_b, *cln_g, *cln_b, *sconv_w, *sconv_b, *dt_bias, *a_log, *dskip, *snorm_g, *qn_g, *w_uq, *kvn_g, *w_ukv,
        *w_out, *ffn_g, *dwg, *dwu, *dwd, *router, *mwg, *mwu, *mwd, *ple_g, *ple_wg, *ple_wp, *fin_g;
    float* out;
    long B, S, T, NSLOT;
    unsigned* ctl;
    bf16 *WIN, *WUQ, *WUKV, *WOUT, *DWGU, *DWD, *MWGU, *MWD, *WPG, *WPP;
    float *RSSP, *H, *CS, *DT, *ACS, *ST, *CB, *YPRE, *TOPG;
    bf16 *HB2, *HB, *U, *YC, *Q, *KK, *V, *XS, *BM, *CM, *YD, *PV, *PB16, *PJ, *ACT, *XB, *YS;
    int *TOPE, *POS, *TOKSLOT, *TILE_E, *BCNT;
};
constexpr int CTL_WORDS = 65536;
HD unsigned* cnt_ptr(const MP& p, int j) { return p.ctl + 1024 + j * 64; }
HD float* rss_ptr(const MP& p, int L, int k) { return p.RSSP + (size_t)(L * 3 + k) * p.T * 16; }

inline size_t carve(MP& p, unsigned char* ws) {
    size_t o = 0; const size_t T = p.T, NSL = p.NSLOT;
    auto take = [&](size_t bytes) { size_t r = o; o += (bytes + 255) & ~(size_t)255; return ws + r; };
    p.ctl = (unsigned*)take(CTL_WORDS * 4);
    p.WIN = (bf16*)take((size_t)DEPTH * NU * D * 2); p.WUQ = (bf16*)take((size_t)DEPTH * 512 * 256 * 2); p.WUKV = (bf16*)take((size_t)DEPTH * 512 * 128 * 2);
    p.WOUT = (bf16*)take((size_t)DEPTH * D * D * 2); p.DWGU = (bf16*)take((size_t)2 * NGU * D * 2); p.DWD = (bf16*)take((size_t)2 * D * DFF * 2);
    p.MWGU = (bf16*)take((size_t)2 * NE * NGU * D * 2); p.MWD = (bf16*)take((size_t)2 * NE * D * DFF * 2);
    p.WPG = (bf16*)take((size_t)DEPTH * D * D * 2); p.WPP = (bf16*)take((size_t)DEPTH * D * PLE * 2);
    p.RSSP = (float*)take((size_t)13 * T * 16 * 4); p.H = (float*)take(T * D * 4); p.HB = (bf16*)take(T * D * 2); p.HB2 = (bf16*)take(T * D * 2); p.CS = (float*)take(T * 32 * 4);
    p.PB16 = (bf16*)take((size_t)DEPTH * T * PLE * 2); p.PJ = (bf16*)take(T * D * 2);
    p.TOPE = (int*)take(T * 2 * 4); p.TOPG = (float*)take(T * 2 * 4); p.POS = (int*)take(T * 2 * 4); p.TOKSLOT = (int*)take(T * 2 * 4); p.TILE_E = (int*)take(1024 * 4); p.BCNT = (int*)take(1024 * NE * 4);
    p.XB = (bf16*)take(NSL * D * 2); p.YS = p.XB;
    const size_t r1 = o;
    p.U = (bf16*)take(T * NU * 2); p.YC = (bf16*)take(T * D * 2); p.Q = (bf16*)take(T * 384 * 2); p.KK = (bf16*)take(T * 384 * 2); p.V = (bf16*)take(T * 256 * 2);
    p.XS = (bf16*)take(T * 512 * 2); p.BM = (bf16*)take(T * 256 * 2); p.CM = (bf16*)take(T * 256 * 2); p.YD = (bf16*)take(T * 512 * 2);
    p.DT = (float*)take(T * 8 * 4); p.ACS = (float*)take(T * 8 * 4); p.ST = (float*)take(T / CHUNK * NH * HP * NS * 4); p.PV = (bf16*)take(T / CHUNK * NH * HP * NS * 2);
    p.CB = nullptr; p.YPRE = nullptr;
    const size_t r1end = o; o = r1;
    p.ACT = (bf16*)take(NSL * DFF * 2);
    if (o < r1end) o = r1end;
    return o;
}

struct V8 { float v[8]; };
HD V8 ld8(const bf16* p) { V8 r; const uint4 u = *(const uint4*)p; const unsigned w[4] = {u.x, u.y, u.z, u.w};
    for (int i = 0; i < 4; ++i) { r.v[2 * i] = bf2f((bf16)(w[i] & 0xffff)); r.v[2 * i + 1] = bf2f((bf16)(w[i] >> 16)); } return r; }
HD float dot8(const V8& a, const V8& b) { float s = 0.f; for (int i = 0; i < 8; ++i) s += a.v[i] * b.v[i]; return s; }

template <class Epi> HD void gemm_nt(const bf16* A, long lda, const bf16* Bt, long ldb, long M, long N, long K, const Epi& epi, long g0, long gs) {
    const long ntn = N / 4, ntile = (M / 4) * ntn;
    for (long t = g0; t < ntile; t += gs) {
        const long m0 = (t / ntn) * 4, n0 = (t % ntn) * 4; float acc[4][4];
        for (int i = 0; i < 4; ++i) for (int j = 0; j < 4; ++j) acc[i][j] = 0.f;
        for (long k = 0; k < K; k += 8) { V8 a0 = ld8(A + (m0 + 0) * lda + k), a1 = ld8(A + (m0 + 1) * lda + k), a2 = ld8(A + (m0 + 2) * lda + k), a3 = ld8(A + (m0 + 3) * lda + k);
            V8 b0 = ld8(Bt + (n0 + 0) * ldb + k), b1 = ld8(Bt + (n0 + 1) * ldb + k), b2 = ld8(Bt + (n0 + 2) * ldb + k), b3 = ld8(Bt + (n0 + 3) * ldb + k);
            acc[0][0] += dot8(a0, b0); acc[0][1] += dot8(a0, b1); acc[0][2] += dot8(a0, b2); acc[0][3] += dot8(a0, b3);
            acc[1][0] += dot8(a1, b0); acc[1][1] += dot8(a1, b1); acc[1][2] += dot8(a1, b2); acc[1][3] += dot8(a1, b3);
            acc[2][0] += dot8(a2, b0); acc[2][1] += dot8(a2, b1); acc[2][2] += dot8(a2, b2); acc[2][3] += dot8(a2, b3);
            acc[3][0] += dot8(a3, b0); acc[3][1] += dot8(a3, b1); acc[3][2] += dot8(a3, b2); acc[3][3] += dot8(a3, b3); }
        epi(m0 + 0, n0 + 0, acc[0][0]); epi(m0 + 0, n0 + 1, acc[0][1]); epi(m0 + 0, n0 + 2, acc[0][2]); epi(m0 + 0, n0 + 3, acc[0][3]);
        epi(m0 + 1, n0 + 0, acc[1][0]); epi(m0 + 1, n0 + 1, acc[1][1]); epi(m0 + 1, n0 + 2, acc[1][2]); epi(m0 + 1, n0 + 3, acc[1][3]);
        epi(m0 + 2, n0 + 0, acc[2][0]); epi(m0 + 2, n0 + 1, acc[2][1]); epi(m0 + 2, n0 + 2, acc[2][2]); epi(m0 + 2, n0 + 3, acc[2][3]);
        epi(m0 + 3, n0 + 0, acc[3][0]); epi(m0 + 3, n0 + 1, acc[3][1]); epi(m0 + 3, n0 + 2, acc[3][2]); epi(m0 + 3, n0 + 3, acc[3][3]);
    }
}
struct EpiStoreBf { bf16* C; long ldc; HD void operator()(long m, long n, float v) const { C[m * ldc + n] = f2bf(v); } };
struct EpiAddF32 { float* C; long ldc; HD void operator()(long m, long n, float v) const { C[m * ldc + n] += v; } };
struct EpiPle { float* H; const bf16* PJ; HD void operator()(long m, long n, float v) const { H[m * D + n] += bf2f(PJ[m * D + n]) * sigmoidf_(v); } };

HD void tr_elem(const float* W, long K, long N, bf16* WT, long i) { const long n = i / K, k = i % K; WT[i] = f2bf(W[k * N + n]); }
HD void nv_prologue(const MP& p, long g0, long gs) {
    const long T = p.T;
    for (long i = g0; i < (long)DEPTH * NU * D; i += gs) { const long l = i / ((long)NU * D), r = i % ((long)NU * D), n = r / D, k = r % D; const int c = ucol_src((int)n);
        p.WIN[i] = c < 0 ? (bf16)0 : f2bf(p.w_in[(l * D + k) * NUO + c]); }
    for (long i = g0; i < (long)DEPTH * 512 * 256; i += gs) { const long l = i / (512 * 256), r = i % (512 * 256), n = r / 256, k = r % 256; p.WUQ[i] = n < 384 ? f2bf(p.w_uq[(l * 256 + k) * 384 + n]) : (bf16)0; }
    for (long i = g0; i < (long)DEPTH * 512 * 128; i += gs) { const long l = i / (512 * 128), r = i % (512 * 128), n = r / 128, k = r % 128; p.WUKV[i] = f2bf(p.w_ukv[(l * 128 + k) * 512 + n]); }
    for (long i = g0; i < (long)DEPTH * D * D; i += gs) { const long l = i / ((long)D * D); tr_elem(p.w_out + l * D * D, D, D, p.WOUT + l * D * D, i % ((long)D * D)); tr_elem(p.ple_wg + l * D * D, D, D, p.WPG + l * D * D, i % ((long)D * D)); }
    for (long i = g0; i < (long)DEPTH * D * PLE; i += gs) { const long l = i / ((long)D * PLE); tr_elem(p.ple_wp + l * PLE * D, PLE, D, p.WPP + l * D * PLE, i % ((long)D * PLE)); }
    for (long i = g0; i < (long)18 * NGU * D; i += gs) { const long mt = i / ((long)NGU * D), r = i % ((long)NGU * D), n = r / D, k = r % D, tl = n / 256, rr = n % 256, col = tl * 128 + (rr & 127);
        const float* src; bf16* dst;
        if (mt < 2) { src = (rr < 128 ? p.dwg : p.dwu) + mt * (long)D * DFF; dst = p.DWGU + mt * (long)NGU * D; } else { src = (rr < 128 ? p.mwg : p.mwu) + (mt - 2) * (long)D * DFF; dst = p.MWGU + (mt - 2) * (long)NGU * D; }
        dst[r] = f2bf(src[k * DFF + col]); }
    for (long i = g0; i < (long)18 * D * DFF; i += gs) { const long mt = i / ((long)D * DFF), r = i % ((long)D * DFF);
        if (mt < 2) tr_elem(p.dwd + mt * (long)DFF * D, DFF, D, p.DWD + mt * (long)D * DFF, r); else tr_elem(p.mwd + (mt - 2) * (long)DFF * D, DFF, D, p.MWD + (mt - 2) * (long)D * DFF, r); }
    for (long i = g0; i < T * D; i += gs) p.H[i] = p.x[i];
    for (long i = g0; i < (long)DEPTH * T * PLE; i += gs) p.PB16[i] = f2bf(p.p[i]);
    for (long i = g0; i < T * 16; i += gs) { const long t = i / 16; const int j = (int)(i % 16); const float inv = powf(10000.0f, -(float)(2 * j) / 32.0f), ang = (float)p.pos[t] * inv;
        p.CS[t * 32 + j] = cosf(ang); p.CS[t * 32 + 16 + j] = sinf(ang); }
}
HD void nv_norm(const MP& p, const float* g, long g0, long gs) {
    for (long t = g0; t < p.T; t += gs) { const float* h = p.H + t * D; float ss = 0.f; for (int i = 0; i < D; ++i) ss += h[i] * h[i];
        const float r = 1.0f / sqrtf(ss / D + RMS_EPS); for (int i = 0; i < D; ++i) p.HB[t * D + i] = f2bf(h[i] * r * g[i]); }
}
HD void nv_inproj(const MP& p, int L, long g0, long gs) {
    gemm_nt(p.HB, D, p.WIN + (long)L * NU * D, D, p.T, NU, D, EpiStoreBf{p.U, NU}, g0, gs);
    gemm_nt(p.PB16 + (long)L * p.T * PLE, PLE, p.WPP + (long)L * D * PLE, PLE, p.T, D, PLE, EpiStoreBf{p.PJ, D}, g0, gs);
}
HD float cm_conv(const MP& p, int L, long b, long s, int c) {
    float acc = p.cdw_b[L * 256 + c];
    for (int j = 0; j < CK; ++j) { const long sp = s - (CK - 1) + j; if (sp < 0) continue; const bf16* u = p.U + (b * p.S + sp) * NU;
        acc += p.cdw_w[(L * CK + j) * 256 + c] * (bf2f(u[c]) * sigmoidf_(bf2f(u[256 + c]))); }
    return acc;
}
HD void nv_mixA1(const MP& p, int L, long g0, long gs, int parts = 15) {
    const long T = p.T, S = p.S;
    if (parts & 1) for (long i = g0; i < T * 4; i += gs) { const long t = i / 4, b = t / S, s = t % S; const int gq = (int)(i % 4);
        float sm = 0.f, sq = 0.f; for (int c = 0; c < 64; ++c) { const float v = cm_conv(p, L, b, s, gq * 64 + c); sm += v; sq += v * v; }
        const float mu = sm / 64.f; float var = sq / 64.f - mu * mu; if (var < 0.f) var = 0.f; const float rs = 1.0f / sqrtf(var + LN_EPS);
        for (int c = 0; c < 64; ++c) { const int ch = gq * 64 + c; const float v = (cm_conv(p, L, b, s, ch) - mu) * rs * p.cln_g[L * 256 + ch] + p.cln_b[L * 256 + ch]; p.YC[t * D + ch] = f2bf(siluf_(v)); } }
    if (parts & 2) for (long i = g0; i < T * 1024; i += gs) { const long t = i / 1024, b = t / S, s = t % S; const int c = (int)(i % 1024);
        float acc = p.sconv_b[L * 1024 + c]; for (int j = 0; j < SCONV; ++j) { const long sp = s - (SCONV - 1) + j; if (sp < 0) continue; acc += p.sconv_w[(L * SCONV + j) * 1024 + c] * bf2f(p.U[(b * S + sp) * NU + U_XBC + c]); }
        const bf16 v = f2bf(siluf_(acc)); if (c < 512) p.XS[t * 512 + c] = v; else if (c < 768) p.BM[t * 256 + c - 512] = v; else p.CM[t * 256 + c - 768] = v; }
    if (parts & 2) for (long i = g0; i < T * 8; i += gs) { const long t = i / 8; const int h = (int)(i % 8); p.DT[i] = softplusf_(bf2f(p.U[t * NU + U_DT + h]) + p.dt_bias[L * 8 + h]); }
    if (parts & 8) for (long i = g0; i < T * 4 * 80; i += gs) { const long t = i / 320; const int h = (int)((i % 320) / 80), ii = (int)(i % 80); const bf16* cq = p.U + t * NU + U_CQ;
        float ss = 0.f; for (int k = 0; k < 256; ++k) { const float v = bf2f(cq[k]); ss += v * v; } const float r = 1.0f / sqrtf(ss / 256.f + RMS_EPS);
        const bf16* W = p.WUQ + (long)L * 512 * 256;
        if (ii < 64) { const int n = h * 96 + ii; float a = 0.f; for (int k = 0; k < 256; ++k) a += bf2f(f2bf(bf2f(cq[k]) * r * p.qn_g[L * 256 + k])) * bf2f(W[n * 256 + k]); p.Q[t * 384 + n] = f2bf(a * QSCALE); }
        else { const int j = ii - 64, n1 = h * 96 + 64 + j, n2 = n1 + 16; float a1 = 0.f, a2 = 0.f;
            for (int k = 0; k < 256; ++k) { const float xv = bf2f(f2bf(bf2f(cq[k]) * r * p.qn_g[L * 256 + k])); a1 += xv * bf2f(W[n1 * 256 + k]); a2 += xv * bf2f(W[n2 * 256 + k]); }
            const float c = p.CS[t * 32 + j], sn = p.CS[t * 32 + 16 + j]; p.Q[t * 384 + n1] = f2bf((a1 * c - a2 * sn) * QSCALE); p.Q[t * 384 + n2] = f2bf((a1 * sn + a2 * c) * QSCALE); } }
    if (parts & 8) for (long i = g0; i < T * 512; i += gs) { const long t = i / 512; const int n = (int)(i % 512); const bf16* ck = p.U + t * NU + U_CKV;
        float ss = 0.f; for (int k = 0; k < 128; ++k) { const float v = bf2f(ck[k]); ss += v * v; } const float r = 1.0f / sqrtf(ss / 128.f + RMS_EPS);
        const bf16* W = p.WUKV + (long)L * 512 * 128; float a = 0.f; for (int k = 0; k < 128; ++k) a += bf2f(f2bf(bf2f(ck[k]) * r * p.kvn_g[L * 128 + k])) * bf2f(W[n * 128 + k]);
        const int h = n / 128, d = n % 128; if (d < 64) p.KK[t * 384 + h * 96 + d] = f2bf(a); else p.V[t * 256 + h * 64 + d - 64] = f2bf(a); }
    if (parts & 8) for (long i = g0; i < T * 16; i += gs) { const long t = i / 16; const int j = (int)(i % 16); const float x1 = bf2f(p.U[t * NU + U_KR + j]), x2 = bf2f(p.U[t * NU + U_KR + 16 + j]), c = p.CS[t * 32 + j], sn = p.CS[t * 32 + 16 + j];
        const bf16 o1 = f2bf(x1 * c - x2 * sn), o2 = f2bf(x1 * sn + x2 * c); for (int h = 0; h < 4; ++h) { p.KK[t * 384 + h * 96 + 64 + j] = o1; p.KK[t * 384 + h * 96 + 80 + j] = o2; } }
}
HD void nv_mixA2(const MP& p, int L, long g0, long gs) {
    const long NC = p.T / CHUNK;
    for (long i = g0; i < NC * 8; i += gs) { const long c = i / 8; const int h = (int)(i % 8); const float a = -expf(p.a_log[L * 8 + h]); float cs = 0.f;
        for (int l = 0; l < CHUNK; ++l) { const long t = c * CHUNK + l; cs += p.DT[t * 8 + h] * a; p.ACS[t * 8 + h] = cs; } }
}
HD void nv_mixA3a(const MP& p, long g0, long gs) {
    const long NC = p.T / CHUNK;
    for (long i = g0; i < NC * 2 * CHUNK * CHUNK; i += gs) { const long u = i / (CHUNK * CHUNK), c = u / 2; const int g = (int)(u % 2), l = (int)((i / CHUNK) % CHUNK), s = (int)(i % CHUNK);
        const bf16* cm = p.CM + (c * CHUNK + l) * 256 + g * 128; const bf16* bm = p.BM + (c * CHUNK + s) * 256 + g * 128; float a = 0.f; for (int n = 0; n < 128; ++n) a += bf2f(cm[n]) * bf2f(bm[n]); p.CB[i] = a; }
}
HD void nv_mixA3b(const MP& p, long g0, long gs) {
    const long T = p.T, NC = T / CHUNK;
    for (long i = g0; i < T * 512; i += gs) { const long t = i / 512, c = t / CHUNK; const int ch = (int)(i % 512), h = ch / 64, g = h / 4, l = (int)(t % CHUNK);
        const float* cb = p.CB + ((c * 2 + g) * CHUNK + l) * CHUNK; const float al = p.ACS[t * 8 + h]; float a = 0.f;
        for (int s = 0; s <= l; ++s) { const long ts = c * CHUNK + s; a += cb[s] * expf(al - p.ACS[ts * 8 + h]) * p.DT[ts * 8 + h] * bf2f(p.XS[ts * 512 + ch]); }
        p.YD[i] = f2bf(a); }
    for (long i = g0; i < NC * 8 * 64 * 128; i += gs) { const long c = i / (8 * 64 * 128); const int h = (int)((i / (64 * 128)) % 8), pp = (int)((i / 128) % 64), n = (int)(i % 128), g = h / 4;
        const float alast = p.ACS[(c * CHUNK + CHUNK - 1) * 8 + h]; float a = 0.f;
        for (int l = 0; l < CHUNK; ++l) { const long t = c * CHUNK + l; a += bf2f(p.BM[t * 256 + g * 128 + n]) * expf(alast - p.ACS[t * 8 + h]) * p.DT[t * 8 + h] * bf2f(p.XS[t * 512 + h * 64 + pp]); }
        p.ST[i] = a; }
}
HD void nv_mixB1(const MP& p, long g0, long gs) {
    const long NCB = p.S / CHUNK;
    for (long i = g0; i < p.B * 8 * 64 * 128; i += gs) { const long b = i / (8 * 64 * 128); const long r = i % (8 * 64 * 128); const int h = (int)(r / (64 * 128)); float carry = 0.f;
        for (long cc = 0; cc < NCB; ++cc) { const long c = b * NCB + cc; const long idx = c * (8 * 64 * 128) + r; p.PV[idx] = f2bf(carry); carry = carry * expf(p.ACS[(c * CHUNK + CHUNK - 1) * 8 + h]) + p.ST[idx]; } }
}
HD void nv_attn(const MP& p, long g0, long gs) {
    const long T = p.T, S = p.S;
    for (long i = g0; i < T * 4; i += gs) { const long t = i / 4, b = t / S, s = t % S; const int h = (int)(i % 4);
        float q[96], o[64]; for (int d = 0; d < 96; ++d) q[d] = bf2f(p.Q[t * 384 + h * 96 + d]); for (int d = 0; d < 64; ++d) o[d] = 0.f; float m = -1e30f, l = 0.f;
        for (long k = 0; k <= s; ++k) { const long tk = b * S + k; const bf16* kk = p.KK + tk * 384 + h * 96; float sc = 0.f; for (int d = 0; d < 96; ++d) sc += q[d] * bf2f(kk[d]);
            const float mn = sc > m ? sc : m, f = exp2f(m - mn), pr = exp2f(sc - mn); l = l * f + pr; const bf16* vv = p.V + tk * 256 + h * 64; for (int d = 0; d < 64; ++d) o[d] = o[d] * f + pr * bf2f(vv[d]); m = mn; }
        for (int d = 0; d < 64; ++d) p.YC[t * D + 768 + h * 64 + d] = f2bf(o[d] / l); }
}
HD void nv_mixC1(const MP& p, int L, long g0, long gs) {
    const long T = p.T;
    for (long i = g0; i < T * 512; i += gs) { const long t = i / 512, c = t / CHUNK; const int ch = (int)(i % 512), h = ch / 64, pp = ch % 64, g = h / 4;
        const bf16* cm = p.CM + t * 256 + g * 128; const bf16* pv = p.PV + ((c * 8 + h) * 64 + pp) * 128; float a = 0.f; for (int n = 0; n < 128; ++n) a += bf2f(cm[n]) * bf2f(pv[n]);
        const float y = a * expf(p.ACS[t * 8 + h]) + bf2f(p.YD[i]) + p.dskip[L * 8 + h] * bf2f(p.XS[i]); p.YPRE[i] = y * siluf_(bf2f(p.U[t * NU + U_Z + ch])); }
}
HD void nv_mixC2(const MP& p, int L, long g0, long gs) {
    for (long i = g0; i < p.T * 2; i += gs) { const long t = i / 2; const int g = (int)(i % 2); const float* y = p.YPRE + t * 512 + g * 256; float ss = 0.f; for (int k = 0; k < 256; ++k) ss += y[k] * y[k];
        const float r = 1.0f / sqrtf(ss / 256.f + RMS_EPS); for (int k = 0; k < 256; ++k) p.YC[t * D + 256 + g * 256 + k] = f2bf(y[k] * r * p.snorm_g[L * 512 + g * 256 + k]); }
}
HD void nv_outproj(const MP& p, int L, long g0, long gs) { gemm_nt(p.YC, D, p.WOUT + (long)L * D * D, D, p.T, D, D, EpiAddF32{p.H, D}, g0, gs); }
HD void nv_router(const MP& p, int L, long g0, long gs) {
    const int j = L / 2; const float* R = p.router + (long)j * D * NE; const float* g = p.ffn_g + L * D; unsigned* cnt = cnt_ptr(p, j);
    for (long t = g0; t < p.T; t += gs) { const float* h = p.H + t * D; float ss = 0.f; for (int i = 0; i < D; ++i) ss += h[i] * h[i]; const float r = 1.0f / sqrtf(ss / D + RMS_EPS);
        float lg[NE]; for (int e = 0; e < NE; ++e) lg[e] = 0.f; for (int i = 0; i < D; ++i) { const float v = h[i] * r * g[i]; for (int e = 0; e < NE; ++e) lg[e] += v * R[i * NE + e]; }
        int e0 = 0; float v0 = lg[0]; for (int e = 1; e < NE; ++e) if (lg[e] > v0) { v0 = lg[e]; e0 = e; }
        int e1 = -1; float v1 = -3.0e38f; for (int e = 0; e < NE; ++e) if (e != e0 && lg[e] > v1) { v1 = lg[e]; e1 = e; }
        const float g1 = 1.0f / (1.0f + expf(v0 - v1)), gg0 = 1.0f - g1; p.TOPE[t * 2] = e0; p.TOPE[t * 2 + 1] = e1; p.TOPG[t * 2] = gg0; p.TOPG[t * 2 + 1] = g1;
#ifdef __HIP_DEVICE_COMPILE__
        p.POS[t * 2] = (int)atomicAdd(cnt + e0, 1u); p.POS[t * 2 + 1] = (int)atomicAdd(cnt + e1, 1u);
#else
        p.POS[t * 2] = (int)__atomic_fetch_add(cnt + e0, 1u, __ATOMIC_RELAXED); p.POS[t * 2 + 1] = (int)__atomic_fetch_add(cnt + e1, 1u, __ATOMIC_RELAXED);
#endif
    }
}
HD int moe_start_of(const MP& p, int j, int E) { const unsigned* cnt = cnt_ptr(p, j); int o = 0; for (int e = 0; e < NE; ++e) if (e < E) o += (int)((cnt[e] + 255u) / 256u) * 256; return o; }
HD void nv_moeplan(const MP& p, int L, long g0, long gs) {
    const int j = L / 2;
    for (long i = g0; i < p.T * 2; i += gs) { const long t = i / 2; const int slot = moe_start_of(p, j, p.TOPE[i]) + p.POS[i]; p.TOKSLOT[i] = slot; for (int k = 0; k < D; ++k) p.XB[(long)slot * D + k] = p.HB[t * D + k]; }
    for (long i = g0; i < 1024; i += gs) { int e = -1; if (i * 256 < moe_start_of(p, j, NE)) { e = 0; for (int q = 1; q < NE; ++q) if (i * 256 >= moe_start_of(p, j, q)) e = q; } p.TILE_E[i] = e; }
}
HD void nv_gateup(const MP& p, int L, long g0, long gs) {
    const int j = L / 2; const bool moe = L & 1; long rows = p.T; const bf16* Ain = p.HB;
    if (moe) { rows = moe_start_of(p, j, NE); Ain = p.XB; }
    for (long i = g0; i < (rows / 4) * DFF; i += gs) { const long m0 = (i / DFF) * 4; const int jj = (int)(i % DFF); const int e = moe ? p.TILE_E[m0 / 256] : 0;
        const bf16* W = moe ? p.MWGU + ((long)j * NE + e) * NGU * D : p.DWGU + (long)j * NGU * D; const long rg = (jj / 128) * 256 + (jj % 128), ru = rg + 128; float ag[4] = {0, 0, 0, 0}, au[4] = {0, 0, 0, 0};
        for (int k = 0; k < D; k += 8) { const V8 wg = ld8(W + rg * D + k), wu = ld8(W + ru * D + k); for (int r = 0; r < 4; ++r) { const V8 a = ld8(Ain + (m0 + r) * D + k); ag[r] += dot8(a, wg); au[r] += dot8(a, wu); } }
        for (int r = 0; r < 4; ++r) p.ACT[(m0 + r) * DFF + jj] = f2bf(siluf_(ag[r]) * au[r]); }
}
struct EpiYs { bf16* C; HD void operator()(long m, long n, float v) const { C[m * D + n] = f2bf(v); } };
HD void nv_down(const MP& p, int L, long g0, long gs) {
    const int j = L / 2;
    if (!(L & 1)) { gemm_nt(p.ACT, DFF, p.DWD + (long)j * D * DFF, DFF, p.T, D, DFF, EpiAddF32{p.H, D}, g0, gs); return; }
    const long rows = moe_start_of(p, j, NE);
    for (long tl = 0; tl < rows / 256; ++tl) { const int e = p.TILE_E[tl]; gemm_nt(p.ACT + tl * 256 * DFF, DFF, p.MWD + ((long)j * NE + e) * D * DFF, DFF, 256, D, DFF, EpiYs{p.YS + tl * 256 * D}, g0, gs); }
}
HD void nv_norm3(const MP& p, int L, long g0, long gs) {
    const float* g = p.ple_g + L * D;
    for (long t = g0; t < p.T; t += gs) { float* h = p.H + t * D;
        if (L & 1) { const bf16* y0 = p.YS + (long)p.TOKSLOT[t * 2] * D; const bf16* y1 = p.YS + (long)p.TOKSLOT[t * 2 + 1] * D; const float a = p.TOPG[t * 2], b = p.TOPG[t * 2 + 1]; for (int i = 0; i < D; ++i) h[i] += a * bf2f(y0[i]) + b * bf2f(y1[i]); }
        float ss = 0.f; for (int i = 0; i < D; ++i) ss += h[i] * h[i]; const float r = 1.0f / sqrtf(ss / D + RMS_EPS); for (int i = 0; i < D; ++i) p.HB[t * D + i] = f2bf(h[i] * r * g[i]); }
}
HD void nv_ple(const MP& p, int L, long g0, long gs) { gemm_nt(p.HB, D, p.WPG + (long)L * D * D, D, p.T, D, D, EpiPle{p.H, p.PJ}, g0, gs); }
HD void nv_final(const MP& p, long g0, long gs) {
    for (long t = g0; t < p.T; t += gs) { const float* h = p.H + t * D; float ss = 0.f; for (int i = 0; i < D; ++i) ss += h[i] * h[i]; const float r = 1.0f / sqrtf(ss / D + RMS_EPS); for (int i = 0; i < D; ++i) p.out[t * D + i] = h[i] * r * p.fin_g[i]; }
}
enum { NV_PROLOGUE = 0, NV_NORM1, NV_INPROJ, NV_A1, NV_A2, NV_A3A, NV_A3B, NV_B1, NV_ATTN, NV_C1, NV_C2, NV_OUTPROJ, NV_NORM2, NV_ROUTER, NV_MOEPLAN, NV_GATEUP, NV_DOWN, NV_NORM3, NV_PLE, NV_FINAL, NV_NPH };
HD void nv_run(const MP& p, int ph, int L, long g0, long gs) {
    switch (ph) {
    case NV_PROLOGUE: nv_prologue(p, g0, gs); break; case NV_NORM1: nv_norm(p, p.attn_g + L * D, g0, gs); break; case NV_INPROJ: nv_inproj(p, L, g0, gs); break;
    case NV_A1: nv_mixA1(p, L, g0, gs); break; case NV_A2: nv_mixA2(p, L, g0, gs); break; case NV_A3A: nv_mixA3a(p, g0, gs); break; case NV_A3B: nv_mixA3b(p, g0, gs); break;
    case NV_B1: nv_mixB1(p, g0, gs); break; case NV_ATTN: nv_attn(p, g0, gs); break; case NV_C1: nv_mixC1(p, L, g0, gs); break; case NV_C2: nv_mixC2(p, L, g0, gs); break;
    case NV_OUTPROJ: nv_outproj(p, L, g0, gs); break; case NV_NORM2: nv_norm(p, p.ffn_g + L * D, g0, gs); break; case NV_ROUTER: if (L & 1) nv_router(p, L, g0, gs); break;
    case NV_MOEPLAN: if (L & 1) nv_moeplan(p, L, g0, gs); break; case NV_GATEUP: nv_gateup(p, L, g0, gs); break; case NV_DOWN: nv_down(p, L, g0, gs); break;
    case NV_NORM3: nv_norm3(p, L, g0, gs); break; case NV_PLE: nv_ple(p, L, g0, gs); break; case NV_FINAL: nv_final(p, g0, gs); break; }
}
}

namespace pg8 {
#define PG8_LAS __attribute__((address_space(3)))
typedef unsigned short bf16_t;
typedef short bf16x8 __attribute__((ext_vector_type(8)));
typedef float f32x4 __attribute__((ext_vector_type(4)));
typedef unsigned u32x4 __attribute__((ext_vector_type(4)));
constexpr int BM = 256, BK = 64, HALF = 128, HTB = HALF * BK * 2  , STAGE_BYTES = 8 * HTB, NXCD = 8, WGM = 8;

__host__ __device__ __forceinline__ int lds_byte(int r, int c) { const int st = (r >> 4) * 2 + (c >> 5), rr = r & 15, cc = c & 31, ob = rr * 64 + cc * 2; return st * 1024 + (ob ^ (((ob >> 9) & 1) << 5)); }
__host__ __device__ __forceinline__ void stage_rc(int b, int& R, int& C) { const int st = b / 1024, sb = b % 1024, swz = sb ^ (((sb >> 9) & 1) << 5); R = (st >> 1) * 16 + swz / 64; C = (st & 1) * 32 + (swz % 64) / 2; }
__host__ __device__ __forceinline__ int perm32(int rho) { const int n = rho >> 4, i = rho & 15; return 8 * (i >> 2) + 4 * n + (i & 3); }

struct Unit { int pm, pn, cn; };
struct Gemm { const bf16_t* A; const bf16_t* Bt; int M, N, K; };

struct StaticOrder {
    int nM, nN, nwg, G, c;
    __host__ __device__ void init(int M, int N, int G_, int c_) { nM = M / BM; nN = N / BM; nwg = nM * nN; G = G_; c = c_; }
    __host__ __device__ bool next(int i, Unit& u) const {
        const long L = (long)i * G + c; if (L >= nwg) return false;
        int wgid = (int)L; { const int q = nwg / NXCD, r = nwg % NXCD, xcd = wgid % NXCD, off = wgid / NXCD; wgid = (xcd < r ? xcd * (q + 1) : r * (q + 1) + (xcd - r) * q) + off; }
        const int nig = WGM * nN, gid = wgid / nig, fm = gid * WGM, gsz = (nM - fm) < WGM ? (nM - fm) : WGM;
        u.pm = fm + ((wgid % nig) % gsz); u.pn = (wgid % nig) / gsz; u.cn = u.pn; return true;
    }
    __device__ __forceinline__ void a_ready(const Unit&) const {}
    __device__ __forceinline__ void done(const Unit&) const {}
};
__device__ __forceinline__ unsigned cvt_pk_bf16(float lo, float hi) { unsigned r; asm volatile("v_cvt_pk_bf16_f32 %0, %1, %2" : "=v"(r) : "v"(lo), "v"(hi)); return r; }
typedef float f32x2 __attribute__((ext_vector_type(2)));
template <class Epi, class Sched, bool ALIGN_EPI = false, bool SP2 = false>
__device__ __forceinline__ void gemm_phase(PG8_LAS unsigned char* lds, const Gemm g, const Sched& S, const Epi& E) {
    const int tid = mk_tid(), wid = __builtin_amdgcn_readfirstlane(tid >> 6), lane = tid & 63, wr = wid >> 2, wc = wid & 3, fr = lane & 15, fq = lane >> 4;
    const int K = g.K, nt = K / BK;
    unsigned voffA[2], voffB[2];
#pragma unroll
    for (int i = 0; i < 2; ++i) { int R, C; stage_rc(tid * 16 + i * 8192, R, C); const int Rb = Epi::PERM ? ((R & ~31) + perm32(R & 31)) : R;
        voffA[i] = (unsigned)(R * K + C) * 2u; voffB[i] = (unsigned)(Rb * K + C) * 2u; }
    const size_t kstep = (size_t)(BK * 2);
    const size_t hstep = (size_t)HALF * K * 2;
    const size_t tstep = 2 * hstep;
    const unsigned ldsw = (unsigned)wid * 1024u;
    const int aoff = lds_byte(wr * 64 + fr, fq * 8), boff = lds_byte(wc * 32 + fr, fq * 8);
#define PG8_SA(b, h) (((b) * 2 + (h)) * HTB)
#define PG8_SB(b, h) ((4 + (b) * 2 + (h)) * HTB)
#define PG8_STAGE(bufoff, gbase, voff) do { _Pragma("unroll") for (int _i = 0; _i < 2; ++_i) \
        __builtin_amdgcn_global_load_lds((const unsigned*)((const char*)(gbase) + (voff)[_i]), (PG8_LAS unsigned*)(lds + (bufoff) + ldsw + _i * 8192), 16, 0, 0); } while (0)
#define PG8_LDA(dst, b, h) do { _Pragma("unroll") for (int m = 0; m < 4; ++m) _Pragma("unroll") for (int k = 0; k < 2; ++k) dst[m][k] = *(const PG8_LAS bf16x8*)(lds + PG8_SA(b, h) + aoff + m * 2048 + k * 1024); } while (0)
#define PG8_LDB(dst, b, h) do { _Pragma("unroll") for (int n = 0; n < 2; ++n) _Pragma("unroll") for (int k = 0; k < 2; ++k) dst[n][k] = *(const PG8_LAS bf16x8*)(lds + PG8_SB(b, h) + boff + n * 2048 + k * 1024); } while (0)
#define PG8_MMA(ai, bj, At, Bt) do { __builtin_amdgcn_s_setprio(1); _Pragma("unroll") for (int m = 0; m < 4; ++m) _Pragma("unroll") for (int n = 0; n < 2; ++n) _Pragma("unroll") for (int k = 0; k < 2; ++k) \
        acc[ai][bj][m][n] = __builtin_amdgcn_mfma_f32_16x16x32_bf16(Bt[n][k], At[m][k], acc[ai][bj][m][n], 0, 0, 0); __builtin_amdgcn_s_setprio(0); } while (0)
#define PG8_WAIT_V(n) asm volatile("s_waitcnt vmcnt(" #n ")" ::: "memory")
#define PG8_WAIT_L(n) asm volatile("s_waitcnt lgkmcnt(" #n ")" ::: "memory")
#define PG8_BAR __builtin_amdgcn_s_barrier()
#define PG8_SCHED __builtin_amdgcn_sched_barrier(0)
    Unit cur, nxt; int ui = 0;
    if (!S.next(0, cur)) return;
    f32x4 acc[2][2][4][2];
#pragma unroll
    for (int a = 0; a < 2; ++a)
#pragma unroll
        for (int b = 0; b < 2; ++b)
#pragma unroll
            for (int m = 0; m < 4; ++m)
#pragma unroll
                for (int n = 0; n < 2; ++n) acc[a][b][m][n] = (f32x4){0.f, 0.f, 0.f, 0.f};
    bf16x8 At[4][2], B0[2][2], B1[2][2];
    const char* cA = (const char*)g.A + (size_t)cur.pm * tstep; const char* cB = (const char*)g.Bt + (size_t)cur.pn * tstep;
    S.a_ready(cur);
    if constexpr (SP2) {
        PG8_STAGE(PG8_SB(0, 0), cB, voffB); PG8_STAGE(PG8_SB(0, 1), cB + hstep, voffB); PG8_STAGE(PG8_SA(0, 0), cA, voffA); PG8_STAGE(PG8_SA(0, 1), cA + hstep, voffA);
        if (wr == 1) PG8_BAR;
        PG8_WAIT_V(2); PG8_BAR;
        PG8_STAGE(PG8_SB(1, 0), cB + kstep, voffB); PG8_STAGE(PG8_SA(1, 0), cA + kstep, voffA); PG8_STAGE(PG8_SB(1, 1), cB + hstep + kstep, voffB);
        PG8_WAIT_V(6); PG8_BAR;
    } else {
        PG8_STAGE(PG8_SB(0, 0), cB, voffB); PG8_STAGE(PG8_SA(0, 0), cA, voffA); PG8_STAGE(PG8_SB(0, 1), cB + hstep, voffB); PG8_STAGE(PG8_SA(0, 1), cA + hstep, voffA);
        if (wr == 1) PG8_BAR;
        PG8_WAIT_V(4); PG8_BAR;
        PG8_STAGE(PG8_SB(1, 0), cB + kstep, voffB); PG8_STAGE(PG8_SA(1, 0), cA + kstep, voffA); PG8_STAGE(PG8_SB(1, 1), cB + hstep + kstep, voffB);
        PG8_WAIT_V(6); PG8_BAR;
    }
    for (;;) {
        const bool has_next = S.next(ui + 1, nxt);
        const char* nA = has_next ? (const char*)g.A + (size_t)nxt.pm * tstep : cA; const char* nB = has_next ? (const char*)g.Bt + (size_t)nxt.pn * tstep : cB;
        for (int t = 0; t < nt; t += 2) {
            const bool last = (t == nt - 2);
            const char* a1 = cA + (size_t)(t + 1) * kstep;
            const char* a2 = last ? nA : cA + (size_t)(t + 2) * kstep; const char* b2 = last ? nB : cB + (size_t)(t + 2) * kstep;
            const char* a3 = a2 + kstep; const char* b3 = b2 + kstep;
            if (last && has_next) S.a_ready(nxt);
            if constexpr (SP2) {
            PG8_LDB(B0, 0, 0); PG8_LDB(B1, 0, 1); PG8_SCHED; PG8_LDA(At, 0, 0); PG8_STAGE(PG8_SA(1, 1), a1 + hstep, voffA);
            PG8_WAIT_V(8); PG8_WAIT_L(0); PG8_BAR; PG8_MMA(0, 0, At, B0); PG8_MMA(0, 1, At, B1); PG8_BAR; PG8_SCHED;
            PG8_LDA(At, 0, 1); PG8_STAGE(PG8_SB(0, 0), b2, voffB); PG8_STAGE(PG8_SB(0, 1), b2 + hstep, voffB); PG8_STAGE(PG8_SA(0, 0), a2, voffA);
            PG8_WAIT_V(8); PG8_WAIT_L(0); PG8_BAR; PG8_MMA(1, 0, At, B0); PG8_MMA(1, 1, At, B1); PG8_BAR; PG8_SCHED;
            PG8_LDB(B0, 1, 0); PG8_LDB(B1, 1, 1); PG8_SCHED; PG8_LDA(At, 1, 0); PG8_STAGE(PG8_SA(0, 1), a2 + hstep, voffA);
            PG8_WAIT_V(8); PG8_WAIT_L(0); PG8_BAR; PG8_MMA(0, 0, At, B0); PG8_MMA(0, 1, At, B1); PG8_BAR; PG8_SCHED;
            PG8_LDA(At, 1, 1); PG8_STAGE(PG8_SB(1, 0), b3, voffB); PG8_STAGE(PG8_SB(1, 1), b3 + hstep, voffB); PG8_STAGE(PG8_SA(1, 0), a3, voffA);
            PG8_WAIT_V(8); PG8_WAIT_L(0); PG8_BAR; PG8_MMA(1, 0, At, B0); PG8_MMA(1, 1, At, B1); PG8_BAR; PG8_SCHED;
            } else {
            PG8_LDB(B0, 0, 0); PG8_SCHED; PG8_LDA(At, 0, 0); PG8_STAGE(PG8_SA(1, 1), a1 + hstep, voffA);
            PG8_WAIT_L(8); PG8_BAR; PG8_WAIT_L(0); PG8_MMA(0, 0, At, B0); PG8_BAR; PG8_SCHED;
            PG8_LDB(B1, 0, 1); PG8_STAGE(PG8_SB(0, 0), b2, voffB);
            PG8_BAR; PG8_WAIT_L(0); PG8_MMA(0, 1, At, B1); PG8_BAR;
            PG8_LDA(At, 0, 1); PG8_STAGE(PG8_SA(0, 0), a2, voffA);
            PG8_BAR; PG8_WAIT_L(0); PG8_MMA(1, 0, At, B0); PG8_BAR; PG8_SCHED;
            PG8_STAGE(PG8_SB(0, 1), b2 + hstep, voffB);
            PG8_WAIT_V(6); PG8_BAR; PG8_MMA(1, 1, At, B1); PG8_BAR;
            PG8_LDB(B0, 1, 0); PG8_SCHED; PG8_LDA(At, 1, 0); PG8_STAGE(PG8_SA(0, 1), a2 + hstep, voffA);
            PG8_WAIT_L(8); PG8_BAR; PG8_WAIT_L(0); PG8_MMA(0, 0, At, B0); PG8_BAR; PG8_SCHED;
            PG8_LDB(B1, 1, 1); PG8_STAGE(PG8_SB(1, 0), b3, voffB);
            PG8_BAR; PG8_WAIT_L(0); PG8_MMA(0, 1, At, B1); PG8_BAR;
            PG8_LDA(At, 1, 1); PG8_STAGE(PG8_SA(1, 0), a3, voffA);
            PG8_BAR; PG8_WAIT_L(0); PG8_MMA(1, 0, At, B0); PG8_BAR; PG8_SCHED;
            PG8_STAGE(PG8_SB(1, 1), b3 + hstep, voffB);
            PG8_WAIT_V(6); PG8_BAR; PG8_MMA(1, 1, At, B1); PG8_BAR;
            }
        }
        if constexpr (ALIGN_EPI) { if (wr == 0) PG8_BAR; }
        if constexpr (!Epi::AFTER_DRAIN) { E(acc, cur, wr, wc, fr, fq); S.done(cur); }
        if (!has_next) break;
#pragma unroll
        for (int a = 0; a < 2; ++a)
#pragma unroll
            for (int b = 0; b < 2; ++b)
#pragma unroll
                for (int m = 0; m < 4; ++m)
#pragma unroll
                    for (int n = 0; n < 2; ++n) acc[a][b][m][n] = (f32x4){0.f, 0.f, 0.f, 0.f};
        cur = nxt; cA = nA; cB = nB; ++ui;
        if constexpr (ALIGN_EPI) { if (wr == 1) PG8_BAR; }
    }
    PG8_WAIT_V(0);
    if constexpr (!ALIGN_EPI) { if (wr == 0) PG8_BAR; }
    PG8_BAR;
    if constexpr (Epi::AFTER_DRAIN) { E.fused(acc, cur, wr, wc, fr, fq, lds, wid, lane); S.done(cur); }
#undef PG8_SA
#undef PG8_SB
#undef PG8_STAGE
#undef PG8_LDA
#undef PG8_LDB
#undef PG8_MMA
#undef PG8_WAIT_V
#undef PG8_WAIT_L
#undef PG8_BAR
#undef PG8_SCHED
}
}

namespace pg8 {
__device__ __forceinline__ float fast_sigmoid(float x) { return __builtin_amdgcn_rcpf(1.0f + __builtin_amdgcn_exp2f(-1.4426950408889634f * x)); }
__device__ __forceinline__ void rstd8(const float* rss, int row0, int fq, float (&rs)[8]) {
    if (!rss) {
#pragma unroll
        for (int i = 0; i < 8; ++i) rs[i] = 1.0f;
        return; }
    f32x4 q[8];
#pragma unroll
    for (int i = 0; i < 8; ++i) q[i] = *(const f32x4*)(rss + (size_t)(row0 + (i >> 2) * HALF + (i & 3) * 16) * 16 + 4 * fq);
#pragma unroll
    for (int i = 0; i < 8; ++i) { float s = (q[i][0] + q[i][1]) + (q[i][2] + q[i][3]); s += __shfl_xor(s, 16); s += __shfl_xor(s, 32); rs[i] = 1.0f / sqrtf(s * (1.0f / 1024.f) + 1e-6f); }
}
struct EpiStore16 {
    static constexpr bool PERM = true, AFTER_DRAIN = false;
    bf16_t* O; int ldc; const float* rss;
    __device__ __forceinline__ void operator()(const f32x4 (&acc)[2][2][4][2], const Unit& u, int wr, int wc, int fr, int fq) const {
        const int row0 = u.pm * BM + wr * 64 + fr, col0 = u.cn * BM + wc * 32 + 8 * fq;
        float rs[8]; rstd8(rss, row0, fq, rs);
#pragma unroll
        for (int ai = 0; ai < 2; ++ai)
#pragma unroll
            for (int m = 0; m < 4; ++m) { const int row = row0 + ai * HALF + m * 16; bf16_t* rowp = O + (size_t)row * ldc + col0; const float r = rs[ai * 4 + m];
#pragma unroll
                for (int bj = 0; bj < 2; ++bj) { const f32x4 v0 = acc[ai][bj][m][0] * r, v1 = acc[ai][bj][m][1] * r;
                    u32x4 w; w.x = cvt_pk_bf16(v0[0], v0[1]); w.y = cvt_pk_bf16(v0[2], v0[3]); w.z = cvt_pk_bf16(v1[0], v1[1]); w.w = cvt_pk_bf16(v1[2], v1[3]);
                    *(u32x4*)(rowp + bj * HALF) = w; } }
    }
};
struct EpiAddH {
    static constexpr bool PERM = false, AFTER_DRAIN = false;
    float* H; int ldc; bf16_t* HBo; float* rss_out;
    __device__ __forceinline__ void operator()(const f32x4 (&acc)[2][2][4][2], const Unit& u, int wr, int wc, int fr, int fq) const {
        typedef unsigned u32x2v __attribute__((ext_vector_type(2)));
        const int row0 = u.pm * BM + wr * 64 + fr, col0 = u.cn * BM + wc * 32 + 4 * fq;
#pragma unroll
        for (int ai = 0; ai < 2; ++ai) { f32x4 h[4][2][2];
#pragma unroll
            for (int m = 0; m < 4; ++m) { const size_t off = (size_t)(row0 + ai * HALF + m * 16) * ldc + col0;
#pragma unroll
                for (int bj = 0; bj < 2; ++bj)
#pragma unroll
                    for (int n = 0; n < 2; ++n) h[m][bj][n] = *(const f32x4*)(H + off + bj * HALF + n * 16); }
#pragma unroll
            for (int m = 0; m < 4; ++m) { const int row = row0 + ai * HALF + m * 16; const size_t off = (size_t)row * ldc + col0; float ss = 0.f;
#pragma unroll
                for (int bj = 0; bj < 2; ++bj)
#pragma unroll
                    for (int n = 0; n < 2; ++n) { const f32x4 o = h[m][bj][n] + acc[ai][bj][m][n]; *(f32x4*)(H + off + bj * HALF + n * 16) = o; ss += (o[0] * o[0] + o[1] * o[1]) + (o[2] * o[2] + o[3] * o[3]);
                        u32x2v w; w.x = cvt_pk_bf16(o[0], o[1]); w.y = cvt_pk_bf16(o[2], o[3]); *(u32x2v*)(HBo + off + bj * HALF + n * 16) = w; }
                ss += __shfl_xor(ss, 16); ss += __shfl_xor(ss, 32);
                if (fq == 0) rss_out[(size_t)row * 16 + u.cn * 4 + wc] = ss; }
            asm volatile("" ::: "memory"); }
    }
};
struct EpiSwiglu {
    static constexpr bool PERM = true, AFTER_DRAIN = false;
    bf16_t* O; int ldc; const float* rss;
    __device__ __forceinline__ void operator()(const f32x4 (&acc)[2][2][4][2], const Unit& u, int wr, int wc, int fr, int fq) const {
        const int row0 = u.pm * BM + wr * 64 + fr, col0 = u.cn * HALF + wc * 32 + 8 * fq;
        float rs[8]; rstd8(rss, row0, fq, rs);
#pragma unroll
        for (int ai = 0; ai < 2; ++ai)
#pragma unroll
            for (int m = 0; m < 4; ++m) { const int row = row0 + ai * HALF + m * 16; bf16_t* rowp = O + (size_t)row * ldc + col0; float o[8]; const float r = rs[ai * 4 + m];
#pragma unroll
                for (int n = 0; n < 2; ++n)
#pragma unroll
                    for (int j = 0; j < 4; ++j) { const float gt = acc[ai][0][m][n][j] * r, up = acc[ai][1][m][n][j] * r; o[n * 4 + j] = gt * fast_sigmoid(gt) * up; }
                u32x4 w; w.x = cvt_pk_bf16(o[0], o[1]); w.y = cvt_pk_bf16(o[2], o[3]); w.z = cvt_pk_bf16(o[4], o[5]); w.w = cvt_pk_bf16(o[6], o[7]);
                *(u32x4*)rowp = w; }
    }
};
struct EpiPleF {
    static constexpr bool PERM = false, AFTER_DRAIN = false;
    float* H; const bf16_t* PJ; int ldc; const float* rss; bf16_t* HBo; float* rss_out;
    __device__ __forceinline__ void operator()(const f32x4 (&acc)[2][2][4][2], const Unit& u, int wr, int wc, int fr, int fq) const {
        typedef unsigned u32x2v __attribute__((ext_vector_type(2)));
        const int row0 = u.pm * BM + wr * 64 + fr, col0 = u.cn * BM + wc * 32 + 4 * fq;
        float rs[8]; rstd8(rss, row0, fq, rs);
#pragma unroll
        for (int ai = 0; ai < 2; ++ai)
#pragma unroll
            for (int mp = 0; mp < 2; ++mp) { f32x4 h[2][2][2]; u32x2v pj[2][2][2];
#pragma unroll
                for (int mm = 0; mm < 2; ++mm) { const size_t off = (size_t)(row0 + ai * HALF + (2 * mp + mm) * 16) * ldc + col0;
#pragma unroll
                    for (int bj = 0; bj < 2; ++bj)
#pragma unroll
                        for (int n = 0; n < 2; ++n) { h[mm][bj][n] = *(const f32x4*)(H + off + bj * HALF + n * 16); pj[mm][bj][n] = *(const u32x2v*)(PJ + off + bj * HALF + n * 16); } }
#pragma unroll
                for (int mm = 0; mm < 2; ++mm) { const int m = 2 * mp + mm, row = row0 + ai * HALF + m * 16; const size_t off = (size_t)row * ldc + col0; const float r = rs[ai * 4 + m]; float ss = 0.f;
#pragma unroll
                    for (int bj = 0; bj < 2; ++bj)
#pragma unroll
                        for (int n = 0; n < 2; ++n) { const f32x4 a = acc[ai][bj][m][n] * r; f32x4 o; const u32x2v q = pj[mm][bj][n]; const f32x4 hh = h[mm][bj][n];
                            o[0] = hh[0] + __uint_as_float(q.x << 16) * fast_sigmoid(a[0]); o[1] = hh[1] + __uint_as_float(q.x & 0xffff0000u) * fast_sigmoid(a[1]);
                            o[2] = hh[2] + __uint_as_float(q.y << 16) * fast_sigmoid(a[2]); o[3] = hh[3] + __uint_as_float(q.y & 0xffff0000u) * fast_sigmoid(a[3]);
                            *(f32x4*)(H + off + bj * HALF + n * 16) = o; ss += (o[0] * o[0] + o[1] * o[1]) + (o[2] * o[2] + o[3] * o[3]);
                            u32x2v w; w.x = cvt_pk_bf16(o[0], o[1]); w.y = cvt_pk_bf16(o[2], o[3]); *(u32x2v*)(HBo + off + bj * HALF + n * 16) = w; }
                    ss += __shfl_xor(ss, 16); ss += __shfl_xor(ss, 32);
                    if (fq == 0) rss_out[(size_t)row * 16 + u.cn * 4 + wc] = ss; }
                asm volatile("" ::: "memory"); }
    }
};
struct ExpertOrder : StaticOrder {
    const int* tile_e;
    __device__ __forceinline__ bool next(int i, Unit& u) const { if (!StaticOrder::next(i, u)) return false; if (tile_e) u.pn += tile_e[u.pm] * nN; return true; }
};
}

namespace fp {
using namespace mdl;
#define FLAS __attribute__((address_space(3)))
typedef float f32x4 __attribute__((ext_vector_type(4)));
typedef float f32x2 __attribute__((ext_vector_type(2)));
typedef unsigned u32x4 __attribute__((ext_vector_type(4)));
typedef unsigned u32x2 __attribute__((ext_vector_type(2)));
typedef __bf16 bf16x2_t __attribute__((ext_vector_type(2)));
__device__ __forceinline__ unsigned pk2(float lo, float hi) { f32x2 v = {lo, hi}; bf16x2_t b = __builtin_convertvector(v, bf16x2_t); return __builtin_bit_cast(unsigned, b); }
__device__ __forceinline__ float blo(unsigned w) { return __uint_as_float(w << 16); }
__device__ __forceinline__ float bhi(unsigned w) { return __uint_as_float(w & 0xffff0000u); }
__device__ __forceinline__ float wave_sum(float v) {
#pragma unroll
    for (int o = 1; o < 64; o <<= 1) v += __shfl_xor(v, o);
    return v;
}
#define FP_LDS_WAIT() asm volatile("s_waitcnt lgkmcnt(0)" ::: "memory")

template <class Map> __device__ __forceinline__ void tr_item(const float* W, int Nsrc, const Map& map, bf16* WT, int K, int k0, int n0, FLAS float* scr, int lane, const float* gain = nullptr) {
    const int nl = lane & 31, c = map(n0 + nl), cc = lane & 7;
    f32x4 g0 = (f32x4){1.f, 1.f, 1.f, 1.f}, g1 = g0;
    if (gain) { g0 = *(const f32x4*)(gain + k0 + 8 * cc); g1 = *(const f32x4*)(gain + k0 + 8 * cc + 4); }
#pragma unroll 8
    for (int i = 0; i < 32; ++i) { const int kk = 2 * i + (lane >> 5); scr[kk * 33 + nl] = c >= 0 ? W[(size_t)(k0 + kk) * Nsrc + c] : 0.f; }
    FP_LDS_WAIT(); asm volatile("" ::: "memory");
#pragma unroll
    for (int j = 0; j < 4; ++j) { const int n = (lane >> 3) + 8 * j; const FLAS float* s = scr + (8 * cc) * 33 + n;
        u32x4 o; o.x = pk2(s[0 * 33] * g0.x, s[1 * 33] * g0.y); o.y = pk2(s[2 * 33] * g0.z, s[3 * 33] * g0.w); o.z = pk2(s[4 * 33] * g1.x, s[5 * 33] * g1.y); o.w = pk2(s[6 * 33] * g1.z, s[7 * 33] * g1.w);
        *(u32x4*)(WT + (size_t)(n0 + n) * K + k0 + 8 * cc) = o; }
    FP_LDS_WAIT(); asm volatile("" ::: "memory");
}
struct MapId { __device__ __forceinline__ int operator()(int n) const { return n; } };
struct MapLt { int lim; __device__ __forceinline__ int operator()(int n) const { return n < lim ? n : -1; } };
struct MapU { __device__ __forceinline__ int operator()(int n) const { return ucol_src(n); } };
struct MapOff { int off; __device__ __forceinline__ int operator()(int n) const { return n + off; } };
__device__ __forceinline__ void prologue(const MP& p, FLAS unsigned char* lds, int bx, int G) {
    const int tid = mk_tid(), lane = tid & 63, wave = __builtin_amdgcn_readfirstlane(tid >> 6);
    FLAS float* scr = (FLAS float*)(lds + wave * 16384);
    const int gw = bx * 8 + wave, NGW = G * 8;
    constexpr int I_WIN = (D / 64) * (NU / 32), I_UQ = 4 * 16, I_UKV = 2 * 16, I_DD = 16 * 32, I_PP = 4 * 32, I_GU = 16 * (NGU / 32), I_DN = (DFF / 64) * 32;
    constexpr int PER_L = I_WIN + I_UQ + I_UKV + 2 * I_DD + I_PP, NITEMS = DEPTH * PER_L + 18 * (I_GU + I_DN);
    for (int it = gw; it < NITEMS; it += NGW) {
        int r = it;
        if (r < DEPTH * PER_L) { const int l = r / PER_L; r %= PER_L;
            if (r < I_WIN) { tr_item(p.w_in + (size_t)l * D * NUO, NUO, MapU{}, p.WIN + (size_t)l * NU * D, D, 64 * (r / (NU / 32)), 32 * (r % (NU / 32)), scr, lane, p.attn_g + l * D); continue; } r -= I_WIN;
            if (r < I_UQ) { tr_item(p.w_uq + (size_t)l * 256 * 384, 384, MapLt{384}, p.WUQ + (size_t)l * 512 * 256, 256, 64 * (r / 16), 32 * (r % 16), scr, lane); continue; } r -= I_UQ;
            if (r < I_UKV) { tr_item(p.w_ukv + (size_t)l * 128 * 512, 512, MapId{}, p.WUKV + (size_t)l * 512 * 128, 128, 64 * (r / 16), 32 * (r % 16), scr, lane); continue; } r -= I_UKV;
            if (r < I_DD) { tr_item(p.w_out + (size_t)l * D * D, D, MapId{}, p.WOUT + (size_t)l * D * D, D, 64 * (r / 32), 32 * (r % 32), scr, lane); continue; } r -= I_DD;
            if (r < I_DD) { tr_item(p.ple_wg + (size_t)l * D * D, D, MapId{}, p.WPG + (size_t)l * D * D, D, 64 * (r / 32), 32 * (r % 32), scr, lane, p.ple_g + l * D); continue; } r -= I_DD;
            tr_item(p.ple_wp + (size_t)l * PLE * D, D, MapId{}, p.WPP + (size_t)l * D * PLE, PLE, 64 * (r / 32), 32 * (r % 32), scr, lane); continue; }
        r -= DEPTH * PER_L;
        if (r < 18 * I_GU) { const int mt = r / I_GU; r %= I_GU; const int k0 = 64 * (r / (NGU / 32)), n0 = 32 * (r % (NGU / 32)); const int tl = n0 / 256, rr = n0 % 256;
            const float* src; bf16* dst;
            if (mt < 2) { src = (rr < 128 ? p.dwg : p.dwu) + (size_t)mt * D * DFF; dst = p.DWGU + (size_t)mt * NGU * D; } else { src = (rr < 128 ? p.mwg : p.mwu) + (size_t)(mt - 2) * D * DFF; dst = p.MWGU + (size_t)(mt - 2) * NGU * D; }
            const int Lg = mt < 2 ? 2 * mt : 2 * ((mt - 2) >> 3) + 1;
            tr_item(src, DFF, MapOff{tl * 128 + (rr & 127) - n0}, dst, D, k0, n0, scr, lane, p.ffn_g + Lg * D); continue; }
        r -= 18 * I_GU;
        { const int mt = r / I_DN; r %= I_DN; const float* src; bf16* dst;
            if (mt < 2) { src = p.dwd + (size_t)mt * DFF * D; dst = p.DWD + (size_t)mt * D * DFF; } else { src = p.mwd + (size_t)(mt - 2) * DFF * D; dst = p.MWD + (size_t)(mt - 2) * D * DFF; }
            tr_item(src, D, MapId{}, dst, DFF, 64 * (r / 32), 32 * (r % 32), scr, lane); }
    }
    const long g0 = (long)bx * 512 + tid, gs = (long)G * 512;
    for (long t = gw; t < p.T; t += NGW) { const f32x4* xr = (const f32x4*)(p.x + t * D) + lane; f32x4* hr = (f32x4*)(p.H + t * D) + lane; u32x2* o = (u32x2*)(p.HB + t * D) + lane; float ss = 0.f;
#pragma unroll
        for (int j = 0; j < 4; ++j) { const f32x4 v = xr[64 * j]; hr[64 * j] = v; u32x2 wv; wv.x = pk2(v.x, v.y); wv.y = pk2(v.z, v.w); o[64 * j] = wv; ss += (v.x * v.x + v.y * v.y) + (v.z * v.z + v.w * v.w); }
        ss = wave_sum(ss); if (lane < 16) rss_ptr(p, 0, 0)[t * 16 + lane] = lane == 0 ? ss : 0.f; }
    for (long i = g0; i < (long)DEPTH * p.T * PLE / 4; i += gs) { const f32x4 v = ((const f32x4*)p.p)[i]; u32x2 o; o.x = pk2(v.x, v.y); o.y = pk2(v.z, v.w); ((u32x2*)p.PB16)[i] = o; }
    for (long i = g0; i < p.T * 16; i += gs) { const long t = i / 16; const int j = (int)(i % 16); const float inv = powf(10000.0f, -(float)(2 * j) / 32.0f), ang = (float)p.pos[t] * inv;
        p.CS[t * 32 + j] = cosf(ang); p.CS[t * 32 + 16 + j] = sinf(ang); }
}
template <int MODE> __device__ __forceinline__ void norm_phase(const MP& p, int L, const float* g, int bx, int G, FLAS unsigned* lcnt = nullptr) {
    const int tid = mk_tid(), lane = tid & 63, wave = __builtin_amdgcn_readfirstlane(tid >> 6);
    const int gw = bx * 8 + wave, NGW = G * 8;
    const f32x4* gr = (const f32x4*)g + lane;
    if (MODE == 1) { __syncthreads(); if (tid < NE) lcnt[tid] = 0u; __syncthreads(); }
    for (long t = gw; t < p.T; t += NGW) {
        f32x4* hr = (f32x4*)(p.H + t * D) + lane; f32x4 v[4];
#pragma unroll
        for (int j = 0; j < 4; ++j) v[j] = hr[64 * j];
        if (MODE == 2) { const int s0 = p.TOKSLOT[t * 2], s1 = p.TOKSLOT[t * 2 + 1]; const float a = p.TOPG[t * 2], b = p.TOPG[t * 2 + 1];
            const u32x2* y0 = (const u32x2*)(p.YS + (size_t)s0 * D) + lane; const u32x2* y1 = (const u32x2*)(p.YS + (size_t)s1 * D) + lane;
#pragma unroll
            for (int j = 0; j < 4; ++j) { const u32x2 q0 = y0[64 * j], q1 = y1[64 * j];
                v[j].x += a * blo(q0.x) + b * blo(q1.x); v[j].y += a * bhi(q0.x) + b * bhi(q1.x); v[j].z += a * blo(q0.y) + b * blo(q1.y); v[j].w += a * bhi(q0.y) + b * bhi(q1.y); hr[64 * j] = v[j]; } }
        float ss = 0.f;
#pragma unroll
        for (int j = 0; j < 4; ++j) ss += (v[j].x * v[j].x + v[j].y * v[j].y) + (v[j].z * v[j].z + v[j].w * v[j].w);
        ss = wave_sum(ss);
        const float r = 1.0f / sqrtf(ss * (1.0f / D) + RMS_EPS);
        if (MODE == 2) { u32x2* o = (u32x2*)(p.HB2 + t * D) + lane;
#pragma unroll
            for (int j = 0; j < 4; ++j) { u32x2 w; w.x = pk2(v[j].x, v[j].y); w.y = pk2(v[j].z, v[j].w); o[64 * j] = w; }
            if (lane < 16) rss_ptr(p, L, 2)[t * 16 + lane] = lane == 0 ? ss : 0.f; }
        if (MODE == 1) { u32x2* o = (u32x2*)(p.HB2 + t * D) + lane;
#pragma unroll
            for (int j = 0; j < 4; ++j) { u32x2 w; w.x = pk2(v[j].x * r, v[j].y * r); w.y = pk2(v[j].z * r, v[j].w * r); o[64 * j] = w; } }
        if (MODE == 1 || MODE == 3) {
#pragma unroll
            for (int j = 0; j < 4; ++j) { const f32x4 gv = gr[64 * j]; v[j].x *= r * gv.x; v[j].y *= r * gv.y; v[j].z *= r * gv.z; v[j].w *= r * gv.w; } }
        if (MODE == 3) {
#pragma unroll
            for (int j = 0; j < 4; ++j) ((f32x4*)(p.out + t * D) + lane)[64 * j] = v[j];
        }
        if (MODE == 1) { const int jm = L >> 1; const f32x4* R = (const f32x4*)(p.router + (size_t)jm * D * NE); float lg[NE];
#pragma unroll
            for (int e = 0; e < NE; ++e) lg[e] = 0.f;
#pragma unroll
            for (int j = 0; j < 4; ++j)
#pragma unroll
                for (int c = 0; c < 4; ++c) { const int idx = 4 * (lane + 64 * j) + c; const f32x4 r0 = R[idx * 2], r1 = R[idx * 2 + 1]; const float x = v[j][c];
                    lg[0] += x * r0.x; lg[1] += x * r0.y; lg[2] += x * r0.z; lg[3] += x * r0.w; lg[4] += x * r1.x; lg[5] += x * r1.y; lg[6] += x * r1.z; lg[7] += x * r1.w; }
#pragma unroll
            for (int e = 0; e < NE; ++e) lg[e] = wave_sum(lg[e]);
            int e0 = 0; float v0 = lg[0];
#pragma unroll
            for (int e = 1; e < NE; ++e) if (lg[e] > v0) { v0 = lg[e]; e0 = e; }
            int e1 = -1; float v1 = -3.0e38f;
#pragma unroll
            for (int e = 0; e < NE; ++e) if (e != e0 && lg[e] > v1) { v1 = lg[e]; e1 = e; }
            if (lane == 0) { const float g1 = 1.0f / (1.0f + expf(v0 - v1));
                p.TOPE[t * 2] = e0; p.TOPE[t * 2 + 1] = e1; p.TOPG[t * 2] = 1.0f - g1; p.TOPG[t * 2 + 1] = g1;
                p.POS[t * 2] = (int)__hip_atomic_fetch_add(lcnt + e0, 1u, __ATOMIC_RELAXED, __HIP_MEMORY_SCOPE_WORKGROUP); p.POS[t * 2 + 1] = (int)__hip_atomic_fetch_add(lcnt + e1, 1u, __ATOMIC_RELAXED, __HIP_MEMORY_SCOPE_WORKGROUP); } }
    }
    if (MODE == 1) { __syncthreads(); if (tid < NE) p.BCNT[bx * NE + tid] = (int)lcnt[tid]; }
}
__device__ __forceinline__ void moeplan(const MP& p, int L, FLAS unsigned char* lds, int bx, int G) {
    const int tid = mk_tid(), lane = tid & 63, wave = __builtin_amdgcn_readfirstlane(tid >> 6), j = L >> 1;
    const int gw = bx * 8 + wave, NGW = G * 8;
    FLAS int* base = (FLAS int*)lds;
    FLAS int* pst = (FLAS int*)(lds + 16384);
    __syncthreads();
    {
        const int e = wave; int c[4], s = 0;
#pragma unroll
        for (int i = 0; i < 4; ++i) { const int b = lane * 4 + i; c[i] = b < G ? p.BCNT[b * NE + e] : 0; s += c[i]; }
        int inc = s;
#pragma unroll
        for (int o = 1; o < 64; o <<= 1) { const int t = __shfl_up(inc, o); if (lane >= o) inc += t; }
        int ex = inc - s;
#pragma unroll
        for (int i = 0; i < 4; ++i) { const int b = lane * 4 + i; if (b < G) base[b * NE + e] = ex; ex += c[i]; }
        if (lane == 63) pst[e] = inc;
    }
    __syncthreads();
    if (tid == 0) { int o = 0; for (int e = 0; e < NE; ++e) { const int cnt = pst[e]; pst[e] = o; if (bx == 0) cnt_ptr(p, j)[e] = (unsigned)cnt; o += ((cnt + 255) / 256) * 256; } pst[NE] = o; }
    __syncthreads();
    for (long i = gw; i < p.T * 2; i += NGW) { const long t = i >> 1; const int e = p.TOPE[i], blk = (int)((t % NGW) >> 3); const int slot = pst[e] + base[blk * NE + e] + p.POS[i]; if (lane == 0) p.TOKSLOT[i] = slot;
        const u32x4* s = (const u32x4*)(p.HB2 + t * D) + lane; u32x4* d = (u32x4*)(p.XB + (size_t)slot * D) + lane; const u32x4 a = s[0], b = s[64]; d[0] = a; d[64] = b; }
    if (bx == 0) for (int i = tid; i < 1024; i += 512) { int e = -1; if (i * 256 < pst[NE]) { e = 0; for (int q = 1; q < NE; ++q) if (i * 256 >= pst[q]) e = q; } p.TILE_E[i] = e; }
    __syncthreads();
}
typedef short bf16x8 __attribute__((ext_vector_type(8)));
typedef short bf16x4 __attribute__((ext_vector_type(4)));
constexpr int AT_KP = 104, AT_VP = 72, AT_VOFF = 64 * AT_KP * 2;
__device__ __forceinline__ void attn_phase(const MP& p, FLAS unsigned char* lds, int bx, int G) {
    const int tid = mk_tid(), lane = tid & 63, w = __builtin_amdgcn_readfirstlane(tid >> 6), fr = lane & 15, fq = lane >> 4;
    FLAS bf16* Ks = (FLAS bf16*)lds; FLAS bf16* Vt = (FLAS bf16*)(lds + AT_VOFF);
    const int S = (int)p.S, nunits = (int)p.B * 4 * 8;
    const int vcu = (G % 8 == 0) ? (bx % 8) * (G / 8) + bx / 8 : bx;
    const int kr0 = tid / 12, kc0 = tid % 12, kr1 = (tid + 512) / 12, kc1 = (tid + 512) % 12; const bool k1ok = tid < 256;
    const int vkey = tid >> 3, vc = tid & 7;
    for (int u = vcu; u < nunits; u += G) {
        const int bh = u >> 3, jp = u & 7, b = bh >> 2, h = bh & 3;
        const bf16* Kg = p.KK + (size_t)b * S * 384 + h * 96; const bf16* Vg = p.V + (size_t)b * S * 256 + h * 64;
        for (int half = 0; half < 2; ++half) {
            const int qb = half ? 15 - jp : jp, q0 = qb * 128, qmin = q0 + 16 * w, qglob = qmin + fr;
            const size_t trow = (size_t)b * S + qglob;
            bf16x8 qf[3];
#pragma unroll
            for (int ks = 0; ks < 3; ++ks) qf[ks] = *(const bf16x8*)(p.Q + trow * 384 + h * 96 + ks * 32 + fq * 8);
            f32x4 o[4];
#pragma unroll
            for (int dt = 0; dt < 4; ++dt) o[dt] = (f32x4){0.f, 0.f, 0.f, 0.f};
            float m = -1e30f, l = 0.f;
            const int nkt = (q0 + 128) / 64;
            u32x4 rk0, rk1 = (u32x4){0u, 0u, 0u, 0u}, rv;
            rk0 = *(const u32x4*)(Kg + (size_t)kr0 * 384 + kc0 * 8); if (k1ok) rk1 = *(const u32x4*)(Kg + (size_t)kr1 * 384 + kc1 * 8); rv = *(const u32x4*)(Vg + (size_t)vkey * 256 + vc * 8);
            for (int kt = 0; kt < nkt; ++kt) {
                __syncthreads();
                *(FLAS u32x4*)(Ks + kr0 * AT_KP + kc0 * 8) = rk0; if (k1ok) *(FLAS u32x4*)(Ks + kr1 * AT_KP + kc1 * 8) = rk1;
                { const unsigned wv[4] = {rv.x, rv.y, rv.z, rv.w};
#pragma unroll
                  for (int i = 0; i < 4; ++i) { Vt[(vc * 8 + 2 * i) * AT_VP + vkey] = (bf16)(wv[i] & 0xffffu); Vt[(vc * 8 + 2 * i + 1) * AT_VP + vkey] = (bf16)(wv[i] >> 16); } }
                __syncthreads();
                if (kt + 1 < nkt) { const size_t kb = (size_t)(kt + 1) * 64;
                    rk0 = *(const u32x4*)(Kg + (kb + kr0) * 384 + kc0 * 8); if (k1ok) rk1 = *(const u32x4*)(Kg + (kb + kr1) * 384 + kc1 * 8); rv = *(const u32x4*)(Vg + (kb + vkey) * 256 + vc * 8); }
                const int kbase = kt * 64;
                if (kbase <= qmin + 15) {
                    f32x4 s[4];
#pragma unroll
                    for (int sub = 0; sub < 4; ++sub) { s[sub] = (f32x4){0.f, 0.f, 0.f, 0.f};
#pragma unroll
                        for (int ks = 0; ks < 3; ++ks) { const bf16x8 a = *(const FLAS bf16x8*)(Ks + (sub * 16 + fr) * AT_KP + ks * 32 + fq * 8); s[sub] = __builtin_amdgcn_mfma_f32_16x16x32_bf16(a, qf[ks], s[sub], 0, 0, 0); } }
                    if (kbase + 63 > qmin) {
#pragma unroll
                        for (int sub = 0; sub < 4; ++sub)
#pragma unroll
                            for (int j = 0; j < 4; ++j) if (kbase + sub * 16 + 4 * fq + j > qglob) s[sub][j] = -1e30f;
                    }
                    float tmax = s[0][0];
#pragma unroll
                    for (int sub = 0; sub < 4; ++sub)
#pragma unroll
                        for (int j = 0; j < 4; ++j) tmax = fmaxf(tmax, s[sub][j]);
                    tmax = fmaxf(tmax, __shfl_xor(tmax, 16)); tmax = fmaxf(tmax, __shfl_xor(tmax, 32));
                    const float mn = fmaxf(m, tmax), alpha = __builtin_amdgcn_exp2f(m - mn); m = mn;
                    float rs = 0.f;
#pragma unroll
                    for (int sub = 0; sub < 4; ++sub)
#pragma unroll
                        for (int j = 0; j < 4; ++j) { s[sub][j] = __builtin_amdgcn_exp2f(s[sub][j] - mn); rs += s[sub][j]; }
                    rs += __shfl_xor(rs, 16); rs += __shfl_xor(rs, 32);
                    l = l * alpha + rs;
#pragma unroll
                    for (int dt = 0; dt < 4; ++dt) o[dt] *= alpha;
#pragma unroll
                    for (int k2 = 0; k2 < 2; ++k2) {
                        u32x4 pw; pw.x = pk2(s[2 * k2][0], s[2 * k2][1]); pw.y = pk2(s[2 * k2][2], s[2 * k2][3]); pw.z = pk2(s[2 * k2 + 1][0], s[2 * k2 + 1][1]); pw.w = pk2(s[2 * k2 + 1][2], s[2 * k2 + 1][3]);
                        const bf16x8 pf = __builtin_bit_cast(bf16x8, pw);
#pragma unroll
                        for (int dt = 0; dt < 4; ++dt) { const FLAS bf16* vp = Vt + (dt * 16 + fr) * AT_VP + 32 * k2 + 4 * fq;
                            const u32x2 v0 = *(const FLAS u32x2*)vp, v1 = *(const FLAS u32x2*)(vp + 16); u32x4 vw; vw.x = v0.x; vw.y = v0.y; vw.z = v1.x; vw.w = v1.y;
                            o[dt] = __builtin_amdgcn_mfma_f32_16x16x32_bf16(__builtin_bit_cast(bf16x8, vw), pf, o[dt], 0, 0, 0); }
                    }
                }
            }
            const float rl = 1.0f / l;
#pragma unroll
            for (int dt = 0; dt < 4; ++dt) { u32x2 ow; ow.x = pk2(o[dt][0] * rl, o[dt][1] * rl); ow.y = pk2(o[dt][2] * rl, o[dt][3] * rl);
                *(u32x2*)(p.YC + trow * D + 768 + h * 64 + dt * 16 + 4 * fq) = ow; }
        }
    }
    __syncthreads();
}
__device__ __forceinline__ void conv_module(const MP& p, int L, FLAS unsigned char* lds, int bx, int G) {
    const int tid = mk_tid(), lane = tid & 63, w = __builtin_amdgcn_readfirstlane(tid >> 6);
    FLAS float* Gs = (FLAS float*)lds;
    const int S = (int)p.S, nchunk = S / 64, nitems = (int)p.B * nchunk;
    for (int it = bx; it < nitems; it += G) {
        const int ck = it % nchunk, b = it / nchunk, s0 = ck * 64;
        __syncthreads();
        u32x4 rv[6], rg[6];
#pragma unroll
        for (int i = 0; i < 6; ++i) { const int idx = tid + 512 * i, row = idx >> 5, c = idx & 31, sp = s0 - 30 + row; rv[i] = (u32x4){0u, 0u, 0u, 0u}; rg[i] = rv[i];
            if (idx < 94 * 32 && sp >= 0) { const bf16* u = p.U + ((size_t)b * S + sp) * NU + c * 8; rv[i] = *(const u32x4*)u; rg[i] = *(const u32x4*)(u + 256); } }
#pragma unroll
        for (int i = 0; i < 6; ++i) { const int idx = tid + 512 * i, row = idx >> 5, c = idx & 31;
            if (idx < 94 * 32) { const unsigned v[4] = {rv[i].x, rv[i].y, rv[i].z, rv[i].w}, g[4] = {rg[i].x, rg[i].y, rg[i].z, rg[i].w}; f32x4 o0, o1;
                o0.x = blo(v[0]) / (1.0f + __expf(-blo(g[0]))); o0.y = bhi(v[0]) / (1.0f + __expf(-bhi(g[0]))); o0.z = blo(v[1]) / (1.0f + __expf(-blo(g[1]))); o0.w = bhi(v[1]) / (1.0f + __expf(-bhi(g[1])));
                o1.x = blo(v[2]) / (1.0f + __expf(-blo(g[2]))); o1.y = bhi(v[2]) / (1.0f + __expf(-bhi(g[2]))); o1.z = blo(v[3]) / (1.0f + __expf(-blo(g[3]))); o1.w = bhi(v[3]) / (1.0f + __expf(-bhi(g[3])));
                *(FLAS f32x4*)(Gs + row * 256 + c * 8) = o0; *(FLAS f32x4*)(Gs + row * 256 + c * 8 + 4) = o1; } }
        __syncthreads();
        const int ch = (w & 3) * 64 + lane, tb = (w >> 2) * 32; float wj[CK];
#pragma unroll
        for (int j = 0; j < CK; ++j) wj[j] = p.cdw_w[(L * CK + j) * 256 + ch];
        const float bias = p.cdw_b[L * 256 + ch], lg = p.cln_g[L * 256 + ch], lb = p.cln_b[L * 256 + ch];
#pragma unroll 2
        for (int i = 0; i < 32; ++i) { const int tl = tb + i; float acc = bias;
#pragma unroll
            for (int j = 0; j < CK; ++j) acc += wj[j] * Gs[(tl + j) * 256 + ch];
            const float mu = wave_sum(acc) * (1.0f / 64.f), dv = acc - mu, var = wave_sum(dv * dv) * (1.0f / 64.f);
            const float hn = dv * (1.0f / sqrtf(var + LN_EPS)) * lg + lb;
            p.YC[((size_t)b * S + s0 + tl) * D + ch] = f2bf(hn / (1.0f + __expf(-hn))); }
    }
    __syncthreads();
}
constexpr int MQ_P = 264, MK_P = 136;
__device__ __forceinline__ void mla_proj(const MP& p, int L, FLAS unsigned char* lds, int bx, int G) {
    const int tid = mk_tid(), lane = tid & 63, w = __builtin_amdgcn_readfirstlane(tid >> 6), fr = lane & 15, fq = lane >> 4;
    FLAS bf16* Aq = (FLAS bf16*)lds; FLAS bf16* Ak = (FLAS bf16*)(lds + 64 * MQ_P * 2);
    const int nunits = (int)(p.T / 64);
    const bf16* Wq = p.WUQ + (size_t)L * 512 * 256; const bf16* Wk = p.WUKV + (size_t)L * 512 * 128;
    for (int u = bx; u < nunits; u += G) {
        const size_t t0 = (size_t)u * 64;
        __syncthreads();
        {
            u32x2 rq[8]; unsigned rk[8];
#pragma unroll
            for (int i = 0; i < 8; ++i) { const bf16* urow = p.U + (t0 + w * 8 + i) * NU; rq[i] = *(const u32x2*)(urow + U_CQ + lane * 4); rk[i] = *(const unsigned*)(urow + U_CKV + lane * 2); }
            const f32x4 gq = *(const f32x4*)(p.qn_g + L * 256 + lane * 4); const f32x2 gk = *(const f32x2*)(p.kvn_g + L * 128 + lane * 2);
#pragma unroll
            for (int i = 0; i < 8; ++i) { const int r = w * 8 + i;
                { const float a0 = blo(rq[i].x), a1 = bhi(rq[i].x), a2 = blo(rq[i].y), a3 = bhi(rq[i].y); const float rs = 1.0f / sqrtf(wave_sum((a0 * a0 + a1 * a1) + (a2 * a2 + a3 * a3)) * (1.0f / 256.f) + RMS_EPS);
                  u32x2 o; o.x = pk2(a0 * rs * gq.x, a1 * rs * gq.y); o.y = pk2(a2 * rs * gq.z, a3 * rs * gq.w); *(FLAS u32x2*)(Aq + r * MQ_P + lane * 4) = o; }
                { const float a0 = blo(rk[i]), a1 = bhi(rk[i]); const float rs = 1.0f / sqrtf(wave_sum(a0 * a0 + a1 * a1) * (1.0f / 128.f) + RMS_EPS); *(FLAS unsigned*)(Ak + r * MK_P + lane * 2) = pk2(a0 * rs * gk.x, a1 * rs * gk.y); } } }
#pragma unroll
        for (int e2 = 0; e2 < 2; ++e2) { const int e = tid + 512 * e2, r = e >> 4, jj = e & 15; const size_t t = t0 + r; const float x1 = bf2f(p.U[t * NU + U_KR + jj]), x2 = bf2f(p.U[t * NU + U_KR + 16 + jj]), c = p.CS[t * 32 + jj], sn = p.CS[t * 32 + 16 + jj];
            const bf16 o1 = f2bf(x1 * c - x2 * sn), o2 = f2bf(x1 * sn + x2 * c);
#pragma unroll
            for (int h = 0; h < 4; ++h) { p.KK[t * 384 + h * 96 + 64 + jj] = o1; p.KK[t * 384 + h * 96 + 80 + jj] = o2; } }
        __syncthreads();
        {
            f32x4 acc[3][4];
#pragma unroll
            for (int ct = 0; ct < 3; ++ct)
#pragma unroll
                for (int rt = 0; rt < 4; ++rt) acc[ct][rt] = (f32x4){0.f, 0.f, 0.f, 0.f};
            bf16x8 wf[8][3];
#pragma unroll
            for (int ks = 0; ks < 8; ++ks)
#pragma unroll
                for (int ct = 0; ct < 3; ++ct) wf[ks][ct] = *(const bf16x8*)(Wq + (size_t)(48 * w + 16 * ct + fr) * 256 + ks * 32 + fq * 8);
#pragma unroll
            for (int ks = 0; ks < 8; ++ks)
#pragma unroll
                for (int rt = 0; rt < 4; ++rt) { const bf16x8 tk = *(const FLAS bf16x8*)(Aq + (rt * 16 + fr) * MQ_P + ks * 32 + fq * 8);
#pragma unroll
                    for (int ct = 0; ct < 3; ++ct) acc[ct][rt] = __builtin_amdgcn_mfma_f32_16x16x32_bf16(wf[ks][ct], tk, acc[ct][rt], 0, 0, 0); }
            const bool pe = (w & 1) != 0;
#pragma unroll
            for (int rt = 0; rt < 4; ++rt) { const size_t t = t0 + rt * 16 + fr; bf16* qrow = p.Q + t * 384 + 48 * w + 4 * fq;
                f32x4 v0 = acc[0][rt], v1 = acc[1][rt], v2 = acc[2][rt];
                if (pe) { const f32x4 c = *(const f32x4*)(p.CS + t * 32 + 4 * fq), sn = *(const f32x4*)(p.CS + t * 32 + 16 + 4 * fq); const f32x4 x1 = v1, x2 = v2; v1 = x1 * c - x2 * sn; v2 = x1 * sn + x2 * c; }
                u32x2 o; o.x = pk2(v0.x * QSCALE, v0.y * QSCALE); o.y = pk2(v0.z * QSCALE, v0.w * QSCALE); *(u32x2*)qrow = o;
                o.x = pk2(v1.x * QSCALE, v1.y * QSCALE); o.y = pk2(v1.z * QSCALE, v1.w * QSCALE); *(u32x2*)(qrow + 16) = o;
                o.x = pk2(v2.x * QSCALE, v2.y * QSCALE); o.y = pk2(v2.z * QSCALE, v2.w * QSCALE); *(u32x2*)(qrow + 32) = o; }
        }
        {
            f32x4 acc[4][4];
#pragma unroll
            for (int ct = 0; ct < 4; ++ct)
#pragma unroll
                for (int rt = 0; rt < 4; ++rt) acc[ct][rt] = (f32x4){0.f, 0.f, 0.f, 0.f};
            bf16x8 wf[4][4];
#pragma unroll
            for (int ks = 0; ks < 4; ++ks)
#pragma unroll
                for (int ct = 0; ct < 4; ++ct) wf[ks][ct] = *(const bf16x8*)(Wk + (size_t)(64 * w + 16 * ct + fr) * 128 + ks * 32 + fq * 8);
#pragma unroll
            for (int ks = 0; ks < 4; ++ks)
#pragma unroll
                for (int rt = 0; rt < 4; ++rt) { const bf16x8 tk = *(const FLAS bf16x8*)(Ak + (rt * 16 + fr) * MK_P + ks * 32 + fq * 8);
#pragma unroll
                    for (int ct = 0; ct < 4; ++ct) acc[ct][rt] = __builtin_amdgcn_mfma_f32_16x16x32_bf16(wf[ks][ct], tk, acc[ct][rt], 0, 0, 0); }
            const int h = w >> 1; const bool isv = (w & 1) != 0;
#pragma unroll
            for (int rt = 0; rt < 4; ++rt) { const size_t t = t0 + rt * 16 + fr; bf16* dst = (isv ? p.V + t * 256 + h * 64 : p.KK + t * 384 + h * 96) + 4 * fq;
#pragma unroll
                for (int ct = 0; ct < 4; ++ct) { u32x2 o; o.x = pk2(acc[ct][rt].x, acc[ct][rt].y); o.y = pk2(acc[ct][rt].z, acc[ct][rt].w); *(u32x2*)(dst + 16 * ct) = o; } }
        }
    }
    __syncthreads();
}
__device__ __forceinline__ void ssd_scan(const MP& p, int bx, int G) {
    const int tid = mk_tid(); const long g0 = (long)bx * 512 + tid, gs = (long)G * 512; const int NCB = (int)(p.S / CHUNK);
    for (long i = g0; i < p.B * 8 * 64 * 32; i += gs) { const long b = i / (8 * 64 * 32), r = i % (8 * 64 * 32); const int h = (int)(r / (64 * 32)); f32x4 carry = (f32x4){0.f, 0.f, 0.f, 0.f};
        for (int cc = 0; cc < NCB; ++cc) { const long c = b * NCB + cc; const size_t idx = (size_t)c * (8 * 64 * 32) + r;
            u32x2 o; o.x = pk2(carry.x, carry.y); o.y = pk2(carry.z, carry.w); ((u32x2*)p.PV)[idx] = o;
            const float dec = __expf(p.ACS[(c * CHUNK + CHUNK - 1) * 8 + h]); const f32x4 st = ((const f32x4*)p.ST)[idx]; carry = carry * dec + st; } }
}
constexpr int SP = 136;
constexpr int SA_DT = 0, SA_ACS = 2048, SA_CM = 4096, SA_BM = SA_CM + 128 * SP * 2, SA_XT = SA_CM, SA_BT = SA_CM + 2 * 128 * SP * 2, SA_MW = SA_BT + 128 * SP * 2, SA_END = SA_MW + 8 * 16 * SP * 2;
__device__ __forceinline__ float silu_f(float x) { return x / (1.0f + __expf(-x)); }
template <int MODE> __device__ __forceinline__ void conv64(const MP& p, int L, const bf16* ub  , int xc  , int s0, int l0  ,
                                                          FLAS bf16* d0, FLAS bf16* d1, bf16* gb  , int gcol  , int gstride, const FLAS float* dts, int n) {
    const float w0 = p.sconv_w[(L * 4 + 0) * 1024 + xc], w1 = p.sconv_w[(L * 4 + 1) * 1024 + xc], w2 = p.sconv_w[(L * 4 + 2) * 1024 + xc], w3 = p.sconv_w[(L * 4 + 3) * 1024 + xc], bias = p.sconv_b[L * 1024 + xc];
#pragma unroll
    for (int hb = 0; hb < 2; ++hb) { const int lb = l0 + 32 * hb; float x[35];
#pragma unroll
        for (int i = 0; i < 35; ++i) { const int sp = s0 + lb - 3 + i; const bf16* rowp = ub + (size_t)(sp < 0 ? 0 : sp) * NU; x[i] = (i >= 3 || sp >= 0) ? bf2f(rowp[xc]) : 0.f; }
#pragma unroll
        for (int i = 0; i < 32; ++i) { const int l = lb + i; const bf16 vb = f2bf(silu_f(bias + w0 * x[i] + w1 * x[i + 1] + w2 * x[i + 2] + w3 * x[i + 3])); bf16* grow = gb + (size_t)l * gstride;
            if (MODE == 0) { d0[l * SP + n] = vb; grow[gcol] = vb; }
            if (MODE == 1) { d0[l * SP + n] = vb; d1[n * SP + l] = vb; }
            if (MODE == 2) { grow[gcol] = vb; d0[n * SP + l] = f2bf(bf2f(vb) * dts[l]); } } }
}
__device__ __forceinline__ void ssd_a(const MP& p, int L, FLAS unsigned char* lds, int bx, int G) {
    const int tid = mk_tid(), lane = tid & 63, w = __builtin_amdgcn_readfirstlane(tid >> 6), fr = lane & 15, fq = lane >> 4;
    FLAS float* dtL = (FLAS float*)(lds + SA_DT); FLAS float* acsL = (FLAS float*)(lds + SA_ACS);
    FLAS bf16* Cm = (FLAS bf16*)(lds + SA_CM); FLAS bf16* Bm = (FLAS bf16*)(lds + SA_BM); FLAS bf16* XT = (FLAS bf16*)(lds + SA_XT); FLAS bf16* BT = (FLAS bf16*)(lds + SA_BT);
    FLAS bf16* Mw = (FLAS bf16*)(lds + SA_MW + w * (16 * SP * 2));
    const int S = (int)p.S, nunits = (int)(p.T / CHUNK) * 2;
    for (int u = bx; u < nunits; u += G) {
        const int g = u & 1; const long c = u >> 1; const size_t t0 = (size_t)c * CHUNK; const int s0 = (int)(t0 % S); const size_t tb = t0 - s0;
        __syncthreads();
        {
            const int h4 = tid >> 7, l = tid & 127, h = 4 * g + h4; dtL[h4 * 128 + l] = softplusf_(bf2f(p.U[(t0 + l) * NU + U_DT + h]) + p.dt_bias[L * 8 + h]); }
        {
            const int ch = tid & 255, half = __builtin_amdgcn_readfirstlane(tid >> 8), n = ch & 127; const bool isC = __builtin_amdgcn_readfirstlane(ch >= 128 ? 1 : 0) != 0; const int xc = (isC ? 768 : 512) + 128 * g + n;
            if (isC) conv64<0>(p, L, p.U + tb * NU + U_XBC, xc, s0, 64 * half, Cm, nullptr, p.CM + t0 * 256 + g * 128, n, 256, nullptr, n);
            else conv64<1>(p, L, p.U + tb * NU + U_XBC, xc, s0, 64 * half, Bm, BT, p.CM, 0, 0, nullptr, n); }
        __syncthreads();
        if (w < 4) {
            const int h = 4 * g + w; const float a = -__expf(p.a_log[L * 8 + h]); const float x0 = dtL[w * 128 + 2 * lane] * a, x1 = dtL[w * 128 + 2 * lane + 1] * a, ps = x0 + x1; float inc = ps;
#pragma unroll
            for (int o = 1; o < 64; o <<= 1) { const float t = __shfl_up(inc, o); if (lane >= o) inc += t; }
            const float ex = inc - ps, c0 = ex + x0, c1 = ex + ps; *(FLAS f32x2*)(acsL + w * 128 + 2 * lane) = (f32x2){c0, c1};
            p.ACS[(t0 + 2 * lane) * 8 + h] = c0; p.ACS[(t0 + 2 * lane + 1) * 8 + h] = c1; }
        f32x4 cbT[8];
#pragma unroll
        for (int ct = 0; ct < 8; ++ct) cbT[ct] = (f32x4){0.f, 0.f, 0.f, 0.f};
#pragma unroll
        for (int ks = 0; ks < 4; ++ks) { const bf16x8 cf = *(const FLAS bf16x8*)(Cm + (16 * w + fr) * SP + ks * 32 + fq * 8);
#pragma unroll
            for (int ct = 0; ct < 8; ++ct) { const bf16x8 bfm = *(const FLAS bf16x8*)(Bm + (16 * ct + fr) * SP + ks * 32 + fq * 8); cbT[ct] = __builtin_amdgcn_mfma_f32_16x16x32_bf16(bfm, cf, cbT[ct], 0, 0, 0); } }
        __syncthreads();
        {
            const int ch = tid & 255, half = __builtin_amdgcn_readfirstlane(tid >> 8), h4 = __builtin_amdgcn_readfirstlane(ch >> 6), xc = 256 * g + ch;
            conv64<2>(p, L, p.U + tb * NU + U_XBC, xc, s0, 64 * half, XT, nullptr, p.XS + t0 * 512, xc, 512, dtL + h4 * 128, ch); }
        __syncthreads();
#pragma unroll 1
        for (int r = 0; r < 4; ++r) {
            const FLAS float* ac = acsL + r * 128; const int h = 4 * g + r; const float al = ac[16 * w + fr];
#pragma unroll
            for (int ct = 0; ct < 8; ++ct) { const f32x4 as = *(const FLAS f32x4*)(ac + 16 * ct + 4 * fq); const int sb = 16 * ct + 4 * fq, l = 16 * w + fr; float m0, m1, m2, m3;
                m0 = (sb + 0 <= l) ? cbT[ct].x * __expf(al - as.x) : 0.f; m1 = (sb + 1 <= l) ? cbT[ct].y * __expf(al - as.y) : 0.f; m2 = (sb + 2 <= l) ? cbT[ct].z * __expf(al - as.z) : 0.f; m3 = (sb + 3 <= l) ? cbT[ct].w * __expf(al - as.w) : 0.f;
                u32x2 o; o.x = pk2(m0, m1); o.y = pk2(m2, m3); *(FLAS u32x2*)(Mw + fr * SP + sb) = o; }
            FP_LDS_WAIT(); asm volatile("" ::: "memory");
            f32x4 yd[4], st[4];
#pragma unroll
            for (int pt = 0; pt < 4; ++pt) { yd[pt] = (f32x4){0.f, 0.f, 0.f, 0.f}; st[pt] = (f32x4){0.f, 0.f, 0.f, 0.f}; }
            const float alast = ac[127];
#pragma unroll
            for (int ks = 0; ks < 4; ++ks) { const bf16x8 am = *(const FLAS bf16x8*)(Mw + fr * SP + ks * 32 + fq * 8);
                const u32x4 braw = *(const FLAS u32x4*)(BT + (16 * w + fr) * SP + ks * 32 + fq * 8); const f32x4 e0 = *(const FLAS f32x4*)(ac + ks * 32 + fq * 8), e1 = *(const FLAS f32x4*)(ac + ks * 32 + fq * 8 + 4); u32x4 bs;
                bs.x = pk2(blo(braw.x) * __expf(alast - e0.x), bhi(braw.x) * __expf(alast - e0.y)); bs.y = pk2(blo(braw.y) * __expf(alast - e0.z), bhi(braw.y) * __expf(alast - e0.w));
                bs.z = pk2(blo(braw.z) * __expf(alast - e1.x), bhi(braw.z) * __expf(alast - e1.y)); bs.w = pk2(blo(braw.w) * __expf(alast - e1.z), bhi(braw.w) * __expf(alast - e1.w));
                const bf16x8 bsf = __builtin_bit_cast(bf16x8, bs);
#pragma unroll
                for (int pt = 0; pt < 4; ++pt) { const bf16x8 x = *(const FLAS bf16x8*)(XT + (r * 64 + 16 * pt + fr) * SP + ks * 32 + fq * 8);
                    yd[pt] = __builtin_amdgcn_mfma_f32_16x16x32_bf16(x, am, yd[pt], 0, 0, 0); st[pt] = __builtin_amdgcn_mfma_f32_16x16x32_bf16(bsf, x, st[pt], 0, 0, 0); } }
#pragma unroll
            for (int pt = 0; pt < 4; ++pt) { u32x2 o; o.x = pk2(yd[pt].x, yd[pt].y); o.y = pk2(yd[pt].z, yd[pt].w); *(u32x2*)(p.YD + (t0 + 16 * w + fr) * 512 + h * 64 + 16 * pt + 4 * fq) = o;
                *(f32x4*)(p.ST + (((size_t)c * 8 + h) * 64 + 16 * pt + fr) * 128 + 16 * w + 4 * fq) = st[pt]; }
            asm volatile("" ::: "memory");
        }
    }
    __syncthreads();
}
__device__ __forceinline__ void ssd_c(const MP& p, int L, int bx, int G) {
    const int tid = mk_tid(), lane = tid & 63, w = __builtin_amdgcn_readfirstlane(tid >> 6), fr = lane & 15, fq = lane >> 4;
    const int nunits = (int)(p.T / CHUNK) * 2;
    for (int u = bx; u < nunits; u += G) {
        const int g = u & 1; const long c = u >> 1; const size_t t0 = (size_t)c * CHUNK, t = t0 + 16 * w + fr;
        bf16x8 cf[4];
#pragma unroll
        for (int ks = 0; ks < 4; ++ks) cf[ks] = *(const bf16x8*)(p.CM + t * 256 + g * 128 + ks * 32 + fq * 8);
        f32x4 y[4][4]; float ssq = 0.f;
#pragma unroll
        for (int r = 0; r < 4; ++r) { const int h = 4 * g + r; const bf16* pv = p.PV + (((size_t)c * 8 + h) * 64) * 128; const float dsk = p.dskip[L * 8 + h], ea = __expf(p.ACS[t * 8 + h]);
            u32x2 ryd[4], rxs[4], rz[4];
#pragma unroll
            for (int pt = 0; pt < 4; ++pt) { const int ch = h * 64 + 16 * pt + 4 * fq; ryd[pt] = *(const u32x2*)(p.YD + t * 512 + ch); rxs[pt] = *(const u32x2*)(p.XS + t * 512 + ch); rz[pt] = *(const u32x2*)(p.U + t * NU + U_Z + ch); }
#pragma unroll
            for (int pt = 0; pt < 4; ++pt) { f32x4 acc = (f32x4){0.f, 0.f, 0.f, 0.f};
#pragma unroll
                for (int ks = 0; ks < 4; ++ks) { const bf16x8 a = *(const bf16x8*)(pv + (size_t)(16 * pt + fr) * 128 + ks * 32 + fq * 8); acc = __builtin_amdgcn_mfma_f32_16x16x32_bf16(a, cf[ks], acc, 0, 0, 0); }
                f32x4 yv;
                yv.x = (acc.x * ea + blo(ryd[pt].x) + dsk * blo(rxs[pt].x)) * silu_f(blo(rz[pt].x)); yv.y = (acc.y * ea + bhi(ryd[pt].x) + dsk * bhi(rxs[pt].x)) * silu_f(bhi(rz[pt].x));
                yv.z = (acc.z * ea + blo(ryd[pt].y) + dsk * blo(rxs[pt].y)) * silu_f(blo(rz[pt].y)); yv.w = (acc.w * ea + bhi(ryd[pt].y) + dsk * bhi(rxs[pt].y)) * silu_f(bhi(rz[pt].y));
                y[r][pt] = yv; ssq += (yv.x * yv.x + yv.y * yv.y) + (yv.z * yv.z + yv.w * yv.w); } }
        ssq += __shfl_xor(ssq, 16); ssq += __shfl_xor(ssq, 32);
        const float rs = 1.0f / sqrtf(ssq * (1.0f / 256.f) + RMS_EPS);
#pragma unroll
        for (int r = 0; r < 4; ++r)
#pragma unroll
            for (int pt = 0; pt < 4; ++pt) { const int cc = g * 256 + r * 64 + 16 * pt + 4 * fq; const f32x4 gn = *(const f32x4*)(p.snorm_g + L * 512 + cc); const f32x4 v = y[r][pt];
                u32x2 o; o.x = pk2(v.x * rs * gn.x, v.y * rs * gn.y); o.y = pk2(v.z * rs * gn.z, v.w * rs * gn.w); *(u32x2*)(p.YC + t * D + 256 + cc) = o; }
    }
}
}

using namespace mdl;
#define LAS __attribute__((address_space(3)))
constexpr int NWAVES = 8, NTHR = NWAVES * 64;
constexpr int LDS_BYTES = 163840, LDSCTL_OFF = LDS_BYTES - 512, MISC_OFF = LDSCTL_OFF + 320;
constexpr int CW_BAR = 4096;
#define XB_TMO      128
#define XB_XCNT(j)  (256  + 64 * (j))
#define XB_XSUB(j)  (1280 + 64 * (j))
#define XB_XGEN(j)  (2304 + 64 * (j))
#define XB_TOP      3328
#define XB_TOPGEN   3392
#define XCD_BAR_WORDS 3456
#define XB_SPIN_CAP (1u << 18)

__device__ __forceinline__ unsigned xb_ld(unsigned* p)              { return __hip_atomic_load(p, __ATOMIC_RELAXED, __HIP_MEMORY_SCOPE_AGENT); }
__device__ __forceinline__ unsigned xb_add(unsigned* p, unsigned v) { return __hip_atomic_fetch_add(p, v, __ATOMIC_RELAXED, __HIP_MEMORY_SCOPE_AGENT); }
__device__ __forceinline__ unsigned xb_xcc_id() { return (unsigned)__builtin_amdgcn_s_getreg((3 << 11) | 20) & 0xFu; }
#define XB_SPIN(cond, bar) do { unsigned _sp = 0; while (cond) { __builtin_amdgcn_s_sleep(1); \
    if ((++_sp & 255u) == 0u) { if (xb_ld(&(bar)[XB_TMO])) break; if (_sp > XB_SPIN_CAP) { atomicAdd(&(bar)[XB_TMO], 1u); break; } } } } while (0)

struct XcdBarrier {
    unsigned* bar; unsigned x;
    volatile LAS unsigned* st;
};

__device__ __forceinline__ XcdBarrier xcd_barrier_post(unsigned* bar, volatile LAS unsigned* st) {
    XcdBarrier b; b.bar = bar; b.x = xb_xcc_id(); b.st = st;
    if (threadIdx.x == 0) (void)xb_add(&bar[XB_XCNT(b.x)], 1u);
    return b;
}
__device__ __forceinline__ void xcd_barrier_complete(unsigned* bar, unsigned x, unsigned& nloc, unsigned& nx) {
    const unsigned G = gridDim.x * gridDim.y * gridDim.z;
    unsigned sum, cnt, mine, sp = 0u;
    for (;;) {
        sum = 0u; cnt = 0u; mine = 0u;
#pragma unroll
        for (unsigned j = 0; j < 16; ++j) { const unsigned c = xb_ld(&bar[XB_XCNT(j)]); sum += c; cnt += (c > 0u) ? 1u : 0u; mine = (j == x) ? c : mine; }
        if (sum == G) break;
        __builtin_amdgcn_s_sleep(1);
        if ((++sp & 255u) == 0u) { if (xb_ld(&bar[XB_TMO])) break; if (sp > XB_SPIN_CAP) { atomicAdd(&bar[XB_TMO], 1u); break; } }
    }
    nloc = mine > 0u ? mine : 1u; nx = cnt > 0u ? cnt : 1u;
}

__device__ __forceinline__ void xcd_barrier(const XcdBarrier& b) {
    asm volatile("s_waitcnt vmcnt(0)" ::: "memory");
    __syncthreads();
    if (threadIdx.x == 0) {
        unsigned* bar = b.bar;
        __builtin_amdgcn_s_waitcnt(0);
        unsigned nloc = b.st[0], nx = b.st[1];
        if (nloc == 0u) { xcd_barrier_complete(bar, b.x, nloc, nx); b.st[0] = nloc; b.st[1] = nx; }
        const unsigned old = xb_add(&bar[XB_XSUB(b.x)], 1u);
        const unsigned gen = old / nloc;
        if (old + 1u == (gen + 1u) * nloc) {
            __builtin_amdgcn_fence(__ATOMIC_RELEASE, "agent");
            asm volatile("s_waitcnt vmcnt(0)" ::: "memory");
            const unsigned og = xb_add(&bar[XB_TOP], 1u);
            const unsigned tg = og / nx;
            if (og + 1u == (tg + 1u) * nx) xb_add(&bar[XB_TOPGEN], 1u);
            else XB_SPIN(xb_ld(&bar[XB_TOPGEN]) == tg, bar);
            __builtin_amdgcn_fence(__ATOMIC_ACQUIRE, "agent");
            xb_add(&bar[XB_XGEN(b.x)], 1u);
            asm volatile("s_waitcnt vmcnt(0)" ::: "memory");
        } else {
            XB_SPIN(xb_ld(&bar[XB_XGEN(b.x)]) == gen, bar);
            __builtin_amdgcn_fence(__ATOMIC_ACQUIRE, "agent");
            asm volatile("s_waitcnt vmcnt(0)" ::: "memory");
        }
    }
    __syncthreads();
}

struct Args { MP p; long flags; };
__global__ void __launch_bounds__(NTHR, 2) mk_fwd(Args a) {
    extern __shared__ __attribute__((aligned(16))) unsigned char lds[];
    LAS unsigned char* const L3 = (LAS unsigned char*)lds;
    volatile LAS unsigned* MISC = (volatile LAS unsigned*)(L3 + MISC_OFF);
    const MP& p = a.p;
    const int tid = threadIdx.x;
    for (int u = tid; u < (LDS_BYTES - LDSCTL_OFF) / 4; u += NTHR) ((LAS unsigned*)(L3 + LDSCTL_OFF))[u] = 0u;
    __syncthreads();
    const XcdBarrier bar = xcd_barrier_post(p.ctl + CW_BAR, MISC + 8);
    const int G = gridDim.x, bx = blockIdx.x;
    const long gs = (long)G * NTHR;
#define g0 ((long)bx * NTHR + mk_tid())
#ifndef PROBE_MASK
#define PROBE_MASK 0
#endif
#define REP(k) for (int rep_ = 0; rep_ < ((PROBE_MASK >> (k)) & 1) + 1; ++rep_)
#define GRID_BAR() do { REP(10) xcd_barrier(bar); } while (0)
#ifndef PROBE_T
#define PROBE_T 0
#endif
#define PH_BEGIN(id) do { if (((PROBE_T >> (id)) & 1) && bx == 0 && tid == 0) { const unsigned long long t_ = __builtin_amdgcn_s_memrealtime(); MISC[0] = (unsigned)t_; MISC[1] = (unsigned)(t_ >> 32); } } while (0)
#define PH_END(id) do { if (((PROBE_T >> (id)) & 1) && bx == 0 && tid == 0) { const unsigned long long t0_ = ((unsigned long long)MISC[1] << 32) | MISC[0]; MISC[2] += (unsigned)(__builtin_amdgcn_s_memrealtime() - t0_); } } while (0)
    PH_BEGIN(0); REP(0) fp::prologue(p, L3, bx, G);
    GRID_BAR(); PH_END(0);
    for (int L = 0; L < DEPTH; ++L) {
        const int j = L >> 1; const bool moe = (L & 1) != 0;
        PH_BEGIN(1);
        REP(1) {
            pg8::Gemm g{p.HB, p.WIN + (size_t)L * NU * D, (int)p.T, NU, D}; pg8::StaticOrder S; S.init((int)p.T, NU, G, bx);
            pg8::EpiStore16 E{p.U, NU, rss_ptr(p, L, 0)}; pg8::gemm_phase<pg8::EpiStore16, pg8::StaticOrder, true, true>(L3, g, S, E);
            pg8::Gemm g2{p.PB16 + (size_t)L * p.T * PLE, p.WPP + (size_t)L * D * PLE, (int)p.T, D, PLE}; pg8::StaticOrder S2; S2.init((int)p.T, D, G, bx);
            pg8::EpiStore16 E2{p.PJ, D, nullptr}; pg8::gemm_phase<pg8::EpiStore16, pg8::StaticOrder, true, true>(L3, g2, S2, E2);
        }
        GRID_BAR(); PH_END(1); PH_BEGIN(2);
        REP(6) { fp::conv_module(p, L, L3, bx, G); fp::mla_proj(p, L, L3, bx, G); fp::ssd_a(p, L, L3, bx, G); }
        GRID_BAR(); PH_END(2); PH_BEGIN(3);
        REP(7) { fp::ssd_scan(p, bx, G); fp::attn_phase(p, L3, bx, G); }
        GRID_BAR(); PH_END(3); PH_BEGIN(4);
        REP(8) fp::ssd_c(p, L, bx, G);
        GRID_BAR(); PH_END(4); PH_BEGIN(5);
        {
            pg8::Gemm g{p.YC, p.WOUT + (size_t)L * D * D, (int)p.T, D, D}; pg8::StaticOrder S; S.init((int)p.T, D, G, bx);
            pg8::EpiAddH E{p.H, D, p.HB2, rss_ptr(p, L, 1)}; pg8::gemm_phase<pg8::EpiAddH, pg8::StaticOrder, true, true>(L3, g, S, E);
        }
        GRID_BAR(); PH_END(5);
        if (moe) { PH_BEGIN(6); fp::norm_phase<1>(p, L, p.ffn_g + L * D, bx, G, (LAS unsigned*)L3); GRID_BAR(); PH_END(6); PH_BEGIN(7); fp::moeplan(p, L, L3, bx, G); GRID_BAR(); PH_END(7); }
        PH_BEGIN(8);
        {
            const int rows = moe ? moe_start_of(p, j, NE) : (int)p.T;
            pg8::Gemm g{moe ? p.XB : p.HB2, moe ? p.MWGU + (size_t)j * NE * NGU * D : p.DWGU + (size_t)j * NGU * D, rows, NGU, D};
            pg8::ExpertOrder S; S.init(rows, NGU, G, bx); S.tile_e = moe ? p.TILE_E : nullptr;
            REP(3) { pg8::EpiSwiglu E{p.ACT, DFF, moe ? nullptr : rss_ptr(p, L, 1)}; pg8::gemm_phase<pg8::EpiSwiglu, pg8::ExpertOrder, true, true>(L3, g, S, E); }
            GRID_BAR(); PH_END(8); PH_BEGIN(9);
            pg8::Gemm gd{p.ACT, moe ? p.MWD + (size_t)j * NE * D * DFF : p.DWD + (size_t)j * D * DFF, rows, D, DFF};
            pg8::ExpertOrder Sd; Sd.init(rows, D, G, bx); Sd.tile_e = moe ? p.TILE_E : nullptr;
            if (moe) { pg8::EpiStore16 Ed{p.YS, D, nullptr}; pg8::gemm_phase<pg8::EpiStore16, pg8::ExpertOrder, true, true>(L3, gd, Sd, Ed); }
            else { pg8::EpiAddH Ed{p.H, D, p.HB2, rss_ptr(p, L, 2)}; pg8::gemm_phase<pg8::EpiAddH, pg8::ExpertOrder, true, true>(L3, gd, Sd, Ed); }
        }
        GRID_BAR(); PH_END(9);
        if (moe) { PH_BEGIN(10); fp::norm_phase<2>(p, L, nullptr, bx, G); GRID_BAR(); PH_END(10); }
        PH_BEGIN(11);
        {
            pg8::Gemm g{p.HB2, p.WPG + (size_t)L * D * D, (int)p.T, D, D}; pg8::StaticOrder S; S.init((int)p.T, D, G, bx);
            pg8::EpiPleF E{p.H, p.PJ, D, rss_ptr(p, L, 2), p.HB, rss_ptr(p, L + 1, 0)}; pg8::gemm_phase<pg8::EpiPleF, pg8::StaticOrder, true, true>(L3, g, S, E);
        }
        GRID_BAR(); PH_END(11);
    }
    PH_BEGIN(12); fp::norm_phase<3>(p, 0, p.fin_g, bx, G); PH_END(12);
    if (PROBE_T && bx == 0 && tid == 0) { const unsigned long long te_ = __builtin_amdgcn_s_memrealtime() + 4ull * MISC[2]; while (__builtin_amdgcn_s_memrealtime() < te_) __builtin_amdgcn_s_sleep(8); }
}
static void fill_params(MP& p, void* const* d_in, void* d_out, void* d_ws) {
    p.x = (const float*)d_in[0]; p.p = (const float*)d_in[1]; p.pos = (const int*)d_in[2];
    const float** w = &p.attn_g; for (int i = 3; i < 32; ++i) w[i - 3] = (const float*)d_in[i];
    p.out = (float*)d_out; p.B = 8; p.S = 2048; p.T = 16384; p.NSLOT = 2 * 16384 + 8 * 256;
    carve(p, (unsigned char*)d_ws);
}
extern "C" void kernel_launch(void* const* d_in, const int* in_sizes, int n_in, void* d_out, int out_size, void* d_ws, size_t ws_size, hipStream_t stream) {
    static int grid = 0;
    if (grid == 0) {
        MP q{}; q.T = 16384; q.NSLOT = 2 * 16384 + 8 * 256; const size_t need = carve(q, nullptr);
        if (n_in != 32 || ws_size < need) { fprintf(stderr, "kernel_launch: need %zu bytes of ws, have %zu (n_in %d)\n", need, ws_size, n_in); grid = -1; return; }
        int dev = 0, cus = 0, per_cu = 0;
        if (hipGetDevice(&dev) != hipSuccess || hipDeviceGetAttribute(&cus, hipDeviceAttributeMultiprocessorCount, dev) != hipSuccess) { grid = -1; return; }
        if (hipFuncSetAttribute((const void*)mk_fwd, hipFuncAttributeMaxDynamicSharedMemorySize, LDS_BYTES) != hipSuccess) { fprintf(stderr, "kernel_launch: hipFuncSetAttribute failed\n"); grid = -1; return; }
        if (hipOccupancyMaxActiveBlocksPerMultiprocessor(&per_cu, (const void*)mk_fwd, NTHR, LDS_BYTES) != hipSuccess || per_cu < 1) { fprintf(stderr, "kernel_launch: occupancy query says %d\n", per_cu); }
        (void)hipGetLastError();
        grid = cus;
    }
    if (grid < 0) return;
    Args a{}; fill_params(a.p, d_in, d_out, d_ws); a.flags = 0;
    if (hipMemsetAsync(a.p.ctl, 0, CTL_WORDS * 4, stream) != hipSuccess) return;
    hipLaunchKernelGGL(mk_fwd, dim3(grid), dim3(NTHR), LDS_BYTES, stream, a);
}
```

```cpp
#include <hip/hip_runtime.h>
#include <cstdio>
#include <cstdint>
__device__ __forceinline__ int mk_tid() { int t = threadIdx.x; asm volatile("" : "+v"(t)); return t; }
#ifndef PROBE_T
#define PROBE_T 0
#endif
constexpr int LDS_BYTES = 163840, LDSCTL_OFF = LDS_BYTES - 512, MISC_OFF = LDSCTL_OFF + 320;
#define TP_MISC(l3) ((volatile __attribute__((address_space(3))) unsigned*)((l3) + MISC_OFF))
#define TP_BEGIN(id, l3) do { if (((PROBE_T >> (id)) & 1) && blockIdx.x == 0 && threadIdx.x == 0) { const unsigned long long t_ = __builtin_amdgcn_s_memrealtime(); TP_MISC(l3)[0] = (unsigned)t_; TP_MISC(l3)[1] = (unsigned)(t_ >> 32); } } while (0)
#define TP_END(id, l3) do { if (((PROBE_T >> (id)) & 1) && blockIdx.x == 0 && threadIdx.x == 0) { const unsigned long long t0_ = ((unsigned long long)TP_MISC(l3)[1] << 32) | TP_MISC(l3)[0]; TP_MISC(l3)[2] += (unsigned)(__builtin_amdgcn_s_memrealtime() - t0_); } } while (0)

#include <cstring>
#include <cmath>
#include <cstdint>
#ifdef __HIPCC__
#define HD __host__ __device__ __forceinline__
#else
#define HD inline
#endif
typedef unsigned short bf16;
namespace mdl {
constexpr int D = 1024, DEPTH = 4, NU = 2560, NUO = 2472, DFF = 3584, NGU = 7168, NE = 8, PLE = 256;
constexpr int CK = 31, SCONV = 4, CHUNK = 128, NH = 8, HP = 64, NS = 128;
constexpr float RMS_EPS = 1e-6f, LN_EPS = 1e-5f;
constexpr float QSCALE = 0.10206207261596577f * 1.4426950408889634f;
constexpr int U_Z = 512, U_XBC = 1024, U_CQ = 2048, U_CKV = 2304, U_KR = 2432, U_DT = 2464;

HD float bf2f(bf16 v) { unsigned u = (unsigned)v << 16; float f; memcpy(&f, &u, 4); return f; }
HD bf16 f2bf(float f) { unsigned u; memcpy(&u, &f, 4); u += 0x7fffu + ((u >> 16) & 1u); return (bf16)(u >> 16); }
HD float sigmoidf_(float x) { return 1.0f / (1.0f + expf(-x)); }
HD float siluf_(float x) { return x / (1.0f + expf(-x)); }
HD float softplusf_(float x) { return x > 20.f ? x : log1pf(expf(x)); }
HD int ucol_src(int n) { return n < 2048 ? n : (n < U_DT ? n + 8 : (n < NUO ? n - U_DT + 2048 : -1)); }

struct MP {
    const float *x, *p; const int* pos;
    const float *attn_g, *w_in, *cdw_w, *cdw_b, *cln_g, *cln_b, *sconv_w, *sconv_b, *dt_bias, *a_log, *dskip, *snorm_g, *qn_g, *w_uq, *kvn_g, *w_ukv,
        *w_out, *ffn_g, *dwg, *dwu, *dwd, *router, *mwg, *mwu, *mwd, *ple_g, *ple_wg, *ple_wp, *fin_g;
    float* out;
    long B, S, T, NSLOT;
    unsigned* ctl;
    bf16 *WIN, *WUQ, *WUKV, *WOUT, *DWGU, *DWD, *MWGU, *MWD, *WPG, *WPP;
    float *RSSP, *H, *CS, *DT, *ACS, *ST, *CB, *YPRE, *TOPG;
    bf16 *HB2, *HB, *U, *YC, *Q, *KK, *V, *XS, *BM, *CM, *YD, *PV, *PB16, *PJ, *ACT, *XB, *YS;
    int *TOPE, *POS, *TOKSLOT, *TILE_E, *BCNT;
};
constexpr int CTL_WORDS = 65536;
HD unsigned* cnt_ptr(const MP& p, int j) { return p.ctl + 1024 + j * 64; }
HD float* rss_ptr(const MP& p, int L, int k) { return p.RSSP + (size_t)(L * 3 + k) * p.T * 16; }

inline size_t carve(MP& p, unsigned char* ws) {
    size_t o = 0; const size_t T = p.T, NSL = p.NSLOT;
    auto take = [&](size_t bytes) { size_t r = o; o += (bytes + 255) & ~(size_t)255; return ws + r; };
    p.ctl = (unsigned*)take(CTL_WORDS * 4);
    p.WIN = (bf16*)take((size_t)DEPTH * NU * D * 2); p.WUQ = (bf16*)take((size_t)DEPTH * 512 * 256 * 2); p.WUKV = (bf16*)take((size_t)DEPTH * 512 * 128 * 2);
    p.WOUT = (bf16*)take((size_t)DEPTH * D * D * 2); p.DWGU = (bf16*)take((size_t)2 * NGU * D * 2); p.DWD = (bf16*)take((size_t)2 * D * DFF * 2);
    p.MWGU = (bf16*)take((size_t)2 * NE * NGU * D * 2); p.MWD = (bf16*)take((size_t)2 * NE * D * DFF * 2);
    p.WPG = (bf16*)take((size_t)DEPTH * D * D * 2); p.WPP = (bf16*)take((size_t)DEPTH * D * PLE * 2);
    p.RSSP = (float*)take((size_t)13 * T * 16 * 4); p.H = (float*)take(T * D * 4); p.HB = (bf16*)take(T * D * 2); p.HB2 = (bf16*)take(T * D * 2); p.CS = (float*)take(T * 32 * 4);
    p.PB16 = (bf16*)take((size_t)DEPTH * T * PLE * 2); p.PJ = (bf16*)take(T * D * 2);
    p.TOPE = (int*)take(T * 2 * 4); p.TOPG = (float*)take(T * 2 * 4); p.POS = (int*)take(T * 2 * 4); p.TOKSLOT = (int*)take(T * 2 * 4); p.TILE_E = (int*)take(1024 * 4); p.BCNT = (int*)take(1024 * NE * 4);
    p.XB = (bf16*)take(NSL * D * 2); p.YS = p.XB;
    const size_t r1 = o;
    p.U = (bf16*)take(T * NU * 2); p.YC = (bf16*)take(T * D * 2); p.Q = (bf16*)take(T * 384 * 2); p.KK = (bf16*)take(T * 384 * 2); p.V = (bf16*)take(T * 256 * 2);
    p.XS = (bf16*)take(T * 512 * 2); p.BM = (bf16*)take(T * 256 * 2); p.CM = (bf16*)take(T * 256 * 2); p.YD = (bf16*)take(T * 512 * 2);
    p.DT = (float*)take(T * 8 * 4); p.ACS = (float*)take(T * 8 * 4); p.ST = (float*)take(T / CHUNK * NH * HP * NS * 4); p.PV = (bf16*)take(T / CHUNK * NH * HP * NS * 2);
    p.CB = nullptr; p.YPRE = nullptr;
    const size_t r1end = o; o = r1;
    p.ACT = (bf16*)take(NSL * DFF * 2);
    if (o < r1end) o = r1end;
    return o;
}

struct V8 { float v[8]; };
HD V8 ld8(const bf16* p) { V8 r; const uint4 u = *(const uint4*)p; const unsigned w[4] = {u.x, u.y, u.z, u.w};
    for (int i = 0; i < 4; ++i) { r.v[2 * i] = bf2f((bf16)(w[i] & 0xffff)); r.v[2 * i + 1] = bf2f((bf16)(w[i] >> 16)); } return r; }
HD float dot8(const V8& a, const V8& b) { float s = 0.f; for (int i = 0; i < 8; ++i) s += a.v[i] * b.v[i]; return s; }

template <class Epi> HD void gemm_nt(const bf16* A, long lda, const bf16* Bt, long ldb, long M, long N, long K, const Epi& epi, long g0, long gs) {
    const long ntn = N / 4, ntile = (M / 4) * ntn;
    for (long t = g0; t < ntile; t += gs) {
        const long m0 = (t / ntn) * 4, n0 = (t % ntn) * 4; float acc[4][4];
        for (int i = 0; i < 4; ++i) for (int j = 0; j < 4; ++j) acc[i][j] = 0.f;
        for (long k = 0; k < K; k += 8) { V8 a0 = ld8(A + (m0 + 0) * lda + k), a1 = ld8(A + (m0 + 1) * lda + k), a2 = ld8(A + (m0 + 2) * lda + k), a3 = ld8(A + (m0 + 3) * lda + k);
            V8 b0 = ld8(Bt + (n0 + 0) * ldb + k), b1 = ld8(Bt + (n0 + 1) * ldb + k), b2 = ld8(Bt + (n0 + 2) * ldb + k), b3 = ld8(Bt + (n0 + 3) * ldb + k);
            acc[0][0] += dot8(a0, b0); acc[0][1] += dot8(a0, b1); acc[0][2] += dot8(a0, b2); acc[0][3] += dot8(a0, b3);
            acc[1][0] += dot8(a1, b0); acc[1][1] += dot8(a1, b1); acc[1][2] += dot8(a1, b2); acc[1][3] += dot8(a1, b3);
            acc[2][0] += dot8(a2, b0); acc[2][1] += dot8(a2, b1); acc[2][2] += dot8(a2, b2); acc[2][3] += dot8(a2, b3);
            acc[3][0] += dot8(a3, b0); acc[3][1] += dot8(a3, b1); acc[3][2] += dot8(a3, b2); acc[3][3] += dot8(a3, b3); }
        epi(m0 + 0, n0 + 0, acc[0][0]); epi(m0 + 0, n0 + 1, acc[0][1]); epi(m0 + 0, n0 + 2, acc[0][2]); epi(m0 + 0, n0 + 3, acc[0][3]);
        epi(m0 + 1, n0 + 0, acc[1][0]); epi(m0 + 1, n0 + 1, acc[1][1]); epi(m0 + 1, n0 + 2, acc[1][2]); epi(m0 + 1, n0 + 3, acc[1][3]);
        epi(m0 + 2, n0 + 0, acc[2][0]); epi(m0 + 2, n0 + 1, acc[2][1]); epi(m0 + 2, n0 + 2, acc[2][2]); epi(m0 + 2, n0 + 3, acc[2][3]);
        epi(m0 + 3, n0 + 0, acc[3][0]); epi(m0 + 3, n0 + 1, acc[3][1]); epi(m0 + 3, n0 + 2, acc[3][2]); epi(m0 + 3, n0 + 3, acc[3][3]);
    }
}
struct EpiStoreBf { bf16* C; long ldc; HD void operator()(long m, long n, float v) const { C[m * ldc + n] = f2bf(v); } };
struct EpiAddF32 { float* C; long ldc; HD void operator()(long m, long n, float v) const { C[m * ldc + n] += v; } };
struct EpiPle { float* H; const bf16* PJ; HD void operator()(long m, long n, float v) const { H[m * D + n] += bf2f(PJ[m * D + n]) * sigmoidf_(v); } };

HD void tr_elem(const float* W, long K, long N, bf16* WT, long i) { const long n = i / K, k = i % K; WT[i] = f2bf(W[k * N + n]); }
HD void nv_prologue(const MP& p, long g0, long gs) {
    const long T = p.T;
    for (long i = g0; i < (long)DEPTH * NU * D; i += gs) { const long l = i / ((long)NU * D), r = i % ((long)NU * D), n = r / D, k = r % D; const int c = ucol_src((int)n);
        p.WIN[i] = c < 0 ? (bf16)0 : f2bf(p.w_in[(l * D + k) * NUO + c]); }
    for (long i = g0; i < (long)DEPTH * 512 * 256; i += gs) { const long l = i / (512 * 256), r = i % (512 * 256), n = r / 256, k = r % 256; p.WUQ[i] = n < 384 ? f2bf(p.w_uq[(l * 256 + k) * 384 + n]) : (bf16)0; }
    for (long i = g0; i < (long)DEPTH * 512 * 128; i += gs) { const long l = i / (512 * 128), r = i % (512 * 128), n = r / 128, k = r % 128; p.WUKV[i] = f2bf(p.w_ukv[(l * 128 + k) * 512 + n]); }
    for (long i = g0; i < (long)DEPTH * D * D; i += gs) { const long l = i / ((long)D * D); tr_elem(p.w_out + l * D * D, D, D, p.WOUT + l * D * D, i % ((long)D * D)); tr_elem(p.ple_wg + l * D * D, D, D, p.WPG + l * D * D, i % ((long)D * D)); }
    for (long i = g0; i < (long)DEPTH * D * PLE; i += gs) { const long l = i / ((long)D * PLE); tr_elem(p.ple_wp + l * PLE * D, PLE, D, p.WPP + l * D * PLE, i % ((long)D * PLE)); }
    for (long i = g0; i < (long)18 * NGU * D; i += gs) { const long mt = i / ((long)NGU * D), r = i % ((long)NGU * D), n = r / D, k = r % D, tl = n / 256, rr = n % 256, col = tl * 128 + (rr & 127);
        const float* src; bf16* dst;
        if (mt < 2) { src = (rr < 128 ? p.dwg : p.dwu) + mt * (long)D * DFF; dst = p.DWGU + mt * (long)NGU * D; } else { src = (rr < 128 ? p.mwg : p.mwu) + (mt - 2) * (long)D * DFF; dst = p.MWGU + (mt - 2) * (long)NGU * D; }
        dst[r] = f2bf(src[k * DFF + col]); }
    for (long i = g0; i < (long)18 * D * DFF; i += gs) { const long mt = i / ((long)D * DFF), r = i % ((long)D * DFF);
        if (mt < 2) tr_elem(p.dwd + mt * (long)DFF * D, DFF, D, p.DWD + mt * (long)D * DFF, r); else tr_elem(p.mwd + (mt - 2) * (long)DFF * D, DFF, D, p.MWD + (mt - 2) * (long)D * DFF, r); }
    for (long i = g0; i < T * D; i += gs) p.H[i] = p.x[i];
    for (long i = g0; i < (long)DEPTH * T * PLE; i += gs) p.PB16[i] = f2bf(p.p[i]);
    for (long i = g0; i < T * 16; i += gs) { const long t = i / 16; const int j = (int)(i % 16); const float inv = powf(10000.0f, -(float)(2 * j) / 32.0f), ang = (float)p.pos[t] * inv;
        p.CS[t * 32 + j] = cosf(ang); p.CS[t * 32 + 16 + j] = sinf(ang); }
}
HD void nv_norm(const MP& p, const float* g, long g0, long gs) {
    for (long t = g0; t < p.T; t += gs) { const float* h = p.H + t * D; float ss = 0.f; for (int i = 0; i < D; ++i) ss += h[i] * h[i];
        const float r = 1.0f / sqrtf(ss / D + RMS_EPS); for (int i = 0; i < D; ++i) p.HB[t * D + i] = f2bf(h[i] * r * g[i]); }
}
HD void nv_inproj(const MP& p, int L, long g0, long gs) {
    gemm_nt(p.HB, D, p.WIN + (long)L * NU * D, D, p.T, NU, D, EpiStoreBf{p.U, NU}, g0, gs);
    gemm_nt(p.PB16 + (long)L * p.T * PLE, PLE, p.WPP + (long)L * D * PLE, PLE, p.T, D, PLE, EpiStoreBf{p.PJ, D}, g0, gs);
}
HD float cm_conv(const MP& p, int L, long b, long s, int c) {
    float acc = p.cdw_b[L * 256 + c];
    for (int j = 0; j < CK; ++j) { const long sp = s - (CK - 1) + j; if (sp < 0) continue; const bf16* u = p.U + (b * p.S + sp) * NU;
        acc += p.cdw_w[(L * CK + j) * 256 + c] * (bf2f(u[c]) * sigmoidf_(bf2f(u[256 + c]))); }
    return acc;
}
HD void nv_mixA1(const MP& p, int L, long g0, long gs, int parts = 15) {
    const long T = p.T, S = p.S;
    if (parts & 1) for (long i = g0; i < T * 4; i += gs) { const long t = i / 4, b = t / S, s = t % S; const int gq = (int)(i % 4);
        float sm = 0.f, sq = 0.f; for (int c = 0; c < 64; ++c) { const float v = cm_conv(p, L, b, s, gq * 64 + c); sm += v; sq += v * v; }
        const float mu = sm / 64.f; float var = sq / 64.f - mu * mu; if (var < 0.f) var = 0.f; const float rs = 1.0f / sqrtf(var + LN_EPS);
        for (int c = 0; c < 64; ++c) { const int ch = gq * 64 + c; const float v = (cm_conv(p, L, b, s, ch) - mu) * rs * p.cln_g[L * 256 + ch] + p.cln_b[L * 256 + ch]; p.YC[t * D + ch] = f2bf(siluf_(v)); } }
    if (parts & 2) for (long i = g0; i < T * 1024; i += gs) { const long t = i / 1024, b = t / S, s = t % S; const int c = (int)(i % 1024);
        float acc = p.sconv_b[L * 1024 + c]; for (int j = 0; j < SCONV; ++j) { const long sp = s - (SCONV - 1) + j; if (sp < 0) continue; acc += p.sconv_w[(L * SCONV + j) * 1024 + c] * bf2f(p.U[(b * S + sp) * NU + U_XBC + c]); }
        const bf16 v = f2bf(siluf_(acc)); if (c < 512) p.XS[t * 512 + c] = v; else if (c < 768) p.BM[t * 256 + c - 512] = v; else p.CM[t * 256 + c - 768] = v; }
    if (parts & 2) for (long i = g0; i < T * 8; i += gs) { const long t = i / 8; const int h = (int)(i % 8); p.DT[i] = softplusf_(bf2f(p.U[t * NU + U_DT + h]) + p.dt_bias[L * 8 + h]); }
    if (parts & 8) for (long i = g0; i < T * 4 * 80; i += gs) { const long t = i / 320; const int h = (int)((i % 320) / 80), ii = (int)(i % 80); const bf16* cq = p.U + t * NU + U_CQ;
        float ss = 0.f; for (int k = 0; k < 256; ++k) { const float v = bf2f(cq[k]); ss += v * v; } const float r = 1.0f / sqrtf(ss / 256.f + RMS_EPS);
        const bf16* W = p.WUQ + (long)L * 512 * 256;
        if (ii < 64) { const int n = h * 96 + ii; float a = 0.f; for (int k = 0; k < 256; ++k) a += bf2f(f2bf(bf2f(cq[k]) * r * p.qn_g[L * 256 + k])) * bf2f(W[n * 256 + k]); p.Q[t * 384 + n] = f2bf(a * QSCALE); }
        else { const int j = ii - 64, n1 = h * 96 + 64 + j, n2 = n1 + 16; float a1 = 0.f, a2 = 0.f;
            for (int k = 0; k < 256; ++k) { const float xv = bf2f(f2bf(bf2f(cq[k]) * r * p.qn_g[L * 256 + k])); a1 += xv * bf2f(W[n1 * 256 + k]); a2 += xv * bf2f(W[n2 * 256 + k]); }
            const float c = p.CS[t * 32 + j], sn = p.CS[t * 32 + 16 + j]; p.Q[t * 384 + n1] = f2bf((a1 * c - a2 * sn) * QSCALE); p.Q[t * 384 + n2] = f2bf((a1 * sn + a2 * c) * QSCALE); } }
    if (parts & 8) for (long i = g0; i < T * 512; i += gs) { const long t = i / 512; const int n = (int)(i % 512); const bf16* ck = p.U + t * NU + U_CKV;
        float ss = 0.f; for (int k = 0; k < 128; ++k) { const float v = bf2f(ck[k]); ss += v * v; } const float r = 1.0f / sqrtf(ss / 128.f + RMS_EPS);
        const bf16* W = p.WUKV + (long)L * 512 * 128; float a = 0.f; for (int k = 0; k < 128; ++k) a += bf2f(f2bf(bf2f(ck[k]) * r * p.kvn_g[L * 128 + k])) * bf2f(W[n * 128 + k]);
        const int h = n / 128, d = n % 128; if (d < 64) p.KK[t * 384 + h * 96 + d] = f2bf(a); else p.V[t * 256 + h * 64 + d - 64] = f2bf(a); }
    if (parts & 8) for (long i = g0; i < T * 16; i += gs) { const long t = i / 16; const int j = (int)(i % 16); const float x1 = bf2f(p.U[t * NU + U_KR + j]), x2 = bf2f(p.U[t * NU + U_KR + 16 + j]), c = p.CS[t * 32 + j], sn = p.CS[t * 32 + 16 + j];
        const bf16 o1 = f2bf(x1 * c - x2 * sn), o2 = f2bf(x1 * sn + x2 * c); for (int h = 0; h < 4; ++h) { p.KK[t * 384 + h * 96 + 64 + j] = o1; p.KK[t * 384 + h * 96 + 80 + j] = o2; } }
}
HD void nv_mixA2(const MP& p, int L, long g0, long gs) {
    const long NC = p.T / CHUNK;
    for (long i = g0; i < NC * 8; i += gs) { const long c = i / 8; const int h = (int)(i % 8); const float a = -expf(p.a_log[L * 8 + h]); float cs = 0.f;
        for (int l = 0; l < CHUNK; ++l) { const long t = c * CHUNK + l; cs += p.DT[t * 8 + h] * a; p.ACS[t * 8 + h] = cs; } }
}
HD void nv_mixA3a(const MP& p, long g0, long gs) {
    const long NC = p.T / CHUNK;
    for (long i = g0; i < NC * 2 * CHUNK * CHUNK; i += gs) { const long u = i / (CHUNK * CHUNK), c = u / 2; const int g = (int)(u % 2), l = (int)((i / CHUNK) % CHUNK), s = (int)(i % CHUNK);
        const bf16* cm = p.CM + (c * CHUNK + l) * 256 + g * 128; const bf16* bm = p.BM + (c * CHUNK + s) * 256 + g * 128; float a = 0.f; for (int n = 0; n < 128; ++n) a += bf2f(cm[n]) * bf2f(bm[n]); p.CB[i] = a; }
}
HD void nv_mixA3b(const MP& p, long g0, long gs) {
    const long T = p.T, NC = T / CHUNK;
    for (long i = g0; i < T * 512; i += gs) { const long t = i / 512, c = t / CHUNK; const int ch = (int)(i % 512), h = ch / 64, g = h / 4, l = (int)(t % CHUNK);
        const float* cb = p.CB + ((c * 2 + g) * CHUNK + l) * CHUNK; const float al = p.ACS[t * 8 + h]; float a = 0.f;
        for (int s = 0; s <= l; ++s) { const long ts = c * CHUNK + s; a += cb[s] * expf(al - p.ACS[ts * 8 + h]) * p.DT[ts * 8 + h] * bf2f(p.XS[ts * 512 + ch]); }
        p.YD[i] = f2bf(a); }
    for (long i = g0; i < NC * 8 * 64 * 128; i += gs) { const long c = i / (8 * 64 * 128); const int h = (int)((i / (64 * 128)) % 8), pp = (int)((i / 128) % 64), n = (int)(i % 128), g = h / 4;
        const float alast = p.ACS[(c * CHUNK + CHUNK - 1) * 8 + h]; float a = 0.f;
        for (int l = 0; l < CHUNK; ++l) { const long t = c * CHUNK + l; a += bf2f(p.BM[t * 256 + g * 128 + n]) * expf(alast - p.ACS[t * 8 + h]) * p.DT[t * 8 + h] * bf2f(p.XS[t * 512 + h * 64 + pp]); }
        p.ST[i] = a; }
}
HD void nv_mixB1(const MP& p, long g0, long gs) {
    const long NCB = p.S / CHUNK;
    for (long i = g0; i < p.B * 8 * 64 * 128; i += gs) { const long b = i / (8 * 64 * 128); const long r = i % (8 * 64 * 128); const int h = (int)(r / (64 * 128)); float carry = 0.f;
        for (long cc = 0; cc < NCB; ++cc) { const long c = b * NCB + cc; const long idx = c * (8 * 64 * 128) + r; p.PV[idx] = f2bf(carry); carry = carry * expf(p.ACS[(c * CHUNK + CHUNK - 1) * 8 + h]) + p.ST[idx]; } }
}
HD void nv_attn(const MP& p, long g0, long gs) {
    const long T = p.T, S = p.S;
    for (long i = g0; i < T * 4; i += gs) { const long t = i / 4, b = t / S, s = t % S; const int h = (int)(i % 4);
        float q[96], o[64]; for (int d = 0; d < 96; ++d) q[d] = bf2f(p.Q[t * 384 + h * 96 + d]); for (int d = 0; d < 64; ++d) o[d] = 0.f; float m = -1e30f, l = 0.f;
        for (long k = 0; k <= s; ++k) { const long tk = b * S + k; const bf16* kk = p.KK + tk * 384 + h * 96; float sc = 0.f; for (int d = 0; d < 96; ++d) sc += q[d] * bf2f(kk[d]);
            const float mn = sc > m ? sc : m, f = exp2f(m - mn), pr = exp2f(sc - mn); l = l * f + pr; const bf16* vv = p.V + tk * 256 + h * 64; for (int d = 0; d < 64; ++d) o[d] = o[d] * f + pr * bf2f(vv[d]); m = mn; }
        for (int d = 0; d < 64; ++d) p.YC[t * D + 768 + h * 64 + d] = f2bf(o[d] / l); }
}
HD void nv_mixC1(const MP& p, int L, long g0, long gs) {
    const long T = p.T;
    for (long i = g0; i < T * 512; i += gs) { const long t = i / 512, c = t / CHUNK; const int ch = (int)(i % 512), h = ch / 64, pp = ch % 64, g = h / 4;
        const bf16* cm = p.CM + t * 256 + g * 128; const bf16* pv = p.PV + ((c * 8 + h) * 64 + pp) * 128; float a = 0.f; for (int n = 0; n < 128; ++n) a += bf2f(cm[n]) * bf2f(pv[n]);
        const float y = a * expf(p.ACS[t * 8 + h]) + bf2f(p.YD[i]) + p.dskip[L * 8 + h] * bf2f(p.XS[i]); p.YPRE[i] = y * siluf_(bf2f(p.U[t * NU + U_Z + ch])); }
}
HD void nv_mixC2(const MP& p, int L, long g0, long gs) {
    for (long i = g0; i < p.T * 2; i += gs) { const long t = i / 2; const int g = (int)(i % 2); const float* y = p.YPRE + t * 512 + g * 256; float ss = 0.f; for (int k = 0; k < 256; ++k) ss += y[k] * y[k];
        const float r = 1.0f / sqrtf(ss / 256.f + RMS_EPS); for (int k = 0; k < 256; ++k) p.YC[t * D + 256 + g * 256 + k] = f2bf(y[k] * r * p.snorm_g[L * 512 + g * 256 + k]); }
}
HD void nv_outproj(const MP& p, int L, long g0, long gs) { gemm_nt(p.YC, D, p.WOUT + (long)L * D * D, D, p.T, D, D, EpiAddF32{p.H, D}, g0, gs); }
HD void nv_router(const MP& p, int L, long g0, long gs) {
    const int j = L / 2; const float* R = p.router + (long)j * D * NE; const float* g = p.ffn_g + L * D; unsigned* cnt = cnt_ptr(p, j);
    for (long t = g0; t < p.T; t += gs) { const float* h = p.H + t * D; float ss = 0.f; for (int i = 0; i < D; ++i) ss += h[i] * h[i]; const float r = 1.0f / sqrtf(ss / D + RMS_EPS);
        float lg[NE]; for (int e = 0; e < NE; ++e) lg[e] = 0.f; for (int i = 0; i < D; ++i) { const float v = h[i] * r * g[i]; for (int e = 0; e < NE; ++e) lg[e] += v * R[i * NE + e]; }
        int e0 = 0; float v0 = lg[0]; for (int e = 1; e < NE; ++e) if (lg[e] > v0) { v0 = lg[e]; e0 = e; }
        int e1 = -1; float v1 = -3.0e38f; for (int e = 0; e < NE; ++e) if (e != e0 && lg[e] > v1) { v1 = lg[e]; e1 = e; }
        const float g1 = 1.0f / (1.0f + expf(v0 - v1)), gg0 = 1.0f - g1; p.TOPE[t * 2] = e0; p.TOPE[t * 2 + 1] = e1; p.TOPG[t * 2] = gg0; p.TOPG[t * 2 + 1] = g1;
#ifdef __HIP_DEVICE_COMPILE__
        p.POS[t * 2] = (int)atomicAdd(cnt + e0, 1u); p.POS[t * 2 + 1] = (int)atomicAdd(cnt + e1, 1u);
#else
        p.POS[t * 2] = (int)__atomic_fetch_add(cnt + e0, 1u, __ATOMIC_RELAXED); p.POS[t * 2 + 1] = (int)__atomic_fetch_add(cnt + e1, 1u, __ATOMIC_RELAXED);
#endif
    }
}
HD int moe_start_of(const MP& p, int j, int E) { const unsigned* cnt = cnt_ptr(p, j); int o = 0; for (int e = 0; e < NE; ++e) if (e < E) o += (int)((cnt[e] + 255u) / 256u) * 256; return o; }
HD void nv_moeplan(const MP& p, int L, long g0, long gs) {
    const int j = L / 2;
    for (long i = g0; i < p.T * 2; i += gs) { const long t = i / 2; const int slot = moe_start_of(p, j, p.TOPE[i]) + p.POS[i]; p.TOKSLOT[i] = slot; for (int k = 0; k < D; ++k) p.XB[(long)slot * D + k] = p.HB[t * D + k]; }
    for (long i = g0; i < 1024; i += gs) { int e = -1; if (i * 256 < moe_start_of(p, j, NE)) { e = 0; for (int q = 1; q < NE; ++q) if (i * 256 >= moe_start_of(p, j, q)) e = q; } p.TILE_E[i] = e; }
}
HD void nv_gateup(const MP& p, int L, long g0, long gs) {
    const int j = L / 2; const bool moe = L & 1; long rows = p.T; const bf16* Ain = p.HB;
    if (moe) { rows = moe_start_of(p, j, NE); Ain = p.XB; }
    for (long i = g0; i < (rows / 4) * DFF; i += gs) { const long m0 = (i / DFF) * 4; const int jj = (int)(i % DFF); const int e = moe ? p.TILE_E[m0 / 256] : 0;
        const bf16* W = moe ? p.MWGU + ((long)j * NE + e) * NGU * D : p.DWGU + (long)j * NGU * D; const long rg = (jj / 128) * 256 + (jj % 128), ru = rg + 128; float ag[4] = {0, 0, 0, 0}, au[4] = {0, 0, 0, 0};
        for (int k = 0; k < D; k += 8) { const V8 wg = ld8(W + rg * D + k), wu = ld8(W + ru * D + k); for (int r = 0; r < 4; ++r) { const V8 a = ld8(Ain + (m0 + r) * D + k); ag[r] += dot8(a, wg); au[r] += dot8(a, wu); } }
        for (int r = 0; r < 4; ++r) p.ACT[(m0 + r) * DFF + jj] = f2bf(siluf_(ag[r]) * au[r]); }
}
struct EpiYs { bf16* C; HD void operator()(long m, long n, float v) const { C[m * D + n] = f2bf(v); } };
HD void nv_down(const MP& p, int L, long g0, long gs) {
    const int j = L / 2;
    if (!(L & 1)) { gemm_nt(p.ACT, DFF, p.DWD + (long)j * D * DFF, DFF, p.T, D, DFF, EpiAddF32{p.H, D}, g0, gs); return; }
    const long rows = moe_start_of(p, j, NE);
    for (long tl = 0; tl < rows / 256; ++tl) { const int e = p.TILE_E[tl]; gemm_nt(p.ACT + tl * 256 * DFF, DFF, p.MWD + ((long)j * NE + e) * D * DFF, DFF, 256, D, DFF, EpiYs{p.YS + tl * 256 * D}, g0, gs); }
}
HD void nv_norm3(const MP& p, int L, long g0, long gs) {
    const float* g = p.ple_g + L * D;
    for (long t = g0; t < p.T; t += gs) { float* h = p.H + t * D;
        if (L & 1) { const bf16* y0 = p.YS + (long)p.TOKSLOT[t * 2] * D; const bf16* y1 = p.YS + (long)p.TOKSLOT[t * 2 + 1] * D; const float a = p.TOPG[t * 2], b = p.TOPG[t * 2 + 1]; for (int i = 0; i < D; ++i) h[i] += a * bf2f(y0[i]) + b * bf2f(y1[i]); }
        float ss = 0.f; for (int i = 0; i < D; ++i) ss += h[i] * h[i]; const float r = 1.0f / sqrtf(ss / D + RMS_EPS); for (int i = 0; i < D; ++i) p.HB[t * D + i] = f2bf(h[i] * r * g[i]); }
}
HD void nv_ple(const MP& p, int L, long g0, long gs) { gemm_nt(p.HB, D, p.WPG + (long)L * D * D, D, p.T, D, D, EpiPle{p.H, p.PJ}, g0, gs); }
HD void nv_final(const MP& p, long g0, long gs) {
    for (long t = g0; t < p.T; t += gs) { const float* h = p.H + t * D; float ss = 0.f; for (int i = 0; i < D; ++i) ss += h[i] * h[i]; const float r = 1.0f / sqrtf(ss / D + RMS_EPS); for (int i = 0; i < D; ++i) p.out[t * D + i] = h[i] * r * p.fin_g[i]; }
}
enum { NV_PROLOGUE = 0, NV_NORM1, NV_INPROJ, NV_A1, NV_A2, NV_A3A, NV_A3B, NV_B1, NV_ATTN, NV_C1, NV_C2, NV_OUTPROJ, NV_NORM2, NV_ROUTER, NV_MOEPLAN, NV_GATEUP, NV_DOWN, NV_NORM3, NV_PLE, NV_FINAL, NV_NPH };
HD void nv_run(const MP& p, int ph, int L, long g0, long gs) {
    switch (ph) {
    case NV_PROLOGUE: nv_prologue(p, g0, gs); break; case NV_NORM1: nv_norm(p, p.attn_g + L * D, g0, gs); break; case NV_INPROJ: nv_inproj(p, L, g0, gs); break;
    case NV_A1: nv_mixA1(p, L, g0, gs); break; case NV_A2: nv_mixA2(p, L, g0, gs); break; case NV_A3A: nv_mixA3a(p, g0, gs); break; case NV_A3B: nv_mixA3b(p, g0, gs); break;
    case NV_B1: nv_mixB1(p, g0, gs); break; case NV_ATTN: nv_attn(p, g0, gs); break; case NV_C1: nv_mixC1(p, L, g0, gs); break; case NV_C2: nv_mixC2(p, L, g0, gs); break;
    case NV_OUTPROJ: nv_outproj(p, L, g0, gs); break; case NV_NORM2: nv_norm(p, p.ffn_g + L * D, g0, gs); break; case NV_ROUTER: if (L & 1) nv_router(p, L, g0, gs); break;
    case NV_MOEPLAN: if (L & 1) nv_moeplan(p, L, g0, gs); break; case NV_GATEUP: nv_gateup(p, L, g0, gs); break; case NV_DOWN: nv_down(p, L, g0, gs); break;
    case NV_NORM3: nv_norm3(p, L, g0, gs); break; case NV_PLE: nv_ple(p, L, g0, gs); break; case NV_FINAL: nv_final(p, g0, gs); break; }
}
}

namespace pg8 {
#define PG8_LAS __attribute__((address_space(3)))
typedef unsigned short bf16_t;
typedef short bf16x8 __attribute__((ext_vector_type(8)));
typedef float f32x4 __attribute__((ext_vector_type(4)));
typedef unsigned u32x4 __attribute__((ext_vector_type(4)));
constexpr int BM = 256, BK = 64, HALF = 128, HTB = HALF * BK * 2  , STAGE_BYTES = 8 * HTB, NXCD = 8, WGM = 8;

__host__ __device__ __forceinline__ int lds_byte(int r, int c) { const int st = (r >> 4) * 2 + (c >> 5), rr = r & 15, cc = c & 31, ob = rr * 64 + cc * 2; return st * 1024 + (ob ^ (((ob >> 9) & 1) << 5)); }
__host__ __device__ __forceinline__ void stage_rc(int b, int& R, int& C) { const int st = b / 1024, sb = b % 1024, swz = sb ^ (((sb >> 9) & 1) << 5); R = (st >> 1) * 16 + swz / 64; C = (st & 1) * 32 + (swz % 64) / 2; }
__host__ __device__ __forceinline__ int perm32(int rho) { const int n = rho >> 4, i = rho & 15; return 8 * (i >> 2) + 4 * n + (i & 3); }

struct Unit { int pm, pn, cn, koff, ks; };
struct Gemm { const bf16_t* A; const bf16_t* Bt; int M, N, K, ld; };

struct StaticOrder {
    int nM, nN, nwg, G, c;
    __host__ __device__ void init(int M, int N, int G_, int c_) { nM = M / BM; nN = N / BM; nwg = nM * nN; G = G_; c = c_; }
    __host__ __device__ bool next(int i, Unit& u) const {
        const long L = (long)i * G + c; if (L >= nwg) return false;
        int wgid = (int)L; { const int q = nwg / NXCD, r = nwg % NXCD, xcd = wgid % NXCD, off = wgid / NXCD; wgid = (xcd < r ? xcd * (q + 1) : r * (q + 1) + (xcd - r) * q) + off; }
        const int nig = WGM * nN, gid = wgid / nig, fm = gid * WGM, gsz = (nM - fm) < WGM ? (nM - fm) : WGM;
        u.pm = fm + ((wgid % nig) % gsz); u.pn = (wgid % nig) / gsz; u.cn = u.pn; u.koff = 0; u.ks = 0; return true;
    }
    __device__ __forceinline__ void a_ready(const Unit&) const {}
    __device__ __forceinline__ void done(const Unit&) const {}
};
__device__ __forceinline__ unsigned cvt_pk_bf16(float lo, float hi) { unsigned r; asm volatile("v_cvt_pk_bf16_f32 %0, %1, %2" : "=v"(r) : "v"(lo), "v"(hi)); return r; }
typedef float f32x2 __attribute__((ext_vector_type(2)));
template <class Epi, class Sched, bool ALIGN_EPI = false, bool SP2 = false>
__device__ __forceinline__ void gemm_phase(PG8_LAS unsigned char* lds, const Gemm g, const Sched& S, const Epi& E) {
    const int tid = mk_tid(), wid = __builtin_amdgcn_readfirstlane(tid >> 6), lane = tid & 63, wr = wid >> 2, wc = wid & 3, fr = lane & 15, fq = lane >> 4;
    const int K = g.ld, nt = g.K / BK;
    unsigned voffA[2], voffB[2];
#pragma unroll
    for (int i = 0; i < 2; ++i) { int R, C; stage_rc(tid * 16 + i * 8192, R, C); const int Rb = Epi::PERM ? ((R & ~31) + perm32(R & 31)) : R;
        voffA[i] = (unsigned)(R * K + C) * 2u; voffB[i] = (unsigned)(Rb * K + C) * 2u; }
    const size_t kstep = (size_t)(BK * 2);
    const size_t hstep = (size_t)HALF * K * 2;
    const size_t tstep = 2 * hstep;
    const unsigned ldsw = (unsigned)wid * 1024u;
    const int aoff = lds_byte(wr * 64 + fr, fq * 8), boff = lds_byte(wc * 32 + fr, fq * 8);
#define PG8_SA(b, h) (((b) * 2 + (h)) * HTB)
#define PG8_SB(b, h) ((4 + (b) * 2 + (h)) * HTB)
#define PG8_STAGE(bufoff, gbase, voff) do { _Pragma("unroll") for (int _i = 0; _i < 2; ++_i) \
        __builtin_amdgcn_global_load_lds((const unsigned*)((const char*)(gbase) + (voff)[_i]), (PG8_LAS unsigned*)(lds + (bufoff) + ldsw + _i * 8192), 16, 0, 0); } while (0)
#define PG8_LDA(dst, b, h) do { _Pragma("unroll") for (int m = 0; m < 4; ++m) _Pragma("unroll") for (int k = 0; k < 2; ++k) dst[m][k] = *(const PG8_LAS bf16x8*)(lds + PG8_SA(b, h) + aoff + m * 2048 + k * 1024); } while (0)
#define PG8_LDB(dst, b, h) do { _Pragma("unroll") for (int n = 0; n < 2; ++n) _Pragma("unroll") for (int k = 0; k < 2; ++k) dst[n][k] = *(const PG8_LAS bf16x8*)(lds + PG8_SB(b, h) + boff + n * 2048 + k * 1024); } while (0)
#define PG8_MMA(ai, bj, At, Bt) do { __builtin_amdgcn_s_setprio(1); _Pragma("unroll") for (int m = 0; m < 4; ++m) _Pragma("unroll") for (int n = 0; n < 2; ++n) _Pragma("unroll") for (int k = 0; k < 2; ++k) \
        acc[ai][bj][m][n] = __builtin_amdgcn_mfma_f32_16x16x32_bf16(Bt[n][k], At[m][k], acc[ai][bj][m][n], 0, 0, 0); __builtin_amdgcn_s_setprio(0); } while (0)
#define PG8_WAIT_V(n) asm volatile("s_waitcnt vmcnt(" #n ")" ::: "memory")
#define PG8_WAIT_L(n) asm volatile("s_waitcnt lgkmcnt(" #n ")" ::: "memory")
#define PG8_BAR __builtin_amdgcn_s_barrier()
#define PG8_SCHED __builtin_amdgcn_sched_barrier(0)
    Unit cur, nxt; int ui = 0;
    if (!S.next(0, cur)) return;
    f32x4 acc[2][2][4][2];
#pragma unroll
    for (int a = 0; a < 2; ++a)
#pragma unroll
        for (int b = 0; b < 2; ++b)
#pragma unroll
            for (int m = 0; m < 4; ++m)
#pragma unroll
                for (int n = 0; n < 2; ++n) acc[a][b][m][n] = (f32x4){0.f, 0.f, 0.f, 0.f};
    bf16x8 At[4][2], B0[2][2], B1[2][2];
    const char* cA = (const char*)g.A + (size_t)cur.pm * tstep + (size_t)cur.koff * 2; const char* cB = (const char*)g.Bt + (size_t)cur.pn * tstep + (size_t)cur.koff * 2;
    S.a_ready(cur);
    if constexpr (SP2) {
        PG8_STAGE(PG8_SB(0, 0), cB, voffB); PG8_STAGE(PG8_SB(0, 1), cB + hstep, voffB); PG8_STAGE(PG8_SA(0, 0), cA, voffA); PG8_STAGE(PG8_SA(0, 1), cA + hstep, voffA);
        if (wr == 1) PG8_BAR;
        PG8_WAIT_V(2); PG8_BAR;
        PG8_STAGE(PG8_SB(1, 0), cB + kstep, voffB); PG8_STAGE(PG8_SA(1, 0), cA + kstep, voffA); PG8_STAGE(PG8_SB(1, 1), cB + hstep + kstep, voffB);
        PG8_WAIT_V(6); PG8_BAR;
    } else {
        PG8_STAGE(PG8_SB(0, 0), cB, voffB); PG8_STAGE(PG8_SA(0, 0), cA, voffA); PG8_STAGE(PG8_SB(0, 1), cB + hstep, voffB); PG8_STAGE(PG8_SA(0, 1), cA + hstep, voffA);
        if (wr == 1) PG8_BAR;
        PG8_WAIT_V(4); PG8_BAR;
        PG8_STAGE(PG8_SB(1, 0), cB + kstep, voffB); PG8_STAGE(PG8_SA(1, 0), cA + kstep, voffA); PG8_STAGE(PG8_SB(1, 1), cB + hstep + kstep, voffB);
        PG8_WAIT_V(6); PG8_BAR;
    }
    for (;;) {
        const bool has_next = S.next(ui + 1, nxt);
        const char* nA = has_next ? (const char*)g.A + (size_t)nxt.pm * tstep + (size_t)nxt.koff * 2 : cA; const char* nB = has_next ? (const char*)g.Bt + (size_t)nxt.pn * tstep + (size_t)nxt.koff * 2 : cB;
        for (int t = 0; t < nt; t += 2) {
            const bool last = (t == nt - 2);
            const char* a1 = cA + (size_t)(t + 1) * kstep;
            const char* a2 = last ? nA : cA + (size_t)(t + 2) * kstep; const char* b2 = last ? nB : cB + (size_t)(t + 2) * kstep;
            const char* a3 = a2 + kstep; const char* b3 = b2 + kstep;
            if (last && has_next) S.a_ready(nxt);
            if constexpr (SP2) {
            PG8_LDB(B0, 0, 0); PG8_LDB(B1, 0, 1); PG8_SCHED; PG8_LDA(At, 0, 0); PG8_STAGE(PG8_SA(1, 1), a1 + hstep, voffA);
            PG8_WAIT_V(8); PG8_WAIT_L(0); PG8_BAR; PG8_MMA(0, 0, At, B0); PG8_MMA(0, 1, At, B1); PG8_BAR; PG8_SCHED;
            PG8_LDA(At, 0, 1); PG8_STAGE(PG8_SB(0, 0), b2, voffB); PG8_STAGE(PG8_SB(0, 1), b2 + hstep, voffB); PG8_STAGE(PG8_SA(0, 0), a2, voffA);
            PG8_WAIT_V(8); PG8_WAIT_L(0); PG8_BAR; PG8_MMA(1, 0, At, B0); PG8_MMA(1, 1, At, B1); PG8_BAR; PG8_SCHED;
            PG8_LDB(B0, 1, 0); PG8_LDB(B1, 1, 1); PG8_SCHED; PG8_LDA(At, 1, 0); PG8_STAGE(PG8_SA(0, 1), a2 + hstep, voffA);
            PG8_WAIT_V(8); PG8_WAIT_L(0); PG8_BAR; PG8_MMA(0, 0, At, B0); PG8_MMA(0, 1, At, B1); PG8_BAR; PG8_SCHED;
            PG8_LDA(At, 1, 1); PG8_STAGE(PG8_SB(1, 0), b3, voffB); PG8_STAGE(PG8_SB(1, 1), b3 + hstep, voffB); PG8_STAGE(PG8_SA(1, 0), a3, voffA);
            PG8_WAIT_V(8); PG8_WAIT_L(0); PG8_BAR; PG8_MMA(1, 0, At, B0); PG8_MMA(1, 1, At, B1); PG8_BAR; PG8_SCHED;
            } else {
            PG8_LDB(B0, 0, 0); PG8_SCHED; PG8_LDA(At, 0, 0); PG8_STAGE(PG8_SA(1, 1), a1 + hstep, voffA);
            PG8_WAIT_L(8); PG8_BAR; PG8_WAIT_L(0); PG8_MMA(0, 0, At, B0); PG8_BAR; PG8_SCHED;
            PG8_LDB(B1, 0, 1); PG8_STAGE(PG8_SB(0, 0), b2, voffB);
            PG8_BAR; PG8_WAIT_L(0); PG8_MMA(0, 1, At, B1); PG8_BAR;
            PG8_LDA(At, 0, 1); PG8_STAGE(PG8_SA(0, 0), a2, voffA);
            PG8_BAR; PG8_WAIT_L(0); PG8_MMA(1, 0, At, B0); PG8_BAR; PG8_SCHED;
            PG8_STAGE(PG8_SB(0, 1), b2 + hstep, voffB);
            PG8_WAIT_V(6); PG8_BAR; PG8_MMA(1, 1, At, B1); PG8_BAR;
            PG8_LDB(B0, 1, 0); PG8_SCHED; PG8_LDA(At, 1, 0); PG8_STAGE(PG8_SA(0, 1), a2 + hstep, voffA);
            PG8_WAIT_L(8); PG8_BAR; PG8_WAIT_L(0); PG8_MMA(0, 0, At, B0); PG8_BAR; PG8_SCHED;
            PG8_LDB(B1, 1, 1); PG8_STAGE(PG8_SB(1, 0), b3, voffB);
            PG8_BAR; PG8_WAIT_L(0); PG8_MMA(0, 1, At, B1); PG8_BAR;
            PG8_LDA(At, 1, 1); PG8_STAGE(PG8_SA(1, 0), a3, voffA);
            PG8_BAR; PG8_WAIT_L(0); PG8_MMA(1, 0, At, B0); PG8_BAR; PG8_SCHED;
            PG8_STAGE(PG8_SB(1, 1), b3 + hstep, voffB);
            PG8_WAIT_V(6); PG8_BAR; PG8_MMA(1, 1, At, B1); PG8_BAR;
            }
        }
        if constexpr (ALIGN_EPI) { if (wr == 0) PG8_BAR; }
        if constexpr (!Epi::AFTER_DRAIN) { E(acc, cur, wr, wc, fr, fq); S.done(cur); }
        if (!has_next) break;
#pragma unroll
        for (int a = 0; a < 2; ++a)
#pragma unroll
            for (int b = 0; b < 2; ++b)
#pragma unroll
                for (int m = 0; m < 4; ++m)
#pragma unroll
                    for (int n = 0; n < 2; ++n) acc[a][b][m][n] = (f32x4){0.f, 0.f, 0.f, 0.f};
        cur = nxt; cA = nA; cB = nB; ++ui;
        if constexpr (ALIGN_EPI) { if (wr == 1) PG8_BAR; }
    }
    PG8_WAIT_V(0);
    if constexpr (!ALIGN_EPI) { if (wr == 0) PG8_BAR; }
    PG8_BAR;
    if constexpr (Epi::AFTER_DRAIN) { E.fused(acc, cur, wr, wc, fr, fq, lds, wid, lane); S.done(cur); }
#undef PG8_SA
#undef PG8_SB
#undef PG8_STAGE
#undef PG8_LDA
#undef PG8_LDB
#undef PG8_MMA
#undef PG8_WAIT_V
#undef PG8_WAIT_L
#undef PG8_BAR
#undef PG8_SCHED
}
}

namespace pg8 {
__device__ __forceinline__ float fast_sigmoid(float x) { return __builtin_amdgcn_rcpf(1.0f + __builtin_amdgcn_exp2f(-1.4426950408889634f * x)); }
__device__ __forceinline__ void rstd8(const float* rss, int row0, int fq, float (&rs)[8]) {
    if (!rss) {
#pragma unroll
        for (int i = 0; i < 8; ++i) rs[i] = 1.0f;
        return; }
    f32x4 q[8];
#pragma unroll
    for (int i = 0; i < 8; ++i) q[i] = *(const f32x4*)(rss + (size_t)(row0 + (i >> 2) * HALF + (i & 3) * 16) * 16 + 4 * fq);
#pragma unroll
    for (int i = 0; i < 8; ++i) { float s = (q[i][0] + q[i][1]) + (q[i][2] + q[i][3]); s += __shfl_xor(s, 16); s += __shfl_xor(s, 32); rs[i] = 1.0f / sqrtf(s * (1.0f / 1024.f) + 1e-6f); }
}
struct EpiStore16 {
    static constexpr bool PERM = true, AFTER_DRAIN = false;
    bf16_t* O; int ldc; const float* rss;
    __device__ __forceinline__ void operator()(const f32x4 (&acc)[2][2][4][2], const Unit& u, int wr, int wc, int fr, int fq) const {
        const int row0 = u.pm * BM + wr * 64 + fr, col0 = u.cn * BM + wc * 32 + 8 * fq;
        float rs[8]; rstd8(rss, row0, fq, rs);
#pragma unroll
        for (int ai = 0; ai < 2; ++ai)
#pragma unroll
            for (int m = 0; m < 4; ++m) { const int row = row0 + ai * HALF + m * 16; bf16_t* rowp = O + (size_t)row * ldc + col0; const float r = rs[ai * 4 + m];
#pragma unroll
                for (int bj = 0; bj < 2; ++bj) { const f32x4 v0 = acc[ai][bj][m][0] * r, v1 = acc[ai][bj][m][1] * r;
                    u32x4 w; w.x = cvt_pk_bf16(v0[0], v0[1]); w.y = cvt_pk_bf16(v0[2], v0[3]); w.z = cvt_pk_bf16(v1[0], v1[1]); w.w = cvt_pk_bf16(v1[2], v1[3]);
                    *(u32x4*)(rowp + bj * HALF) = w; } }
    }
};
struct EpiAddH {
    static constexpr bool PERM = false, AFTER_DRAIN = false;
    float* H; int ldc; bf16_t* HBo; float* rss_out;
    __device__ __forceinline__ void operator()(const f32x4 (&acc)[2][2][4][2], const Unit& u, int wr, int wc, int fr, int fq) const {
        typedef unsigned u32x2v __attribute__((ext_vector_type(2)));
        const int row0 = u.pm * BM + wr * 64 + fr, col0 = u.cn * BM + wc * 32 + 4 * fq;
#pragma unroll
        for (int ai = 0; ai < 2; ++ai) { f32x4 h[4][2][2];
#pragma unroll
            for (int m = 0; m < 4; ++m) { const size_t off = (size_t)(row0 + ai * HALF + m * 16) * ldc + col0;
#pragma unroll
                for (int bj = 0; bj < 2; ++bj)
#pragma unroll
                    for (int n = 0; n < 2; ++n) h[m][bj][n] = *(const f32x4*)(H + off + bj * HALF + n * 16); }
#pragma unroll
            for (int m = 0; m < 4; ++m) { const int row = row0 + ai * HALF + m * 16; const size_t off = (size_t)row * ldc + col0; float ss = 0.f;
#pragma unroll
                for (int bj = 0; bj < 2; ++bj)
#pragma unroll
                    for (int n = 0; n < 2; ++n) { const f32x4 o = h[m][bj][n] + acc[ai][bj][m][n]; *(f32x4*)(H + off + bj * HALF + n * 16) = o; ss += (o[0] * o[0] + o[1] * o[1]) + (o[2] * o[2] + o[3] * o[3]);
                        u32x2v w; w.x = cvt_pk_bf16(o[0], o[1]); w.y = cvt_pk_bf16(o[2], o[3]); *(u32x2v*)(HBo + off + bj * HALF + n * 16) = w; }
                ss += __shfl_xor(ss, 16); ss += __shfl_xor(ss, 32);
                if (fq == 0) rss_out[(size_t)row * 16 + u.cn * 4 + wc] = ss; }
            asm volatile("" ::: "memory"); }
    }
};
struct EpiSwiglu {
    static constexpr bool PERM = true, AFTER_DRAIN = false;
    bf16_t* O; int ldc; const float* rss;
    __device__ __forceinline__ void operator()(const f32x4 (&acc)[2][2][4][2], const Unit& u, int wr, int wc, int fr, int fq) const {
        const int row0 = u.pm * BM + wr * 64 + fr, col0 = u.cn * HALF + wc * 32 + 8 * fq;
        float rs[8]; rstd8(rss, row0, fq, rs);
#pragma unroll
        for (int ai = 0; ai < 2; ++ai)
#pragma unroll
            for (int m = 0; m < 4; ++m) { const int row = row0 + ai * HALF + m * 16; bf16_t* rowp = O + (size_t)row * ldc + col0; float o[8]; const float r = rs[ai * 4 + m];
#pragma unroll
                for (int n = 0; n < 2; ++n)
#pragma unroll
                    for (int j = 0; j < 4; ++j) { const float gt = acc[ai][0][m][n][j] * r, up = acc[ai][1][m][n][j] * r; o[n * 4 + j] = gt * fast_sigmoid(gt) * up; }
                u32x4 w; w.x = cvt_pk_bf16(o[0], o[1]); w.y = cvt_pk_bf16(o[2], o[3]); w.z = cvt_pk_bf16(o[4], o[5]); w.w = cvt_pk_bf16(o[6], o[7]);
                *(u32x4*)rowp = w; }
    }
};
struct EpiPleF {
    static constexpr bool PERM = false, AFTER_DRAIN = false;
    float* H; const bf16_t* PJ; int ldc; const float* rss; bf16_t* HBo; float* rss_out;
    __device__ __forceinline__ void operator()(const f32x4 (&acc)[2][2][4][2], const Unit& u, int wr, int wc, int fr, int fq) const {
        typedef unsigned u32x2v __attribute__((ext_vector_type(2)));
        const int row0 = u.pm * BM + wr * 64 + fr, col0 = u.cn * BM + wc * 32 + 4 * fq;
        float rs[8]; rstd8(rss, row0, fq, rs);
#pragma unroll
        for (int ai = 0; ai < 2; ++ai)
#pragma unroll
            for (int mp = 0; mp < 2; ++mp) { f32x4 h[2][2][2]; u32x2v pj[2][2][2];
#pragma unroll
                for (int mm = 0; mm < 2; ++mm) { const size_t off = (size_t)(row0 + ai * HALF + (2 * mp + mm) * 16) * ldc + col0;
#pragma unroll
                    for (int bj = 0; bj < 2; ++bj)
#pragma unroll
                        for (int n = 0; n < 2; ++n) { h[mm][bj][n] = *(const f32x4*)(H + off + bj * HALF + n * 16); pj[mm][bj][n] = *(const u32x2v*)(PJ + off + bj * HALF + n * 16); } }
#pragma unroll
                for (int mm = 0; mm < 2; ++mm) { const int m = 2 * mp + mm, row = row0 + ai * HALF + m * 16; const size_t off = (size_t)row * ldc + col0; const float r = rs[ai * 4 + m]; float ss = 0.f;
#pragma unroll
                    for (int bj = 0; bj < 2; ++bj)
#pragma unroll
                        for (int n = 0; n < 2; ++n) { const f32x4 a = acc[ai][bj][m][n] * r; f32x4 o; const u32x2v q = pj[mm][bj][n]; const f32x4 hh = h[mm][bj][n];
                            o[0] = hh[0] + __uint_as_float(q.x << 16) * fast_sigmoid(a[0]); o[1] = hh[1] + __uint_as_float(q.x & 0xffff0000u) * fast_sigmoid(a[1]);
                            o[2] = hh[2] + __uint_as_float(q.y << 16) * fast_sigmoid(a[2]); o[3] = hh[3] + __uint_as_float(q.y & 0xffff0000u) * fast_sigmoid(a[3]);
                            *(f32x4*)(H + off + bj * HALF + n * 16) = o; ss += (o[0] * o[0] + o[1] * o[1]) + (o[2] * o[2] + o[3] * o[3]);
                            u32x2v w; w.x = cvt_pk_bf16(o[0], o[1]); w.y = cvt_pk_bf16(o[2], o[3]); *(u32x2v*)(HBo + off + bj * HALF + n * 16) = w; }
                    ss += __shfl_xor(ss, 16); ss += __shfl_xor(ss, 32);
                    if (fq == 0) rss_out[(size_t)row * 16 + u.cn * 4 + wc] = ss; }
                asm volatile("" ::: "memory"); }
    }
};
struct ExpertOrder : StaticOrder {
    const int* tile_e;
    __device__ __forceinline__ bool next(int i, Unit& u) const { if (!StaticOrder::next(i, u)) return false; if (tile_e) u.pn += tile_e[u.pm] * nN; return true; }
};
struct MoeDownOrder {
    int nwg, nfull, G, c, ks_n, kslice; const int* tile_e;
    __device__ __forceinline__ bool next(int i, Unit& u) const {
        const int q = i * G + c; int L;
        if (ks_n == 0) { L = q; if (L >= nfull) return false; u.koff = 0; u.ks = 0; }
        else { if (q >= (nwg - nfull) * ks_n) return false; L = nfull + q / ks_n; u.ks = q % ks_n; u.koff = u.ks * kslice; }
        u.pm = L >> 2; u.cn = L & 3; u.pn = u.cn + tile_e[u.pm] * 4; return true;
    }
    __device__ __forceinline__ void a_ready(const Unit&) const {}
    __device__ __forceinline__ void done(const Unit&) const {}
};
struct EpiMoeDown {
    static constexpr bool PERM = true, AFTER_DRAIN = false;
    bf16_t* O; bf16_t* P; size_t pstride; int row0p;
    __device__ __forceinline__ void operator()(const f32x4 (&acc)[2][2][4][2], const Unit& u, int wr, int wc, int fr, int fq) const {
        const int col0 = u.cn * BM + wc * 32 + 8 * fq; const int rowt = u.pm * BM + wr * 64 + fr;
        bf16_t* base = u.ks == 0 ? O + (size_t)rowt * 1024 : P + (size_t)(u.ks - 1) * pstride + (size_t)(rowt - row0p) * 1024;
#pragma unroll
        for (int ai = 0; ai < 2; ++ai)
#pragma unroll
            for (int m = 0; m < 4; ++m) { bf16_t* rowp = base + (size_t)(ai * HALF + m * 16) * 1024 + col0;
#pragma unroll
                for (int bj = 0; bj < 2; ++bj) { const f32x4 v0 = acc[ai][bj][m][0], v1 = acc[ai][bj][m][1];
                    u32x4 w; w.x = cvt_pk_bf16(v0[0], v0[1]); w.y = cvt_pk_bf16(v0[2], v0[3]); w.z = cvt_pk_bf16(v1[0], v1[1]); w.w = cvt_pk_bf16(v1[2], v1[3]);
                    *(u32x4*)(rowp + bj * HALF) = w; } }
    }
};
}

namespace fp {
using namespace mdl;
#define FLAS __attribute__((address_space(3)))
typedef float f32x4 __attribute__((ext_vector_type(4)));
typedef float f32x2 __attribute__((ext_vector_type(2)));
typedef unsigned u32x4 __attribute__((ext_vector_type(4)));
typedef unsigned u32x2 __attribute__((ext_vector_type(2)));
typedef __bf16 bf16x2_t __attribute__((ext_vector_type(2)));
__device__ __forceinline__ unsigned pk2(float lo, float hi) { f32x2 v = {lo, hi}; bf16x2_t b = __builtin_convertvector(v, bf16x2_t); return __builtin_bit_cast(unsigned, b); }
__device__ __forceinline__ float blo(unsigned w) { return __uint_as_float(w << 16); }
__device__ __forceinline__ float bhi(unsigned w) { return __uint_as_float(w & 0xffff0000u); }
__device__ __forceinline__ float wave_sum(float v) {
#pragma unroll
    for (int o = 1; o < 64; o <<= 1) v += __shfl_xor(v, o);
    return v;
}
#define FP_LDS_WAIT() asm volatile("s_waitcnt lgkmcnt(0)" ::: "memory")

template <class Map> __device__ __forceinline__ void tr_item(const float* W, int Nsrc, const Map& map, bf16* WT, int K, int k0, int n0, FLAS float* scr, int lane, const float* gain = nullptr) {
    const int nl = lane & 31, c = map(n0 + nl), cc = lane & 7;
    f32x4 g0 = (f32x4){1.f, 1.f, 1.f, 1.f}, g1 = g0;
    if (gain) { g0 = *(const f32x4*)(gain + k0 + 8 * cc); g1 = *(const f32x4*)(gain + k0 + 8 * cc + 4); }
#pragma unroll 8
    for (int i = 0; i < 32; ++i) { const int kk = 2 * i + (lane >> 5); scr[kk * 33 + nl] = c >= 0 ? W[(size_t)(k0 + kk) * Nsrc + c] : 0.f; }
    FP_LDS_WAIT(); asm volatile("" ::: "memory");
#pragma unroll
    for (int j = 0; j < 4; ++j) { const int n = (lane >> 3) + 8 * j; const FLAS float* s = scr + (8 * cc) * 33 + n;
        u32x4 o; o.x = pk2(s[0 * 33] * g0.x, s[1 * 33] * g0.y); o.y = pk2(s[2 * 33] * g0.z, s[3 * 33] * g0.w); o.z = pk2(s[4 * 33] * g1.x, s[5 * 33] * g1.y); o.w = pk2(s[6 * 33] * g1.z, s[7 * 33] * g1.w);
        *(u32x4*)(WT + (size_t)(n0 + n) * K + k0 + 8 * cc) = o; }
    FP_LDS_WAIT(); asm volatile("" ::: "memory");
}
struct MapId { __device__ __forceinline__ int operator()(int n) const { return n; } };
struct MapLt { int lim; __device__ __forceinline__ int operator()(int n) const { return n < lim ? n : -1; } };
struct MapU { __device__ __forceinline__ int operator()(int n) const { return ucol_src(n); } };
struct MapOff { int off; __device__ __forceinline__ int operator()(int n) const { return n + off; } };
__device__ __forceinline__ void prologue(const MP& p, FLAS unsigned char* lds, int bx, int G) {
    const int tid = mk_tid(), lane = tid & 63, wave = __builtin_amdgcn_readfirstlane(tid >> 6);
    FLAS float* scr = (FLAS float*)(lds + wave * 16384);
    const int gw = bx * 8 + wave, NGW = G * 8;
    constexpr int I_WIN = (D / 64) * (NU / 32), I_UQ = 4 * 16, I_UKV = 2 * 16, I_DD = 16 * 32, I_PP = 4 * 32, I_GU = 16 * (NGU / 32), I_DN = (DFF / 64) * 32;
    constexpr int PER_L = I_WIN + I_UQ + I_UKV + 2 * I_DD + I_PP, NITEMS = DEPTH * PER_L + 18 * (I_GU + I_DN);
    for (int it = gw; it < NITEMS; it += NGW) {
        int r = it;
        if (r < DEPTH * PER_L) { const int l = r / PER_L; r %= PER_L;
            if (r < I_WIN) { tr_item(p.w_in + (size_t)l * D * NUO, NUO, MapU{}, p.WIN + (size_t)l * NU * D, D, 64 * (r / (NU / 32)), 32 * (r % (NU / 32)), scr, lane, p.attn_g + l * D); continue; } r -= I_WIN;
            if (r < I_UQ) { tr_item(p.w_uq + (size_t)l * 256 * 384, 384, MapLt{384}, p.WUQ + (size_t)l * 512 * 256, 256, 64 * (r / 16), 32 * (r % 16), scr, lane); continue; } r -= I_UQ;
            if (r < I_UKV) { tr_item(p.w_ukv + (size_t)l * 128 * 512, 512, MapId{}, p.WUKV + (size_t)l * 512 * 128, 128, 64 * (r / 16), 32 * (r % 16), scr, lane); continue; } r -= I_UKV;
            if (r < I_DD) { tr_item(p.w_out + (size_t)l * D * D, D, MapId{}, p.WOUT + (size_t)l * D * D, D, 64 * (r / 32), 32 * (r % 32), scr, lane); continue; } r -= I_DD;
            if (r < I_DD) { tr_item(p.ple_wg + (size_t)l * D * D, D, MapId{}, p.WPG + (size_t)l * D * D, D, 64 * (r / 32), 32 * (r % 32), scr, lane, p.ple_g + l * D); continue; } r -= I_DD;
            tr_item(p.ple_wp + (size_t)l * PLE * D, D, MapId{}, p.WPP + (size_t)l * D * PLE, PLE, 64 * (r / 32), 32 * (r % 32), scr, lane); continue; }
        r -= DEPTH * PER_L;
        if (r < 18 * I_GU) { const int mt = r / I_GU; r %= I_GU; const int k0 = 64 * (r / (NGU / 32)), n0 = 32 * (r % (NGU / 32)); const int tl = n0 / 256, rr = n0 % 256;
            const float* src; bf16* dst;
            if (mt < 2) { src = (rr < 128 ? p.dwg : p.dwu) + (size_t)mt * D * DFF; dst = p.DWGU + (size_t)mt * NGU * D; } else { src = (rr < 128 ? p.mwg : p.mwu) + (size_t)(mt - 2) * D * DFF; dst = p.MWGU + (size_t)(mt - 2) * NGU * D; }
            const int Lg = mt < 2 ? 2 * mt : 2 * ((mt - 2) >> 3) + 1;
            tr_item(src, DFF, MapOff{tl * 128 + (rr & 127) - n0}, dst, D, k0, n0, scr, lane, p.ffn_g + Lg * D); continue; }
        r -= 18 * I_GU;
        { const int mt = r / I_DN; r %= I_DN; const float* src; bf16* dst;
            if (mt < 2) { src = p.dwd + (size_t)mt * DFF * D; dst = p.DWD + (size_t)mt * D * DFF; } else { src = p.mwd + (size_t)(mt - 2) * DFF * D; dst = p.MWD + (size_t)(mt - 2) * D * DFF; }
            tr_item(src, D, MapId{}, dst, DFF, 64 * (r / 32), 32 * (r % 32), scr, lane); }
    }
    const long g0 = (long)bx * 512 + tid, gs = (long)G * 512;
    for (long t = gw; t < p.T; t += NGW) { const f32x4* xr = (const f32x4*)(p.x + t * D) + lane; f32x4* hr = (f32x4*)(p.H + t * D) + lane; u32x2* o = (u32x2*)(p.HB + t * D) + lane; float ss = 0.f;
#pragma unroll
        for (int j = 0; j < 4; ++j) { const f32x4 v = xr[64 * j]; hr[64 * j] = v; u32x2 wv; wv.x = pk2(v.x, v.y); wv.y = pk2(v.z, v.w); o[64 * j] = wv; ss += (v.x * v.x + v.y * v.y) + (v.z * v.z + v.w * v.w); }
        ss = wave_sum(ss); if (lane < 16) rss_ptr(p, 0, 0)[t * 16 + lane] = lane == 0 ? ss : 0.f; }
    for (long i = g0; i < (long)DEPTH * p.T * PLE / 4; i += gs) { const f32x4 v = ((const f32x4*)p.p)[i]; u32x2 o; o.x = pk2(v.x, v.y); o.y = pk2(v.z, v.w); ((u32x2*)p.PB16)[i] = o; }
    for (long i = g0; i < p.T * 16; i += gs) { const long t = i / 16; const int j = (int)(i % 16); const float inv = powf(10000.0f, -(float)(2 * j) / 32.0f), ang = (float)p.pos[t] * inv;
        p.CS[t * 32 + j] = cosf(ang); p.CS[t * 32 + 16 + j] = sinf(ang); }
}
template <int MODE> __device__ __forceinline__ void norm_phase(const MP& p, int L, const float* g, int bx, int G, FLAS unsigned* lcnt = nullptr) {
    const int tid = mk_tid(), lane = tid & 63, wave = __builtin_amdgcn_readfirstlane(tid >> 6);
    const int gw = bx * 8 + wave, NGW = G * 8;
    const f32x4* gr = (const f32x4*)g + lane;
    f32x4 Rr[MODE == 1 ? 32 : 1];
    if (MODE == 1) { __syncthreads(); if (tid < NE) lcnt[tid] = 0u; __syncthreads(); const f32x4* R = (const f32x4*)(p.router + (size_t)(L >> 1) * D * NE);
#pragma unroll
        for (int j = 0; j < 4; ++j)
#pragma unroll
            for (int c = 0; c < 4; ++c) { const int idx = 4 * (lane + 64 * j) + c; Rr[(j * 4 + c) * 2] = R[idx * 2]; Rr[(j * 4 + c) * 2 + 1] = R[idx * 2 + 1]; } }
    for (long t = gw; t < p.T; t += NGW) {
        f32x4* hr = (f32x4*)(p.H + t * D) + lane; f32x4 v[4];
#pragma unroll
        for (int j = 0; j < 4; ++j) v[j] = hr[64 * j];
        if (MODE == 2) { const int sl[2] = {p.TOKSLOT[t * 2], p.TOKSLOT[t * 2 + 1]}; const float gt[2] = {p.TOPG[t * 2], p.TOPG[t * 2 + 1]};
            const int row0p = p.TILE_E[1000], ksn = p.TILE_E[1001]; const size_t pstride = (size_t)p.TILE_E[1002] * D;
#pragma unroll
            for (int k = 0; k < 2; ++k) { const u32x2* y0 = (const u32x2*)(p.YS + (size_t)sl[k] * D) + lane; u32x2 q[4];
#pragma unroll
                for (int j = 0; j < 4; ++j) q[j] = y0[64 * j];
                float acc[4][4];
#pragma unroll
                for (int j = 0; j < 4; ++j) { acc[j][0] = blo(q[j].x); acc[j][1] = bhi(q[j].x); acc[j][2] = blo(q[j].y); acc[j][3] = bhi(q[j].y); }
                if (sl[k] >= row0p) for (int s = 1; s < ksn; ++s) { const u32x2* yp = (const u32x2*)(p.HB + (size_t)(s - 1) * pstride + (size_t)(sl[k] - row0p) * D) + lane;
#pragma unroll
                    for (int j = 0; j < 4; ++j) { const u32x2 r = yp[64 * j]; acc[j][0] += blo(r.x); acc[j][1] += bhi(r.x); acc[j][2] += blo(r.y); acc[j][3] += bhi(r.y); } }
#pragma unroll
                for (int j = 0; j < 4; ++j) { v[j].x += gt[k] * acc[j][0]; v[j].y += gt[k] * acc[j][1]; v[j].z += gt[k] * acc[j][2]; v[j].w += gt[k] * acc[j][3]; } }
#pragma unroll
            for (int j = 0; j < 4; ++j) hr[64 * j] = v[j]; }
        float ss = 0.f;
#pragma unroll
        for (int j = 0; j < 4; ++j) ss += (v[j].x * v[j].x + v[j].y * v[j].y) + (v[j].z * v[j].z + v[j].w * v[j].w);
        ss = wave_sum(ss);
        const float r = 1.0f / sqrtf(ss * (1.0f / D) + RMS_EPS);
        if (MODE == 2) { u32x2* o = (u32x2*)(p.HB2 + t * D) + lane;
#pragma unroll
            for (int j = 0; j < 4; ++j) { u32x2 w; w.x = pk2(v[j].x, v[j].y); w.y = pk2(v[j].z, v[j].w); o[64 * j] = w; }
            if (lane < 16) rss_ptr(p, L, 2)[t * 16 + lane] = lane == 0 ? ss : 0.f; }
        if (MODE == 1) { u32x2* o = (u32x2*)(p.HB2 + t * D) + lane;
#pragma unroll
            for (int j = 0; j < 4; ++j) { u32x2 w; w.x = pk2(v[j].x * r, v[j].y * r); w.y = pk2(v[j].z * r, v[j].w * r); o[64 * j] = w; } }
        if (MODE == 1 || MODE == 3) {
#pragma unroll
            for (int j = 0; j < 4; ++j) { const f32x4 gv = gr[64 * j]; v[j].x *= r * gv.x; v[j].y *= r * gv.y; v[j].z *= r * gv.z; v[j].w *= r * gv.w; } }
        if (MODE == 3) {
#pragma unroll
            for (int j = 0; j < 4; ++j) ((f32x4*)(p.out + t * D) + lane)[64 * j] = v[j];
        }
        if (MODE == 1) { float lg[NE];
#pragma unroll
            for (int e = 0; e < NE; ++e) lg[e] = 0.f;
#pragma unroll
            for (int j = 0; j < 4; ++j)
#pragma unroll
                for (int c = 0; c < 4; ++c) { const f32x4 r0 = Rr[(j * 4 + c) * 2], r1 = Rr[(j * 4 + c) * 2 + 1]; const float x = v[j][c];
                    lg[0] += x * r0.x; lg[1] += x * r0.y; lg[2] += x * r0.z; lg[3] += x * r0.w; lg[4] += x * r1.x; lg[5] += x * r1.y; lg[6] += x * r1.z; lg[7] += x * r1.w; }
#pragma unroll
            for (int e = 0; e < NE; ++e) lg[e] = wave_sum(lg[e]);
            int e0 = 0; float v0 = lg[0];
#pragma unroll
            for (int e = 1; e < NE; ++e) if (lg[e] > v0) { v0 = lg[e]; e0 = e; }
            int e1 = -1; float v1 = -3.0e38f;
#pragma unroll
            for (int e = 0; e < NE; ++e) if (e != e0 && lg[e] > v1) { v1 = lg[e]; e1 = e; }
            if (lane == 0) { const float g1 = 1.0f / (1.0f + expf(v0 - v1));
                p.TOPE[t * 2] = e0; p.TOPE[t * 2 + 1] = e1; p.TOPG[t * 2] = 1.0f - g1; p.TOPG[t * 2 + 1] = g1;
                p.POS[t * 2] = (int)__hip_atomic_fetch_add(lcnt + e0, 1u, __ATOMIC_RELAXED, __HIP_MEMORY_SCOPE_WORKGROUP); p.POS[t * 2 + 1] = (int)__hip_atomic_fetch_add(lcnt + e1, 1u, __ATOMIC_RELAXED, __HIP_MEMORY_SCOPE_WORKGROUP); } }
    }
    if (MODE == 1) { __syncthreads(); if (tid < NE) p.BCNT[bx * NE + tid] = (int)lcnt[tid]; }
}
__device__ __forceinline__ void moeplan(const MP& p, int L, FLAS unsigned char* lds, int bx, int G) {
    const int tid = mk_tid(), lane = tid & 63, wave = __builtin_amdgcn_readfirstlane(tid >> 6), j = L >> 1;
    const int gw = bx * 8 + wave, NGW = G * 8;
    FLAS int* base = (FLAS int*)lds;
    FLAS int* pst = (FLAS int*)(lds + 16384);
    __syncthreads();
    {
        const int e = wave; int c[4], s = 0;
#pragma unroll
        for (int i = 0; i < 4; ++i) { const int b = lane * 4 + i; c[i] = b < G ? p.BCNT[b * NE + e] : 0; s += c[i]; }
        int inc = s;
#pragma unroll
        for (int o = 1; o < 64; o <<= 1) { const int t = __shfl_up(inc, o); if (lane >= o) inc += t; }
        int ex = inc - s;
#pragma unroll
        for (int i = 0; i < 4; ++i) { const int b = lane * 4 + i; if (b < G) base[b * NE + e] = ex; ex += c[i]; }
        if (lane == 63) pst[e] = inc;
    }
    __syncthreads();
    if (tid == 0) { int o = 0; for (int e = 0; e < NE; ++e) { const int cnt = pst[e]; pst[e] = o; if (bx == 0) cnt_ptr(p, j)[e] = (unsigned)cnt; o += ((cnt + 255) / 256) * 256; } pst[NE] = o; }
    __syncthreads();
    for (long i = gw; i < p.T * 2; i += NGW) { const long t = i >> 1; const int e = p.TOPE[i], blk = (int)((t % NGW) >> 3); const int slot = pst[e] + base[blk * NE + e] + p.POS[i]; if (lane == 0) p.TOKSLOT[i] = slot;
        const u32x4* s = (const u32x4*)(p.HB2 + t * D) + lane; u32x4* d = (u32x4*)(p.XB + (size_t)slot * D) + lane; const u32x4 a = s[0], b = s[64]; d[0] = a; d[64] = b; }
    if (bx == 0) for (int i = tid; i < 1024; i += 512) { int e = -1; if (i * 256 < pst[NE]) { e = 0; for (int q = 1; q < NE; ++q) if (i * 256 >= pst[q]) e = q; } p.TILE_E[i] = e; }
    __syncthreads();
}
typedef short bf16x8 __attribute__((ext_vector_type(8)));
typedef short bf16x4 __attribute__((ext_vector_type(4)));
constexpr int AT_KP = 104, AT_VP = 136, AT_KBYTES = 128 * AT_KP * 2, AT_BUF = AT_KBYTES + 80 * AT_VP * 2;
__device__ __forceinline__ void attn_phase(const MP& p, FLAS unsigned char* lds, int bx, int G) {
    const int S = (int)p.S, nunits = (int)p.B * 4 * 8;
    const int vcu = (G % 8 == 0) ? (bx % 8) * (G / 8) + bx / 8 : bx;
    { const int tid0 = mk_tid(); __syncthreads();
      for (int e = tid0; e < 2 * 16 * AT_VP; e += 512) { const int bufi = e / (16 * AT_VP), r = (e % (16 * AT_VP)) / AT_VP, c = e % AT_VP; ((FLAS bf16*)(lds + bufi * AT_BUF + AT_KBYTES))[(64 + r) * AT_VP + c] = r == 0 ? (bf16)0x3f80 : (bf16)0; } }
    for (int u = vcu; u < nunits; u += G) {
        const int tid = mk_tid(), lane = tid & 63, w = __builtin_amdgcn_readfirstlane(tid >> 6), fr = lane & 15, fq = lane >> 4;
        int kro[3], kco[3];
#pragma unroll
        for (int i = 0; i < 3; ++i) { const int c = tid + 512 * i; kro[i] = c / 12; kco[i] = c % 12; }
        const int vd = tid >> 4, vkc = tid & 15;
        const int bh = u >> 3, jp = u & 7, b = bh >> 2, h = bh & 3;
        const bf16* Kg = p.KK + (size_t)b * S * 384 + h * 96; const bf16* Vg = p.V + (size_t)bh * 64 * S;
        for (int half = 0; half < 2; ++half) {
            const int qb = half ? 15 - jp : jp, q0 = qb * 128, qmin = q0 + 16 * w, qglob = qmin + fr;
            const size_t trow = (size_t)b * S + qglob;
            bf16x8 qf[3];
#pragma unroll
            for (int ks = 0; ks < 3; ++ks) qf[ks] = *(const bf16x8*)(p.Q + trow * 384 + h * 96 + ks * 32 + fq * 8);
            f32x4 o[5];
#pragma unroll
            for (int dt = 0; dt < 5; ++dt) o[dt] = (f32x4){0.f, 0.f, 0.f, 0.f};
            float m = -1e30f;
            const int nkt = qb + 1;
            u32x4 rk[3], rv[2];
#define AT_LOAD(kt_) do { const size_t kb_ = (size_t)(kt_) * 128; _Pragma("unroll") for (int i = 0; i < 3; ++i) rk[i] = *(const u32x4*)(Kg + (kb_ + kro[i]) * 384 + kco[i] * 8); \
            _Pragma("unroll") for (int i = 0; i < 2; ++i) rv[i] = *(const u32x4*)(Vg + (size_t)(vd + 32 * i) * S + kb_ + vkc * 8); } while (0)
#define AT_WRITE(buf_) do { FLAS bf16* Kw = (FLAS bf16*)(lds + (buf_) * AT_BUF); FLAS bf16* Vw = (FLAS bf16*)(lds + (buf_) * AT_BUF + AT_KBYTES); \
            _Pragma("unroll") for (int i = 0; i < 3; ++i) *(FLAS u32x4*)(Kw + kro[i] * AT_KP + kco[i] * 8) = rk[i]; \
            _Pragma("unroll") for (int i = 0; i < 2; ++i) *(FLAS u32x4*)(Vw + (vd + 32 * i) * AT_VP + vkc * 8) = rv[i]; } while (0)
            AT_LOAD(0);
            __syncthreads();
            AT_WRITE(0);
            __syncthreads();
            for (int kt = 0; kt < nkt; ++kt) {
                const bool more = kt + 1 < nkt;
                TP_BEGIN(18, lds); if (more) AT_LOAD(kt + 1); TP_END(18, lds); TP_BEGIN(19, lds);
                const FLAS bf16* Ks = (const FLAS bf16*)(lds + (kt & 1) * AT_BUF); const FLAS bf16* Vt = (const FLAS bf16*)(lds + (kt & 1) * AT_BUF + AT_KBYTES);
                f32x4 s[8];
#pragma unroll
                for (int sub = 0; sub < 8; ++sub) { s[sub] = (f32x4){0.f, 0.f, 0.f, 0.f};
#pragma unroll
                    for (int ks = 0; ks < 3; ++ks) { const bf16x8 a = *(const FLAS bf16x8*)(Ks + (sub * 16 + fr) * AT_KP + ks * 32 + fq * 8); s[sub] = __builtin_amdgcn_mfma_f32_16x16x32_bf16(a, qf[ks], s[sub], 0, 0, 0); } }
                if (kt == qb) {
#pragma unroll
                    for (int sub = 0; sub < 8; ++sub)
#pragma unroll
                        for (int j = 0; j < 4; ++j) if (16 * sub + 4 * fq + j > 16 * w + fr) s[sub][j] = -1e30f; }
                float t0 = __builtin_fmaxf(__builtin_fmaxf(s[0][0], s[0][1]), s[0][2]), t1 = __builtin_fmaxf(__builtin_fmaxf(s[0][3], s[1][0]), s[1][1]);
                t0 = __builtin_fmaxf(__builtin_fmaxf(t0, s[1][2]), s[1][3]);
#pragma unroll
                for (int sub = 2; sub < 8; sub += 2) { t0 = __builtin_fmaxf(__builtin_fmaxf(t0, s[sub][0]), s[sub][1]); t1 = __builtin_fmaxf(__builtin_fmaxf(t1, s[sub][2]), s[sub][3]);
                    t0 = __builtin_fmaxf(__builtin_fmaxf(t0, s[sub + 1][0]), s[sub + 1][1]); t1 = __builtin_fmaxf(__builtin_fmaxf(t1, s[sub + 1][2]), s[sub + 1][3]); }
                float tmax = __builtin_fmaxf(t0, t1);
                tmax = __builtin_fmaxf(tmax, __shfl_xor(tmax, 16)); tmax = __builtin_fmaxf(tmax, __shfl_xor(tmax, 32));
                const float mn = __builtin_fmaxf(m, tmax), alpha = __builtin_amdgcn_exp2f(m - mn); m = mn;
#pragma unroll
                for (int sub = 0; sub < 8; ++sub)
#pragma unroll
                    for (int j = 0; j < 4; ++j) s[sub][j] = __builtin_amdgcn_exp2f(s[sub][j] - mn);
#pragma unroll
                for (int dt = 0; dt < 5; ++dt) o[dt] *= alpha;
#pragma unroll
                for (int k2 = 0; k2 < 4; ++k2) {
                    u32x4 pw; pw.x = pk2(s[2 * k2][0], s[2 * k2][1]); pw.y = pk2(s[2 * k2][2], s[2 * k2][3]); pw.z = pk2(s[2 * k2 + 1][0], s[2 * k2 + 1][1]); pw.w = pk2(s[2 * k2 + 1][2], s[2 * k2 + 1][3]);
                    const bf16x8 pf = __builtin_bit_cast(bf16x8, pw);
#pragma unroll
                    for (int dt = 0; dt < 5; ++dt) { const FLAS bf16* vp = Vt + (dt * 16 + fr) * AT_VP + 32 * k2 + 4 * fq;
                        const u32x2 v0 = *(const FLAS u32x2*)vp, v1 = *(const FLAS u32x2*)(vp + 16); u32x4 vw; vw.x = v0.x; vw.y = v0.y; vw.z = v1.x; vw.w = v1.y;
                        o[dt] = __builtin_amdgcn_mfma_f32_16x16x32_bf16(__builtin_bit_cast(bf16x8, vw), pf, o[dt], 0, 0, 0); } }
                TP_END(19, lds); TP_BEGIN(20, lds); if (more) AT_WRITE((kt + 1) & 1);
                __syncthreads(); TP_END(20, lds);
            }
#undef AT_LOAD
#undef AT_WRITE
            const float l = __shfl(o[4][0], fr);
            const float rl = 1.0f / l;
#pragma unroll
            for (int dt = 0; dt < 4; ++dt) { u32x2 ow; ow.x = pk2(o[dt][0] * rl, o[dt][1] * rl); ow.y = pk2(o[dt][2] * rl, o[dt][3] * rl);
                *(u32x2*)(p.YC + trow * D + 768 + h * 64 + dt * 16 + 4 * fq) = ow; }
        }
    }
    __syncthreads();
}
__device__ __forceinline__ void conv_module(const MP& p, int L, FLAS unsigned char* lds, int bx, int G) {
    FLAS float* Gs = (FLAS float*)lds;
    const int S = (int)p.S, nchunk = S / 64, nitems = (int)p.B * nchunk;
    for (int it = bx; it < nitems; it += G) {
        const int tid = mk_tid(), lane = tid & 63, w = __builtin_amdgcn_readfirstlane(tid >> 6);
        const int ck = it % nchunk, b = it / nchunk, s0 = ck * 64;
        __syncthreads();
        u32x4 rv[6], rg[6];
#pragma unroll
        for (int i = 0; i < 6; ++i) { const int idx = tid + 512 * i, row = idx >> 5, c = idx & 31, sp = s0 - 30 + row; rv[i] = (u32x4){0u, 0u, 0u, 0u}; rg[i] = rv[i];
            if (idx < 94 * 32 && sp >= 0) { const bf16* u = p.U + ((size_t)b * S + sp) * NU + c * 8; rv[i] = *(const u32x4*)u; rg[i] = *(const u32x4*)(u + 256); } }
        __builtin_amdgcn_sched_barrier(0);
#pragma unroll
        for (int i = 0; i < 6; ++i) { const int idx = tid + 512 * i, row = idx >> 5, c = idx & 31;
            if (idx < 94 * 32) { const unsigned v[4] = {rv[i].x, rv[i].y, rv[i].z, rv[i].w}, g[4] = {rg[i].x, rg[i].y, rg[i].z, rg[i].w}; f32x4 o0, o1;
                o0.x = blo(v[0]) / (1.0f + __expf(-blo(g[0]))); o0.y = bhi(v[0]) / (1.0f + __expf(-bhi(g[0]))); o0.z = blo(v[1]) / (1.0f + __expf(-blo(g[1]))); o0.w = bhi(v[1]) / (1.0f + __expf(-bhi(g[1])));
                o1.x = blo(v[2]) / (1.0f + __expf(-blo(g[2]))); o1.y = bhi(v[2]) / (1.0f + __expf(-bhi(g[2]))); o1.z = blo(v[3]) / (1.0f + __expf(-blo(g[3]))); o1.w = bhi(v[3]) / (1.0f + __expf(-bhi(g[3])));
                *(FLAS f32x4*)(Gs + row * 256 + c * 8) = o0; *(FLAS f32x4*)(Gs + row * 256 + c * 8 + 4) = o1; } }
        __syncthreads();
        const int ch = (w & 3) * 64 + lane, tb = (w >> 2) * 32; float wj[CK];
#pragma unroll
        for (int j = 0; j < CK; ++j) wj[j] = p.cdw_w[(L * CK + j) * 256 + ch];
        const float bias = p.cdw_b[L * 256 + ch], lg = p.cln_g[L * 256 + ch], lb = p.cln_b[L * 256 + ch];
#pragma unroll 1
        for (int i8 = 0; i8 < 4; ++i8) { const int tl0 = tb + 8 * i8; float win[38], acc[8];
#pragma unroll
            for (int r = 0; r < 38; ++r) win[r] = Gs[(tl0 + r) * 256 + ch];
#pragma unroll
            for (int q = 0; q < 8; ++q) { float a = bias;
#pragma unroll
                for (int j = 0; j < CK; ++j) a += wj[j] * win[q + j];
                acc[q] = a; }
            float mu[8], var[8];
#pragma unroll
            for (int q = 0; q < 8; ++q) mu[q] = acc[q];
#pragma unroll
            for (int o = 1; o < 64; o <<= 1)
#pragma unroll
                for (int q = 0; q < 8; ++q) mu[q] += __shfl_xor(mu[q], o);
#pragma unroll
            for (int q = 0; q < 8; ++q) { mu[q] *= (1.0f / 64.f); acc[q] -= mu[q]; var[q] = acc[q] * acc[q]; }
#pragma unroll
            for (int o = 1; o < 64; o <<= 1)
#pragma unroll
                for (int q = 0; q < 8; ++q) var[q] += __shfl_xor(var[q], o);
#pragma unroll
            for (int q = 0; q < 8; ++q) { const float hn = acc[q] * (1.0f / sqrtf(var[q] * (1.0f / 64.f) + LN_EPS)) * lg + lb; p.YC[((size_t)b * S + s0 + tl0 + q) * D + ch] = f2bf(hn / (1.0f + __expf(-hn))); } }
    }
    __syncthreads();
}
constexpr int MQ_P = 264, MK_P = 136;
__device__ __forceinline__ void mla_proj(const MP& p, int L, FLAS unsigned char* lds, int bx, int G) {
    FLAS bf16* Aq = (FLAS bf16*)lds; FLAS bf16* Ak = (FLAS bf16*)(lds + 64 * MQ_P * 2);
    const int nunits = (int)(p.T / 64);
    const bf16* Wq = p.WUQ + (size_t)L * 512 * 256; const bf16* Wk = p.WUKV + (size_t)L * 512 * 128;
    for (int u = bx; u < nunits; u += G) {
        const int tid = mk_tid(), lane = tid & 63, w = __builtin_amdgcn_readfirstlane(tid >> 6), fr = lane & 15, fq = lane >> 4;
        const size_t t0 = (size_t)u * 64;
        __syncthreads();
        {
            u32x2 rq[8]; unsigned rk[8];
#pragma unroll
            for (int i = 0; i < 8; ++i) { const bf16* urow = p.U + (t0 + w * 8 + i) * NU; rq[i] = *(const u32x2*)(urow + U_CQ + lane * 4); rk[i] = *(const unsigned*)(urow + U_CKV + lane * 2); }
            const f32x4 gq = *(const f32x4*)(p.qn_g + L * 256 + lane * 4); const f32x2 gk = *(const f32x2*)(p.kvn_g + L * 128 + lane * 2);
            __builtin_amdgcn_sched_barrier(0);
#pragma unroll
            for (int i = 0; i < 8; ++i) { const int r = w * 8 + i;
                { const float a0 = blo(rq[i].x), a1 = bhi(rq[i].x), a2 = blo(rq[i].y), a3 = bhi(rq[i].y); const float rs = 1.0f / sqrtf(wave_sum((a0 * a0 + a1 * a1) + (a2 * a2 + a3 * a3)) * (1.0f / 256.f) + RMS_EPS);
                  u32x2 o; o.x = pk2(a0 * rs * gq.x, a1 * rs * gq.y); o.y = pk2(a2 * rs * gq.z, a3 * rs * gq.w); *(FLAS u32x2*)(Aq + r * MQ_P + lane * 4) = o; }
                { const float a0 = blo(rk[i]), a1 = bhi(rk[i]); const float rs = 1.0f / sqrtf(wave_sum(a0 * a0 + a1 * a1) * (1.0f / 128.f) + RMS_EPS); *(FLAS unsigned*)(Ak + r * MK_P + lane * 2) = pk2(a0 * rs * gk.x, a1 * rs * gk.y); } } }
#pragma unroll
        for (int e2 = 0; e2 < 2; ++e2) { const int e = tid + 512 * e2, r = e >> 4, jj = e & 15; const size_t t = t0 + r; const float x1 = bf2f(p.U[t * NU + U_KR + jj]), x2 = bf2f(p.U[t * NU + U_KR + 16 + jj]), c = p.CS[t * 32 + jj], sn = p.CS[t * 32 + 16 + jj];
            const bf16 o1 = f2bf(x1 * c - x2 * sn), o2 = f2bf(x1 * sn + x2 * c);
#pragma unroll
            for (int h = 0; h < 4; ++h) { p.KK[t * 384 + h * 96 + 64 + jj] = o1; p.KK[t * 384 + h * 96 + 80 + jj] = o2; } }
        __syncthreads();
        {
            f32x4 acc[3][4];
#pragma unroll
            for (int ct = 0; ct < 3; ++ct)
#pragma unroll
                for (int rt = 0; rt < 4; ++rt) acc[ct][rt] = (f32x4){0.f, 0.f, 0.f, 0.f};
#pragma unroll
            for (int kh = 0; kh < 2; ++kh) { bf16x8 wf[4][3];
#pragma unroll
                for (int k4 = 0; k4 < 4; ++k4)
#pragma unroll
                    for (int ct = 0; ct < 3; ++ct) wf[k4][ct] = *(const bf16x8*)(Wq + (size_t)(48 * w + 16 * ct + fr) * 256 + (4 * kh + k4) * 32 + fq * 8);
                __builtin_amdgcn_sched_barrier(0);
#pragma unroll
                for (int k4 = 0; k4 < 4; ++k4)
#pragma unroll
                    for (int rt = 0; rt < 4; ++rt) { const bf16x8 tk = *(const FLAS bf16x8*)(Aq + (rt * 16 + fr) * MQ_P + (4 * kh + k4) * 32 + fq * 8);
#pragma unroll
                        for (int ct = 0; ct < 3; ++ct) acc[ct][rt] = __builtin_amdgcn_mfma_f32_16x16x32_bf16(wf[k4][ct], tk, acc[ct][rt], 0, 0, 0); } }
            const bool pe = (w & 1) != 0;
#pragma unroll
            for (int rt = 0; rt < 4; ++rt) { const size_t t = t0 + rt * 16 + fr; bf16* qrow = p.Q + t * 384 + 48 * w + 4 * fq;
                f32x4 v0 = acc[0][rt], v1 = acc[1][rt], v2 = acc[2][rt];
                if (pe) { const f32x4 c = *(const f32x4*)(p.CS + t * 32 + 4 * fq), sn = *(const f32x4*)(p.CS + t * 32 + 16 + 4 * fq); const f32x4 x1 = v1, x2 = v2; v1 = x1 * c - x2 * sn; v2 = x1 * sn + x2 * c; }
                u32x2 o; o.x = pk2(v0.x * QSCALE, v0.y * QSCALE); o.y = pk2(v0.z * QSCALE, v0.w * QSCALE); *(u32x2*)qrow = o;
                o.x = pk2(v1.x * QSCALE, v1.y * QSCALE); o.y = pk2(v1.z * QSCALE, v1.w * QSCALE); *(u32x2*)(qrow + 16) = o;
                o.x = pk2(v2.x * QSCALE, v2.y * QSCALE); o.y = pk2(v2.z * QSCALE, v2.w * QSCALE); *(u32x2*)(qrow + 32) = o; }
        }
        {
            f32x4 acc[4][4];
#pragma unroll
            for (int ct = 0; ct < 4; ++ct)
#pragma unroll
                for (int rt = 0; rt < 4; ++rt) acc[ct][rt] = (f32x4){0.f, 0.f, 0.f, 0.f};
            const int h = w >> 1; const bool isv = (w & 1) != 0;
            bf16x8 wf[4][4];
#pragma unroll
            for (int ks = 0; ks < 4; ++ks)
#pragma unroll
                for (int ct = 0; ct < 4; ++ct) wf[ks][ct] = *(const bf16x8*)(Wk + (size_t)(64 * w + 16 * ct + fr) * 128 + ks * 32 + fq * 8);
            __builtin_amdgcn_sched_barrier(0);
            if (!isv) {
#pragma unroll
                for (int ks = 0; ks < 4; ++ks)
#pragma unroll
                    for (int rt = 0; rt < 4; ++rt) { const bf16x8 tk = *(const FLAS bf16x8*)(Ak + (rt * 16 + fr) * MK_P + ks * 32 + fq * 8);
#pragma unroll
                        for (int ct = 0; ct < 4; ++ct) acc[ct][rt] = __builtin_amdgcn_mfma_f32_16x16x32_bf16(wf[ks][ct], tk, acc[ct][rt], 0, 0, 0); }
#pragma unroll
                for (int rt = 0; rt < 4; ++rt) { const size_t t = t0 + rt * 16 + fr; bf16* dst = p.KK + t * 384 + h * 96 + 4 * fq;
#pragma unroll
                    for (int ct = 0; ct < 4; ++ct) { u32x2 o; o.x = pk2(acc[ct][rt].x, acc[ct][rt].y); o.y = pk2(acc[ct][rt].z, acc[ct][rt].w); *(u32x2*)(dst + 16 * ct) = o; } }
            } else {
#pragma unroll
                for (int ks = 0; ks < 4; ++ks)
#pragma unroll
                    for (int rt = 0; rt < 4; ++rt) { const bf16x8 tk = *(const FLAS bf16x8*)(Ak + (rt * 16 + fr) * MK_P + ks * 32 + fq * 8);
#pragma unroll
                        for (int ct = 0; ct < 4; ++ct) acc[ct][rt] = __builtin_amdgcn_mfma_f32_16x16x32_bf16(tk, wf[ks][ct], acc[ct][rt], 0, 0, 0); }
                const size_t bq = t0 / p.S, sq = t0 % p.S;
#pragma unroll
                for (int ct = 0; ct < 4; ++ct) { bf16* drow = p.V + ((bq * 4 + h) * 64 + 16 * ct + fr) * p.S + sq + 4 * fq;
#pragma unroll
                    for (int rt = 0; rt < 4; ++rt) { u32x2 o; o.x = pk2(acc[ct][rt].x, acc[ct][rt].y); o.y = pk2(acc[ct][rt].z, acc[ct][rt].w); *(u32x2*)(drow + 16 * rt) = o; } }
            }
        }
    }
    __syncthreads();
}
__device__ __forceinline__ void ssd_scan(const MP& p, int bx, int G) {
    const int tid = mk_tid(); const long g0 = (long)bx * 512 + tid, gs = (long)G * 512; const int NCB = (int)(p.S / CHUNK);
    for (long i = g0; i < p.B * 8 * 64 * 32; i += gs) { const long b = i / (8 * 64 * 32), r = i % (8 * 64 * 32); const int h = (int)(r / (64 * 32)); f32x4 carry = (f32x4){0.f, 0.f, 0.f, 0.f};
        f32x4 st[16]; float dec[16];
#pragma unroll
        for (int cc = 0; cc < 16; ++cc) { const long c = b * NCB + cc; st[cc] = ((const f32x4*)p.ST)[(size_t)c * (8 * 64 * 32) + r]; dec[cc] = p.ACS[(c * CHUNK + CHUNK - 1) * 8 + h]; }
        __builtin_amdgcn_sched_barrier(0);
#pragma unroll
        for (int cc = 0; cc < 16; ++cc) { const long c = b * NCB + cc; u32x2 o; o.x = pk2(carry.x, carry.y); o.y = pk2(carry.z, carry.w); ((u32x2*)p.PV)[(size_t)c * (8 * 64 * 32) + r] = o; carry = carry * __expf(dec[cc]) + st[cc]; } }
}
constexpr int SP = 136;
constexpr int SA_DT = 0, SA_ACS = 2048, SA_CM = 4096, SA_BM = SA_CM + 128 * SP * 2, SA_XT = SA_CM, SA_BT = SA_CM + 2 * 128 * SP * 2, SA_MW = SA_BT + 128 * SP * 2, SA_END = SA_MW + 8 * 16 * SP * 2;
__device__ __forceinline__ float silu_f(float x) { return x / (1.0f + __expf(-x)); }
__device__ __forceinline__ float softplus_fast(float x) { if (x > 20.f) return x; const float e = __builtin_amdgcn_exp2f(x * 1.4426950408889634f); return e < 1e-3f ? e * (1.0f - 0.5f * e) : 0.6931471805599453f * __builtin_amdgcn_logf(1.0f + e); }
template <int MODE> __device__ __forceinline__ void conv64(const MP& p, int L, const bf16* ub  , int xc  , int s0, int l0  ,
                                                          FLAS bf16* d0, FLAS bf16* d1, bf16* gb  , int gcol  , int gstride, const FLAS float* dts, int n) {
    const float w0 = p.sconv_w[(L * 4 + 0) * 1024 + xc], w1 = p.sconv_w[(L * 4 + 1) * 1024 + xc], w2 = p.sconv_w[(L * 4 + 2) * 1024 + xc], w3 = p.sconv_w[(L * 4 + 3) * 1024 + xc], bias = p.sconv_b[L * 1024 + xc];
#pragma unroll
    for (int hb = 0; hb < 2; ++hb) { const int lb = l0 + 32 * hb; float x[35];
#pragma unroll
        for (int i = 0; i < 35; ++i) { const int sp = s0 + lb - 3 + i; const bf16* rowp = ub + (size_t)(sp < 0 ? 0 : sp) * NU; x[i] = (i >= 3 || sp >= 0) ? bf2f(rowp[xc]) : 0.f; }
        __builtin_amdgcn_sched_barrier(0);
#pragma unroll
        for (int i = 0; i < 32; ++i) { const int l = lb + i; const bf16 vb = f2bf(silu_f(bias + w0 * x[i] + w1 * x[i + 1] + w2 * x[i + 2] + w3 * x[i + 3])); bf16* grow = gb + (size_t)l * gstride;
            if (MODE == 0) { d0[l * SP + n] = vb; grow[gcol] = vb; }
            if (MODE == 1) { d0[l * SP + n] = vb; d1[n * SP + l] = vb; }
            if (MODE == 2) { grow[gcol] = vb; d0[n * SP + l] = f2bf(bf2f(vb) * dts[l]); } } }
}
__device__ __forceinline__ void ssd_a(const MP& p, int L, FLAS unsigned char* lds, int bx, int G) {
    FLAS float* dtL = (FLAS float*)(lds + SA_DT); FLAS float* acsL = (FLAS float*)(lds + SA_ACS);
    FLAS bf16* Cm = (FLAS bf16*)(lds + SA_CM); FLAS bf16* Bm = (FLAS bf16*)(lds + SA_BM); FLAS bf16* XT = (FLAS bf16*)(lds + SA_XT); FLAS bf16* BT = (FLAS bf16*)(lds + SA_BT);
    const int S = (int)p.S, nunits = (int)(p.T / CHUNK) * 2;
    for (int u = bx; u < nunits; u += G) {
        const int tid = mk_tid(), lane = tid & 63, w = __builtin_amdgcn_readfirstlane(tid >> 6), fr = lane & 15, fq = lane >> 4;
        FLAS bf16* Mw = (FLAS bf16*)(lds + SA_MW + w * (16 * SP * 2));
        const int g = u & 1; const long c = u >> 1; const size_t t0 = (size_t)c * CHUNK; const int s0 = (int)(t0 % S); const size_t tb = t0 - s0;
        __syncthreads();
        {
            const int h4 = tid >> 7, l = tid & 127, h = 4 * g + h4; dtL[h4 * 128 + l] = softplus_fast(bf2f(p.U[(t0 + l) * NU + U_DT + h]) + p.dt_bias[L * 8 + h]); }
        {
            const int ch = tid & 255, half = __builtin_amdgcn_readfirstlane(tid >> 8), n = ch & 127; const bool isC = __builtin_amdgcn_readfirstlane(ch >= 128 ? 1 : 0) != 0; const int xc = (isC ? 768 : 512) + 128 * g + n;
            if (isC) conv64<0>(p, L, p.U + tb * NU + U_XBC, xc, s0, 64 * half, Cm, nullptr, p.CM + t0 * 256 + g * 128, n, 256, nullptr, n);
            else conv64<1>(p, L, p.U + tb * NU + U_XBC, xc, s0, 64 * half, Bm, BT, p.CM, 0, 0, nullptr, n); }
        __syncthreads();
        if (w < 4) {
            const int h = 4 * g + w; const float a = -__expf(p.a_log[L * 8 + h]); const float x0 = dtL[w * 128 + 2 * lane] * a, x1 = dtL[w * 128 + 2 * lane + 1] * a, ps = x0 + x1; float inc = ps;
#pragma unroll
            for (int o = 1; o < 64; o <<= 1) { const float t = __shfl_up(inc, o); if (lane >= o) inc += t; }
            const float ex = inc - ps, c0 = ex + x0, c1 = ex + ps; *(FLAS f32x2*)(acsL + w * 128 + 2 * lane) = (f32x2){c0, c1};
            p.ACS[(t0 + 2 * lane) * 8 + h] = c0; p.ACS[(t0 + 2 * lane + 1) * 8 + h] = c1; }
        f32x4 cbT[8];
#pragma unroll
        for (int ct = 0; ct < 8; ++ct) cbT[ct] = (f32x4){0.f, 0.f, 0.f, 0.f};
#pragma unroll
        for (int ks = 0; ks < 4; ++ks) { const bf16x8 cf = *(const FLAS bf16x8*)(Cm + (16 * w + fr) * SP + ks * 32 + fq * 8);
#pragma unroll
            for (int ct = 0; ct < 8; ++ct) { const bf16x8 bfm = *(const FLAS bf16x8*)(Bm + (16 * ct + fr) * SP + ks * 32 + fq * 8); cbT[ct] = __builtin_amdgcn_mfma_f32_16x16x32_bf16(bfm, cf, cbT[ct], 0, 0, 0); } }
        __syncthreads();
        {
            const int ch = tid & 255, half = __builtin_amdgcn_readfirstlane(tid >> 8), h4 = __builtin_amdgcn_readfirstlane(ch >> 6), xc = 256 * g + ch;
            conv64<2>(p, L, p.U + tb * NU + U_XBC, xc, s0, 64 * half, XT, nullptr, p.XS + t0 * 512, xc, 512, dtL + h4 * 128, ch); }
        __syncthreads();
#pragma unroll 1
        for (int r = 0; r < 4; ++r) {
            const FLAS float* ac = acsL + r * 128; const int h = 4 * g + r; const float al = ac[16 * w + fr];
#pragma unroll
            for (int ct = 0; ct < 8; ++ct) { const f32x4 as = *(const FLAS f32x4*)(ac + 16 * ct + 4 * fq); const int sb = 16 * ct + 4 * fq, l = 16 * w + fr; float m0, m1, m2, m3;
                m0 = (sb + 0 <= l) ? cbT[ct].x * __expf(al - as.x) : 0.f; m1 = (sb + 1 <= l) ? cbT[ct].y * __expf(al - as.y) : 0.f; m2 = (sb + 2 <= l) ? cbT[ct].z * __expf(al - as.z) : 0.f; m3 = (sb + 3 <= l) ? cbT[ct].w * __expf(al - as.w) : 0.f;
                u32x2 o; o.x = pk2(m0, m1); o.y = pk2(m2, m3); *(FLAS u32x2*)(Mw + fr * SP + sb) = o; }
            FP_LDS_WAIT(); asm volatile("" ::: "memory");
            f32x4 yd[4], st[4];
#pragma unroll
            for (int pt = 0; pt < 4; ++pt) { yd[pt] = (f32x4){0.f, 0.f, 0.f, 0.f}; st[pt] = (f32x4){0.f, 0.f, 0.f, 0.f}; }
            const float alast = ac[127];
#pragma unroll
            for (int ks = 0; ks < 4; ++ks) { const bf16x8 am = *(const FLAS bf16x8*)(Mw + fr * SP + ks * 32 + fq * 8);
                const u32x4 braw = *(const FLAS u32x4*)(BT + (16 * w + fr) * SP + ks * 32 + fq * 8); const f32x4 e0 = *(const FLAS f32x4*)(ac + ks * 32 + fq * 8), e1 = *(const FLAS f32x4*)(ac + ks * 32 + fq * 8 + 4); u32x4 bs;
                bs.x = pk2(blo(braw.x) * __expf(alast - e0.x), bhi(braw.x) * __expf(alast - e0.y)); bs.y = pk2(blo(braw.y) * __expf(alast - e0.z), bhi(braw.y) * __expf(alast - e0.w));
                bs.z = pk2(blo(braw.z) * __expf(alast - e1.x), bhi(braw.z) * __expf(alast - e1.y)); bs.w = pk2(blo(braw.w) * __expf(alast - e1.z), bhi(braw.w) * __expf(alast - e1.w));
                const bf16x8 bsf = __builtin_bit_cast(bf16x8, bs);
#pragma unroll
                for (int pt = 0; pt < 4; ++pt) { const bf16x8 x = *(const FLAS bf16x8*)(XT + (r * 64 + 16 * pt + fr) * SP + ks * 32 + fq * 8);
                    yd[pt] = __builtin_amdgcn_mfma_f32_16x16x32_bf16(x, am, yd[pt], 0, 0, 0); st[pt] = __builtin_amdgcn_mfma_f32_16x16x32_bf16(bsf, x, st[pt], 0, 0, 0); } }
#pragma unroll
            for (int pt = 0; pt < 4; ++pt) { u32x2 o; o.x = pk2(yd[pt].x, yd[pt].y); o.y = pk2(yd[pt].z, yd[pt].w); *(u32x2*)(p.YD + (t0 + 16 * w + fr) * 512 + h * 64 + 16 * pt + 4 * fq) = o;
                *(f32x4*)(p.ST + (((size_t)c * 8 + h) * 64 + 16 * pt + fr) * 128 + 16 * w + 4 * fq) = st[pt]; }
            asm volatile("" ::: "memory");
        }
    }
    __syncthreads();
}
__device__ __forceinline__ void ssd_c(const MP& p, int L, FLAS unsigned char* lds, int bx, int G) {
    const int nunits = (int)(p.T / CHUNK) * 2;
    for (int u = bx; u < nunits; u += G) {
        const int tid = mk_tid(), lane = tid & 63, w = __builtin_amdgcn_readfirstlane(tid >> 6), fr = lane & 15, fq = lane >> 4;
        const int g = u & 1; const long c = u >> 1; const size_t t0 = (size_t)c * CHUNK, t = t0 + 16 * w + fr;
        bf16x8 cf[4];
        TP_BEGIN(23, lds);
#pragma unroll
        for (int ks = 0; ks < 4; ++ks) cf[ks] = *(const bf16x8*)(p.CM + t * 256 + g * 128 + ks * 32 + fq * 8);
        if ((PROBE_T >> 23) & 1) { asm volatile("s_waitcnt vmcnt(0)" ::: "memory"); } TP_END(23, lds);
        f32x4 y[4][4]; float ssq = 0.f;
        TP_BEGIN(21, lds);
#pragma unroll
        for (int r = 0; r < 4; ++r) { const int h = 4 * g + r; const bf16* pv = p.PV + (((size_t)c * 8 + h) * 64) * 128; const float dsk = p.dskip[L * 8 + h], ea = __expf(p.ACS[t * 8 + h]);
            u32x2 ryd[4], rxs[4], rz[4];
#pragma unroll
            for (int pt = 0; pt < 4; ++pt) { const int ch = h * 64 + 16 * pt + 4 * fq; ryd[pt] = *(const u32x2*)(p.YD + t * 512 + ch); rxs[pt] = *(const u32x2*)(p.XS + t * 512 + ch); rz[pt] = *(const u32x2*)(p.U + t * NU + U_Z + ch); }
#pragma unroll
            for (int ph = 0; ph < 2; ++ph) { bf16x8 pvf[2][4];
#pragma unroll
                for (int pq = 0; pq < 2; ++pq)
#pragma unroll
                    for (int ks = 0; ks < 4; ++ks) pvf[pq][ks] = *(const bf16x8*)(pv + (size_t)(16 * (2 * ph + pq) + fr) * 128 + ks * 32 + fq * 8);
                __builtin_amdgcn_sched_barrier(0);
#pragma unroll
                for (int pq = 0; pq < 2; ++pq) { const int pt = 2 * ph + pq; f32x4 acc = (f32x4){0.f, 0.f, 0.f, 0.f};
#pragma unroll
                    for (int ks = 0; ks < 4; ++ks) acc = __builtin_amdgcn_mfma_f32_16x16x32_bf16(pvf[pq][ks], cf[ks], acc, 0, 0, 0);
                f32x4 yv;
                yv.x = (acc.x * ea + blo(ryd[pt].x) + dsk * blo(rxs[pt].x)) * silu_f(blo(rz[pt].x)); yv.y = (acc.y * ea + bhi(ryd[pt].x) + dsk * bhi(rxs[pt].x)) * silu_f(bhi(rz[pt].x));
                yv.z = (acc.z * ea + blo(ryd[pt].y) + dsk * blo(rxs[pt].y)) * silu_f(blo(rz[pt].y)); yv.w = (acc.w * ea + bhi(ryd[pt].y) + dsk * bhi(rxs[pt].y)) * silu_f(bhi(rz[pt].y));
                y[r][pt] = yv; ssq += (yv.x * yv.x + yv.y * yv.y) + (yv.z * yv.z + yv.w * yv.w); } } }
        asm volatile("s_waitcnt vmcnt(0)" ::: "memory"); TP_END(21, lds); TP_BEGIN(22, lds);
        ssq += __shfl_xor(ssq, 16); ssq += __shfl_xor(ssq, 32);
        const float rs = 1.0f / sqrtf(ssq * (1.0f / 256.f) + RMS_EPS);
#pragma unroll
        for (int r = 0; r < 4; ++r)
#pragma unroll
            for (int pt = 0; pt < 4; ++pt) { const int cc = g * 256 + r * 64 + 16 * pt + 4 * fq; const f32x4 gn = *(const f32x4*)(p.snorm_g + L * 512 + cc); const f32x4 v = y[r][pt];
                u32x2 o; o.x = pk2(v.x * rs * gn.x, v.y * rs * gn.y); o.y = pk2(v.z * rs * gn.z, v.w * rs * gn.w); *(u32x2*)(p.YC + t * D + 256 + cc) = o; }
        asm volatile("s_waitcnt vmcnt(0)" ::: "memory"); TP_END(22, lds);
    }
}
}

using namespace mdl;
#define LAS __attribute__((address_space(3)))
constexpr int NWAVES = 8, NTHR = NWAVES * 64;
constexpr int CW_BAR = 4096;
#define XB_TMO      128
#define XB_XCNT(j)  (256  + 64 * (j))
#define XB_XSUB(j)  (1280 + 64 * (j))
#define XB_XGEN(j)  (2304 + 64 * (j))
#define XB_TOP      3328
#define XB_TOPGEN   3392
#define XCD_BAR_WORDS 3456
#define XB_SPIN_CAP (1u << 18)

__device__ __forceinline__ unsigned xb_ld(unsigned* p)              { return __hip_atomic_load(p, __ATOMIC_RELAXED, __HIP_MEMORY_SCOPE_AGENT); }
__device__ __forceinline__ unsigned xb_add(unsigned* p, unsigned v) { return __hip_atomic_fetch_add(p, v, __ATOMIC_RELAXED, __HIP_MEMORY_SCOPE_AGENT); }
__device__ __forceinline__ unsigned xb_xcc_id() { return (unsigned)__builtin_amdgcn_s_getreg((3 << 11) | 20) & 0xFu; }
#define XB_SPIN(cond, bar) do { unsigned _sp = 0; while (cond) { __builtin_amdgcn_s_sleep(1); \
    if ((++_sp & 255u) == 0u) { if (xb_ld(&(bar)[XB_TMO])) break; if (_sp > XB_SPIN_CAP) { atomicAdd(&(bar)[XB_TMO], 1u); break; } } } } while (0)

struct XcdBarrier {
    unsigned* bar; unsigned x;
    volatile LAS unsigned* st;
};

__device__ __forceinline__ XcdBarrier xcd_barrier_post(unsigned* bar, volatile LAS unsigned* st) {
    XcdBarrier b; b.bar = bar; b.x = xb_xcc_id(); b.st = st;
    if (threadIdx.x == 0) (void)xb_add(&bar[XB_XCNT(b.x)], 1u);
    return b;
}
__device__ __forceinline__ void xcd_barrier_complete(unsigned* bar, unsigned x, unsigned& nloc, unsigned& nx) {
    const unsigned G = gridDim.x * gridDim.y * gridDim.z;
    unsigned sum, cnt, mine, sp = 0u;
    for (;;) {
        sum = 0u; cnt = 0u; mine = 0u;
#pragma unroll
        for (unsigned j = 0; j < 16; ++j) { const unsigned c = xb_ld(&bar[XB_XCNT(j)]); sum += c; cnt += (c > 0u) ? 1u : 0u; mine = (j == x) ? c : mine; }
        if (sum == G) break;
        __builtin_amdgcn_s_sleep(1);
        if ((++sp & 255u) == 0u) { if (xb_ld(&bar[XB_TMO])) break; if (sp > XB_SPIN_CAP) { atomicAdd(&bar[XB_TMO], 1u); break; } }
    }
    nloc = mine > 0u ? mine : 1u; nx = cnt > 0u ? cnt : 1u;
}

__device__ __forceinline__ void xcd_barrier(const XcdBarrier& b) {
    asm volatile("s_waitcnt vmcnt(0)" ::: "memory");
    __syncthreads();
    if (threadIdx.x == 0) {
        unsigned* bar = b.bar;
        __builtin_amdgcn_s_waitcnt(0);
        unsigned nloc = b.st[0], nx = b.st[1];
        if (nloc == 0u) { xcd_barrier_complete(bar, b.x, nloc, nx); b.st[0] = nloc; b.st[1] = nx; }
        const unsigned old = xb_add(&bar[XB_XSUB(b.x)], 1u);
        const unsigned gen = old / nloc;
        if (old + 1u == (gen + 1u) * nloc) {
            __builtin_amdgcn_fence(__ATOMIC_RELEASE, "agent");
            asm volatile("s_waitcnt vmcnt(0)" ::: "memory");
            const unsigned og = xb_add(&bar[XB_TOP], 1u);
            const unsigned tg = og / nx;
            if (og + 1u == (tg + 1u) * nx) xb_add(&bar[XB_TOPGEN], 1u);
            else XB_SPIN(xb_ld(&bar[XB_TOPGEN]) == tg, bar);
            __builtin_amdgcn_fence(__ATOMIC_ACQUIRE, "agent");
            xb_add(&bar[XB_XGEN(b.x)], 1u);
            asm volatile("s_waitcnt vmcnt(0)" ::: "memory");
        } else {
            XB_SPIN(xb_ld(&bar[XB_XGEN(b.x)]) == gen, bar);
            __builtin_amdgcn_fence(__ATOMIC_ACQUIRE, "agent");
            asm volatile("s_waitcnt vmcnt(0)" ::: "memory");
        }
    }
    __syncthreads();
}

struct Args { MP p; long flags; };
__global__ void __launch_bounds__(NTHR, 2) mk_fwd(Args a) {
    extern __shared__ __attribute__((aligned(16))) unsigned char lds[];
    LAS unsigned char* const L3 = (LAS unsigned char*)lds;
    volatile LAS unsigned* MISC = (volatile LAS unsigned*)(L3 + MISC_OFF);
    const MP& p = a.p;
    const int tid = threadIdx.x;
    for (int u = tid; u < (LDS_BYTES - LDSCTL_OFF) / 4; u += NTHR) ((LAS unsigned*)(L3 + LDSCTL_OFF))[u] = 0u;
    __syncthreads();
    const XcdBarrier bar = xcd_barrier_post(p.ctl + CW_BAR, MISC + 8);
    const int G = gridDim.x, bx = blockIdx.x;
    const long gs = (long)G * NTHR;
#define g0 ((long)bx * NTHR + mk_tid())
#ifndef PROBE_MASK
#define PROBE_MASK 0
#endif
#define REP(k) for (int rep_ = 0; rep_ < ((PROBE_MASK >> (k)) & 1) + 1; ++rep_)
#define GRID_BAR() do { REP(10) xcd_barrier(bar); } while (0)
#define PH_BEGIN(id) TP_BEGIN(id, L3)
#define PH_END(id) TP_END(id, L3)
    PH_BEGIN(0); REP(0) fp::prologue(p, L3, bx, G);
    GRID_BAR(); PH_END(0);
    for (int L = 0; L < DEPTH; ++L) {
        const int j = L >> 1; const bool moe = (L & 1) != 0;
        PH_BEGIN(1);
        REP(1) {
            pg8::Gemm g{p.HB, p.WIN + (size_t)L * NU * D, (int)p.T, NU, D, D}; pg8::StaticOrder S; S.init((int)p.T, NU, G, bx);
            pg8::EpiStore16 E{p.U, NU, rss_ptr(p, L, 0)}; pg8::gemm_phase<pg8::EpiStore16, pg8::StaticOrder, true, true>(L3, g, S, E);
            pg8::Gemm g2{p.PB16 + (size_t)L * p.T * PLE, p.WPP + (size_t)L * D * PLE, (int)p.T, D, PLE, PLE}; pg8::StaticOrder S2; S2.init((int)p.T, D, G, bx);
            pg8::EpiStore16 E2{p.PJ, D, nullptr}; pg8::gemm_phase<pg8::EpiStore16, pg8::StaticOrder, true, true>(L3, g2, S2, E2);
        }
        GRID_BAR(); PH_END(1); PH_BEGIN(2);
        REP(6) { PH_BEGIN(13); fp::conv_module(p, L, L3, bx, G); PH_END(13); PH_BEGIN(14); fp::mla_proj(p, L, L3, bx, G); PH_END(14); PH_BEGIN(15); fp::ssd_a(p, L, L3, bx, G); PH_END(15); }
        GRID_BAR(); PH_END(2); PH_BEGIN(3);
        REP(7) { PH_BEGIN(16); fp::ssd_scan(p, bx, G); PH_END(16); PH_BEGIN(17); fp::attn_phase(p, L3, bx, G); PH_END(17); }
        GRID_BAR(); PH_END(3); PH_BEGIN(4);
        REP(8) fp::ssd_c(p, L, L3, bx, G);
        GRID_BAR(); PH_END(4); PH_BEGIN(5);
        {
            pg8::Gemm g{p.YC, p.WOUT + (size_t)L * D * D, (int)p.T, D, D, D}; pg8::StaticOrder S; S.init((int)p.T, D, G, bx);
            pg8::EpiAddH E{p.H, D, p.HB2, rss_ptr(p, L, 1)}; pg8::gemm_phase<pg8::EpiAddH, pg8::StaticOrder, true, true>(L3, g, S, E);
        }
        GRID_BAR(); PH_END(5);
        if (moe) { PH_BEGIN(6); fp::norm_phase<1>(p, L, p.ffn_g + L * D, bx, G, (LAS unsigned*)L3); GRID_BAR(); PH_END(6); PH_BEGIN(7); fp::moeplan(p, L, L3, bx, G); GRID_BAR(); PH_END(7); }
        PH_BEGIN(8);
        {
            const int rows = moe ? moe_start_of(p, j, NE) : (int)p.T;
            pg8::Gemm g{moe ? p.XB : p.HB2, moe ? p.MWGU + (size_t)j * NE * NGU * D : p.DWGU + (size_t)j * NGU * D, rows, NGU, D, D};
            pg8::ExpertOrder S; S.init(rows, NGU, G, bx); S.tile_e = moe ? p.TILE_E : nullptr;
            REP(3) { pg8::EpiSwiglu E{p.ACT, DFF, moe ? nullptr : rss_ptr(p, L, 1)}; pg8::gemm_phase<pg8::EpiSwiglu, pg8::ExpertOrder, true, true>(L3, g, S, E); }
            GRID_BAR(); PH_END(8); PH_BEGIN(9);
            if (moe) {
                const int nwg = (rows >> 8) * 4, nfull = (nwg / G) * G, R = nwg - nfull; const int ksn = (R == 0) ? 1 : (R * 4 <= G && R <= 20 ? 4 : (R * 2 <= G && R <= 64 ? 2 : 1));
                const bf16* Wd = p.MWD + (size_t)j * NE * D * DFF; pg8::EpiMoeDown Ed{p.YS, p.HB, (size_t)R * 256 * 1024, (nfull >> 2) * 256};
                { pg8::Gemm gd{p.ACT, Wd, rows, D, DFF, DFF}; pg8::MoeDownOrder Sd{nwg, nfull, G, bx, 0, 0, p.TILE_E}; REP(4) pg8::gemm_phase<pg8::EpiMoeDown, pg8::MoeDownOrder, true, true>(L3, gd, Sd, Ed); }
                if (R > 0) { pg8::Gemm gd{p.ACT, Wd, rows, D, DFF / ksn, DFF}; pg8::MoeDownOrder Sd{nwg, nfull, G, bx, ksn, DFF / ksn, p.TILE_E}; pg8::gemm_phase<pg8::EpiMoeDown, pg8::MoeDownOrder, true, true>(L3, gd, Sd, Ed); }
                if (bx == 0 && mk_tid() == 0) { p.TILE_E[1000] = (nfull >> 2) * 256; p.TILE_E[1001] = ksn; p.TILE_E[1002] = R * 256; }
            } else {
                pg8::Gemm gd{p.ACT, p.DWD + (size_t)j * D * DFF, rows, D, DFF, DFF}; pg8::StaticOrder Sd; Sd.init(rows, D, G, bx);
                REP(4) { pg8::EpiAddH Ed{p.H, D, p.HB2, rss_ptr(p, L, 2)}; pg8::gemm_phase<pg8::EpiAddH, pg8::StaticOrder, true, true>(L3, gd, Sd, Ed); }
            }
        }
        GRID_BAR(); PH_END(9);
        if (moe) { PH_BEGIN(10); fp::norm_phase<2>(p, L, nullptr, bx, G); GRID_BAR(); PH_END(10); }
        PH_BEGIN(11);
        {
            pg8::Gemm g{p.HB2, p.WPG + (size_t)L * D * D, (int)p.T, D, D, D}; pg8::StaticOrder S; S.init((int)p.T, D, G, bx);
            pg8::EpiPleF E{p.H, p.PJ, D, rss_ptr(p, L, 2), p.HB, rss_ptr(p, L + 1, 0)}; pg8::gemm_phase<pg8::EpiPleF, pg8::StaticOrder, true, true>(L3, g, S, E);
        }
        GRID_BAR(); PH_END(11);
    }
    PH_BEGIN(12); fp::norm_phase<3>(p, 0, p.fin_g, bx, G); PH_END(12);
    if (PROBE_T && bx == 0 && tid == 0) { const unsigned long long te_ = __builtin_amdgcn_s_memrealtime() + 4ull * MISC[2]; while (__builtin_amdgcn_s_memrealtime() < te_) __builtin_amdgcn_s_sleep(8); }
}
static void fill_params(MP& p, void* const* d_in, void* d_out, void* d_ws) {
    p.x = (const float*)d_in[0]; p.p = (const float*)d_in[1]; p.pos = (const int*)d_in[2];
    const float** w = &p.attn_g; for (int i = 3; i < 32; ++i) w[i - 3] = (const float*)d_in[i];
    p.out = (float*)d_out; p.B = 8; p.S = 2048; p.T = 16384; p.NSLOT = 2 * 16384 + 8 * 256;
    carve(p, (unsigned char*)d_ws);
}
extern "C" void kernel_launch(void* const* d_in, const int* in_sizes, int n_in, void* d_out, int out_size, void* d_ws, size_t ws_size, hipStream_t stream) {
    static int grid = 0;
    if (grid == 0) {
        MP q{}; q.T = 16384; q.NSLOT = 2 * 16384 + 8 * 256; const size_t need = carve(q, nullptr);
        if (n_in != 32 || ws_size < need) { fprintf(stderr, "kernel_launch: need %zu bytes of ws, have %zu (n_in %d)\n", need, ws_size, n_in); grid = -1; return; }
        int dev = 0, cus = 0, per_cu = 0;
        if (hipGetDevice(&dev) != hipSuccess || hipDeviceGetAttribute(&cus, hipDeviceAttributeMultiprocessorCount, dev) != hipSuccess) { grid = -1; return; }
        if (hipFuncSetAttribute((const void*)mk_fwd, hipFuncAttributeMaxDynamicSharedMemorySize, LDS_BYTES) != hipSuccess) { fprintf(stderr, "kernel_launch: hipFuncSetAttribute failed\n"); grid = -1; return; }
        if (hipOccupancyMaxActiveBlocksPerMultiprocessor(&per_cu, (const void*)mk_fwd, NTHR, LDS_BYTES) != hipSuccess || per_cu < 1) { fprintf(stderr, "kernel_launch: occupancy query says %d\n", per_cu); }
        (void)hipGetLastError();
        grid = cus;
    }
    if (grid < 0) return;
    Args a{}; fill_params(a.p, d_in, d_out, d_ws); a.flags = 0;
    if (hipMemsetAsync(a.p.ctl, 0, CTL_WORDS * 4, stream) != hipSuccess) return;
    hipLaunchKernelGGL(mk_fwd, dim3(grid), dim3(NTHR), LDS_BYTES, stream, a);
}
```

```cpp
#include <hip/hip_runtime.h>
#include <cstdio>
#include <cstdint>
__device__ __forceinline__ int mk_tid() { int t = threadIdx.x; asm volatile("" : "+v"(t)); return t; }
#ifndef PROBE_T
#define PROBE_T 0
#endif
#ifndef PROBE_CK
#define PROBE_CK 0
#endif
constexpr int LDS_BYTES = 163840, LDSCTL_OFF = LDS_BYTES - 512, MISC_OFF = LDSCTL_OFF + 320;
#define TP_MISC(l3) ((volatile __attribute__((address_space(3))) unsigned*)((l3) + MISC_OFF))
#define TP_BEGIN(id, l3) do { if (((PROBE_T >> (id)) & 1) && blockIdx.x == 0 && threadIdx.x == 0) { const unsigned long long t_ = __builtin_amdgcn_s_memrealtime(); TP_MISC(l3)[0] = (unsigned)t_; TP_MISC(l3)[1] = (unsigned)(t_ >> 32); } } while (0)
#define TP_END(id, l3) do { if (((PROBE_T >> (id)) & 1) && blockIdx.x == 0 && threadIdx.x == 0) { const unsigned long long t0_ = ((unsigned long long)TP_MISC(l3)[1] << 32) | TP_MISC(l3)[0]; TP_MISC(l3)[2] += (unsigned)(__builtin_amdgcn_s_memrealtime() - t0_); } } while (0)

#include <cstring>
#include <cmath>
#include <cstdint>
#ifdef __HIPCC__
#define HD __host__ __device__ __forceinline__
#else
#define HD inline
#endif
typedef unsigned short bf16;
namespace mdl {
constexpr int D = 1024, DEPTH = 4, NU = 2560, NUO = 2472, DFF = 3584, NGU = 7168, NE = 8, PLE = 256;
constexpr int CK = 31, SCONV = 4, CHUNK = 128, NH = 8, HP = 64, NS = 128;
constexpr float RMS_EPS = 1e-6f, LN_EPS = 1e-5f;
constexpr float QSCALE = 0.10206207261596577f * 1.4426950408889634f;
constexpr int U_Z = 512, U_XBC = 1024, U_CQ = 2048, U_CKV = 2304, U_KR = 2432, U_DT = 2464;

HD float bf2f(bf16 v) { unsigned u = (unsigned)v << 16; float f; memcpy(&f, &u, 4); return f; }
HD bf16 f2bf(float f) { unsigned u; memcpy(&u, &f, 4); u += 0x7fffu + ((u >> 16) & 1u); return (bf16)(u >> 16); }
HD float sigmoidf_(float x) { return 1.0f / (1.0f + expf(-x)); }
HD float siluf_(float x) { return x / (1.0f + expf(-x)); }
HD float softplusf_(float x) { return x > 20.f ? x : log1pf(expf(x)); }
HD int ucol_src(int n) { return n < 2048 ? n : (n < U_DT ? n + 8 : (n < NUO ? n - U_DT + 2048 : -1)); }

struct MP {
    const float *x, *p; const int* pos;
    const float *attn_g, *w_in, *cdw_w, *cdw_b, *cln_g, *cln_b, *sconv_w, *sconv_b, *dt_bias, *a_log, *dskip, *snorm_g, *qn_g, *w_uq, *kvn_g, *w_ukv,
        *w_out, *ffn_g, *dwg, *dwu, *dwd, *router, *mwg, *mwu, *mwd, *ple_g, *ple_wg, *ple_wp, *fin_g;
    float* out;
    long B, S, T, NSLOT;
    unsigned* ctl;
    bf16 *WIN, *WUQ, *WUKV, *WOUT, *DWGU, *DWD, *MWGU, *MWD, *WPG, *WPP;
    float *RSSP, *H, *CS, *DT, *ACS, *ST, *CB, *YPRE, *TOPG;
    bf16 *HB2, *HB, *U, *YC, *Q, *KK, *V, *XS, *BM, *CM, *YD, *PV, *PB16, *PJ, *ACT, *XB, *YS;
    int *TOPE, *POS, *TOKSLOT, *TILE_E, *BCNT;
};
constexpr int CTL_WORDS = 65536;
HD unsigned* cnt_ptr(const MP& p, int j) { return p.ctl + 1024 + j * 64; }
HD float* rss_ptr(const MP& p, int L, int k) { return p.RSSP + (size_t)(L * 3 + k) * p.T * 16; }

inline size_t carve(MP& p, unsigned char* ws) {
    size_t o = 0; const size_t T = p.T, NSL = p.NSLOT;
    auto take = [&](size_t bytes) { size_t r = o; o += (bytes + 255) & ~(size_t)255; return ws + r; };
    p.ctl = (unsigned*)take(CTL_WORDS * 4);
    p.WIN = (bf16*)take((size_t)DEPTH * NU * D * 2); p.WUQ = (bf16*)take((size_t)DEPTH * 512 * 256 * 2); p.WUKV = (bf16*)take((size_t)DEPTH * 512 * 128 * 2);
    p.WOUT = (bf16*)take((size_t)DEPTH * D * D * 2); p.DWGU = (bf16*)take((size_t)2 * NGU * D * 2); p.DWD = (bf16*)take((size_t)2 * D * DFF * 2);
    p.MWGU = (bf16*)take((size_t)2 * NE * NGU * D * 2); p.MWD = (bf16*)take((size_t)2 * NE * D * DFF * 2);
    p.WPG = (bf16*)take((size_t)DEPTH * D * D * 2); p.WPP = (bf16*)take((size_t)DEPTH * D * PLE * 2);
    p.RSSP = (float*)take((size_t)13 * T * 16 * 4); p.H = (float*)take(T * D * 4); p.HB = (bf16*)take(T * D * 2); p.HB2 = (bf16*)take(T * D * 2); p.CS = (float*)take(T * 32 * 4);
    p.PB16 = (bf16*)take((size_t)DEPTH * T * PLE * 2); p.PJ = (bf16*)take(T * D * 2);
    p.TOPE = (int*)take(T * 2 * 4); p.TOPG = (float*)take(T * 2 * 4); p.POS = (int*)take(T * 2 * 4); p.TOKSLOT = (int*)take(T * 2 * 4); p.TILE_E = (int*)take(1024 * 4); p.BCNT = (int*)take(1024 * NE * 4);
    p.XB = (bf16*)take(NSL * D * 2); p.YS = p.XB;
    const size_t r1 = o;
    p.U = (bf16*)take(T * NU * 2); p.YC = (bf16*)take(T * D * 2); p.Q = (bf16*)take(T * 384 * 2); p.KK = (bf16*)take(T * 384 * 2); p.V = (bf16*)take(T * 256 * 2);
    p.XS = (bf16*)take(T * 512 * 2); p.BM = (bf16*)take(T * 256 * 2); p.CM = (bf16*)take(T * 256 * 2); p.YD = (bf16*)take(T * 512 * 2);
    p.DT = (float*)take(T * 8 * 4); p.ACS = (float*)take(T * 8 * 4); p.ST = (float*)take(T / CHUNK * NH * HP * NS * 4); p.PV = (bf16*)take(T / CHUNK * NH * HP * NS * 2);
    p.CB = nullptr; p.YPRE = nullptr;
    const size_t r1end = o; o = r1;
    p.ACT = (bf16*)take(NSL * DFF * 2);
    if (o < r1end) o = r1end;
    return o;
}

struct V8 { float v[8]; };
HD V8 ld8(const bf16* p) { V8 r; const uint4 u = *(const uint4*)p; const unsigned w[4] = {u.x, u.y, u.z, u.w};
    for (int i = 0; i < 4; ++i) { r.v[2 * i] = bf2f((bf16)(w[i] & 0xffff)); r.v[2 * i + 1] = bf2f((bf16)(w[i] >> 16)); } return r; }
HD float dot8(const V8& a, const V8& b) { float s = 0.f; for (int i = 0; i < 8; ++i) s += a.v[i] * b.v[i]; return s; }

template <class Epi> HD void gemm_nt(const bf16* A, long lda, const bf16* Bt, long ldb, long M, long N, long K, const Epi& epi, long g0, long gs) {
    const long ntn = N / 4, ntile = (M / 4) * ntn;
    for (long t = g0; t < ntile; t += gs) {
        const long m0 = (t / ntn) * 4, n0 = (t % ntn) * 4; float acc[4][4];
        for (int i = 0; i < 4; ++i) for (int j = 0; j < 4; ++j) acc[i][j] = 0.f;
        for (long k = 0; k < K; k += 8) { V8 a0 = ld8(A + (m0 + 0) * lda + k), a1 = ld8(A + (m0 + 1) * lda + k), a2 = ld8(A + (m0 + 2) * lda + k), a3 = ld8(A + (m0 + 3) * lda + k);
            V8 b0 = ld8(Bt + (n0 + 0) * ldb + k), b1 = ld8(Bt + (n0 + 1) * ldb + k), b2 = ld8(Bt + (n0 + 2) * ldb + k), b3 = ld8(Bt + (n0 + 3) * ldb + k);
            acc[0][0] += dot8(a0, b0); acc[0][1] += dot8(a0, b1); acc[0][2] += dot8(a0, b2); acc[0][3] += dot8(a0, b3);
            acc[1][0] += dot8(a1, b0); acc[1][1] += dot8(a1, b1); acc[1][2] += dot8(a1, b2); acc[1][3] += dot8(a1, b3);
            acc[2][0] += dot8(a2, b0); acc[2][1] += dot8(a2, b1); acc[2][2] += dot8(a2, b2); acc[2][3] += dot8(a2, b3);
            acc[3][0] += dot8(a3, b0); acc[3][1] += dot8(a3, b1); acc[3][2] += dot8(a3, b2); acc[3][3] += dot8(a3, b3); }
        epi(m0 + 0, n0 + 0, acc[0][0]); epi(m0 + 0, n0 + 1, acc[0][1]); epi(m0 + 0, n0 + 2, acc[0][2]); epi(m0 + 0, n0 + 3, acc[0][3]);
        epi(m0 + 1, n0 + 0, acc[1][0]); epi(m0 + 1, n0 + 1, acc[1][1]); epi(m0 + 1, n0 + 2, acc[1][2]); epi(m0 + 1, n0 + 3, acc[1][3]);
        epi(m0 + 2, n0 + 0, acc[2][0]); epi(m0 + 2, n0 + 1, acc[2][1]); epi(m0 + 2, n0 + 2, acc[2][2]); epi(m0 + 2, n0 + 3, acc[2][3]);
        epi(m0 + 3, n0 + 0, acc[3][0]); epi(m0 + 3, n0 + 1, acc[3][1]); epi(m0 + 3, n0 + 2, acc[3][2]); epi(m0 + 3, n0 + 3, acc[3][3]);
    }
}
struct EpiStoreBf { bf16* C; long ldc; HD void operator()(long m, long n, float v) const { C[m * ldc + n] = f2bf(v); } };
struct EpiAddF32 { float* C; long ldc; HD void operator()(long m, long n, float v) const { C[m * ldc + n] += v; } };
struct EpiPle { float* H; const bf16* PJ; HD void operator()(long m, long n, float v) const { H[m * D + n] += bf2f(PJ[m * D + n]) * sigmoidf_(v); } };

HD void tr_elem(const float* W, long K, long N, bf16* WT, long i) { const long n = i / K, k = i % K; WT[i] = f2bf(W[k * N + n]); }
HD void nv_prologue(const MP& p, long g0, long gs) {
    const long T = p.T;
    for (long i = g0; i < (long)DEPTH * NU * D; i += gs) { const long l = i / ((long)NU * D), r = i % ((long)NU * D), n = r / D, k = r % D; const int c = ucol_src((int)n);
        p.WIN[i] = c < 0 ? (bf16)0 : f2bf(p.w_in[(l * D + k) * NUO + c]); }
    for (long i = g0; i < (long)DEPTH * 512 * 256; i += gs) { const long l = i / (512 * 256), r = i % (512 * 256), n = r / 256, k = r % 256; p.WUQ[i] = n < 384 ? f2bf(p.w_uq[(l * 256 + k) * 384 + n]) : (bf16)0; }
    for (long i = g0; i < (long)DEPTH * 512 * 128; i += gs) { const long l = i / (512 * 128), r = i % (512 * 128), n = r / 128, k = r % 128; p.WUKV[i] = f2bf(p.w_ukv[(l * 128 + k) * 512 + n]); }
    for (long i = g0; i < (long)DEPTH * D * D; i += gs) { const long l = i / ((long)D * D); tr_elem(p.w_out + l * D * D, D, D, p.WOUT + l * D * D, i % ((long)D * D)); tr_elem(p.ple_wg + l * D * D, D, D, p.WPG + l * D * D, i % ((long)D * D)); }
    for (long i = g0; i < (long)DEPTH * D * PLE; i += gs) { const long l = i / ((long)D * PLE); tr_elem(p.ple_wp + l * PLE * D, PLE, D, p.WPP + l * D * PLE, i % ((long)D * PLE)); }
    for (long i = g0; i < (long)18 * NGU * D; i += gs) { const long mt = i / ((long)NGU * D), r = i % ((long)NGU * D), n = r / D, k = r % D, tl = n / 256, rr = n % 256, col = tl * 128 + (rr & 127);
        const float* src; bf16* dst;
        if (mt < 2) { src = (rr < 128 ? p.dwg : p.dwu) + mt * (long)D * DFF; dst = p.DWGU + mt * (long)NGU * D; } else { src = (rr < 128 ? p.mwg : p.mwu) + (mt - 2) * (long)D * DFF; dst = p.MWGU + (mt - 2) * (long)NGU * D; }
        dst[r] = f2bf(src[k * DFF + col]); }
    for (long i = g0; i < (long)18 * D * DFF; i += gs) { const long mt = i / ((long)D * DFF), r = i % ((long)D * DFF);
        if (mt < 2) tr_elem(p.dwd + mt * (long)DFF * D, DFF, D, p.DWD + mt * (long)D * DFF, r); else tr_elem(p.mwd + (mt - 2) * (long)DFF * D, DFF, D, p.MWD + (mt - 2) * (long)D * DFF, r); }
    for (long i = g0; i < T * D; i += gs) p.H[i] = p.x[i];
    for (long i = g0; i < (long)DEPTH * T * PLE; i += gs) p.PB16[i] = f2bf(p.p[i]);
    for (long i = g0; i < T * 16; i += gs) { const long t = i / 16; const int j = (int)(i % 16); const float inv = powf(10000.0f, -(float)(2 * j) / 32.0f), ang = (float)p.pos[t] * inv;
        p.CS[t * 32 + j] = cosf(ang); p.CS[t * 32 + 16 + j] = sinf(ang); }
}
HD void nv_norm(const MP& p, const float* g, long g0, long gs) {
    for (long t = g0; t < p.T; t += gs) { const float* h = p.H + t * D; float ss = 0.f; for (int i = 0; i < D; ++i) ss += h[i] * h[i];
        const float r = 1.0f / sqrtf(ss / D + RMS_EPS); for (int i = 0; i < D; ++i) p.HB[t * D + i] = f2bf(h[i] * r * g[i]); }
}
HD void nv_inproj(const MP& p, int L, long g0, long gs) {
    gemm_nt(p.HB, D, p.WIN + (long)L * NU * D, D, p.T, NU, D, EpiStoreBf{p.U, NU}, g0, gs);
    gemm_nt(p.PB16 + (long)L * p.T * PLE, PLE, p.WPP + (long)L * D * PLE, PLE, p.T, D, PLE, EpiStoreBf{p.PJ, D}, g0, gs);
}
HD float cm_conv(const MP& p, int L, long b, long s, int c) {
    float acc = p.cdw_b[L * 256 + c];
    for (int j = 0; j < CK; ++j) { const long sp = s - (CK - 1) + j; if (sp < 0) continue; const bf16* u = p.U + (b * p.S + sp) * NU;
        acc += p.cdw_w[(L * CK + j) * 256 + c] * (bf2f(u[c]) * sigmoidf_(bf2f(u[256 + c]))); }
    return acc;
}
HD void nv_mixA1(const MP& p, int L, long g0, long gs, int parts = 15) {
    const long T = p.T, S = p.S;
    if (parts & 1) for (long i = g0; i < T * 4; i += gs) { const long t = i / 4, b = t / S, s = t % S; const int gq = (int)(i % 4);
        float sm = 0.f, sq = 0.f; for (int c = 0; c < 64; ++c) { const float v = cm_conv(p, L, b, s, gq * 64 + c); sm += v; sq += v * v; }
        const float mu = sm / 64.f; float var = sq / 64.f - mu * mu; if (var < 0.f) var = 0.f; const float rs = 1.0f / sqrtf(var + LN_EPS);
        for (int c = 0; c < 64; ++c) { const int ch = gq * 64 + c; const float v = (cm_conv(p, L, b, s, ch) - mu) * rs * p.cln_g[L * 256 + ch] + p.cln_b[L * 256 + ch]; p.YC[t * D + ch] = f2bf(siluf_(v)); } }
    if (parts & 2) for (long i = g0; i < T * 1024; i += gs) { const long t = i / 1024, b = t / S, s = t % S; const int c = (int)(i % 1024);
        float acc = p.sconv_b[L * 1024 + c]; for (int j = 0; j < SCONV; ++j) { const long sp = s - (SCONV - 1) + j; if (sp < 0) continue; acc += p.sconv_w[(L * SCONV + j) * 1024 + c] * bf2f(p.U[(b * S + sp) * NU + U_XBC + c]); }
        const bf16 v = f2bf(siluf_(acc)); if (c < 512) p.XS[t * 512 + c] = v; else if (c < 768) p.BM[t * 256 + c - 512] = v; else p.CM[t * 256 + c - 768] = v; }
    if (parts & 2) for (long i = g0; i < T * 8; i += gs) { const long t = i / 8; const int h = (int)(i % 8); p.DT[i] = softplusf_(bf2f(p.U[t * NU + U_DT + h]) + p.dt_bias[L * 8 + h]); }
    if (parts & 8) for (long i = g0; i < T * 4 * 80; i += gs) { const long t = i / 320; const int h = (int)((i % 320) / 80), ii = (int)(i % 80); const bf16* cq = p.U + t * NU + U_CQ;
        float ss = 0.f; for (int k = 0; k < 256; ++k) { const float v = bf2f(cq[k]); ss += v * v; } const float r = 1.0f / sqrtf(ss / 256.f + RMS_EPS);
        const bf16* W = p.WUQ + (long)L * 512 * 256;
        if (ii < 64) { const int n = h * 96 + ii; float a = 0.f; for (int k = 0; k < 256; ++k) a += bf2f(f2bf(bf2f(cq[k]) * r * p.qn_g[L * 256 + k])) * bf2f(W[n * 256 + k]); p.Q[t * 384 + n] = f2bf(a * QSCALE); }
        else { const int j = ii - 64, n1 = h * 96 + 64 + j, n2 = n1 + 16; float a1 = 0.f, a2 = 0.f;
            for (int k = 0; k < 256; ++k) { const float xv = bf2f(f2bf(bf2f(cq[k]) * r * p.qn_g[L * 256 + k])); a1 += xv * bf2f(W[n1 * 256 + k]); a2 += xv * bf2f(W[n2 * 256 + k]); }
            const float c = p.CS[t * 32 + j], sn = p.CS[t * 32 + 16 + j]; p.Q[t * 384 + n1] = f2bf((a1 * c - a2 * sn) * QSCALE); p.Q[t * 384 + n2] = f2bf((a1 * sn + a2 * c) * QSCALE); } }
    if (parts & 8) for (long i = g0; i < T * 512; i += gs) { const long t = i / 512; const int n = (int)(i % 512); const bf16* ck = p.U + t * NU + U_CKV;
        float ss = 0.f; for (int k = 0; k < 128; ++k) { const float v = bf2f(ck[k]); ss += v * v; } const float r = 1.0f / sqrtf(ss / 128.f + RMS_EPS);
        const bf16* W = p.WUKV + (long)L * 512 * 128; float a = 0.f; for (int k = 0; k < 128; ++k) a += bf2f(f2bf(bf2f(ck[k]) * r * p.kvn_g[L * 128 + k])) * bf2f(W[n * 128 + k]);
        const int h = n / 128, d = n % 128; if (d < 64) p.KK[t * 384 + h * 96 + d] = f2bf(a); else p.V[t * 256 + h * 64 + d - 64] = f2bf(a); }
    if (parts & 8) for (long i = g0; i < T * 16; i += gs) { const long t = i / 16; const int j = (int)(i % 16); const float x1 = bf2f(p.U[t * NU + U_KR + j]), x2 = bf2f(p.U[t * NU + U_KR + 16 + j]), c = p.CS[t * 32 + j], sn = p.CS[t * 32 + 16 + j];
        const bf16 o1 = f2bf(x1 * c - x2 * sn), o2 = f2bf(x1 * sn + x2 * c); for (int h = 0; h < 4; ++h) { p.KK[t * 384 + h * 96 + 64 + j] = o1; p.KK[t * 384 + h * 96 + 80 + j] = o2; } }
}
HD void nv_mixA2(const MP& p, int L, long g0, long gs) {
    const long NC = p.T / CHUNK;
    for (long i = g0; i < NC * 8; i += gs) { const long c = i / 8; const int h = (int)(i % 8); const float a = -expf(p.a_log[L * 8 + h]); float cs = 0.f;
        for (int l = 0; l < CHUNK; ++l) { const long t = c * CHUNK + l; cs += p.DT[t * 8 + h] * a; p.ACS[t * 8 + h] = cs; } }
}
HD void nv_mixA3a(const MP& p, long g0, long gs) {
    const long NC = p.T / CHUNK;
    for (long i = g0; i < NC * 2 * CHUNK * CHUNK; i += gs) { const long u = i / (CHUNK * CHUNK), c = u / 2; const int g = (int)(u % 2), l = (int)((i / CHUNK) % CHUNK), s = (int)(i % CHUNK);
        const bf16* cm = p.CM + (c * CHUNK + l) * 256 + g * 128; const bf16* bm = p.BM + (c * CHUNK + s) * 256 + g * 128; float a = 0.f; for (int n = 0; n < 128; ++n) a += bf2f(cm[n]) * bf2f(bm[n]); p.CB[i] = a; }
}
HD void nv_mixA3b(const MP& p, long g0, long gs) {
    const long T = p.T, NC = T / CHUNK;
    for (long i = g0; i < T * 512; i += gs) { const long t = i / 512, c = t / CHUNK; const int ch = (int)(i % 512), h = ch / 64, g = h / 4, l = (int)(t % CHUNK);
        const float* cb = p.CB + ((c * 2 + g) * CHUNK + l) * CHUNK; const float al = p.ACS[t * 8 + h]; float a = 0.f;
        for (int s = 0; s <= l; ++s) { const long ts = c * CHUNK + s; a += cb[s] * expf(al - p.ACS[ts * 8 + h]) * p.DT[ts * 8 + h] * bf2f(p.XS[ts * 512 + ch]); }
        p.YD[i] = f2bf(a); }
    for (long i = g0; i < NC * 8 * 64 * 128; i += gs) { const long c = i / (8 * 64 * 128); const int h = (int)((i / (64 * 128)) % 8), pp = (int)((i / 128) % 64), n = (int)(i % 128), g = h / 4;
        const float alast = p.ACS[(c * CHUNK + CHUNK - 1) * 8 + h]; float a = 0.f;
        for (int l = 0; l < CHUNK; ++l) { const long t = c * CHUNK + l; a += bf2f(p.BM[t * 256 + g * 128 + n]) * expf(alast - p.ACS[t * 8 + h]) * p.DT[t * 8 + h] * bf2f(p.XS[t * 512 + h * 64 + pp]); }
        p.ST[i] = a; }
}
HD void nv_mixB1(const MP& p, long g0, long gs) {
    const long NCB = p.S / CHUNK;
    for (long i = g0; i < p.B * 8 * 64 * 128; i += gs) { const long b = i / (8 * 64 * 128); const long r = i % (8 * 64 * 128); const int h = (int)(r / (64 * 128)); float carry = 0.f;
        for (long cc = 0; cc < NCB; ++cc) { const long c = b * NCB + cc; const long idx = c * (8 * 64 * 128) + r; p.PV[idx] = f2bf(carry); carry = carry * expf(p.ACS[(c * CHUNK + CHUNK - 1) * 8 + h]) + p.ST[idx]; } }
}
HD void nv_attn(const MP& p, long g0, long gs) {
    const long T = p.T, S = p.S;
    for (long i = g0; i < T * 4; i += gs) { const long t = i / 4, b = t / S, s = t % S; const int h = (int)(i % 4);
        float q[96], o[64]; for (int d = 0; d < 96; ++d) q[d] = bf2f(p.Q[t * 384 + h * 96 + d]); for (int d = 0; d < 64; ++d) o[d] = 0.f; float m = -1e30f, l = 0.f;
        for (long k = 0; k <= s; ++k) { const long tk = b * S + k; const bf16* kk = p.KK + tk * 384 + h * 96; float sc = 0.f; for (int d = 0; d < 96; ++d) sc += q[d] * bf2f(kk[d]);
            const float mn = sc > m ? sc : m, f = exp2f(m - mn), pr = exp2f(sc - mn); l = l * f + pr; const bf16* vv = p.V + tk * 256 + h * 64; for (int d = 0; d < 64; ++d) o[d] = o[d] * f + pr * bf2f(vv[d]); m = mn; }
        for (int d = 0; d < 64; ++d) p.YC[t * D + 768 + h * 64 + d] = f2bf(o[d] / l); }
}
HD void nv_mixC1(const MP& p, int L, long g0, long gs) {
    const long T = p.T;
    for (long i = g0; i < T * 512; i += gs) { const long t = i / 512, c = t / CHUNK; const int ch = (int)(i % 512), h = ch / 64, pp = ch % 64, g = h / 4;
        const bf16* cm = p.CM + t * 256 + g * 128; const bf16* pv = p.PV + ((c * 8 + h) * 64 + pp) * 128; float a = 0.f; for (int n = 0; n < 128; ++n) a += bf2f(cm[n]) * bf2f(pv[n]);
        const float y = a * expf(p.ACS[t * 8 + h]) + bf2f(p.YD[i]) + p.dskip[L * 8 + h] * bf2f(p.XS[i]); p.YPRE[i] = y * siluf_(bf2f(p.U[t * NU + U_Z + ch])); }
}
HD void nv_mixC2(const MP& p, int L, long g0, long gs) {
    for (long i = g0; i < p.T * 2; i += gs) { const long t = i / 2; const int g = (int)(i % 2); const float* y = p.YPRE + t * 512 + g * 256; float ss = 0.f; for (int k = 0; k < 256; ++k) ss += y[k] * y[k];
        const float r = 1.0f / sqrtf(ss / 256.f + RMS_EPS); for (int k = 0; k < 256; ++k) p.YC[t * D + 256 + g * 256 + k] = f2bf(y[k] * r * p.snorm_g[L * 512 + g * 256 + k]); }
}
HD void nv_outproj(const MP& p, int L, long g0, long gs) { gemm_nt(p.YC, D, p.WOUT + (long)L * D * D, D, p.T, D, D, EpiAddF32{p.H, D}, g0, gs); }
HD void nv_router(const MP& p, int L, long g0, long gs) {
    const int j = L / 2; const float* R = p.router + (long)j * D * NE; const float* g = p.ffn_g + L * D; unsigned* cnt = cnt_ptr(p, j);
    for (long t = g0; t < p.T; t += gs) { const float* h = p.H + t * D; float ss = 0.f; for (int i = 0; i < D; ++i) ss += h[i] * h[i]; const float r = 1.0f / sqrtf(ss / D + RMS_EPS);
        float lg[NE]; for (int e = 0; e < NE; ++e) lg[e] = 0.f; for (int i = 0; i < D; ++i) { const float v = h[i] * r * g[i]; for (int e = 0; e < NE; ++e) lg[e] += v * R[i * NE + e]; }
        int e0 = 0; float v0 = lg[0]; for (int e = 1; e < NE; ++e) if (lg[e] > v0) { v0 = lg[e]; e0 = e; }
        int e1 = -1; float v1 = -3.0e38f; for (int e = 0; e < NE; ++e) if (e != e0 && lg[e] > v1) { v1 = lg[e]; e1 = e; }
        const float g1 = 1.0f / (1.0f + expf(v0 - v1)), gg0 = 1.0f - g1; p.TOPE[t * 2] = e0; p.TOPE[t * 2 + 1] = e1; p.TOPG[t * 2] = gg0; p.TOPG[t * 2 + 1] = g1;
#ifdef __HIP_DEVICE_COMPILE__
        p.POS[t * 2] = (int)atomicAdd(cnt + e0, 1u); p.POS[t * 2 + 1] = (int)atomicAdd(cnt + e1, 1u);
#else
        p.POS[t * 2] = (int)__atomic_fetch_add(cnt + e0, 1u, __ATOMIC_RELAXED); p.POS[t * 2 + 1] = (int)__atomic_fetch_add(cnt + e1, 1u, __ATOMIC_RELAXED);
#endif
    }
}
HD int moe_start_of(const MP& p, int j, int E) { const unsigned* cnt = cnt_ptr(p, j); int o = 0; for (int e = 0; e < NE; ++e) if (e < E) o += (int)((cnt[e] + 255u) / 256u) * 256; return o; }
HD void nv_moeplan(const MP& p, int L, long g0, long gs) {
    const int j = L / 2;
    for (long i = g0; i < p.T * 2; i += gs) { const long t = i / 2; const int slot = moe_start_of(p, j, p.TOPE[i]) + p.POS[i]; p.TOKSLOT[i] = slot; for (int k = 0; k < D; ++k) p.XB[(long)slot * D + k] = p.HB[t * D + k]; }
    for (long i = g0; i < 1024; i += gs) { int e = -1; if (i * 256 < moe_start_of(p, j, NE)) { e = 0; for (int q = 1; q < NE; ++q) if (i * 256 >= moe_start_of(p, j, q)) e = q; } p.TILE_E[i] = e; }
}
HD void nv_gateup(const MP& p, int L, long g0, long gs) {
    const int j = L / 2; const bool moe = L & 1; long rows = p.T; const bf16* Ain = p.HB;
    if (moe) { rows = moe_start_of(p, j, NE); Ain = p.XB; }
    for (long i = g0; i < (rows / 4) * DFF; i += gs) { const long m0 = (i / DFF) * 4; const int jj = (int)(i % DFF); const int e = moe ? p.TILE_E[m0 / 256] : 0;
        const bf16* W = moe ? p.MWGU + ((long)j * NE + e) * NGU * D : p.DWGU + (long)j * NGU * D; const long rg = (jj / 128) * 256 + (jj % 128), ru = rg + 128; float ag[4] = {0, 0, 0, 0}, au[4] = {0, 0, 0, 0};
        for (int k = 0; k < D; k += 8) { const V8 wg = ld8(W + rg * D + k), wu = ld8(W + ru * D + k); for (int r = 0; r < 4; ++r) { const V8 a = ld8(Ain + (m0 + r) * D + k); ag[r] += dot8(a, wg); au[r] += dot8(a, wu); } }
        for (int r = 0; r < 4; ++r) p.ACT[(m0 + r) * DFF + jj] = f2bf(siluf_(ag[r]) * au[r]); }
}
struct EpiYs { bf16* C; HD void operator()(long m, long n, float v) const { C[m * D + n] = f2bf(v); } };
HD void nv_down(const MP& p, int L, long g0, long gs) {
    const int j = L / 2;
    if (!(L & 1)) { gemm_nt(p.ACT, DFF, p.DWD + (long)j * D * DFF, DFF, p.T, D, DFF, EpiAddF32{p.H, D}, g0, gs); return; }
    const long rows = moe_start_of(p, j, NE);
    for (long tl = 0; tl < rows / 256; ++tl) { const int e = p.TILE_E[tl]; gemm_nt(p.ACT + tl * 256 * DFF, DFF, p.MWD + ((long)j * NE + e) * D * DFF, DFF, 256, D, DFF, EpiYs{p.YS + tl * 256 * D}, g0, gs); }
}
HD void nv_norm3(const MP& p, int L, long g0, long gs) {
    const float* g = p.ple_g + L * D;
    for (long t = g0; t < p.T; t += gs) { float* h = p.H + t * D;
        if (L & 1) { const bf16* y0 = p.YS + (long)p.TOKSLOT[t * 2] * D; const bf16* y1 = p.YS + (long)p.TOKSLOT[t * 2 + 1] * D; const float a = p.TOPG[t * 2], b = p.TOPG[t * 2 + 1]; for (int i = 0; i < D; ++i) h[i] += a * bf2f(y0[i]) + b * bf2f(y1[i]); }
        float ss = 0.f; for (int i = 0; i < D; ++i) ss += h[i] * h[i]; const float r = 1.0f / sqrtf(ss / D + RMS_EPS); for (int i = 0; i < D; ++i) p.HB[t * D + i] = f2bf(h[i] * r * g[i]); }
}
HD void nv_ple(const MP& p, int L, long g0, long gs) { gemm_nt(p.HB, D, p.WPG + (long)L * D * D, D, p.T, D, D, EpiPle{p.H, p.PJ}, g0, gs); }
HD void nv_final(const MP& p, long g0, long gs) {
    for (long t = g0; t < p.T; t += gs) { const float* h = p.H + t * D; float ss = 0.f; for (int i = 0; i < D; ++i) ss += h[i] * h[i]; const float r = 1.0f / sqrtf(ss / D + RMS_EPS); for (int i = 0; i < D; ++i) p.out[t * D + i] = h[i] * r * p.fin_g[i]; }
}
enum { NV_PROLOGUE = 0, NV_NORM1, NV_INPROJ, NV_A1, NV_A2, NV_A3A, NV_A3B, NV_B1, NV_ATTN, NV_C1, NV_C2, NV_OUTPROJ, NV_NORM2, NV_ROUTER, NV_MOEPLAN, NV_GATEUP, NV_DOWN, NV_NORM3, NV_PLE, NV_FINAL, NV_NPH };
HD void nv_run(const MP& p, int ph, int L, long g0, long gs) {
    switch (ph) {
    case NV_PROLOGUE: nv_prologue(p, g0, gs); break; case NV_NORM1: nv_norm(p, p.attn_g + L * D, g0, gs); break; case NV_INPROJ: nv_inproj(p, L, g0, gs); break;
    case NV_A1: nv_mixA1(p, L, g0, gs); break; case NV_A2: nv_mixA2(p, L, g0, gs); break; case NV_A3A: nv_mixA3a(p, g0, gs); break; case NV_A3B: nv_mixA3b(p, g0, gs); break;
    case NV_B1: nv_mixB1(p, g0, gs); break; case NV_ATTN: nv_attn(p, g0, gs); break; case NV_C1: nv_mixC1(p, L, g0, gs); break; case NV_C2: nv_mixC2(p, L, g0, gs); break;
    case NV_OUTPROJ: nv_outproj(p, L, g0, gs); break; case NV_NORM2: nv_norm(p, p.ffn_g + L * D, g0, gs); break; case NV_ROUTER: if (L & 1) nv_router(p, L, g0, gs); break;
    case NV_MOEPLAN: if (L & 1) nv_moeplan(p, L, g0, gs); break; case NV_GATEUP: nv_gateup(p, L, g0, gs); break; case NV_DOWN: nv_down(p, L, g0, gs); break;
    case NV_NORM3: nv_norm3(p, L, g0, gs); break; case NV_PLE: nv_ple(p, L, g0, gs); break; case NV_FINAL: nv_final(p, g0, gs); break; }
}
}

namespace pg8 {
#define PG8_LAS __attribute__((address_space(3)))
typedef unsigned short bf16_t;
typedef short bf16x8 __attribute__((ext_vector_type(8)));
typedef float f32x4 __attribute__((ext_vector_type(4)));
typedef unsigned u32x4 __attribute__((ext_vector_type(4)));
constexpr int BM = 256, BK = 64, HALF = 128, HTB = HALF * BK * 2  , STAGE_BYTES = 8 * HTB, NXCD = 8, WGM = 8;

__host__ __device__ __forceinline__ int lds_byte(int r, int c) { const int st = (r >> 4) * 2 + (c >> 5), rr = r & 15, cc = c & 31, ob = rr * 64 + cc * 2; return st * 1024 + (ob ^ (((ob >> 9) & 1) << 5)); }
__host__ __device__ __forceinline__ void stage_rc(int b, int& R, int& C) { const int st = b / 1024, sb = b % 1024, swz = sb ^ (((sb >> 9) & 1) << 5); R = (st >> 1) * 16 + swz / 64; C = (st & 1) * 32 + (swz % 64) / 2; }
__host__ __device__ __forceinline__ int perm32(int rho) { const int n = rho >> 4, i = rho & 15; return 8 * (i >> 2) + 4 * n + (i & 3); }

struct Unit { int pm, pn, cn, koff, ks, ui; };
struct Gemm { const bf16_t* A; const bf16_t* Bt; int M, N, K, ld; };

struct StaticOrder {
    int nM, nN, nwg, G, c;
    __host__ __device__ void init(int M, int N, int G_, int c_) { nM = M / BM; nN = N / BM; nwg = nM * nN; G = G_; c = c_; }
    __host__ __device__ bool next(int i, Unit& u) const {
        const int L = i * G + c; if (L >= nwg) return false;
        int wgid = L; { const int q = nwg / NXCD, r = nwg % NXCD, xcd = wgid % NXCD, off = wgid / NXCD; wgid = (xcd < r ? xcd * (q + 1) : r * (q + 1) + (xcd - r) * q) + off; }
        const int nig = WGM * nN, gid = wgid / nig, fm = gid * WGM, gsz = (nM - fm) < WGM ? (nM - fm) : WGM;
        u.pm = fm + ((wgid % nig) % gsz); u.pn = (wgid % nig) / gsz; u.cn = u.pn; u.koff = 0; u.ks = 0; u.ui = i; return true;
    }
    __device__ __forceinline__ void a_ready(const Unit&) const {}
    __device__ __forceinline__ void done(const Unit&) const {}
};
__device__ __forceinline__ unsigned cvt_pk_bf16(float lo, float hi) { unsigned r; asm volatile("v_cvt_pk_bf16_f32 %0, %1, %2" : "=v"(r) : "v"(lo), "v"(hi)); return r; }
typedef float f32x2 __attribute__((ext_vector_type(2)));
template <class Epi, class Sched, bool ALIGN_EPI = false, bool SP2 = false>
__device__ __forceinline__ void gemm_phase(PG8_LAS unsigned char* lds, const Gemm g, const Sched& S, const Epi& E) {
    if (Epi::TAG == PROBE_CK) TP_BEGIN(27, lds);
    const int tid = mk_tid(), wid = __builtin_amdgcn_readfirstlane(tid >> 6), lane = tid & 63, wr = wid >> 2, wc = wid & 3, fr = lane & 15, fq = lane >> 4;
    const int K = g.ld, nt = g.K / BK;
    unsigned voffA[2], voffB[2];
#pragma unroll
    for (int i = 0; i < 2; ++i) { int R, C; stage_rc(tid * 16 + i * 8192, R, C); const int Rb = Epi::PERM ? ((R & ~31) + perm32(R & 31)) : R;
        voffA[i] = (unsigned)(R * K + C) * 2u; voffB[i] = (unsigned)(Rb * K + C) * 2u; }
    const size_t kstep = (size_t)(BK * 2);
    const size_t hstep = (size_t)HALF * K * 2;
    const size_t tstep = 2 * hstep;
    const unsigned ldsw = (unsigned)wid * 1024u;
    const int aoff = lds_byte(wr * 64 + fr, fq * 8), boff = lds_byte(wc * 32 + fr, fq * 8);
#define PG8_SA(b, h) (((b) * 2 + (h)) * HTB)
#define PG8_SB(b, h) ((4 + (b) * 2 + (h)) * HTB)
#define PG8_STAGE(bufoff, gbase, voff) do { _Pragma("unroll") for (int _i = 0; _i < 2; ++_i) \
        __builtin_amdgcn_global_load_lds((const unsigned*)((const char*)(gbase) + (voff)[_i]), (PG8_LAS unsigned*)(lds + (bufoff) + ldsw + _i * 8192), 16, 0, 0); } while (0)
#define PG8_LDA(dst, b, h) do { _Pragma("unroll") for (int m = 0; m < 4; ++m) _Pragma("unroll") for (int k = 0; k < 2; ++k) dst[m][k] = *(const PG8_LAS bf16x8*)(lds + PG8_SA(b, h) + aoff + m * 2048 + k * 1024); } while (0)
#define PG8_LDB(dst, b, h) do { _Pragma("unroll") for (int n = 0; n < 2; ++n) _Pragma("unroll") for (int k = 0; k < 2; ++k) dst[n][k] = *(const PG8_LAS bf16x8*)(lds + PG8_SB(b, h) + boff + n * 2048 + k * 1024); } while (0)
#define PG8_MMA(ai, bj, At, Bt) do { __builtin_amdgcn_s_setprio(1); _Pragma("unroll") for (int m = 0; m < 4; ++m) _Pragma("unroll") for (int n = 0; n < 2; ++n) _Pragma("unroll") for (int k = 0; k < 2; ++k) \
        acc[ai][bj][m][n] = __builtin_amdgcn_mfma_f32_16x16x32_bf16(Bt[n][k], At[m][k], acc[ai][bj][m][n], 0, 0, 0); __builtin_amdgcn_s_setprio(0); } while (0)
#define PG8_WAIT_V(n) asm volatile("s_waitcnt vmcnt(" #n ")" ::: "memory")
#define PG8_WAIT_L(n) asm volatile("s_waitcnt lgkmcnt(" #n ")" ::: "memory")
#define PG8_BAR __builtin_amdgcn_s_barrier()
#define PG8_SCHED __builtin_amdgcn_sched_barrier(0)
    Unit cur, nxt; int ui = 0;
    if (!S.next(0, cur)) return;
    f32x4 acc[2][2][4][2];
#pragma unroll
    for (int a = 0; a < 2; ++a)
#pragma unroll
        for (int b = 0; b < 2; ++b)
#pragma unroll
            for (int m = 0; m < 4; ++m)
#pragma unroll
                for (int n = 0; n < 2; ++n) acc[a][b][m][n] = (f32x4){0.f, 0.f, 0.f, 0.f};
    bf16x8 At[4][2], B0[2][2], B1[2][2];
    const char* cA = (const char*)g.A + (size_t)cur.pm * tstep + (size_t)cur.koff * 2; const char* cB = (const char*)g.Bt + (size_t)cur.pn * tstep + (size_t)cur.koff * 2;
    S.a_ready(cur);
    if constexpr (SP2) {
        PG8_STAGE(PG8_SB(0, 0), cB, voffB); PG8_STAGE(PG8_SB(0, 1), cB + hstep, voffB); PG8_STAGE(PG8_SA(0, 0), cA, voffA); PG8_STAGE(PG8_SA(0, 1), cA + hstep, voffA);
        if (wr == 1) PG8_BAR;
        PG8_WAIT_V(2); PG8_BAR;
        PG8_STAGE(PG8_SB(1, 0), cB + kstep, voffB); PG8_STAGE(PG8_SA(1, 0), cA + kstep, voffA); PG8_STAGE(PG8_SB(1, 1), cB + hstep + kstep, voffB);
        PG8_WAIT_V(6); PG8_BAR;
    } else {
        PG8_STAGE(PG8_SB(0, 0), cB, voffB); PG8_STAGE(PG8_SA(0, 0), cA, voffA); PG8_STAGE(PG8_SB(0, 1), cB + hstep, voffB); PG8_STAGE(PG8_SA(0, 1), cA + hstep, voffA);
        if (wr == 1) PG8_BAR;
        PG8_WAIT_V(4); PG8_BAR;
        PG8_STAGE(PG8_SB(1, 0), cB + kstep, voffB); PG8_STAGE(PG8_SA(1, 0), cA + kstep, voffA); PG8_STAGE(PG8_SB(1, 1), cB + hstep + kstep, voffB);
        PG8_WAIT_V(6); PG8_BAR;
    }
    for (;;) {
        const bool has_next = S.next(ui + 1, nxt);
        const char* nA = has_next ? (const char*)g.A + (size_t)nxt.pm * tstep + (size_t)nxt.koff * 2 : cA; const char* nB = has_next ? (const char*)g.Bt + (size_t)nxt.pn * tstep + (size_t)nxt.koff * 2 : cB;
#pragma unroll 1
        for (int t = 0; t < nt; t += 2) {
            const bool last = (t == nt - 2);
            const char* a1 = cA + (size_t)(t + 1) * kstep;
            const char* a2 = last ? nA : cA + (size_t)(t + 2) * kstep; const char* b2 = last ? nB : cB + (size_t)(t + 2) * kstep;
            const char* a3 = a2 + kstep; const char* b3 = b2 + kstep;
            if (last && has_next) S.a_ready(nxt);
            if constexpr (SP2) {
            PG8_LDB(B0, 0, 0); PG8_LDB(B1, 0, 1); PG8_SCHED; PG8_LDA(At, 0, 0); PG8_STAGE(PG8_SA(1, 1), a1 + hstep, voffA);
            PG8_WAIT_V(8); PG8_WAIT_L(0); PG8_BAR; PG8_MMA(0, 0, At, B0); PG8_MMA(0, 1, At, B1); PG8_BAR; PG8_SCHED;
            PG8_LDA(At, 0, 1); PG8_STAGE(PG8_SB(0, 0), b2, voffB); PG8_STAGE(PG8_SB(0, 1), b2 + hstep, voffB); PG8_STAGE(PG8_SA(0, 0), a2, voffA);
            PG8_WAIT_V(8); PG8_WAIT_L(0); PG8_BAR; PG8_MMA(1, 0, At, B0); PG8_MMA(1, 1, At, B1); PG8_BAR; PG8_SCHED;
            PG8_LDB(B0, 1, 0); PG8_LDB(B1, 1, 1); PG8_SCHED; PG8_LDA(At, 1, 0); PG8_STAGE(PG8_SA(0, 1), a2 + hstep, voffA);
            PG8_WAIT_V(8); PG8_WAIT_L(0); PG8_BAR; PG8_MMA(0, 0, At, B0); PG8_MMA(0, 1, At, B1); PG8_BAR; PG8_SCHED;
            PG8_LDA(At, 1, 1); PG8_STAGE(PG8_SB(1, 0), b3, voffB); PG8_STAGE(PG8_SB(1, 1), b3 + hstep, voffB); PG8_STAGE(PG8_SA(1, 0), a3, voffA);
            PG8_WAIT_V(8); PG8_WAIT_L(0); PG8_BAR; PG8_MMA(1, 0, At, B0); PG8_MMA(1, 1, At, B1); PG8_BAR; PG8_SCHED;
            } else {
            PG8_LDB(B0, 0, 0); PG8_SCHED; PG8_LDA(At, 0, 0); PG8_STAGE(PG8_SA(1, 1), a1 + hstep, voffA);
            PG8_WAIT_L(8); PG8_BAR; PG8_WAIT_L(0); PG8_MMA(0, 0, At, B0); PG8_BAR; PG8_SCHED;
            PG8_LDB(B1, 0, 1); PG8_STAGE(PG8_SB(0, 0), b2, voffB);
            PG8_BAR; PG8_WAIT_L(0); PG8_MMA(0, 1, At, B1); PG8_BAR;
            PG8_LDA(At, 0, 1); PG8_STAGE(PG8_SA(0, 0), a2, voffA);
            PG8_BAR; PG8_WAIT_L(0); PG8_MMA(1, 0, At, B0); PG8_BAR; PG8_SCHED;
            PG8_STAGE(PG8_SB(0, 1), b2 + hstep, voffB);
            PG8_WAIT_V(6); PG8_BAR; PG8_MMA(1, 1, At, B1); PG8_BAR;
            PG8_LDB(B0, 1, 0); PG8_SCHED; PG8_LDA(At, 1, 0); PG8_STAGE(PG8_SA(0, 1), a2 + hstep, voffA);
            PG8_WAIT_L(8); PG8_BAR; PG8_WAIT_L(0); PG8_MMA(0, 0, At, B0); PG8_BAR; PG8_SCHED;
            PG8_LDB(B1, 1, 1); PG8_STAGE(PG8_SB(1, 0), b3, voffB);
            PG8_BAR; PG8_WAIT_L(0); PG8_MMA(0, 1, At, B1); PG8_BAR;
            PG8_LDA(At, 1, 1); PG8_STAGE(PG8_SA(1, 0), a3, voffA);
            PG8_BAR; PG8_WAIT_L(0); PG8_MMA(1, 0, At, B0); PG8_BAR; PG8_SCHED;
            PG8_STAGE(PG8_SB(1, 1), b3 + hstep, voffB);
            PG8_WAIT_V(6); PG8_BAR; PG8_MMA(1, 1, At, B1); PG8_BAR;
            }
        }
        TP_BEGIN(26, lds); if constexpr (ALIGN_EPI) { if (wr == 0) PG8_BAR; } TP_END(26, lds);
        if (Epi::TAG == PROBE_CK) TP_BEGIN(25, lds); if constexpr (!Epi::AFTER_DRAIN) { E(acc, cur, wr, wc, fr, fq); S.done(cur); } if (((PROBE_T >> 25) & 1) && Epi::TAG == PROBE_CK) { asm volatile("s_waitcnt vmcnt(0)" ::: "memory"); TP_END(25, lds); }
        if (!has_next) break;
#pragma unroll
        for (int a = 0; a < 2; ++a)
#pragma unroll
            for (int b = 0; b < 2; ++b)
#pragma unroll
                for (int m = 0; m < 4; ++m)
#pragma unroll
                    for (int n = 0; n < 2; ++n) acc[a][b][m][n] = (f32x4){0.f, 0.f, 0.f, 0.f};
        cur = nxt; cA = nA; cB = nB; ++ui;
        if constexpr (ALIGN_EPI) { if (wr == 1) PG8_BAR; }
    }
    PG8_WAIT_V(0);
    if constexpr (!ALIGN_EPI) { if (wr == 0) PG8_BAR; }
    PG8_BAR;
    if constexpr (Epi::AFTER_DRAIN) { E.fused(acc, cur, wr, wc, fr, fq, lds, wid, lane); S.done(cur); }
    if (Epi::TAG == PROBE_CK) TP_END(27, lds);
#undef PG8_SA
#undef PG8_SB
#undef PG8_STAGE
#undef PG8_LDA
#undef PG8_LDB
#undef PG8_MMA
#undef PG8_WAIT_V
#undef PG8_WAIT_L
#undef PG8_BAR
#undef PG8_SCHED
}
}

namespace pg8 {
__device__ __forceinline__ float fast_sigmoid(float x) { return __builtin_amdgcn_rcpf(1.0f + __builtin_amdgcn_exp2f(-1.4426950408889634f * x)); }
constexpr int RSTD_TAB_OFF = STAGE_BYTES, RSTD_MAX_UNITS = 8;
template <class Sched> __device__ __forceinline__ void rstd_table(PG8_LAS unsigned char* lds, const float* rss, const Sched& S) {
    PG8_LAS float* tab = (PG8_LAS float*)(lds + RSTD_TAB_OFF); const int tid = mk_tid(), r = tid & 255, par = __builtin_amdgcn_readfirstlane(tid >> 8);
    f32x4 q[4][4]; bool ok[4];
#pragma unroll
    for (int it = 0; it < 4; ++it) { Unit u; const int ui = 2 * it + par; ok[it] = S.next(ui, u);
        if (ok[it]) { const f32x4* src = (const f32x4*)(rss + ((size_t)u.pm * BM + r) * 16);
#pragma unroll
            for (int k = 0; k < 4; ++k) q[it][k] = src[k]; } }
#pragma unroll
    for (int it = 0; it < 4; ++it) if (ok[it]) { const f32x4 a = q[it][0], b = q[it][1], c = q[it][2], d = q[it][3];
        const float s = (((a[0] + a[1]) + (a[2] + a[3])) + ((b[0] + b[1]) + (b[2] + b[3]))) + (((c[0] + c[1]) + (c[2] + c[3])) + ((d[0] + d[1]) + (d[2] + d[3])));
        tab[(2 * it + par) * 256 + r] = 1.0f / sqrtf(s * (1.0f / 1024.f) + 1e-6f); }
    asm volatile("s_waitcnt lgkmcnt(0)" ::: "memory"); __syncthreads();
}
__device__ __forceinline__ void rstd8(const PG8_LAS float* tab, int ui, int rl0, float (&rs)[8]) {
    if (!tab) {
#pragma unroll
        for (int i = 0; i < 8; ++i) rs[i] = 1.0f;
        return; }
#pragma unroll
    for (int i = 0; i < 8; ++i) rs[i] = tab[ui * 256 + rl0 + (i >> 2) * HALF + (i & 3) * 16];
}
struct EpiStore16 {
    static constexpr bool PERM = true, AFTER_DRAIN = false; static constexpr int TAG = 3;
    bf16_t* O; int ldc; const PG8_LAS float* tab;
    __device__ __forceinline__ void operator()(const f32x4 (&acc)[2][2][4][2], const Unit& u, int wr, int wc, int fr, int fq) const {
        const int row0 = u.pm * BM + wr * 64 + fr, col0 = u.cn * BM + wc * 32 + 8 * fq;
        float rs[8]; rstd8(tab, u.ui, wr * 64 + fr, rs);
#pragma unroll
        for (int ai = 0; ai < 2; ++ai)
#pragma unroll
            for (int m = 0; m < 4; ++m) { const int row = row0 + ai * HALF + m * 16; bf16_t* rowp = O + (size_t)row * ldc + col0; const float r = rs[ai * 4 + m];
#pragma unroll
                for (int bj = 0; bj < 2; ++bj) { const f32x4 v0 = acc[ai][bj][m][0] * r, v1 = acc[ai][bj][m][1] * r;
                    u32x4 w; w.x = cvt_pk_bf16(v0[0], v0[1]); w.y = cvt_pk_bf16(v0[2], v0[3]); w.z = cvt_pk_bf16(v1[0], v1[1]); w.w = cvt_pk_bf16(v1[2], v1[3]);
                    *(u32x4*)(rowp + bj * HALF) = w; } }
    }
};
struct EpiAddH {
    static constexpr bool PERM = false, AFTER_DRAIN = false; static constexpr int TAG = 1;
    bf16_t* Hb; int ldc; float* rss_out;
    __device__ __forceinline__ void operator()(const f32x4 (&acc)[2][2][4][2], const Unit& u, int wr, int wc, int fr, int fq) const {
        typedef unsigned u32x2v __attribute__((ext_vector_type(2)));
        const int row0 = u.pm * BM + wr * 64 + fr, col0 = u.cn * BM + wc * 32 + 4 * fq;
        u32x2v h[2][4][2][2];
#pragma unroll
        for (int ai = 0; ai < 2; ++ai)
#pragma unroll
            for (int m = 0; m < 4; ++m) { const size_t off = (size_t)(row0 + ai * HALF + m * 16) * ldc + col0;
#pragma unroll
                for (int bj = 0; bj < 2; ++bj)
#pragma unroll
                    for (int n = 0; n < 2; ++n) h[ai][m][bj][n] = *(const u32x2v*)(Hb + off + bj * HALF + n * 16); }
        __builtin_amdgcn_sched_barrier(0);
#pragma unroll
        for (int ai = 0; ai < 2; ++ai)
#pragma unroll
            for (int m = 0; m < 4; ++m) { const int row = row0 + ai * HALF + m * 16; const size_t off = (size_t)row * ldc + col0; float ss = 0.f;
#pragma unroll
                for (int bj = 0; bj < 2; ++bj)
#pragma unroll
                    for (int n = 0; n < 2; ++n) { const u32x2v q = h[ai][m][bj][n]; const f32x4 a = acc[ai][bj][m][n];
                        u32x2v w; w.x = cvt_pk_bf16(__uint_as_float(q.x << 16) + a[0], __uint_as_float(q.x & 0xffff0000u) + a[1]); w.y = cvt_pk_bf16(__uint_as_float(q.y << 16) + a[2], __uint_as_float(q.y & 0xffff0000u) + a[3]);
                        *(u32x2v*)(Hb + off + bj * HALF + n * 16) = w;
                        const float o0 = __uint_as_float(w.x << 16), o1 = __uint_as_float(w.x & 0xffff0000u), o2 = __uint_as_float(w.y << 16), o3 = __uint_as_float(w.y & 0xffff0000u); ss += (o0 * o0 + o1 * o1) + (o2 * o2 + o3 * o3); }
                ss += __shfl_xor(ss, 16); ss += __shfl_xor(ss, 32);
                if (fq == 0) rss_out[(size_t)row * 16 + u.cn * 4 + wc] = ss; }
    }
};
struct EpiSwiglu {
    static constexpr bool PERM = true, AFTER_DRAIN = false; static constexpr int TAG = 4;
    bf16_t* O; int ldc; const PG8_LAS float* tab;
    __device__ __forceinline__ void operator()(const f32x4 (&acc)[2][2][4][2], const Unit& u, int wr, int wc, int fr, int fq) const {
        const int row0 = u.pm * BM + wr * 64 + fr, col0 = u.cn * HALF + wc * 32 + 8 * fq;
        float rs[8]; rstd8(tab, u.ui, wr * 64 + fr, rs);
#pragma unroll
        for (int ai = 0; ai < 2; ++ai)
#pragma unroll
            for (int m = 0; m < 4; ++m) { const int row = row0 + ai * HALF + m * 16; bf16_t* rowp = O + (size_t)row * ldc + col0; float o[8]; const float r = rs[ai * 4 + m];
#pragma unroll
                for (int n = 0; n < 2; ++n)
#pragma unroll
                    for (int j = 0; j < 4; ++j) { const float gt = acc[ai][0][m][n][j] * r, up = acc[ai][1][m][n][j] * r; o[n * 4 + j] = gt * fast_sigmoid(gt) * up; }
                u32x4 w; w.x = cvt_pk_bf16(o[0], o[1]); w.y = cvt_pk_bf16(o[2], o[3]); w.z = cvt_pk_bf16(o[4], o[5]); w.w = cvt_pk_bf16(o[6], o[7]);
                *(u32x4*)rowp = w; }
    }
};
struct EpiPleF {
    static constexpr bool PERM = false, AFTER_DRAIN = false; static constexpr int TAG = 2;
    const bf16_t* Hin; bf16_t* Hout; const bf16_t* PJ; int ldc; const PG8_LAS float* tab; float* rss_out;
    __device__ __forceinline__ void operator()(const f32x4 (&acc)[2][2][4][2], const Unit& u, int wr, int wc, int fr, int fq) const {
        typedef unsigned u32x2v __attribute__((ext_vector_type(2)));
        const int row0 = u.pm * BM + wr * 64 + fr, col0 = u.cn * BM + wc * 32 + 4 * fq;
        float rs[8]; rstd8(tab, u.ui, wr * 64 + fr, rs);
#pragma unroll
        for (int ai = 0; ai < 2; ++ai) { u32x2v h[4][2][2], pj[4][2][2];
#pragma unroll
            for (int m = 0; m < 4; ++m) { const size_t off = (size_t)(row0 + ai * HALF + m * 16) * ldc + col0;
#pragma unroll
                for (int bj = 0; bj < 2; ++bj)
#pragma unroll
                    for (int n = 0; n < 2; ++n) { h[m][bj][n] = *(const u32x2v*)(Hin + off + bj * HALF + n * 16); pj[m][bj][n] = *(const u32x2v*)(PJ + off + bj * HALF + n * 16); } }
            __builtin_amdgcn_sched_barrier(0);
#pragma unroll
            for (int m = 0; m < 4; ++m) { const int row = row0 + ai * HALF + m * 16; const size_t off = (size_t)row * ldc + col0; const float r = rs[ai * 4 + m]; float ss = 0.f;
#pragma unroll
                for (int bj = 0; bj < 2; ++bj)
#pragma unroll
                    for (int n = 0; n < 2; ++n) { const f32x4 a = acc[ai][bj][m][n] * r; const u32x2v q = pj[m][bj][n], hh = h[m][bj][n];
                        const float o0 = __uint_as_float(hh.x << 16) + __uint_as_float(q.x << 16) * fast_sigmoid(a[0]), o1 = __uint_as_float(hh.x & 0xffff0000u) + __uint_as_float(q.x & 0xffff0000u) * fast_sigmoid(a[1]);
                        const float o2 = __uint_as_float(hh.y << 16) + __uint_as_float(q.y << 16) * fast_sigmoid(a[2]), o3 = __uint_as_float(hh.y & 0xffff0000u) + __uint_as_float(q.y & 0xffff0000u) * fast_sigmoid(a[3]);
                        u32x2v w; w.x = cvt_pk_bf16(o0, o1); w.y = cvt_pk_bf16(o2, o3); *(u32x2v*)(Hout + off + bj * HALF + n * 16) = w;
                        const float p0 = __uint_as_float(w.x << 16), p1 = __uint_as_float(w.x & 0xffff0000u), p2 = __uint_as_float(w.y << 16), p3 = __uint_as_float(w.y & 0xffff0000u); ss += (p0 * p0 + p1 * p1) + (p2 * p2 + p3 * p3); }
                ss += __shfl_xor(ss, 16); ss += __shfl_xor(ss, 32);
                if (fq == 0) rss_out[(size_t)row * 16 + u.cn * 4 + wc] = ss; }
            asm volatile("" ::: "memory"); }
    }
};
struct ExpertOrder : StaticOrder {
    const int* tile_e;
    __device__ __forceinline__ bool next(int i, Unit& u) const { if (!StaticOrder::next(i, u)) return false; if (tile_e) u.pn += tile_e[u.pm] * nN; return true; }
};
struct UpperHalfOrder : StaticOrder {
    __host__ __device__ void init2(int M, int N, int G_, int c_) { init(M, N, G_ / 2, c_ - G_ / 2); if (c_ < G_ / 2) c = nwg; }
};
struct MoeDownOrder {
    int nwg, nfull, G, c, ks_n, kslice; const int* tile_e;
    __device__ __forceinline__ bool next(int i, Unit& u) const {
        const int q = i * G + c; int L;
        if (ks_n == 0) { L = q; if (L >= nfull) return false; u.koff = 0; u.ks = 0; }
        else { if (q >= (nwg - nfull) * ks_n) return false; L = nfull + q / ks_n; u.ks = q % ks_n; u.koff = u.ks * kslice; }
        u.pm = L >> 2; u.cn = L & 3; u.pn = u.cn + tile_e[u.pm] * 4; u.ui = i; return true;
    }
    __device__ __forceinline__ void a_ready(const Unit&) const {}
    __device__ __forceinline__ void done(const Unit&) const {}
};
struct EpiMoeDown {
    static constexpr bool PERM = true, AFTER_DRAIN = false; static constexpr int TAG = 5;
    bf16_t* O; bf16_t* P; size_t pstride; int row0p;
    __device__ __forceinline__ void operator()(const f32x4 (&acc)[2][2][4][2], const Unit& u, int wr, int wc, int fr, int fq) const {
        const int col0 = u.cn * BM + wc * 32 + 8 * fq; const int rowt = u.pm * BM + wr * 64 + fr;
        bf16_t* base = u.ks == 0 ? O + (size_t)rowt * 1024 : P + (size_t)(u.ks - 1) * pstride + (size_t)(rowt - row0p) * 1024;
#pragma unroll
        for (int ai = 0; ai < 2; ++ai)
#pragma unroll
            for (int m = 0; m < 4; ++m) { bf16_t* rowp = base + (size_t)(ai * HALF + m * 16) * 1024 + col0;
#pragma unroll
                for (int bj = 0; bj < 2; ++bj) { const f32x4 v0 = acc[ai][bj][m][0], v1 = acc[ai][bj][m][1];
                    u32x4 w; w.x = cvt_pk_bf16(v0[0], v0[1]); w.y = cvt_pk_bf16(v0[2], v0[3]); w.z = cvt_pk_bf16(v1[0], v1[1]); w.w = cvt_pk_bf16(v1[2], v1[3]);
                    *(u32x4*)(rowp + bj * HALF) = w; } }
    }
};
}

namespace fp {
using namespace mdl;
#define FLAS __attribute__((address_space(3)))
typedef float f32x4 __attribute__((ext_vector_type(4)));
typedef float f32x2 __attribute__((ext_vector_type(2)));
typedef unsigned u32x4 __attribute__((ext_vector_type(4)));
typedef unsigned u32x2 __attribute__((ext_vector_type(2)));
typedef __bf16 bf16x2_t __attribute__((ext_vector_type(2)));
__device__ __forceinline__ unsigned pk2(float lo, float hi) { f32x2 v = {lo, hi}; bf16x2_t b = __builtin_convertvector(v, bf16x2_t); return __builtin_bit_cast(unsigned, b); }
__device__ __forceinline__ float blo(unsigned w) { return __uint_as_float(w << 16); }
__device__ __forceinline__ float bhi(unsigned w) { return __uint_as_float(w & 0xffff0000u); }
__device__ __forceinline__ float wave_sum(float v) {
#pragma unroll
    for (int o = 1; o < 64; o <<= 1) v += __shfl_xor(v, o);
    return v;
}
#define FP_LDS_WAIT() asm volatile("s_waitcnt lgkmcnt(0)" ::: "memory")
template <int ROWS, int ROWB, int PB, int NTHR_> __device__ __forceinline__ void tile_out(const FLAS unsigned char* st, unsigned char* gbase, size_t gpitch, int t) {
    constexpr int CPR = ROWB / 16, N = ROWS * CPR;
#pragma unroll
    for (int i0 = 0; i0 < N; i0 += NTHR_) { const int i = i0 + t; if (N % NTHR_ == 0 || i < N) { const int r = i / CPR, c = i % CPR; *(u32x4*)(gbase + (size_t)r * gpitch + c * 16) = *(const FLAS u32x4*)(st + r * PB + c * 16); } }
}

template <class Map> __device__ __forceinline__ void tr_item(const float* W, int Nsrc, const Map& map, bf16* WT, int K, int k0, int n0, FLAS float* scr, int lane, const float* gain = nullptr) {
    const int nl = lane & 31, c = map(n0 + nl), cc = lane & 7;
    f32x4 g0 = (f32x4){1.f, 1.f, 1.f, 1.f}, g1 = g0;
    if (gain) { g0 = *(const f32x4*)(gain + k0 + 8 * cc); g1 = *(const f32x4*)(gain + k0 + 8 * cc + 4); }
#pragma unroll 8
    for (int i = 0; i < 32; ++i) { const int kk = 2 * i + (lane >> 5); scr[kk * 33 + nl] = c >= 0 ? W[(size_t)(k0 + kk) * Nsrc + c] : 0.f; }
    FP_LDS_WAIT(); asm volatile("" ::: "memory");
#pragma unroll
    for (int j = 0; j < 4; ++j) { const int n = (lane >> 3) + 8 * j; const FLAS float* s = scr + (8 * cc) * 33 + n;
        u32x4 o; o.x = pk2(s[0 * 33] * g0.x, s[1 * 33] * g0.y); o.y = pk2(s[2 * 33] * g0.z, s[3 * 33] * g0.w); o.z = pk2(s[4 * 33] * g1.x, s[5 * 33] * g1.y); o.w = pk2(s[6 * 33] * g1.z, s[7 * 33] * g1.w);
        *(u32x4*)(WT + (size_t)(n0 + n) * K + k0 + 8 * cc) = o; }
    FP_LDS_WAIT(); asm volatile("" ::: "memory");
}
struct MapId { __device__ __forceinline__ int operator()(int n) const { return n; } };
struct MapLt { int lim; __device__ __forceinline__ int operator()(int n) const { return n < lim ? n : -1; } };
struct MapU { __device__ __forceinline__ int operator()(int n) const { return ucol_src(n); } };
struct MapOff { int off; __device__ __forceinline__ int operator()(int n) const { return n + off; } };
__device__ __forceinline__ void prologue(const MP& p, FLAS unsigned char* lds, int bx, int G) {
    const int tid = mk_tid(), lane = tid & 63, wave = __builtin_amdgcn_readfirstlane(tid >> 6);
    FLAS float* scr = (FLAS float*)(lds + wave * 16384);
    const int gw = bx * 8 + wave, NGW = G * 8;
    constexpr int I_WIN = (D / 64) * (NU / 32), I_UQ = 4 * 16, I_UKV = 2 * 16, I_DD = 16 * 32, I_PP = 4 * 32, I_GU = 16 * (NGU / 32), I_DN = (DFF / 64) * 32;
    constexpr int PER_L = I_WIN + I_UQ + I_UKV + 2 * I_DD + I_PP, NITEMS = DEPTH * PER_L + 18 * (I_GU + I_DN);
    for (int it = gw; it < NITEMS; it += NGW) {
        int r = it;
        if (r < DEPTH * PER_L) { const int l = r / PER_L; r %= PER_L;
            if (r < I_WIN) { tr_item(p.w_in + (size_t)l * D * NUO, NUO, MapU{}, p.WIN + (size_t)l * NU * D, D, 64 * (r / (NU / 32)), 32 * (r % (NU / 32)), scr, lane, p.attn_g + l * D); continue; } r -= I_WIN;
            if (r < I_UQ) { tr_item(p.w_uq + (size_t)l * 256 * 384, 384, MapLt{384}, p.WUQ + (size_t)l * 512 * 256, 256, 64 * (r / 16), 32 * (r % 16), scr, lane); continue; } r -= I_UQ;
            if (r < I_UKV) { tr_item(p.w_ukv + (size_t)l * 128 * 512, 512, MapId{}, p.WUKV + (size_t)l * 512 * 128, 128, 64 * (r / 16), 32 * (r % 16), scr, lane); continue; } r -= I_UKV;
            if (r < I_DD) { tr_item(p.w_out + (size_t)l * D * D, D, MapId{}, p.WOUT + (size_t)l * D * D, D, 64 * (r / 32), 32 * (r % 32), scr, lane); continue; } r -= I_DD;
            if (r < I_DD) { tr_item(p.ple_wg + (size_t)l * D * D, D, MapId{}, p.WPG + (size_t)l * D * D, D, 64 * (r / 32), 32 * (r % 32), scr, lane, p.ple_g + l * D); continue; } r -= I_DD;
            tr_item(p.ple_wp + (size_t)l * PLE * D, D, MapId{}, p.WPP + (size_t)l * D * PLE, PLE, 64 * (r / 32), 32 * (r % 32), scr, lane); continue; }
        r -= DEPTH * PER_L;
        if (r < 18 * I_GU) { const int mt = r / I_GU; r %= I_GU; const int k0 = 64 * (r / (NGU / 32)), n0 = 32 * (r % (NGU / 32)); const int tl = n0 / 256, rr = n0 % 256;
            const float* src; bf16* dst;
            if (mt < 2) { src = (rr < 128 ? p.dwg : p.dwu) + (size_t)mt * D * DFF; dst = p.DWGU + (size_t)mt * NGU * D; } else { src = (rr < 128 ? p.mwg : p.mwu) + (size_t)(mt - 2) * D * DFF; dst = p.MWGU + (size_t)(mt - 2) * NGU * D; }
            const int Lg = mt < 2 ? 2 * mt : 2 * ((mt - 2) >> 3) + 1;
            tr_item(src, DFF, MapOff{tl * 128 + (rr & 127) - n0}, dst, D, k0, n0, scr, lane, p.ffn_g + Lg * D); continue; }
        r -= 18 * I_GU;
        { const int mt = r / I_DN; r %= I_DN; const float* src; bf16* dst;
            if (mt < 2) { src = p.dwd + (size_t)mt * DFF * D; dst = p.DWD + (size_t)mt * D * DFF; } else { src = p.mwd + (size_t)(mt - 2) * DFF * D; dst = p.MWD + (size_t)(mt - 2) * D * DFF; }
            tr_item(src, D, MapId{}, dst, DFF, 64 * (r / 32), 32 * (r % 32), scr, lane); }
    }
    const long g0 = (long)bx * 512 + tid, gs = (long)G * 512;
    for (long t = gw; t < p.T; t += NGW) { const f32x4* xr = (const f32x4*)(p.x + t * D) + lane; u32x2* o = (u32x2*)(p.HB + t * D) + lane; float ss = 0.f;
#pragma unroll
        for (int j = 0; j < 4; ++j) { const f32x4 v = xr[64 * j]; u32x2 wv; wv.x = pk2(v.x, v.y); wv.y = pk2(v.z, v.w); o[64 * j] = wv; const float a = blo(wv.x), b = bhi(wv.x), c = blo(wv.y), d = bhi(wv.y); ss += (a * a + b * b) + (c * c + d * d); }
        ss = wave_sum(ss); if (lane < 16) rss_ptr(p, 0, 0)[t * 16 + lane] = lane == 0 ? ss : 0.f; }
    for (long i = g0; i < (long)DEPTH * p.T * PLE / 4; i += gs) { const f32x4 v = ((const f32x4*)p.p)[i]; u32x2 o; o.x = pk2(v.x, v.y); o.y = pk2(v.z, v.w); ((u32x2*)p.PB16)[i] = o; }
    for (long i = g0; i < p.T * 16; i += gs) { const long t = i / 16; const int j = (int)(i % 16); const float inv = powf(10000.0f, -(float)(2 * j) / 32.0f), ang = (float)p.pos[t] * inv;
        p.CS[t * 32 + j] = cosf(ang); p.CS[t * 32 + 16 + j] = sinf(ang); }
}
template <int MODE> __device__ __forceinline__ void norm_phase(const MP& p, int L, const float* g, bf16* hb, int bx, int G, FLAS unsigned* lcnt = nullptr, const bf16* part = nullptr) {
    const int tid = mk_tid(), lane = tid & 63, wave = __builtin_amdgcn_readfirstlane(tid >> 6);
    const int gw = bx * 8 + wave, NGW = G * 8;
    const f32x4* gr = (const f32x4*)g + lane;
    bf16* const HBN = (bf16*)p.H;
    f32x4 Rr[MODE == 1 ? 32 : 1];
    if (MODE == 1) { __syncthreads(); if (tid < NE) lcnt[tid] = 0u; __syncthreads(); const f32x4* R = (const f32x4*)(p.router + (size_t)(L >> 1) * D * NE);
#pragma unroll
        for (int j = 0; j < 4; ++j)
#pragma unroll
            for (int c = 0; c < 4; ++c) { const int idx = 4 * (lane + 64 * j) + c; Rr[(j * 4 + c) * 2] = R[idx * 2]; Rr[(j * 4 + c) * 2 + 1] = R[idx * 2 + 1]; } }
    for (long t = gw; t < p.T; t += NGW) {
        u32x2* hr = (u32x2*)(hb + t * D) + lane; f32x4 v[4];
#pragma unroll
        for (int j = 0; j < 4; ++j) { const u32x2 q = hr[64 * j]; v[j] = (f32x4){blo(q.x), bhi(q.x), blo(q.y), bhi(q.y)}; }
        if (MODE == 2) { const int sl[2] = {p.TOKSLOT[t * 2], p.TOKSLOT[t * 2 + 1]}; const float gt[2] = {p.TOPG[t * 2], p.TOPG[t * 2 + 1]};
            const int row0p = p.TILE_E[1000], ksn = p.TILE_E[1001]; const size_t pstride = (size_t)p.TILE_E[1002] * D;
#pragma unroll
            for (int k = 0; k < 2; ++k) { const u32x2* y0 = (const u32x2*)(p.YS + (size_t)sl[k] * D) + lane; u32x2 q[4];
#pragma unroll
                for (int j = 0; j < 4; ++j) q[j] = y0[64 * j];
                float acc[4][4];
#pragma unroll
                for (int j = 0; j < 4; ++j) { acc[j][0] = blo(q[j].x); acc[j][1] = bhi(q[j].x); acc[j][2] = blo(q[j].y); acc[j][3] = bhi(q[j].y); }
                if (sl[k] >= row0p) for (int s = 1; s < ksn; ++s) { const u32x2* yp = (const u32x2*)(part + (size_t)(s - 1) * pstride + (size_t)(sl[k] - row0p) * D) + lane;
#pragma unroll
                    for (int j = 0; j < 4; ++j) { const u32x2 r = yp[64 * j]; acc[j][0] += blo(r.x); acc[j][1] += bhi(r.x); acc[j][2] += blo(r.y); acc[j][3] += bhi(r.y); } }
#pragma unroll
                for (int j = 0; j < 4; ++j) { v[j].x += gt[k] * acc[j][0]; v[j].y += gt[k] * acc[j][1]; v[j].z += gt[k] * acc[j][2]; v[j].w += gt[k] * acc[j][3]; } }
#pragma unroll
            for (int j = 0; j < 4; ++j) { u32x2 wv; wv.x = pk2(v[j].x, v[j].y); wv.y = pk2(v[j].z, v[j].w); hr[64 * j] = wv; v[j] = (f32x4){blo(wv.x), bhi(wv.x), blo(wv.y), bhi(wv.y)}; } }
        float ss = 0.f;
#pragma unroll
        for (int j = 0; j < 4; ++j) ss += (v[j].x * v[j].x + v[j].y * v[j].y) + (v[j].z * v[j].z + v[j].w * v[j].w);
        ss = wave_sum(ss);
        const float r = 1.0f / sqrtf(ss * (1.0f / D) + RMS_EPS);
        if (MODE == 2) { if (lane < 16) rss_ptr(p, L, 2)[t * 16 + lane] = lane == 0 ? ss : 0.f; }
        if (MODE == 1) { u32x2* o = (u32x2*)(HBN + t * D) + lane;
#pragma unroll
            for (int j = 0; j < 4; ++j) { u32x2 w; w.x = pk2(v[j].x * r, v[j].y * r); w.y = pk2(v[j].z * r, v[j].w * r); o[64 * j] = w; } }
        if (MODE == 1 || MODE == 3) {
#pragma unroll
            for (int j = 0; j < 4; ++j) { const f32x4 gv = gr[64 * j]; v[j].x *= r * gv.x; v[j].y *= r * gv.y; v[j].z *= r * gv.z; v[j].w *= r * gv.w; } }
        if (MODE == 3) {
#pragma unroll
            for (int j = 0; j < 4; ++j) ((f32x4*)(p.out + t * D) + lane)[64 * j] = v[j];
        }
        if (MODE == 1) { float lg[NE];
#pragma unroll
            for (int e = 0; e < NE; ++e) lg[e] = 0.f;
#pragma unroll
            for (int j = 0; j < 4; ++j)
#pragma unroll
                for (int c = 0; c < 4; ++c) { const f32x4 r0 = Rr[(j * 4 + c) * 2], r1 = Rr[(j * 4 + c) * 2 + 1]; const float x = v[j][c];
                    lg[0] += x * r0.x; lg[1] += x * r0.y; lg[2] += x * r0.z; lg[3] += x * r0.w; lg[4] += x * r1.x; lg[5] += x * r1.y; lg[6] += x * r1.z; lg[7] += x * r1.w; }
#pragma unroll
            for (int e = 0; e < NE; ++e) lg[e] = wave_sum(lg[e]);
            int e0 = 0; float v0 = lg[0];
#pragma unroll
            for (int e = 1; e < NE; ++e) if (lg[e] > v0) { v0 = lg[e]; e0 = e; }
            int e1 = -1; float v1 = -3.0e38f;
#pragma unroll
            for (int e = 0; e < NE; ++e) if (e != e0 && lg[e] > v1) { v1 = lg[e]; e1 = e; }
            if (lane == 0) { const float g1 = 1.0f / (1.0f + expf(v0 - v1));
                p.TOPE[t * 2] = e0; p.TOPE[t * 2 + 1] = e1; p.TOPG[t * 2] = 1.0f - g1; p.TOPG[t * 2 + 1] = g1;
                p.POS[t * 2] = (int)__hip_atomic_fetch_add(lcnt + e0, 1u, __ATOMIC_RELAXED, __HIP_MEMORY_SCOPE_WORKGROUP); p.POS[t * 2 + 1] = (int)__hip_atomic_fetch_add(lcnt + e1, 1u, __ATOMIC_RELAXED, __HIP_MEMORY_SCOPE_WORKGROUP); } }
    }
    if (MODE == 1) { __syncthreads(); if (tid < NE) p.BCNT[bx * NE + tid] = (int)lcnt[tid]; }
}
__device__ __forceinline__ void moeplan(const MP& p, int L, FLAS unsigned char* lds, int bx, int G) {
    const int tid = mk_tid(), lane = tid & 63, wave = __builtin_amdgcn_readfirstlane(tid >> 6), j = L >> 1;
    const int gw = bx * 8 + wave, NGW = G * 8;
    FLAS int* base = (FLAS int*)lds;
    FLAS int* pst = (FLAS int*)(lds + 16384);
    __syncthreads();
    {
        const int e = wave; int c[4], s = 0;
#pragma unroll
        for (int i = 0; i < 4; ++i) { const int b = lane * 4 + i; c[i] = b < G ? p.BCNT[b * NE + e] : 0; s += c[i]; }
        int inc = s;
#pragma unroll
        for (int o = 1; o < 64; o <<= 1) { const int t = __shfl_up(inc, o); if (lane >= o) inc += t; }
        int ex = inc - s;
#pragma unroll
        for (int i = 0; i < 4; ++i) { const int b = lane * 4 + i; if (b < G) base[b * NE + e] = ex; ex += c[i]; }
        if (lane == 63) pst[e] = inc;
    }
    __syncthreads();
    if (tid == 0) { int o = 0; for (int e = 0; e < NE; ++e) { const int cnt = pst[e]; pst[e] = o; if (bx == 0) cnt_ptr(p, j)[e] = (unsigned)cnt; o += ((cnt + 255) / 256) * 256; } pst[NE] = o; }
    __syncthreads();
    for (long i = gw; i < p.T * 2; i += NGW) { const long t = i >> 1; const int e = p.TOPE[i], blk = (int)((t % NGW) >> 3); const int slot = pst[e] + base[blk * NE + e] + p.POS[i]; if (lane == 0) p.TOKSLOT[i] = slot;
        const u32x4* s = (const u32x4*)((const bf16*)p.H + t * D) + lane; u32x4* d = (u32x4*)(p.XB + (size_t)slot * D) + lane; const u32x4 a = s[0], b = s[64]; d[0] = a; d[64] = b; }
    if (bx == 0) for (int i = tid; i < 1024; i += 512) { int e = -1; if (i * 256 < pst[NE]) { e = 0; for (int q = 1; q < NE; ++q) if (i * 256 >= pst[q]) e = q; } p.TILE_E[i] = e; }
    __syncthreads();
}
typedef short bf16x8 __attribute__((ext_vector_type(8)));
typedef short bf16x4 __attribute__((ext_vector_type(4)));
constexpr int AT_KP = 104, AT_VP = 136, AT_KBYTES = 128 * AT_KP * 2, AT_BUF = AT_KBYTES + 80 * AT_VP * 2;
__device__ __forceinline__ void attn_phase(const MP& p, FLAS unsigned char* lds, int bx, int G) {
    const int S = (int)p.S, nunits = (int)p.B * 4 * 8;
    const int vcu = (G % 8 == 0) ? (bx % 8) * (G / 8) + bx / 8 : bx;
    { const int tid0 = mk_tid(); __syncthreads();
      for (int e = tid0; e < 2 * 16 * AT_VP; e += 512) { const int bufi = e / (16 * AT_VP), r = (e % (16 * AT_VP)) / AT_VP, c = e % AT_VP; ((FLAS bf16*)(lds + bufi * AT_BUF + AT_KBYTES))[(64 + r) * AT_VP + c] = r == 0 ? (bf16)0x3f80 : (bf16)0; } }
    for (int u = vcu; u < nunits; u += G) {
        const int tid = mk_tid(), lane = tid & 63, w = __builtin_amdgcn_readfirstlane(tid >> 6), fr = lane & 15, fq = lane >> 4;
        int kro[3], kco[3];
#pragma unroll
        for (int i = 0; i < 3; ++i) { const int c = tid + 512 * i; kro[i] = c / 12; kco[i] = c % 12; }
        const int vd = tid >> 4, vkc = tid & 15;
        const int bh = u >> 3, jp = u & 7, b = bh >> 2, h = bh & 3;
        const bf16* Kg = p.KK + (size_t)b * S * 384 + h * 96; const bf16* Vg = p.V + (size_t)bh * 64 * S;
        for (int half = 0; half < 2; ++half) {
            const int qb = half ? 15 - jp : jp, q0 = qb * 128, qmin = q0 + 16 * w, qglob = qmin + fr;
            const size_t trow = (size_t)b * S + qglob;
            bf16x8 qf[3];
#pragma unroll
            for (int ks = 0; ks < 3; ++ks) qf[ks] = *(const bf16x8*)(p.Q + trow * 384 + h * 96 + ks * 32 + fq * 8);
            f32x4 o[5];
#pragma unroll
            for (int dt = 0; dt < 5; ++dt) o[dt] = (f32x4){0.f, 0.f, 0.f, 0.f};
            float m = -1e30f;
            const int nkt = qb + 1;
            u32x4 rk[3], rv[2];
#define AT_LOAD(kt_) do { const size_t kb_ = (size_t)(kt_) * 128; _Pragma("unroll") for (int i = 0; i < 3; ++i) rk[i] = *(const u32x4*)(Kg + (kb_ + kro[i]) * 384 + kco[i] * 8); \
            _Pragma("unroll") for (int i = 0; i < 2; ++i) rv[i] = *(const u32x4*)(Vg + (size_t)(vd + 32 * i) * S + kb_ + vkc * 8); } while (0)
#define AT_WRITE(buf_) do { FLAS bf16* Kw = (FLAS bf16*)(lds + (buf_) * AT_BUF); FLAS bf16* Vw = (FLAS bf16*)(lds + (buf_) * AT_BUF + AT_KBYTES); \
            _Pragma("unroll") for (int i = 0; i < 3; ++i) *(FLAS u32x4*)(Kw + kro[i] * AT_KP + kco[i] * 8) = rk[i]; \
            _Pragma("unroll") for (int i = 0; i < 2; ++i) *(FLAS u32x4*)(Vw + (vd + 32 * i) * AT_VP + vkc * 8) = rv[i]; } while (0)
            AT_LOAD(0);
            __syncthreads();
            AT_WRITE(0);
            __syncthreads();
            for (int kt = 0; kt < nkt; ++kt) {
                const bool more = kt + 1 < nkt;
                TP_BEGIN(18, lds); if (more) AT_LOAD(kt + 1); TP_END(18, lds); TP_BEGIN(19, lds);
                const FLAS bf16* Ks = (const FLAS bf16*)(lds + (kt & 1) * AT_BUF); const FLAS bf16* Vt = (const FLAS bf16*)(lds + (kt & 1) * AT_BUF + AT_KBYTES);
                f32x4 s[8];
#pragma unroll
                for (int sub = 0; sub < 8; ++sub) { s[sub] = (f32x4){0.f, 0.f, 0.f, 0.f};
#pragma unroll
                    for (int ks = 0; ks < 3; ++ks) { const bf16x8 a = *(const FLAS bf16x8*)(Ks + (sub * 16 + fr) * AT_KP + ks * 32 + fq * 8); s[sub] = __builtin_amdgcn_mfma_f32_16x16x32_bf16(a, qf[ks], s[sub], 0, 0, 0); } }
                if (kt == qb) {
#pragma unroll
                    for (int sub = 0; sub < 8; ++sub)
#pragma unroll
                        for (int j = 0; j < 4; ++j) if (16 * sub + 4 * fq + j > 16 * w + fr) s[sub][j] = -1e30f; }
                float t0 = __builtin_fmaxf(__builtin_fmaxf(s[0][0], s[0][1]), s[0][2]), t1 = __builtin_fmaxf(__builtin_fmaxf(s[0][3], s[1][0]), s[1][1]);
                t0 = __builtin_fmaxf(__builtin_fmaxf(t0, s[1][2]), s[1][3]);
#pragma unroll
                for (int sub = 2; sub < 8; sub += 2) { t0 = __builtin_fmaxf(__builtin_fmaxf(t0, s[sub][0]), s[sub][1]); t1 = __builtin_fmaxf(__builtin_fmaxf(t1, s[sub][2]), s[sub][3]);
                    t0 = __builtin_fmaxf(__builtin_fmaxf(t0, s[sub + 1][0]), s[sub + 1][1]); t1 = __builtin_fmaxf(__builtin_fmaxf(t1, s[sub + 1][2]), s[sub + 1][3]); }
                float tmax = __builtin_fmaxf(t0, t1);
                tmax = __builtin_fmaxf(tmax, __shfl_xor(tmax, 16)); tmax = __builtin_fmaxf(tmax, __shfl_xor(tmax, 32));
                const float mn = __builtin_fmaxf(m, tmax), alpha = __builtin_amdgcn_exp2f(m - mn); m = mn;
#pragma unroll
                for (int sub = 0; sub < 8; ++sub)
#pragma unroll
                    for (int j = 0; j < 4; ++j) s[sub][j] = __builtin_amdgcn_exp2f(s[sub][j] - mn);
#pragma unroll
                for (int dt = 0; dt < 5; ++dt) o[dt] *= alpha;
#pragma unroll
                for (int k2 = 0; k2 < 4; ++k2) {
                    u32x4 pw; pw.x = pk2(s[2 * k2][0], s[2 * k2][1]); pw.y = pk2(s[2 * k2][2], s[2 * k2][3]); pw.z = pk2(s[2 * k2 + 1][0], s[2 * k2 + 1][1]); pw.w = pk2(s[2 * k2 + 1][2], s[2 * k2 + 1][3]);
                    const bf16x8 pf = __builtin_bit_cast(bf16x8, pw);
#pragma unroll
                    for (int dt = 0; dt < 5; ++dt) { const FLAS bf16* vp = Vt + (dt * 16 + fr) * AT_VP + 32 * k2 + 4 * fq;
                        const u32x2 v0 = *(const FLAS u32x2*)vp, v1 = *(const FLAS u32x2*)(vp + 16); u32x4 vw; vw.x = v0.x; vw.y = v0.y; vw.z = v1.x; vw.w = v1.y;
                        o[dt] = __builtin_amdgcn_mfma_f32_16x16x32_bf16(__builtin_bit_cast(bf16x8, vw), pf, o[dt], 0, 0, 0); } }
                TP_END(19, lds); TP_BEGIN(20, lds); if (more) AT_WRITE((kt + 1) & 1);
                __syncthreads(); TP_END(20, lds);
            }
#undef AT_LOAD
#undef AT_WRITE
            const float l = __shfl(o[4][0], fr);
            const float rl = 1.0f / l;
            FLAS unsigned char* ostg = lds + 2 * AT_BUF + w * (16 * 144);
#pragma unroll
            for (int dt = 0; dt < 4; ++dt) { u32x2 ow; ow.x = pk2(o[dt][0] * rl, o[dt][1] * rl); ow.y = pk2(o[dt][2] * rl, o[dt][3] * rl); *(FLAS u32x2*)(ostg + fr * 144 + (dt * 16 + 4 * fq) * 2) = ow; }
            FP_LDS_WAIT(); asm volatile("" ::: "memory");
            tile_out<16, 128, 144, 64>(ostg, (unsigned char*)(p.YC + ((size_t)b * S + qmin) * D + 768 + h * 64), (size_t)D * 2, lane);
            FP_LDS_WAIT(); asm volatile("" ::: "memory");
        }
    }
    __syncthreads();
}
__device__ __forceinline__ void conv_module(const MP& p, int L, FLAS unsigned char* lds, int bx, int G) {
    FLAS float* Gs = (FLAS float*)lds;
    const int S = (int)p.S, nchunk = S / 64, nitems = (int)p.B * nchunk;
    for (int it = bx; it < nitems; it += G) {
        const int tid = mk_tid(), lane = tid & 63, w = __builtin_amdgcn_readfirstlane(tid >> 6);
        const int ck = it % nchunk, b = it / nchunk, s0 = ck * 64;
        __syncthreads();
        const int ch = (w & 3) * 64 + lane, tb = (w >> 2) * 32; float wj[CK];
#pragma unroll
        for (int j = 0; j < CK; ++j) wj[j] = p.cdw_w[(L * CK + j) * 256 + ch];
        const float bias = p.cdw_b[L * 256 + ch], lg = p.cln_g[L * 256 + ch], lb = p.cln_b[L * 256 + ch];
        u32x4 rv[6], rg[6];
#pragma unroll
        for (int i = 0; i < 6; ++i) { const int idx = tid + 512 * i, row = idx >> 5, c = idx & 31, sp = s0 - 30 + row; rv[i] = (u32x4){0u, 0u, 0u, 0u}; rg[i] = rv[i];
            if (idx < 94 * 32 && sp >= 0) { const bf16* u = p.U + ((size_t)b * S + sp) * NU + c * 8; rv[i] = *(const u32x4*)u; rg[i] = *(const u32x4*)(u + 256); } }
        __builtin_amdgcn_sched_barrier(0);
#pragma unroll
        for (int i = 0; i < 6; ++i) { const int idx = tid + 512 * i, row = idx >> 5, c = idx & 31;
            if (idx < 94 * 32) { const unsigned v[4] = {rv[i].x, rv[i].y, rv[i].z, rv[i].w}, g[4] = {rg[i].x, rg[i].y, rg[i].z, rg[i].w}; f32x4 o0, o1;
                o0.x = blo(v[0]) / (1.0f + __expf(-blo(g[0]))); o0.y = bhi(v[0]) / (1.0f + __expf(-bhi(g[0]))); o0.z = blo(v[1]) / (1.0f + __expf(-blo(g[1]))); o0.w = bhi(v[1]) / (1.0f + __expf(-bhi(g[1])));
                o1.x = blo(v[2]) / (1.0f + __expf(-blo(g[2]))); o1.y = bhi(v[2]) / (1.0f + __expf(-bhi(g[2]))); o1.z = blo(v[3]) / (1.0f + __expf(-blo(g[3]))); o1.w = bhi(v[3]) / (1.0f + __expf(-bhi(g[3])));
                *(FLAS f32x4*)(Gs + row * 256 + c * 8) = o0; *(FLAS f32x4*)(Gs + row * 256 + c * 8 + 4) = o1; } }
        __syncthreads();
#pragma unroll 1
        for (int i8 = 0; i8 < 4; ++i8) { const int tl0 = tb + 8 * i8; float win[38], acc[8];
#pragma unroll
            for (int r = 0; r < 38; ++r) win[r] = Gs[(tl0 + r) * 256 + ch];
#pragma unroll
            for (int q = 0; q < 8; ++q) { float a = bias;
#pragma unroll
                for (int j = 0; j < CK; ++j) a += wj[j] * win[q + j];
                acc[q] = a; }
            float mu[8], var[8];
#pragma unroll
            for (int q = 0; q < 8; ++q) mu[q] = acc[q];
#pragma unroll
            for (int o = 1; o < 64; o <<= 1)
#pragma unroll
                for (int q = 0; q < 8; ++q) mu[q] += __shfl_xor(mu[q], o);
#pragma unroll
            for (int q = 0; q < 8; ++q) { mu[q] *= (1.0f / 64.f); acc[q] -= mu[q]; var[q] = acc[q] * acc[q]; }
#pragma unroll
            for (int o = 1; o < 64; o <<= 1)
#pragma unroll
                for (int q = 0; q < 8; ++q) var[q] += __shfl_xor(var[q], o);
#pragma unroll
            for (int q = 0; q < 8; ++q) { const float hn = acc[q] * (1.0f / sqrtf(var[q] * (1.0f / 64.f) + LN_EPS)) * lg + lb; p.YC[((size_t)b * S + s0 + tl0 + q) * D + ch] = f2bf(hn / (1.0f + __expf(-hn))); } }
    }
    __syncthreads();
}
constexpr int MQ_P = 264, MK_P = 136;
__device__ __forceinline__ void mla_proj(const MP& p, int L, FLAS unsigned char* lds, int bx, int G) {
    FLAS bf16* Aq = (FLAS bf16*)lds; FLAS bf16* Ak = (FLAS bf16*)(lds + 64 * MQ_P * 2);
    const int nunits = (int)(p.T / 64);
    const bf16* Wq = p.WUQ + (size_t)L * 512 * 256; const bf16* Wk = p.WUKV + (size_t)L * 512 * 128;
    for (int u = bx; u < nunits; u += G) {
        const int tid = mk_tid(), lane = tid & 63, w = __builtin_amdgcn_readfirstlane(tid >> 6), fr = lane & 15, fq = lane >> 4;
        const size_t t0 = (size_t)u * 64;
        __syncthreads();
        bf16x8 wq0[4][3], wkf[4][4];
        {
            u32x2 rq[8]; unsigned rk[8];
#pragma unroll
            for (int i = 0; i < 8; ++i) { const bf16* urow = p.U + (t0 + w * 8 + i) * NU; rq[i] = *(const u32x2*)(urow + U_CQ + lane * 4); rk[i] = *(const unsigned*)(urow + U_CKV + lane * 2); }
            const f32x4 gq = *(const f32x4*)(p.qn_g + L * 256 + lane * 4); const f32x2 gk = *(const f32x2*)(p.kvn_g + L * 128 + lane * 2);
#pragma unroll
            for (int k4 = 0; k4 < 4; ++k4)
#pragma unroll
                for (int ct = 0; ct < 3; ++ct) wq0[k4][ct] = *(const bf16x8*)(Wq + (size_t)(48 * w + 16 * ct + fr) * 256 + k4 * 32 + fq * 8);
#pragma unroll
            for (int ks = 0; ks < 4; ++ks)
#pragma unroll
                for (int ct = 0; ct < 4; ++ct) wkf[ks][ct] = *(const bf16x8*)(Wk + (size_t)(64 * w + 16 * ct + fr) * 128 + ks * 32 + fq * 8);
            __builtin_amdgcn_sched_barrier(0);
#pragma unroll
            for (int i = 0; i < 8; ++i) { const int r = w * 8 + i;
                { const float a0 = blo(rq[i].x), a1 = bhi(rq[i].x), a2 = blo(rq[i].y), a3 = bhi(rq[i].y); const float rs = 1.0f / sqrtf(wave_sum((a0 * a0 + a1 * a1) + (a2 * a2 + a3 * a3)) * (1.0f / 256.f) + RMS_EPS);
                  u32x2 o; o.x = pk2(a0 * rs * gq.x, a1 * rs * gq.y); o.y = pk2(a2 * rs * gq.z, a3 * rs * gq.w); *(FLAS u32x2*)(Aq + r * MQ_P + lane * 4) = o; }
                { const float a0 = blo(rk[i]), a1 = bhi(rk[i]); const float rs = 1.0f / sqrtf(wave_sum(a0 * a0 + a1 * a1) * (1.0f / 128.f) + RMS_EPS); *(FLAS unsigned*)(Ak + r * MK_P + lane * 2) = pk2(a0 * rs * gk.x, a1 * rs * gk.y); } } }
#pragma unroll
        for (int e2 = 0; e2 < 2; ++e2) { const int e = tid + 512 * e2, r = e >> 4, jj = e & 15; const size_t t = t0 + r; const float x1 = bf2f(p.U[t * NU + U_KR + jj]), x2 = bf2f(p.U[t * NU + U_KR + 16 + jj]), c = p.CS[t * 32 + jj], sn = p.CS[t * 32 + 16 + jj];
            const bf16 o1 = f2bf(x1 * c - x2 * sn), o2 = f2bf(x1 * sn + x2 * c);
#pragma unroll
            for (int h = 0; h < 4; ++h) { p.KK[t * 384 + h * 96 + 64 + jj] = o1; p.KK[t * 384 + h * 96 + 80 + jj] = o2; } }
        __syncthreads();
        {
            f32x4 acc[3][4];
#pragma unroll
            for (int ct = 0; ct < 3; ++ct)
#pragma unroll
                for (int rt = 0; rt < 4; ++rt) acc[ct][rt] = (f32x4){0.f, 0.f, 0.f, 0.f};
            bf16x8 wq1[4][3];
#pragma unroll
            for (int k4 = 0; k4 < 4; ++k4)
#pragma unroll
                for (int ct = 0; ct < 3; ++ct) wq1[k4][ct] = *(const bf16x8*)(Wq + (size_t)(48 * w + 16 * ct + fr) * 256 + (4 + k4) * 32 + fq * 8);
            __builtin_amdgcn_sched_barrier(0);
#pragma unroll
            for (int k4 = 0; k4 < 4; ++k4)
#pragma unroll
                for (int rt = 0; rt < 4; ++rt) { const bf16x8 tk = *(const FLAS bf16x8*)(Aq + (rt * 16 + fr) * MQ_P + k4 * 32 + fq * 8);
#pragma unroll
                    for (int ct = 0; ct < 3; ++ct) acc[ct][rt] = __builtin_amdgcn_mfma_f32_16x16x32_bf16(wq0[k4][ct], tk, acc[ct][rt], 0, 0, 0); }
#pragma unroll
            for (int k4 = 0; k4 < 4; ++k4)
#pragma unroll
                for (int rt = 0; rt < 4; ++rt) { const bf16x8 tk = *(const FLAS bf16x8*)(Aq + (rt * 16 + fr) * MQ_P + (4 + k4) * 32 + fq * 8);
#pragma unroll
                    for (int ct = 0; ct < 3; ++ct) acc[ct][rt] = __builtin_amdgcn_mfma_f32_16x16x32_bf16(wq1[k4][ct], tk, acc[ct][rt], 0, 0, 0); }
            const bool pe = (w & 1) != 0;
#pragma unroll
            for (int rt = 0; rt < 4; ++rt) { const size_t t = t0 + rt * 16 + fr; bf16* qrow = p.Q + t * 384 + 48 * w + 4 * fq;
                f32x4 v0 = acc[0][rt], v1 = acc[1][rt], v2 = acc[2][rt];
                if (pe) { const f32x4 c = *(const f32x4*)(p.CS + t * 32 + 4 * fq), sn = *(const f32x4*)(p.CS + t * 32 + 16 + 4 * fq); const f32x4 x1 = v1, x2 = v2; v1 = x1 * c - x2 * sn; v2 = x1 * sn + x2 * c; }
                u32x2 o; o.x = pk2(v0.x * QSCALE, v0.y * QSCALE); o.y = pk2(v0.z * QSCALE, v0.w * QSCALE); *(u32x2*)qrow = o;
                o.x = pk2(v1.x * QSCALE, v1.y * QSCALE); o.y = pk2(v1.z * QSCALE, v1.w * QSCALE); *(u32x2*)(qrow + 16) = o;
                o.x = pk2(v2.x * QSCALE, v2.y * QSCALE); o.y = pk2(v2.z * QSCALE, v2.w * QSCALE); *(u32x2*)(qrow + 32) = o; }
        }
        {
            f32x4 acc[4][4];
#pragma unroll
            for (int ct = 0; ct < 4; ++ct)
#pragma unroll
                for (int rt = 0; rt < 4; ++rt) acc[ct][rt] = (f32x4){0.f, 0.f, 0.f, 0.f};
            const int h = w >> 1; const bool isv = (w & 1) != 0;
            if (!isv) {
#pragma unroll
                for (int ks = 0; ks < 4; ++ks)
#pragma unroll
                    for (int rt = 0; rt < 4; ++rt) { const bf16x8 tk = *(const FLAS bf16x8*)(Ak + (rt * 16 + fr) * MK_P + ks * 32 + fq * 8);
#pragma unroll
                        for (int ct = 0; ct < 4; ++ct) acc[ct][rt] = __builtin_amdgcn_mfma_f32_16x16x32_bf16(wkf[ks][ct], tk, acc[ct][rt], 0, 0, 0); }
#pragma unroll
                for (int rt = 0; rt < 4; ++rt) { const size_t t = t0 + rt * 16 + fr; bf16* dst = p.KK + t * 384 + h * 96 + 4 * fq;
#pragma unroll
                    for (int ct = 0; ct < 4; ++ct) { u32x2 o; o.x = pk2(acc[ct][rt].x, acc[ct][rt].y); o.y = pk2(acc[ct][rt].z, acc[ct][rt].w); *(u32x2*)(dst + 16 * ct) = o; } }
            } else {
#pragma unroll
                for (int ks = 0; ks < 4; ++ks)
#pragma unroll
                    for (int rt = 0; rt < 4; ++rt) { const bf16x8 tk = *(const FLAS bf16x8*)(Ak + (rt * 16 + fr) * MK_P + ks * 32 + fq * 8);
#pragma unroll
                        for (int ct = 0; ct < 4; ++ct) acc[ct][rt] = __builtin_amdgcn_mfma_f32_16x16x32_bf16(tk, wkf[ks][ct], acc[ct][rt], 0, 0, 0); }
                const size_t bq = t0 / p.S, sq = t0 % p.S;
#pragma unroll
                for (int ct = 0; ct < 4; ++ct) { bf16* drow = p.V + ((bq * 4 + h) * 64 + 16 * ct + fr) * p.S + sq + 4 * fq;
#pragma unroll
                    for (int rt = 0; rt < 4; ++rt) { u32x2 o; o.x = pk2(acc[ct][rt].x, acc[ct][rt].y); o.y = pk2(acc[ct][rt].z, acc[ct][rt].w); *(u32x2*)(drow + 16 * rt) = o; } }
            }
        }
    }
    __syncthreads();
}
__device__ __forceinline__ void ssd_scan(const MP& p, int bx, int G) {
    const int tid = mk_tid(); const long g0 = (long)bx * 512 + tid, gs = (long)G * 512; const int NCB = (int)(p.S / CHUNK);
    for (long i = g0; i < p.B * 8 * 64 * 32; i += gs) { const long b = i / (8 * 64 * 32), r = i % (8 * 64 * 32); const int h = (int)(r / (64 * 32)); f32x4 carry = (f32x4){0.f, 0.f, 0.f, 0.f};
        f32x4 st[16]; float dec[16];
#pragma unroll
        for (int cc = 0; cc < 16; ++cc) { const long c = b * NCB + cc; st[cc] = ((const f32x4*)p.ST)[(size_t)c * (8 * 64 * 32) + r]; dec[cc] = p.ACS[(c * CHUNK + CHUNK - 1) * 8 + h]; }
        __builtin_amdgcn_sched_barrier(0);
#pragma unroll
        for (int cc = 0; cc < 16; ++cc) { const long c = b * NCB + cc; u32x2 o; o.x = pk2(carry.x, carry.y); o.y = pk2(carry.z, carry.w); ((u32x2*)p.PV)[(size_t)c * (8 * 64 * 32) + r] = o; carry = carry * __expf(dec[cc]) + st[cc]; } }
}
constexpr int SP = 136;
constexpr int SA_DT = 0, SA_ACS = 2048, SA_CM = 4096, SA_BM = SA_CM + 128 * SP * 2, SA_XT = SA_CM, SA_BT = SA_CM + 2 * 128 * SP * 2, SA_MW = SA_BT + 128 * SP * 2, SA_END = SA_MW + 8 * 16 * SP * 2;
__device__ __forceinline__ float silu_f(float x) { return x / (1.0f + __expf(-x)); }
__device__ __forceinline__ float softplus_fast(float x) { if (x > 20.f) return x; const float e = __builtin_amdgcn_exp2f(x * 1.4426950408889634f); return e < 1e-3f ? e * (1.0f - 0.5f * e) : 0.6931471805599453f * __builtin_amdgcn_logf(1.0f + e); }
__device__ __forceinline__ void conv_load(const bf16* ub  , int xc  , int s0, int l0  , float (&x)[67]) {
#pragma unroll
    for (int i = 0; i < 67; ++i) { const int sp = s0 + l0 - 3 + i; const bf16* rowp = ub + (size_t)(sp < 0 ? 0 : sp) * NU; x[i] = (i >= 3 || sp >= 0) ? bf2f(rowp[xc]) : 0.f; }
}
template <int MODE> __device__ __forceinline__ void conv_compute(const float (&cw)[5], int l0, const float (&x)[67], FLAS bf16* d0, FLAS bf16* d1, bf16* gb  , int gcol  , int gstride, const FLAS float* dts, int n) {
    const float w0 = cw[0], w1 = cw[1], w2 = cw[2], w3 = cw[3], bias = cw[4];
#pragma unroll
    for (int i = 0; i < 64; ++i) { const int l = l0 + i; const bf16 vb = f2bf(silu_f(bias + w0 * x[i] + w1 * x[i + 1] + w2 * x[i + 2] + w3 * x[i + 3])); bf16* grow = gb + (size_t)l * gstride;
        if (MODE == 0) { d0[l * SP + n] = vb; grow[gcol] = vb; }
        if (MODE == 1) { d0[l * SP + n] = vb; d1[n * SP + l] = vb; }
        if (MODE == 2) { grow[gcol] = vb; d0[n * SP + l] = f2bf(bf2f(vb) * dts[l]); } }
}
__device__ __forceinline__ void ssd_a(const MP& p, int L, FLAS unsigned char* lds, int bx, int G) {
    FLAS float* dtL = (FLAS float*)(lds + SA_DT); FLAS float* acsL = (FLAS float*)(lds + SA_ACS);
    FLAS bf16* Cm = (FLAS bf16*)(lds + SA_CM); FLAS bf16* Bm = (FLAS bf16*)(lds + SA_BM); FLAS bf16* XT = (FLAS bf16*)(lds + SA_XT); FLAS bf16* BT = (FLAS bf16*)(lds + SA_BT);
    const int S = (int)p.S, nunits = (int)(p.T / CHUNK) * 2;
    for (int u = bx; u < nunits; u += G) {
        const int tid = mk_tid(), lane = tid & 63, w = __builtin_amdgcn_readfirstlane(tid >> 6), fr = lane & 15, fq = lane >> 4;
        FLAS bf16* Mw = (FLAS bf16*)(lds + SA_MW + w * (16 * SP * 2));
        const int g = u & 1; const long c = u >> 1; const size_t t0 = (size_t)c * CHUNK; const int s0 = (int)(t0 % S); const size_t tb = t0 - s0;
        __syncthreads();
        const int ch = tid & 255, half = __builtin_amdgcn_readfirstlane(tid >> 8), nbc = ch & 127; const bool isC = __builtin_amdgcn_readfirstlane(ch >= 128 ? 1 : 0) != 0;
        const int xcb = (isC ? 768 : 512) + 128 * g + nbc, xcs = 256 * g + ch, h4x = __builtin_amdgcn_readfirstlane(ch >> 6);
        float xb[67], xs[67];
        const int h4 = tid >> 7, ldt = tid & 127; const bf16 dtraw = p.U[(t0 + ldt) * NU + U_DT + 4 * g + h4];
        conv_load(p.U + tb * NU + U_XBC, xcb, s0, 64 * half, xb);
        conv_load(p.U + tb * NU + U_XBC, xcs, s0, 64 * half, xs);
        float cwb[5], cws[5];
#pragma unroll
        for (int j = 0; j < 4; ++j) { cwb[j] = p.sconv_w[(L * 4 + j) * 1024 + xcb]; cws[j] = p.sconv_w[(L * 4 + j) * 1024 + xcs]; }
        cwb[4] = p.sconv_b[L * 1024 + xcb]; cws[4] = p.sconv_b[L * 1024 + xcs];
        __builtin_amdgcn_sched_barrier(0);
        dtL[h4 * 128 + ldt] = softplus_fast(bf2f(dtraw) + p.dt_bias[L * 8 + 4 * g + h4]);
        if (isC) conv_compute<0>(cwb, 64 * half, xb, Cm, nullptr, p.CM + t0 * 256 + g * 128, nbc, 256, nullptr, nbc);
        else conv_compute<1>(cwb, 64 * half, xb, Bm, BT, p.CM, 0, 0, nullptr, nbc);
        __syncthreads();
        if (w < 4) {
            const int h = 4 * g + w; const float a = -__expf(p.a_log[L * 8 + h]); const float x0 = dtL[w * 128 + 2 * lane] * a, x1 = dtL[w * 128 + 2 * lane + 1] * a, ps = x0 + x1; float inc = ps;
#pragma unroll
            for (int o = 1; o < 64; o <<= 1) { const float t = __shfl_up(inc, o); if (lane >= o) inc += t; }
            const float ex = inc - ps, c0 = ex + x0, c1 = ex + ps; *(FLAS f32x2*)(acsL + w * 128 + 2 * lane) = (f32x2){c0, c1};
            p.ACS[(t0 + 2 * lane) * 8 + h] = c0; p.ACS[(t0 + 2 * lane + 1) * 8 + h] = c1; }
        f32x4 cbT[8];
#pragma unroll
        for (int ct = 0; ct < 8; ++ct) cbT[ct] = (f32x4){0.f, 0.f, 0.f, 0.f};
#pragma unroll
        for (int ks = 0; ks < 4; ++ks) { const bf16x8 cf = *(const FLAS bf16x8*)(Cm + (16 * w + fr) * SP + ks * 32 + fq * 8);
#pragma unroll
            for (int ct = 0; ct < 8; ++ct) { const bf16x8 bfm = *(const FLAS bf16x8*)(Bm + (16 * ct + fr) * SP + ks * 32 + fq * 8); cbT[ct] = __builtin_amdgcn_mfma_f32_16x16x32_bf16(bfm, cf, cbT[ct], 0, 0, 0); } }
        __syncthreads();
        conv_compute<2>(cws, 64 * half, xs, XT, nullptr, p.XS + t0 * 512, xcs, 512, dtL + h4x * 128, ch);
        __syncthreads();
#pragma unroll 1
        for (int r = 0; r < 4; ++r) {
            const FLAS float* ac = acsL + r * 128; const int h = 4 * g + r; const float al = ac[16 * w + fr];
#pragma unroll
            for (int ct = 0; ct < 8; ++ct) { const f32x4 as = *(const FLAS f32x4*)(ac + 16 * ct + 4 * fq); const int sb = 16 * ct + 4 * fq, l = 16 * w + fr; float m0, m1, m2, m3;
                m0 = (sb + 0 <= l) ? cbT[ct].x * __expf(al - as.x) : 0.f; m1 = (sb + 1 <= l) ? cbT[ct].y * __expf(al - as.y) : 0.f; m2 = (sb + 2 <= l) ? cbT[ct].z * __expf(al - as.z) : 0.f; m3 = (sb + 3 <= l) ? cbT[ct].w * __expf(al - as.w) : 0.f;
                u32x2 o; o.x = pk2(m0, m1); o.y = pk2(m2, m3); *(FLAS u32x2*)(Mw + fr * SP + sb) = o; }
            FP_LDS_WAIT(); asm volatile("" ::: "memory");
            f32x4 yd[4], st[4];
#pragma unroll
            for (int pt = 0; pt < 4; ++pt) { yd[pt] = (f32x4){0.f, 0.f, 0.f, 0.f}; st[pt] = (f32x4){0.f, 0.f, 0.f, 0.f}; }
            const float alast = ac[127];
#pragma unroll
            for (int ks = 0; ks < 4; ++ks) { const bf16x8 am = *(const FLAS bf16x8*)(Mw + fr * SP + ks * 32 + fq * 8);
                const u32x4 braw = *(const FLAS u32x4*)(BT + (16 * w + fr) * SP + ks * 32 + fq * 8); const f32x4 e0 = *(const FLAS f32x4*)(ac + ks * 32 + fq * 8), e1 = *(const FLAS f32x4*)(ac + ks * 32 + fq * 8 + 4); u32x4 bs;
                bs.x = pk2(blo(braw.x) * __expf(alast - e0.x), bhi(braw.x) * __expf(alast - e0.y)); bs.y = pk2(blo(braw.y) * __expf(alast - e0.z), bhi(braw.y) * __expf(alast - e0.w));
                bs.z = pk2(blo(braw.z) * __expf(alast - e1.x), bhi(braw.z) * __expf(alast - e1.y)); bs.w = pk2(blo(braw.w) * __expf(alast - e1.z), bhi(braw.w) * __expf(alast - e1.w));
                const bf16x8 bsf = __builtin_bit_cast(bf16x8, bs);
#pragma unroll
                for (int pt = 0; pt < 4; ++pt) { const bf16x8 x = *(const FLAS bf16x8*)(XT + (r * 64 + 16 * pt + fr) * SP + ks * 32 + fq * 8);
                    yd[pt] = __builtin_amdgcn_mfma_f32_16x16x32_bf16(x, am, yd[pt], 0, 0, 0); st[pt] = __builtin_amdgcn_mfma_f32_16x16x32_bf16(bsf, x, st[pt], 0, 0, 0); } }
#pragma unroll
            for (int pt = 0; pt < 4; ++pt) { u32x2 o; o.x = pk2(yd[pt].x, yd[pt].y); o.y = pk2(yd[pt].z, yd[pt].w); *(FLAS u32x2*)((FLAS unsigned char*)Mw + fr * 144 + (16 * pt + 4 * fq) * 2) = o;
                *(f32x4*)(p.ST + (((size_t)c * 8 + h) * 64 + 16 * pt + fr) * 128 + 16 * w + 4 * fq) = st[pt]; }
            FP_LDS_WAIT(); asm volatile("" ::: "memory");
            tile_out<16, 128, 144, 64>((const FLAS unsigned char*)Mw, (unsigned char*)(p.YD + (t0 + 16 * w) * 512 + h * 64), (size_t)512 * 2, lane);
            FP_LDS_WAIT(); asm volatile("" ::: "memory");
        }
    }
    __syncthreads();
}
__device__ __forceinline__ void ssd_c(const MP& p, int L, FLAS unsigned char* lds, int bx, int G) {
    const int nunits = (int)(p.T / CHUNK) * 2;
    for (int u = bx; u < nunits; u += G) {
        const int tid = mk_tid(), lane = tid & 63, w = __builtin_amdgcn_readfirstlane(tid >> 6), fr = lane & 15, fq = lane >> 4;
        const int g = u & 1; const long c = u >> 1; const size_t t0 = (size_t)c * CHUNK, t = t0 + 16 * w + fr;
        FLAS float* gnl = (FLAS float*)(lds + 8 * (16 * 528));
        __syncthreads();
        if (tid < 64) *(FLAS f32x4*)(gnl + 4 * tid) = *(const f32x4*)(p.snorm_g + L * 512 + g * 256 + 4 * tid);
        __syncthreads();
        TP_BEGIN(24, lds);
        bf16x8 cf[4];
#pragma unroll
        for (int ks = 0; ks < 4; ++ks) cf[ks] = *(const bf16x8*)(p.CM + t * 256 + g * 128 + ks * 32 + fq * 8);
        if (PROBE_CK == 1) { asm volatile("s_waitcnt vmcnt(0) lgkmcnt(0)" ::: "memory"); TP_END(24, lds); }
        f32x4 y[4][4]; float ssq = 0.f;
#pragma unroll
        for (int hp = 0; hp < 2; ++hp) { bf16x8 pvf[2][4][4];
#pragma unroll
            for (int rr = 0; rr < 2; ++rr) { const bf16* pv = p.PV + (((size_t)c * 8 + 4 * g + 2 * hp + rr) * 64) * 128;
#pragma unroll
                for (int pt = 0; pt < 4; ++pt)
#pragma unroll
                    for (int ks = 0; ks < 4; ++ks) pvf[rr][pt][ks] = *(const bf16x8*)(pv + (size_t)(16 * pt + fr) * 128 + ks * 32 + fq * 8); }
            __builtin_amdgcn_sched_barrier(0);
#pragma unroll
            for (int rr = 0; rr < 2; ++rr)
#pragma unroll
                for (int pt = 0; pt < 4; ++pt) { f32x4 acc = (f32x4){0.f, 0.f, 0.f, 0.f};
#pragma unroll
                    for (int ks = 0; ks < 4; ++ks) acc = __builtin_amdgcn_mfma_f32_16x16x32_bf16(pvf[rr][pt][ks], cf[ks], acc, 0, 0, 0);
                    y[2 * hp + rr][pt] = acc; }
            __builtin_amdgcn_sched_barrier(0); }
        if (PROBE_CK == 2) { asm volatile("s_waitcnt vmcnt(0) lgkmcnt(0)" ::: "memory"); TP_END(24, lds); }
        u32x2 ryd[4][4], rxs[4][4], rz[4][4]; float ea[4];
#pragma unroll
        for (int r = 0; r < 4; ++r) { const int h = 4 * g + r; ea[r] = p.ACS[t * 8 + h];
#pragma unroll
            for (int pt = 0; pt < 4; ++pt) { const int ch = h * 64 + 16 * pt + 4 * fq; ryd[r][pt] = *(const u32x2*)(p.YD + t * 512 + ch); rxs[r][pt] = *(const u32x2*)(p.XS + t * 512 + ch); rz[r][pt] = *(const u32x2*)(p.U + t * NU + U_Z + ch); } }
        __builtin_amdgcn_sched_barrier(0);
        if (PROBE_CK == 3) { asm volatile("s_waitcnt vmcnt(0) lgkmcnt(0)" ::: "memory"); TP_END(24, lds); }
#pragma unroll
        for (int r = 0; r < 4; ++r) { const float dsk = p.dskip[L * 8 + 4 * g + r], e = __expf(ea[r]);
#pragma unroll
            for (int pt = 0; pt < 4; ++pt) { const f32x4 acc = y[r][pt]; f32x4 yv;
                yv.x = (acc.x * e + blo(ryd[r][pt].x) + dsk * blo(rxs[r][pt].x)) * silu_f(blo(rz[r][pt].x)); yv.y = (acc.y * e + bhi(ryd[r][pt].x) + dsk * bhi(rxs[r][pt].x)) * silu_f(bhi(rz[r][pt].x));
                yv.z = (acc.z * e + blo(ryd[r][pt].y) + dsk * blo(rxs[r][pt].y)) * silu_f(blo(rz[r][pt].y)); yv.w = (acc.w * e + bhi(ryd[r][pt].y) + dsk * bhi(rxs[r][pt].y)) * silu_f(bhi(rz[r][pt].y));
                y[r][pt] = yv; ssq += (yv.x * yv.x + yv.y * yv.y) + (yv.z * yv.z + yv.w * yv.w); } }
        if (PROBE_CK == 4) { asm volatile("s_waitcnt vmcnt(0) lgkmcnt(0)" ::: "memory"); TP_END(24, lds); }
        ssq += __shfl_xor(ssq, 16); ssq += __shfl_xor(ssq, 32);
        const float rs = 1.0f / sqrtf(ssq * (1.0f / 256.f) + RMS_EPS);
        FLAS unsigned char* stg = lds + w * (16 * 528);
#pragma unroll
        for (int r = 0; r < 4; ++r)
#pragma unroll
            for (int pt = 0; pt < 4; ++pt) { const int cl = r * 64 + 16 * pt + 4 * fq; const f32x4 gn = *(const FLAS f32x4*)(gnl + cl); const f32x4 v = y[r][pt];
                u32x2 o; o.x = pk2(v.x * rs * gn.x, v.y * rs * gn.y); o.y = pk2(v.z * rs * gn.z, v.w * rs * gn.w); *(FLAS u32x2*)(stg + fr * 528 + cl * 2) = o; }
        if (PROBE_CK == 5) { asm volatile("s_waitcnt vmcnt(0) lgkmcnt(0)" ::: "memory"); TP_END(24, lds); }
        FP_LDS_WAIT(); asm volatile("" ::: "memory");
        tile_out<16, 512, 528, 64>(stg, (unsigned char*)(p.YC + (t0 + 16 * w) * D + 256 + g * 256), (size_t)D * 2, lane);
        FP_LDS_WAIT(); asm volatile("" ::: "memory");
        if (PROBE_CK == 6) { asm volatile("s_waitcnt vmcnt(0) lgkmcnt(0)" ::: "memory"); TP_END(24, lds); }
    }
}
}

using namespace mdl;
#define LAS __attribute__((address_space(3)))
constexpr int NWAVES = 8, NTHR = NWAVES * 64;
constexpr int CW_BAR = 4096;
#define XB_TMO      128
#define XB_XCNT(j)  (256  + 64 * (j))
#define XB_XSUB(j)  (1280 + 64 * (j))
#define XB_XGEN(j)  (2304 + 64 * (j))
#define XB_TOP      3328
#define XB_TOPGEN   3392
#define XCD_BAR_WORDS 3456
#define XB_SPIN_CAP (1u << 18)

__device__ __forceinline__ unsigned xb_ld(unsigned* p)              { return __hip_atomic_load(p, __ATOMIC_RELAXED, __HIP_MEMORY_SCOPE_AGENT); }
__device__ __forceinline__ unsigned xb_add(unsigned* p, unsigned v) { return __hip_atomic_fetch_add(p, v, __ATOMIC_RELAXED, __HIP_MEMORY_SCOPE_AGENT); }
__device__ __forceinline__ unsigned xb_xcc_id() { return (unsigned)__builtin_amdgcn_s_getreg((3 << 11) | 20) & 0xFu; }
#define XB_SPIN(cond, bar) do { unsigned _sp = 0; while (cond) { __builtin_amdgcn_s_sleep(1); \
    if ((++_sp & 255u) == 0u) { if (xb_ld(&(bar)[XB_TMO])) break; if (_sp > XB_SPIN_CAP) { atomicAdd(&(bar)[XB_TMO], 1u); break; } } } } while (0)

struct XcdBarrier {
    unsigned* bar; unsigned x;
    volatile LAS unsigned* st;
};

__device__ __forceinline__ XcdBarrier xcd_barrier_post(unsigned* bar, volatile LAS unsigned* st) {
    XcdBarrier b; b.bar = bar; b.x = xb_xcc_id(); b.st = st;
    if (threadIdx.x == 0) (void)xb_add(&bar[XB_XCNT(b.x)], 1u);
    return b;
}
__device__ __forceinline__ void xcd_barrier_complete(unsigned* bar, unsigned x, unsigned& nloc, unsigned& nx) {
    const unsigned G = gridDim.x * gridDim.y * gridDim.z;
    unsigned sum, cnt, mine, sp = 0u;
    for (;;) {
        sum = 0u; cnt = 0u; mine = 0u;
#pragma unroll
        for (unsigned j = 0; j < 16; ++j) { const unsigned c = xb_ld(&bar[XB_XCNT(j)]); sum += c; cnt += (c > 0u) ? 1u : 0u; mine = (j == x) ? c : mine; }
        if (sum == G) break;
        __builtin_amdgcn_s_sleep(1);
        if ((++sp & 255u) == 0u) { if (xb_ld(&bar[XB_TMO])) break; if (sp > XB_SPIN_CAP) { atomicAdd(&bar[XB_TMO], 1u); break; } }
    }
    nloc = mine > 0u ? mine : 1u; nx = cnt > 0u ? cnt : 1u;
}

__device__ __forceinline__ void xcd_barrier(const XcdBarrier& b) {
    asm volatile("s_waitcnt vmcnt(0)" ::: "memory");
    __syncthreads();
    if (threadIdx.x == 0) {
        unsigned* bar = b.bar;
        __builtin_amdgcn_s_waitcnt(0);
        unsigned nloc = b.st[0], nx = b.st[1];
        if (nloc == 0u) { xcd_barrier_complete(bar, b.x, nloc, nx); b.st[0] = nloc; b.st[1] = nx; }
        const unsigned old = xb_add(&bar[XB_XSUB(b.x)], 1u);
        const unsigned gen = old / nloc;
        if (old + 1u == (gen + 1u) * nloc) {
            __builtin_amdgcn_fence(__ATOMIC_RELEASE, "agent");
            asm volatile("s_waitcnt vmcnt(0)" ::: "memory");
            const unsigned og = xb_add(&bar[XB_TOP], 1u);
            const unsigned tg = og / nx;
            if (og + 1u == (tg + 1u) * nx) xb_add(&bar[XB_TOPGEN], 1u);
            else XB_SPIN(xb_ld(&bar[XB_TOPGEN]) == tg, bar);
            __builtin_amdgcn_fence(__ATOMIC_ACQUIRE, "agent");
            xb_add(&bar[XB_XGEN(b.x)], 1u);
            asm volatile("s_waitcnt vmcnt(0)" ::: "memory");
        } else {
            XB_SPIN(xb_ld(&bar[XB_XGEN(b.x)]) == gen, bar);
            __builtin_amdgcn_fence(__ATOMIC_ACQUIRE, "agent");
            asm volatile("s_waitcnt vmcnt(0)" ::: "memory");
        }
    }
    __syncthreads();
}

struct Args { MP p; long flags; };
__global__ void __launch_bounds__(NTHR, 2) mk_fwd(Args a) {
    extern __shared__ __attribute__((aligned(16))) unsigned char lds[];
    LAS unsigned char* const L3 = (LAS unsigned char*)lds;
    volatile LAS unsigned* MISC = (volatile LAS unsigned*)(L3 + MISC_OFF);
    const MP& p = a.p;
    const int tid = threadIdx.x;
    for (int u = tid; u < (LDS_BYTES - LDSCTL_OFF) / 4; u += NTHR) ((LAS unsigned*)(L3 + LDSCTL_OFF))[u] = 0u;
    __syncthreads();
    const XcdBarrier bar = xcd_barrier_post(p.ctl + CW_BAR, MISC + 8);
    const int G = gridDim.x, bx = blockIdx.x;
    const long gs = (long)G * NTHR;
#define g0 ((long)bx * NTHR + mk_tid())
#ifndef PROBE_MASK
#define PROBE_MASK 0
#endif
#define REP(k) for (int rep_ = 0; rep_ < ((PROBE_MASK >> (k)) & 1) + 1; ++rep_)
#define GRID_BAR() do { REP(10) xcd_barrier(bar); } while (0)
#define PH_BEGIN(id) TP_BEGIN(id, L3)
#define PH_END(id) TP_END(id, L3)
    PH_BEGIN(0); REP(0) fp::prologue(p, L3, bx, G);
    GRID_BAR(); PH_END(0);
    for (int L = 0; L < DEPTH; ++L) {
        const int j = L >> 1; const bool moe = (L & 1) != 0;
        bf16* const hcur = (L & 1) ? p.HB2 : p.HB; bf16* const hnxt = (L & 1) ? p.HB : p.HB2;
        PH_BEGIN(1);
        REP(1) {
            pg8::Gemm g{hcur, p.WIN + (size_t)L * NU * D, (int)p.T, NU, D, D}; pg8::StaticOrder S; S.init((int)p.T, NU, G, bx);
            pg8::rstd_table(L3, rss_ptr(p, L, 0), S);
            pg8::EpiStore16 E{p.U, NU, (const LAS float*)(L3 + pg8::RSTD_TAB_OFF)}; pg8::gemm_phase<pg8::EpiStore16, pg8::StaticOrder, true, true>(L3, g, S, E);
            pg8::Gemm g2{p.PB16 + (size_t)L * p.T * PLE, p.WPP + (size_t)L * D * PLE, (int)p.T, D, PLE, PLE}; pg8::UpperHalfOrder S2; S2.init2((int)p.T, D, G, bx);
            pg8::EpiStore16 E2{p.PJ, D, nullptr}; pg8::gemm_phase<pg8::EpiStore16, pg8::UpperHalfOrder, true, true>(L3, g2, S2, E2);
        }
        GRID_BAR(); PH_END(1); PH_BEGIN(2);
        REP(6) { PH_BEGIN(13); fp::conv_module(p, L, L3, bx, G); PH_END(13); PH_BEGIN(14); fp::mla_proj(p, L, L3, bx, G); PH_END(14); PH_BEGIN(15); fp::ssd_a(p, L, L3, bx, G); PH_END(15); }
        GRID_BAR(); PH_END(2); PH_BEGIN(3);
        REP(7) { PH_BEGIN(16); fp::ssd_scan(p, bx, G); PH_END(16); PH_BEGIN(17); fp::attn_phase(p, L3, bx, G); PH_END(17); }
        GRID_BAR(); PH_END(3); PH_BEGIN(4);
        REP(8) fp::ssd_c(p, L, L3, bx, G);
        GRID_BAR(); PH_END(4); PH_BEGIN(5);
        {
            pg8::Gemm g{p.YC, p.WOUT + (size_t)L * D * D, (int)p.T, D, D, D}; pg8::StaticOrder S; S.init((int)p.T, D, G, bx);
            pg8::EpiAddH E{hcur, D, rss_ptr(p, L, 1)}; pg8::gemm_phase<pg8::EpiAddH, pg8::StaticOrder, true, true>(L3, g, S, E);
        }
        GRID_BAR(); PH_END(5);
        if (moe) { PH_BEGIN(6); fp::norm_phase<1>(p, L, p.ffn_g + L * D, hcur, bx, G, (LAS unsigned*)L3); GRID_BAR(); PH_END(6); PH_BEGIN(7); fp::moeplan(p, L, L3, bx, G); GRID_BAR(); PH_END(7); }
        PH_BEGIN(8);
        {
            const int rows = moe ? moe_start_of(p, j, NE) : (int)p.T;
            pg8::Gemm g{moe ? p.XB : hcur, moe ? p.MWGU + (size_t)j * NE * NGU * D : p.DWGU + (size_t)j * NGU * D, rows, NGU, D, D};
            pg8::ExpertOrder S; S.init(rows, NGU, G, bx); S.tile_e = moe ? p.TILE_E : nullptr;
            if (!moe) pg8::rstd_table(L3, rss_ptr(p, L, 1), S);
            REP(3) { pg8::EpiSwiglu E{p.ACT, DFF, moe ? (const LAS float*)nullptr : (const LAS float*)(L3 + pg8::RSTD_TAB_OFF)}; pg8::gemm_phase<pg8::EpiSwiglu, pg8::ExpertOrder, true, true>(L3, g, S, E); }
            GRID_BAR(); PH_END(8); PH_BEGIN(9);
            if (moe) {
                const int nwg = (rows >> 8) * 4, nfull = (nwg / G) * G, R = nwg - nfull; const int ksn = (R == 0) ? 1 : (R * 4 <= G && R <= 20 ? 4 : (R * 2 <= G && R <= 64 ? 2 : 1));
                const bf16* Wd = p.MWD + (size_t)j * NE * D * DFF; pg8::EpiMoeDown Ed{p.YS, hnxt, (size_t)R * 256 * 1024, (nfull >> 2) * 256};
                { pg8::Gemm gd{p.ACT, Wd, rows, D, DFF, DFF}; pg8::MoeDownOrder Sd{nwg, nfull, G, bx, 0, 0, p.TILE_E}; REP(4) pg8::gemm_phase<pg8::EpiMoeDown, pg8::MoeDownOrder, true, true>(L3, gd, Sd, Ed); }
                if (R > 0) { pg8::Gemm gd{p.ACT, Wd, rows, D, DFF / ksn, DFF}; pg8::MoeDownOrder Sd{nwg, nfull, G, bx, ksn, DFF / ksn, p.TILE_E}; pg8::gemm_phase<pg8::EpiMoeDown, pg8::MoeDownOrder, true, true>(L3, gd, Sd, Ed); }
                if (bx == 0 && mk_tid() == 0) { p.TILE_E[1000] = (nfull >> 2) * 256; p.TILE_E[1001] = ksn; p.TILE_E[1002] = R * 256; }
            } else {
                pg8::Gemm gd{p.ACT, p.DWD + (size_t)j * D * DFF, rows, D, DFF, DFF}; pg8::StaticOrder Sd; Sd.init(rows, D, G, bx);
                REP(4) { pg8::EpiAddH Ed{hcur, D, rss_ptr(p, L, 2)}; pg8::gemm_phase<pg8::EpiAddH, pg8::StaticOrder, true, true>(L3, gd, Sd, Ed); }
            }
        }
        GRID_BAR(); PH_END(9);
        if (moe) { PH_BEGIN(10); fp::norm_phase<2>(p, L, nullptr, hcur, bx, G, nullptr, hnxt); GRID_BAR(); PH_END(10); }
        PH_BEGIN(11);
        {
            pg8::Gemm g{hcur, p.WPG + (size_t)L * D * D, (int)p.T, D, D, D}; pg8::StaticOrder S; S.init((int)p.T, D, G, bx);
            pg8::rstd_table(L3, rss_ptr(p, L, 2), S);
            pg8::EpiPleF E{hcur, hnxt, p.PJ, D, (const LAS float*)(L3 + pg8::RSTD_TAB_OFF), rss_ptr(p, L + 1, 0)}; pg8::gemm_phase<pg8::EpiPleF, pg8::StaticOrder, true, true>(L3, g, S, E);
        }
        GRID_BAR(); PH_END(11);
    }
    PH_BEGIN(12); fp::norm_phase<3>(p, 0, p.fin_g, p.HB, bx, G); PH_END(12);
    if (PROBE_T && bx == 0 && tid == 0) { const unsigned long long te_ = __builtin_amdgcn_s_memrealtime() + 4ull * MISC[2]; while (__builtin_amdgcn_s_memrealtime() < te_) __builtin_amdgcn_s_sleep(8); }
}
static void fill_params(MP& p, void* const* d_in, void* d_out, void* d_ws) {
    p.x = (const float*)d_in[0]; p.p = (const float*)d_in[1]; p.pos = (const int*)d_in[2];
    const float** w = &p.attn_g; for (int i = 3; i < 32; ++i) w[i - 3] = (const float*)d_in[i];
    p.out = (float*)d_out; p.B = 8; p.S = 2048; p.T = 16384; p.NSLOT = 2 * 16384 + 8 * 256;
    carve(p, (unsigned char*)d_ws);
}
extern "C" void kernel_launch(void* const* d_in, const int* in_sizes, int n_in, void* d_out, int out_size, void* d_ws, size_t ws_size, hipStream_t stream) {
    static int grid = 0;
    if (grid == 0) {
        MP q{}; q.T = 16384; q.NSLOT = 2 * 16384 + 8 * 256; const size_t need = carve(q, nullptr);
        if (n_in != 32 || ws_size < need) { fprintf(stderr, "kernel_launch: need %zu bytes of ws, have %zu (n_in %d)\n", need, ws_size, n_in); grid = -1; return; }
        int dev = 0, cus = 0, per_cu = 0;
        if (hipGetDevice(&dev) != hipSuccess || hipDeviceGetAttribute(&cus, hipDeviceAttributeMultiprocessorCount, dev) != hipSuccess) { grid = -1; return; }
        if (hipFuncSetAttribute((const void*)mk_fwd, hipFuncAttributeMaxDynamicSharedMemorySize, LDS_BYTES) != hipSuccess) { fprintf(stderr, "kernel_launch: hipFuncSetAttribute failed\n"); grid = -1; return; }
        if (hipOccupancyMaxActiveBlocksPerMultiprocessor(&per_cu, (const void*)mk_fwd, NTHR, LDS_BYTES) != hipSuccess || per_cu < 1) { fprintf(stderr, "kernel_launch: occupancy query says %d\n", per_cu); }
        (void)hipGetLastError();
        grid = cus;
    }
    if (grid < 0) return;
    Args a{}; fill_params(a.p, d_in, d_out, d_ws); a.flags = 0;
    if (hipMemsetAsync(a.p.ctl, 0, CTL_WORDS * 4, stream) != hipSuccess) return;
    hipLaunchKernelGGL(mk_fwd, dim3(grid), dim3(NTHR), LDS_BYTES, stream, a);
}
```

```cpp
#include <hip/hip_runtime.h>
#include <cstdio>
#include <cstdint>
__device__ __forceinline__ int mk_tid() { int t = threadIdx.x; asm volatile("" : "+v"(t)); return t; }
#ifndef PROBE_T
#define PROBE_T 0
#endif
#ifndef PROBE_CK
#define PROBE_CK 0
#endif
constexpr int LDS_BYTES = 163840, LDSCTL_OFF = LDS_BYTES - 512, MISC_OFF = LDSCTL_OFF + 320;
#define TP_MISC(l3) ((volatile __attribute__((address_space(3))) unsigned*)((l3) + MISC_OFF))
#define TP_BEGIN(id, l3) do { if (((PROBE_T >> (id)) & 1) && blockIdx.x == 0 && threadIdx.x == 0) { const unsigned long long t_ = __builtin_amdgcn_s_memrealtime(); TP_MISC(l3)[0] = (unsigned)t_; TP_MISC(l3)[1] = (unsigned)(t_ >> 32); } } while (0)
#define TP_END(id, l3) do { if (((PROBE_T >> (id)) & 1) && blockIdx.x == 0 && threadIdx.x == 0) { const unsigned long long t0_ = ((unsigned long long)TP_MISC(l3)[1] << 32) | TP_MISC(l3)[0]; TP_MISC(l3)[2] += (unsigned)(__builtin_amdgcn_s_memrealtime() - t0_); } } while (0)

#include <cstring>
#include <cmath>
#include <cstdint>
#ifdef __HIPCC__
#define HD __host__ __device__ __forceinline__
#else
#define HD inline
#endif
typedef unsigned short bf16;
namespace mdl {
constexpr int D = 1024, DEPTH = 4, NU = 2560, NUO = 2472, DFF = 3584, NGU = 7168, NE = 8, PLE = 256;
constexpr int CK = 31, SCONV = 4, CHUNK = 128, NH = 8, HP = 64, NS = 128;
constexpr float RMS_EPS = 1e-6f, LN_EPS = 1e-5f;
constexpr float QSCALE = 0.10206207261596577f * 1.4426950408889634f;
constexpr int U_Z = 512, U_XBC = 1024, U_CQ = 2048, U_CKV = 2304, U_KR = 2432, U_DT = 2464;

HD float bf2f(bf16 v) { unsigned u = (unsigned)v << 16; float f; memcpy(&f, &u, 4); return f; }
HD bf16 f2bf(float f) { unsigned u; memcpy(&u, &f, 4); u += 0x7fffu + ((u >> 16) & 1u); return (bf16)(u >> 16); }
HD float sigmoidf_(float x) { return 1.0f / (1.0f + expf(-x)); }
HD float siluf_(float x) { return x / (1.0f + expf(-x)); }
HD float softplusf_(float x) { return x > 20.f ? x : log1pf(expf(x)); }
HD int ucol_src(int n) { return n < 2048 ? n : (n < U_DT ? n + 8 : (n < NUO ? n - U_DT + 2048 : -1)); }

struct MP {
    const float *x, *p; const int* pos;
    const float *attn_g, *w_in, *cdw_w, *cdw_b, *cln_g, *cln_b, *sconv_w, *sconv_b, *dt_bias, *a_log, *dskip, *snorm_g, *qn_g, *w_uq, *kvn_g, *w_ukv,
        *w_out, *ffn_g, *dwg, *dwu, *dwd, *router, *mwg, *mwu, *mwd, *ple_g, *ple_wg, *ple_wp, *fin_g;
    float* out;
    long B, S, T, NSLOT;
    unsigned* ctl;
    bf16 *WIN, *WUQ, *WUKV, *WOUT, *DWGU, *DWD, *MWGU, *MWD, *WPG, *WPP;
    float *RSSP, *H, *CS, *DT, *ACS, *ST, *CB, *YPRE, *TOPG;
    bf16 *HB2, *HB, *U, *YC, *Q, *KK, *V, *XS, *BM, *CM, *YD, *PV, *PB16, *PJ, *ACT, *XB, *YS;
    int *TOPE, *POS, *TOKSLOT, *TILE_E, *BCNT;
};
constexpr int CTL_WORDS = 65536;
HD unsigned* cnt_ptr(const MP& p, int j) { return p.ctl + 1024 + j * 64; }
HD float* rss_ptr(const MP& p, int L, int k) { return p.RSSP + (size_t)(L * 3 + k) * p.T * 16; }

inline size_t carve(MP& p, unsigned char* ws) {
    size_t o = 0; const size_t T = p.T, NSL = p.NSLOT;
    auto take = [&](size_t bytes) { size_t r = o; o += (bytes + 255) & ~(size_t)255; return ws + r; };
    p.ctl = (unsigned*)take(CTL_WORDS * 4);
    p.WIN = (bf16*)take((size_t)DEPTH * NU * D * 2); p.WUQ = (bf16*)take((size_t)DEPTH * 512 * 256 * 2); p.WUKV = (bf16*)take((size_t)DEPTH * 512 * 128 * 2);
    p.WOUT = (bf16*)take((size_t)DEPTH * D * D * 2); p.DWGU = (bf16*)take((size_t)2 * NGU * D * 2); p.DWD = (bf16*)take((size_t)2 * D * DFF * 2);
    p.MWGU = (bf16*)take((size_t)2 * NE * NGU * D * 2); p.MWD = (bf16*)take((size_t)2 * NE * D * DFF * 2);
    p.WPG = (bf16*)take((size_t)DEPTH * D * D * 2); p.WPP = (bf16*)take((size_t)DEPTH * D * PLE * 2);
    p.RSSP = (float*)take((size_t)13 * T * 16 * 4); p.H = (float*)take(T * D * 4); p.HB = (bf16*)take(T * D * 2); p.HB2 = (bf16*)take(T * D * 2); p.CS = (float*)take(T * 32 * 4);
    p.PB16 = (bf16*)take((size_t)DEPTH * T * PLE * 2); p.PJ = (bf16*)take(T * D * 2);
    p.TOPE = (int*)take(T * 2 * 4); p.TOPG = (float*)take(T * 2 * 4); p.POS = (int*)take(T * 2 * 4); p.TOKSLOT = (int*)take(T * 2 * 4); p.TILE_E = (int*)take(1024 * 4); p.BCNT = (int*)take(1024 * NE * 4);
    p.XB = (bf16*)take(NSL * D * 2); p.YS = p.XB;
    const size_t r1 = o;
    p.U = (bf16*)take(T * NU * 2); p.YC = (bf16*)take(T * D * 2); p.Q = (bf16*)take(T * 384 * 2); p.KK = (bf16*)take(T * 384 * 2); p.V = (bf16*)take(T * 256 * 2);
    p.XS = (bf16*)take(T * 512 * 2); p.BM = (bf16*)take(T * 256 * 2); p.CM = (bf16*)take(T * 256 * 2); p.YD = (bf16*)take(T * 512 * 2);
    p.DT = (float*)take(T * 8 * 4); p.ACS = (float*)take(T * 8 * 4); p.ST = (float*)take(T / CHUNK * NH * HP * NS * 4); p.PV = (bf16*)take(T / CHUNK * NH * HP * NS * 2);
    p.CB = nullptr; p.YPRE = nullptr;
    const size_t r1end = o; o = r1;
    p.ACT = (bf16*)take(NSL * DFF * 2);
    if (o < r1end) o = r1end;
    return o;
}

struct V8 { float v[8]; };
HD V8 ld8(const bf16* p) { V8 r; const uint4 u = *(const uint4*)p; const unsigned w[4] = {u.x, u.y, u.z, u.w};
    for (int i = 0; i < 4; ++i) { r.v[2 * i] = bf2f((bf16)(w[i] & 0xffff)); r.v[2 * i + 1] = bf2f((bf16)(w[i] >> 16)); } return r; }
HD float dot8(const V8& a, const V8& b) { float s = 0.f; for (int i = 0; i < 8; ++i) s += a.v[i] * b.v[i]; return s; }

template <class Epi> HD void gemm_nt(const bf16* A, long lda, const bf16* Bt, long ldb, long M, long N, long K, const Epi& epi, long g0, long gs) {
    const long ntn = N / 4, ntile = (M / 4) * ntn;
    for (long t = g0; t < ntile; t += gs) {
        const long m0 = (t / ntn) * 4, n0 = (t % ntn) * 4; float acc[4][4];
        for (int i = 0; i < 4; ++i) for (int j = 0; j < 4; ++j) acc[i][j] = 0.f;
        for (long k = 0; k < K; k += 8) { V8 a0 = ld8(A + (m0 + 0) * lda + k), a1 = ld8(A + (m0 + 1) * lda + k), a2 = ld8(A + (m0 + 2) * lda + k), a3 = ld8(A + (m0 + 3) * lda + k);
            V8 b0 = ld8(Bt + (n0 + 0) * ldb + k), b1 = ld8(Bt + (n0 + 1) * ldb + k), b2 = ld8(Bt + (n0 + 2) * ldb + k), b3 = ld8(Bt + (n0 + 3) * ldb + k);
            acc[0][0] += dot8(a0, b0); acc[0][1] += dot8(a0, b1); acc[0][2] += dot8(a0, b2); acc[0][3] += dot8(a0, b3);
            acc[1][0] += dot8(a1, b0); acc[1][1] += dot8(a1, b1); acc[1][2] += dot8(a1, b2); acc[1][3] += dot8(a1, b3);
            acc[2][0] += dot8(a2, b0); acc[2][1] += dot8(a2, b1); acc[2][2] += dot8(a2, b2); acc[2][3] += dot8(a2, b3);
            acc[3][0] += dot8(a3, b0); acc[3][1] += dot8(a3, b1); acc[3][2] += dot8(a3, b2); acc[3][3] += dot8(a3, b3); }
        epi(m0 + 0, n0 + 0, acc[0][0]); epi(m0 + 0, n0 + 1, acc[0][1]); epi(m0 + 0, n0 + 2, acc[0][2]); epi(m0 + 0, n0 + 3, acc[0][3]);
        epi(m0 + 1, n0 + 0, acc[1][0]); epi(m0 + 1, n0 + 1, acc[1][1]); epi(m0 + 1, n0 + 2, acc[1][2]); epi(m0 + 1, n0 + 3, acc[1][3]);
        epi(m0 + 2, n0 + 0, acc[2][0]); epi(m0 + 2, n0 + 1, acc[2][1]); epi(m0 + 2, n0 + 2, acc[2][2]); epi(m0 + 2, n0 + 3, acc[2][3]);
        epi(m0 + 3, n0 + 0, acc[3][0]); epi(m0 + 3, n0 + 1, acc[3][1]); epi(m0 + 3, n0 + 2, acc[3][2]); epi(m0 + 3, n0 + 3, acc[3][3]);
    }
}
struct EpiStoreBf { bf16* C; long ldc; HD void operator()(long m, long n, float v) const { C[m * ldc + n] = f2bf(v); } };
struct EpiAddF32 { float* C; long ldc; HD void operator()(long m, long n, float v) const { C[m * ldc + n] += v; } };
struct EpiPle { float* H; const bf16* PJ; HD void operator()(long m, long n, float v) const { H[m * D + n] += bf2f(PJ[m * D + n]) * sigmoidf_(v); } };

HD void tr_elem(const float* W, long K, long N, bf16* WT, long i) { const long n = i / K, k = i % K; WT[i] = f2bf(W[k * N + n]); }
HD void nv_prologue(const MP& p, long g0, long gs) {
    const long T = p.T;
    for (long i = g0; i < (long)DEPTH * NU * D; i += gs) { const long l = i / ((long)NU * D), r = i % ((long)NU * D), n = r / D, k = r % D; const int c = ucol_src((int)n);
        p.WIN[i] = c < 0 ? (bf16)0 : f2bf(p.w_in[(l * D + k) * NUO + c]); }
    for (long i = g0; i < (long)DEPTH * 512 * 256; i += gs) { const long l = i / (512 * 256), r = i % (512 * 256), n = r / 256, k = r % 256; p.WUQ[i] = n < 384 ? f2bf(p.w_uq[(l * 256 + k) * 384 + n]) : (bf16)0; }
    for (long i = g0; i < (long)DEPTH * 512 * 128; i += gs) { const long l = i / (512 * 128), r = i % (512 * 128), n = r / 128, k = r % 128; p.WUKV[i] = f2bf(p.w_ukv[(l * 128 + k) * 512 + n]); }
    for (long i = g0; i < (long)DEPTH * D * D; i += gs) { const long l = i / ((long)D * D); tr_elem(p.w_out + l * D * D, D, D, p.WOUT + l * D * D, i % ((long)D * D)); tr_elem(p.ple_wg + l * D * D, D, D, p.WPG + l * D * D, i % ((long)D * D)); }
    for (long i = g0; i < (long)DEPTH * D * PLE; i += gs) { const long l = i / ((long)D * PLE); tr_elem(p.ple_wp + l * PLE * D, PLE, D, p.WPP + l * D * PLE, i % ((long)D * PLE)); }
    for (long i = g0; i < (long)18 * NGU * D; i += gs) { const long mt = i / ((long)NGU * D), r = i % ((long)NGU * D), n = r / D, k = r % D, tl = n / 256, rr = n % 256, col = tl * 128 + (rr & 127);
        const float* src; bf16* dst;
        if (mt < 2) { src = (rr < 128 ? p.dwg : p.dwu) + mt * (long)D * DFF; dst = p.DWGU + mt * (long)NGU * D; } else { src = (rr < 128 ? p.mwg : p.mwu) + (mt - 2) * (long)D * DFF; dst = p.MWGU + (mt - 2) * (long)NGU * D; }
        dst[r] = f2bf(src[k * DFF + col]); }
    for (long i = g0; i < (long)18 * D * DFF; i += gs) { const long mt = i / ((long)D * DFF), r = i % ((long)D * DFF);
        if (mt < 2) tr_elem(p.dwd + mt * (long)DFF * D, DFF, D, p.DWD + mt * (long)D * DFF, r); else tr_elem(p.mwd + (mt - 2) * (long)DFF * D, DFF, D, p.MWD + (mt - 2) * (long)D * DFF, r); }
    for (long i = g0; i < T * D; i += gs) p.H[i] = p.x[i];
    for (long i = g0; i < (long)DEPTH * T * PLE; i += gs) p.PB16[i] = f2bf(p.p[i]);
    for (long i = g0; i < T * 16; i += gs) { const long t = i / 16; const int j = (int)(i % 16); const float inv = powf(10000.0f, -(float)(2 * j) / 32.0f), ang = (float)p.pos[t] * inv;
        p.CS[t * 32 + j] = cosf(ang); p.CS[t * 32 + 16 + j] = sinf(ang); }
}
HD void nv_norm(const MP& p, const float* g, long g0, long gs) {
    for (long t = g0; t < p.T; t += gs) { const float* h = p.H + t * D; float ss = 0.f; for (int i = 0; i < D; ++i) ss += h[i] * h[i];
        const float r = 1.0f / sqrtf(ss / D + RMS_EPS); for (int i = 0; i < D; ++i) p.HB[t * D + i] = f2bf(h[i] * r * g[i]); }
}
HD void nv_inproj(const MP& p, int L, long g0, long gs) {
    gemm_nt(p.HB, D, p.WIN + (long)L * NU * D, D, p.T, NU, D, EpiStoreBf{p.U, NU}, g0, gs);
    gemm_nt(p.PB16 + (long)L * p.T * PLE, PLE, p.WPP + (long)L * D * PLE, PLE, p.T, D, PLE, EpiStoreBf{p.PJ, D}, g0, gs);
}
HD float cm_conv(const MP& p, int L, long b, long s, int c) {
    float acc = p.cdw_b[L * 256 + c];
    for (int j = 0; j < CK; ++j) { const long sp = s - (CK - 1) + j; if (sp < 0) continue; const bf16* u = p.U + (b * p.S + sp) * NU;
        acc += p.cdw_w[(L * CK + j) * 256 + c] * (bf2f(u[c]) * sigmoidf_(bf2f(u[256 + c]))); }
    return acc;
}
HD void nv_mixA1(const MP& p, int L, long g0, long gs, int parts = 15) {
    const long T = p.T, S = p.S;
    if (parts & 1) for (long i = g0; i < T * 4; i += gs) { const long t = i / 4, b = t / S, s = t % S; const int gq = (int)(i % 4);
        float sm = 0.f, sq = 0.f; for (int c = 0; c < 64; ++c) { const float v = cm_conv(p, L, b, s, gq * 64 + c); sm += v; sq += v * v; }
        const float mu = sm / 64.f; float var = sq / 64.f - mu * mu; if (var < 0.f) var = 0.f; const float rs = 1.0f / sqrtf(var + LN_EPS);
        for (int c = 0; c < 64; ++c) { const int ch = gq * 64 + c; const float v = (cm_conv(p, L, b, s, ch) - mu) * rs * p.cln_g[L * 256 + ch] + p.cln_b[L * 256 + ch]; p.YC[t * D + ch] = f2bf(siluf_(v)); } }
    if (parts & 2) for (long i = g0; i < T * 1024; i += gs) { const long t = i / 1024, b = t / S, s = t % S; const int c = (int)(i % 1024);
        float acc = p.sconv_b[L * 1024 + c]; for (int j = 0; j < SCONV; ++j) { const long sp = s - (SCONV - 1) + j; if (sp < 0) continue; acc += p.sconv_w[(L * SCONV + j) * 1024 + c] * bf2f(p.U[(b * S + sp) * NU + U_XBC + c]); }
        const bf16 v = f2bf(siluf_(acc)); if (c < 512) p.XS[t * 512 + c] = v; else if (c < 768) p.BM[t * 256 + c - 512] = v; else p.CM[t * 256 + c - 768] = v; }
    if (parts & 2) for (long i = g0; i < T * 8; i += gs) { const long t = i / 8; const int h = (int)(i % 8); p.DT[i] = softplusf_(bf2f(p.U[t * NU + U_DT + h]) + p.dt_bias[L * 8 + h]); }
    if (parts & 8) for (long i = g0; i < T * 4 * 80; i += gs) { const long t = i / 320; const int h = (int)((i % 320) / 80), ii = (int)(i % 80); const bf16* cq = p.U + t * NU + U_CQ;
        float ss = 0.f; for (int k = 0; k < 256; ++k) { const float v = bf2f(cq[k]); ss += v * v; } const float r = 1.0f / sqrtf(ss / 256.f + RMS_EPS);
        const bf16* W = p.WUQ + (long)L * 512 * 256;
        if (ii < 64) { const int n = h * 96 + ii; float a = 0.f; for (int k = 0; k < 256; ++k) a += bf2f(f2bf(bf2f(cq[k]) * r * p.qn_g[L * 256 + k])) * bf2f(W[n * 256 + k]); p.Q[t * 384 + n] = f2bf(a * QSCALE); }
        else { const int j = ii - 64, n1 = h * 96 + 64 + j, n2 = n1 + 16; float a1 = 0.f, a2 = 0.f;
            for (int k = 0; k < 256; ++k) { const float xv = bf2f(f2bf(bf2f(cq[k]) * r * p.qn_g[L * 256 + k])); a1 += xv * bf2f(W[n1 * 256 + k]); a2 += xv * bf2f(W[n2 * 256 + k]); }
            const float c = p.CS[t * 32 + j], sn = p.CS[t * 32 + 16 + j]; p.Q[t * 384 + n1] = f2bf((a1 * c - a2 * sn) * QSCALE); p.Q[t * 384 + n2] = f2bf((a1 * sn + a2 * c) * QSCALE); } }
    if (parts & 8) for (long i = g0; i < T * 512; i += gs) { const long t = i / 512; const int n = (int)(i % 512); const bf16* ck = p.U + t * NU + U_CKV;
        float ss = 0.f; for (int k = 0; k < 128; ++k) { const float v = bf2f(ck[k]); ss += v * v; } const float r = 1.0f / sqrtf(ss / 128.f + RMS_EPS);
        const bf16* W = p.WUKV + (long)L * 512 * 128; float a = 0.f; for (int k = 0; k < 128; ++k) a += bf2f(f2bf(bf2f(ck[k]) * r * p.kvn_g[L * 128 + k])) * bf2f(W[n * 128 + k]);
        const int h = n / 128, d = n % 128; if (d < 64) p.KK[t * 384 + h * 96 + d] = f2bf(a); else p.V[t * 256 + h * 64 + d - 64] = f2bf(a); }
    if (parts & 8) for (long i = g0; i < T * 16; i += gs) { const long t = i / 16; const int j = (int)(i % 16); const float x1 = bf2f(p.U[t * NU + U_KR + j]), x2 = bf2f(p.U[t * NU + U_KR + 16 + j]), c = p.CS[t * 32 + j], sn = p.CS[t * 32 + 16 + j];
        const bf16 o1 = f2bf(x1 * c - x2 * sn), o2 = f2bf(x1 * sn + x2 * c); for (int h = 0; h < 4; ++h) { p.KK[t * 384 + h * 96 + 64 + j] = o1; p.KK[t * 384 + h * 96 + 80 + j] = o2; } }
}
HD void nv_mixA2(const MP& p, int L, long g0, long gs) {
    const long NC = p.T / CHUNK;
    for (long i = g0; i < NC * 8; i += gs) { const long c = i / 8; const int h = (int)(i % 8); const float a = -expf(p.a_log[L * 8 + h]); float cs = 0.f;
        for (int l = 0; l < CHUNK; ++l) { const long t = c * CHUNK + l; cs += p.DT[t * 8 + h] * a; p.ACS[t * 8 + h] = cs; } }
}
HD void nv_mixA3a(const MP& p, long g0, long gs) {
    const long NC = p.T / CHUNK;
    for (long i = g0; i < NC * 2 * CHUNK * CHUNK; i += gs) { const long u = i / (CHUNK * CHUNK), c = u / 2; const int g = (int)(u % 2), l = (int)((i / CHUNK) % CHUNK), s = (int)(i % CHUNK);
        const bf16* cm = p.CM + (c * CHUNK + l) * 256 + g * 128; const bf16* bm = p.BM + (c * CHUNK + s) * 256 + g * 128; float a = 0.f; for (int n = 0; n < 128; ++n) a += bf2f(cm[n]) * bf2f(bm[n]); p.CB[i] = a; }
}
HD void nv_mixA3b(const MP& p, long g0, long gs) {
    const long T = p.T, NC = T / CHUNK;
    for (long i = g0; i < T * 512; i += gs) { const long t = i / 512, c = t / CHUNK; const int ch = (int)(i % 512), h = ch / 64, g = h / 4, l = (int)(t % CHUNK);
        const float* cb = p.CB + ((c * 2 + g) * CHUNK + l) * CHUNK; const float al = p.ACS[t * 8 + h]; float a = 0.f;
        for (int s = 0; s <= l; ++s) { const long ts = c * CHUNK + s; a += cb[s] * expf(al - p.ACS[ts * 8 + h]) * p.DT[ts * 8 + h] * bf2f(p.XS[ts * 512 + ch]); }
        p.YD[i] = f2bf(a); }
    for (long i = g0; i < NC * 8 * 64 * 128; i += gs) { const long c = i / (8 * 64 * 128); const int h = (int)((i / (64 * 128)) % 8), pp = (int)((i / 128) % 64), n = (int)(i % 128), g = h / 4;
        const float alast = p.ACS[(c * CHUNK + CHUNK - 1) * 8 + h]; float a = 0.f;
        for (int l = 0; l < CHUNK; ++l) { const long t = c * CHUNK + l; a += bf2f(p.BM[t * 256 + g * 128 + n]) * expf(alast - p.ACS[t * 8 + h]) * p.DT[t * 8 + h] * bf2f(p.XS[t * 512 + h * 64 + pp]); }
        p.ST[i] = a; }
}
HD void nv_mixB1(const MP& p, long g0, long gs) {
    const long NCB = p.S / CHUNK;
    for (long i = g0; i < p.B * 8 * 64 * 128; i += gs) { const long b = i / (8 * 64 * 128); const long r = i % (8 * 64 * 128); const int h = (int)(r / (64 * 128)); float carry = 0.f;
        for (long cc = 0; cc < NCB; ++cc) { const long c = b * NCB + cc; const long idx = c * (8 * 64 * 128) + r; p.PV[idx] = f2bf(carry); carry = carry * expf(p.ACS[(c * CHUNK + CHUNK - 1) * 8 + h]) + p.ST[idx]; } }
}
HD void nv_attn(const MP& p, long g0, long gs) {
    const long T = p.T, S = p.S;
    for (long i = g0; i < T * 4; i += gs) { const long t = i / 4, b = t / S, s = t % S; const int h = (int)(i % 4);
        float q[96], o[64]; for (int d = 0; d < 96; ++d) q[d] = bf2f(p.Q[t * 384 + h * 96 + d]); for (int d = 0; d < 64; ++d) o[d] = 0.f; float m = -1e30f, l = 0.f;
        for (long k = 0; k <= s; ++k) { const long tk = b * S + k; const bf16* kk = p.KK + tk * 384 + h * 96; float sc = 0.f; for (int d = 0; d < 96; ++d) sc += q[d] * bf2f(kk[d]);
            const float mn = sc > m ? sc : m, f = exp2f(m - mn), pr = exp2f(sc - mn); l = l * f + pr; const bf16* vv = p.V + tk * 256 + h * 64; for (int d = 0; d < 64; ++d) o[d] = o[d] * f + pr * bf2f(vv[d]); m = mn; }
        for (int d = 0; d < 64; ++d) p.YC[t * D + 768 + h * 64 + d] = f2bf(o[d] / l); }
}
HD void nv_mixC1(const MP& p, int L, long g0, long gs) {
    const long T = p.T;
    for (long i = g0; i < T * 512; i += gs) { const long t = i / 512, c = t / CHUNK; const int ch = (int)(i % 512), h = ch / 64, pp = ch % 64, g = h / 4;
        const bf16* cm = p.CM + t * 256 + g * 128; const bf16* pv = p.PV + ((c * 8 + h) * 64 + pp) * 128; float a = 0.f; for (int n = 0; n < 128; ++n) a += bf2f(cm[n]) * bf2f(pv[n]);
        const float y = a * expf(p.ACS[t * 8 + h]) + bf2f(p.YD[i]) + p.dskip[L * 8 + h] * bf2f(p.XS[i]); p.YPRE[i] = y * siluf_(bf2f(p.U[t * NU + U_Z + ch])); }
}
HD void nv_mixC2(const MP& p, int L, long g0, long gs) {
    for (long i = g0; i < p.T * 2; i += gs) { const long t = i / 2; const int g = (int)(i % 2); const float* y = p.YPRE + t * 512 + g * 256; float ss = 0.f; for (int k = 0; k < 256; ++k) ss += y[k] * y[k];
        const float r = 1.0f / sqrtf(ss / 256.f + RMS_EPS); for (int k = 0; k < 256; ++k) p.YC[t * D + 256 + g * 256 + k] = f2bf(y[k] * r * p.snorm_g[L * 512 + g * 256 + k]); }
}
HD void nv_outproj(const MP& p, int L, long g0, long gs) { gemm_nt(p.YC, D, p.WOUT + (long)L * D * D, D, p.T, D, D, EpiAddF32{p.H, D}, g0, gs); }
HD void nv_router(const MP& p, int L, long g0, long gs) {
    const int j = L / 2; const float* R = p.router + (long)j * D * NE; const float* g = p.ffn_g + L * D; unsigned* cnt = cnt_ptr(p, j);
    for (long t = g0; t < p.T; t += gs) { const float* h = p.H + t * D; float ss = 0.f; for (int i = 0; i < D; ++i) ss += h[i] * h[i]; const float r = 1.0f / sqrtf(ss / D + RMS_EPS);
        float lg[NE]; for (int e = 0; e < NE; ++e) lg[e] = 0.f; for (int i = 0; i < D; ++i) { const float v = h[i] * r * g[i]; for (int e = 0; e < NE; ++e) lg[e] += v * R[i * NE + e]; }
        int e0 = 0; float v0 = lg[0]; for (int e = 1; e < NE; ++e) if (lg[e] > v0) { v0 = lg[e]; e0 = e; }
        int e1 = -1; float v1 = -3.0e38f; for (int e = 0; e < NE; ++e) if (e != e0 && lg[e] > v1) { v1 = lg[e]; e1 = e; }
        const float g1 = 1.0f / (1.0f + expf(v0 - v1)), gg0 = 1.0f - g1; p.TOPE[t * 2] = e0; p.TOPE[t * 2 + 1] = e1; p.TOPG[t * 2] = gg0; p.TOPG[t * 2 + 1] = g1;
#ifdef __HIP_DEVICE_COMPILE__
        p.POS[t * 2] = (int)atomicAdd(cnt + e0, 1u); p.POS[t * 2 + 1] = (int)atomicAdd(cnt + e1, 1u);
#else
        p.POS[t * 2] = (int)__atomic_fetch_add(cnt + e0, 1u, __ATOMIC_RELAXED); p.POS[t * 2 + 1] = (int)__atomic_fetch_add(cnt + e1, 1u, __ATOMIC_RELAXED);
#endif
    }
}
HD int moe_start_of(const MP& p, int j, int E) { const unsigned* cnt = cnt_ptr(p, j); int o = 0; for (int e = 0; e < NE; ++e) if (e < E) o += (int)((cnt[e] + 255u) / 256u) * 256; return o; }
HD void nv_moeplan(const MP& p, int L, long g0, long gs) {
    const int j = L / 2;
    for (long i = g0; i < p.T * 2; i += gs) { const long t = i / 2; const int slot = moe_start_of(p, j, p.TOPE[i]) + p.POS[i]; p.TOKSLOT[i] = slot; for (int k = 0; k < D; ++k) p.XB[(long)slot * D + k] = p.HB[t * D + k]; }
    for (long i = g0; i < 1024; i += gs) { int e = -1; if (i * 256 < moe_start_of(p, j, NE)) { e = 0; for (int q = 1; q < NE; ++q) if (i * 256 >= moe_start_of(p, j, q)) e = q; } p.TILE_E[i] = e; }
}
HD void nv_gateup(const MP& p, int L, long g0, long gs) {
    const int j = L / 2; const bool moe = L & 1; long rows = p.T; const bf16* Ain = p.HB;
    if (moe) { rows = moe_start_of(p, j, NE); Ain = p.XB; }
    for (long i = g0; i < (rows / 4) * DFF; i += gs) { const long m0 = (i / DFF) * 4; const int jj = (int)(i % DFF); const int e = moe ? p.TILE_E[m0 / 256] : 0;
        const bf16* W = moe ? p.MWGU + ((long)j * NE + e) * NGU * D : p.DWGU + (long)j * NGU * D; const long rg = (jj / 128) * 256 + (jj % 128), ru = rg + 128; float ag[4] = {0, 0, 0, 0}, au[4] = {0, 0, 0, 0};
        for (int k = 0; k < D; k += 8) { const V8 wg = ld8(W + rg * D + k), wu = ld8(W + ru * D + k); for (int r = 0; r < 4; ++r) { const V8 a = ld8(Ain + (m0 + r) * D + k); ag[r] += dot8(a, wg); au[r] += dot8(a, wu); } }
        for (int r = 0; r < 4; ++r) p.ACT[(m0 + r) * DFF + jj] = f2bf(siluf_(ag[r]) * au[r]); }
}
struct EpiYs { bf16* C; HD void operator()(long m, long n, float v) const { C[m * D + n] = f2bf(v); } };
HD void nv_down(const MP& p, int L, long g0, long gs) {
    const int j = L / 2;
    if (!(L & 1)) { gemm_nt(p.ACT, DFF, p.DWD + (long)j * D * DFF, DFF, p.T, D, DFF, EpiAddF32{p.H, D}, g0, gs); return; }
    const long rows = moe_start_of(p, j, NE);
    for (long tl = 0; tl < rows / 256; ++tl) { const int e = p.TILE_E[tl]; gemm_nt(p.ACT + tl * 256 * DFF, DFF, p.MWD + ((long)j * NE + e) * D * DFF, DFF, 256, D, DFF, EpiYs{p.YS + tl * 256 * D}, g0, gs); }
}
HD void nv_norm3(const MP& p, int L, long g0, long gs) {
    const float* g = p.ple_g + L * D;
    for (long t = g0; t < p.T; t += gs) { float* h = p.H + t * D;
        if (L & 1) { const bf16* y0 = p.YS + (long)p.TOKSLOT[t * 2] * D; const bf16* y1 = p.YS + (long)p.TOKSLOT[t * 2 + 1] * D; const float a = p.TOPG[t * 2], b = p.TOPG[t * 2 + 1]; for (int i = 0; i < D; ++i) h[i] += a * bf2f(y0[i]) + b * bf2f(y1[i]); }
        float ss = 0.f; for (int i = 0; i < D; ++i) ss += h[i] * h[i]; const float r = 1.0f / sqrtf(ss / D + RMS_EPS); for (int i = 0; i < D; ++i) p.HB[t * D + i] = f2bf(h[i] * r * g[i]); }
}
HD void nv_ple(const MP& p, int L, long g0, long gs) { gemm_nt(p.HB, D, p.WPG + (long)L * D * D, D, p.T, D, D, EpiPle{p.H, p.PJ}, g0, gs); }
HD void nv_final(const MP& p, long g0, long gs) {
    for (long t = g0; t < p.T; t += gs) { const float* h = p.H + t * D; float ss = 0.f; for (int i = 0; i < D; ++i) ss += h[i] * h[i]; const float r = 1.0f / sqrtf(ss / D + RMS_EPS); for (int i = 0; i < D; ++i) p.out[t * D + i] = h[i] * r * p.fin_g[i]; }
}
enum { NV_PROLOGUE = 0, NV_NORM1, NV_INPROJ, NV_A1, NV_A2, NV_A3A, NV_A3B, NV_B1, NV_ATTN, NV_C1, NV_C2, NV_OUTPROJ, NV_NORM2, NV_ROUTER, NV_MOEPLAN, NV_GATEUP, NV_DOWN, NV_NORM3, NV_PLE, NV_FINAL, NV_NPH };
HD void nv_run(const MP& p, int ph, int L, long g0, long gs) {
    switch (ph) {
    case NV_PROLOGUE: nv_prologue(p, g0, gs); break; case NV_NORM1: nv_norm(p, p.attn_g + L * D, g0, gs); break; case NV_INPROJ: nv_inproj(p, L, g0, gs); break;
    case NV_A1: nv_mixA1(p, L, g0, gs); break; case NV_A2: nv_mixA2(p, L, g0, gs); break; case NV_A3A: nv_mixA3a(p, g0, gs); break; case NV_A3B: nv_mixA3b(p, g0, gs); break;
    case NV_B1: nv_mixB1(p, g0, gs); break; case NV_ATTN: nv_attn(p, g0, gs); break; case NV_C1: nv_mixC1(p, L, g0, gs); break; case NV_C2: nv_mixC2(p, L, g0, gs); break;
    case NV_OUTPROJ: nv_outproj(p, L, g0, gs); break; case NV_NORM2: nv_norm(p, p.ffn_g + L * D, g0, gs); break; case NV_ROUTER: if (L & 1) nv_router(p, L, g0, gs); break;
    case NV_MOEPLAN: if (L & 1) nv_moeplan(p, L, g0, gs); break; case NV_GATEUP: nv_gateup(p, L, g0, gs); break; case NV_DOWN: nv_down(p, L, g0, gs); break;
    case NV_NORM3: nv_norm3(p, L, g0, gs); break; case NV_PLE: nv_ple(p, L, g0, gs); break; case NV_FINAL: nv_final(p, g0, gs); break; }
}
}

namespace pg8 {
#define PG8_LAS __attribute__((address_space(3)))
typedef unsigned short bf16_t;
typedef short bf16x8 __attribute__((ext_vector_type(8)));
typedef float f32x4 __attribute__((ext_vector_type(4)));
typedef unsigned u32x4 __attribute__((ext_vector_type(4)));
constexpr int BM = 256, BK = 64, HALF = 128, HTB = HALF * BK * 2  , STAGE_BYTES = 8 * HTB, NXCD = 8, WGM = 8;

__host__ __device__ __forceinline__ int lds_byte(int r, int c) { const int st = (r >> 4) * 2 + (c >> 5), rr = r & 15, cc = c & 31, ob = rr * 64 + cc * 2; return st * 1024 + (ob ^ (((ob >> 9) & 1) << 5)); }
__host__ __device__ __forceinline__ void stage_rc(int b, int& R, int& C) { const int st = b / 1024, sb = b % 1024, swz = sb ^ (((sb >> 9) & 1) << 5); R = (st >> 1) * 16 + swz / 64; C = (st & 1) * 32 + (swz % 64) / 2; }
__host__ __device__ __forceinline__ int perm32(int rho) { const int n = rho >> 4, i = rho & 15; return 8 * (i >> 2) + 4 * n + (i & 3); }

struct Unit { int pm, pn, cn, koff, ks, ui; };
struct Gemm { const bf16_t* A; const bf16_t* Bt; int M, N, K, ld; };

struct StaticOrder {
    int nM, nN, nwg, G, c;
    __host__ __device__ void init(int M, int N, int G_, int c_) { nM = M / BM; nN = N / BM; nwg = nM * nN; G = G_; c = c_; }
    __host__ __device__ bool next(int i, Unit& u) const {
        const int L = i * G + c; if (L >= nwg) return false;
        int wgid = L; { const int q = nwg / NXCD, r = nwg % NXCD, xcd = wgid % NXCD, off = wgid / NXCD; wgid = (xcd < r ? xcd * (q + 1) : r * (q + 1) + (xcd - r) * q) + off; }
        const int nig = WGM * nN, gid = wgid / nig, fm = gid * WGM, gsz = (nM - fm) < WGM ? (nM - fm) : WGM;
        u.pm = fm + ((wgid % nig) % gsz); u.pn = (wgid % nig) / gsz; u.cn = u.pn; u.koff = 0; u.ks = 0; u.ui = i; return true;
    }
    __device__ __forceinline__ void a_ready(const Unit&) const {}
    __device__ __forceinline__ void done(const Unit&) const {}
};
__device__ __forceinline__ unsigned cvt_pk_bf16(float lo, float hi) { unsigned r; asm volatile("v_cvt_pk_bf16_f32 %0, %1, %2" : "=v"(r) : "v"(lo), "v"(hi)); return r; }
typedef float f32x2 __attribute__((ext_vector_type(2)));
template <class Epi, class Sched, bool ALIGN_EPI = false, bool SP2 = false>
__device__ __forceinline__ void gemm_phase(PG8_LAS unsigned char* lds, const Gemm g, const Sched& S, const Epi& E) {
    if (Epi::TAG == PROBE_CK) TP_BEGIN(27, lds);
    const int tid = mk_tid(), wid = __builtin_amdgcn_readfirstlane(tid >> 6), lane = tid & 63, wr = wid >> 2, wc = wid & 3, fr = lane & 15, fq = lane >> 4;
    const int K = g.ld, nt = g.K / BK;
    unsigned voffA[2], voffB[2];
#pragma unroll
    for (int i = 0; i < 2; ++i) { int R, C; stage_rc(tid * 16 + i * 8192, R, C); const int Rb = Epi::PERM ? ((R & ~31) + perm32(R & 31)) : R;
        voffA[i] = (unsigned)(R * K + C) * 2u; voffB[i] = (unsigned)(Rb * K + C) * 2u; }
    const size_t kstep = (size_t)(BK * 2);
    const size_t hstep = (size_t)HALF * K * 2;
    const size_t tstep = 2 * hstep;
    const unsigned ldsw = (unsigned)wid * 1024u;
    const int aoff = lds_byte(wr * 64 + fr, fq * 8), boff = lds_byte(wc * 32 + fr, fq * 8);
#define PG8_SA(b, h) (((b) * 2 + (h)) * HTB)
#define PG8_SB(b, h) ((4 + (b) * 2 + (h)) * HTB)
#define PG8_STAGE(bufoff, gbase, voff) do { _Pragma("unroll") for (int _i = 0; _i < 2; ++_i) \
        __builtin_amdgcn_global_load_lds((const unsigned*)((const char*)(gbase) + (voff)[_i]), (PG8_LAS unsigned*)(lds + (bufoff) + ldsw + _i * 8192), 16, 0, 0); } while (0)
#define PG8_LDA(dst, b, h) do { _Pragma("unroll") for (int m = 0; m < 4; ++m) _Pragma("unroll") for (int k = 0; k < 2; ++k) dst[m][k] = *(const PG8_LAS bf16x8*)(lds + PG8_SA(b, h) + aoff + m * 2048 + k * 1024); } while (0)
#define PG8_LDB(dst, b, h) do { _Pragma("unroll") for (int n = 0; n < 2; ++n) _Pragma("unroll") for (int k = 0; k < 2; ++k) dst[n][k] = *(const PG8_LAS bf16x8*)(lds + PG8_SB(b, h) + boff + n * 2048 + k * 1024); } while (0)
#define PG8_MMA(ai, bj, At, Bt) do { __builtin_amdgcn_s_setprio(1); _Pragma("unroll") for (int m = 0; m < 4; ++m) _Pragma("unroll") for (int n = 0; n < 2; ++n) _Pragma("unroll") for (int k = 0; k < 2; ++k) \
        acc[ai][bj][m][n] = __builtin_amdgcn_mfma_f32_16x16x32_bf16(Bt[n][k], At[m][k], acc[ai][bj][m][n], 0, 0, 0); __builtin_amdgcn_s_setprio(0); } while (0)
#define PG8_WAIT_V(n) asm volatile("s_waitcnt vmcnt(" #n ")" ::: "memory")
#define PG8_WAIT_L(n) asm volatile("s_waitcnt lgkmcnt(" #n ")" ::: "memory")
#define PG8_BAR __builtin_amdgcn_s_barrier()
#define PG8_SCHED __builtin_amdgcn_sched_barrier(0)
    Unit cur, nxt; int ui = 0;
    if (!S.next(0, cur)) return;
    f32x4 acc[2][2][4][2];
#pragma unroll
    for (int a = 0; a < 2; ++a)
#pragma unroll
        for (int b = 0; b < 2; ++b)
#pragma unroll
            for (int m = 0; m < 4; ++m)
#pragma unroll
                for (int n = 0; n < 2; ++n) acc[a][b][m][n] = (f32x4){0.f, 0.f, 0.f, 0.f};
    bf16x8 At[4][2], B0[2][2], B1[2][2];
    const char* cA = (const char*)g.A + (size_t)cur.pm * tstep + (size_t)cur.koff * 2; const char* cB = (const char*)g.Bt + (size_t)cur.pn * tstep + (size_t)cur.koff * 2;
    S.a_ready(cur);
    if constexpr (SP2) {
        PG8_STAGE(PG8_SB(0, 0), cB, voffB); PG8_STAGE(PG8_SB(0, 1), cB + hstep, voffB); PG8_STAGE(PG8_SA(0, 0), cA, voffA); PG8_STAGE(PG8_SA(0, 1), cA + hstep, voffA);
        if (wr == 1) PG8_BAR;
        PG8_WAIT_V(2); PG8_BAR;
        PG8_STAGE(PG8_SB(1, 0), cB + kstep, voffB); PG8_STAGE(PG8_SA(1, 0), cA + kstep, voffA); PG8_STAGE(PG8_SB(1, 1), cB + hstep + kstep, voffB);
        PG8_WAIT_V(6); PG8_BAR;
    } else {
        PG8_STAGE(PG8_SB(0, 0), cB, voffB); PG8_STAGE(PG8_SA(0, 0), cA, voffA); PG8_STAGE(PG8_SB(0, 1), cB + hstep, voffB); PG8_STAGE(PG8_SA(0, 1), cA + hstep, voffA);
        if (wr == 1) PG8_BAR;
        PG8_WAIT_V(4); PG8_BAR;
        PG8_STAGE(PG8_SB(1, 0), cB + kstep, voffB); PG8_STAGE(PG8_SA(1, 0), cA + kstep, voffA); PG8_STAGE(PG8_SB(1, 1), cB + hstep + kstep, voffB);
        PG8_WAIT_V(6); PG8_BAR;
    }
    for (;;) {
        const bool has_next = S.next(ui + 1, nxt);
        const char* nA = has_next ? (const char*)g.A + (size_t)nxt.pm * tstep + (size_t)nxt.koff * 2 : cA; const char* nB = has_next ? (const char*)g.Bt + (size_t)nxt.pn * tstep + (size_t)nxt.koff * 2 : cB;
#pragma unroll 1
        for (int t = 0; t < nt; t += 2) {
            const bool last = (t == nt - 2);
            const char* a1 = cA + (size_t)(t + 1) * kstep;
            const char* a2 = last ? nA : cA + (size_t)(t + 2) * kstep; const char* b2 = last ? nB : cB + (size_t)(t + 2) * kstep;
            const char* a3 = a2 + kstep; const char* b3 = b2 + kstep;
            if (last && has_next) S.a_ready(nxt);
            if constexpr (SP2) {
            PG8_LDB(B0, 0, 0); PG8_LDB(B1, 0, 1); PG8_SCHED; PG8_LDA(At, 0, 0); PG8_STAGE(PG8_SA(1, 1), a1 + hstep, voffA);
            PG8_WAIT_V(8); PG8_WAIT_L(0); PG8_BAR; PG8_MMA(0, 0, At, B0); PG8_MMA(0, 1, At, B1); PG8_BAR; PG8_SCHED;
            PG8_LDA(At, 0, 1); PG8_STAGE(PG8_SB(0, 0), b2, voffB); PG8_STAGE(PG8_SB(0, 1), b2 + hstep, voffB); PG8_STAGE(PG8_SA(0, 0), a2, voffA);
            PG8_WAIT_V(8); PG8_WAIT_L(0); PG8_BAR; PG8_MMA(1, 0, At, B0); PG8_MMA(1, 1, At, B1); PG8_BAR; PG8_SCHED;
            PG8_LDB(B0, 1, 0); PG8_LDB(B1, 1, 1); PG8_SCHED; PG8_LDA(At, 1, 0); PG8_STAGE(PG8_SA(0, 1), a2 + hstep, voffA);
            PG8_WAIT_V(8); PG8_WAIT_L(0); PG8_BAR; PG8_MMA(0, 0, At, B0); PG8_MMA(0, 1, At, B1); PG8_BAR; PG8_SCHED;
            PG8_LDA(At, 1, 1); PG8_STAGE(PG8_SB(1, 0), b3, voffB); PG8_STAGE(PG8_SB(1, 1), b3 + hstep, voffB); PG8_STAGE(PG8_SA(1, 0), a3, voffA);
            PG8_WAIT_V(8); PG8_WAIT_L(0); PG8_BAR; PG8_MMA(1, 0, At, B0); PG8_MMA(1, 1, At, B1); PG8_BAR; PG8_SCHED;
            } else {
            PG8_LDB(B0, 0, 0); PG8_SCHED; PG8_LDA(At, 0, 0); PG8_STAGE(PG8_SA(1, 1), a1 + hstep, voffA);
            PG8_WAIT_L(8); PG8_BAR; PG8_WAIT_L(0); PG8_MMA(0, 0, At, B0); PG8_BAR; PG8_SCHED;
            PG8_LDB(B1, 0, 1); PG8_STAGE(PG8_SB(0, 0), b2, voffB);
            PG8_BAR; PG8_WAIT_L(0); PG8_MMA(0, 1, At, B1); PG8_BAR;
            PG8_LDA(At, 0, 1); PG8_STAGE(PG8_SA(0, 0), a2, voffA);
            PG8_BAR; PG8_WAIT_L(0); PG8_MMA(1, 0, At, B0); PG8_BAR; PG8_SCHED;
            PG8_STAGE(PG8_SB(0, 1), b2 + hstep, voffB);
            PG8_WAIT_V(6); PG8_BAR; PG8_MMA(1, 1, At, B1); PG8_BAR;
            PG8_LDB(B0, 1, 0); PG8_SCHED; PG8_LDA(At, 1, 0); PG8_STAGE(PG8_SA(0, 1), a2 + hstep, voffA);
            PG8_WAIT_L(8); PG8_BAR; PG8_WAIT_L(0); PG8_MMA(0, 0, At, B0); PG8_BAR; PG8_SCHED;
            PG8_LDB(B1, 1, 1); PG8_STAGE(PG8_SB(1, 0), b3, voffB);
            PG8_BAR; PG8_WAIT_L(0); PG8_MMA(0, 1, At, B1); PG8_BAR;
            PG8_LDA(At, 1, 1); PG8_STAGE(PG8_SA(1, 0), a3, voffA);
            PG8_BAR; PG8_WAIT_L(0); PG8_MMA(1, 0, At, B0); PG8_BAR; PG8_SCHED;
            PG8_STAGE(PG8_SB(1, 1), b3 + hstep, voffB);
            PG8_WAIT_V(6); PG8_BAR; PG8_MMA(1, 1, At, B1); PG8_BAR;
            }
        }
        TP_BEGIN(26, lds); if constexpr (ALIGN_EPI) { if (wr == 0) PG8_BAR; } TP_END(26, lds);
        if (Epi::TAG == PROBE_CK) TP_BEGIN(25, lds); if constexpr (!Epi::AFTER_DRAIN) { E(acc, cur, wr, wc, fr, fq); S.done(cur); } if (((PROBE_T >> 25) & 1) && Epi::TAG == PROBE_CK) { asm volatile("s_waitcnt vmcnt(0)" ::: "memory"); TP_END(25, lds); }
        if (!has_next) break;
#pragma unroll
        for (int a = 0; a < 2; ++a)
#pragma unroll
            for (int b = 0; b < 2; ++b)
#pragma unroll
                for (int m = 0; m < 4; ++m)
#pragma unroll
                    for (int n = 0; n < 2; ++n) acc[a][b][m][n] = (f32x4){0.f, 0.f, 0.f, 0.f};
        cur = nxt; cA = nA; cB = nB; ++ui;
        if constexpr (ALIGN_EPI) { if (wr == 1) PG8_BAR; }
    }
    PG8_WAIT_V(0);
    if constexpr (!ALIGN_EPI) { if (wr == 0) PG8_BAR; }
    PG8_BAR;
    if constexpr (Epi::AFTER_DRAIN) { E.fused(acc, cur, wr, wc, fr, fq, lds, wid, lane); S.done(cur); }
    if (Epi::TAG == PROBE_CK) TP_END(27, lds);
#undef PG8_SA
#undef PG8_SB
#undef PG8_STAGE
#undef PG8_LDA
#undef PG8_LDB
#undef PG8_MMA
#undef PG8_WAIT_V
#undef PG8_WAIT_L
#undef PG8_BAR
#undef PG8_SCHED
}
}

namespace pg8 {
__device__ __forceinline__ float fast_sigmoid(float x) { return __builtin_amdgcn_rcpf(1.0f + __builtin_amdgcn_exp2f(-1.4426950408889634f * x)); }
constexpr int RSTD_TAB_OFF = STAGE_BYTES, RSTD_MAX_UNITS = 8;
template <class Sched> __device__ __forceinline__ void rstd_table(PG8_LAS unsigned char* lds, const float* rss, const Sched& S) {
    PG8_LAS float* tab = (PG8_LAS float*)(lds + RSTD_TAB_OFF); const int tid = mk_tid(), r = tid & 255, par = __builtin_amdgcn_readfirstlane(tid >> 8);
    f32x4 q[4][4]; bool ok[4];
#pragma unroll
    for (int it = 0; it < 4; ++it) { Unit u; const int ui = 2 * it + par; ok[it] = S.next(ui, u);
        if (ok[it]) { const f32x4* src = (const f32x4*)(rss + ((size_t)u.pm * BM + r) * 16);
#pragma unroll
            for (int k = 0; k < 4; ++k) q[it][k] = src[k]; } }
#pragma unroll
    for (int it = 0; it < 4; ++it) if (ok[it]) { const f32x4 a = q[it][0], b = q[it][1], c = q[it][2], d = q[it][3];
        const float s = (((a[0] + a[1]) + (a[2] + a[3])) + ((b[0] + b[1]) + (b[2] + b[3]))) + (((c[0] + c[1]) + (c[2] + c[3])) + ((d[0] + d[1]) + (d[2] + d[3])));
        tab[(2 * it + par) * 256 + r] = 1.0f / sqrtf(s * (1.0f / 1024.f) + 1e-6f); }
    asm volatile("s_waitcnt lgkmcnt(0)" ::: "memory"); __syncthreads();
}
__device__ __forceinline__ void rstd8(const PG8_LAS float* tab, int ui, int rl0, float (&rs)[8]) {
    if (!tab) {
#pragma unroll
        for (int i = 0; i < 8; ++i) rs[i] = 1.0f;
        return; }
#pragma unroll
    for (int i = 0; i < 8; ++i) rs[i] = tab[ui * 256 + rl0 + (i >> 2) * HALF + (i & 3) * 16];
}
struct EpiStore16 {
    static constexpr bool PERM = true, AFTER_DRAIN = false; static constexpr int TAG = 3;
    bf16_t* O; int ldc; const PG8_LAS float* tab;
    __device__ __forceinline__ void operator()(const f32x4 (&acc)[2][2][4][2], const Unit& u, int wr, int wc, int fr, int fq) const {
        const int row0 = u.pm * BM + wr * 64 + fr, col0 = u.cn * BM + wc * 32 + 8 * fq;
        float rs[8]; rstd8(tab, u.ui, wr * 64 + fr, rs);
#pragma unroll
        for (int ai = 0; ai < 2; ++ai)
#pragma unroll
            for (int m = 0; m < 4; ++m) { const int row = row0 + ai * HALF + m * 16; bf16_t* rowp = O + (size_t)row * ldc + col0; const float r = rs[ai * 4 + m];
#pragma unroll
                for (int bj = 0; bj < 2; ++bj) { const f32x4 v0 = acc[ai][bj][m][0] * r, v1 = acc[ai][bj][m][1] * r;
                    u32x4 w; w.x = cvt_pk_bf16(v0[0], v0[1]); w.y = cvt_pk_bf16(v0[2], v0[3]); w.z = cvt_pk_bf16(v1[0], v1[1]); w.w = cvt_pk_bf16(v1[2], v1[3]);
                    *(u32x4*)(rowp + bj * HALF) = w; } }
    }
};
__device__ __forceinline__ float sq8(const u32x4 w) { float s = 0.f;
#pragma unroll
    for (int i = 0; i < 4; ++i) { const float a = __uint_as_float(w[i] << 16), b = __uint_as_float(w[i] & 0xffff0000u); s += a * a + b * b; } return s; }
struct EpiAddH {
    static constexpr bool PERM = true, AFTER_DRAIN = false; static constexpr int TAG = 1;
    bf16_t* Hb; int ldc; float* rss_out;
    __device__ __forceinline__ void operator()(const f32x4 (&acc)[2][2][4][2], const Unit& u, int wr, int wc, int fr, int fq) const {
        const int row0 = u.pm * BM + wr * 64 + fr, col0 = u.cn * BM + wc * 32 + 8 * fq;
        u32x4 h[2][4][2];
#pragma unroll
        for (int ai = 0; ai < 2; ++ai)
#pragma unroll
            for (int m = 0; m < 4; ++m)
#pragma unroll
                for (int bj = 0; bj < 2; ++bj) h[ai][m][bj] = *(const u32x4*)(Hb + (size_t)(row0 + ai * HALF + m * 16) * ldc + col0 + bj * HALF);
        __builtin_amdgcn_sched_barrier(0);
#pragma unroll
        for (int ai = 0; ai < 2; ++ai)
#pragma unroll
            for (int m = 0; m < 4; ++m) { const int row = row0 + ai * HALF + m * 16; float ss = 0.f;
#pragma unroll
                for (int bj = 0; bj < 2; ++bj) { const u32x4 q = h[ai][m][bj]; const f32x4 a0 = acc[ai][bj][m][0], a1 = acc[ai][bj][m][1]; u32x4 w;
                    w.x = cvt_pk_bf16(__uint_as_float(q.x << 16) + a0[0], __uint_as_float(q.x & 0xffff0000u) + a0[1]); w.y = cvt_pk_bf16(__uint_as_float(q.y << 16) + a0[2], __uint_as_float(q.y & 0xffff0000u) + a0[3]);
                    w.z = cvt_pk_bf16(__uint_as_float(q.z << 16) + a1[0], __uint_as_float(q.z & 0xffff0000u) + a1[1]); w.w = cvt_pk_bf16(__uint_as_float(q.w << 16) + a1[2], __uint_as_float(q.w & 0xffff0000u) + a1[3]);
                    *(u32x4*)(Hb + (size_t)row * ldc + col0 + bj * HALF) = w; ss += sq8(w); }
                ss += __shfl_xor(ss, 16); ss += __shfl_xor(ss, 32);
                if (fq == 0) rss_out[(size_t)row * 16 + u.cn * 4 + wc] = ss; }
    }
};
struct EpiSwiglu {
    static constexpr bool PERM = true, AFTER_DRAIN = false; static constexpr int TAG = 4;
    bf16_t* O; int ldc; const PG8_LAS float* tab;
    __device__ __forceinline__ void operator()(const f32x4 (&acc)[2][2][4][2], const Unit& u, int wr, int wc, int fr, int fq) const {
        const int row0 = u.pm * BM + wr * 64 + fr, col0 = u.cn * HALF + wc * 32 + 8 * fq;
        float rs[8]; rstd8(tab, u.ui, wr * 64 + fr, rs);
#pragma unroll
        for (int ai = 0; ai < 2; ++ai)
#pragma unroll
            for (int m = 0; m < 4; ++m) { const int row = row0 + ai * HALF + m * 16; bf16_t* rowp = O + (size_t)row * ldc + col0; float o[8]; const float r = rs[ai * 4 + m];
#pragma unroll
                for (int n = 0; n < 2; ++n)
#pragma unroll
                    for (int j = 0; j < 4; ++j) { const float gt = acc[ai][0][m][n][j] * r, up = acc[ai][1][m][n][j] * r; o[n * 4 + j] = gt * fast_sigmoid(gt) * up; }
                u32x4 w; w.x = cvt_pk_bf16(o[0], o[1]); w.y = cvt_pk_bf16(o[2], o[3]); w.z = cvt_pk_bf16(o[4], o[5]); w.w = cvt_pk_bf16(o[6], o[7]);
                *(u32x4*)rowp = w; }
    }
};
struct EpiPleF {
    static constexpr bool PERM = true, AFTER_DRAIN = false; static constexpr int TAG = 2;
    const bf16_t* Hin; bf16_t* Hout; const bf16_t* PJ; int ldc; const PG8_LAS float* tab; float* rss_out;
    __device__ __forceinline__ void operator()(const f32x4 (&acc)[2][2][4][2], const Unit& u, int wr, int wc, int fr, int fq) const {
        const int row0 = u.pm * BM + wr * 64 + fr, col0 = u.cn * BM + wc * 32 + 8 * fq;
        float rs[8]; rstd8(tab, u.ui, wr * 64 + fr, rs);
#pragma unroll
        for (int ai = 0; ai < 2; ++ai) { u32x4 h[4][2], pj[4][2];
#pragma unroll
            for (int m = 0; m < 4; ++m)
#pragma unroll
                for (int bj = 0; bj < 2; ++bj) { const size_t off = (size_t)(row0 + ai * HALF + m * 16) * ldc + col0 + bj * HALF; h[m][bj] = *(const u32x4*)(Hin + off); pj[m][bj] = *(const u32x4*)(PJ + off); }
            __builtin_amdgcn_sched_barrier(0);
#pragma unroll
            for (int m = 0; m < 4; ++m) { const int row = row0 + ai * HALF + m * 16; const float r = rs[ai * 4 + m]; float ss = 0.f;
#pragma unroll
                for (int bj = 0; bj < 2; ++bj) { const u32x4 hh = h[m][bj], q = pj[m][bj]; u32x4 w;
#pragma unroll
                    for (int i = 0; i < 4; ++i) { const float a_lo = acc[ai][bj][m][i >> 1][(i & 1) * 2] * r, a_hi = acc[ai][bj][m][i >> 1][(i & 1) * 2 + 1] * r;
                        w[i] = cvt_pk_bf16(__uint_as_float(hh[i] << 16) + __uint_as_float(q[i] << 16) * fast_sigmoid(a_lo), __uint_as_float(hh[i] & 0xffff0000u) + __uint_as_float(q[i] & 0xffff0000u) * fast_sigmoid(a_hi)); }
                    *(u32x4*)(Hout + (size_t)row * ldc + col0 + bj * HALF) = w; ss += sq8(w); }
                ss += __shfl_xor(ss, 16); ss += __shfl_xor(ss, 32);
                if (fq == 0) rss_out[(size_t)row * 16 + u.cn * 4 + wc] = ss; }
            asm volatile("" ::: "memory"); }
    }
};
struct ExpertOrder : StaticOrder {
    const int* tile_e;
    __device__ __forceinline__ bool next(int i, Unit& u) const { if (!StaticOrder::next(i, u)) return false; if (tile_e) u.pn += tile_e[u.pm] * nN; return true; }
};
struct UpperHalfOrder : StaticOrder {
    __host__ __device__ void init2(int M, int N, int G_, int c_) { init(M, N, G_ / 2, c_ - G_ / 2); if (c_ < G_ / 2) c = nwg; }
};
struct MoeDownOrder {
    int nwg, nfull, G, c, ks_n, kslice; const int* tile_e;
    __device__ __forceinline__ bool next(int i, Unit& u) const {
        const int q = i * G + c; int L;
        if (ks_n == 0) { L = q; if (L >= nfull) return false; u.koff = 0; u.ks = 0; }
        else { if (q >= (nwg - nfull) * ks_n) return false; L = nfull + q / ks_n; u.ks = q % ks_n; u.koff = u.ks * kslice; }
        u.pm = L >> 2; u.cn = L & 3; u.pn = u.cn + tile_e[u.pm] * 4; u.ui = i; return true;
    }
    __device__ __forceinline__ void a_ready(const Unit&) const {}
    __device__ __forceinline__ void done(const Unit&) const {}
};
struct EpiMoeDown {
    static constexpr bool PERM = true, AFTER_DRAIN = false; static constexpr int TAG = 5;
    bf16_t* O; bf16_t* P; size_t pstride; int row0p;
    __device__ __forceinline__ void operator()(const f32x4 (&acc)[2][2][4][2], const Unit& u, int wr, int wc, int fr, int fq) const {
        const int col0 = u.cn * BM + wc * 32 + 8 * fq; const int rowt = u.pm * BM + wr * 64 + fr;
        bf16_t* base = u.ks == 0 ? O + (size_t)rowt * 1024 : P + (size_t)(u.ks - 1) * pstride + (size_t)(rowt - row0p) * 1024;
#pragma unroll
        for (int ai = 0; ai < 2; ++ai)
#pragma unroll
            for (int m = 0; m < 4; ++m) { bf16_t* rowp = base + (size_t)(ai * HALF + m * 16) * 1024 + col0;
#pragma unroll
                for (int bj = 0; bj < 2; ++bj) { const f32x4 v0 = acc[ai][bj][m][0], v1 = acc[ai][bj][m][1];
                    u32x4 w; w.x = cvt_pk_bf16(v0[0], v0[1]); w.y = cvt_pk_bf16(v0[2], v0[3]); w.z = cvt_pk_bf16(v1[0], v1[1]); w.w = cvt_pk_bf16(v1[2], v1[3]);
                    *(u32x4*)(rowp + bj * HALF) = w; } }
    }
};
}

namespace fp {
using namespace mdl;
#define FLAS __attribute__((address_space(3)))
typedef float f32x4 __attribute__((ext_vector_type(4)));
typedef float f32x2 __attribute__((ext_vector_type(2)));
typedef unsigned u32x4 __attribute__((ext_vector_type(4)));
typedef unsigned u32x2 __attribute__((ext_vector_type(2)));
typedef __bf16 bf16x2_t __attribute__((ext_vector_type(2)));
__device__ __forceinline__ unsigned pk2(float lo, float hi) { f32x2 v = {lo, hi}; bf16x2_t b = __builtin_convertvector(v, bf16x2_t); return __builtin_bit_cast(unsigned, b); }
__device__ __forceinline__ float blo(unsigned w) { return __uint_as_float(w << 16); }
__device__ __forceinline__ float bhi(unsigned w) { return __uint_as_float(w & 0xffff0000u); }
template <int CTRL, int ROWMASK> __device__ __forceinline__ float dpp_add(float v) {
    return v + __builtin_bit_cast(float, __builtin_amdgcn_update_dpp(0, __builtin_bit_cast(int, v), CTRL, ROWMASK, 0xF, false)); }
__device__ __forceinline__ float wave_sum(float v) {
    v = dpp_add<0xB1, 0xF>(v);
    v = dpp_add<0x4E, 0xF>(v);
    v = dpp_add<0x141, 0xF>(v);
    v = dpp_add<0x140, 0xF>(v);
    v = dpp_add<0x142, 0xA>(v);
    v = dpp_add<0x143, 0xC>(v);
    return __builtin_bit_cast(float, __builtin_amdgcn_readlane(__builtin_bit_cast(int, v), 63));
}
#define FP_LDS_WAIT() asm volatile("s_waitcnt lgkmcnt(0)" ::: "memory")
template <int ROWS, int ROWB, int PB, int NTHR_> __device__ __forceinline__ void tile_out(const FLAS unsigned char* st, unsigned char* gbase, size_t gpitch, int t) {
    constexpr int CPR = ROWB / 16, N = ROWS * CPR;
#pragma unroll
    for (int i0 = 0; i0 < N; i0 += NTHR_) { const int i = i0 + t; if (N % NTHR_ == 0 || i < N) { const int r = i / CPR, c = i % CPR; *(u32x4*)(gbase + (size_t)r * gpitch + c * 16) = *(const FLAS u32x4*)(st + r * PB + c * 16); } }
}

template <class Map> __device__ __forceinline__ void tr_item(const float* W, int Nsrc, const Map& map, bf16* WT, int K, int k0, int n0, FLAS float* scr, int lane, const float* gain = nullptr) {
    const int nl = lane & 31, c = map(n0 + nl), cc = lane & 7;
    f32x4 g0 = (f32x4){1.f, 1.f, 1.f, 1.f}, g1 = g0;
    if (gain) { g0 = *(const f32x4*)(gain + k0 + 8 * cc); g1 = *(const f32x4*)(gain + k0 + 8 * cc + 4); }
    float wv[32];
#pragma unroll
    for (int i = 0; i < 32; ++i) { const int kk = 2 * i + (lane >> 5); wv[i] = c >= 0 ? W[(size_t)(k0 + kk) * Nsrc + c] : 0.f; }
    __builtin_amdgcn_sched_barrier(0);
#pragma unroll
    for (int i = 0; i < 32; ++i) { const int kk = 2 * i + (lane >> 5); scr[kk * 33 + nl] = wv[i]; }
    FP_LDS_WAIT(); asm volatile("" ::: "memory");
#pragma unroll
    for (int j = 0; j < 4; ++j) { const int n = (lane >> 3) + 8 * j; const FLAS float* s = scr + (8 * cc) * 33 + n;
        u32x4 o; o.x = pk2(s[0 * 33] * g0.x, s[1 * 33] * g0.y); o.y = pk2(s[2 * 33] * g0.z, s[3 * 33] * g0.w); o.z = pk2(s[4 * 33] * g1.x, s[5 * 33] * g1.y); o.w = pk2(s[6 * 33] * g1.z, s[7 * 33] * g1.w);
        *(u32x4*)(WT + (size_t)(n0 + n) * K + k0 + 8 * cc) = o; }
    FP_LDS_WAIT(); asm volatile("" ::: "memory");
}
struct MapId { __device__ __forceinline__ int operator()(int n) const { return n; } };
struct MapLt { int lim; __device__ __forceinline__ int operator()(int n) const { return n < lim ? n : -1; } };
struct MapU { __device__ __forceinline__ int operator()(int n) const { return ucol_src(n); } };
struct MapOff { int off; __device__ __forceinline__ int operator()(int n) const { return n + off; } };
__device__ __forceinline__ void prologue(const MP& p, FLAS unsigned char* lds, int bx, int G) {
    const int tid = mk_tid(), lane = tid & 63, wave = __builtin_amdgcn_readfirstlane(tid >> 6);
    FLAS float* scr = (FLAS float*)(lds + wave * 16384);
    const int gw = bx * 8 + wave, NGW = G * 8;
    constexpr int I_WIN = (D / 64) * (NU / 32), I_UQ = 4 * 16, I_UKV = 2 * 16, I_DD = 16 * 32, I_PP = 4 * 32, I_GU = 16 * (NGU / 32), I_DN = (DFF / 64) * 32;
    constexpr int PER_L = I_WIN + I_UQ + I_UKV + 2 * I_DD + I_PP, NITEMS = DEPTH * PER_L + 18 * (I_GU + I_DN);
    for (int it = gw; it < NITEMS; it += NGW) {
        int r = it;
        if (r < DEPTH * PER_L) { const int l = r / PER_L; r %= PER_L;
            if (r < I_WIN) { tr_item(p.w_in + (size_t)l * D * NUO, NUO, MapU{}, p.WIN + (size_t)l * NU * D, D, 64 * (r / (NU / 32)), 32 * (r % (NU / 32)), scr, lane, p.attn_g + l * D); continue; } r -= I_WIN;
            if (r < I_UQ) { tr_item(p.w_uq + (size_t)l * 256 * 384, 384, MapLt{384}, p.WUQ + (size_t)l * 512 * 256, 256, 64 * (r / 16), 32 * (r % 16), scr, lane); continue; } r -= I_UQ;
            if (r < I_UKV) { tr_item(p.w_ukv + (size_t)l * 128 * 512, 512, MapId{}, p.WUKV + (size_t)l * 512 * 128, 128, 64 * (r / 16), 32 * (r % 16), scr, lane); continue; } r -= I_UKV;
            if (r < I_DD) { tr_item(p.w_out + (size_t)l * D * D, D, MapId{}, p.WOUT + (size_t)l * D * D, D, 64 * (r / 32), 32 * (r % 32), scr, lane); continue; } r -= I_DD;
            if (r < I_DD) { tr_item(p.ple_wg + (size_t)l * D * D, D, MapId{}, p.WPG + (size_t)l * D * D, D, 64 * (r / 32), 32 * (r % 32), scr, lane, p.ple_g + l * D); continue; } r -= I_DD;
            tr_item(p.ple_wp + (size_t)l * PLE * D, D, MapId{}, p.WPP + (size_t)l * D * PLE, PLE, 64 * (r / 32), 32 * (r % 32), scr, lane); continue; }
        r -= DEPTH * PER_L;
        if (r < 18 * I_GU) { const int mt = r / I_GU; r %= I_GU; const int k0 = 64 * (r / (NGU / 32)), n0 = 32 * (r % (NGU / 32)); const int tl = n0 / 256, rr = n0 % 256;
            const float* src; bf16* dst;
            if (mt < 2) { src = (rr < 128 ? p.dwg : p.dwu) + (size_t)mt * D * DFF; dst = p.DWGU + (size_t)mt * NGU * D; } else { src = (rr < 128 ? p.mwg : p.mwu) + (size_t)(mt - 2) * D * DFF; dst = p.MWGU + (size_t)(mt - 2) * NGU * D; }
            const int Lg = mt < 2 ? 2 * mt : 2 * ((mt - 2) >> 3) + 1;
            tr_item(src, DFF, MapOff{tl * 128 + (rr & 127) - n0}, dst, D, k0, n0, scr, lane, p.ffn_g + Lg * D); continue; }
        r -= 18 * I_GU;
        { const int mt = r / I_DN; r %= I_DN; const float* src; bf16* dst;
            if (mt < 2) { src = p.dwd + (size_t)mt * DFF * D; dst = p.DWD + (size_t)mt * D * DFF; } else { src = p.mwd + (size_t)(mt - 2) * DFF * D; dst = p.MWD + (size_t)(mt - 2) * D * DFF; }
            tr_item(src, D, MapId{}, dst, DFF, 64 * (r / 32), 32 * (r % 32), scr, lane); }
    }
    const long g0 = (long)bx * 512 + tid, gs = (long)G * 512;
    for (long t = gw; t < p.T; t += NGW) { const f32x4* xr = (const f32x4*)(p.x + t * D) + lane; u32x2* o = (u32x2*)(p.HB + t * D) + lane; float ss = 0.f;
#pragma unroll
        for (int j = 0; j < 4; ++j) { const f32x4 v = xr[64 * j]; u32x2 wv; wv.x = pk2(v.x, v.y); wv.y = pk2(v.z, v.w); o[64 * j] = wv; const float a = blo(wv.x), b = bhi(wv.x), c = blo(wv.y), d = bhi(wv.y); ss += (a * a + b * b) + (c * c + d * d); }
        ss = wave_sum(ss); if (lane < 16) rss_ptr(p, 0, 0)[t * 16 + lane] = lane == 0 ? ss : 0.f; }
    for (long i = g0; i < (long)DEPTH * p.T * PLE / 4; i += gs) { const f32x4 v = ((const f32x4*)p.p)[i]; u32x2 o; o.x = pk2(v.x, v.y); o.y = pk2(v.z, v.w); ((u32x2*)p.PB16)[i] = o; }
    for (long i = g0; i < p.T * 16; i += gs) { const long t = i / 16; const int j = (int)(i % 16); const float inv = powf(10000.0f, -(float)(2 * j) / 32.0f), ang = (float)p.pos[t] * inv;
        p.CS[t * 32 + j] = cosf(ang); p.CS[t * 32 + 16 + j] = sinf(ang); }
}
template <int MODE> __device__ __forceinline__ void norm_phase(const MP& p, int L, const float* g, bf16* hb, int bx, int G, FLAS unsigned* lcnt = nullptr, const bf16* part = nullptr) {
    const int tid = mk_tid(), lane = tid & 63, wave = __builtin_amdgcn_readfirstlane(tid >> 6);
    const int gw = bx * 8 + wave, NGW = G * 8;
    const f32x4* gr = (const f32x4*)g + lane;
    bf16* const HBN = (bf16*)p.H;
    f32x4 Rr[MODE == 1 ? 32 : 1];
    if (MODE == 1) { __syncthreads(); if (tid < NE) lcnt[tid] = 0u; __syncthreads(); const f32x4* R = (const f32x4*)(p.router + (size_t)(L >> 1) * D * NE);
#pragma unroll
        for (int j = 0; j < 4; ++j)
#pragma unroll
            for (int c = 0; c < 4; ++c) { const int idx = 4 * (lane + 64 * j) + c; Rr[(j * 4 + c) * 2] = R[idx * 2]; Rr[(j * 4 + c) * 2 + 1] = R[idx * 2 + 1]; } }
    for (long t = gw; t < p.T; t += NGW) {
        u32x2* hr = (u32x2*)(hb + t * D) + lane; f32x4 v[4];
#pragma unroll
        for (int j = 0; j < 4; ++j) { const u32x2 q = hr[64 * j]; v[j] = (f32x4){blo(q.x), bhi(q.x), blo(q.y), bhi(q.y)}; }
        if (MODE == 2) { const int sl[2] = {p.TOKSLOT[t * 2], p.TOKSLOT[t * 2 + 1]}; const float gt[2] = {p.TOPG[t * 2], p.TOPG[t * 2 + 1]};
            const int row0p = p.TILE_E[1000], ksn = p.TILE_E[1001]; const size_t pstride = (size_t)p.TILE_E[1002] * D;
#pragma unroll
            for (int k = 0; k < 2; ++k) { const u32x2* y0 = (const u32x2*)(p.YS + (size_t)sl[k] * D) + lane; u32x2 q[4];
#pragma unroll
                for (int j = 0; j < 4; ++j) q[j] = y0[64 * j];
                float acc[4][4];
#pragma unroll
                for (int j = 0; j < 4; ++j) { acc[j][0] = blo(q[j].x); acc[j][1] = bhi(q[j].x); acc[j][2] = blo(q[j].y); acc[j][3] = bhi(q[j].y); }
                if (sl[k] >= row0p) for (int s = 1; s < ksn; ++s) { const u32x2* yp = (const u32x2*)(part + (size_t)(s - 1) * pstride + (size_t)(sl[k] - row0p) * D) + lane;
#pragma unroll
                    for (int j = 0; j < 4; ++j) { const u32x2 r = yp[64 * j]; acc[j][0] += blo(r.x); acc[j][1] += bhi(r.x); acc[j][2] += blo(r.y); acc[j][3] += bhi(r.y); } }
#pragma unroll
                for (int j = 0; j < 4; ++j) { v[j].x += gt[k] * acc[j][0]; v[j].y += gt[k] * acc[j][1]; v[j].z += gt[k] * acc[j][2]; v[j].w += gt[k] * acc[j][3]; } }
#pragma unroll
            for (int j = 0; j < 4; ++j) { u32x2 wv; wv.x = pk2(v[j].x, v[j].y); wv.y = pk2(v[j].z, v[j].w); hr[64 * j] = wv; v[j] = (f32x4){blo(wv.x), bhi(wv.x), blo(wv.y), bhi(wv.y)}; } }
        float ss = 0.f;
#pragma unroll
        for (int j = 0; j < 4; ++j) ss += (v[j].x * v[j].x + v[j].y * v[j].y) + (v[j].z * v[j].z + v[j].w * v[j].w);
        ss = wave_sum(ss);
        const float r = 1.0f / sqrtf(ss * (1.0f / D) + RMS_EPS);
        if (MODE == 2) { if (lane < 16) rss_ptr(p, L, 2)[t * 16 + lane] = lane == 0 ? ss : 0.f; }
        if (MODE == 1) { u32x2* o = (u32x2*)(HBN + t * D) + lane;
#pragma unroll
            for (int j = 0; j < 4; ++j) { u32x2 w; w.x = pk2(v[j].x * r, v[j].y * r); w.y = pk2(v[j].z * r, v[j].w * r); o[64 * j] = w; } }
        if (MODE == 1 || MODE == 3) {
#pragma unroll
            for (int j = 0; j < 4; ++j) { const f32x4 gv = gr[64 * j]; v[j].x *= r * gv.x; v[j].y *= r * gv.y; v[j].z *= r * gv.z; v[j].w *= r * gv.w; } }
        if (MODE == 3) {
#pragma unroll
            for (int j = 0; j < 4; ++j) ((f32x4*)(p.out + t * D) + lane)[64 * j] = v[j];
        }
        if (MODE == 1) { float lg[NE];
#pragma unroll
            for (int e = 0; e < NE; ++e) lg[e] = 0.f;
#pragma unroll
            for (int j = 0; j < 4; ++j)
#pragma unroll
                for (int c = 0; c < 4; ++c) { const f32x4 r0 = Rr[(j * 4 + c) * 2], r1 = Rr[(j * 4 + c) * 2 + 1]; const float x = v[j][c];
                    lg[0] += x * r0.x; lg[1] += x * r0.y; lg[2] += x * r0.z; lg[3] += x * r0.w; lg[4] += x * r1.x; lg[5] += x * r1.y; lg[6] += x * r1.z; lg[7] += x * r1.w; }
#pragma unroll
            for (int e = 0; e < NE; ++e) lg[e] = wave_sum(lg[e]);
            int e0 = 0; float v0 = lg[0];
#pragma unroll
            for (int e = 1; e < NE; ++e) if (lg[e] > v0) { v0 = lg[e]; e0 = e; }
            int e1 = -1; float v1 = -3.0e38f;
#pragma unroll
            for (int e = 0; e < NE; ++e) if (e != e0 && lg[e] > v1) { v1 = lg[e]; e1 = e; }
            if (lane == 0) { const float g1 = 1.0f / (1.0f + expf(v0 - v1));
                p.TOPE[t * 2] = e0; p.TOPE[t * 2 + 1] = e1; p.TOPG[t * 2] = 1.0f - g1; p.TOPG[t * 2 + 1] = g1;
                p.POS[t * 2] = (int)__hip_atomic_fetch_add(lcnt + e0, 1u, __ATOMIC_RELAXED, __HIP_MEMORY_SCOPE_WORKGROUP); p.POS[t * 2 + 1] = (int)__hip_atomic_fetch_add(lcnt + e1, 1u, __ATOMIC_RELAXED, __HIP_MEMORY_SCOPE_WORKGROUP); } }
    }
    if (MODE == 1) { __syncthreads(); if (tid < NE) p.BCNT[bx * NE + tid] = (int)lcnt[tid]; }
}
__device__ __forceinline__ void moeplan(const MP& p, int L, FLAS unsigned char* lds, int bx, int G) {
    const int tid = mk_tid(), lane = tid & 63, wave = __builtin_amdgcn_readfirstlane(tid >> 6), j = L >> 1;
    const int gw = bx * 8 + wave, NGW = G * 8;
    FLAS int* base = (FLAS int*)lds;
    FLAS int* pst = (FLAS int*)(lds + 16384);
    __syncthreads();
    {
        const int e = wave; int c[4], s = 0;
#pragma unroll
        for (int i = 0; i < 4; ++i) { const int b = lane * 4 + i; c[i] = b < G ? p.BCNT[b * NE + e] : 0; s += c[i]; }
        int inc = s;
#pragma unroll
        for (int o = 1; o < 64; o <<= 1) { const int t = __shfl_up(inc, o); if (lane >= o) inc += t; }
        int ex = inc - s;
#pragma unroll
        for (int i = 0; i < 4; ++i) { const int b = lane * 4 + i; if (b < G) base[b * NE + e] = ex; ex += c[i]; }
        if (lane == 63) pst[e] = inc;
    }
    __syncthreads();
    if (tid == 0) { int o = 0; for (int e = 0; e < NE; ++e) { const int cnt = pst[e]; pst[e] = o; if (bx == 0) cnt_ptr(p, j)[e] = (unsigned)cnt; o += ((cnt + 255) / 256) * 256; } pst[NE] = o; }
    __syncthreads();
    for (long i = gw; i < p.T * 2; i += NGW) { const long t = i >> 1; const int e = p.TOPE[i], blk = (int)((t % NGW) >> 3); const int slot = pst[e] + base[blk * NE + e] + p.POS[i]; if (lane == 0) p.TOKSLOT[i] = slot;
        const u32x4* s = (const u32x4*)((const bf16*)p.H + t * D) + lane; u32x4* d = (u32x4*)(p.XB + (size_t)slot * D) + lane; const u32x4 a = s[0], b = s[64]; d[0] = a; d[64] = b; }
    if (bx == 0) for (int i = tid; i < 1024; i += 512) { int e = -1; if (i * 256 < pst[NE]) { e = 0; for (int q = 1; q < NE; ++q) if (i * 256 >= pst[q]) e = q; } p.TILE_E[i] = e; }
    __syncthreads();
}
typedef short bf16x8 __attribute__((ext_vector_type(8)));
typedef short bf16x4 __attribute__((ext_vector_type(4)));
constexpr int AT_KP = 104, AT_VP = 136, AT_KBYTES = 128 * AT_KP * 2, AT_BUF = AT_KBYTES + 80 * AT_VP * 2;
__device__ __forceinline__ void attn_phase(const MP& p, FLAS unsigned char* lds, int bx, int G) {
    const int S = (int)p.S, nunits = (int)p.B * 4 * 8;
    const int vcu = (G % 8 == 0) ? (bx % 8) * (G / 8) + bx / 8 : bx;
    { const int tid0 = mk_tid(); __syncthreads();
      for (int e = tid0; e < 2 * 16 * AT_VP; e += 512) { const int bufi = e / (16 * AT_VP), r = (e % (16 * AT_VP)) / AT_VP, c = e % AT_VP; ((FLAS bf16*)(lds + bufi * AT_BUF + AT_KBYTES))[(64 + r) * AT_VP + c] = r == 0 ? (bf16)0x3f80 : (bf16)0; } }
    for (int u = vcu; u < nunits; u += G) {
        const int tid = mk_tid(), lane = tid & 63, w = __builtin_amdgcn_readfirstlane(tid >> 6), fr = lane & 15, fq = lane >> 4;
        int kro[3], kco[3];
#pragma unroll
        for (int i = 0; i < 3; ++i) { const int c = tid + 512 * i; kro[i] = c / 12; kco[i] = c % 12; }
        const int vd = tid >> 4, vkc = tid & 15;
        const int bh = u >> 3, jp = u & 7, b = bh >> 2, h = bh & 3;
        const bf16* Kg = p.KK + (size_t)b * S * 384 + h * 96; const bf16* Vg = p.V + (size_t)bh * 64 * S;
        for (int half = 0; half < 2; ++half) {
            const int qb = half ? 15 - jp : jp, q0 = qb * 128, qmin = q0 + 16 * w, qglob = qmin + fr;
            const size_t trow = (size_t)b * S + qglob;
            bf16x8 qf[3];
#pragma unroll
            for (int ks = 0; ks < 3; ++ks) qf[ks] = *(const bf16x8*)(p.Q + trow * 384 + h * 96 + ks * 32 + fq * 8);
            f32x4 o[5];
#pragma unroll
            for (int dt = 0; dt < 5; ++dt) o[dt] = (f32x4){0.f, 0.f, 0.f, 0.f};
            float m = -1e30f;
            const int nkt = qb + 1;
            u32x4 rk[3], rv[2];
#define AT_LOAD(kt_) do { const size_t kb_ = (size_t)(kt_) * 128; _Pragma("unroll") for (int i = 0; i < 3; ++i) rk[i] = *(const u32x4*)(Kg + (kb_ + kro[i]) * 384 + kco[i] * 8); \
            _Pragma("unroll") for (int i = 0; i < 2; ++i) rv[i] = *(const u32x4*)(Vg + (size_t)(vd + 32 * i) * S + kb_ + vkc * 8); } while (0)
#define AT_WRITE(buf_) do { FLAS bf16* Kw = (FLAS bf16*)(lds + (buf_) * AT_BUF); FLAS bf16* Vw = (FLAS bf16*)(lds + (buf_) * AT_BUF + AT_KBYTES); \
            _Pragma("unroll") for (int i = 0; i < 3; ++i) *(FLAS u32x4*)(Kw + kro[i] * AT_KP + kco[i] * 8) = rk[i]; \
            _Pragma("unroll") for (int i = 0; i < 2; ++i) *(FLAS u32x4*)(Vw + (vd + 32 * i) * AT_VP + vkc * 8) = rv[i]; } while (0)
            AT_LOAD(0);
            __syncthreads();
            AT_WRITE(0);
            __syncthreads();
            for (int kt = 0; kt < nkt; ++kt) {
                const bool more = kt + 1 < nkt;
                TP_BEGIN(18, lds); if (more) AT_LOAD(kt + 1); TP_END(18, lds); TP_BEGIN(19, lds);
                const FLAS bf16* Ks = (const FLAS bf16*)(lds + (kt & 1) * AT_BUF); const FLAS bf16* Vt = (const FLAS bf16*)(lds + (kt & 1) * AT_BUF + AT_KBYTES);
                f32x4 s[8];
#pragma unroll
                for (int sub = 0; sub < 8; ++sub) { s[sub] = (f32x4){0.f, 0.f, 0.f, 0.f};
#pragma unroll
                    for (int ks = 0; ks < 3; ++ks) { const bf16x8 a = *(const FLAS bf16x8*)(Ks + (sub * 16 + fr) * AT_KP + ks * 32 + fq * 8); s[sub] = __builtin_amdgcn_mfma_f32_16x16x32_bf16(a, qf[ks], s[sub], 0, 0, 0); } }
                if (kt == qb) {
#pragma unroll
                    for (int sub = 0; sub < 8; ++sub)
#pragma unroll
                        for (int j = 0; j < 4; ++j) if (16 * sub + 4 * fq + j > 16 * w + fr) s[sub][j] = -1e30f; }
                float t0 = __builtin_fmaxf(__builtin_fmaxf(s[0][0], s[0][1]), s[0][2]), t1 = __builtin_fmaxf(__builtin_fmaxf(s[0][3], s[1][0]), s[1][1]);
                t0 = __builtin_fmaxf(__builtin_fmaxf(t0, s[1][2]), s[1][3]);
#pragma unroll
                for (int sub = 2; sub < 8; sub += 2) { t0 = __builtin_fmaxf(__builtin_fmaxf(t0, s[sub][0]), s[sub][1]); t1 = __builtin_fmaxf(__builtin_fmaxf(t1, s[sub][2]), s[sub][3]);
                    t0 = __builtin_fmaxf(__builtin_fmaxf(t0, s[sub + 1][0]), s[sub + 1][1]); t1 = __builtin_fmaxf(__builtin_fmaxf(t1, s[sub + 1][2]), s[sub + 1][3]); }
                float tmax = __builtin_fmaxf(t0, t1);
                tmax = __builtin_fmaxf(tmax, __shfl_xor(tmax, 16)); tmax = __builtin_fmaxf(tmax, __shfl_xor(tmax, 32));
                const float mn = __builtin_fmaxf(m, tmax), alpha = __builtin_amdgcn_exp2f(m - mn); m = mn;
#pragma unroll
                for (int sub = 0; sub < 8; ++sub)
#pragma unroll
                    for (int j = 0; j < 4; ++j) s[sub][j] = __builtin_amdgcn_exp2f(s[sub][j] - mn);
#pragma unroll
                for (int dt = 0; dt < 5; ++dt) o[dt] *= alpha;
#pragma unroll
                for (int k2 = 0; k2 < 4; ++k2) {
                    u32x4 pw; pw.x = pk2(s[2 * k2][0], s[2 * k2][1]); pw.y = pk2(s[2 * k2][2], s[2 * k2][3]); pw.z = pk2(s[2 * k2 + 1][0], s[2 * k2 + 1][1]); pw.w = pk2(s[2 * k2 + 1][2], s[2 * k2 + 1][3]);
                    const bf16x8 pf = __builtin_bit_cast(bf16x8, pw);
#pragma unroll
                    for (int dt = 0; dt < 5; ++dt) { const FLAS bf16* vp = Vt + (dt * 16 + fr) * AT_VP + 32 * k2 + 4 * fq;
                        const u32x2 v0 = *(const FLAS u32x2*)vp, v1 = *(const FLAS u32x2*)(vp + 16); u32x4 vw; vw.x = v0.x; vw.y = v0.y; vw.z = v1.x; vw.w = v1.y;
                        o[dt] = __builtin_amdgcn_mfma_f32_16x16x32_bf16(__builtin_bit_cast(bf16x8, vw), pf, o[dt], 0, 0, 0); } }
                TP_END(19, lds); TP_BEGIN(20, lds); if (more) AT_WRITE((kt + 1) & 1);
                __syncthreads(); TP_END(20, lds);
            }
#undef AT_LOAD
#undef AT_WRITE
            const float l = __shfl(o[4][0], fr);
            const float rl = 1.0f / l;
            FLAS unsigned char* ostg = lds + 2 * AT_BUF + w * (16 * 144);
#pragma unroll
            for (int dt = 0; dt < 4; ++dt) { u32x2 ow; ow.x = pk2(o[dt][0] * rl, o[dt][1] * rl); ow.y = pk2(o[dt][2] * rl, o[dt][3] * rl); *(FLAS u32x2*)(ostg + fr * 144 + (dt * 16 + 4 * fq) * 2) = ow; }
            FP_LDS_WAIT(); asm volatile("" ::: "memory");
            tile_out<16, 128, 144, 64>(ostg, (unsigned char*)(p.YC + ((size_t)b * S + qmin) * D + 768 + h * 64), (size_t)D * 2, lane);
            FP_LDS_WAIT(); asm volatile("" ::: "memory");
        }
    }
    __syncthreads();
}
__device__ __forceinline__ void conv_module(const MP& p, int L, FLAS unsigned char* lds, int bx, int G) {
    FLAS float* Gs = (FLAS float*)lds;
    const int S = (int)p.S, nchunk = S / 64, nitems = (int)p.B * nchunk;
    for (int it = bx; it < nitems; it += G) {
        const int tid = mk_tid(), lane = tid & 63, w = __builtin_amdgcn_readfirstlane(tid >> 6);
        const int ck = it % nchunk, b = it / nchunk, s0 = ck * 64;
        __syncthreads();
        const int ch = (w & 3) * 64 + lane, tb = (w >> 2) * 32; float wj[CK];
#pragma unroll
        for (int j = 0; j < CK; ++j) wj[j] = p.cdw_w[(L * CK + j) * 256 + ch];
        const float bias = p.cdw_b[L * 256 + ch], lg = p.cln_g[L * 256 + ch], lb = p.cln_b[L * 256 + ch];
        u32x4 rv[6], rg[6];
#pragma unroll
        for (int i = 0; i < 6; ++i) { const int idx = tid + 512 * i, row = idx >> 5, c = idx & 31, sp = s0 - 30 + row; rv[i] = (u32x4){0u, 0u, 0u, 0u}; rg[i] = rv[i];
            if (idx < 94 * 32 && sp >= 0) { const bf16* u = p.U + ((size_t)b * S + sp) * NU + c * 8; rv[i] = *(const u32x4*)u; rg[i] = *(const u32x4*)(u + 256); } }
        __builtin_amdgcn_sched_barrier(0);
#pragma unroll
        for (int i = 0; i < 6; ++i) { const int idx = tid + 512 * i, row = idx >> 5, c = idx & 31;
            if (idx < 94 * 32) { const unsigned v[4] = {rv[i].x, rv[i].y, rv[i].z, rv[i].w}, g[4] = {rg[i].x, rg[i].y, rg[i].z, rg[i].w}; f32x4 o0, o1;
                o0.x = blo(v[0]) / (1.0f + __expf(-blo(g[0]))); o0.y = bhi(v[0]) / (1.0f + __expf(-bhi(g[0]))); o0.z = blo(v[1]) / (1.0f + __expf(-blo(g[1]))); o0.w = bhi(v[1]) / (1.0f + __expf(-bhi(g[1])));
                o1.x = blo(v[2]) / (1.0f + __expf(-blo(g[2]))); o1.y = bhi(v[2]) / (1.0f + __expf(-bhi(g[2]))); o1.z = blo(v[3]) / (1.0f + __expf(-blo(g[3]))); o1.w = bhi(v[3]) / (1.0f + __expf(-bhi(g[3])));
                *(FLAS f32x4*)(Gs + row * 256 + c * 8) = o0; *(FLAS f32x4*)(Gs + row * 256 + c * 8 + 4) = o1; } }
        __syncthreads();
#pragma unroll 1
        for (int i8 = 0; i8 < 4; ++i8) { const int tl0 = tb + 8 * i8; float win[38], acc[8];
#pragma unroll
            for (int r = 0; r < 38; ++r) win[r] = Gs[(tl0 + r) * 256 + ch];
#pragma unroll
            for (int q = 0; q < 8; ++q) { float a = bias;
#pragma unroll
                for (int j = 0; j < CK; ++j) a += wj[j] * win[q + j];
                acc[q] = a; }
            float mu[8], var[8];
#pragma unroll
            for (int q = 0; q < 8; ++q) { mu[q] = wave_sum(acc[q]) * (1.0f / 64.f); acc[q] -= mu[q]; }
#pragma unroll
            for (int q = 0; q < 8; ++q) var[q] = wave_sum(acc[q] * acc[q]);
#pragma unroll
            for (int q = 0; q < 8; ++q) { const float hn = acc[q] * (1.0f / sqrtf(var[q] * (1.0f / 64.f) + LN_EPS)) * lg + lb; ((FLAS bf16*)(lds + 94 * 256 * 4 + w * (32 * 144)))[(8 * i8 + q) * 72 + lane] = f2bf(hn / (1.0f + __expf(-hn))); } }
        FP_LDS_WAIT(); asm volatile("" ::: "memory");
        tile_out<32, 128, 144, 64>(lds + 94 * 256 * 4 + w * (32 * 144), (unsigned char*)(p.YC + ((size_t)b * S + s0 + tb) * D + (w & 3) * 64), (size_t)D * 2, lane);
        FP_LDS_WAIT(); asm volatile("" ::: "memory");
    }
    __syncthreads();
}
constexpr int MQ_P = 264, MK_P = 136;
__device__ __forceinline__ void mla_proj(const MP& p, int L, FLAS unsigned char* lds, int bx, int G) {
    FLAS bf16* Aq = (FLAS bf16*)lds; FLAS bf16* Ak = (FLAS bf16*)(lds + 64 * MQ_P * 2);
    const int nunits = (int)(p.T / 64);
    const bf16* Wq = p.WUQ + (size_t)L * 512 * 256; const bf16* Wk = p.WUKV + (size_t)L * 512 * 128;
    for (int u = bx; u < nunits; u += G) {
        const int tid = mk_tid(), lane = tid & 63, w = __builtin_amdgcn_readfirstlane(tid >> 6), fr = lane & 15, fq = lane >> 4;
        const size_t t0 = (size_t)u * 64;
        __syncthreads();
        bf16x8 wq0[4][3], wkf[4][4];
        {
            u32x2 rq[8]; unsigned rk[8];
#pragma unroll
            for (int i = 0; i < 8; ++i) { const bf16* urow = p.U + (t0 + w * 8 + i) * NU; rq[i] = *(const u32x2*)(urow + U_CQ + lane * 4); rk[i] = *(const unsigned*)(urow + U_CKV + lane * 2); }
            const f32x4 gq = *(const f32x4*)(p.qn_g + L * 256 + lane * 4); const f32x2 gk = *(const f32x2*)(p.kvn_g + L * 128 + lane * 2);
#pragma unroll
            for (int k4 = 0; k4 < 4; ++k4)
#pragma unroll
                for (int ct = 0; ct < 3; ++ct) wq0[k4][ct] = *(const bf16x8*)(Wq + (size_t)(48 * w + 16 * ct + fr) * 256 + k4 * 32 + fq * 8);
#pragma unroll
            for (int ks = 0; ks < 4; ++ks)
#pragma unroll
                for (int ct = 0; ct < 4; ++ct) wkf[ks][ct] = *(const bf16x8*)(Wk + (size_t)(64 * w + 16 * ct + fr) * 128 + ks * 32 + fq * 8);
            __builtin_amdgcn_sched_barrier(0);
#pragma unroll
            for (int i = 0; i < 8; ++i) { const int r = w * 8 + i;
                { const float a0 = blo(rq[i].x), a1 = bhi(rq[i].x), a2 = blo(rq[i].y), a3 = bhi(rq[i].y); const float rs = 1.0f / sqrtf(wave_sum((a0 * a0 + a1 * a1) + (a2 * a2 + a3 * a3)) * (1.0f / 256.f) + RMS_EPS);
                  u32x2 o; o.x = pk2(a0 * rs * gq.x, a1 * rs * gq.y); o.y = pk2(a2 * rs * gq.z, a3 * rs * gq.w); *(FLAS u32x2*)(Aq + r * MQ_P + lane * 4) = o; }
                { const float a0 = blo(rk[i]), a1 = bhi(rk[i]); const float rs = 1.0f / sqrtf(wave_sum(a0 * a0 + a1 * a1) * (1.0f / 128.f) + RMS_EPS); *(FLAS unsigned*)(Ak + r * MK_P + lane * 2) = pk2(a0 * rs * gk.x, a1 * rs * gk.y); } } }
#pragma unroll
        for (int e2 = 0; e2 < 2; ++e2) { const int e = tid + 512 * e2, r = e >> 4, jj = e & 15; const size_t t = t0 + r; const float x1 = bf2f(p.U[t * NU + U_KR + jj]), x2 = bf2f(p.U[t * NU + U_KR + 16 + jj]), c = p.CS[t * 32 + jj], sn = p.CS[t * 32 + 16 + jj];
            const bf16 o1 = f2bf(x1 * c - x2 * sn), o2 = f2bf(x1 * sn + x2 * c);
#pragma unroll
            for (int h = 0; h < 4; ++h) { p.KK[t * 384 + h * 96 + 64 + jj] = o1; p.KK[t * 384 + h * 96 + 80 + jj] = o2; } }
        __syncthreads();
        {
            f32x4 acc[3][4];
#pragma unroll
            for (int ct = 0; ct < 3; ++ct)
#pragma unroll
                for (int rt = 0; rt < 4; ++rt) acc[ct][rt] = (f32x4){0.f, 0.f, 0.f, 0.f};
            bf16x8 wq1[4][3];
#pragma unroll
            for (int k4 = 0; k4 < 4; ++k4)
#pragma unroll
                for (int ct = 0; ct < 3; ++ct) wq1[k4][ct] = *(const bf16x8*)(Wq + (size_t)(48 * w + 16 * ct + fr) * 256 + (4 + k4) * 32 + fq * 8);
            __builtin_amdgcn_sched_barrier(0);
#pragma unroll
            for (int k4 = 0; k4 < 4; ++k4)
#pragma unroll
                for (int rt = 0; rt < 4; ++rt) { const bf16x8 tk = *(const FLAS bf16x8*)(Aq + (rt * 16 + fr) * MQ_P + k4 * 32 + fq * 8);
#pragma unroll
                    for (int ct = 0; ct < 3; ++ct) acc[ct][rt] = __builtin_amdgcn_mfma_f32_16x16x32_bf16(wq0[k4][ct], tk, acc[ct][rt], 0, 0, 0); }
#pragma unroll
            for (int k4 = 0; k4 < 4; ++k4)
#pragma unroll
                for (int rt = 0; rt < 4; ++rt) { const bf16x8 tk = *(const FLAS bf16x8*)(Aq + (rt * 16 + fr) * MQ_P + (4 + k4) * 32 + fq * 8);
#pragma unroll
                    for (int ct = 0; ct < 3; ++ct) acc[ct][rt] = __builtin_amdgcn_mfma_f32_16x16x32_bf16(wq1[k4][ct], tk, acc[ct][rt], 0, 0, 0); }
            const bool pe = (w & 1) != 0;
#pragma unroll
            for (int rt = 0; rt < 4; ++rt) { const size_t t = t0 + rt * 16 + fr; bf16* qrow = p.Q + t * 384 + 48 * w + 4 * fq;
                f32x4 v0 = acc[0][rt], v1 = acc[1][rt], v2 = acc[2][rt];
                if (pe) { const f32x4 c = *(const f32x4*)(p.CS + t * 32 + 4 * fq), sn = *(const f32x4*)(p.CS + t * 32 + 16 + 4 * fq); const f32x4 x1 = v1, x2 = v2; v1 = x1 * c - x2 * sn; v2 = x1 * sn + x2 * c; }
                u32x2 o; o.x = pk2(v0.x * QSCALE, v0.y * QSCALE); o.y = pk2(v0.z * QSCALE, v0.w * QSCALE); *(u32x2*)qrow = o;
                o.x = pk2(v1.x * QSCALE, v1.y * QSCALE); o.y = pk2(v1.z * QSCALE, v1.w * QSCALE); *(u32x2*)(qrow + 16) = o;
                o.x = pk2(v2.x * QSCALE, v2.y * QSCALE); o.y = pk2(v2.z * QSCALE, v2.w * QSCALE); *(u32x2*)(qrow + 32) = o; }
        }
        {
            f32x4 acc[4][4];
#pragma unroll
            for (int ct = 0; ct < 4; ++ct)
#pragma unroll
                for (int rt = 0; rt < 4; ++rt) acc[ct][rt] = (f32x4){0.f, 0.f, 0.f, 0.f};
            const int h = w >> 1; const bool isv = (w & 1) != 0;
            if (!isv) {
#pragma unroll
                for (int ks = 0; ks < 4; ++ks)
#pragma unroll
                    for (int rt = 0; rt < 4; ++rt) { const bf16x8 tk = *(const FLAS bf16x8*)(Ak + (rt * 16 + fr) * MK_P + ks * 32 + fq * 8);
#pragma unroll
                        for (int ct = 0; ct < 4; ++ct) acc[ct][rt] = __builtin_amdgcn_mfma_f32_16x16x32_bf16(wkf[ks][ct], tk, acc[ct][rt], 0, 0, 0); }
#pragma unroll
                for (int rt = 0; rt < 4; ++rt) { const size_t t = t0 + rt * 16 + fr; bf16* dst = p.KK + t * 384 + h * 96 + 4 * fq;
#pragma unroll
                    for (int ct = 0; ct < 4; ++ct) { u32x2 o; o.x = pk2(acc[ct][rt].x, acc[ct][rt].y); o.y = pk2(acc[ct][rt].z, acc[ct][rt].w); *(u32x2*)(dst + 16 * ct) = o; } }
            } else {
#pragma unroll
                for (int ks = 0; ks < 4; ++ks)
#pragma unroll
                    for (int rt = 0; rt < 4; ++rt) { const bf16x8 tk = *(const FLAS bf16x8*)(Ak + (rt * 16 + fr) * MK_P + ks * 32 + fq * 8);
#pragma unroll
                        for (int ct = 0; ct < 4; ++ct) acc[ct][rt] = __builtin_amdgcn_mfma_f32_16x16x32_bf16(tk, wkf[ks][ct], acc[ct][rt], 0, 0, 0); }
                const size_t bq = t0 / p.S, sq = t0 % p.S;
#pragma unroll
                for (int ct = 0; ct < 4; ++ct) { bf16* drow = p.V + ((bq * 4 + h) * 64 + 16 * ct + fr) * p.S + sq + 4 * fq;
#pragma unroll
                    for (int rt = 0; rt < 4; ++rt) { u32x2 o; o.x = pk2(acc[ct][rt].x, acc[ct][rt].y); o.y = pk2(acc[ct][rt].z, acc[ct][rt].w); *(u32x2*)(drow + 16 * rt) = o; } }
            }
        }
    }
    __syncthreads();
}
__device__ __forceinline__ void ssd_scan(const MP& p, int bx, int G) {
    const int tid = mk_tid(); const long g0 = (long)bx * 512 + tid, gs = (long)G * 512; const int NCB = (int)(p.S / CHUNK);
    for (long i = g0; i < p.B * 8 * 64 * 32; i += gs) { const long b = i / (8 * 64 * 32), r = i % (8 * 64 * 32); const int h = (int)(r / (64 * 32)); f32x4 carry = (f32x4){0.f, 0.f, 0.f, 0.f};
        f32x4 st[16]; float dec[16];
#pragma unroll
        for (int cc = 0; cc < 16; ++cc) { const long c = b * NCB + cc; st[cc] = ((const f32x4*)p.ST)[(size_t)c * (8 * 64 * 32) + r]; dec[cc] = p.ACS[(c * CHUNK + CHUNK - 1) * 8 + h]; }
        __builtin_amdgcn_sched_barrier(0);
#pragma unroll
        for (int cc = 0; cc < 16; ++cc) { const long c = b * NCB + cc; u32x2 o; o.x = pk2(carry.x, carry.y); o.y = pk2(carry.z, carry.w); ((u32x2*)p.PV)[(size_t)c * (8 * 64 * 32) + r] = o; carry = carry * __expf(dec[cc]) + st[cc]; } }
}
constexpr int SP = 136;
constexpr int SA_DT = 0, SA_ACS = 2048, SA_CM = 4096, SA_BM = SA_CM + 128 * SP * 2, SA_XT = SA_CM, SA_BT = SA_CM + 2 * 128 * SP * 2, SA_MW = SA_BT + 128 * SP * 2, SA_END = SA_MW + 8 * 16 * SP * 2;
__device__ __forceinline__ float silu_f(float x) { return x / (1.0f + __expf(-x)); }
__device__ __forceinline__ float softplus_fast(float x) { if (x > 20.f) return x; const float e = __builtin_amdgcn_exp2f(x * 1.4426950408889634f); return e < 1e-3f ? e * (1.0f - 0.5f * e) : 0.6931471805599453f * __builtin_amdgcn_logf(1.0f + e); }
struct ConvW { f32x4 w[4][2], b[2]; };
__device__ __forceinline__ void convw_load(const MP& p, int L, int xc0, ConvW& cw) {
#pragma unroll
    for (int j = 0; j < 4; ++j) { cw.w[j][0] = *(const f32x4*)(p.sconv_w + (L * 4 + j) * 1024 + xc0); cw.w[j][1] = *(const f32x4*)(p.sconv_w + (L * 4 + j) * 1024 + xc0 + 4); }
    cw.b[0] = *(const f32x4*)(p.sconv_b + L * 1024 + xc0); cw.b[1] = *(const f32x4*)(p.sconv_b + L * 1024 + xc0 + 4);
}
__device__ __forceinline__ void conv_rows_load(const bf16* ub  , int xc0, int s0, int l0, u32x4 (&x)[11]) {
#pragma unroll
    for (int i = 0; i < 11; ++i) { const int sp = s0 + l0 - 3 + i; x[i] = (u32x4){0u, 0u, 0u, 0u}; if (i >= 3 || sp >= 0) x[i] = *(const u32x4*)(ub + (size_t)(sp < 0 ? 0 : sp) * NU + xc0); }
}
__device__ __forceinline__ float conv_elem(const u32x4 (&x)[11], const ConvW& cw, int i, int c) {
    float a = cw.b[c >> 2][c & 3];
#pragma unroll
    for (int j = 0; j < 4; ++j) { const unsigned wd = x[i + j][c >> 1]; a += cw.w[j][c >> 2][c & 3] * ((c & 1) ? bhi(wd) : blo(wd)); }
    return silu_f(a);
}
__device__ __forceinline__ void ssd_a(const MP& p, int L, FLAS unsigned char* lds, int bx, int G) {
    FLAS float* dtL = (FLAS float*)(lds + SA_DT); FLAS float* acsL = (FLAS float*)(lds + SA_ACS);
    FLAS bf16* Cm = (FLAS bf16*)(lds + SA_CM); FLAS bf16* Bm = (FLAS bf16*)(lds + SA_BM); FLAS bf16* XT = (FLAS bf16*)(lds + SA_XT); FLAS bf16* BT = (FLAS bf16*)(lds + SA_BT);
    const int S = (int)p.S, nunits = (int)(p.T / CHUNK) * 2;
    for (int u = bx; u < nunits; u += G) {
        const int tid = mk_tid(), lane = tid & 63, w = __builtin_amdgcn_readfirstlane(tid >> 6), fr = lane & 15, fq = lane >> 4;
        FLAS bf16* Mw = (FLAS bf16*)(lds + SA_MW + w * (16 * SP * 2));
        const int g = u & 1; const long c = u >> 1; const size_t t0 = (size_t)c * CHUNK; const int s0 = (int)(t0 % S); const size_t tb = t0 - s0;
        __syncthreads();
        TP_BEGIN(28, lds);
        const int cg2 = tid & 31, ts = tid >> 5, l0 = 8 * ts; const bool isC = cg2 >= 16; const int nbc = 8 * (cg2 & 15);
        const int xcb = (isC ? 768 : 512) + 128 * g + nbc, chs = 8 * cg2, xcs = 256 * g + chs;
        u32x4 xb[11], xs[11]; ConvW cwb, cws;
        const int h4 = tid >> 7, ldt = tid & 127; const bf16 dtraw = p.U[(t0 + ldt) * NU + U_DT + 4 * g + h4];
        conv_rows_load(p.U + tb * NU + U_XBC, xcb, s0, l0, xb);
        conv_rows_load(p.U + tb * NU + U_XBC, xcs, s0, l0, xs);
        convw_load(p, L, xcb, cwb); convw_load(p, L, xcs, cws);
        __builtin_amdgcn_sched_barrier(0);
        if (PROBE_CK == 11) { asm volatile("s_waitcnt vmcnt(0) lgkmcnt(0)" ::: "memory"); TP_END(28, lds); }
        dtL[h4 * 128 + ldt] = softplus_fast(bf2f(dtraw) + p.dt_bias[L * 8 + 4 * g + h4]);
        {
            FLAS bf16* rowdst = (isC ? Cm : Bm) + nbc; u32x4 colw[8];
#pragma unroll
            for (int i = 0; i < 8; ++i) { float o[8];
#pragma unroll
                for (int c = 0; c < 8; ++c) o[c] = conv_elem(xb, cwb, i, c);
                u32x4 wv; wv.x = pk2(o[0], o[1]); wv.y = pk2(o[2], o[3]); wv.z = pk2(o[4], o[5]); wv.w = pk2(o[6], o[7]); *(FLAS u32x4*)(rowdst + (l0 + i) * SP) = wv;
#pragma unroll
                for (int c = 0; c < 8; ++c) { const unsigned hv = (c & 1) ? (wv[c >> 1] >> 16) : (wv[c >> 1] & 0xffffu); if (i & 1) colw[c][i >> 1] |= hv << 16; else colw[c][i >> 1] = hv; } }
            if (!isC) {
#pragma unroll
                for (int c = 0; c < 8; ++c) *(FLAS u32x4*)(BT + (nbc + c) * SP + l0) = colw[c]; }
        }
        if (PROBE_CK == 12) { asm volatile("s_waitcnt vmcnt(0) lgkmcnt(0)" ::: "memory"); TP_END(28, lds); }
        __syncthreads();
        if (w < 4) {
            const int h = 4 * g + w; const float a = -__expf(p.a_log[L * 8 + h]); const float x0 = dtL[w * 128 + 2 * lane] * a, x1 = dtL[w * 128 + 2 * lane + 1] * a, ps = x0 + x1; float inc = ps;
#pragma unroll
            for (int o = 1; o < 64; o <<= 1) { const float t = __shfl_up(inc, o); if (lane >= o) inc += t; }
            const float ex = inc - ps, c0 = ex + x0, c1 = ex + ps; *(FLAS f32x2*)(acsL + w * 128 + 2 * lane) = (f32x2){c0, c1};
            p.ACS[(t0 + 2 * lane) * 8 + h] = c0; p.ACS[(t0 + 2 * lane + 1) * 8 + h] = c1; }
        tile_out<128, 256, SP * 2, 512>((const FLAS unsigned char*)Cm, (unsigned char*)(p.CM + t0 * 256 + g * 128), (size_t)256 * 2, tid);
        f32x4 cbT[8];
#pragma unroll
        for (int ct = 0; ct < 8; ++ct) cbT[ct] = (f32x4){0.f, 0.f, 0.f, 0.f};
#pragma unroll
        for (int ks = 0; ks < 4; ++ks) { const bf16x8 cf = *(const FLAS bf16x8*)(Cm + (16 * w + fr) * SP + ks * 32 + fq * 8);
#pragma unroll
            for (int ct = 0; ct < 8; ++ct) { const bf16x8 bfm = *(const FLAS bf16x8*)(Bm + (16 * ct + fr) * SP + ks * 32 + fq * 8); cbT[ct] = __builtin_amdgcn_mfma_f32_16x16x32_bf16(bfm, cf, cbT[ct], 0, 0, 0); } }
        __syncthreads();
        if (PROBE_CK == 13) { asm volatile("s_waitcnt vmcnt(0) lgkmcnt(0)" ::: "memory"); TP_END(28, lds); }
        {   const FLAS float* dts = dtL + (chs >> 6) * 128 + l0; const f32x4 d0 = *(const FLAS f32x4*)dts, d1 = *(const FLAS f32x4*)(dts + 4);
            const float dtv[8] = {d0.x, d0.y, d0.z, d0.w, d1.x, d1.y, d1.z, d1.w};
#pragma unroll
            for (int c = 0; c < 8; ++c) { float o[8];
#pragma unroll
                for (int i = 0; i < 8; ++i) o[i] = bf2f(f2bf(conv_elem(xs, cws, i, c))) * dtv[i];
                u32x4 wv; wv.x = pk2(o[0], o[1]); wv.y = pk2(o[2], o[3]); wv.z = pk2(o[4], o[5]); wv.w = pk2(o[6], o[7]); *(FLAS u32x4*)(XT + (chs + c) * SP + l0) = wv; } }
        if (PROBE_CK == 14) { asm volatile("s_waitcnt vmcnt(0) lgkmcnt(0)" ::: "memory"); TP_END(28, lds); }
        __syncthreads();
#pragma unroll 1
        for (int r = 0; r < 4; ++r) {
            const FLAS float* ac = acsL + r * 128; const int h = 4 * g + r; const float al = ac[16 * w + fr];
            const float dsd = p.dskip[L * 8 + h] / dtL[r * 128 + 16 * w + fr];
#pragma unroll
            for (int ct = 0; ct < 8; ++ct) { const f32x4 as = *(const FLAS f32x4*)(ac + 16 * ct + 4 * fq); const int sb = 16 * ct + 4 * fq, l = 16 * w + fr; float m0, m1, m2, m3;
                m0 = (sb + 0 <= l) ? cbT[ct].x * __expf(al - as.x) : 0.f; m1 = (sb + 1 <= l) ? cbT[ct].y * __expf(al - as.y) : 0.f; m2 = (sb + 2 <= l) ? cbT[ct].z * __expf(al - as.z) : 0.f; m3 = (sb + 3 <= l) ? cbT[ct].w * __expf(al - as.w) : 0.f;
                m0 += (sb + 0 == l) ? dsd : 0.f; m1 += (sb + 1 == l) ? dsd : 0.f; m2 += (sb + 2 == l) ? dsd : 0.f; m3 += (sb + 3 == l) ? dsd : 0.f;
                u32x2 o; o.x = pk2(m0, m1); o.y = pk2(m2, m3); *(FLAS u32x2*)(Mw + fr * SP + sb) = o; }
            FP_LDS_WAIT(); asm volatile("" ::: "memory");
            f32x4 yd[4], st[4];
#pragma unroll
            for (int pt = 0; pt < 4; ++pt) { yd[pt] = (f32x4){0.f, 0.f, 0.f, 0.f}; st[pt] = (f32x4){0.f, 0.f, 0.f, 0.f}; }
            const float alast = ac[127];
#pragma unroll
            for (int ks = 0; ks < 4; ++ks) { const bf16x8 am = *(const FLAS bf16x8*)(Mw + fr * SP + ks * 32 + fq * 8);
                const u32x4 braw = *(const FLAS u32x4*)(BT + (16 * w + fr) * SP + ks * 32 + fq * 8); const f32x4 e0 = *(const FLAS f32x4*)(ac + ks * 32 + fq * 8), e1 = *(const FLAS f32x4*)(ac + ks * 32 + fq * 8 + 4); u32x4 bs;
                bs.x = pk2(blo(braw.x) * __expf(alast - e0.x), bhi(braw.x) * __expf(alast - e0.y)); bs.y = pk2(blo(braw.y) * __expf(alast - e0.z), bhi(braw.y) * __expf(alast - e0.w));
                bs.z = pk2(blo(braw.z) * __expf(alast - e1.x), bhi(braw.z) * __expf(alast - e1.y)); bs.w = pk2(blo(braw.w) * __expf(alast - e1.z), bhi(braw.w) * __expf(alast - e1.w));
                const bf16x8 bsf = __builtin_bit_cast(bf16x8, bs);
#pragma unroll
                for (int pt = 0; pt < 4; ++pt) { const bf16x8 x = *(const FLAS bf16x8*)(XT + (r * 64 + 16 * pt + fr) * SP + ks * 32 + fq * 8);
                    yd[pt] = __builtin_amdgcn_mfma_f32_16x16x32_bf16(x, am, yd[pt], 0, 0, 0); st[pt] = __builtin_amdgcn_mfma_f32_16x16x32_bf16(bsf, x, st[pt], 0, 0, 0); } }
#pragma unroll
            for (int pt = 0; pt < 4; ++pt) { u32x2 o; o.x = pk2(yd[pt].x, yd[pt].y); o.y = pk2(yd[pt].z, yd[pt].w); *(FLAS u32x2*)((FLAS unsigned char*)Mw + fr * 144 + (16 * pt + 4 * fq) * 2) = o;
                *(f32x4*)(p.ST + (((size_t)c * 8 + h) * 64 + 16 * pt + fr) * 128 + 16 * w + 4 * fq) = st[pt]; }
            FP_LDS_WAIT(); asm volatile("" ::: "memory");
            tile_out<16, 128, 144, 64>((const FLAS unsigned char*)Mw, (unsigned char*)(p.YD + (t0 + 16 * w) * 512 + h * 64), (size_t)512 * 2, lane);
            FP_LDS_WAIT(); asm volatile("" ::: "memory");
            if (r == 0) {if (PROBE_CK == 15) { asm volatile("s_waitcnt vmcnt(0) lgkmcnt(0)" ::: "memory"); TP_END(28, lds); } }
        }
        if (PROBE_CK == 16) { asm volatile("s_waitcnt vmcnt(0) lgkmcnt(0)" ::: "memory"); TP_END(28, lds); }
    }
    __syncthreads();
}
__device__ __forceinline__ void ssd_c(const MP& p, int L, FLAS unsigned char* lds, int bx, int G) {
    const int nunits = (int)(p.T / CHUNK) * 2;
    for (int u = bx; u < nunits; u += G) {
        const int tid = mk_tid(), lane = tid & 63, w = __builtin_amdgcn_readfirstlane(tid >> 6), fr = lane & 15, fq = lane >> 4;
        const int g = u & 1; const long c = u >> 1; const size_t t0 = (size_t)c * CHUNK, t = t0 + 16 * w + fr;
        FLAS float* gnl = (FLAS float*)(lds + 8 * (16 * 528));
        __syncthreads();
        if (tid < 64) *(FLAS f32x4*)(gnl + 4 * tid) = *(const f32x4*)(p.snorm_g + L * 512 + g * 256 + 4 * tid);
        __syncthreads();
        TP_BEGIN(24, lds);
        bf16x8 cf[4];
#pragma unroll
        for (int ks = 0; ks < 4; ++ks) cf[ks] = *(const bf16x8*)(p.CM + t * 256 + g * 128 + ks * 32 + fq * 8);
        if (PROBE_CK == 1) { asm volatile("s_waitcnt vmcnt(0) lgkmcnt(0)" ::: "memory"); TP_END(24, lds); }
        f32x4 y[4][4]; float ssq = 0.f;
#pragma unroll
        for (int hp = 0; hp < 2; ++hp) { bf16x8 pvf[2][4][4];
#pragma unroll
            for (int rr = 0; rr < 2; ++rr) { const bf16* pv = p.PV + (((size_t)c * 8 + 4 * g + 2 * hp + rr) * 64) * 128;
#pragma unroll
                for (int pt = 0; pt < 4; ++pt)
#pragma unroll
                    for (int ks = 0; ks < 4; ++ks) pvf[rr][pt][ks] = *(const bf16x8*)(pv + (size_t)(16 * pt + fr) * 128 + ks * 32 + fq * 8); }
            __builtin_amdgcn_sched_barrier(0);
#pragma unroll
            for (int rr = 0; rr < 2; ++rr)
#pragma unroll
                for (int pt = 0; pt < 4; ++pt) { f32x4 acc = (f32x4){0.f, 0.f, 0.f, 0.f};
#pragma unroll
                    for (int ks = 0; ks < 4; ++ks) acc = __builtin_amdgcn_mfma_f32_16x16x32_bf16(pvf[rr][pt][ks], cf[ks], acc, 0, 0, 0);
                    y[2 * hp + rr][pt] = acc; }
            __builtin_amdgcn_sched_barrier(0); }
        if (PROBE_CK == 2) { asm volatile("s_waitcnt vmcnt(0) lgkmcnt(0)" ::: "memory"); TP_END(24, lds); }
        u32x2 ryd[4][4], rz[4][4]; float ea[4];
#pragma unroll
        for (int r = 0; r < 4; ++r) { const int h = 4 * g + r; ea[r] = p.ACS[t * 8 + h];
#pragma unroll
            for (int pt = 0; pt < 4; ++pt) { const int ch = h * 64 + 16 * pt + 4 * fq; ryd[r][pt] = *(const u32x2*)(p.YD + t * 512 + ch); rz[r][pt] = *(const u32x2*)(p.U + t * NU + U_Z + ch); } }
        __builtin_amdgcn_sched_barrier(0);
        if (PROBE_CK == 3) { asm volatile("s_waitcnt vmcnt(0) lgkmcnt(0)" ::: "memory"); TP_END(24, lds); }
#pragma unroll
        for (int r = 0; r < 4; ++r) { const float e = __expf(ea[r]);
#pragma unroll
            for (int pt = 0; pt < 4; ++pt) { const f32x4 acc = y[r][pt]; f32x4 yv;
                yv.x = (acc.x * e + blo(ryd[r][pt].x)) * silu_f(blo(rz[r][pt].x)); yv.y = (acc.y * e + bhi(ryd[r][pt].x)) * silu_f(bhi(rz[r][pt].x));
                yv.z = (acc.z * e + blo(ryd[r][pt].y)) * silu_f(blo(rz[r][pt].y)); yv.w = (acc.w * e + bhi(ryd[r][pt].y)) * silu_f(bhi(rz[r][pt].y));
                y[r][pt] = yv; ssq += (yv.x * yv.x + yv.y * yv.y) + (yv.z * yv.z + yv.w * yv.w); } }
        if (PROBE_CK == 4) { asm volatile("s_waitcnt vmcnt(0) lgkmcnt(0)" ::: "memory"); TP_END(24, lds); }
        ssq += __shfl_xor(ssq, 16); ssq += __shfl_xor(ssq, 32);
        const float rs = 1.0f / sqrtf(ssq * (1.0f / 256.f) + RMS_EPS);
        FLAS unsigned char* stg = lds + w * (16 * 528);
#pragma unroll
        for (int r = 0; r < 4; ++r)
#pragma unroll
            for (int pt = 0; pt < 4; ++pt) { const int cl = r * 64 + 16 * pt + 4 * fq; const f32x4 gn = *(const FLAS f32x4*)(gnl + cl); const f32x4 v = y[r][pt];
                u32x2 o; o.x = pk2(v.x * rs * gn.x, v.y * rs * gn.y); o.y = pk2(v.z * rs * gn.z, v.w * rs * gn.w); *(FLAS u32x2*)(stg + fr * 528 + cl * 2) = o; }
        if (PROBE_CK == 5) { asm volatile("s_waitcnt vmcnt(0) lgkmcnt(0)" ::: "memory"); TP_END(24, lds); }
        FP_LDS_WAIT(); asm volatile("" ::: "memory");
        tile_out<16, 512, 528, 64>(stg, (unsigned char*)(p.YC + (t0 + 16 * w) * D + 256 + g * 256), (size_t)D * 2, lane);
        FP_LDS_WAIT(); asm volatile("" ::: "memory");
        if (PROBE_CK == 6) { asm volatile("s_waitcnt vmcnt(0) lgkmcnt(0)" ::: "memory"); TP_END(24, lds); }
    }
}
}

using namespace mdl;
#define LAS __attribute__((address_space(3)))
constexpr int NWAVES = 8, NTHR = NWAVES * 64;
constexpr int CW_BAR = 4096;
#define XB_TMO      128
#define XB_XCNT(j)  (256  + 64 * (j))
#define XB_XSUB(j)  (1280 + 64 * (j))
#define XB_XGEN(j)  (2304 + 64 * (j))
#define XB_TOP      3328
#define XB_TOPGEN   3392
#define XCD_BAR_WORDS 3456
#define XB_SPIN_CAP (1u << 18)

__device__ __forceinline__ unsigned xb_ld(unsigned* p)              { return __hip_atomic_load(p, __ATOMIC_RELAXED, __HIP_MEMORY_SCOPE_AGENT); }
__device__ __forceinline__ unsigned xb_add(unsigned* p, unsigned v) { return __hip_atomic_fetch_add(p, v, __ATOMIC_RELAXED, __HIP_MEMORY_SCOPE_AGENT); }
__device__ __forceinline__ unsigned xb_xcc_id() { return (unsigned)__builtin_amdgcn_s_getreg((3 << 11) | 20) & 0xFu; }
#define XB_SPIN(cond, bar) do { unsigned _sp = 0; while (cond) { __builtin_amdgcn_s_sleep(1); \
    if ((++_sp & 255u) == 0u) { if (xb_ld(&(bar)[XB_TMO])) break; if (_sp > XB_SPIN_CAP) { atomicAdd(&(bar)[XB_TMO], 1u); break; } } } } while (0)

struct XcdBarrier {
    unsigned* bar; unsigned x;
    volatile LAS unsigned* st;
};

__device__ __forceinline__ XcdBarrier xcd_barrier_post(unsigned* bar, volatile LAS unsigned* st) {
    XcdBarrier b; b.bar = bar; b.x = xb_xcc_id(); b.st = st;
    if (threadIdx.x == 0) (void)xb_add(&bar[XB_XCNT(b.x)], 1u);
    return b;
}
__device__ __forceinline__ void xcd_barrier_complete(unsigned* bar, unsigned x, unsigned& nloc, unsigned& nx) {
    const unsigned G = gridDim.x * gridDim.y * gridDim.z;
    unsigned sum, cnt, mine, sp = 0u;
    for (;;) {
        sum = 0u; cnt = 0u; mine = 0u;
#pragma unroll
        for (unsigned j = 0; j < 16; ++j) { const unsigned c = xb_ld(&bar[XB_XCNT(j)]); sum += c; cnt += (c > 0u) ? 1u : 0u; mine = (j == x) ? c : mine; }
        if (sum == G) break;
        __builtin_amdgcn_s_sleep(1);
        if ((++sp & 255u) == 0u) { if (xb_ld(&bar[XB_TMO])) break; if (sp > XB_SPIN_CAP) { atomicAdd(&bar[XB_TMO], 1u); break; } }
    }
    nloc = mine > 0u ? mine : 1u; nx = cnt > 0u ? cnt : 1u;
}

__device__ __forceinline__ void xcd_barrier(const XcdBarrier& b) {
    asm volatile("s_waitcnt vmcnt(0)" ::: "memory");
    __syncthreads();
    if (threadIdx.x == 0) {
        unsigned* bar = b.bar;
        __builtin_amdgcn_s_waitcnt(0);
        unsigned nloc = b.st[0], nx = b.st[1];
        if (nloc == 0u) { xcd_barrier_complete(bar, b.x, nloc, nx); b.st[0] = nloc; b.st[1] = nx; }
        const unsigned old = xb_add(&bar[XB_XSUB(b.x)], 1u);
        const unsigned gen = old / nloc;
        if (old + 1u == (gen + 1u) * nloc) {
            __builtin_amdgcn_fence(__ATOMIC_RELEASE, "agent");
            asm volatile("s_waitcnt vmcnt(0)" ::: "memory");
            const unsigned og = xb_add(&bar[XB_TOP], 1u);
            const unsigned tg = og / nx;
            if (og + 1u == (tg + 1u) * nx) xb_add(&bar[XB_TOPGEN], 1u);
            else XB_SPIN(xb_ld(&bar[XB_TOPGEN]) == tg, bar);
            __builtin_amdgcn_fence(__ATOMIC_ACQUIRE, "agent");
            xb_add(&bar[XB_XGEN(b.x)], 1u);
            asm volatile("s_waitcnt vmcnt(0)" ::: "memory");
        } else {
            XB_SPIN(xb_ld(&bar[XB_XGEN(b.x)]) == gen, bar);
            __builtin_amdgcn_fence(__ATOMIC_ACQUIRE, "agent");
            asm volatile("s_waitcnt vmcnt(0)" ::: "memory");
        }
    }
    __syncthreads();
}

struct Args { MP p; long flags; };
__global__ void __launch_bounds__(NTHR, 2) mk_fwd(Args a) {
    extern __shared__ __attribute__((aligned(16))) unsigned char lds[];
    LAS unsigned char* const L3 = (LAS unsigned char*)lds;
    volatile LAS unsigned* MISC = (volatile LAS unsigned*)(L3 + MISC_OFF);
    const MP& p = a.p;
    const int tid = threadIdx.x;
    for (int u = tid; u < (LDS_BYTES - LDSCTL_OFF) / 4; u += NTHR) ((LAS unsigned*)(L3 + LDSCTL_OFF))[u] = 0u;
    __syncthreads();
    const XcdBarrier bar = xcd_barrier_post(p.ctl + CW_BAR, MISC + 8);
    const int G = gridDim.x, bx = blockIdx.x;
    const long gs = (long)G * NTHR;
#define g0 ((long)bx * NTHR + mk_tid())
#ifndef PROBE_MASK
#define PROBE_MASK 0
#endif
#define REP(k) for (int rep_ = 0; rep_ < ((PROBE_MASK >> (k)) & 1) + 1; ++rep_)
#define GRID_BAR() do { REP(10) xcd_barrier(bar); } while (0)
#define PH_BEGIN(id) TP_BEGIN(id, L3)
#define PH_END(id) TP_END(id, L3)
    PH_BEGIN(0); REP(0) fp::prologue(p, L3, bx, G);
    GRID_BAR(); PH_END(0);
    for (int L = 0; L < DEPTH; ++L) {
        const int j = L >> 1; const bool moe = (L & 1) != 0;
        bf16* const hcur = (L & 1) ? p.HB2 : p.HB; bf16* const hnxt = (L & 1) ? p.HB : p.HB2;
        PH_BEGIN(1);
        REP(1) {
            pg8::Gemm g{hcur, p.WIN + (size_t)L * NU * D, (int)p.T, NU, D, D}; pg8::StaticOrder S; S.init((int)p.T, NU, G, bx);
            pg8::rstd_table(L3, rss_ptr(p, L, 0), S);
            pg8::EpiStore16 E{p.U, NU, (const LAS float*)(L3 + pg8::RSTD_TAB_OFF)}; pg8::gemm_phase<pg8::EpiStore16, pg8::StaticOrder, true, true>(L3, g, S, E);
            pg8::Gemm g2{p.PB16 + (size_t)L * p.T * PLE, p.WPP + (size_t)L * D * PLE, (int)p.T, D, PLE, PLE}; pg8::UpperHalfOrder S2; S2.init2((int)p.T, D, G, bx);
            pg8::EpiStore16 E2{p.PJ, D, nullptr}; pg8::gemm_phase<pg8::EpiStore16, pg8::UpperHalfOrder, true, true>(L3, g2, S2, E2);
        }
        GRID_BAR(); PH_END(1); PH_BEGIN(2);
        REP(6) { PH_BEGIN(13); fp::conv_module(p, L, L3, bx, G); PH_END(13); PH_BEGIN(14); fp::mla_proj(p, L, L3, bx, G); PH_END(14); PH_BEGIN(15); fp::ssd_a(p, L, L3, bx, G); PH_END(15); }
        GRID_BAR(); PH_END(2); PH_BEGIN(3);
        REP(7) { PH_BEGIN(16); fp::ssd_scan(p, bx, G); PH_END(16); PH_BEGIN(17); fp::attn_phase(p, L3, bx, G); PH_END(17); }
        GRID_BAR(); PH_END(3); PH_BEGIN(4);
        REP(8) fp::ssd_c(p, L, L3, bx, G);
        GRID_BAR(); PH_END(4); PH_BEGIN(5);
        {
            pg8::Gemm g{p.YC, p.WOUT + (size_t)L * D * D, (int)p.T, D, D, D}; pg8::StaticOrder S; S.init((int)p.T, D, G, bx);
            pg8::EpiAddH E{hcur, D, rss_ptr(p, L, 1)}; pg8::gemm_phase<pg8::EpiAddH, pg8::StaticOrder, true, true>(L3, g, S, E);
        }
        GRID_BAR(); PH_END(5);
        if (moe) { PH_BEGIN(6); fp::norm_phase<1>(p, L, p.ffn_g + L * D, hcur, bx, G, (LAS unsigned*)L3); GRID_BAR(); PH_END(6); PH_BEGIN(7); fp::moeplan(p, L, L3, bx, G); GRID_BAR(); PH_END(7); }
        PH_BEGIN(8);
        {
            const int rows = moe ? moe_start_of(p, j, NE) : (int)p.T;
            pg8::Gemm g{moe ? p.XB : hcur, moe ? p.MWGU + (size_t)j * NE * NGU * D : p.DWGU + (size_t)j * NGU * D, rows, NGU, D, D};
            pg8::ExpertOrder S; S.init(rows, NGU, G, bx); S.tile_e = moe ? p.TILE_E : nullptr;
            if (!moe) pg8::rstd_table(L3, rss_ptr(p, L, 1), S);
            REP(3) { pg8::EpiSwiglu E{p.ACT, DFF, moe ? (const LAS float*)nullptr : (const LAS float*)(L3 + pg8::RSTD_TAB_OFF)}; pg8::gemm_phase<pg8::EpiSwiglu, pg8::ExpertOrder, true, true>(L3, g, S, E); }
            GRID_BAR(); PH_END(8); PH_BEGIN(9);
            if (moe) {
                const int nwg = (rows >> 8) * 4, nfull = (nwg / G) * G, R = nwg - nfull; const int ksn = (R == 0) ? 1 : (R * 4 <= G && R <= 20 ? 4 : (R * 2 <= G && R <= 64 ? 2 : 1));
                const bf16* Wd = p.MWD + (size_t)j * NE * D * DFF; pg8::EpiMoeDown Ed{p.YS, hnxt, (size_t)R * 256 * 1024, (nfull >> 2) * 256};
                { pg8::Gemm gd{p.ACT, Wd, rows, D, DFF, DFF}; pg8::MoeDownOrder Sd{nwg, nfull, G, bx, 0, 0, p.TILE_E}; REP(4) pg8::gemm_phase<pg8::EpiMoeDown, pg8::MoeDownOrder, true, true>(L3, gd, Sd, Ed); }
                if (R > 0) { pg8::Gemm gd{p.ACT, Wd, rows, D, DFF / ksn, DFF}; pg8::MoeDownOrder Sd{nwg, nfull, G, bx, ksn, DFF / ksn, p.TILE_E}; pg8::gemm_phase<pg8::EpiMoeDown, pg8::MoeDownOrder, true, true>(L3, gd, Sd, Ed); }
                if (bx == 0 && mk_tid() == 0) { p.TILE_E[1000] = (nfull >> 2) * 256; p.TILE_E[1001] = ksn; p.TILE_E[1002] = R * 256; }
            } else {
                pg8::Gemm gd{p.ACT, p.DWD + (size_t)j * D * DFF, rows, D, DFF, DFF}; pg8::StaticOrder Sd; Sd.init(rows, D, G, bx);
                REP(4) { pg8::EpiAddH Ed{hcur, D, rss_ptr(p, L, 2)}; pg8::gemm_phase<pg8::EpiAddH, pg8::StaticOrder, true, true>(L3, gd, Sd, Ed); }
            }
        }
        GRID_BAR(); PH_END(9);
        if (moe) { PH_BEGIN(10); fp::norm_phase<2>(p, L, nullptr, hcur, bx, G, nullptr, hnxt); GRID_BAR(); PH_END(10); }
        PH_BEGIN(11);
        {
            pg8::Gemm g{hcur, p.WPG + (size_t)L * D * D, (int)p.T, D, D, D}; pg8::StaticOrder S; S.init((int)p.T, D, G, bx);
            pg8::rstd_table(L3, rss_ptr(p, L, 2), S);
            pg8::EpiPleF E{hcur, hnxt, p.PJ, D, (const LAS float*)(L3 + pg8::RSTD_TAB_OFF), rss_ptr(p, L + 1, 0)}; pg8::gemm_phase<pg8::EpiPleF, pg8::StaticOrder, true, true>(L3, g, S, E);
        }
        GRID_BAR(); PH_END(11);
    }
    PH_BEGIN(12); fp::norm_phase<3>(p, 0, p.fin_g, p.HB, bx, G); PH_END(12);
    if (PROBE_T && bx == 0 && tid == 0) { const unsigned long long te_ = __builtin_amdgcn_s_memrealtime() + 4ull * MISC[2]; while (__builtin_amdgcn_s_memrealtime() < te_) __builtin_amdgcn_s_sleep(8); }
}
static void fill_params(MP& p, void* const* d_in, void* d_out, void* d_ws) {
    p.x = (const float*)d_in[0]; p.p = (const float*)d_in[1]; p.pos = (const int*)d_in[2];
    const float** w = &p.attn_g; for (int i = 3; i < 32; ++i) w[i - 3] = (const float*)d_in[i];
    p.out = (float*)d_out; p.B = 8; p.S = 2048; p.T = 16384; p.NSLOT = 2 * 16384 + 8 * 256;
    carve(p, (unsigned char*)d_ws);
}
extern "C" void kernel_launch(void* const* d_in, const int* in_sizes, int n_in, void* d_out, int out_size, void* d_ws, size_t ws_size, hipStream_t stream) {
    static int grid = 0;
    if (grid == 0) {
        MP q{}; q.T = 16384; q.NSLOT = 2 * 16384 + 8 * 256; const size_t need = carve(q, nullptr);
        if (n_in != 32 || ws_size < need) { fprintf(stderr, "kernel_launch: need %zu bytes of ws, have %zu (n_in %d)\n", need, ws_size, n_in); grid = -1; return; }
        int dev = 0, cus = 0, per_cu = 0;
        if (hipGetDevice(&dev) != hipSuccess || hipDeviceGetAttribute(&cus, hipDeviceAttributeMultiprocessorCount, dev) != hipSuccess) { grid = -1; return; }
        if (hipFuncSetAttribute((const void*)mk_fwd, hipFuncAttributeMaxDynamicSharedMemorySize, LDS_BYTES) != hipSuccess) { fprintf(stderr, "kernel_launch: hipFuncSetAttribute failed\n"); grid = -1; return; }
        if (hipOccupancyMaxActiveBlocksPerMultiprocessor(&per_cu, (const void*)mk_fwd, NTHR, LDS_BYTES) != hipSuccess || per_cu < 1) { fprintf(stderr, "kernel_launch: occupancy query says %d\n", per_cu); }
        (void)hipGetLastError();
        grid = cus;
    }
    if (grid < 0) return;
    Args a{}; fill_params(a.p, d_in, d_out, d_ws); a.flags = 0;
    if (hipMemsetAsync(a.p.ctl, 0, CTL_WORDS * 4, stream) != hipSuccess) return;
    hipLaunchKernelGGL(mk_fwd, dim3(grid), dim3(NTHR), LDS_BYTES, stream, a);
}
```

```cpp
#include <hip/hip_runtime.h>
#include <cstdio>
#include <cstdint>
__device__ __forceinline__ int mk_tid() { int t = threadIdx.x; asm volatile("" : "+v"(t)); return t; }
#ifndef PROBE_T
#define PROBE_T 0
#endif
#ifndef PROBE_CK
#define PROBE_CK 0
#endif
constexpr int LDS_BYTES = 163840, LDSCTL_OFF = LDS_BYTES - 512, MISC_OFF = LDSCTL_OFF + 320;
#define TP_MISC(l3) ((volatile __attribute__((address_space(3))) unsigned*)((l3) + MISC_OFF))
#define TP_BEGIN(id, l3) do { if (((PROBE_T >> (id)) & 1) && blockIdx.x == 0 && threadIdx.x == 0) { const unsigned long long t_ = __builtin_amdgcn_s_memrealtime(); TP_MISC(l3)[0] = (unsigned)t_; TP_MISC(l3)[1] = (unsigned)(t_ >> 32); } } while (0)
#define TP_END(id, l3) do { if (((PROBE_T >> (id)) & 1) && blockIdx.x == 0 && threadIdx.x == 0) { const unsigned long long t0_ = ((unsigned long long)TP_MISC(l3)[1] << 32) | TP_MISC(l3)[0]; TP_MISC(l3)[2] += (unsigned)(__builtin_amdgcn_s_memrealtime() - t0_); } } while (0)

#include <cstring>
#include <cmath>
#include <cstdint>
#ifdef __HIPCC__
#define HD __host__ __device__ __forceinline__
#else
#define HD inline
#endif
typedef unsigned short bf16;
namespace mdl {
constexpr int D = 1024, DEPTH = 4, NU = 2560, NUO = 2472, DFF = 3584, NGU = 7168, NE = 8, PLE = 256;
constexpr int CK = 31, SCONV = 4, CHUNK = 128, NH = 8, HP = 64, NS = 128;
constexpr float RMS_EPS = 1e-6f, LN_EPS = 1e-5f;
constexpr float QSCALE = 0.10206207261596577f * 1.4426950408889634f;
constexpr int U_Z = 512, U_XBC = 1024, U_CQ = 2048, U_CKV = 2304, U_KR = 2432, U_DT = 2464;

HD float bf2f(bf16 v) { unsigned u = (unsigned)v << 16; float f; memcpy(&f, &u, 4); return f; }
HD bf16 f2bf(float f) { unsigned u; memcpy(&u, &f, 4); u += 0x7fffu + ((u >> 16) & 1u); return (bf16)(u >> 16); }
HD float sigmoidf_(float x) { return 1.0f / (1.0f + expf(-x)); }
HD float siluf_(float x) { return x / (1.0f + expf(-x)); }
HD float softplusf_(float x) { return x > 20.f ? x : log1pf(expf(x)); }
HD int ucol_src(int n) { return n < 2048 ? n : (n < U_DT ? n + 8 : (n < NUO ? n - U_DT + 2048 : -1)); }

struct MP {
    const float *x, *p; const int* pos;
    const float *attn_g, *w_in, *cdw_w, *cdw_b, *cln_g, *cln_b, *sconv_w, *sconv_b, *dt_bias, *a_log, *dskip, *snorm_g, *qn_g, *w_uq, *kvn_g, *w_ukv,
        *w_out, *ffn_g, *dwg, *dwu, *dwd, *router, *mwg, *mwu, *mwd, *ple_g, *ple_wg, *ple_wp, *fin_g;
    float* out;
    long B, S, T, NSLOT;
    unsigned* ctl;
    bf16 *WIN, *WUQ, *WUKV, *WOUT, *DWGU, *DWD, *MWGU, *MWD, *WPG, *WPP;
    float *RSSP, *H, *CS, *DT, *ACS, *ST, *CB, *YPRE, *TOPG;
    bf16 *HB2, *HB, *U, *YC, *Q, *KK, *V, *XS, *BM, *CM, *YD, *PV, *PB16, *PJ, *ACT, *XB, *YS;
    int *TOPE, *POS, *TOKSLOT, *TILE_E, *BCNT;
};
constexpr int CTL_WORDS = 65536;
HD unsigned* cnt_ptr(const MP& p, int j) { return p.ctl + 1024 + j * 64; }
HD float* rss_ptr(const MP& p, int L, int k) { return p.RSSP + (size_t)(L * 3 + k) * p.T * 16; }

inline size_t carve(MP& p, unsigned char* ws) {
    size_t o = 0; const size_t T = p.T, NSL = p.NSLOT;
    auto take = [&](size_t bytes) { size_t r = o; o += (bytes + 255) & ~(size_t)255; return ws + r; };
    p.ctl = (unsigned*)take(CTL_WORDS * 4);
    p.WIN = (bf16*)take((size_t)DEPTH * NU * D * 2); p.WUQ = (bf16*)take((size_t)DEPTH * 512 * 256 * 2); p.WUKV = (bf16*)take((size_t)DEPTH * 512 * 128 * 2);
    p.WOUT = (bf16*)take((size_t)DEPTH * D * D * 2); p.DWGU = (bf16*)take((size_t)2 * NGU * D * 2); p.DWD = (bf16*)take((size_t)2 * D * DFF * 2);
    p.MWGU = (bf16*)take((size_t)2 * NE * NGU * D * 2); p.MWD = (bf16*)take((size_t)2 * NE * D * DFF * 2);
    p.WPG = (bf16*)take((size_t)DEPTH * D * D * 2); p.WPP = (bf16*)take((size_t)DEPTH * D * PLE * 2);
    p.RSSP = (float*)take((size_t)13 * T * 16 * 4); p.H = (float*)take(T * D * 4);     p.HB = (bf16*)take(T * D * 2); p.HB2 = (bf16*)take(T * D * 2); p.CS = (float*)take(T * 32 * 4);
    p.PB16 = (bf16*)take((size_t)DEPTH * T * PLE * 2); p.PJ = (bf16*)take(T * D * 2);
    p.TOPE = (int*)take(T * 2 * 4); p.TOPG = (float*)take(T * 2 * 4); p.POS = (int*)take(T * 2 * 4); p.TOKSLOT = (int*)take(T * 2 * 4); p.TILE_E = (int*)take(1024 * 4); p.BCNT = (int*)take(1024 * NE * 4);
    p.XB = (bf16*)take(NSL * D * 2); p.YS = p.XB;
    const size_t r1 = o;
    p.U = (bf16*)take(T * NU * 2); p.YC = (bf16*)take(T * D * 2); p.Q = (bf16*)take(T * 384 * 2); p.KK = (bf16*)take(T * 384 * 2); p.V = (bf16*)take(T * 256 * 2);
    p.XS = (bf16*)take(T * 512 * 2); p.BM = (bf16*)take(T * 256 * 2); p.CM = (bf16*)take(T * 256 * 2); p.YD = (bf16*)take(T * 512 * 2);
    p.DT = (float*)take(T * 8 * 4); p.ACS = (float*)take(T * 8 * 4); p.ST = (float*)take(T / CHUNK * NH * HP * NS * 4); p.PV = (bf16*)take(T / CHUNK * NH * HP * NS * 2);
    p.CB = nullptr; p.YPRE = nullptr;
    const size_t r1end = o; o = r1;
    p.ACT = (bf16*)take(NSL * DFF * 2);
    if (o < r1end) o = r1end;
    return o;
}

HD int moe_start_of(const MP& p, int j, int E) { const unsigned* cnt = cnt_ptr(p, j); int o = 0; for (int e = 0; e < NE; ++e) if (e < E) o += (int)((cnt[e] + 255u) / 256u) * 256; return o; }
}

namespace pg8 {
#define PG8_LAS __attribute__((address_space(3)))
typedef unsigned short bf16_t;
typedef short bf16x8 __attribute__((ext_vector_type(8)));
typedef float f32x4 __attribute__((ext_vector_type(4)));
typedef unsigned u32x4 __attribute__((ext_vector_type(4)));
constexpr int BM = 256, BK = 64, HALF = 128, HTB = HALF * BK * 2  , STAGE_BYTES = 8 * HTB, NXCD = 8, WGM = 8;

__host__ __device__ __forceinline__ int lds_byte(int r, int c) { const int st = (r >> 4) * 2 + (c >> 5), rr = r & 15, cc = c & 31, ob = rr * 64 + cc * 2; return st * 1024 + (ob ^ (((ob >> 9) & 1) << 5)); }
__host__ __device__ __forceinline__ void stage_rc(int b, int& R, int& C) { const int st = b / 1024, sb = b % 1024, swz = sb ^ (((sb >> 9) & 1) << 5); R = (st >> 1) * 16 + swz / 64; C = (st & 1) * 32 + (swz % 64) / 2; }
__host__ __device__ __forceinline__ int perm32(int rho) { const int n = rho >> 4, i = rho & 15; return 8 * (i >> 2) + 4 * n + (i & 3); }

struct Unit { int pm, pn, cn, koff, ks, ui; };
struct Gemm { const bf16_t* A; const bf16_t* Bt; int M, N, K, ld; };

struct StaticOrder {
    int nM, nN, nwg, G, c;
    __host__ __device__ void init(int M, int N, int G_, int c_) { nM = M / BM; nN = N / BM; nwg = nM * nN; G = G_; c = c_; }
    __host__ __device__ bool next(int i, Unit& u) const {
        const int L = i * G + c; if (L >= nwg) return false;
        int wgid = L; { const int q = nwg / NXCD, r = nwg % NXCD, xcd = wgid % NXCD, off = wgid / NXCD; wgid = (xcd < r ? xcd * (q + 1) : r * (q + 1) + (xcd - r) * q) + off; }
        const int nig = WGM * nN, gid = wgid / nig, fm = gid * WGM, gsz = (nM - fm) < WGM ? (nM - fm) : WGM;
        u.pm = fm + ((wgid % nig) % gsz); u.pn = (wgid % nig) / gsz; u.cn = u.pn; u.koff = 0; u.ks = 0; u.ui = i; return true;
    }
    __device__ __forceinline__ void a_ready(const Unit&) const {}
    __device__ __forceinline__ void done(const Unit&) const {}
};
__device__ __forceinline__ unsigned cvt_pk_bf16(float lo, float hi) { unsigned r; asm volatile("v_cvt_pk_bf16_f32 %0, %1, %2" : "=v"(r) : "v"(lo), "v"(hi)); return r; }
typedef float f32x2 __attribute__((ext_vector_type(2)));
template <class Epi, class Sched, bool ALIGN_EPI = false, bool SP2 = false>
__device__ __forceinline__ void gemm_phase(PG8_LAS unsigned char* lds, const Gemm g, const Sched& S, const Epi& E) {
    if (Epi::TAG == PROBE_CK) TP_BEGIN(27, lds);
    const int tid = mk_tid(), wid = __builtin_amdgcn_readfirstlane(tid >> 6), lane = tid & 63, wr = wid >> 2, wc = wid & 3, fr = lane & 15, fq = lane >> 4;
    const int K = g.ld, nt = g.K / BK;
    unsigned voffA[2], voffB[2];
#pragma unroll
    for (int i = 0; i < 2; ++i) { int R, C; stage_rc(tid * 16 + i * 8192, R, C); const int Rb = Epi::PERM ? ((R & ~31) + perm32(R & 31)) : R;
        voffA[i] = (unsigned)(R * K + C) * 2u; voffB[i] = (unsigned)(Rb * K + C) * 2u; }
    const size_t kstep = (size_t)(BK * 2);
    const size_t hstep = (size_t)HALF * K * 2;
    const size_t tstep = 2 * hstep;
    const unsigned ldsw = (unsigned)wid * 1024u;
    const int aoff = lds_byte(wr * 64 + fr, fq * 8), boff = lds_byte(wc * 32 + fr, fq * 8);
#define PG8_SA(b, h) (((b) * 2 + (h)) * HTB)
#define PG8_SB(b, h) ((4 + (b) * 2 + (h)) * HTB)
#define PG8_STAGE(bufoff, gbase, voff) do { _Pragma("unroll") for (int _i = 0; _i < 2; ++_i) \
        __builtin_amdgcn_global_load_lds((const unsigned*)((const char*)(gbase) + (voff)[_i]), (PG8_LAS unsigned*)(lds + (bufoff) + ldsw + _i * 8192), 16, 0, 0); } while (0)
#define PG8_LDA(dst, b, h) do { _Pragma("unroll") for (int m = 0; m < 4; ++m) _Pragma("unroll") for (int k = 0; k < 2; ++k) dst[m][k] = *(const PG8_LAS bf16x8*)(lds + PG8_SA(b, h) + aoff + m * 2048 + k * 1024); } while (0)
#define PG8_LDB(dst, b, h) do { _Pragma("unroll") for (int n = 0; n < 2; ++n) _Pragma("unroll") for (int k = 0; k < 2; ++k) dst[n][k] = *(const PG8_LAS bf16x8*)(lds + PG8_SB(b, h) + boff + n * 2048 + k * 1024); } while (0)
#define PG8_MMA(ai, bj, At, Bt) do { __builtin_amdgcn_s_setprio(1); _Pragma("unroll") for (int m = 0; m < 4; ++m) _Pragma("unroll") for (int n = 0; n < 2; ++n) _Pragma("unroll") for (int k = 0; k < 2; ++k) \
        acc[ai][bj][m][n] = __builtin_amdgcn_mfma_f32_16x16x32_bf16(Bt[n][k], At[m][k], acc[ai][bj][m][n], 0, 0, 0); __builtin_amdgcn_s_setprio(0); } while (0)
#define PG8_WAIT_V(n) asm volatile("s_waitcnt vmcnt(" #n ")" ::: "memory")
#define PG8_WAIT_L(n) asm volatile("s_waitcnt lgkmcnt(" #n ")" ::: "memory")
#define PG8_BAR __builtin_amdgcn_s_barrier()
#define PG8_SCHED __builtin_amdgcn_sched_barrier(0)
    Unit cur, nxt; int ui = 0;
    if (!S.next(0, cur)) return;
    f32x4 acc[2][2][4][2];
#pragma unroll
    for (int a = 0; a < 2; ++a)
#pragma unroll
        for (int b = 0; b < 2; ++b)
#pragma unroll
            for (int m = 0; m < 4; ++m)
#pragma unroll
                for (int n = 0; n < 2; ++n) acc[a][b][m][n] = (f32x4){0.f, 0.f, 0.f, 0.f};
    bf16x8 At[4][2], B0[2][2], B1[2][2];
    const char* cA = (const char*)g.A + (size_t)cur.pm * tstep + (size_t)cur.koff * 2; const char* cB = (const char*)g.Bt + (size_t)cur.pn * tstep + (size_t)cur.koff * 2;
    S.a_ready(cur);
    if constexpr (SP2) {
        PG8_STAGE(PG8_SB(0, 0), cB, voffB); PG8_STAGE(PG8_SB(0, 1), cB + hstep, voffB); PG8_STAGE(PG8_SA(0, 0), cA, voffA); PG8_STAGE(PG8_SA(0, 1), cA + hstep, voffA);
        if (wr == 1) PG8_BAR;
        PG8_WAIT_V(2); PG8_BAR;
        PG8_STAGE(PG8_SB(1, 0), cB + kstep, voffB); PG8_STAGE(PG8_SA(1, 0), cA + kstep, voffA); PG8_STAGE(PG8_SB(1, 1), cB + hstep + kstep, voffB);
        PG8_WAIT_V(6); PG8_BAR;
    } else {
        PG8_STAGE(PG8_SB(0, 0), cB, voffB); PG8_STAGE(PG8_SA(0, 0), cA, voffA); PG8_STAGE(PG8_SB(0, 1), cB + hstep, voffB); PG8_STAGE(PG8_SA(0, 1), cA + hstep, voffA);
        if (wr == 1) PG8_BAR;
        PG8_WAIT_V(4); PG8_BAR;
        PG8_STAGE(PG8_SB(1, 0), cB + kstep, voffB); PG8_STAGE(PG8_SA(1, 0), cA + kstep, voffA); PG8_STAGE(PG8_SB(1, 1), cB + hstep + kstep, voffB);
        PG8_WAIT_V(6); PG8_BAR;
    }
    for (;;) {
        const bool has_next = S.next(ui + 1, nxt);
        const char* nA = has_next ? (const char*)g.A + (size_t)nxt.pm * tstep + (size_t)nxt.koff * 2 : cA; const char* nB = has_next ? (const char*)g.Bt + (size_t)nxt.pn * tstep + (size_t)nxt.koff * 2 : cB;
#pragma unroll 1
        for (int t = 0; t < nt; t += 2) {
            const bool last = (t == nt - 2);
            const char* a1 = cA + (size_t)(t + 1) * kstep;
            const char* a2 = last ? nA : cA + (size_t)(t + 2) * kstep; const char* b2 = last ? nB : cB + (size_t)(t + 2) * kstep;
            const char* a3 = a2 + kstep; const char* b3 = b2 + kstep;
            if (last && has_next) S.a_ready(nxt);
            if constexpr (SP2) {
            PG8_LDB(B0, 0, 0); PG8_LDB(B1, 0, 1); PG8_SCHED; PG8_LDA(At, 0, 0); PG8_STAGE(PG8_SA(1, 1), a1 + hstep, voffA);
            PG8_WAIT_V(8); PG8_WAIT_L(0); PG8_BAR; PG8_MMA(0, 0, At, B0); PG8_MMA(0, 1, At, B1); PG8_BAR; PG8_SCHED;
            PG8_LDA(At, 0, 1); PG8_STAGE(PG8_SB(0, 0), b2, voffB); PG8_STAGE(PG8_SB(0, 1), b2 + hstep, voffB); PG8_STAGE(PG8_SA(0, 0), a2, voffA);
            PG8_WAIT_V(8); PG8_WAIT_L(0); PG8_BAR; PG8_MMA(1, 0, At, B0); PG8_MMA(1, 1, At, B1); PG8_BAR; PG8_SCHED;
            PG8_LDB(B0, 1, 0); PG8_LDB(B1, 1, 1); PG8_SCHED; PG8_LDA(At, 1, 0); PG8_STAGE(PG8_SA(0, 1), a2 + hstep, voffA);
            PG8_WAIT_V(8); PG8_WAIT_L(0); PG8_BAR; PG8_MMA(0, 0, At, B0); PG8_MMA(0, 1, At, B1); PG8_BAR; PG8_SCHED;
            PG8_LDA(At, 1, 1); PG8_STAGE(PG8_SB(1, 0), b3, voffB); PG8_STAGE(PG8_SB(1, 1), b3 + hstep, voffB); PG8_STAGE(PG8_SA(1, 0), a3, voffA);
            PG8_WAIT_V(8); PG8_WAIT_L(0); PG8_BAR; PG8_MMA(1, 0, At, B0); PG8_MMA(1, 1, At, B1); PG8_BAR; PG8_SCHED;
            } else {
            PG8_LDB(B0, 0, 0); PG8_SCHED; PG8_LDA(At, 0, 0); PG8_STAGE(PG8_SA(1, 1), a1 + hstep, voffA);
            PG8_WAIT_L(8); PG8_BAR; PG8_WAIT_L(0); PG8_MMA(0, 0, At, B0); PG8_BAR; PG8_SCHED;
            PG8_LDB(B1, 0, 1); PG8_STAGE(PG8_SB(0, 0), b2, voffB);
            PG8_BAR; PG8_WAIT_L(0); PG8_MMA(0, 1, At, B1); PG8_BAR;
            PG8_LDA(At, 0, 1); PG8_STAGE(PG8_SA(0, 0), a2, voffA);
            PG8_BAR; PG8_WAIT_L(0); PG8_MMA(1, 0, At, B0); PG8_BAR; PG8_SCHED;
            PG8_STAGE(PG8_SB(0, 1), b2 + hstep, voffB);
            PG8_WAIT_V(6); PG8_BAR; PG8_MMA(1, 1, At, B1); PG8_BAR;
            PG8_LDB(B0, 1, 0); PG8_SCHED; PG8_LDA(At, 1, 0); PG8_STAGE(PG8_SA(0, 1), a2 + hstep, voffA);
            PG8_WAIT_L(8); PG8_BAR; PG8_WAIT_L(0); PG8_MMA(0, 0, At, B0); PG8_BAR; PG8_SCHED;
            PG8_LDB(B1, 1, 1); PG8_STAGE(PG8_SB(1, 0), b3, voffB);
            PG8_BAR; PG8_WAIT_L(0); PG8_MMA(0, 1, At, B1); PG8_BAR;
            PG8_LDA(At, 1, 1); PG8_STAGE(PG8_SA(1, 0), a3, voffA);
            PG8_BAR; PG8_WAIT_L(0); PG8_MMA(1, 0, At, B0); PG8_BAR; PG8_SCHED;
            PG8_STAGE(PG8_SB(1, 1), b3 + hstep, voffB);
            PG8_WAIT_V(6); PG8_BAR; PG8_MMA(1, 1, At, B1); PG8_BAR;
            }
        }
        TP_BEGIN(26, lds); if constexpr (ALIGN_EPI) { if (wr == 0) PG8_BAR; } TP_END(26, lds);
        if (Epi::TAG == PROBE_CK) TP_BEGIN(25, lds); if constexpr (!Epi::AFTER_DRAIN) { E(acc, cur, wr, wc, fr, fq); S.done(cur); } if (((PROBE_T >> 25) & 1) && Epi::TAG == PROBE_CK) { asm volatile("s_waitcnt vmcnt(0)" ::: "memory"); TP_END(25, lds); }
        if (!has_next) break;
#pragma unroll
        for (int a = 0; a < 2; ++a)
#pragma unroll
            for (int b = 0; b < 2; ++b)
#pragma unroll
                for (int m = 0; m < 4; ++m)
#pragma unroll
                    for (int n = 0; n < 2; ++n) acc[a][b][m][n] = (f32x4){0.f, 0.f, 0.f, 0.f};
        cur = nxt; cA = nA; cB = nB; ++ui;
        if constexpr (ALIGN_EPI) { if (wr == 1) PG8_BAR; }
    }
    PG8_WAIT_V(0);
    if constexpr (!ALIGN_EPI) { if (wr == 0) PG8_BAR; }
    PG8_BAR;
    if constexpr (Epi::AFTER_DRAIN) { E.fused(acc, cur, wr, wc, fr, fq, lds, wid, lane); S.done(cur); }
    if (Epi::TAG == PROBE_CK) TP_END(27, lds);
#undef PG8_SA
#undef PG8_SB
#undef PG8_STAGE
#undef PG8_LDA
#undef PG8_LDB
#undef PG8_MMA
#undef PG8_WAIT_V
#undef PG8_WAIT_L
#undef PG8_BAR
#undef PG8_SCHED
}
}

namespace pg8 {
__device__ __forceinline__ float fast_sigmoid(float x) { return __builtin_amdgcn_rcpf(1.0f + __builtin_amdgcn_exp2f(-1.4426950408889634f * x)); }
constexpr int RSTD_TAB_OFF = STAGE_BYTES, RSTD_MAX_UNITS = 8;
template <class Sched> __device__ __forceinline__ void rstd_table(PG8_LAS unsigned char* lds, const float* rss, const Sched& S) {
    PG8_LAS float* tab = (PG8_LAS float*)(lds + RSTD_TAB_OFF); const int tid = mk_tid(), r = tid & 255, par = __builtin_amdgcn_readfirstlane(tid >> 8);
    f32x4 q[4][4]; bool ok[4];
#pragma unroll
    for (int it = 0; it < 4; ++it) { Unit u; const int ui = 2 * it + par; ok[it] = S.next(ui, u);
        if (ok[it]) { const f32x4* src = (const f32x4*)(rss + ((size_t)u.pm * BM + r) * 16);
#pragma unroll
            for (int k = 0; k < 4; ++k) q[it][k] = src[k]; } }
#pragma unroll
    for (int it = 0; it < 4; ++it) if (ok[it]) { const f32x4 a = q[it][0], b = q[it][1], c = q[it][2], d = q[it][3];
        const float s = (((a[0] + a[1]) + (a[2] + a[3])) + ((b[0] + b[1]) + (b[2] + b[3]))) + (((c[0] + c[1]) + (c[2] + c[3])) + ((d[0] + d[1]) + (d[2] + d[3])));
        tab[(2 * it + par) * 256 + r] = 1.0f / sqrtf(s * (1.0f / 1024.f) + 1e-6f); }
    asm volatile("s_waitcnt lgkmcnt(0)" ::: "memory"); __syncthreads();
}
__device__ __forceinline__ void rstd8(const PG8_LAS float* tab, int ui, int rl0, float (&rs)[8]) {
    if (!tab) {
#pragma unroll
        for (int i = 0; i < 8; ++i) rs[i] = 1.0f;
        return; }
#pragma unroll
    for (int i = 0; i < 8; ++i) rs[i] = tab[ui * 256 + rl0 + (i >> 2) * HALF + (i & 3) * 16];
}
struct EpiStore16 {
    static constexpr bool PERM = true, AFTER_DRAIN = false; static constexpr int TAG = 3;
    bf16_t* O; int ldc; const PG8_LAS float* tab;
    __device__ __forceinline__ void operator()(const f32x4 (&acc)[2][2][4][2], const Unit& u, int wr, int wc, int fr, int fq) const {
        const int row0 = u.pm * BM + wr * 64 + fr, col0 = u.cn * BM + wc * 32 + 8 * fq;
        float rs[8]; rstd8(tab, u.ui, wr * 64 + fr, rs);
#pragma unroll
        for (int ai = 0; ai < 2; ++ai)
#pragma unroll
            for (int m = 0; m < 4; ++m) { const int row = row0 + ai * HALF + m * 16; bf16_t* rowp = O + (size_t)row * ldc + col0; const float r = rs[ai * 4 + m];
#pragma unroll
                for (int bj = 0; bj < 2; ++bj) { const f32x4 v0 = acc[ai][bj][m][0] * r, v1 = acc[ai][bj][m][1] * r;
                    u32x4 w; w.x = cvt_pk_bf16(v0[0], v0[1]); w.y = cvt_pk_bf16(v0[2], v0[3]); w.z = cvt_pk_bf16(v1[0], v1[1]); w.w = cvt_pk_bf16(v1[2], v1[3]);
                    *(u32x4*)(rowp + bj * HALF) = w; } }
    }
};
__device__ __forceinline__ float sq8(const u32x4 w) { float s = 0.f;
#pragma unroll
    for (int i = 0; i < 4; ++i) { const float a = __uint_as_float(w[i] << 16), b = __uint_as_float(w[i] & 0xffff0000u); s += a * a + b * b; } return s; }
struct EpiAddH {
    static constexpr bool PERM = true, AFTER_DRAIN = false; static constexpr int TAG = 1;
    bf16_t* Hb; int ldc; float* rss_out;
    __device__ __forceinline__ void operator()(const f32x4 (&acc)[2][2][4][2], const Unit& u, int wr, int wc, int fr, int fq) const {
        const int row0 = u.pm * BM + wr * 64 + fr, col0 = u.cn * BM + wc * 32 + 8 * fq;
        u32x4 h[2][4][2];
#pragma unroll
        for (int ai = 0; ai < 2; ++ai)
#pragma unroll
            for (int m = 0; m < 4; ++m)
#pragma unroll
                for (int bj = 0; bj < 2; ++bj) h[ai][m][bj] = *(const u32x4*)(Hb + (size_t)(row0 + ai * HALF + m * 16) * ldc + col0 + bj * HALF);
        __builtin_amdgcn_sched_barrier(0);
#pragma unroll
        for (int ai = 0; ai < 2; ++ai)
#pragma unroll
            for (int m = 0; m < 4; ++m) { const int row = row0 + ai * HALF + m * 16; float ss = 0.f;
#pragma unroll
                for (int bj = 0; bj < 2; ++bj) { const u32x4 q = h[ai][m][bj]; const f32x4 a0 = acc[ai][bj][m][0], a1 = acc[ai][bj][m][1]; u32x4 w;
                    w.x = cvt_pk_bf16(__uint_as_float(q.x << 16) + a0[0], __uint_as_float(q.x & 0xffff0000u) + a0[1]); w.y = cvt_pk_bf16(__uint_as_float(q.y << 16) + a0[2], __uint_as_float(q.y & 0xffff0000u) + a0[3]);
                    w.z = cvt_pk_bf16(__uint_as_float(q.z << 16) + a1[0], __uint_as_float(q.z & 0xffff0000u) + a1[1]); w.w = cvt_pk_bf16(__uint_as_float(q.w << 16) + a1[2], __uint_as_float(q.w & 0xffff0000u) + a1[3]);
                    *(u32x4*)(Hb + (size_t)row * ldc + col0 + bj * HALF) = w; ss += sq8(w); }
                ss += __shfl_xor(ss, 16); ss += __shfl_xor(ss, 32);
                if (fq == 0) rss_out[(size_t)row * 16 + u.cn * 4 + wc] = ss; }
    }
};
struct EpiSwiglu {
    static constexpr bool PERM = true, AFTER_DRAIN = false; static constexpr int TAG = 4;
    bf16_t* O; int ldc; const PG8_LAS float* tab;
    __device__ __forceinline__ void operator()(const f32x4 (&acc)[2][2][4][2], const Unit& u, int wr, int wc, int fr, int fq) const {
        const int row0 = u.pm * BM + wr * 64 + fr, col0 = u.cn * HALF + wc * 32 + 8 * fq;
        float rs[8]; rstd8(tab, u.ui, wr * 64 + fr, rs);
#pragma unroll
        for (int ai = 0; ai < 2; ++ai)
#pragma unroll
            for (int m = 0; m < 4; ++m) { const int row = row0 + ai * HALF + m * 16; bf16_t* rowp = O + (size_t)row * ldc + col0; float o[8]; const float r = rs[ai * 4 + m];
#pragma unroll
                for (int n = 0; n < 2; ++n)
#pragma unroll
                    for (int j = 0; j < 4; ++j) { const float gt = acc[ai][0][m][n][j] * r, up = acc[ai][1][m][n][j] * r; o[n * 4 + j] = gt * fast_sigmoid(gt) * up; }
                u32x4 w; w.x = cvt_pk_bf16(o[0], o[1]); w.y = cvt_pk_bf16(o[2], o[3]); w.z = cvt_pk_bf16(o[4], o[5]); w.w = cvt_pk_bf16(o[6], o[7]);
                *(u32x4*)rowp = w; }
    }
};
struct EpiPleF {
    static constexpr bool PERM = true, AFTER_DRAIN = false; static constexpr int TAG = 2;
    const bf16_t* Hin; bf16_t* Hout; const bf16_t* PJ; int ldc; const PG8_LAS float* tab; float* rss_out;
    __device__ __forceinline__ void operator()(const f32x4 (&acc)[2][2][4][2], const Unit& u, int wr, int wc, int fr, int fq) const {
        const int row0 = u.pm * BM + wr * 64 + fr, col0 = u.cn * BM + wc * 32 + 8 * fq;
        float rs[8]; rstd8(tab, u.ui, wr * 64 + fr, rs);
#pragma unroll
        for (int ai = 0; ai < 2; ++ai) { u32x4 h[4][2], pj[4][2];
#pragma unroll
            for (int m = 0; m < 4; ++m)
#pragma unroll
                for (int bj = 0; bj < 2; ++bj) { const size_t off = (size_t)(row0 + ai * HALF + m * 16) * ldc + col0 + bj * HALF; h[m][bj] = *(const u32x4*)(Hin + off); pj[m][bj] = *(const u32x4*)(PJ + off); }
            __builtin_amdgcn_sched_barrier(0);
#pragma unroll
            for (int m = 0; m < 4; ++m) { const int row = row0 + ai * HALF + m * 16; const float r = rs[ai * 4 + m]; float ss = 0.f;
#pragma unroll
                for (int bj = 0; bj < 2; ++bj) { const u32x4 hh = h[m][bj], q = pj[m][bj]; u32x4 w;
#pragma unroll
                    for (int i = 0; i < 4; ++i) { const float a_lo = acc[ai][bj][m][i >> 1][(i & 1) * 2] * r, a_hi = acc[ai][bj][m][i >> 1][(i & 1) * 2 + 1] * r;
                        w[i] = cvt_pk_bf16(__uint_as_float(hh[i] << 16) + __uint_as_float(q[i] << 16) * fast_sigmoid(a_lo), __uint_as_float(hh[i] & 0xffff0000u) + __uint_as_float(q[i] & 0xffff0000u) * fast_sigmoid(a_hi)); }
                    *(u32x4*)(Hout + (size_t)row * ldc + col0 + bj * HALF) = w; ss += sq8(w); }
                ss += __shfl_xor(ss, 16); ss += __shfl_xor(ss, 32);
                if (fq == 0) rss_out[(size_t)row * 16 + u.cn * 4 + wc] = ss; }
            asm volatile("" ::: "memory"); }
    }
};
struct ExpertOrder : StaticOrder {
    const int* tile_e;
    __device__ __forceinline__ bool next(int i, Unit& u) const { if (!StaticOrder::next(i, u)) return false; if (tile_e) u.pn += tile_e[u.pm] * nN; return true; }
};
struct UpperHalfOrder : StaticOrder {
    __host__ __device__ void init2(int M, int N, int G_, int c_) { init(M, N, G_ / 2, c_ - G_ / 2); if (c_ < G_ / 2) c = nwg; }
};
struct MoeDownOrder {
    int nwg, nfull, G, c, ks_n, kslice; const int* tile_e;
    __device__ __forceinline__ bool next(int i, Unit& u) const {
        const int q = i * G + c; int L;
        if (ks_n == 0) { L = q; if (L >= nfull) return false; u.koff = 0; u.ks = 0; }
        else { if (q >= (nwg - nfull) * ks_n) return false; L = nfull + q / ks_n; u.ks = q % ks_n; u.koff = u.ks * kslice; }
        u.pm = L >> 2; u.cn = L & 3; u.pn = u.cn + tile_e[u.pm] * 4; u.ui = i; return true;
    }
    __device__ __forceinline__ void a_ready(const Unit&) const {}
    __device__ __forceinline__ void done(const Unit&) const {}
};
struct EpiMoeDown {
    static constexpr bool PERM = true, AFTER_DRAIN = false; static constexpr int TAG = 5;
    bf16_t* O; bf16_t* P; size_t pstride; int row0p;
    __device__ __forceinline__ void operator()(const f32x4 (&acc)[2][2][4][2], const Unit& u, int wr, int wc, int fr, int fq) const {
        const int col0 = u.cn * BM + wc * 32 + 8 * fq; const int rowt = u.pm * BM + wr * 64 + fr;
        bf16_t* base = u.ks == 0 ? O + (size_t)rowt * 1024 : P + (size_t)(u.ks - 1) * pstride + (size_t)(rowt - row0p) * 1024;
#pragma unroll
        for (int ai = 0; ai < 2; ++ai)
#pragma unroll
            for (int m = 0; m < 4; ++m) { bf16_t* rowp = base + (size_t)(ai * HALF + m * 16) * 1024 + col0;
#pragma unroll
                for (int bj = 0; bj < 2; ++bj) { const f32x4 v0 = acc[ai][bj][m][0], v1 = acc[ai][bj][m][1];
                    u32x4 w; w.x = cvt_pk_bf16(v0[0], v0[1]); w.y = cvt_pk_bf16(v0[2], v0[3]); w.z = cvt_pk_bf16(v1[0], v1[1]); w.w = cvt_pk_bf16(v1[2], v1[3]);
                    *(u32x4*)(rowp + bj * HALF) = w; } }
    }
};
}

namespace fp {
using namespace mdl;
#define FLAS __attribute__((address_space(3)))
typedef float f32x4 __attribute__((ext_vector_type(4)));
typedef float f32x2 __attribute__((ext_vector_type(2)));
typedef unsigned u32x4 __attribute__((ext_vector_type(4)));
typedef unsigned u32x2 __attribute__((ext_vector_type(2)));
typedef __bf16 bf16x2_t __attribute__((ext_vector_type(2)));
__device__ __forceinline__ unsigned pk2(float lo, float hi) { f32x2 v = {lo, hi}; bf16x2_t b = __builtin_convertvector(v, bf16x2_t); return __builtin_bit_cast(unsigned, b); }
__device__ __forceinline__ float blo(unsigned w) { return __uint_as_float(w << 16); }
__device__ __forceinline__ float bhi(unsigned w) { return __uint_as_float(w & 0xffff0000u); }
template <int CTRL, int ROWMASK> __device__ __forceinline__ float dpp_add(float v) {
    return v + __builtin_bit_cast(float, __builtin_amdgcn_update_dpp(0, __builtin_bit_cast(int, v), CTRL, ROWMASK, 0xF, false)); }
__device__ __forceinline__ float wave_sum(float v) {
    v = dpp_add<0xB1, 0xF>(v);
    v = dpp_add<0x4E, 0xF>(v);
    v = dpp_add<0x141, 0xF>(v);
    v = dpp_add<0x140, 0xF>(v);
    v = dpp_add<0x142, 0xA>(v);
    v = dpp_add<0x143, 0xC>(v);
    return __builtin_bit_cast(float, __builtin_amdgcn_readlane(__builtin_bit_cast(int, v), 63));
}
#define FP_LDS_WAIT() asm volatile("s_waitcnt lgkmcnt(0)" ::: "memory")
template <int ROWS, int ROWB, int PB, int NTHR_> __device__ __forceinline__ void tile_out(const FLAS unsigned char* st, unsigned char* gbase, size_t gpitch, int t) {
    constexpr int CPR = ROWB / 16, N = ROWS * CPR;
#pragma unroll
    for (int i0 = 0; i0 < N; i0 += NTHR_) { const int i = i0 + t; if (N % NTHR_ == 0 || i < N) { const int r = i / CPR, c = i % CPR; *(u32x4*)(gbase + (size_t)r * gpitch + c * 16) = *(const FLAS u32x4*)(st + r * PB + c * 16); } }
}

template <class Map> __device__ __forceinline__ void tr_item(const float* W, int Nsrc, const Map& map, bf16* WT, int K, int k0, int n0, FLAS float* scr, int lane, const float* gain = nullptr) {
    const int nl = lane & 31, c = map(n0 + nl), cc = lane & 7;
    f32x4 g0 = (f32x4){1.f, 1.f, 1.f, 1.f}, g1 = g0;
    if (gain) { g0 = *(const f32x4*)(gain + k0 + 8 * cc); g1 = *(const f32x4*)(gain + k0 + 8 * cc + 4); }
    float wv[32];
#pragma unroll
    for (int i = 0; i < 32; ++i) { const int kk = 2 * i + (lane >> 5); wv[i] = c >= 0 ? W[(size_t)(k0 + kk) * Nsrc + c] : 0.f; }
    __builtin_amdgcn_sched_barrier(0);
#pragma unroll
    for (int i = 0; i < 32; ++i) { const int kk = 2 * i + (lane >> 5); scr[kk * 33 + nl] = wv[i]; }
    FP_LDS_WAIT(); asm volatile("" ::: "memory");
#pragma unroll
    for (int j = 0; j < 4; ++j) { const int n = (lane >> 3) + 8 * j; const FLAS float* s = scr + (8 * cc) * 33 + n;
        u32x4 o; o.x = pk2(s[0 * 33] * g0.x, s[1 * 33] * g0.y); o.y = pk2(s[2 * 33] * g0.z, s[3 * 33] * g0.w); o.z = pk2(s[4 * 33] * g1.x, s[5 * 33] * g1.y); o.w = pk2(s[6 * 33] * g1.z, s[7 * 33] * g1.w);
        *(u32x4*)(WT + (size_t)(n0 + n) * K + k0 + 8 * cc) = o; }
    FP_LDS_WAIT(); asm volatile("" ::: "memory");
}
struct MapId { __device__ __forceinline__ int operator()(int n) const { return n; } };
struct MapLt { int lim; __device__ __forceinline__ int operator()(int n) const { return n < lim ? n : -1; } };
struct MapU { __device__ __forceinline__ int operator()(int n) const { return ucol_src(n); } };
struct MapOff { int off; __device__ __forceinline__ int operator()(int n) const { return n + off; } };
__device__ __forceinline__ void prologue(const MP& p, FLAS unsigned char* lds, int bx, int G) {
    const int tid = mk_tid(), lane = tid & 63, wave = __builtin_amdgcn_readfirstlane(tid >> 6);
    FLAS float* scr = (FLAS float*)(lds + wave * 16384);
    const int gw = bx * 8 + wave, NGW = G * 8;
    constexpr int I_WIN = (D / 64) * (NU / 32), I_UQ = 4 * 16, I_UKV = 2 * 16, I_DD = 16 * 32, I_PP = 4 * 32, I_GU = 16 * (NGU / 32), I_DN = (DFF / 64) * 32;
    constexpr int PER_L = I_WIN + I_UQ + I_UKV + 2 * I_DD + I_PP, NITEMS = DEPTH * PER_L + 18 * (I_GU + I_DN);
    for (int it = gw; it < NITEMS; it += NGW) {
        int r = it;
        if (r < DEPTH * PER_L) { const int l = r / PER_L; r %= PER_L;
            if (r < I_WIN) { tr_item(p.w_in + (size_t)l * D * NUO, NUO, MapU{}, p.WIN + (size_t)l * NU * D, D, 64 * (r / (NU / 32)), 32 * (r % (NU / 32)), scr, lane, p.attn_g + l * D); continue; } r -= I_WIN;
            if (r < I_UQ) { tr_item(p.w_uq + (size_t)l * 256 * 384, 384, MapLt{384}, p.WUQ + (size_t)l * 512 * 256, 256, 64 * (r / 16), 32 * (r % 16), scr, lane); continue; } r -= I_UQ;
            if (r < I_UKV) { tr_item(p.w_ukv + (size_t)l * 128 * 512, 512, MapId{}, p.WUKV + (size_t)l * 512 * 128, 128, 64 * (r / 16), 32 * (r % 16), scr, lane); continue; } r -= I_UKV;
            if (r < I_DD) { tr_item(p.w_out + (size_t)l * D * D, D, MapId{}, p.WOUT + (size_t)l * D * D, D, 64 * (r / 32), 32 * (r % 32), scr, lane); continue; } r -= I_DD;
            if (r < I_DD) { tr_item(p.ple_wg + (size_t)l * D * D, D, MapId{}, p.WPG + (size_t)l * D * D, D, 64 * (r / 32), 32 * (r % 32), scr, lane, p.ple_g + l * D); continue; } r -= I_DD;
            tr_item(p.ple_wp + (size_t)l * PLE * D, D, MapId{}, p.WPP + (size_t)l * D * PLE, PLE, 64 * (r / 32), 32 * (r % 32), scr, lane); continue; }
        r -= DEPTH * PER_L;
        if (r < 18 * I_GU) { const int mt = r / I_GU; r %= I_GU; const int k0 = 64 * (r / (NGU / 32)), n0 = 32 * (r % (NGU / 32)); const int tl = n0 / 256, rr = n0 % 256;
            const float* src; bf16* dst;
            if (mt < 2) { src = (rr < 128 ? p.dwg : p.dwu) + (size_t)mt * D * DFF; dst = p.DWGU + (size_t)mt * NGU * D; } else { src = (rr < 128 ? p.mwg : p.mwu) + (size_t)(mt - 2) * D * DFF; dst = p.MWGU + (size_t)(mt - 2) * NGU * D; }
            const int Lg = mt < 2 ? 2 * mt : 2 * ((mt - 2) >> 3) + 1;
            tr_item(src, DFF, MapOff{tl * 128 + (rr & 127) - n0}, dst, D, k0, n0, scr, lane, p.ffn_g + Lg * D); continue; }
        r -= 18 * I_GU;
        { const int mt = r / I_DN; r %= I_DN; const float* src; bf16* dst;
            if (mt < 2) { src = p.dwd + (size_t)mt * DFF * D; dst = p.DWD + (size_t)mt * D * DFF; } else { src = p.mwd + (size_t)(mt - 2) * DFF * D; dst = p.MWD + (size_t)(mt - 2) * D * DFF; }
            tr_item(src, D, MapId{}, dst, DFF, 64 * (r / 32), 32 * (r % 32), scr, lane); }
    }
    const long g0 = (long)bx * 512 + tid, gs = (long)G * 512;
    for (long t = gw; t < p.T; t += NGW) { const f32x4* xr = (const f32x4*)(p.x + t * D) + lane; u32x2* o = (u32x2*)(p.HB + t * D) + lane; float ss = 0.f;
#pragma unroll
        for (int j = 0; j < 4; ++j) { const f32x4 v = xr[64 * j]; u32x2 wv; wv.x = pk2(v.x, v.y); wv.y = pk2(v.z, v.w); o[64 * j] = wv; const float a = blo(wv.x), b = bhi(wv.x), c = blo(wv.y), d = bhi(wv.y); ss += (a * a + b * b) + (c * c + d * d); }
        ss = wave_sum(ss); if (lane < 16) rss_ptr(p, 0, 0)[t * 16 + lane] = lane == 0 ? ss : 0.f; }
    for (long i = g0; i < (long)DEPTH * p.T * PLE / 4; i += gs) { const f32x4 v = ((const f32x4*)p.p)[i]; u32x2 o; o.x = pk2(v.x, v.y); o.y = pk2(v.z, v.w); ((u32x2*)p.PB16)[i] = o; }
    for (long i = g0; i < p.T * 16; i += gs) { const long t = i / 16; const int j = (int)(i % 16); const float inv = powf(10000.0f, -(float)(2 * j) / 32.0f), ang = (float)p.pos[t] * inv;
        p.CS[t * 32 + j] = cosf(ang); p.CS[t * 32 + 16 + j] = sinf(ang); }
}
template <int MODE> __device__ __forceinline__ void norm_phase(const MP& p, int L, const float* g, bf16* hb, int bx, int G, FLAS unsigned* lcnt = nullptr, const bf16* part = nullptr) {
    const int tid = mk_tid(), lane = tid & 63, wave = __builtin_amdgcn_readfirstlane(tid >> 6);
    const int gw = bx * 8 + wave, NGW = G * 8;
    const f32x4* gr = (const f32x4*)g + lane;
    bf16* const HBN = (bf16*)p.H;
    f32x4 Rr[MODE == 1 ? 32 : 1];
    if (MODE == 1) { __syncthreads(); if (tid < NE) lcnt[tid] = 0u; __syncthreads(); const f32x4* R = (const f32x4*)(p.router + (size_t)(L >> 1) * D * NE);
#pragma unroll
        for (int j = 0; j < 4; ++j)
#pragma unroll
            for (int c = 0; c < 4; ++c) { const int idx = 4 * (lane + 64 * j) + c; Rr[(j * 4 + c) * 2] = R[idx * 2]; Rr[(j * 4 + c) * 2 + 1] = R[idx * 2 + 1]; } }
    for (long t = gw; t < p.T; t += NGW) {
        u32x2* hr = (u32x2*)(hb + t * D) + lane; f32x4 v[4];
#pragma unroll
        for (int j = 0; j < 4; ++j) { const u32x2 q = hr[64 * j]; v[j] = (f32x4){blo(q.x), bhi(q.x), blo(q.y), bhi(q.y)}; }
        if (MODE == 2) { const int sl[2] = {p.TOKSLOT[t * 2], p.TOKSLOT[t * 2 + 1]}; const float gt[2] = {p.TOPG[t * 2], p.TOPG[t * 2 + 1]};
            const int row0p = p.TILE_E[1000], ksn = p.TILE_E[1001]; const size_t pstride = (size_t)p.TILE_E[1002] * D;
#pragma unroll
            for (int k = 0; k < 2; ++k) { const u32x2* y0 = (const u32x2*)(p.YS + (size_t)sl[k] * D) + lane; u32x2 q[4];
#pragma unroll
                for (int j = 0; j < 4; ++j) q[j] = y0[64 * j];
                float acc[4][4];
#pragma unroll
                for (int j = 0; j < 4; ++j) { acc[j][0] = blo(q[j].x); acc[j][1] = bhi(q[j].x); acc[j][2] = blo(q[j].y); acc[j][3] = bhi(q[j].y); }
                if (sl[k] >= row0p) for (int s = 1; s < ksn; ++s) { const u32x2* yp = (const u32x2*)(part + (size_t)(s - 1) * pstride + (size_t)(sl[k] - row0p) * D) + lane;
#pragma unroll
                    for (int j = 0; j < 4; ++j) { const u32x2 r = yp[64 * j]; acc[j][0] += blo(r.x); acc[j][1] += bhi(r.x); acc[j][2] += blo(r.y); acc[j][3] += bhi(r.y); } }
#pragma unroll
                for (int j = 0; j < 4; ++j) { v[j].x += gt[k] * acc[j][0]; v[j].y += gt[k] * acc[j][1]; v[j].z += gt[k] * acc[j][2]; v[j].w += gt[k] * acc[j][3]; } }
#pragma unroll
            for (int j = 0; j < 4; ++j) { u32x2 wv; wv.x = pk2(v[j].x, v[j].y); wv.y = pk2(v[j].z, v[j].w); hr[64 * j] = wv; v[j] = (f32x4){blo(wv.x), bhi(wv.x), blo(wv.y), bhi(wv.y)}; } }
        float ss = 0.f;
#pragma unroll
        for (int j = 0; j < 4; ++j) ss += (v[j].x * v[j].x + v[j].y * v[j].y) + (v[j].z * v[j].z + v[j].w * v[j].w);
        ss = wave_sum(ss);
        const float r = 1.0f / sqrtf(ss * (1.0f / D) + RMS_EPS);
        if (MODE == 2) { if (lane < 16) rss_ptr(p, L, 2)[t * 16 + lane] = lane == 0 ? ss : 0.f; }
        if (MODE == 1) { u32x2* o = (u32x2*)(HBN + t * D) + lane;
#pragma unroll
            for (int j = 0; j < 4; ++j) { u32x2 w; w.x = pk2(v[j].x * r, v[j].y * r); w.y = pk2(v[j].z * r, v[j].w * r); o[64 * j] = w; } }
        if (MODE == 1 || MODE == 3) {
#pragma unroll
            for (int j = 0; j < 4; ++j) { const f32x4 gv = gr[64 * j]; v[j].x *= r * gv.x; v[j].y *= r * gv.y; v[j].z *= r * gv.z; v[j].w *= r * gv.w; } }
        if (MODE == 3) {
#pragma unroll
            for (int j = 0; j < 4; ++j) ((f32x4*)(p.out + t * D) + lane)[64 * j] = v[j];
        }
        if (MODE == 1) { float lg[NE];
#pragma unroll
            for (int e = 0; e < NE; ++e) lg[e] = 0.f;
#pragma unroll
            for (int j = 0; j < 4; ++j)
#pragma unroll
                for (int c = 0; c < 4; ++c) { const f32x4 r0 = Rr[(j * 4 + c) * 2], r1 = Rr[(j * 4 + c) * 2 + 1]; const float x = v[j][c];
                    lg[0] += x * r0.x; lg[1] += x * r0.y; lg[2] += x * r0.z; lg[3] += x * r0.w; lg[4] += x * r1.x; lg[5] += x * r1.y; lg[6] += x * r1.z; lg[7] += x * r1.w; }
#pragma unroll
            for (int e = 0; e < NE; ++e) lg[e] = wave_sum(lg[e]);
            int e0 = 0; float v0 = lg[0];
#pragma unroll
            for (int e = 1; e < NE; ++e) if (lg[e] > v0) { v0 = lg[e]; e0 = e; }
            int e1 = -1; float v1 = -3.0e38f;
#pragma unroll
            for (int e = 0; e < NE; ++e) if (e != e0 && lg[e] > v1) { v1 = lg[e]; e1 = e; }
            if (lane == 0) { const float g1 = 1.0f / (1.0f + expf(v0 - v1));
                p.TOPE[t * 2] = e0; p.TOPE[t * 2 + 1] = e1; p.TOPG[t * 2] = 1.0f - g1; p.TOPG[t * 2 + 1] = g1;
                p.POS[t * 2] = (int)__hip_atomic_fetch_add(lcnt + e0, 1u, __ATOMIC_RELAXED, __HIP_MEMORY_SCOPE_WORKGROUP); p.POS[t * 2 + 1] = (int)__hip_atomic_fetch_add(lcnt + e1, 1u, __ATOMIC_RELAXED, __HIP_MEMORY_SCOPE_WORKGROUP); } }
    }
    if (MODE == 1) { __syncthreads(); if (tid < NE) p.BCNT[bx * NE + tid] = (int)lcnt[tid]; }
}
__device__ __forceinline__ void moeplan(const MP& p, int L, FLAS unsigned char* lds, int bx, int G) {
    const int tid = mk_tid(), lane = tid & 63, wave = __builtin_amdgcn_readfirstlane(tid >> 6), j = L >> 1;
    const int gw = bx * 8 + wave, NGW = G * 8;
    FLAS int* base = (FLAS int*)lds;
    FLAS int* pst = (FLAS int*)(lds + 16384);
    __syncthreads();
    {
        const int e = wave; int c[4], s = 0;
#pragma unroll
        for (int i = 0; i < 4; ++i) { const int b = lane * 4 + i; c[i] = b < G ? p.BCNT[b * NE + e] : 0; s += c[i]; }
        int inc = s;
#pragma unroll
        for (int o = 1; o < 64; o <<= 1) { const int t = __shfl_up(inc, o); if (lane >= o) inc += t; }
        int ex = inc - s;
#pragma unroll
        for (int i = 0; i < 4; ++i) { const int b = lane * 4 + i; if (b < G) base[b * NE + e] = ex; ex += c[i]; }
        if (lane == 63) pst[e] = inc;
    }
    __syncthreads();
    if (tid == 0) { int o = 0; for (int e = 0; e < NE; ++e) { const int cnt = pst[e]; pst[e] = o; if (bx == 0) cnt_ptr(p, j)[e] = (unsigned)cnt; o += ((cnt + 255) / 256) * 256; } pst[NE] = o; }
    __syncthreads();
    for (long i = gw; i < p.T * 2; i += NGW) { const long t = i >> 1; const int e = p.TOPE[i], blk = (int)((t % NGW) >> 3); const int slot = pst[e] + base[blk * NE + e] + p.POS[i]; if (lane == 0) p.TOKSLOT[i] = slot;
        const u32x4* s = (const u32x4*)((const bf16*)p.H + t * D) + lane; u32x4* d = (u32x4*)(p.XB + (size_t)slot * D) + lane; const u32x4 a = s[0], b = s[64]; d[0] = a; d[64] = b; }
    if (bx == 0) for (int i = tid; i < 1024; i += 512) { int e = -1; if (i * 256 < pst[NE]) { e = 0; for (int q = 1; q < NE; ++q) if (i * 256 >= pst[q]) e = q; } p.TILE_E[i] = e; }
    __syncthreads();
}
typedef short bf16x8 __attribute__((ext_vector_type(8)));
typedef short bf16x4 __attribute__((ext_vector_type(4)));
constexpr int AT_KP = 112, AT_VP = 136, AT_KBYTES = 128 * AT_KP * 2, AT_BUF = AT_KBYTES + 80 * AT_VP * 2;
__device__ __forceinline__ void attn_phase(const MP& p, FLAS unsigned char* lds, int bx, int G) {
    const int S = (int)p.S, nunits = (int)p.B * 4 * 8;
    const int vcu = (G % 8 == 0) ? (bx % 8) * (G / 8) + bx / 8 : bx;
    { const int tid0 = mk_tid(); __syncthreads();
      for (int e = tid0; e < 2 * 16 * AT_VP; e += 512) { const int bufi = e / (16 * AT_VP), r = (e % (16 * AT_VP)) / AT_VP, c = e % AT_VP; ((FLAS bf16*)(lds + bufi * AT_BUF + AT_KBYTES))[(64 + r) * AT_VP + c] = r == 0 ? (bf16)0x3f80 : (bf16)0; } }
    for (int u = vcu; u < nunits; u += G) {
        const int tid = mk_tid(), lane = tid & 63, w = __builtin_amdgcn_readfirstlane(tid >> 6), fr = lane & 15, fq = lane >> 4;
        int kro[3], kco[3];
#pragma unroll
        for (int i = 0; i < 3; ++i) { const int c = tid + 512 * i; kro[i] = c / 12; kco[i] = c % 12; }
        const int vd = tid >> 4, vkc = tid & 15;
        const int bh = u >> 3, jp = u & 7, b = bh >> 2, h = bh & 3;
        const bf16* Kg = p.KK + (size_t)b * S * 384 + h * 96; const bf16* Vg = p.V + (size_t)bh * 64 * S;
        for (int half = 0; half < 2; ++half) {
            const int qb = half ? 15 - jp : jp, q0 = qb * 128, qmin = q0 + 16 * w, qglob = qmin + fr;
            const size_t trow = (size_t)b * S + qglob;
            bf16x8 qf[3];
#pragma unroll
            for (int ks = 0; ks < 3; ++ks) qf[ks] = *(const bf16x8*)(p.Q + trow * 384 + h * 96 + ks * 32 + fq * 8);
            f32x4 o[5];
#pragma unroll
            for (int dt = 0; dt < 5; ++dt) o[dt] = (f32x4){0.f, 0.f, 0.f, 0.f};
            float m = -1e30f;
            const int nkt = qb + 1;
            u32x4 rk[3], rv[2];
#define AT_LOAD(kt_) do { const size_t kb_ = (size_t)(kt_) * 128; _Pragma("unroll") for (int i = 0; i < 3; ++i) rk[i] = *(const u32x4*)(Kg + (kb_ + kro[i]) * 384 + kco[i] * 8); \
            _Pragma("unroll") for (int i = 0; i < 2; ++i) rv[i] = *(const u32x4*)(Vg + (size_t)(vd + 32 * i) * S + kb_ + vkc * 8); } while (0)
#define AT_WRITE(buf_) do { FLAS bf16* Kw = (FLAS bf16*)(lds + (buf_) * AT_BUF); FLAS bf16* Vw = (FLAS bf16*)(lds + (buf_) * AT_BUF + AT_KBYTES); \
            _Pragma("unroll") for (int i = 0; i < 3; ++i) *(FLAS u32x4*)(Kw + kro[i] * AT_KP + kco[i] * 8) = rk[i]; \
            _Pragma("unroll") for (int i = 0; i < 2; ++i) *(FLAS u32x4*)(Vw + (vd + 32 * i) * AT_VP + vkc * 8) = rv[i]; } while (0)
            AT_LOAD(0);
            __syncthreads();
            AT_WRITE(0);
            __syncthreads();
            for (int kt = 0; kt < nkt; ++kt) {
                const bool more = kt + 1 < nkt;
                TP_BEGIN(18, lds); if (more) AT_LOAD(kt + 1); TP_END(18, lds); TP_BEGIN(19, lds);
                const FLAS bf16* Ks = (const FLAS bf16*)(lds + (kt & 1) * AT_BUF); const FLAS bf16* Vt = (const FLAS bf16*)(lds + (kt & 1) * AT_BUF + AT_KBYTES);
                f32x4 s[8];
#pragma unroll
                for (int sub = 0; sub < 8; ++sub) { s[sub] = (f32x4){0.f, 0.f, 0.f, 0.f};
#pragma unroll
                    for (int ks = 0; ks < 3; ++ks) { const bf16x8 a = *(const FLAS bf16x8*)(Ks + (sub * 16 + fr) * AT_KP + ks * 32 + fq * 8); s[sub] = __builtin_amdgcn_mfma_f32_16x16x32_bf16(a, qf[ks], s[sub], 0, 0, 0); } }
                if (kt == qb) {
#pragma unroll
                    for (int sub = 0; sub < 8; ++sub)
#pragma unroll
                        for (int j = 0; j < 4; ++j) if (16 * sub + 4 * fq + j > 16 * w + fr) s[sub][j] = -1e30f; }
                float t0 = __builtin_fmaxf(__builtin_fmaxf(s[0][0], s[0][1]), s[0][2]), t1 = __builtin_fmaxf(__builtin_fmaxf(s[0][3], s[1][0]), s[1][1]);
                t0 = __builtin_fmaxf(__builtin_fmaxf(t0, s[1][2]), s[1][3]);
#pragma unroll
                for (int sub = 2; sub < 8; sub += 2) { t0 = __builtin_fmaxf(__builtin_fmaxf(t0, s[sub][0]), s[sub][1]); t1 = __builtin_fmaxf(__builtin_fmaxf(t1, s[sub][2]), s[sub][3]);
                    t0 = __builtin_fmaxf(__builtin_fmaxf(t0, s[sub + 1][0]), s[sub + 1][1]); t1 = __builtin_fmaxf(__builtin_fmaxf(t1, s[sub + 1][2]), s[sub + 1][3]); }
                float tmax = __builtin_fmaxf(t0, t1);
                tmax = __builtin_fmaxf(tmax, __shfl_xor(tmax, 16)); tmax = __builtin_fmaxf(tmax, __shfl_xor(tmax, 32));
                const float mn = __builtin_fmaxf(m, tmax), alpha = __builtin_amdgcn_exp2f(m - mn); m = mn;
#pragma unroll
                for (int sub = 0; sub < 8; ++sub)
#pragma unroll
                    for (int j = 0; j < 4; ++j) s[sub][j] = __builtin_amdgcn_exp2f(s[sub][j] - mn);
#pragma unroll
                for (int dt = 0; dt < 5; ++dt) o[dt] *= alpha;
#pragma unroll
                for (int k2 = 0; k2 < 4; ++k2) {
                    u32x4 pw; pw.x = pk2(s[2 * k2][0], s[2 * k2][1]); pw.y = pk2(s[2 * k2][2], s[2 * k2][3]); pw.z = pk2(s[2 * k2 + 1][0], s[2 * k2 + 1][1]); pw.w = pk2(s[2 * k2 + 1][2], s[2 * k2 + 1][3]);
                    const bf16x8 pf = __builtin_bit_cast(bf16x8, pw);
#pragma unroll
                    for (int dt = 0; dt < 5; ++dt) { const FLAS bf16* vp = Vt + (dt * 16 + fr) * AT_VP + 32 * k2 + 4 * fq;
                        const u32x2 v0 = *(const FLAS u32x2*)vp, v1 = *(const FLAS u32x2*)(vp + 16); u32x4 vw; vw.x = v0.x; vw.y = v0.y; vw.z = v1.x; vw.w = v1.y;
                        o[dt] = __builtin_amdgcn_mfma_f32_16x16x32_bf16(__builtin_bit_cast(bf16x8, vw), pf, o[dt], 0, 0, 0); } }
                TP_END(19, lds); TP_BEGIN(20, lds); if (more) AT_WRITE((kt + 1) & 1);
                __syncthreads(); TP_END(20, lds);
            }
#undef AT_LOAD
#undef AT_WRITE
            const float l = __shfl(o[4][0], fr);
            const float rl = 1.0f / l;
            FLAS unsigned char* ostg = lds + 2 * AT_BUF + w * (16 * 144);
#pragma unroll
            for (int dt = 0; dt < 4; ++dt) { u32x2 ow; ow.x = pk2(o[dt][0] * rl, o[dt][1] * rl); ow.y = pk2(o[dt][2] * rl, o[dt][3] * rl); *(FLAS u32x2*)(ostg + fr * 144 + (dt * 16 + 4 * fq) * 2) = ow; }
            FP_LDS_WAIT(); asm volatile("" ::: "memory");
            tile_out<16, 128, 144, 64>(ostg, (unsigned char*)(p.YC + ((size_t)b * S + qmin) * D + 768 + h * 64), (size_t)D * 2, lane);
            FP_LDS_WAIT(); asm volatile("" ::: "memory");
        }
    }
    __syncthreads();
}
__device__ __forceinline__ void conv_module(const MP& p, int L, FLAS unsigned char* lds, int bx, int G) {
    FLAS float* Gs = (FLAS float*)lds;
    const int S = (int)p.S, nchunk = S / 64, nitems = (int)p.B * nchunk;
    for (int it = bx; it < nitems; it += G) {
        const int tid = mk_tid(), lane = tid & 63, w = __builtin_amdgcn_readfirstlane(tid >> 6);
        const int ck = it % nchunk, b = it / nchunk, s0 = ck * 64;
        __syncthreads();
        const int ch = (w & 3) * 64 + lane, tb = (w >> 2) * 32; float wj[CK];
#pragma unroll
        for (int j = 0; j < CK; ++j) wj[j] = p.cdw_w[(L * CK + j) * 256 + ch];
        const float bias = p.cdw_b[L * 256 + ch], lg = p.cln_g[L * 256 + ch], lb = p.cln_b[L * 256 + ch];
        u32x4 rv[6], rg[6];
#pragma unroll
        for (int i = 0; i < 6; ++i) { const int idx = tid + 512 * i, row = idx >> 5, c = idx & 31, sp = s0 - 30 + row; rv[i] = (u32x4){0u, 0u, 0u, 0u}; rg[i] = rv[i];
            if (idx < 94 * 32 && sp >= 0) { const bf16* u = p.U + ((size_t)b * S + sp) * NU + c * 8; rv[i] = *(const u32x4*)u; rg[i] = *(const u32x4*)(u + 256); } }
        __builtin_amdgcn_sched_barrier(0);
#pragma unroll
        for (int i = 0; i < 6; ++i) { const int idx = tid + 512 * i, row = idx >> 5, c = idx & 31;
            if (idx < 94 * 32) { const unsigned v[4] = {rv[i].x, rv[i].y, rv[i].z, rv[i].w}, g[4] = {rg[i].x, rg[i].y, rg[i].z, rg[i].w}; f32x4 o0, o1;
                o0.x = blo(v[0]) / (1.0f + __expf(-blo(g[0]))); o0.y = bhi(v[0]) / (1.0f + __expf(-bhi(g[0]))); o0.z = blo(v[1]) / (1.0f + __expf(-blo(g[1]))); o0.w = bhi(v[1]) / (1.0f + __expf(-bhi(g[1])));
                o1.x = blo(v[2]) / (1.0f + __expf(-blo(g[2]))); o1.y = bhi(v[2]) / (1.0f + __expf(-bhi(g[2]))); o1.z = blo(v[3]) / (1.0f + __expf(-blo(g[3]))); o1.w = bhi(v[3]) / (1.0f + __expf(-bhi(g[3])));
                *(FLAS f32x4*)(Gs + row * 256 + c * 8) = o0; *(FLAS f32x4*)(Gs + row * 256 + c * 8 + 4) = o1; } }
        __syncthreads();
#pragma unroll 1
        for (int i8 = 0; i8 < 4; ++i8) { const int tl0 = tb + 8 * i8; float win[38], acc[8];
#pragma unroll
            for (int r = 0; r < 38; ++r) win[r] = Gs[(tl0 + r) * 256 + ch];
#pragma unroll
            for (int q = 0; q < 8; ++q) { float a = bias;
#pragma unroll
                for (int j = 0; j < CK; ++j) a += wj[j] * win[q + j];
                acc[q] = a; }
            float mu[8], var[8];
#pragma unroll
            for (int q = 0; q < 8; ++q) { mu[q] = wave_sum(acc[q]) * (1.0f / 64.f); acc[q] -= mu[q]; }
#pragma unroll
            for (int q = 0; q < 8; ++q) var[q] = wave_sum(acc[q] * acc[q]);
#pragma unroll
            for (int q = 0; q < 8; ++q) { const float hn = acc[q] * (1.0f / sqrtf(var[q] * (1.0f / 64.f) + LN_EPS)) * lg + lb; ((FLAS bf16*)(lds + 94 * 256 * 4 + w * (32 * 144)))[(8 * i8 + q) * 72 + lane] = f2bf(hn / (1.0f + __expf(-hn))); } }
        FP_LDS_WAIT(); asm volatile("" ::: "memory");
        tile_out<32, 128, 144, 64>(lds + 94 * 256 * 4 + w * (32 * 144), (unsigned char*)(p.YC + ((size_t)b * S + s0 + tb) * D + (w & 3) * 64), (size_t)D * 2, lane);
        FP_LDS_WAIT(); asm volatile("" ::: "memory");
    }
    __syncthreads();
}
constexpr int MQ_P = 264, MK_P = 136;
__device__ __forceinline__ void mla_proj(const MP& p, int L, FLAS unsigned char* lds, int bx, int G) {
    FLAS bf16* Aq = (FLAS bf16*)lds; FLAS bf16* Ak = (FLAS bf16*)(lds + 64 * MQ_P * 2);
    const int nunits = (int)(p.T / 64);
    const bf16* Wq = p.WUQ + (size_t)L * 512 * 256; const bf16* Wk = p.WUKV + (size_t)L * 512 * 128;
    for (int u = bx; u < nunits; u += G) {
        const int tid = mk_tid(), lane = tid & 63, w = __builtin_amdgcn_readfirstlane(tid >> 6), fr = lane & 15, fq = lane >> 4;
        const size_t t0 = (size_t)u * 64;
        __syncthreads();
        bf16x8 wq0[4][3], wkf[4][4];
        {
            u32x2 rq[8]; unsigned rk[8];
#pragma unroll
            for (int i = 0; i < 8; ++i) { const bf16* urow = p.U + (t0 + w * 8 + i) * NU; rq[i] = *(const u32x2*)(urow + U_CQ + lane * 4); rk[i] = *(const unsigned*)(urow + U_CKV + lane * 2); }
            const f32x4 gq = *(const f32x4*)(p.qn_g + L * 256 + lane * 4); const f32x2 gk = *(const f32x2*)(p.kvn_g + L * 128 + lane * 2);
#pragma unroll
            for (int k4 = 0; k4 < 4; ++k4)
#pragma unroll
                for (int ct = 0; ct < 3; ++ct) wq0[k4][ct] = *(const bf16x8*)(Wq + (size_t)(48 * w + 16 * ct + fr) * 256 + k4 * 32 + fq * 8);
#pragma unroll
            for (int ks = 0; ks < 4; ++ks)
#pragma unroll
                for (int ct = 0; ct < 4; ++ct) wkf[ks][ct] = *(const bf16x8*)(Wk + (size_t)(64 * w + 16 * ct + fr) * 128 + ks * 32 + fq * 8);
            __builtin_amdgcn_sched_barrier(0);
#pragma unroll
            for (int i = 0; i < 8; ++i) { const int r = w * 8 + i;
                { const float a0 = blo(rq[i].x), a1 = bhi(rq[i].x), a2 = blo(rq[i].y), a3 = bhi(rq[i].y); const float rs = 1.0f / sqrtf(wave_sum((a0 * a0 + a1 * a1) + (a2 * a2 + a3 * a3)) * (1.0f / 256.f) + RMS_EPS);
                  u32x2 o; o.x = pk2(a0 * rs * gq.x, a1 * rs * gq.y); o.y = pk2(a2 * rs * gq.z, a3 * rs * gq.w); *(FLAS u32x2*)(Aq + r * MQ_P + lane * 4) = o; }
                { const float a0 = blo(rk[i]), a1 = bhi(rk[i]); const float rs = 1.0f / sqrtf(wave_sum(a0 * a0 + a1 * a1) * (1.0f / 128.f) + RMS_EPS); *(FLAS unsigned*)(Ak + r * MK_P + lane * 2) = pk2(a0 * rs * gk.x, a1 * rs * gk.y); } } }
#pragma unroll
        for (int e2 = 0; e2 < 2; ++e2) { const int e = tid + 512 * e2, r = e >> 4, jj = e & 15; const size_t t = t0 + r; const float x1 = bf2f(p.U[t * NU + U_KR + jj]), x2 = bf2f(p.U[t * NU + U_KR + 16 + jj]), c = p.CS[t * 32 + jj], sn = p.CS[t * 32 + 16 + jj];
            const bf16 o1 = f2bf(x1 * c - x2 * sn), o2 = f2bf(x1 * sn + x2 * c);
#pragma unroll
            for (int h = 0; h < 4; ++h) { p.KK[t * 384 + h * 96 + 64 + jj] = o1; p.KK[t * 384 + h * 96 + 80 + jj] = o2; } }
        __syncthreads();
        {
            f32x4 acc[3][4];
#pragma unroll
            for (int ct = 0; ct < 3; ++ct)
#pragma unroll
                for (int rt = 0; rt < 4; ++rt) acc[ct][rt] = (f32x4){0.f, 0.f, 0.f, 0.f};
            bf16x8 wq1[4][3];
#pragma unroll
            for (int k4 = 0; k4 < 4; ++k4)
#pragma unroll
                for (int ct = 0; ct < 3; ++ct) wq1[k4][ct] = *(const bf16x8*)(Wq + (size_t)(48 * w + 16 * ct + fr) * 256 + (4 + k4) * 32 + fq * 8);
            __builtin_amdgcn_sched_barrier(0);
#pragma unroll
            for (int k4 = 0; k4 < 4; ++k4)
#pragma unroll
                for (int rt = 0; rt < 4; ++rt) { const bf16x8 tk = *(const FLAS bf16x8*)(Aq + (rt * 16 + fr) * MQ_P + k4 * 32 + fq * 8);
#pragma unroll
                    for (int ct = 0; ct < 3; ++ct) acc[ct][rt] = __builtin_amdgcn_mfma_f32_16x16x32_bf16(wq0[k4][ct], tk, acc[ct][rt], 0, 0, 0); }
#pragma unroll
            for (int k4 = 0; k4 < 4; ++k4)
#pragma unroll
                for (int rt = 0; rt < 4; ++rt) { const bf16x8 tk = *(const FLAS bf16x8*)(Aq + (rt * 16 + fr) * MQ_P + (4 + k4) * 32 + fq * 8);
#pragma unroll
                    for (int ct = 0; ct < 3; ++ct) acc[ct][rt] = __builtin_amdgcn_mfma_f32_16x16x32_bf16(wq1[k4][ct], tk, acc[ct][rt], 0, 0, 0); }
            const bool pe = (w & 1) != 0;
#pragma unroll
            for (int rt = 0; rt < 4; ++rt) { const size_t t = t0 + rt * 16 + fr; bf16* qrow = p.Q + t * 384 + 48 * w + 4 * fq;
                f32x4 v0 = acc[0][rt], v1 = acc[1][rt], v2 = acc[2][rt];
                if (pe) { const f32x4 c = *(const f32x4*)(p.CS + t * 32 + 4 * fq), sn = *(const f32x4*)(p.CS + t * 32 + 16 + 4 * fq); const f32x4 x1 = v1, x2 = v2; v1 = x1 * c - x2 * sn; v2 = x1 * sn + x2 * c; }
                u32x2 o; o.x = pk2(v0.x * QSCALE, v0.y * QSCALE); o.y = pk2(v0.z * QSCALE, v0.w * QSCALE); *(u32x2*)qrow = o;
                o.x = pk2(v1.x * QSCALE, v1.y * QSCALE); o.y = pk2(v1.z * QSCALE, v1.w * QSCALE); *(u32x2*)(qrow + 16) = o;
                o.x = pk2(v2.x * QSCALE, v2.y * QSCALE); o.y = pk2(v2.z * QSCALE, v2.w * QSCALE); *(u32x2*)(qrow + 32) = o; }
        }
        {
            f32x4 acc[4][4];
#pragma unroll
            for (int ct = 0; ct < 4; ++ct)
#pragma unroll
                for (int rt = 0; rt < 4; ++rt) acc[ct][rt] = (f32x4){0.f, 0.f, 0.f, 0.f};
            const int h = w >> 1; const bool isv = (w & 1) != 0;
            if (!isv) {
#pragma unroll
                for (int ks = 0; ks < 4; ++ks)
#pragma unroll
                    for (int rt = 0; rt < 4; ++rt) { const bf16x8 tk = *(const FLAS bf16x8*)(Ak + (rt * 16 + fr) * MK_P + ks * 32 + fq * 8);
#pragma unroll
                        for (int ct = 0; ct < 4; ++ct) acc[ct][rt] = __builtin_amdgcn_mfma_f32_16x16x32_bf16(wkf[ks][ct], tk, acc[ct][rt], 0, 0, 0); }
#pragma unroll
                for (int rt = 0; rt < 4; ++rt) { const size_t t = t0 + rt * 16 + fr; bf16* dst = p.KK + t * 384 + h * 96 + 4 * fq;
#pragma unroll
                    for (int ct = 0; ct < 4; ++ct) { u32x2 o; o.x = pk2(acc[ct][rt].x, acc[ct][rt].y); o.y = pk2(acc[ct][rt].z, acc[ct][rt].w); *(u32x2*)(dst + 16 * ct) = o; } }
            } else {
#pragma unroll
                for (int ks = 0; ks < 4; ++ks)
#pragma unroll
                    for (int rt = 0; rt < 4; ++rt) { const bf16x8 tk = *(const FLAS bf16x8*)(Ak + (rt * 16 + fr) * MK_P + ks * 32 + fq * 8);
#pragma unroll
                        for (int ct = 0; ct < 4; ++ct) acc[ct][rt] = __builtin_amdgcn_mfma_f32_16x16x32_bf16(tk, wkf[ks][ct], acc[ct][rt], 0, 0, 0); }
                const size_t bq = t0 / p.S, sq = t0 % p.S;
#pragma unroll
                for (int ct = 0; ct < 4; ++ct) { bf16* drow = p.V + ((bq * 4 + h) * 64 + 16 * ct + fr) * p.S + sq + 4 * fq;
#pragma unroll
                    for (int rt = 0; rt < 4; ++rt) { u32x2 o; o.x = pk2(acc[ct][rt].x, acc[ct][rt].y); o.y = pk2(acc[ct][rt].z, acc[ct][rt].w); *(u32x2*)(drow + 16 * rt) = o; } }
            }
        }
    }
    __syncthreads();
}
__device__ __forceinline__ void ssd_scan(const MP& p, int bx, int G) {
    const int tid = mk_tid(); const long g0 = (long)bx * 512 + tid, gs = (long)G * 512; const int NCB = (int)(p.S / CHUNK);
    for (long i = g0; i < p.B * 8 * 64 * 32; i += gs) { const long b = i / (8 * 64 * 32), r = i % (8 * 64 * 32); const int h = (int)(r / (64 * 32)); f32x4 carry = (f32x4){0.f, 0.f, 0.f, 0.f};
        f32x4 st[16]; float dec[16];
#pragma unroll
        for (int cc = 0; cc < 16; ++cc) { const long c = b * NCB + cc; st[cc] = ((const f32x4*)p.ST)[(size_t)c * (8 * 64 * 32) + r]; dec[cc] = p.ACS[(c * CHUNK + CHUNK - 1) * 8 + h]; }
        __builtin_amdgcn_sched_barrier(0);
#pragma unroll
        for (int cc = 0; cc < 16; ++cc) { const long c = b * NCB + cc; u32x2 o; o.x = pk2(carry.x, carry.y); o.y = pk2(carry.z, carry.w); ((u32x2*)p.PV)[(size_t)c * (8 * 64 * 32) + r] = o; carry = carry * __expf(dec[cc]) + st[cc]; } }
}
constexpr int SP = 136;
constexpr int SA_DT = 0, SA_ACS = 2048, SA_CM = 4096, SA_BM = SA_CM + 128 * SP * 2, SA_XT = SA_CM, SA_BT = SA_CM + 2 * 128 * SP * 2, SA_MW = SA_BT + 128 * SP * 2, SA_END = SA_MW + 8 * 16 * SP * 2;
__device__ __forceinline__ float silu_f(float x) { return x / (1.0f + __expf(-x)); }
__device__ __forceinline__ float softplus_fast(float x) { if (x > 20.f) return x; const float e = __builtin_amdgcn_exp2f(x * 1.4426950408889634f); return e < 1e-3f ? e * (1.0f - 0.5f * e) : 0.6931471805599453f * __builtin_amdgcn_logf(1.0f + e); }
struct ConvW { f32x4 w[4][2], b[2]; };
__device__ __forceinline__ void convw_load(const MP& p, int L, int xc0, ConvW& cw) {
#pragma unroll
    for (int j = 0; j < 4; ++j) { cw.w[j][0] = *(const f32x4*)(p.sconv_w + (L * 4 + j) * 1024 + xc0); cw.w[j][1] = *(const f32x4*)(p.sconv_w + (L * 4 + j) * 1024 + xc0 + 4); }
    cw.b[0] = *(const f32x4*)(p.sconv_b + L * 1024 + xc0); cw.b[1] = *(const f32x4*)(p.sconv_b + L * 1024 + xc0 + 4);
}
__device__ __forceinline__ void conv_rows_load(const bf16* ub  , int xc0, int s0, int l0, u32x4 (&x)[11]) {
#pragma unroll
    for (int i = 0; i < 11; ++i) { const int sp = s0 + l0 - 3 + i; x[i] = (u32x4){0u, 0u, 0u, 0u}; if (i >= 3 || sp >= 0) x[i] = *(const u32x4*)(ub + (size_t)(sp < 0 ? 0 : sp) * NU + xc0); }
}
__device__ __forceinline__ float conv_elem(const u32x4 (&x)[11], const ConvW& cw, int i, int c) {
    float a = cw.b[c >> 2][c & 3];
#pragma unroll
    for (int j = 0; j < 4; ++j) { const unsigned wd = x[i + j][c >> 1]; a += cw.w[j][c >> 2][c & 3] * ((c & 1) ? bhi(wd) : blo(wd)); }
    return silu_f(a);
}
__device__ __forceinline__ void ssd_a(const MP& p, int L, FLAS unsigned char* lds, int bx, int G) {
    FLAS float* dtL = (FLAS float*)(lds + SA_DT); FLAS float* acsL = (FLAS float*)(lds + SA_ACS);
    FLAS bf16* Cm = (FLAS bf16*)(lds + SA_CM); FLAS bf16* Bm = (FLAS bf16*)(lds + SA_BM); FLAS bf16* XT = (FLAS bf16*)(lds + SA_XT); FLAS bf16* BT = (FLAS bf16*)(lds + SA_BT);
    const int S = (int)p.S, nunits = (int)(p.T / CHUNK) * 2;
    for (int u = bx; u < nunits; u += G) {
        const int tid = mk_tid(), lane = tid & 63, w = __builtin_amdgcn_readfirstlane(tid >> 6), fr = lane & 15, fq = lane >> 4;
        FLAS bf16* Mw = (FLAS bf16*)(lds + SA_MW + w * (16 * SP * 2));
        const int g = u & 1; const long c = u >> 1; const size_t t0 = (size_t)c * CHUNK; const int s0 = (int)(t0 % S); const size_t tb = t0 - s0;
        __syncthreads();
        TP_BEGIN(28, lds);
        const int cg2 = tid & 31, ts = tid >> 5, l0 = 8 * ts; const bool isC = cg2 >= 16; const int nbc = 8 * (cg2 & 15);
        const int xcb = (isC ? 768 : 512) + 128 * g + nbc, chs = 8 * cg2, xcs = 256 * g + chs;
        u32x4 xb[11], xs[11]; ConvW cwb, cws;
        const int h4 = tid >> 7, ldt = tid & 127; const bf16 dtraw = p.U[(t0 + ldt) * NU + U_DT + 4 * g + h4];
        conv_rows_load(p.U + tb * NU + U_XBC, xcb, s0, l0, xb);
        conv_rows_load(p.U + tb * NU + U_XBC, xcs, s0, l0, xs);
        convw_load(p, L, xcb, cwb); convw_load(p, L, xcs, cws);
        __builtin_amdgcn_sched_barrier(0);
        if (PROBE_CK == 11) { asm volatile("s_waitcnt vmcnt(0) lgkmcnt(0)" ::: "memory"); TP_END(28, lds); }
        dtL[h4 * 128 + ldt] = softplus_fast(bf2f(dtraw) + p.dt_bias[L * 8 + 4 * g + h4]);
        {
            FLAS bf16* rowdst = (isC ? Cm : Bm) + nbc; u32x4 colw[8];
#pragma unroll
            for (int i = 0; i < 8; ++i) { float o[8];
#pragma unroll
                for (int c = 0; c < 8; ++c) o[c] = conv_elem(xb, cwb, i, c);
                u32x4 wv; wv.x = pk2(o[0], o[1]); wv.y = pk2(o[2], o[3]); wv.z = pk2(o[4], o[5]); wv.w = pk2(o[6], o[7]); *(FLAS u32x4*)(rowdst + (l0 + i) * SP) = wv;
#pragma unroll
                for (int c = 0; c < 8; ++c) { const unsigned hv = (c & 1) ? (wv[c >> 1] >> 16) : (wv[c >> 1] & 0xffffu); if (i & 1) colw[c][i >> 1] |= hv << 16; else colw[c][i >> 1] = hv; } }
            if (!isC) {
#pragma unroll
                for (int c = 0; c < 8; ++c) *(FLAS u32x4*)(BT + (nbc + c) * SP + l0) = colw[c]; }
        }
        if (PROBE_CK == 12) { asm volatile("s_waitcnt vmcnt(0) lgkmcnt(0)" ::: "memory"); TP_END(28, lds); }
        __syncthreads();
        if (w < 4) {
            const int h = 4 * g + w; const float a = -__expf(p.a_log[L * 8 + h]); const float x0 = dtL[w * 128 + 2 * lane] * a, x1 = dtL[w * 128 + 2 * lane + 1] * a, ps = x0 + x1; float inc = ps;
#pragma unroll
            for (int o = 1; o < 64; o <<= 1) { const float t = __shfl_up(inc, o); if (lane >= o) inc += t; }
            const float ex = inc - ps, c0 = ex + x0, c1 = ex + ps; *(FLAS f32x2*)(acsL + w * 128 + 2 * lane) = (f32x2){c0, c1};
            p.ACS[(t0 + 2 * lane) * 8 + h] = c0; p.ACS[(t0 + 2 * lane + 1) * 8 + h] = c1; }
        tile_out<128, 256, SP * 2, 512>((const FLAS unsigned char*)Cm, (unsigned char*)(p.CM + t0 * 256 + g * 128), (size_t)256 * 2, tid);
        f32x4 cbT[8];
#pragma unroll
        for (int ct = 0; ct < 8; ++ct) cbT[ct] = (f32x4){0.f, 0.f, 0.f, 0.f};
#pragma unroll
        for (int ks = 0; ks < 4; ++ks) { const bf16x8 cf = *(const FLAS bf16x8*)(Cm + (16 * w + fr) * SP + ks * 32 + fq * 8);
#pragma unroll
            for (int ct = 0; ct < 8; ++ct) { const bf16x8 bfm = *(const FLAS bf16x8*)(Bm + (16 * ct + fr) * SP + ks * 32 + fq * 8); cbT[ct] = __builtin_amdgcn_mfma_f32_16x16x32_bf16(bfm, cf, cbT[ct], 0, 0, 0); } }
        __syncthreads();
        if (PROBE_CK == 13) { asm volatile("s_waitcnt vmcnt(0) lgkmcnt(0)" ::: "memory"); TP_END(28, lds); }
        {   const FLAS float* dts = dtL + (chs >> 6) * 128 + l0; const f32x4 d0 = *(const FLAS f32x4*)dts, d1 = *(const FLAS f32x4*)(dts + 4);
            const float dtv[8] = {d0.x, d0.y, d0.z, d0.w, d1.x, d1.y, d1.z, d1.w};
#pragma unroll
            for (int c = 0; c < 8; ++c) { float o[8];
#pragma unroll
                for (int i = 0; i < 8; ++i) o[i] = bf2f(f2bf(conv_elem(xs, cws, i, c))) * dtv[i];
                u32x4 wv; wv.x = pk2(o[0], o[1]); wv.y = pk2(o[2], o[3]); wv.z = pk2(o[4], o[5]); wv.w = pk2(o[6], o[7]); *(FLAS u32x4*)(XT + (chs + c) * SP + l0) = wv; } }
        if (PROBE_CK == 14) { asm volatile("s_waitcnt vmcnt(0) lgkmcnt(0)" ::: "memory"); TP_END(28, lds); }
        __syncthreads();
#pragma unroll 1
        for (int r = 0; r < 4; ++r) {
            const FLAS float* ac = acsL + r * 128; const int h = 4 * g + r; const float al = ac[16 * w + fr];
            const float dsd = p.dskip[L * 8 + h] / dtL[r * 128 + 16 * w + fr];
#pragma unroll
            for (int ct = 0; ct < 8; ++ct) { const f32x4 as = *(const FLAS f32x4*)(ac + 16 * ct + 4 * fq); const int sb = 16 * ct + 4 * fq, l = 16 * w + fr; float m0, m1, m2, m3;
                m0 = (sb + 0 <= l) ? cbT[ct].x * __expf(al - as.x) : 0.f; m1 = (sb + 1 <= l) ? cbT[ct].y * __expf(al - as.y) : 0.f; m2 = (sb + 2 <= l) ? cbT[ct].z * __expf(al - as.z) : 0.f; m3 = (sb + 3 <= l) ? cbT[ct].w * __expf(al - as.w) : 0.f;
                m0 += (sb + 0 == l) ? dsd : 0.f; m1 += (sb + 1 == l) ? dsd : 0.f; m2 += (sb + 2 == l) ? dsd : 0.f; m3 += (sb + 3 == l) ? dsd : 0.f;
                u32x2 o; o.x = pk2(m0, m1); o.y = pk2(m2, m3); *(FLAS u32x2*)(Mw + fr * SP + sb) = o; }
            FP_LDS_WAIT(); asm volatile("" ::: "memory");
            f32x4 yd[4], st[4];
#pragma unroll
            for (int pt = 0; pt < 4; ++pt) { yd[pt] = (f32x4){0.f, 0.f, 0.f, 0.f}; st[pt] = (f32x4){0.f, 0.f, 0.f, 0.f}; }
            const float alast = ac[127];
#pragma unroll
            for (int ks = 0; ks < 4; ++ks) { const bf16x8 am = *(const FLAS bf16x8*)(Mw + fr * SP + ks * 32 + fq * 8);
                const u32x4 braw = *(const FLAS u32x4*)(BT + (16 * w + fr) * SP + ks * 32 + fq * 8); const f32x4 e0 = *(const FLAS f32x4*)(ac + ks * 32 + fq * 8), e1 = *(const FLAS f32x4*)(ac + ks * 32 + fq * 8 + 4); u32x4 bs;
                bs.x = pk2(blo(braw.x) * __expf(alast - e0.x), bhi(braw.x) * __expf(alast - e0.y)); bs.y = pk2(blo(braw.y) * __expf(alast - e0.z), bhi(braw.y) * __expf(alast - e0.w));
                bs.z = pk2(blo(braw.z) * __expf(alast - e1.x), bhi(braw.z) * __expf(alast - e1.y)); bs.w = pk2(blo(braw.w) * __expf(alast - e1.z), bhi(braw.w) * __expf(alast - e1.w));
                const bf16x8 bsf = __builtin_bit_cast(bf16x8, bs);
#pragma unroll
                for (int pt = 0; pt < 4; ++pt) { const bf16x8 x = *(const FLAS bf16x8*)(XT + (r * 64 + 16 * pt + fr) * SP + ks * 32 + fq * 8);
                    yd[pt] = __builtin_amdgcn_mfma_f32_16x16x32_bf16(x, am, yd[pt], 0, 0, 0); st[pt] = __builtin_amdgcn_mfma_f32_16x16x32_bf16(bsf, x, st[pt], 0, 0, 0); } }
#pragma unroll
            for (int pt = 0; pt < 4; ++pt) { u32x2 o; o.x = pk2(yd[pt].x, yd[pt].y); o.y = pk2(yd[pt].z, yd[pt].w); *(FLAS u32x2*)((FLAS unsigned char*)Mw + fr * 144 + (16 * pt + 4 * fq) * 2) = o;
                *(f32x4*)(p.ST + (((size_t)c * 8 + h) * 64 + 16 * pt + fr) * 128 + 16 * w + 4 * fq) = st[pt]; }
            FP_LDS_WAIT(); asm volatile("" ::: "memory");
            tile_out<16, 128, 144, 64>((const FLAS unsigned char*)Mw, (unsigned char*)(p.YD + (t0 + 16 * w) * 512 + h * 64), (size_t)512 * 2, lane);
            FP_LDS_WAIT(); asm volatile("" ::: "memory");
            if (r == 0) {if (PROBE_CK == 15) { asm volatile("s_waitcnt vmcnt(0) lgkmcnt(0)" ::: "memory"); TP_END(28, lds); } }
        }
        if (PROBE_CK == 16) { asm volatile("s_waitcnt vmcnt(0) lgkmcnt(0)" ::: "memory"); TP_END(28, lds); }
    }
    __syncthreads();
}
__device__ __forceinline__ void ssd_c(const MP& p, int L, FLAS unsigned char* lds, int bx, int G) {
    const int nunits = (int)(p.T / CHUNK) * 2;
    for (int u = bx; u < nunits; u += G) {
        const int tid = mk_tid(), lane = tid & 63, w = __builtin_amdgcn_readfirstlane(tid >> 6), fr = lane & 15, fq = lane >> 4;
        const int g = u & 1; const long c = u >> 1; const size_t t0 = (size_t)c * CHUNK, t = t0 + 16 * w + fr;
        FLAS float* gnl = (FLAS float*)(lds + 8 * (16 * 528));
        __syncthreads();
        if (tid < 64) *(FLAS f32x4*)(gnl + 4 * tid) = *(const f32x4*)(p.snorm_g + L * 512 + g * 256 + 4 * tid);
        __syncthreads();
        TP_BEGIN(24, lds);
        bf16x8 cf[4];
#pragma unroll
        for (int ks = 0; ks < 4; ++ks) cf[ks] = *(const bf16x8*)(p.CM + t * 256 + g * 128 + ks * 32 + fq * 8);
        if (PROBE_CK == 1) { asm volatile("s_waitcnt vmcnt(0) lgkmcnt(0)" ::: "memory"); TP_END(24, lds); }
        f32x4 y[4][4]; float ssq = 0.f;
#pragma unroll
        for (int hp = 0; hp < 2; ++hp) { bf16x8 pvf[2][4][4];
#pragma unroll
            for (int rr = 0; rr < 2; ++rr) { const bf16* pv = p.PV + (((size_t)c * 8 + 4 * g + 2 * hp + rr) * 64) * 128;
#pragma unroll
                for (int pt = 0; pt < 4; ++pt)
#pragma unroll
                    for (int ks = 0; ks < 4; ++ks) pvf[rr][pt][ks] = *(const bf16x8*)(pv + (size_t)(16 * pt + fr) * 128 + ks * 32 + fq * 8); }
            __builtin_amdgcn_sched_barrier(0);
#pragma unroll
            for (int rr = 0; rr < 2; ++rr)
#pragma unroll
                for (int pt = 0; pt < 4; ++pt) { f32x4 acc = (f32x4){0.f, 0.f, 0.f, 0.f};
#pragma unroll
                    for (int ks = 0; ks < 4; ++ks) acc = __builtin_amdgcn_mfma_f32_16x16x32_bf16(pvf[rr][pt][ks], cf[ks], acc, 0, 0, 0);
                    y[2 * hp + rr][pt] = acc; }
            __builtin_amdgcn_sched_barrier(0); }
        if (PROBE_CK == 2) { asm volatile("s_waitcnt vmcnt(0) lgkmcnt(0)" ::: "memory"); TP_END(24, lds); }
        u32x2 ryd[4][4], rz[4][4]; float ea[4];
#pragma unroll
        for (int r = 0; r < 4; ++r) { const int h = 4 * g + r; ea[r] = p.ACS[t * 8 + h];
#pragma unroll
            for (int pt = 0; pt < 4; ++pt) { const int ch = h * 64 + 16 * pt + 4 * fq; ryd[r][pt] = *(const u32x2*)(p.YD + t * 512 + ch); rz[r][pt] = *(const u32x2*)(p.U + t * NU + U_Z + ch); } }
        __builtin_amdgcn_sched_barrier(0);
        if (PROBE_CK == 3) { asm volatile("s_waitcnt vmcnt(0) lgkmcnt(0)" ::: "memory"); TP_END(24, lds); }
#pragma unroll
        for (int r = 0; r < 4; ++r) { const float e = __expf(ea[r]);
#pragma unroll
            for (int pt = 0; pt < 4; ++pt) { const f32x4 acc = y[r][pt]; f32x4 yv;
                yv.x = (acc.x * e + blo(ryd[r][pt].x)) * silu_f(blo(rz[r][pt].x)); yv.y = (acc.y * e + bhi(ryd[r][pt].x)) * silu_f(bhi(rz[r][pt].x));
                yv.z = (acc.z * e + blo(ryd[r][pt].y)) * silu_f(blo(rz[r][pt].y)); yv.w = (acc.w * e + bhi(ryd[r][pt].y)) * silu_f(bhi(rz[r][pt].y));
                y[r][pt] = yv; ssq += (yv.x * yv.x + yv.y * yv.y) + (yv.z * yv.z + yv.w * yv.w); } }
        if (PROBE_CK == 4) { asm volatile("s_waitcnt vmcnt(0) lgkmcnt(0)" ::: "memory"); TP_END(24, lds); }
        ssq += __shfl_xor(ssq, 16); ssq += __shfl_xor(ssq, 32);
        const float rs = 1.0f / sqrtf(ssq * (1.0f / 256.f) + RMS_EPS);
        FLAS unsigned char* stg = lds + w * (16 * 528);
#pragma unroll
        for (int r = 0; r < 4; ++r)
#pragma unroll
            for (int pt = 0; pt < 4; ++pt) { const int cl = r * 64 + 16 * pt + 4 * fq; const f32x4 gn = *(const FLAS f32x4*)(gnl + cl); const f32x4 v = y[r][pt];
                u32x2 o; o.x = pk2(v.x * rs * gn.x, v.y * rs * gn.y); o.y = pk2(v.z * rs * gn.z, v.w * rs * gn.w); *(FLAS u32x2*)(stg + fr * 528 + cl * 2) = o; }
        if (PROBE_CK == 5) { asm volatile("s_waitcnt vmcnt(0) lgkmcnt(0)" ::: "memory"); TP_END(24, lds); }
        FP_LDS_WAIT(); asm volatile("" ::: "memory");
        tile_out<16, 512, 528, 64>(stg, (unsigned char*)(p.YC + (t0 + 16 * w) * D + 256 + g * 256), (size_t)D * 2, lane);
        FP_LDS_WAIT(); asm volatile("" ::: "memory");
        if (PROBE_CK == 6) { asm volatile("s_waitcnt vmcnt(0) lgkmcnt(0)" ::: "memory"); TP_END(24, lds); }
    }
}
}

using namespace mdl;
#define LAS __attribute__((address_space(3)))
constexpr int NWAVES = 8, NTHR = NWAVES * 64;
constexpr int CW_BAR = 4096;
#define XB_TMO      128
#define XB_XCNT(j)  (256  + 64 * (j))
#define XB_XSUB(j)  (1280 + 64 * (j))
#define XB_XGEN(j)  (2304 + 64 * (j))
#define XB_TOP      3328
#define XB_TOPGEN   3392
#define XCD_BAR_WORDS 3456
#define XB_SPIN_CAP (1u << 18)

__device__ __forceinline__ unsigned xb_ld(unsigned* p)              { return __hip_atomic_load(p, __ATOMIC_RELAXED, __HIP_MEMORY_SCOPE_AGENT); }
__device__ __forceinline__ unsigned xb_add(unsigned* p, unsigned v) { return __hip_atomic_fetch_add(p, v, __ATOMIC_RELAXED, __HIP_MEMORY_SCOPE_AGENT); }
__device__ __forceinline__ unsigned xb_xcc_id() { return (unsigned)__builtin_amdgcn_s_getreg((3 << 11) | 20) & 0xFu; }
#define XB_SPIN(cond, bar) do { unsigned _sp = 0; while (cond) { __builtin_amdgcn_s_sleep(1); \
    if ((++_sp & 255u) == 0u) { if (xb_ld(&(bar)[XB_TMO])) break; if (_sp > XB_SPIN_CAP) { atomicAdd(&(bar)[XB_TMO], 1u); break; } } } } while (0)

struct XcdBarrier {
    unsigned* bar; unsigned x;
    volatile LAS unsigned* st;
};

__device__ __forceinline__ XcdBarrier xcd_barrier_post(unsigned* bar, volatile LAS unsigned* st) {
    XcdBarrier b; b.bar = bar; b.x = xb_xcc_id(); b.st = st;
    if (threadIdx.x == 0) (void)xb_add(&bar[XB_XCNT(b.x)], 1u);
    return b;
}
__device__ __forceinline__ void xcd_barrier_complete(unsigned* bar, unsigned x, unsigned& nloc, unsigned& nx) {
    const unsigned G = gridDim.x * gridDim.y * gridDim.z;
    unsigned sum, cnt, mine, sp = 0u;
    for (;;) {
        sum = 0u; cnt = 0u; mine = 0u;
#pragma unroll
        for (unsigned j = 0; j < 16; ++j) { const unsigned c = xb_ld(&bar[XB_XCNT(j)]); sum += c; cnt += (c > 0u) ? 1u : 0u; mine = (j == x) ? c : mine; }
        if (sum == G) break;
        __builtin_amdgcn_s_sleep(1);
        if ((++sp & 255u) == 0u) { if (xb_ld(&bar[XB_TMO])) break; if (sp > XB_SPIN_CAP) { atomicAdd(&bar[XB_TMO], 1u); break; } }
    }
    nloc = mine > 0u ? mine : 1u; nx = cnt > 0u ? cnt : 1u;
}

__device__ __forceinline__ void xcd_barrier(const XcdBarrier& b) {
    asm volatile("s_waitcnt vmcnt(0)" ::: "memory");
    __syncthreads();
    if (threadIdx.x == 0) {
        unsigned* bar = b.bar;
        __builtin_amdgcn_s_waitcnt(0);
        unsigned nloc = b.st[0], nx = b.st[1];
        if (nloc == 0u) { xcd_barrier_complete(bar, b.x, nloc, nx); b.st[0] = nloc; b.st[1] = nx; }
        const unsigned old = xb_add(&bar[XB_XSUB(b.x)], 1u);
        const unsigned gen = old / nloc;
        if (old + 1u == (gen + 1u) * nloc) {
            __builtin_amdgcn_fence(__ATOMIC_RELEASE, "agent");
            asm volatile("s_waitcnt vmcnt(0)" ::: "memory");
            const unsigned og = xb_add(&bar[XB_TOP], 1u);
            const unsigned tg = og / nx;
            if (og + 1u == (tg + 1u) * nx) xb_add(&bar[XB_TOPGEN], 1u);
            else XB_SPIN(xb_ld(&bar[XB_TOPGEN]) == tg, bar);
            __builtin_amdgcn_fence(__ATOMIC_ACQUIRE, "agent");
            xb_add(&bar[XB_XGEN(b.x)], 1u);
            asm volatile("s_waitcnt vmcnt(0)" ::: "memory");
        } else {
            XB_SPIN(xb_ld(&bar[XB_XGEN(b.x)]) == gen, bar);
            __builtin_amdgcn_fence(__ATOMIC_ACQUIRE, "agent");
            asm volatile("s_waitcnt vmcnt(0)" ::: "memory");
        }
    }
    __syncthreads();
}

struct Args { MP p; long flags; };
__global__ void __launch_bounds__(NTHR, 2) mk_fwd(Args a) {
    extern __shared__ __attribute__((aligned(16))) unsigned char lds[];
    LAS unsigned char* const L3 = (LAS unsigned char*)lds;
    volatile LAS unsigned* MISC = (volatile LAS unsigned*)(L3 + MISC_OFF);
    const MP& p = a.p;
    const int tid = threadIdx.x;
    for (int u = tid; u < (LDS_BYTES - LDSCTL_OFF) / 4; u += NTHR) ((LAS unsigned*)(L3 + LDSCTL_OFF))[u] = 0u;
    __syncthreads();
    const XcdBarrier bar = xcd_barrier_post(p.ctl + CW_BAR, MISC + 8);
    const int G = gridDim.x, bx = blockIdx.x;
    const long gs = (long)G * NTHR;
#define g0 ((long)bx * NTHR + mk_tid())
#ifndef PROBE_MASK
#define PROBE_MASK 0
#endif
#define REP(k) for (int rep_ = 0; rep_ < ((PROBE_MASK >> (k)) & 1) + 1; ++rep_)
#define GRID_BAR() do { REP(10) xcd_barrier(bar); } while (0)
#define PH_BEGIN(id) TP_BEGIN(id, L3)
#define PH_END(id) TP_END(id, L3)
    PH_BEGIN(0); REP(0) fp::prologue(p, L3, bx, G);
    GRID_BAR(); PH_END(0);
    for (int L = 0; L < DEPTH; ++L) {
        const int j = L >> 1; const bool moe = (L & 1) != 0;
        bf16* const hcur = (L & 1) ? p.HB2 : p.HB; bf16* const hnxt = (L & 1) ? p.HB : p.HB2;
        PH_BEGIN(1);
        REP(1) {
            pg8::Gemm g{hcur, p.WIN + (size_t)L * NU * D, (int)p.T, NU, D, D}; pg8::StaticOrder S; S.init((int)p.T, NU, G, bx);
            pg8::rstd_table(L3, rss_ptr(p, L, 0), S);
            pg8::EpiStore16 E{p.U, NU, (const LAS float*)(L3 + pg8::RSTD_TAB_OFF)}; pg8::gemm_phase<pg8::EpiStore16, pg8::StaticOrder, true, true>(L3, g, S, E);
            pg8::Gemm g2{p.PB16 + (size_t)L * p.T * PLE, p.WPP + (size_t)L * D * PLE, (int)p.T, D, PLE, PLE}; pg8::UpperHalfOrder S2; S2.init2((int)p.T, D, G, bx);
            pg8::EpiStore16 E2{p.PJ, D, nullptr}; pg8::gemm_phase<pg8::EpiStore16, pg8::UpperHalfOrder, true, true>(L3, g2, S2, E2);
        }
        GRID_BAR(); PH_END(1); PH_BEGIN(2);
        REP(6) { PH_BEGIN(13); fp::conv_module(p, L, L3, bx, G); PH_END(13); PH_BEGIN(14); fp::mla_proj(p, L, L3, bx, G); PH_END(14); PH_BEGIN(15); fp::ssd_a(p, L, L3, bx, G); PH_END(15); }
        GRID_BAR(); PH_END(2); PH_BEGIN(3);
        REP(7) { PH_BEGIN(16); fp::ssd_scan(p, bx, G); PH_END(16); PH_BEGIN(17); fp::attn_phase(p, L3, bx, G); PH_END(17); }
        GRID_BAR(); PH_END(3); PH_BEGIN(4);
        REP(8) fp::ssd_c(p, L, L3, bx, G);
        GRID_BAR(); PH_END(4); PH_BEGIN(5);
        {
            pg8::Gemm g{p.YC, p.WOUT + (size_t)L * D * D, (int)p.T, D, D, D}; pg8::StaticOrder S; S.init((int)p.T, D, G, bx);
            pg8::EpiAddH E{hcur, D, rss_ptr(p, L, 1)}; pg8::gemm_phase<pg8::EpiAddH, pg8::StaticOrder, true, true>(L3, g, S, E);
        }
        GRID_BAR(); PH_END(5);
        if (moe) { PH_BEGIN(6); fp::norm_phase<1>(p, L, p.ffn_g + L * D, hcur, bx, G, (LAS unsigned*)L3); GRID_BAR(); PH_END(6); PH_BEGIN(7); fp::moeplan(p, L, L3, bx, G); GRID_BAR(); PH_END(7); }
        PH_BEGIN(8);
        {
            const int rows = moe ? moe_start_of(p, j, NE) : (int)p.T;
            pg8::Gemm g{moe ? p.XB : hcur, moe ? p.MWGU + (size_t)j * NE * NGU * D : p.DWGU + (size_t)j * NGU * D, rows, NGU, D, D};
            pg8::ExpertOrder S; S.init(rows, NGU, G, bx); S.tile_e = moe ? p.TILE_E : nullptr;
            if (!moe) pg8::rstd_table(L3, rss_ptr(p, L, 1), S);
            REP(3) { pg8::EpiSwiglu E{p.ACT, DFF, moe ? (const LAS float*)nullptr : (const LAS float*)(L3 + pg8::RSTD_TAB_OFF)}; pg8::gemm_phase<pg8::EpiSwiglu, pg8::ExpertOrder, true, true>(L3, g, S, E); }
            GRID_BAR(); PH_END(8); PH_BEGIN(9);
            if (moe) {
                const int nwg = (rows >> 8) * 4, nfull = (nwg / G) * G, R = nwg - nfull; const int ksn = (R == 0) ? 1 : (R * 4 <= G && R <= 20 ? 4 : (R * 2 <= G && R <= 64 ? 2 : 1));
                const bf16* Wd = p.MWD + (size_t)j * NE * D * DFF; pg8::EpiMoeDown Ed{p.YS, hnxt, (size_t)R * 256 * 1024, (nfull >> 2) * 256};
                { pg8::Gemm gd{p.ACT, Wd, rows, D, DFF, DFF}; pg8::MoeDownOrder Sd{nwg, nfull, G, bx, 0, 0, p.TILE_E}; REP(4) pg8::gemm_phase<pg8::EpiMoeDown, pg8::MoeDownOrder, true, true>(L3, gd, Sd, Ed); }
                if (R > 0) { pg8::Gemm gd{p.ACT, Wd, rows, D, DFF / ksn, DFF}; pg8::MoeDownOrder Sd{nwg, nfull, G, bx, ksn, DFF / ksn, p.TILE_E}; pg8::gemm_phase<pg8::EpiMoeDown, pg8::MoeDownOrder, true, true>(L3, gd, Sd, Ed); }
                if (bx == 0 && mk_tid() == 0) { p.TILE_E[1000] = (nfull >> 2) * 256; p.TILE_E[1001] = ksn; p.TILE_E[1002] = R * 256; }
            } else {
                pg8::Gemm gd{p.ACT, p.DWD + (size_t)j * D * DFF, rows, D, DFF, DFF}; pg8::StaticOrder Sd; Sd.init(rows, D, G, bx);
                REP(4) { pg8::EpiAddH Ed{hcur, D, rss_ptr(p, L, 2)}; pg8::gemm_phase<pg8::EpiAddH, pg8::StaticOrder, true, true>(L3, gd, Sd, Ed); }
            }
        }
        GRID_BAR(); PH_END(9);
        if (moe) { PH_BEGIN(10); fp::norm_phase<2>(p, L, nullptr, hcur, bx, G, nullptr, hnxt); GRID_BAR(); PH_END(10); }
        PH_BEGIN(11);
        {
            pg8::Gemm g{hcur, p.WPG + (size_t)L * D * D, (int)p.T, D, D, D}; pg8::StaticOrder S; S.init((int)p.T, D, G, bx);
            pg8::rstd_table(L3, rss_ptr(p, L, 2), S);
            pg8::EpiPleF E{hcur, hnxt, p.PJ, D, (const LAS float*)(L3 + pg8::RSTD_TAB_OFF), rss_ptr(p, L + 1, 0)}; pg8::gemm_phase<pg8::EpiPleF, pg8::StaticOrder, true, true>(L3, g, S, E);
        }
        GRID_BAR(); PH_END(11);
    }
    PH_BEGIN(12); fp::norm_phase<3>(p, 0, p.fin_g, p.HB, bx, G); PH_END(12);
    if (PROBE_T && bx == 0 && tid == 0) { const unsigned long long te_ = __builtin_amdgcn_s_memrealtime() + 4ull * MISC[2]; while (__builtin_amdgcn_s_memrealtime() < te_) __builtin_amdgcn_s_sleep(8); }
}
static void fill_params(MP& p, void* const* d_in, void* d_out, void* d_ws) {
    p.x = (const float*)d_in[0]; p.p = (const float*)d_in[1]; p.pos = (const int*)d_in[2];
    const float** w = &p.attn_g; for (int i = 3; i < 32; ++i) w[i - 3] = (const float*)d_in[i];
    p.out = (float*)d_out; p.B = 8; p.S = 2048; p.T = 16384; p.NSLOT = 2 * 16384 + 8 * 256;
    carve(p, (unsigned char*)d_ws);
}
extern "C" void kernel_launch(void* const* d_in, const int* in_sizes, int n_in, void* d_out, int out_size, void* d_ws, size_t ws_size, hipStream_t stream) {
    static int grid = 0;
    if (grid == 0) {
        MP q{}; q.T = 16384; q.NSLOT = 2 * 16384 + 8 * 256; const size_t need = carve(q, nullptr);
        if (n_in != 32 || ws_size < need) { fprintf(stderr, "kernel_launch: need %zu bytes of ws, have %zu (n_in %d)\n", need, ws_size, n_in); grid = -1; return; }
        int dev = 0, cus = 0, per_cu = 0;
        if (hipGetDevice(&dev) != hipSuccess || hipDeviceGetAttribute(&cus, hipDeviceAttributeMultiprocessorCount, dev) != hipSuccess) { grid = -1; return; }
        if (hipFuncSetAttribute((const void*)mk_fwd, hipFuncAttributeMaxDynamicSharedMemorySize, LDS_BYTES) != hipSuccess) { fprintf(stderr, "kernel_launch: hipFuncSetAttribute failed\n"); grid = -1; return; }
        if (hipOccupancyMaxActiveBlocksPerMultiprocessor(&per_cu, (const void*)mk_fwd, NTHR, LDS_BYTES) != hipSuccess || per_cu < 1) { fprintf(stderr, "kernel_launch: occupancy query says %d\n", per_cu); }
        (void)hipGetLastError();
        grid = cus;
    }
    if (grid < 0) return;
    Args a{}; fill_params(a.p, d_in, d_out, d_ws); a.flags = 0;
    if (hipMemsetAsync(a.p.ctl, 0, CTL_WORDS * 4, stream) != hipSuccess) return;
    hipLaunchKernelGGL(mk_fwd, dim3(grid), dim3(NTHR), LDS_BYTES, stream, a);
}
```

```cpp
#include <hip/hip_runtime.h>
#include <cstdio>
#include <cstdint>
__device__ __forceinline__ int mk_tid() { int t = threadIdx.x; asm volatile("" : "+v"(t)); return t; }
#ifndef PROBE_T
#define PROBE_T 0
#endif
#ifndef PROBE_CK
#define PROBE_CK 0
#endif
constexpr int LDS_BYTES = 163840, LDSCTL_OFF = LDS_BYTES - 512, MISC_OFF = LDSCTL_OFF + 320;
#define TP_MISC(l3) ((volatile __attribute__((address_space(3))) unsigned*)((l3) + MISC_OFF))
#define TP_BEGIN(id, l3) do { if (((PROBE_T >> (id)) & 1) && blockIdx.x == 0 && threadIdx.x == 0) { const unsigned long long t_ = __builtin_amdgcn_s_memrealtime(); TP_MISC(l3)[0] = (unsigned)t_; TP_MISC(l3)[1] = (unsigned)(t_ >> 32); } } while (0)
#define TP_END(id, l3) do { if (((PROBE_T >> (id)) & 1) && blockIdx.x == 0 && threadIdx.x == 0) { const unsigned long long t0_ = ((unsigned long long)TP_MISC(l3)[1] << 32) | TP_MISC(l3)[0]; TP_MISC(l3)[2] += (unsigned)(__builtin_amdgcn_s_memrealtime() - t0_); } } while (0)

#include <cstring>
#include <cmath>
#include <cstdint>
#ifdef __HIPCC__
#define HD __host__ __device__ __forceinline__
#else
#define HD inline
#endif
typedef unsigned short bf16;
namespace mdl {
constexpr int D = 1024, DEPTH = 4, NU = 2560, NUO = 2472, DFF = 3584, NGU = 7168, NE = 8, PLE = 256;
constexpr int CK = 31, SCONV = 4, CHUNK = 128, NH = 8, HP = 64, NS = 128;
constexpr float RMS_EPS = 1e-6f, LN_EPS = 1e-5f;
constexpr float QSCALE = 0.10206207261596577f * 1.4426950408889634f;
constexpr int U_Z = 512, U_XBC = 1024, U_CQ = 2048, U_CKV = 2304, U_KR = 2432, U_DT = 2464;

HD float bf2f(bf16 v) { unsigned u = (unsigned)v << 16; float f; memcpy(&f, &u, 4); return f; }
HD bf16 f2bf(float f) { unsigned u; memcpy(&u, &f, 4); u += 0x7fffu + ((u >> 16) & 1u); return (bf16)(u >> 16); }
HD float sigmoidf_(float x) { return 1.0f / (1.0f + expf(-x)); }
HD float siluf_(float x) { return x / (1.0f + expf(-x)); }
HD float softplusf_(float x) { return x > 20.f ? x : log1pf(expf(x)); }
HD int ucol_src(int n) { return n < 2048 ? n : (n < U_DT ? n + 8 : (n < NUO ? n - U_DT + 2048 : -1)); }

struct MP {
    const float *x, *p; const int* pos;
    const float *attn_g, *w_in, *cdw_w, *cdw_b, *cln_g, *cln_b, *sconv_w, *sconv_b, *dt_bias, *a_log, *dskip, *snorm_g, *qn_g, *w_uq, *kvn_g, *w_ukv,
        *w_out, *ffn_g, *dwg, *dwu, *dwd, *router, *mwg, *mwu, *mwd, *ple_g, *ple_wg, *ple_wp, *fin_g;
    float* out;
    long B, S, T, NSLOT;
    unsigned* ctl;
    bf16 *WIN, *WUQ, *WUKV, *WOUT, *DWGU, *DWD, *MWGU, *MWD, *WPG, *WPP;
    float *RSSP, *H, *CS, *DT, *ACS, *ST, *CB, *YPRE, *TOPG;
    bf16 *HB2, *HB, *U, *YC, *Q, *KK, *V, *XS, *BM, *CM, *YD, *PV, *PB16, *PJ, *ACT, *XB, *YS;
    int *TOPE, *POS, *TOKSLOT, *TILE_E, *BCNT;
};
constexpr int CTL_WORDS = 65536;
HD unsigned* cnt_ptr(const MP& p, int j) { return p.ctl + 1024 + j * 64; }
HD float* rss_ptr(const MP& p, int L, int k) { return p.RSSP + (size_t)(L * 3 + k) * p.T * 16; }

inline size_t carve(MP& p, unsigned char* ws) {
    size_t o = 0; const size_t T = p.T, NSL = p.NSLOT;
    auto take = [&](size_t bytes) { size_t r = o; o += (bytes + 255) & ~(size_t)255; return ws + r; };
    p.ctl = (unsigned*)take(CTL_WORDS * 4);
    p.WIN = (bf16*)take((size_t)DEPTH * NU * D * 2); p.WUQ = (bf16*)take((size_t)DEPTH * 512 * 256 * 2); p.WUKV = (bf16*)take((size_t)DEPTH * 512 * 128 * 2);
    p.WOUT = (bf16*)take((size_t)DEPTH * D * D * 2); p.DWGU = (bf16*)take((size_t)2 * NGU * D * 2); p.DWD = (bf16*)take((size_t)2 * D * DFF * 2);
    p.MWGU = (bf16*)take((size_t)2 * NE * NGU * D * 2); p.MWD = (bf16*)take((size_t)2 * NE * D * DFF * 2);
    p.WPG = (bf16*)take((size_t)DEPTH * D * D * 2); p.WPP = (bf16*)take((size_t)DEPTH * D * PLE * 2);
    p.RSSP = (float*)take((size_t)13 * T * 16 * 4); p.H = (float*)take(T * D * 4);     p.HB = (bf16*)take(T * D * 2); p.HB2 = (bf16*)take(T * D * 2); p.CS = (float*)take(T * 32 * 4);
    p.PB16 = (bf16*)take((size_t)DEPTH * T * PLE * 2); p.PJ = (bf16*)take(T * D * 2);
    p.TOPE = (int*)take(T * 2 * 4); p.TOPG = (float*)take(T * 2 * 4); p.POS = (int*)take(T * 2 * 4); p.TOKSLOT = (int*)take(T * 2 * 4); p.TILE_E = (int*)take(1024 * 4); p.BCNT = (int*)take(1024 * NE * 4);
    p.XB = (bf16*)take(NSL * D * 2); p.YS = p.XB;
    const size_t r1 = o;
    p.U = (bf16*)take(T * NU * 2); p.YC = (bf16*)take(T * D * 2); p.Q = (bf16*)take(T * 384 * 2); p.KK = (bf16*)take(T * 384 * 2); p.V = (bf16*)take(T * 256 * 2);
    p.XS = (bf16*)take(T * 512 * 2); p.BM = (bf16*)take(T * 256 * 2); p.CM = (bf16*)take(T * 256 * 2); p.YD = (bf16*)take(T * 512 * 2);
    p.DT = (float*)take(T * 8 * 4); p.ACS = (float*)take(T * 8 * 4); p.ST = (float*)take(T / CHUNK * NH * HP * NS * 4); p.PV = (bf16*)take(T / CHUNK * NH * HP * NS * 2);
    p.CB = nullptr; p.YPRE = nullptr;
    const size_t r1end = o; o = r1;
    p.ACT = (bf16*)take(NSL * DFF * 2);
    if (o < r1end) o = r1end;
    return o;
}

HD int moe_start_of(const MP& p, int j, int E) { const unsigned* cnt = cnt_ptr(p, j); int o = 0; for (int e = 0; e < NE; ++e) if (e < E) o += (int)((cnt[e] + 255u) / 256u) * 256; return o; }
}

namespace pg8 {
#define PG8_LAS __attribute__((address_space(3)))
typedef unsigned short bf16_t;
typedef short bf16x8 __attribute__((ext_vector_type(8)));
typedef float f32x4 __attribute__((ext_vector_type(4)));
typedef unsigned u32x4 __attribute__((ext_vector_type(4)));
constexpr int BM = 256, BK = 64, HALF = 128, HTB = HALF * BK * 2  , STAGE_BYTES = 8 * HTB, NXCD = 8, WGM = 8;

__host__ __device__ __forceinline__ int lds_byte(int r, int c) { const int st = (r >> 4) * 2 + (c >> 5), rr = r & 15, cc = c & 31, ob = rr * 64 + cc * 2; return st * 1024 + (ob ^ (((ob >> 9) & 1) << 5)); }
__host__ __device__ __forceinline__ void stage_rc(int b, int& R, int& C) { const int st = b / 1024, sb = b % 1024, swz = sb ^ (((sb >> 9) & 1) << 5); R = (st >> 1) * 16 + swz / 64; C = (st & 1) * 32 + (swz % 64) / 2; }
__host__ __device__ __forceinline__ int perm32(int rho) { const int n = rho >> 4, i = rho & 15; return 8 * (i >> 2) + 4 * n + (i & 3); }

struct Unit { int pm, pn, cn, koff, ks, ui; };
struct Gemm { const bf16_t* A; const bf16_t* Bt; int M, N, K, ld; };

struct StaticOrder {
    int nM, nN, nwg, G, c;
    __host__ __device__ void init(int M, int N, int G_, int c_) { nM = M / BM; nN = N / BM; nwg = nM * nN; G = G_; c = c_; }
    __host__ __device__ bool next(int i, Unit& u) const {
        const int L = i * G + c; if (L >= nwg) return false;
        int wgid = L; { const int q = nwg / NXCD, r = nwg % NXCD, xcd = wgid % NXCD, off = wgid / NXCD; wgid = (xcd < r ? xcd * (q + 1) : r * (q + 1) + (xcd - r) * q) + off; }
        const int nig = WGM * nN, gid = wgid / nig, fm = gid * WGM, gsz = (nM - fm) < WGM ? (nM - fm) : WGM;
        u.pm = fm + ((wgid % nig) % gsz); u.pn = (wgid % nig) / gsz; u.cn = u.pn; u.koff = 0; u.ks = 0; u.ui = i; return true;
    }
    __device__ __forceinline__ void a_ready(const Unit&) const {}
    __device__ __forceinline__ void done(const Unit&) const {}
};
__device__ __forceinline__ unsigned cvt_pk_bf16(float lo, float hi) { unsigned r; asm volatile("v_cvt_pk_bf16_f32 %0, %1, %2" : "=v"(r) : "v"(lo), "v"(hi)); return r; }
typedef float f32x2 __attribute__((ext_vector_type(2)));
template <class Epi, class Sched, bool ALIGN_EPI = false, bool SP2 = false>
__device__ __forceinline__ void gemm_phase(PG8_LAS unsigned char* lds, const Gemm g, const Sched& S, const Epi& E) {
    if (Epi::TAG == PROBE_CK) TP_BEGIN(27, lds);
    const int tid = mk_tid(), wid = __builtin_amdgcn_readfirstlane(tid >> 6), lane = tid & 63, wr = wid >> 2, wc = wid & 3, fr = lane & 15, fq = lane >> 4;
    const int K = g.ld, nt = g.K / BK;
    unsigned voffA[2], voffB[2];
#pragma unroll
    for (int i = 0; i < 2; ++i) { int R, C; stage_rc(tid * 16 + i * 8192, R, C); const int Rb = Epi::PERM ? ((R & ~31) + perm32(R & 31)) : R;
        voffA[i] = (unsigned)(R * K + C) * 2u; voffB[i] = (unsigned)(Rb * K + C) * 2u; }
    const size_t kstep = (size_t)(BK * 2);
    const size_t hstep = (size_t)HALF * K * 2;
    const size_t tstep = 2 * hstep;
    const unsigned ldsw = (unsigned)wid * 1024u;
    const int aoff = lds_byte(wr * 64 + fr, fq * 8), boff = lds_byte(wc * 32 + fr, fq * 8);
#define PG8_SA(b, h) (((b) * 2 + (h)) * HTB)
#define PG8_SB(b, h) ((4 + (b) * 2 + (h)) * HTB)
#define PG8_STAGE(bufoff, gbase, voff) do { _Pragma("unroll") for (int _i = 0; _i < 2; ++_i) \
        __builtin_amdgcn_global_load_lds((const unsigned*)((const char*)(gbase) + (voff)[_i]), (PG8_LAS unsigned*)(lds + (bufoff) + ldsw + _i * 8192), 16, 0, 0); } while (0)
#define PG8_LDA(dst, b, h) do { _Pragma("unroll") for (int m = 0; m < 4; ++m) _Pragma("unroll") for (int k = 0; k < 2; ++k) dst[m][k] = *(const PG8_LAS bf16x8*)(lds + PG8_SA(b, h) + aoff + m * 2048 + k * 1024); } while (0)
#define PG8_LDB(dst, b, h) do { _Pragma("unroll") for (int n = 0; n < 2; ++n) _Pragma("unroll") for (int k = 0; k < 2; ++k) dst[n][k] = *(const PG8_LAS bf16x8*)(lds + PG8_SB(b, h) + boff + n * 2048 + k * 1024); } while (0)
#define PG8_MMA(ai, bj, At, Bt) do { __builtin_amdgcn_s_setprio(1); _Pragma("unroll") for (int m = 0; m < 4; ++m) _Pragma("unroll") for (int n = 0; n < 2; ++n) _Pragma("unroll") for (int k = 0; k < 2; ++k) \
        acc[ai][bj][m][n] = __builtin_amdgcn_mfma_f32_16x16x32_bf16(Bt[n][k], At[m][k], acc[ai][bj][m][n], 0, 0, 0); __builtin_amdgcn_s_setprio(0); } while (0)
#define PG8_WAIT_V(n) asm volatile("s_waitcnt vmcnt(" #n ")" ::: "memory")
#define PG8_WAIT_L(n) asm volatile("s_waitcnt lgkmcnt(" #n ")" ::: "memory")
#define PG8_BAR __builtin_amdgcn_s_barrier()
#define PG8_SCHED __builtin_amdgcn_sched_barrier(0)
    Unit cur, nxt; int ui = 0;
    if (!S.next(0, cur)) return;
    f32x4 acc[2][2][4][2];
#pragma unroll
    for (int a = 0; a < 2; ++a)
#pragma unroll
        for (int b = 0; b < 2; ++b)
#pragma unroll
            for (int m = 0; m < 4; ++m)
#pragma unroll
                for (int n = 0; n < 2; ++n) acc[a][b][m][n] = (f32x4){0.f, 0.f, 0.f, 0.f};
    bf16x8 At[4][2], B0[2][2], B1[2][2];
    const char* cA = (const char*)g.A + (size_t)cur.pm * tstep + (size_t)cur.koff * 2; const char* cB = (const char*)g.Bt + (size_t)cur.pn * tstep + (size_t)cur.koff * 2;
    S.a_ready(cur);
    if constexpr (SP2) {
        PG8_STAGE(PG8_SB(0, 0), cB, voffB); PG8_STAGE(PG8_SB(0, 1), cB + hstep, voffB); PG8_STAGE(PG8_SA(0, 0), cA, voffA); PG8_STAGE(PG8_SA(0, 1), cA + hstep, voffA);
        if (wr == 1) PG8_BAR;
        PG8_WAIT_V(2); PG8_BAR;
        PG8_STAGE(PG8_SB(1, 0), cB + kstep, voffB); PG8_STAGE(PG8_SA(1, 0), cA + kstep, voffA); PG8_STAGE(PG8_SB(1, 1), cB + hstep + kstep, voffB);
        PG8_WAIT_V(6); PG8_BAR;
    } else {
        PG8_STAGE(PG8_SB(0, 0), cB, voffB); PG8_STAGE(PG8_SA(0, 0), cA, voffA); PG8_STAGE(PG8_SB(0, 1), cB + hstep, voffB); PG8_STAGE(PG8_SA(0, 1), cA + hstep, voffA);
        if (wr == 1) PG8_BAR;
        PG8_WAIT_V(4); PG8_BAR;
        PG8_STAGE(PG8_SB(1, 0), cB + kstep, voffB); PG8_STAGE(PG8_SA(1, 0), cA + kstep, voffA); PG8_STAGE(PG8_SB(1, 1), cB + hstep + kstep, voffB);
        PG8_WAIT_V(6); PG8_BAR;
    }
    for (;;) {
        const bool has_next = S.next(ui + 1, nxt);
        const char* nA = has_next ? (const char*)g.A + (size_t)nxt.pm * tstep + (size_t)nxt.koff * 2 : cA; const char* nB = has_next ? (const char*)g.Bt + (size_t)nxt.pn * tstep + (size_t)nxt.koff * 2 : cB;
#pragma unroll 1
        for (int t = 0; t < nt; t += 2) {
            const bool last = (t == nt - 2);
            const char* a1 = cA + (size_t)(t + 1) * kstep;
            const char* a2 = last ? nA : cA + (size_t)(t + 2) * kstep; const char* b2 = last ? nB : cB + (size_t)(t + 2) * kstep;
            const char* a3 = a2 + kstep; const char* b3 = b2 + kstep;
            if (last && has_next) S.a_ready(nxt);
            if constexpr (SP2) {
            PG8_LDB(B0, 0, 0); PG8_LDB(B1, 0, 1); PG8_SCHED; PG8_LDA(At, 0, 0); PG8_STAGE(PG8_SA(1, 1), a1 + hstep, voffA);
            PG8_WAIT_V(8); PG8_WAIT_L(0); PG8_BAR; PG8_MMA(0, 0, At, B0); PG8_MMA(0, 1, At, B1); PG8_BAR; PG8_SCHED;
            PG8_LDA(At, 0, 1); PG8_STAGE(PG8_SB(0, 0), b2, voffB); PG8_STAGE(PG8_SB(0, 1), b2 + hstep, voffB); PG8_STAGE(PG8_SA(0, 0), a2, voffA);
            PG8_WAIT_V(8); PG8_WAIT_L(0); PG8_BAR; PG8_MMA(1, 0, At, B0); PG8_MMA(1, 1, At, B1); PG8_BAR; PG8_SCHED;
            PG8_LDB(B0, 1, 0); PG8_LDB(B1, 1, 1); PG8_SCHED; PG8_LDA(At, 1, 0); PG8_STAGE(PG8_SA(0, 1), a2 + hstep, voffA);
            PG8_WAIT_V(8); PG8_WAIT_L(0); PG8_BAR; PG8_MMA(0, 0, At, B0); PG8_MMA(0, 1, At, B1); PG8_BAR; PG8_SCHED;
            PG8_LDA(At, 1, 1); PG8_STAGE(PG8_SB(1, 0), b3, voffB); PG8_STAGE(PG8_SB(1, 1), b3 + hstep, voffB); PG8_STAGE(PG8_SA(1, 0), a3, voffA);
            PG8_WAIT_V(8); PG8_WAIT_L(0); PG8_BAR; PG8_MMA(1, 0, At, B0); PG8_MMA(1, 1, At, B1); PG8_BAR; PG8_SCHED;
            } else {
            PG8_LDB(B0, 0, 0); PG8_SCHED; PG8_LDA(At, 0, 0); PG8_STAGE(PG8_SA(1, 1), a1 + hstep, voffA);
            PG8_WAIT_L(8); PG8_BAR; PG8_WAIT_L(0); PG8_MMA(0, 0, At, B0); PG8_BAR; PG8_SCHED;
            PG8_LDB(B1, 0, 1); PG8_STAGE(PG8_SB(0, 0), b2, voffB);
            PG8_BAR; PG8_WAIT_L(0); PG8_MMA(0, 1, At, B1); PG8_BAR;
            PG8_LDA(At, 0, 1); PG8_STAGE(PG8_SA(0, 0), a2, voffA);
            PG8_BAR; PG8_WAIT_L(0); PG8_MMA(1, 0, At, B0); PG8_BAR; PG8_SCHED;
            PG8_STAGE(PG8_SB(0, 1), b2 + hstep, voffB);
            PG8_WAIT_V(6); PG8_BAR; PG8_MMA(1, 1, At, B1); PG8_BAR;
            PG8_LDB(B0, 1, 0); PG8_SCHED; PG8_LDA(At, 1, 0); PG8_STAGE(PG8_SA(0, 1), a2 + hstep, voffA);
            PG8_WAIT_L(8); PG8_BAR; PG8_WAIT_L(0); PG8_MMA(0, 0, At, B0); PG8_BAR; PG8_SCHED;
            PG8_LDB(B1, 1, 1); PG8_STAGE(PG8_SB(1, 0), b3, voffB);
            PG8_BAR; PG8_WAIT_L(0); PG8_MMA(0, 1, At, B1); PG8_BAR;
            PG8_LDA(At, 1, 1); PG8_STAGE(PG8_SA(1, 0), a3, voffA);
            PG8_BAR; PG8_WAIT_L(0); PG8_MMA(1, 0, At, B0); PG8_BAR; PG8_SCHED;
            PG8_STAGE(PG8_SB(1, 1), b3 + hstep, voffB);
            PG8_WAIT_V(6); PG8_BAR; PG8_MMA(1, 1, At, B1); PG8_BAR;
            }
        }
        TP_BEGIN(26, lds); if constexpr (ALIGN_EPI) { if (wr == 0) PG8_BAR; } TP_END(26, lds);
        if (Epi::TAG == PROBE_CK) TP_BEGIN(25, lds); if constexpr (!Epi::AFTER_DRAIN) { E(acc, cur, wr, wc, fr, fq); S.done(cur); } if (((PROBE_T >> 25) & 1) && Epi::TAG == PROBE_CK) { asm volatile("s_waitcnt vmcnt(0)" ::: "memory"); TP_END(25, lds); }
        if (!has_next) break;
#pragma unroll
        for (int a = 0; a < 2; ++a)
#pragma unroll
            for (int b = 0; b < 2; ++b)
#pragma unroll
                for (int m = 0; m < 4; ++m)
#pragma unroll
                    for (int n = 0; n < 2; ++n) acc[a][b][m][n] = (f32x4){0.f, 0.f, 0.f, 0.f};
        cur = nxt; cA = nA; cB = nB; ++ui;
        if constexpr (ALIGN_EPI) { if (wr == 1) PG8_BAR; }
    }
    PG8_WAIT_V(0);
    if constexpr (!ALIGN_EPI) { if (wr == 0) PG8_BAR; }
    PG8_BAR;
    if constexpr (Epi::AFTER_DRAIN) { E.fused(acc, cur, wr, wc, fr, fq, lds, wid, lane); S.done(cur); }
    if (Epi::TAG == PROBE_CK) TP_END(27, lds);
#undef PG8_SA
#undef PG8_SB
#undef PG8_STAGE
#undef PG8_LDA
#undef PG8_LDB
#undef PG8_MMA
#undef PG8_WAIT_V
#undef PG8_WAIT_L
#undef PG8_BAR
#undef PG8_SCHED
}
}

namespace pg8 {
__device__ __forceinline__ float fast_sigmoid(float x) { return __builtin_amdgcn_rcpf(1.0f + __builtin_amdgcn_exp2f(-1.4426950408889634f * x)); }
constexpr int RSTD_TAB_OFF = STAGE_BYTES, RSTD_MAX_UNITS = 8;
template <class Sched> __device__ __forceinline__ void rstd_table(PG8_LAS unsigned char* lds, const float* rss, const Sched& S) {
    PG8_LAS float* tab = (PG8_LAS float*)(lds + RSTD_TAB_OFF); const int tid = mk_tid(), r = tid & 255, par = __builtin_amdgcn_readfirstlane(tid >> 8);
    f32x4 q[4][4]; bool ok[4];
#pragma unroll
    for (int it = 0; it < 4; ++it) { Unit u; const int ui = 2 * it + par; ok[it] = S.next(ui, u);
        if (ok[it]) { const f32x4* src = (const f32x4*)(rss + ((size_t)u.pm * BM + r) * 16);
#pragma unroll
            for (int k = 0; k < 4; ++k) q[it][k] = src[k]; } }
#pragma unroll
    for (int it = 0; it < 4; ++it) if (ok[it]) { const f32x4 a = q[it][0], b = q[it][1], c = q[it][2], d = q[it][3];
        const float s = (((a[0] + a[1]) + (a[2] + a[3])) + ((b[0] + b[1]) + (b[2] + b[3]))) + (((c[0] + c[1]) + (c[2] + c[3])) + ((d[0] + d[1]) + (d[2] + d[3])));
        tab[(2 * it + par) * 256 + r] = 1.0f / sqrtf(s * (1.0f / 1024.f) + 1e-6f); }
    asm volatile("s_waitcnt lgkmcnt(0)" ::: "memory"); __syncthreads();
}
__device__ __forceinline__ void rstd8(const PG8_LAS float* tab, int ui, int rl0, float (&rs)[8]) {
    if (!tab) {
#pragma unroll
        for (int i = 0; i < 8; ++i) rs[i] = 1.0f;
        return; }
#pragma unroll
    for (int i = 0; i < 8; ++i) rs[i] = tab[ui * 256 + rl0 + (i >> 2) * HALF + (i & 3) * 16];
}
struct EpiStore16 {
    static constexpr bool PERM = true, AFTER_DRAIN = false; static constexpr int TAG = 3;
    bf16_t* O; int ldc; const PG8_LAS float* tab;
    __device__ __forceinline__ void operator()(const f32x4 (&acc)[2][2][4][2], const Unit& u, int wr, int wc, int fr, int fq) const {
        const int row0 = u.pm * BM + wr * 64 + fr, col0 = u.cn * BM + wc * 32 + 8 * fq;
        float rs[8]; rstd8(tab, u.ui, wr * 64 + fr, rs);
#pragma unroll
        for (int ai = 0; ai < 2; ++ai)
#pragma unroll
            for (int m = 0; m < 4; ++m) { const int row = row0 + ai * HALF + m * 16; bf16_t* rowp = O + (size_t)row * ldc + col0; const float r = rs[ai * 4 + m];
#pragma unroll
                for (int bj = 0; bj < 2; ++bj) { const f32x4 v0 = acc[ai][bj][m][0] * r, v1 = acc[ai][bj][m][1] * r;
                    u32x4 w; w.x = cvt_pk_bf16(v0[0], v0[1]); w.y = cvt_pk_bf16(v0[2], v0[3]); w.z = cvt_pk_bf16(v1[0], v1[1]); w.w = cvt_pk_bf16(v1[2], v1[3]);
                    *(u32x4*)(rowp + bj * HALF) = w; } }
    }
};
__device__ __forceinline__ float sq8(const u32x4 w) { float s = 0.f;
#pragma unroll
    for (int i = 0; i < 4; ++i) { const float a = __uint_as_float(w[i] << 16), b = __uint_as_float(w[i] & 0xffff0000u); s += a * a + b * b; } return s; }
struct EpiAddH {
    static constexpr bool PERM = true, AFTER_DRAIN = false; static constexpr int TAG = 1;
    bf16_t* Hb; int ldc; float* rss_out;
    __device__ __forceinline__ void operator()(const f32x4 (&acc)[2][2][4][2], const Unit& u, int wr, int wc, int fr, int fq) const {
        const int row0 = u.pm * BM + wr * 64 + fr, col0 = u.cn * BM + wc * 32 + 8 * fq;
        u32x4 h[2][4][2];
#pragma unroll
        for (int ai = 0; ai < 2; ++ai)
#pragma unroll
            for (int m = 0; m < 4; ++m)
#pragma unroll
                for (int bj = 0; bj < 2; ++bj) h[ai][m][bj] = *(const u32x4*)(Hb + (size_t)(row0 + ai * HALF + m * 16) * ldc + col0 + bj * HALF);
        __builtin_amdgcn_sched_barrier(0);
#pragma unroll
        for (int ai = 0; ai < 2; ++ai)
#pragma unroll
            for (int m = 0; m < 4; ++m) { const int row = row0 + ai * HALF + m * 16; float ss = 0.f;
#pragma unroll
                for (int bj = 0; bj < 2; ++bj) { const u32x4 q = h[ai][m][bj]; const f32x4 a0 = acc[ai][bj][m][0], a1 = acc[ai][bj][m][1]; u32x4 w;
                    w.x = cvt_pk_bf16(__uint_as_float(q.x << 16) + a0[0], __uint_as_float(q.x & 0xffff0000u) + a0[1]); w.y = cvt_pk_bf16(__uint_as_float(q.y << 16) + a0[2], __uint_as_float(q.y & 0xffff0000u) + a0[3]);
                    w.z = cvt_pk_bf16(__uint_as_float(q.z << 16) + a1[0], __uint_as_float(q.z & 0xffff0000u) + a1[1]); w.w = cvt_pk_bf16(__uint_as_float(q.w << 16) + a1[2], __uint_as_float(q.w & 0xffff0000u) + a1[3]);
                    *(u32x4*)(Hb + (size_t)row * ldc + col0 + bj * HALF) = w; ss += sq8(w); }
                ss += __shfl_xor(ss, 16); ss += __shfl_xor(ss, 32);
                if (fq == 0) rss_out[(size_t)row * 16 + u.cn * 4 + wc] = ss; }
    }
};
struct EpiSwiglu {
    static constexpr bool PERM = true, AFTER_DRAIN = false; static constexpr int TAG = 4;
    bf16_t* O; int ldc; const PG8_LAS float* tab;
    __device__ __forceinline__ void operator()(const f32x4 (&acc)[2][2][4][2], const Unit& u, int wr, int wc, int fr, int fq) const {
        const int row0 = u.pm * BM + wr * 64 + fr, col0 = u.cn * HALF + wc * 32 + 8 * fq;
        float rs[8]; rstd8(tab, u.ui, wr * 64 + fr, rs);
#pragma unroll
        for (int ai = 0; ai < 2; ++ai)
#pragma unroll
            for (int m = 0; m < 4; ++m) { const int row = row0 + ai * HALF + m * 16; bf16_t* rowp = O + (size_t)row * ldc + col0; float o[8]; const float r = rs[ai * 4 + m];
#pragma unroll
                for (int n = 0; n < 2; ++n)
#pragma unroll
                    for (int j = 0; j < 4; ++j) { const float gt = acc[ai][0][m][n][j] * r, up = acc[ai][1][m][n][j] * r; o[n * 4 + j] = gt * fast_sigmoid(gt) * up; }
                u32x4 w; w.x = cvt_pk_bf16(o[0], o[1]); w.y = cvt_pk_bf16(o[2], o[3]); w.z = cvt_pk_bf16(o[4], o[5]); w.w = cvt_pk_bf16(o[6], o[7]);
                *(u32x4*)rowp = w; }
    }
};
struct EpiPleF {
    static constexpr bool PERM = true, AFTER_DRAIN = false; static constexpr int TAG = 2;
    const bf16_t* Hin; bf16_t* Hout; const bf16_t* PJ; int ldc; const PG8_LAS float* tab; float* rss_out;
    __device__ __forceinline__ void operator()(const f32x4 (&acc)[2][2][4][2], const Unit& u, int wr, int wc, int fr, int fq) const {
        const int row0 = u.pm * BM + wr * 64 + fr, col0 = u.cn * BM + wc * 32 + 8 * fq;
        float rs[8]; rstd8(tab, u.ui, wr * 64 + fr, rs);
#pragma unroll
        for (int ai = 0; ai < 2; ++ai) { u32x4 h[4][2], pj[4][2];
#pragma unroll
            for (int m = 0; m < 4; ++m)
#pragma unroll
                for (int bj = 0; bj < 2; ++bj) { const size_t off = (size_t)(row0 + ai * HALF + m * 16) * ldc + col0 + bj * HALF; h[m][bj] = *(const u32x4*)(Hin + off); pj[m][bj] = *(const u32x4*)(PJ + off); }
            __builtin_amdgcn_sched_barrier(0);
#pragma unroll
            for (int m = 0; m < 4; ++m) { const int row = row0 + ai * HALF + m * 16; const float r = rs[ai * 4 + m]; float ss = 0.f;
#pragma unroll
                for (int bj = 0; bj < 2; ++bj) { const u32x4 hh = h[m][bj], q = pj[m][bj]; u32x4 w;
#pragma unroll
                    for (int i = 0; i < 4; ++i) { const float a_lo = acc[ai][bj][m][i >> 1][(i & 1) * 2] * r, a_hi = acc[ai][bj][m][i >> 1][(i & 1) * 2 + 1] * r;
                        w[i] = cvt_pk_bf16(__uint_as_float(hh[i] << 16) + __uint_as_float(q[i] << 16) * fast_sigmoid(a_lo), __uint_as_float(hh[i] & 0xffff0000u) + __uint_as_float(q[i] & 0xffff0000u) * fast_sigmoid(a_hi)); }
                    *(u32x4*)(Hout + (size_t)row * ldc + col0 + bj * HALF) = w; ss += sq8(w); }
                ss += __shfl_xor(ss, 16); ss += __shfl_xor(ss, 32);
                if (fq == 0) rss_out[(size_t)row * 16 + u.cn * 4 + wc] = ss; }
            asm volatile("" ::: "memory"); }
    }
};
struct ExpertOrder : StaticOrder {
    const int* tile_e;
    __device__ __forceinline__ bool next(int i, Unit& u) const { if (!StaticOrder::next(i, u)) return false; if (tile_e) u.pn += tile_e[u.pm] * nN; return true; }
};
struct UpperHalfOrder : StaticOrder {
    __host__ __device__ void init2(int M, int N, int G_, int c_) { init(M, N, G_ / 2, c_ - G_ / 2); if (c_ < G_ / 2) c = nwg; }
};
struct MoeDownOrder {
    int nwg, nfull, G, c, ks_n, kslice; const int* tile_e;
    __device__ __forceinline__ bool next(int i, Unit& u) const {
        const int q = i * G + c; int L;
        if (ks_n == 0) { L = q; if (L >= nfull) return false; u.koff = 0; u.ks = 0; }
        else { if (q >= (nwg - nfull) * ks_n) return false; L = nfull + q / ks_n; u.ks = q % ks_n; u.koff = u.ks * kslice; }
        u.pm = L >> 2; u.cn = L & 3; u.pn = u.cn + tile_e[u.pm] * 4; u.ui = i; return true;
    }
    __device__ __forceinline__ void a_ready(const Unit&) const {}
    __device__ __forceinline__ void done(const Unit&) const {}
};
struct EpiMoeDown {
    static constexpr bool PERM = true, AFTER_DRAIN = false; static constexpr int TAG = 5;
    bf16_t* O; bf16_t* P; size_t pstride; int row0p;
    __device__ __forceinline__ void operator()(const f32x4 (&acc)[2][2][4][2], const Unit& u, int wr, int wc, int fr, int fq) const {
        const int col0 = u.cn * BM + wc * 32 + 8 * fq; const int rowt = u.pm * BM + wr * 64 + fr;
        bf16_t* base = u.ks == 0 ? O + (size_t)rowt * 1024 : P + (size_t)(u.ks - 1) * pstride + (size_t)(rowt - row0p) * 1024;
#pragma unroll
        for (int ai = 0; ai < 2; ++ai)
#pragma unroll
            for (int m = 0; m < 4; ++m) { bf16_t* rowp = base + (size_t)(ai * HALF + m * 16) * 1024 + col0;
#pragma unroll
                for (int bj = 0; bj < 2; ++bj) { const f32x4 v0 = acc[ai][bj][m][0], v1 = acc[ai][bj][m][1];
                    u32x4 w; w.x = cvt_pk_bf16(v0[0], v0[1]); w.y = cvt_pk_bf16(v0[2], v0[3]); w.z = cvt_pk_bf16(v1[0], v1[1]); w.w = cvt_pk_bf16(v1[2], v1[3]);
                    *(u32x4*)(rowp + bj * HALF) = w; } }
    }
};
}

namespace fp {
using namespace mdl;
#define FLAS __attribute__((address_space(3)))
typedef float f32x4 __attribute__((ext_vector_type(4)));
typedef float f32x2 __attribute__((ext_vector_type(2)));
typedef unsigned u32x4 __attribute__((ext_vector_type(4)));
typedef unsigned u32x2 __attribute__((ext_vector_type(2)));
typedef __bf16 bf16x2_t __attribute__((ext_vector_type(2)));
__device__ __forceinline__ unsigned pk2(float lo, float hi) { f32x2 v = {lo, hi}; bf16x2_t b = __builtin_convertvector(v, bf16x2_t); return __builtin_bit_cast(unsigned, b); }
__device__ __forceinline__ float blo(unsigned w) { return __uint_as_float(w << 16); }
__device__ __forceinline__ float bhi(unsigned w) { return __uint_as_float(w & 0xffff0000u); }
template <int CTRL, int ROWMASK> __device__ __forceinline__ float dpp_add(float v) {
    return v + __builtin_bit_cast(float, __builtin_amdgcn_update_dpp(0, __builtin_bit_cast(int, v), CTRL, ROWMASK, 0xF, false)); }
__device__ __forceinline__ float wave_sum(float v) {
    v = dpp_add<0xB1, 0xF>(v);
    v = dpp_add<0x4E, 0xF>(v);
    v = dpp_add<0x141, 0xF>(v);
    v = dpp_add<0x140, 0xF>(v);
    v = dpp_add<0x142, 0xA>(v);
    v = dpp_add<0x143, 0xC>(v);
    return __builtin_bit_cast(float, __builtin_amdgcn_readlane(__builtin_bit_cast(int, v), 63));
}
#define FP_LDS_WAIT() asm volatile("s_waitcnt lgkmcnt(0)" ::: "memory")
template <int ROWS, int ROWB, int PB, int NTHR_> __device__ __forceinline__ void tile_out(const FLAS unsigned char* st, unsigned char* gbase, size_t gpitch, int t) {
    constexpr int CPR = ROWB / 16, N = ROWS * CPR;
#pragma unroll
    for (int i0 = 0; i0 < N; i0 += NTHR_) { const int i = i0 + t; if (N % NTHR_ == 0 || i < N) { const int r = i / CPR, c = i % CPR; *(u32x4*)(gbase + (size_t)r * gpitch + c * 16) = *(const FLAS u32x4*)(st + r * PB + c * 16); } }
}

template <class Map> __device__ __forceinline__ void tr_item(const float* W, int Nsrc, const Map& map, bf16* WT, int K, int k0, int n0, FLAS float* scr, int lane, const float* gain = nullptr) {
    const int nl = lane & 31, c = map(n0 + nl), cc = lane & 7;
    f32x4 g0 = (f32x4){1.f, 1.f, 1.f, 1.f}, g1 = g0;
    if (gain) { g0 = *(const f32x4*)(gain + k0 + 8 * cc); g1 = *(const f32x4*)(gain + k0 + 8 * cc + 4); }
    float wv[32];
#pragma unroll
    for (int i = 0; i < 32; ++i) { const int kk = 2 * i + (lane >> 5); wv[i] = c >= 0 ? W[(size_t)(k0 + kk) * Nsrc + c] : 0.f; }
    __builtin_amdgcn_sched_barrier(0);
#pragma unroll
    for (int i = 0; i < 32; ++i) { const int kk = 2 * i + (lane >> 5); scr[kk * 33 + nl] = wv[i]; }
    FP_LDS_WAIT(); asm volatile("" ::: "memory");
#pragma unroll
    for (int j = 0; j < 4; ++j) { const int n = (lane >> 3) + 8 * j; const FLAS float* s = scr + (8 * cc) * 33 + n;
        u32x4 o; o.x = pk2(s[0 * 33] * g0.x, s[1 * 33] * g0.y); o.y = pk2(s[2 * 33] * g0.z, s[3 * 33] * g0.w); o.z = pk2(s[4 * 33] * g1.x, s[5 * 33] * g1.y); o.w = pk2(s[6 * 33] * g1.z, s[7 * 33] * g1.w);
        *(u32x4*)(WT + (size_t)(n0 + n) * K + k0 + 8 * cc) = o; }
    FP_LDS_WAIT(); asm volatile("" ::: "memory");
}
struct MapId { __device__ __forceinline__ int operator()(int n) const { return n; } };
struct MapLt { int lim; __device__ __forceinline__ int operator()(int n) const { return n < lim ? n : -1; } };
struct MapU { __device__ __forceinline__ int operator()(int n) const { return ucol_src(n); } };
struct MapOff { int off; __device__ __forceinline__ int operator()(int n) const { return n + off; } };
__device__ __forceinline__ void prologue(const MP& p, FLAS unsigned char* lds, int bx, int G) {
    const int tid = mk_tid(), lane = tid & 63, wave = __builtin_amdgcn_readfirstlane(tid >> 6);
    FLAS float* scr = (FLAS float*)(lds + wave * 16384);
    const int gw = bx * 8 + wave, NGW = G * 8;
    constexpr int I_WIN = (D / 64) * (NU / 32), I_UQ = 4 * 16, I_UKV = 2 * 16, I_DD = 16 * 32, I_PP = 4 * 32, I_GU = 16 * (NGU / 32), I_DN = (DFF / 64) * 32;
    constexpr int PER_L = I_WIN + I_UQ + I_UKV + 2 * I_DD + I_PP, NITEMS = DEPTH * PER_L + 18 * (I_GU + I_DN);
    for (int it = gw; it < NITEMS; it += NGW) {
        int r = it;
        if (r < DEPTH * PER_L) { const int l = r / PER_L; r %= PER_L;
            if (r < I_WIN) { tr_item(p.w_in + (size_t)l * D * NUO, NUO, MapU{}, p.WIN + (size_t)l * NU * D, D, 64 * (r / (NU / 32)), 32 * (r % (NU / 32)), scr, lane, p.attn_g + l * D); continue; } r -= I_WIN;
            if (r < I_UQ) { tr_item(p.w_uq + (size_t)l * 256 * 384, 384, MapLt{384}, p.WUQ + (size_t)l * 512 * 256, 256, 64 * (r / 16), 32 * (r % 16), scr, lane); continue; } r -= I_UQ;
            if (r < I_UKV) { tr_item(p.w_ukv + (size_t)l * 128 * 512, 512, MapId{}, p.WUKV + (size_t)l * 512 * 128, 128, 64 * (r / 16), 32 * (r % 16), scr, lane); continue; } r -= I_UKV;
            if (r < I_DD) { tr_item(p.w_out + (size_t)l * D * D, D, MapId{}, p.WOUT + (size_t)l * D * D, D, 64 * (r / 32), 32 * (r % 32), scr, lane); continue; } r -= I_DD;
            if (r < I_DD) { tr_item(p.ple_wg + (size_t)l * D * D, D, MapId{}, p.WPG + (size_t)l * D * D, D, 64 * (r / 32), 32 * (r % 32), scr, lane, p.ple_g + l * D); continue; } r -= I_DD;
            tr_item(p.ple_wp + (size_t)l * PLE * D, D, MapId{}, p.WPP + (size_t)l * D * PLE, PLE, 64 * (r / 32), 32 * (r % 32), scr, lane); continue; }
        r -= DEPTH * PER_L;
        if (r < 18 * I_GU) { const int mt = r / I_GU; r %= I_GU; const int k0 = 64 * (r / (NGU / 32)), n0 = 32 * (r % (NGU / 32)); const int tl = n0 / 256, rr = n0 % 256;
            const float* src; bf16* dst;
            if (mt < 2) { src = (rr < 128 ? p.dwg : p.dwu) + (size_t)mt * D * DFF; dst = p.DWGU + (size_t)mt * NGU * D; } else { src = (rr < 128 ? p.mwg : p.mwu) + (size_t)(mt - 2) * D * DFF; dst = p.MWGU + (size_t)(mt - 2) * NGU * D; }
            const int Lg = mt < 2 ? 2 * mt : 2 * ((mt - 2) >> 3) + 1;
            tr_item(src, DFF, MapOff{tl * 128 + (rr & 127) - n0}, dst, D, k0, n0, scr, lane, p.ffn_g + Lg * D); continue; }
        r -= 18 * I_GU;
        { const int mt = r / I_DN; r %= I_DN; const float* src; bf16* dst;
            if (mt < 2) { src = p.dwd + (size_t)mt * DFF * D; dst = p.DWD + (size_t)mt * D * DFF; } else { src = p.mwd + (size_t)(mt - 2) * DFF * D; dst = p.MWD + (size_t)(mt - 2) * D * DFF; }
            tr_item(src, D, MapId{}, dst, DFF, 64 * (r / 32), 32 * (r % 32), scr, lane); }
    }
    const long g0 = (long)bx * 512 + tid, gs = (long)G * 512;
    for (long t = gw; t < p.T; t += NGW) { const f32x4* xr = (const f32x4*)(p.x + t * D) + lane; u32x2* o = (u32x2*)(p.HB + t * D) + lane; float ss = 0.f;
#pragma unroll
        for (int j = 0; j < 4; ++j) { const f32x4 v = xr[64 * j]; u32x2 wv; wv.x = pk2(v.x, v.y); wv.y = pk2(v.z, v.w); o[64 * j] = wv; const float a = blo(wv.x), b = bhi(wv.x), c = blo(wv.y), d = bhi(wv.y); ss += (a * a + b * b) + (c * c + d * d); }
        ss = wave_sum(ss); if (lane < 16) rss_ptr(p, 0, 0)[t * 16 + lane] = lane == 0 ? ss : 0.f; }
    for (long i = g0; i < (long)DEPTH * p.T * PLE / 4; i += gs) { const f32x4 v = ((const f32x4*)p.p)[i]; u32x2 o; o.x = pk2(v.x, v.y); o.y = pk2(v.z, v.w); ((u32x2*)p.PB16)[i] = o; }
    for (long i = g0; i < p.T * 16; i += gs) { const long t = i / 16; const int j = (int)(i % 16); const float inv = powf(10000.0f, -(float)(2 * j) / 32.0f), ang = (float)p.pos[t] * inv;
        p.CS[t * 32 + j] = cosf(ang); p.CS[t * 32 + 16 + j] = sinf(ang); }
}
__device__ __forceinline__ void unpack8(const u32x4 q, float (&v)[8]) {
#pragma unroll
    for (int i = 0; i < 4; ++i) { v[2 * i] = blo(q[i]); v[2 * i + 1] = bhi(q[i]); } }
__device__ __forceinline__ u32x4 pack8(const float (&v)[8]) { u32x4 q; q.x = pk2(v[0], v[1]); q.y = pk2(v[2], v[3]); q.z = pk2(v[4], v[5]); q.w = pk2(v[6], v[7]); return q; }
template <int MODE> __device__ __forceinline__ void norm_phase(const MP& p, int L, const float* g, bf16* hb, int bx, int G, FLAS unsigned* lcnt = nullptr, const bf16* part = nullptr) {
    const int tid = mk_tid(), lane = tid & 63, wave = __builtin_amdgcn_readfirstlane(tid >> 6);
    const int gw = bx * 8 + wave, NGW = G * 8;
    bf16* const HBN = (bf16*)p.H;
    f32x4 Rr[MODE == 1 ? 32 : 1];
    if (MODE == 1) { __syncthreads(); if (tid < NE) lcnt[tid] = 0u; __syncthreads(); const f32x4* R = (const f32x4*)(p.router + (size_t)(L >> 1) * D * NE);
#pragma unroll
        for (int c = 0; c < 2; ++c)
#pragma unroll
            for (int i = 0; i < 8; ++i) { const int idx = 512 * c + 8 * lane + i; Rr[(c * 8 + i) * 2] = R[idx * 2]; Rr[(c * 8 + i) * 2 + 1] = R[idx * 2 + 1]; } }
    for (long t = gw; t < p.T; t += NGW) {
        u32x4* hr = (u32x4*)(hb + t * D) + lane; float v[2][8];
        { const u32x4 q0 = hr[0], q1 = hr[64]; unpack8(q0, v[0]); unpack8(q1, v[1]); }
        if (MODE == 2) { const int sl[2] = {p.TOKSLOT[t * 2], p.TOKSLOT[t * 2 + 1]}; const float gt[2] = {p.TOPG[t * 2], p.TOPG[t * 2 + 1]};
            const int row0p = p.TILE_E[1000], ksn = p.TILE_E[1001]; const size_t pstride = (size_t)p.TILE_E[1002] * D;
            u32x4 y[2][2];
#pragma unroll
            for (int k = 0; k < 2; ++k) { const u32x4* y0 = (const u32x4*)(p.YS + (size_t)sl[k] * D) + lane; y[k][0] = y0[0]; y[k][1] = y0[64]; }
#pragma unroll
            for (int k = 0; k < 2; ++k) { float acc[2][8]; unpack8(y[k][0], acc[0]); unpack8(y[k][1], acc[1]);
                if (sl[k] >= row0p) for (int s = 1; s < ksn; ++s) { const u32x4* yp = (const u32x4*)(part + (size_t)(s - 1) * pstride + (size_t)(sl[k] - row0p) * D) + lane; float r0[8], r1[8]; unpack8(yp[0], r0); unpack8(yp[64], r1);
#pragma unroll
                    for (int i = 0; i < 8; ++i) { acc[0][i] += r0[i]; acc[1][i] += r1[i]; } }
#pragma unroll
                for (int c = 0; c < 2; ++c)
#pragma unroll
                    for (int i = 0; i < 8; ++i) v[c][i] += gt[k] * acc[c][i]; }
            const u32x4 w0 = pack8(v[0]), w1 = pack8(v[1]); hr[0] = w0; hr[64] = w1; unpack8(w0, v[0]); unpack8(w1, v[1]); }
        float ss = 0.f;
#pragma unroll
        for (int c = 0; c < 2; ++c)
#pragma unroll
            for (int i = 0; i < 8; ++i) ss += v[c][i] * v[c][i];
        ss = wave_sum(ss);
        const float r = 1.0f / sqrtf(ss * (1.0f / D) + RMS_EPS);
        if (MODE == 2) { if (lane < 16) rss_ptr(p, L, 2)[t * 16 + lane] = lane == 0 ? ss : 0.f; }
        if (MODE == 1) { u32x4* o = (u32x4*)(HBN + t * D) + lane; float n0[8], n1[8];
#pragma unroll
            for (int i = 0; i < 8; ++i) { n0[i] = v[0][i] * r; n1[i] = v[1][i] * r; }
            o[0] = pack8(n0); o[64] = pack8(n1); }
        if (MODE == 1 || MODE == 3) {
#pragma unroll
            for (int c = 0; c < 2; ++c) { const f32x4 g0 = *(const f32x4*)(g + 512 * c + 8 * lane), g1 = *(const f32x4*)(g + 512 * c + 8 * lane + 4);
                v[c][0] *= r * g0.x; v[c][1] *= r * g0.y; v[c][2] *= r * g0.z; v[c][3] *= r * g0.w; v[c][4] *= r * g1.x; v[c][5] *= r * g1.y; v[c][6] *= r * g1.z; v[c][7] *= r * g1.w; } }
        if (MODE == 3) {
#pragma unroll
            for (int c = 0; c < 2; ++c) { f32x4* o = (f32x4*)(p.out + t * D + 512 * c + 8 * lane); o[0] = (f32x4){v[c][0], v[c][1], v[c][2], v[c][3]}; o[1] = (f32x4){v[c][4], v[c][5], v[c][6], v[c][7]}; }
        }
        if (MODE == 1) { float lg[NE];
#pragma unroll
            for (int e = 0; e < NE; ++e) lg[e] = 0.f;
#pragma unroll
            for (int c = 0; c < 2; ++c)
#pragma unroll
                for (int i = 0; i < 8; ++i) { const f32x4 r0 = Rr[(c * 8 + i) * 2], r1 = Rr[(c * 8 + i) * 2 + 1]; const float x = v[c][i];
                    lg[0] += x * r0.x; lg[1] += x * r0.y; lg[2] += x * r0.z; lg[3] += x * r0.w; lg[4] += x * r1.x; lg[5] += x * r1.y; lg[6] += x * r1.z; lg[7] += x * r1.w; }
#pragma unroll
            for (int e = 0; e < NE; ++e) lg[e] = wave_sum(lg[e]);
            int e0 = 0; float v0 = lg[0];
#pragma unroll
            for (int e = 1; e < NE; ++e) if (lg[e] > v0) { v0 = lg[e]; e0 = e; }
            int e1 = -1; float v1 = -3.0e38f;
#pragma unroll
            for (int e = 0; e < NE; ++e) if (e != e0 && lg[e] > v1) { v1 = lg[e]; e1 = e; }
            if (lane == 0) { const float g1 = 1.0f / (1.0f + expf(v0 - v1));
                p.TOPE[t * 2] = e0; p.TOPE[t * 2 + 1] = e1; p.TOPG[t * 2] = 1.0f - g1; p.TOPG[t * 2 + 1] = g1;
                p.POS[t * 2] = (int)__hip_atomic_fetch_add(lcnt + e0, 1u, __ATOMIC_RELAXED, __HIP_MEMORY_SCOPE_WORKGROUP); p.POS[t * 2 + 1] = (int)__hip_atomic_fetch_add(lcnt + e1, 1u, __ATOMIC_RELAXED, __HIP_MEMORY_SCOPE_WORKGROUP); } }
    }
    if (MODE == 1) { __syncthreads(); if (tid < NE) p.BCNT[bx * NE + tid] = (int)lcnt[tid]; }
}
__device__ __forceinline__ void moeplan(const MP& p, int L, FLAS unsigned char* lds, int bx, int G) {
    const int tid = mk_tid(), lane = tid & 63, wave = __builtin_amdgcn_readfirstlane(tid >> 6), j = L >> 1;
    const int gw = bx * 8 + wave, NGW = G * 8;
    FLAS int* base = (FLAS int*)lds;
    FLAS int* pst = (FLAS int*)(lds + 16384);
    __syncthreads();
    {
        const int e = wave; int c[4], s = 0;
#pragma unroll
        for (int i = 0; i < 4; ++i) { const int b = lane * 4 + i; c[i] = b < G ? p.BCNT[b * NE + e] : 0; s += c[i]; }
        int inc = s;
#pragma unroll
        for (int o = 1; o < 64; o <<= 1) { const int t = __shfl_up(inc, o); if (lane >= o) inc += t; }
        int ex = inc - s;
#pragma unroll
        for (int i = 0; i < 4; ++i) { const int b = lane * 4 + i; if (b < G) base[b * NE + e] = ex; ex += c[i]; }
        if (lane == 63) pst[e] = inc;
    }
    __syncthreads();
    if (tid == 0) { int o = 0; for (int e = 0; e < NE; ++e) { const int cnt = pst[e]; pst[e] = o; if (bx == 0) cnt_ptr(p, j)[e] = (unsigned)cnt; o += ((cnt + 255) / 256) * 256; } pst[NE] = o; }
    __syncthreads();
    for (long i = gw; i < p.T * 2; i += NGW) { const long t = i >> 1; const int e = p.TOPE[i], blk = (int)((t % NGW) >> 3); const int slot = pst[e] + base[blk * NE + e] + p.POS[i]; if (lane == 0) p.TOKSLOT[i] = slot;
        const u32x4* s = (const u32x4*)((const bf16*)p.H + t * D) + lane; u32x4* d = (u32x4*)(p.XB + (size_t)slot * D) + lane; const u32x4 a = s[0], b = s[64]; d[0] = a; d[64] = b; }
    if (bx == 0) for (int i = tid; i < 1024; i += 512) { int e = -1; if (i * 256 < pst[NE]) { e = 0; for (int q = 1; q < NE; ++q) if (i * 256 >= pst[q]) e = q; } p.TILE_E[i] = e; }
    __syncthreads();
}
typedef short bf16x8 __attribute__((ext_vector_type(8)));
typedef short bf16x4 __attribute__((ext_vector_type(4)));
constexpr int AT_KP = 112, AT_VP = 136, AT_KBYTES = 128 * AT_KP * 2, AT_BUF = AT_KBYTES + 80 * AT_VP * 2;
__device__ __forceinline__ void attn_phase(const MP& p, FLAS unsigned char* lds, int bx, int G) {
    const int S = (int)p.S, nunits = (int)p.B * 4 * 8;
    const int vcu = (G % 8 == 0) ? (bx % 8) * (G / 8) + bx / 8 : bx;
    { const int tid0 = mk_tid(); __syncthreads();
      for (int e = tid0; e < 2 * 16 * AT_VP; e += 512) { const int bufi = e / (16 * AT_VP), r = (e % (16 * AT_VP)) / AT_VP, c = e % AT_VP; ((FLAS bf16*)(lds + bufi * AT_BUF + AT_KBYTES))[(64 + r) * AT_VP + c] = r == 0 ? (bf16)0x3f80 : (bf16)0; } }
    for (int u = vcu; u < nunits; u += G) {
        const int tid = mk_tid(), lane = tid & 63, w = __builtin_amdgcn_readfirstlane(tid >> 6), fr = lane & 15, fq = lane >> 4;
        int kro[3], kco[3];
#pragma unroll
        for (int i = 0; i < 3; ++i) { const int c = tid + 512 * i; kro[i] = c / 12; kco[i] = c % 12; }
        const int vd = tid >> 4, vkc = tid & 15;
        const int bh = u >> 3, jp = u & 7, b = bh >> 2, h = bh & 3;
        const bf16* Kg = p.KK + (size_t)b * S * 384 + h * 96; const bf16* Vg = p.V + (size_t)bh * 64 * S;
        for (int half = 0; half < 2; ++half) {
            const int qb = half ? 15 - jp : jp, q0 = qb * 128, qmin = q0 + 16 * w, qglob = qmin + fr;
            const size_t trow = (size_t)b * S + qglob;
            bf16x8 qf[3];
#pragma unroll
            for (int ks = 0; ks < 3; ++ks) qf[ks] = *(const bf16x8*)(p.Q + trow * 384 + h * 96 + ks * 32 + fq * 8);
            f32x4 o[5];
#pragma unroll
            for (int dt = 0; dt < 5; ++dt) o[dt] = (f32x4){0.f, 0.f, 0.f, 0.f};
            float m = -1e30f;
            const int nkt = qb + 1;
            u32x4 rk[3], rv[2];
#define AT_LOAD(kt_) do { const size_t kb_ = (size_t)(kt_) * 128; _Pragma("unroll") for (int i = 0; i < 3; ++i) rk[i] = *(const u32x4*)(Kg + (kb_ + kro[i]) * 384 + kco[i] * 8); \
            _Pragma("unroll") for (int i = 0; i < 2; ++i) rv[i] = *(const u32x4*)(Vg + (size_t)(vd + 32 * i) * S + kb_ + vkc * 8); } while (0)
#define AT_WRITE(buf_) do { FLAS bf16* Kw = (FLAS bf16*)(lds + (buf_) * AT_BUF); FLAS bf16* Vw = (FLAS bf16*)(lds + (buf_) * AT_BUF + AT_KBYTES); \
            _Pragma("unroll") for (int i = 0; i < 3; ++i) *(FLAS u32x4*)(Kw + kro[i] * AT_KP + kco[i] * 8) = rk[i]; \
            _Pragma("unroll") for (int i = 0; i < 2; ++i) *(FLAS u32x4*)(Vw + (vd + 32 * i) * AT_VP + vkc * 8) = rv[i]; } while (0)
            AT_LOAD(0);
            __syncthreads();
            AT_WRITE(0);
            __syncthreads();
            for (int kt = 0; kt < nkt; ++kt) {
                const bool more = kt + 1 < nkt;
                TP_BEGIN(18, lds); if (more) AT_LOAD(kt + 1); TP_END(18, lds); TP_BEGIN(19, lds);
                const FLAS bf16* Ks = (const FLAS bf16*)(lds + (kt & 1) * AT_BUF); const FLAS bf16* Vt = (const FLAS bf16*)(lds + (kt & 1) * AT_BUF + AT_KBYTES);
                f32x4 s[8];
#pragma unroll
                for (int sub = 0; sub < 8; ++sub) { s[sub] = (f32x4){0.f, 0.f, 0.f, 0.f};
#pragma unroll
                    for (int ks = 0; ks < 3; ++ks) { const bf16x8 a = *(const FLAS bf16x8*)(Ks + (sub * 16 + fr) * AT_KP + ks * 32 + fq * 8); s[sub] = __builtin_amdgcn_mfma_f32_16x16x32_bf16(a, qf[ks], s[sub], 0, 0, 0); } }
                if (kt == qb) {
#pragma unroll
                    for (int sub = 0; sub < 8; ++sub)
#pragma unroll
                        for (int j = 0; j < 4; ++j) if (16 * sub + 4 * fq + j > 16 * w + fr) s[sub][j] = -1e30f; }
                float t0 = __builtin_fmaxf(__builtin_fmaxf(s[0][0], s[0][1]), s[0][2]), t1 = __builtin_fmaxf(__builtin_fmaxf(s[0][3], s[1][0]), s[1][1]);
                t0 = __builtin_fmaxf(__builtin_fmaxf(t0, s[1][2]), s[1][3]);
#pragma unroll
                for (int sub = 2; sub < 8; sub += 2) { t0 = __builtin_fmaxf(__builtin_fmaxf(t0, s[sub][0]), s[sub][1]); t1 = __builtin_fmaxf(__builtin_fmaxf(t1, s[sub][2]), s[sub][3]);
                    t0 = __builtin_fmaxf(__builtin_fmaxf(t0, s[sub + 1][0]), s[sub + 1][1]); t1 = __builtin_fmaxf(__builtin_fmaxf(t1, s[sub + 1][2]), s[sub + 1][3]); }
                float tmax = __builtin_fmaxf(t0, t1);
                tmax = __builtin_fmaxf(tmax, __shfl_xor(tmax, 16)); tmax = __builtin_fmaxf(tmax, __shfl_xor(tmax, 32));
                const float mn = __builtin_fmaxf(m, tmax), alpha = __builtin_amdgcn_exp2f(m - mn); m = mn;
#pragma unroll
                for (int sub = 0; sub < 8; ++sub)
#pragma unroll
                    for (int j = 0; j < 4; ++j) s[sub][j] = __builtin_amdgcn_exp2f(s[sub][j] - mn);
#pragma unroll
                for (int dt = 0; dt < 5; ++dt) o[dt] *= alpha;
#pragma unroll
                for (int k2 = 0; k2 < 4; ++k2) {
                    u32x4 pw; pw.x = pk2(s[2 * k2][0], s[2 * k2][1]); pw.y = pk2(s[2 * k2][2], s[2 * k2][3]); pw.z = pk2(s[2 * k2 + 1][0], s[2 * k2 + 1][1]); pw.w = pk2(s[2 * k2 + 1][2], s[2 * k2 + 1][3]);
                    const bf16x8 pf = __builtin_bit_cast(bf16x8, pw);
#pragma unroll
                    for (int dt = 0; dt < 5; ++dt) { const FLAS bf16* vp = Vt + (dt * 16 + fr) * AT_VP + 32 * k2 + 4 * fq;
                        const u32x2 v0 = *(const FLAS u32x2*)vp, v1 = *(const FLAS u32x2*)(vp + 16); u32x4 vw; vw.x = v0.x; vw.y = v0.y; vw.z = v1.x; vw.w = v1.y;
                        o[dt] = __builtin_amdgcn_mfma_f32_16x16x32_bf16(__builtin_bit_cast(bf16x8, vw), pf, o[dt], 0, 0, 0); } }
                TP_END(19, lds); TP_BEGIN(20, lds); if (more) AT_WRITE((kt + 1) & 1);
                __syncthreads(); TP_END(20, lds);
            }
#undef AT_LOAD
#undef AT_WRITE
            const float l = __shfl(o[4][0], fr);
            const float rl = 1.0f / l;
            FLAS unsigned char* ostg = lds + 2 * AT_BUF + w * (16 * 144);
#pragma unroll
            for (int dt = 0; dt < 4; ++dt) { u32x2 ow; ow.x = pk2(o[dt][0] * rl, o[dt][1] * rl); ow.y = pk2(o[dt][2] * rl, o[dt][3] * rl); *(FLAS u32x2*)(ostg + fr * 144 + (dt * 16 + 4 * fq) * 2) = ow; }
            FP_LDS_WAIT(); asm volatile("" ::: "memory");
            tile_out<16, 128, 144, 64>(ostg, (unsigned char*)(p.YC + ((size_t)b * S + qmin) * D + 768 + h * 64), (size_t)D * 2, lane);
            FP_LDS_WAIT(); asm volatile("" ::: "memory");
        }
    }
    __syncthreads();
}
__device__ __forceinline__ void conv_module(const MP& p, int L, FLAS unsigned char* lds, int bx, int G) {
    FLAS float* Gs = (FLAS float*)lds;
    const int S = (int)p.S, nchunk = S / 64, nitems = (int)p.B * nchunk;
    for (int it = bx; it < nitems; it += G) {
        const int tid = mk_tid(), lane = tid & 63, w = __builtin_amdgcn_readfirstlane(tid >> 6);
        const int ck = it % nchunk, b = it / nchunk, s0 = ck * 64;
        __syncthreads();
        const int ch = (w & 3) * 64 + lane, tb = (w >> 2) * 32; float wj[CK];
#pragma unroll
        for (int j = 0; j < CK; ++j) wj[j] = p.cdw_w[(L * CK + j) * 256 + ch];
        const float bias = p.cdw_b[L * 256 + ch], lg = p.cln_g[L * 256 + ch], lb = p.cln_b[L * 256 + ch];
        u32x4 rv[6], rg[6];
#pragma unroll
        for (int i = 0; i < 6; ++i) { const int idx = tid + 512 * i, row = idx >> 5, c = idx & 31, sp = s0 - 30 + row; rv[i] = (u32x4){0u, 0u, 0u, 0u}; rg[i] = rv[i];
            if (idx < 94 * 32 && sp >= 0) { const bf16* u = p.U + ((size_t)b * S + sp) * NU + c * 8; rv[i] = *(const u32x4*)u; rg[i] = *(const u32x4*)(u + 256); } }
        __builtin_amdgcn_sched_barrier(0);
#pragma unroll
        for (int i = 0; i < 6; ++i) { const int idx = tid + 512 * i, row = idx >> 5, c = idx & 31;
            if (idx < 94 * 32) { const unsigned v[4] = {rv[i].x, rv[i].y, rv[i].z, rv[i].w}, g[4] = {rg[i].x, rg[i].y, rg[i].z, rg[i].w}; f32x4 o0, o1;
                o0.x = blo(v[0]) / (1.0f + __expf(-blo(g[0]))); o0.y = bhi(v[0]) / (1.0f + __expf(-bhi(g[0]))); o0.z = blo(v[1]) / (1.0f + __expf(-blo(g[1]))); o0.w = bhi(v[1]) / (1.0f + __expf(-bhi(g[1])));
                o1.x = blo(v[2]) / (1.0f + __expf(-blo(g[2]))); o1.y = bhi(v[2]) / (1.0f + __expf(-bhi(g[2]))); o1.z = blo(v[3]) / (1.0f + __expf(-blo(g[3]))); o1.w = bhi(v[3]) / (1.0f + __expf(-bhi(g[3])));
                *(FLAS f32x4*)(Gs + row * 256 + c * 8) = o0; *(FLAS f32x4*)(Gs + row * 256 + c * 8 + 4) = o1; } }
        __syncthreads();
#pragma unroll 1
        for (int i8 = 0; i8 < 4; ++i8) { const int tl0 = tb + 8 * i8; float win[38], acc[8];
#pragma unroll
            for (int r = 0; r < 38; ++r) win[r] = Gs[(tl0 + r) * 256 + ch];
#pragma unroll
            for (int q = 0; q < 8; ++q) { float a = bias;
#pragma unroll
                for (int j = 0; j < CK; ++j) a += wj[j] * win[q + j];
                acc[q] = a; }
            float mu[8], var[8];
#pragma unroll
            for (int q = 0; q < 8; ++q) { mu[q] = wave_sum(acc[q]) * (1.0f / 64.f); acc[q] -= mu[q]; }
#pragma unroll
            for (int q = 0; q < 8; ++q) var[q] = wave_sum(acc[q] * acc[q]);
#pragma unroll
            for (int q = 0; q < 8; ++q) { const float hn = acc[q] * (1.0f / sqrtf(var[q] * (1.0f / 64.f) + LN_EPS)) * lg + lb; ((FLAS bf16*)(lds + 94 * 256 * 4 + w * (32 * 144)))[(8 * i8 + q) * 72 + lane] = f2bf(hn / (1.0f + __expf(-hn))); } }
        FP_LDS_WAIT(); asm volatile("" ::: "memory");
        tile_out<32, 128, 144, 64>(lds + 94 * 256 * 4 + w * (32 * 144), (unsigned char*)(p.YC + ((size_t)b * S + s0 + tb) * D + (w & 3) * 64), (size_t)D * 2, lane);
        FP_LDS_WAIT(); asm volatile("" ::: "memory");
    }
    __syncthreads();
}
constexpr int MQ_P = 264, MK_P = 136;
__device__ __forceinline__ void mla_proj(const MP& p, int L, FLAS unsigned char* lds, int bx, int G) {
    FLAS bf16* Aq = (FLAS bf16*)lds; FLAS bf16* Ak = (FLAS bf16*)(lds + 64 * MQ_P * 2);
    const int nunits = (int)(p.T / 64);
    const bf16* Wq = p.WUQ + (size_t)L * 512 * 256; const bf16* Wk = p.WUKV + (size_t)L * 512 * 128;
    for (int u = bx; u < nunits; u += G) {
        const int tid = mk_tid(), lane = tid & 63, w = __builtin_amdgcn_readfirstlane(tid >> 6), fr = lane & 15, fq = lane >> 4;
        const size_t t0 = (size_t)u * 64;
        __syncthreads();
        bf16x8 wq0[4][3], wkf[4][4];
        {
            u32x2 rq[8]; unsigned rk[8];
#pragma unroll
            for (int i = 0; i < 8; ++i) { const bf16* urow = p.U + (t0 + w * 8 + i) * NU; rq[i] = *(const u32x2*)(urow + U_CQ + lane * 4); rk[i] = *(const unsigned*)(urow + U_CKV + lane * 2); }
            const f32x4 gq = *(const f32x4*)(p.qn_g + L * 256 + lane * 4); const f32x2 gk = *(const f32x2*)(p.kvn_g + L * 128 + lane * 2);
#pragma unroll
            for (int k4 = 0; k4 < 4; ++k4)
#pragma unroll
                for (int ct = 0; ct < 3; ++ct) wq0[k4][ct] = *(const bf16x8*)(Wq + (size_t)(48 * w + 16 * ct + fr) * 256 + k4 * 32 + fq * 8);
#pragma unroll
            for (int ks = 0; ks < 4; ++ks)
#pragma unroll
                for (int ct = 0; ct < 4; ++ct) wkf[ks][ct] = *(const bf16x8*)(Wk + (size_t)(64 * w + 16 * ct + fr) * 128 + ks * 32 + fq * 8);
            __builtin_amdgcn_sched_barrier(0);
#pragma unroll
            for (int i = 0; i < 8; ++i) { const int r = w * 8 + i;
                { const float a0 = blo(rq[i].x), a1 = bhi(rq[i].x), a2 = blo(rq[i].y), a3 = bhi(rq[i].y); const float rs = 1.0f / sqrtf(wave_sum((a0 * a0 + a1 * a1) + (a2 * a2 + a3 * a3)) * (1.0f / 256.f) + RMS_EPS);
                  u32x2 o; o.x = pk2(a0 * rs * gq.x, a1 * rs * gq.y); o.y = pk2(a2 * rs * gq.z, a3 * rs * gq.w); *(FLAS u32x2*)(Aq + r * MQ_P + lane * 4) = o; }
                { const float a0 = blo(rk[i]), a1 = bhi(rk[i]); const float rs = 1.0f / sqrtf(wave_sum(a0 * a0 + a1 * a1) * (1.0f / 128.f) + RMS_EPS); *(FLAS unsigned*)(Ak + r * MK_P + lane * 2) = pk2(a0 * rs * gk.x, a1 * rs * gk.y); } } }
#pragma unroll
        for (int e2 = 0; e2 < 2; ++e2) { const int e = tid + 512 * e2, r = e >> 4, jj = e & 15; const size_t t = t0 + r; const float x1 = bf2f(p.U[t * NU + U_KR + jj]), x2 = bf2f(p.U[t * NU + U_KR + 16 + jj]), c = p.CS[t * 32 + jj], sn = p.CS[t * 32 + 16 + jj];
            const bf16 o1 = f2bf(x1 * c - x2 * sn), o2 = f2bf(x1 * sn + x2 * c);
#pragma unroll
            for (int h = 0; h < 4; ++h) { p.KK[t * 384 + h * 96 + 64 + jj] = o1; p.KK[t * 384 + h * 96 + 80 + jj] = o2; } }
        __syncthreads();
        {
            f32x4 acc[3][4];
#pragma unroll
            for (int ct = 0; ct < 3; ++ct)
#pragma unroll
                for (int rt = 0; rt < 4; ++rt) acc[ct][rt] = (f32x4){0.f, 0.f, 0.f, 0.f};
            bf16x8 wq1[4][3];
#pragma unroll
            for (int k4 = 0; k4 < 4; ++k4)
#pragma unroll
                for (int ct = 0; ct < 3; ++ct) wq1[k4][ct] = *(const bf16x8*)(Wq + (size_t)(48 * w + 16 * ct + fr) * 256 + (4 + k4) * 32 + fq * 8);
            __builtin_amdgcn_sched_barrier(0);
#pragma unroll
            for (int k4 = 0; k4 < 4; ++k4)
#pragma unroll
                for (int rt = 0; rt < 4; ++rt) { const bf16x8 tk = *(const FLAS bf16x8*)(Aq + (rt * 16 + fr) * MQ_P + k4 * 32 + fq * 8);
#pragma unroll
                    for (int ct = 0; ct < 3; ++ct) acc[ct][rt] = __builtin_amdgcn_mfma_f32_16x16x32_bf16(wq0[k4][ct], tk, acc[ct][rt], 0, 0, 0); }
#pragma unroll
            for (int k4 = 0; k4 < 4; ++k4)
#pragma unroll
                for (int rt = 0; rt < 4; ++rt) { const bf16x8 tk = *(const FLAS bf16x8*)(Aq + (rt * 16 + fr) * MQ_P + (4 + k4) * 32 + fq * 8);
#pragma unroll
                    for (int ct = 0; ct < 3; ++ct) acc[ct][rt] = __builtin_amdgcn_mfma_f32_16x16x32_bf16(wq1[k4][ct], tk, acc[ct][rt], 0, 0, 0); }
            const bool pe = (w & 1) != 0;
#pragma unroll
            for (int rt = 0; rt < 4; ++rt) { const size_t t = t0 + rt * 16 + fr; bf16* qrow = p.Q + t * 384 + 48 * w + 4 * fq;
                f32x4 v0 = acc[0][rt], v1 = acc[1][rt], v2 = acc[2][rt];
                if (pe) { const f32x4 c = *(const f32x4*)(p.CS + t * 32 + 4 * fq), sn = *(const f32x4*)(p.CS + t * 32 + 16 + 4 * fq); const f32x4 x1 = v1, x2 = v2; v1 = x1 * c - x2 * sn; v2 = x1 * sn + x2 * c; }
                u32x2 o; o.x = pk2(v0.x * QSCALE, v0.y * QSCALE); o.y = pk2(v0.z * QSCALE, v0.w * QSCALE); *(u32x2*)qrow = o;
                o.x = pk2(v1.x * QSCALE, v1.y * QSCALE); o.y = pk2(v1.z * QSCALE, v1.w * QSCALE); *(u32x2*)(qrow + 16) = o;
                o.x = pk2(v2.x * QSCALE, v2.y * QSCALE); o.y = pk2(v2.z * QSCALE, v2.w * QSCALE); *(u32x2*)(qrow + 32) = o; }
        }
        {
            f32x4 acc[4][4];
#pragma unroll
            for (int ct = 0; ct < 4; ++ct)
#pragma unroll
                for (int rt = 0; rt < 4; ++rt) acc[ct][rt] = (f32x4){0.f, 0.f, 0.f, 0.f};
            const int h = w >> 1; const bool isv = (w & 1) != 0;
            if (!isv) {
#pragma unroll
                for (int ks = 0; ks < 4; ++ks)
#pragma unroll
                    for (int rt = 0; rt < 4; ++rt) { const bf16x8 tk = *(const FLAS bf16x8*)(Ak + (rt * 16 + fr) * MK_P + ks * 32 + fq * 8);
#pragma unroll
                        for (int ct = 0; ct < 4; ++ct) acc[ct][rt] = __builtin_amdgcn_mfma_f32_16x16x32_bf16(wkf[ks][ct], tk, acc[ct][rt], 0, 0, 0); }
#pragma unroll
                for (int rt = 0; rt < 4; ++rt) { const size_t t = t0 + rt * 16 + fr; bf16* dst = p.KK + t * 384 + h * 96 + 4 * fq;
#pragma unroll
                    for (int ct = 0; ct < 4; ++ct) { u32x2 o; o.x = pk2(acc[ct][rt].x, acc[ct][rt].y); o.y = pk2(acc[ct][rt].z, acc[ct][rt].w); *(u32x2*)(dst + 16 * ct) = o; } }
            } else {
#pragma unroll
                for (int ks = 0; ks < 4; ++ks)
#pragma unroll
                    for (int rt = 0; rt < 4; ++rt) { const bf16x8 tk = *(const FLAS bf16x8*)(Ak + (rt * 16 + fr) * MK_P + ks * 32 + fq * 8);
#pragma unroll
                        for (int ct = 0; ct < 4; ++ct) acc[ct][rt] = __builtin_amdgcn_mfma_f32_16x16x32_bf16(tk, wkf[ks][ct], acc[ct][rt], 0, 0, 0); }
                const size_t bq = t0 / p.S, sq = t0 % p.S;
#pragma unroll
                for (int ct = 0; ct < 4; ++ct) { bf16* drow = p.V + ((bq * 4 + h) * 64 + 16 * ct + fr) * p.S + sq + 4 * fq;
#pragma unroll
                    for (int rt = 0; rt < 4; ++rt) { u32x2 o; o.x = pk2(acc[ct][rt].x, acc[ct][rt].y); o.y = pk2(acc[ct][rt].z, acc[ct][rt].w); *(u32x2*)(drow + 16 * rt) = o; } }
            }
        }
    }
    __syncthreads();
}
__device__ __forceinline__ void ssd_scan(const MP& p, int bx, int G) {
    const int tid = mk_tid(); const long g0 = (long)bx * 512 + tid, gs = (long)G * 512; const int NCB = (int)(p.S / CHUNK);
    for (long i = g0; i < p.B * 8 * 64 * 32; i += gs) { const long b = i / (8 * 64 * 32), r = i % (8 * 64 * 32); const int h = (int)(r / (64 * 32)); f32x4 carry = (f32x4){0.f, 0.f, 0.f, 0.f};
        f32x4 st[16]; float dec[16];
#pragma unroll
        for (int cc = 0; cc < 16; ++cc) { const long c = b * NCB + cc; st[cc] = ((const f32x4*)p.ST)[(size_t)c * (8 * 64 * 32) + r]; dec[cc] = p.ACS[(c * CHUNK + CHUNK - 1) * 8 + h]; }
        __builtin_amdgcn_sched_barrier(0);
#pragma unroll
        for (int cc = 0; cc < 16; ++cc) { const long c = b * NCB + cc; u32x2 o; o.x = pk2(carry.x, carry.y); o.y = pk2(carry.z, carry.w); ((u32x2*)p.PV)[(size_t)c * (8 * 64 * 32) + r] = o; carry = carry * __expf(dec[cc]) + st[cc]; } }
}
constexpr int SP = 136;
constexpr int SA_DT = 0, SA_ACS = 2048, SA_CM = 4096, SA_BM = SA_CM + 128 * SP * 2, SA_XT = SA_CM, SA_BT = SA_CM + 2 * 128 * SP * 2, SA_MW = SA_BT + 128 * SP * 2, SA_END = SA_MW + 8 * 16 * SP * 2;
__device__ __forceinline__ float silu_f(float x) { return x / (1.0f + __expf(-x)); }
__device__ __forceinline__ float softplus_fast(float x) { if (x > 20.f) return x; const float e = __builtin_amdgcn_exp2f(x * 1.4426950408889634f); return e < 1e-3f ? e * (1.0f - 0.5f * e) : 0.6931471805599453f * __builtin_amdgcn_logf(1.0f + e); }
struct ConvW { f32x4 w[4][2], b[2]; };
__device__ __forceinline__ void convw_load(const MP& p, int L, int xc0, ConvW& cw) {
#pragma unroll
    for (int j = 0; j < 4; ++j) { cw.w[j][0] = *(const f32x4*)(p.sconv_w + (L * 4 + j) * 1024 + xc0); cw.w[j][1] = *(const f32x4*)(p.sconv_w + (L * 4 + j) * 1024 + xc0 + 4); }
    cw.b[0] = *(const f32x4*)(p.sconv_b + L * 1024 + xc0); cw.b[1] = *(const f32x4*)(p.sconv_b + L * 1024 + xc0 + 4);
}
__device__ __forceinline__ void conv_rows_load(const bf16* ub  , int xc0, int s0, int l0, u32x4 (&x)[11]) {
#pragma unroll
    for (int i = 0; i < 11; ++i) { const int sp = s0 + l0 - 3 + i; x[i] = (u32x4){0u, 0u, 0u, 0u}; if (i >= 3 || sp >= 0) x[i] = *(const u32x4*)(ub + (size_t)(sp < 0 ? 0 : sp) * NU + xc0); }
}
__device__ __forceinline__ float conv_elem(const u32x4 (&x)[11], const ConvW& cw, int i, int c) {
    float a = cw.b[c >> 2][c & 3];
#pragma unroll
    for (int j = 0; j < 4; ++j) { const unsigned wd = x[i + j][c >> 1]; a += cw.w[j][c >> 2][c & 3] * ((c & 1) ? bhi(wd) : blo(wd)); }
    return silu_f(a);
}
__device__ __forceinline__ void ssd_a(const MP& p, int L, FLAS unsigned char* lds, int bx, int G) {
    FLAS float* dtL = (FLAS float*)(lds + SA_DT); FLAS float* acsL = (FLAS float*)(lds + SA_ACS);
    FLAS bf16* Cm = (FLAS bf16*)(lds + SA_CM); FLAS bf16* Bm = (FLAS bf16*)(lds + SA_BM); FLAS bf16* XT = (FLAS bf16*)(lds + SA_XT); FLAS bf16* BT = (FLAS bf16*)(lds + SA_BT);
    const int S = (int)p.S, nunits = (int)(p.T / CHUNK) * 2;
    for (int u = bx; u < nunits; u += G) {
        const int tid = mk_tid(), lane = tid & 63, w = __builtin_amdgcn_readfirstlane(tid >> 6), fr = lane & 15, fq = lane >> 4;
        FLAS bf16* Mw = (FLAS bf16*)(lds + SA_MW + w * (16 * SP * 2));
        const int g = u & 1; const long c = u >> 1; const size_t t0 = (size_t)c * CHUNK; const int s0 = (int)(t0 % S); const size_t tb = t0 - s0;
        __syncthreads();
        TP_BEGIN(28, lds);
        const int cg2 = tid & 31, ts = tid >> 5, l0 = 8 * ts; const bool isC = cg2 >= 16; const int nbc = 8 * (cg2 & 15);
        const int xcb = (isC ? 768 : 512) + 128 * g + nbc, chs = 8 * cg2, xcs = 256 * g + chs;
        u32x4 xb[11], xs[11]; ConvW cwb, cws;
        const int h4 = tid >> 7, ldt = tid & 127; const bf16 dtraw = p.U[(t0 + ldt) * NU + U_DT + 4 * g + h4];
        conv_rows_load(p.U + tb * NU + U_XBC, xcb, s0, l0, xb);
        conv_rows_load(p.U + tb * NU + U_XBC, xcs, s0, l0, xs);
        convw_load(p, L, xcb, cwb); convw_load(p, L, xcs, cws);
        __builtin_amdgcn_sched_barrier(0);
        if (PROBE_CK == 11) { asm volatile("s_waitcnt vmcnt(0) lgkmcnt(0)" ::: "memory"); TP_END(28, lds); }
        dtL[h4 * 128 + ldt] = softplus_fast(bf2f(dtraw) + p.dt_bias[L * 8 + 4 * g + h4]);
        {
            FLAS bf16* rowdst = (isC ? Cm : Bm) + nbc; u32x4 colw[8];
#pragma unroll
            for (int i = 0; i < 8; ++i) { float o[8];
#pragma unroll
                for (int c = 0; c < 8; ++c) o[c] = conv_elem(xb, cwb, i, c);
                u32x4 wv; wv.x = pk2(o[0], o[1]); wv.y = pk2(o[2], o[3]); wv.z = pk2(o[4], o[5]); wv.w = pk2(o[6], o[7]); *(FLAS u32x4*)(rowdst + (l0 + i) * SP) = wv;
#pragma unroll
                for (int c = 0; c < 8; ++c) { const unsigned hv = (c & 1) ? (wv[c >> 1] >> 16) : (wv[c >> 1] & 0xffffu); if (i & 1) colw[c][i >> 1] |= hv << 16; else colw[c][i >> 1] = hv; } }
            if (!isC) {
#pragma unroll
                for (int c = 0; c < 8; ++c) *(FLAS u32x4*)(BT + (nbc + c) * SP + l0) = colw[c]; }
        }
        if (PROBE_CK == 12) { asm volatile("s_waitcnt vmcnt(0) lgkmcnt(0)" ::: "memory"); TP_END(28, lds); }
        __syncthreads();
        if (w < 4) {
            const int h = 4 * g + w; const float a = -__expf(p.a_log[L * 8 + h]); const float x0 = dtL[w * 128 + 2 * lane] * a, x1 = dtL[w * 128 + 2 * lane + 1] * a, ps = x0 + x1; float inc = ps;
#pragma unroll
            for (int o = 1; o < 64; o <<= 1) { const float t = __shfl_up(inc, o); if (lane >= o) inc += t; }
            const float ex = inc - ps, c0 = ex + x0, c1 = ex + ps; *(FLAS f32x2*)(acsL + w * 128 + 2 * lane) = (f32x2){c0, c1};
            p.ACS[(t0 + 2 * lane) * 8 + h] = c0; p.ACS[(t0 + 2 * lane + 1) * 8 + h] = c1; }
        tile_out<128, 256, SP * 2, 512>((const FLAS unsigned char*)Cm, (unsigned char*)(p.CM + t0 * 256 + g * 128), (size_t)256 * 2, tid);
        f32x4 cbT[8];
#pragma unroll
        for (int ct = 0; ct < 8; ++ct) cbT[ct] = (f32x4){0.f, 0.f, 0.f, 0.f};
#pragma unroll
        for (int ks = 0; ks < 4; ++ks) { const bf16x8 cf = *(const FLAS bf16x8*)(Cm + (16 * w + fr) * SP + ks * 32 + fq * 8);
#pragma unroll
            for (int ct = 0; ct < 8; ++ct) { const bf16x8 bfm = *(const FLAS bf16x8*)(Bm + (16 * ct + fr) * SP + ks * 32 + fq * 8); cbT[ct] = __builtin_amdgcn_mfma_f32_16x16x32_bf16(bfm, cf, cbT[ct], 0, 0, 0); } }
        __syncthreads();
        if (PROBE_CK == 13) { asm volatile("s_waitcnt vmcnt(0) lgkmcnt(0)" ::: "memory"); TP_END(28, lds); }
        {   const FLAS float* dts = dtL + (chs >> 6) * 128 + l0; const f32x4 d0 = *(const FLAS f32x4*)dts, d1 = *(const FLAS f32x4*)(dts + 4);
            const float dtv[8] = {d0.x, d0.y, d0.z, d0.w, d1.x, d1.y, d1.z, d1.w};
#pragma unroll
            for (int c = 0; c < 8; ++c) { float o[8];
#pragma unroll
                for (int i = 0; i < 8; ++i) o[i] = bf2f(f2bf(conv_elem(xs, cws, i, c))) * dtv[i];
                u32x4 wv; wv.x = pk2(o[0], o[1]); wv.y = pk2(o[2], o[3]); wv.z = pk2(o[4], o[5]); wv.w = pk2(o[6], o[7]); *(FLAS u32x4*)(XT + (chs + c) * SP + l0) = wv; } }
        if (PROBE_CK == 14) { asm volatile("s_waitcnt vmcnt(0) lgkmcnt(0)" ::: "memory"); TP_END(28, lds); }
        __syncthreads();
#pragma unroll 1
        for (int r = 0; r < 4; ++r) {
            const FLAS float* ac = acsL + r * 128; const int h = 4 * g + r; const float al = ac[16 * w + fr];
            const float dsd = p.dskip[L * 8 + h] / dtL[r * 128 + 16 * w + fr];
#pragma unroll
            for (int ct = 0; ct < 8; ++ct) { const f32x4 as = *(const FLAS f32x4*)(ac + 16 * ct + 4 * fq); const int sb = 16 * ct + 4 * fq, l = 16 * w + fr; float m0, m1, m2, m3;
                m0 = (sb + 0 <= l) ? cbT[ct].x * __expf(al - as.x) : 0.f; m1 = (sb + 1 <= l) ? cbT[ct].y * __expf(al - as.y) : 0.f; m2 = (sb + 2 <= l) ? cbT[ct].z * __expf(al - as.z) : 0.f; m3 = (sb + 3 <= l) ? cbT[ct].w * __expf(al - as.w) : 0.f;
                m0 += (sb + 0 == l) ? dsd : 0.f; m1 += (sb + 1 == l) ? dsd : 0.f; m2 += (sb + 2 == l) ? dsd : 0.f; m3 += (sb + 3 == l) ? dsd : 0.f;
                u32x2 o; o.x = pk2(m0, m1); o.y = pk2(m2, m3); *(FLAS u32x2*)(Mw + fr * SP + sb) = o; }
            FP_LDS_WAIT(); asm volatile("" ::: "memory");
            f32x4 yd[4], st[4];
#pragma unroll
            for (int pt = 0; pt < 4; ++pt) { yd[pt] = (f32x4){0.f, 0.f, 0.f, 0.f}; st[pt] = (f32x4){0.f, 0.f, 0.f, 0.f}; }
            const float alast = ac[127];
#pragma unroll
            for (int ks = 0; ks < 4; ++ks) { const bf16x8 am = *(const FLAS bf16x8*)(Mw + fr * SP + ks * 32 + fq * 8);
                const u32x4 braw = *(const FLAS u32x4*)(BT + (16 * w + fr) * SP + ks * 32 + fq * 8); const f32x4 e0 = *(const FLAS f32x4*)(ac + ks * 32 + fq * 8), e1 = *(const FLAS f32x4*)(ac + ks * 32 + fq * 8 + 4); u32x4 bs;
                bs.x = pk2(blo(braw.x) * __expf(alast - e0.x), bhi(braw.x) * __expf(alast - e0.y)); bs.y = pk2(blo(braw.y) * __expf(alast - e0.z), bhi(braw.y) * __expf(alast - e0.w));
                bs.z = pk2(blo(braw.z) * __expf(alast - e1.x), bhi(braw.z) * __expf(alast - e1.y)); bs.w = pk2(blo(braw.w) * __expf(alast - e1.z), bhi(braw.w) * __expf(alast - e1.w));
                const bf16x8 bsf = __builtin_bit_cast(bf16x8, bs);
#pragma unroll
                for (int pt = 0; pt < 4; ++pt) { const bf16x8 x = *(const FLAS bf16x8*)(XT + (r * 64 + 16 * pt + fr) * SP + ks * 32 + fq * 8);
                    yd[pt] = __builtin_amdgcn_mfma_f32_16x16x32_bf16(x, am, yd[pt], 0, 0, 0); st[pt] = __builtin_amdgcn_mfma_f32_16x16x32_bf16(bsf, x, st[pt], 0, 0, 0); } }
#pragma unroll
            for (int pt = 0; pt < 4; ++pt) { u32x2 o; o.x = pk2(yd[pt].x, yd[pt].y); o.y = pk2(yd[pt].z, yd[pt].w); *(FLAS u32x2*)((FLAS unsigned char*)Mw + fr * 144 + (16 * pt + 4 * fq) * 2) = o;
                *(f32x4*)(p.ST + (((size_t)c * 8 + h) * 64 + 16 * pt + fr) * 128 + 16 * w + 4 * fq) = st[pt]; }
            FP_LDS_WAIT(); asm volatile("" ::: "memory");
            tile_out<16, 128, 144, 64>((const FLAS unsigned char*)Mw, (unsigned char*)(p.YD + (t0 + 16 * w) * 512 + h * 64), (size_t)512 * 2, lane);
            FP_LDS_WAIT(); asm volatile("" ::: "memory");
            if (r == 0) {if (PROBE_CK == 15) { asm volatile("s_waitcnt vmcnt(0) lgkmcnt(0)" ::: "memory"); TP_END(28, lds); } }
        }
        if (PROBE_CK == 16) { asm volatile("s_waitcnt vmcnt(0) lgkmcnt(0)" ::: "memory"); TP_END(28, lds); }
    }
    __syncthreads();
}
__device__ __forceinline__ void ssd_c(const MP& p, int L, FLAS unsigned char* lds, int bx, int G) {
    const int nunits = (int)(p.T / CHUNK) * 2;
    for (int u = bx; u < nunits; u += G) {
        const int tid = mk_tid(), lane = tid & 63, w = __builtin_amdgcn_readfirstlane(tid >> 6), fr = lane & 15, fq = lane >> 4;
        const int g = u & 1; const long c = u >> 1; const size_t t0 = (size_t)c * CHUNK, t = t0 + 16 * w + fr;
        FLAS float* gnl = (FLAS float*)(lds + 8 * (16 * 528));
        __syncthreads();
        if (tid < 64) *(FLAS f32x4*)(gnl + 4 * tid) = *(const f32x4*)(p.snorm_g + L * 512 + g * 256 + 4 * tid);
        __syncthreads();
        TP_BEGIN(24, lds);
        bf16x8 cf[4];
#pragma unroll
        for (int ks = 0; ks < 4; ++ks) cf[ks] = *(const bf16x8*)(p.CM + t * 256 + g * 128 + ks * 32 + fq * 8);
        if (PROBE_CK == 1) { asm volatile("s_waitcnt vmcnt(0) lgkmcnt(0)" ::: "memory"); TP_END(24, lds); }
        f32x4 y[4][4]; float ssq = 0.f;
#pragma unroll
        for (int hp = 0; hp < 2; ++hp) { bf16x8 pvf[2][4][4];
#pragma unroll
            for (int rr = 0; rr < 2; ++rr) { const bf16* pv = p.PV + (((size_t)c * 8 + 4 * g + 2 * hp + rr) * 64) * 128;
#pragma unroll
                for (int pt = 0; pt < 4; ++pt)
#pragma unroll
                    for (int ks = 0; ks < 4; ++ks) pvf[rr][pt][ks] = *(const bf16x8*)(pv + (size_t)(32 * (pt >> 1) + 8 * (fr >> 2) + 4 * (pt & 1) + (fr & 3)) * 128 + ks * 32 + fq * 8); }
            __builtin_amdgcn_sched_barrier(0);
#pragma unroll
            for (int rr = 0; rr < 2; ++rr)
#pragma unroll
                for (int pt = 0; pt < 4; ++pt) { f32x4 acc = (f32x4){0.f, 0.f, 0.f, 0.f};
#pragma unroll
                    for (int ks = 0; ks < 4; ++ks) acc = __builtin_amdgcn_mfma_f32_16x16x32_bf16(pvf[rr][pt][ks], cf[ks], acc, 0, 0, 0);
                    y[2 * hp + rr][pt] = acc; }
            __builtin_amdgcn_sched_barrier(0); }
        if (PROBE_CK == 2) { asm volatile("s_waitcnt vmcnt(0) lgkmcnt(0)" ::: "memory"); TP_END(24, lds); }
        u32x4 ryd[4][2], rz[4][2]; float ea[4];
#pragma unroll
        for (int r = 0; r < 4; ++r) { const int h = 4 * g + r; ea[r] = p.ACS[t * 8 + h];
#pragma unroll
            for (int k = 0; k < 2; ++k) { const int ch = h * 64 + 32 * k + 8 * fq; ryd[r][k] = *(const u32x4*)(p.YD + t * 512 + ch); rz[r][k] = *(const u32x4*)(p.U + t * NU + U_Z + ch); } }
        __builtin_amdgcn_sched_barrier(0);
        if (PROBE_CK == 3) { asm volatile("s_waitcnt vmcnt(0) lgkmcnt(0)" ::: "memory"); TP_END(24, lds); }
#pragma unroll
        for (int r = 0; r < 4; ++r) { const float e = __expf(ea[r]);
#pragma unroll
            for (int pt = 0; pt < 4; ++pt) { const f32x4 acc = y[r][pt]; const unsigned d0 = ryd[r][pt >> 1][2 * (pt & 1)], d1 = ryd[r][pt >> 1][2 * (pt & 1) + 1], z0 = rz[r][pt >> 1][2 * (pt & 1)], z1 = rz[r][pt >> 1][2 * (pt & 1) + 1]; f32x4 yv;
                yv.x = (acc.x * e + blo(d0)) * silu_f(blo(z0)); yv.y = (acc.y * e + bhi(d0)) * silu_f(bhi(z0));
                yv.z = (acc.z * e + blo(d1)) * silu_f(blo(z1)); yv.w = (acc.w * e + bhi(d1)) * silu_f(bhi(z1));
                y[r][pt] = yv; ssq += (yv.x * yv.x + yv.y * yv.y) + (yv.z * yv.z + yv.w * yv.w); } }
        if (PROBE_CK == 4) { asm volatile("s_waitcnt vmcnt(0) lgkmcnt(0)" ::: "memory"); TP_END(24, lds); }
        ssq += __shfl_xor(ssq, 16); ssq += __shfl_xor(ssq, 32);
        const float rs = 1.0f / sqrtf(ssq * (1.0f / 256.f) + RMS_EPS);
        FLAS unsigned char* stg = lds + w * (16 * 528);
#pragma unroll
        for (int r = 0; r < 4; ++r)
#pragma unroll
            for (int k = 0; k < 2; ++k) { const int cl = r * 64 + 32 * k + 8 * fq; const f32x4 g0 = *(const FLAS f32x4*)(gnl + cl), g1 = *(const FLAS f32x4*)(gnl + cl + 4); const f32x4 v0 = y[r][2 * k], v1 = y[r][2 * k + 1];
                u32x4 o; o.x = pk2(v0.x * rs * g0.x, v0.y * rs * g0.y); o.y = pk2(v0.z * rs * g0.z, v0.w * rs * g0.w); o.z = pk2(v1.x * rs * g1.x, v1.y * rs * g1.y); o.w = pk2(v1.z * rs * g1.z, v1.w * rs * g1.w); *(FLAS u32x4*)(stg + fr * 528 + cl * 2) = o; }
        if (PROBE_CK == 5) { asm volatile("s_waitcnt vmcnt(0) lgkmcnt(0)" ::: "memory"); TP_END(24, lds); }
        FP_LDS_WAIT(); asm volatile("" ::: "memory");
        tile_out<16, 512, 528, 64>(stg, (unsigned char*)(p.YC + (t0 + 16 * w) * D + 256 + g * 256), (size_t)D * 2, lane);
        FP_LDS_WAIT(); asm volatile("" ::: "memory");
        if (PROBE_CK == 6) { asm volatile("s_waitcnt vmcnt(0) lgkmcnt(0)" ::: "memory"); TP_END(24, lds); }
    }
}
}

using namespace mdl;
#define LAS __attribute__((address_space(3)))
constexpr int NWAVES = 8, NTHR = NWAVES * 64;
constexpr int CW_BAR = 4096;
#define XB_TMO      128
#define XB_XCNT(j)  (256  + 64 * (j))
#define XB_XSUB(j)  (1280 + 64 * (j))
#define XB_XGEN(j)  (2304 + 64 * (j))
#define XB_TOP      3328
#define XB_TOPGEN   3392
#define XCD_BAR_WORDS 3456
#define XB_SPIN_CAP (1u << 18)

__device__ __forceinline__ unsigned xb_ld(unsigned* p)              { return __hip_atomic_load(p, __ATOMIC_RELAXED, __HIP_MEMORY_SCOPE_AGENT); }
__device__ __forceinline__ unsigned xb_add(unsigned* p, unsigned v) { return __hip_atomic_fetch_add(p, v, __ATOMIC_RELAXED, __HIP_MEMORY_SCOPE_AGENT); }
__device__ __forceinline__ unsigned xb_xcc_id() { return (unsigned)__builtin_amdgcn_s_getreg((3 << 11) | 20) & 0xFu; }
#define XB_SPIN(cond, bar) do { unsigned _sp = 0; while (cond) { __builtin_amdgcn_s_sleep(1); \
    if ((++_sp & 255u) == 0u) { if (xb_ld(&(bar)[XB_TMO])) break; if (_sp > XB_SPIN_CAP) { atomicAdd(&(bar)[XB_TMO], 1u); break; } } } } while (0)

struct XcdBarrier {
    unsigned* bar; unsigned x;
    volatile LAS unsigned* st;
};

__device__ __forceinline__ XcdBarrier xcd_barrier_post(unsigned* bar, volatile LAS unsigned* st) {
    XcdBarrier b; b.bar = bar; b.x = xb_xcc_id(); b.st = st;
    if (threadIdx.x == 0) (void)xb_add(&bar[XB_XCNT(b.x)], 1u);
    return b;
}
__device__ __forceinline__ void xcd_barrier_complete(unsigned* bar, unsigned x, unsigned& nloc, unsigned& nx) {
    const unsigned G = gridDim.x * gridDim.y * gridDim.z;
    unsigned sum, cnt, mine, sp = 0u;
    for (;;) {
        sum = 0u; cnt = 0u; mine = 0u;
#pragma unroll
        for (unsigned j = 0; j < 16; ++j) { const unsigned c = xb_ld(&bar[XB_XCNT(j)]); sum += c; cnt += (c > 0u) ? 1u : 0u; mine = (j == x) ? c : mine; }
        if (sum == G) break;
        __builtin_amdgcn_s_sleep(1);
        if ((++sp & 255u) == 0u) { if (xb_ld(&bar[XB_TMO])) break; if (sp > XB_SPIN_CAP) { atomicAdd(&bar[XB_TMO], 1u); break; } }
    }
    nloc = mine > 0u ? mine : 1u; nx = cnt > 0u ? cnt : 1u;
}

__device__ __forceinline__ void xcd_barrier(const XcdBarrier& b) {
    asm volatile("s_waitcnt vmcnt(0)" ::: "memory");
    __syncthreads();
    if (threadIdx.x == 0) {
        unsigned* bar = b.bar;
        __builtin_amdgcn_s_waitcnt(0);
        unsigned nloc = b.st[0], nx = b.st[1];
        if (nloc == 0u) { xcd_barrier_complete(bar, b.x, nloc, nx); b.st[0] = nloc; b.st[1] = nx; }
        const unsigned old = xb_add(&bar[XB_XSUB(b.x)], 1u);
        const unsigned gen = old / nloc;
        if (old + 1u == (gen + 1u) * nloc) {
            __builtin_amdgcn_fence(__ATOMIC_RELEASE, "agent");
            asm volatile("s_waitcnt vmcnt(0)" ::: "memory");
            const unsigned og = xb_add(&bar[XB_TOP], 1u);
            const unsigned tg = og / nx;
            if (og + 1u == (tg + 1u) * nx) xb_add(&bar[XB_TOPGEN], 1u);
            else XB_SPIN(xb_ld(&bar[XB_TOPGEN]) == tg, bar);
            __builtin_amdgcn_fence(__ATOMIC_ACQUIRE, "agent");
            xb_add(&bar[XB_XGEN(b.x)], 1u);
            asm volatile("s_waitcnt vmcnt(0)" ::: "memory");
        } else {
            XB_SPIN(xb_ld(&bar[XB_XGEN(b.x)]) == gen, bar);
            __builtin_amdgcn_fence(__ATOMIC_ACQUIRE, "agent");
            asm volatile("s_waitcnt vmcnt(0)" ::: "memory");
        }
    }
    __syncthreads();
}

struct Args { MP p; long flags; };
__global__ void __launch_bounds__(NTHR, 2) mk_fwd(Args a) {
    extern __shared__ __attribute__((aligned(16))) unsigned char lds[];
    LAS unsigned char* const L3 = (LAS unsigned char*)lds;
    volatile LAS unsigned* MISC = (volatile LAS unsigned*)(L3 + MISC_OFF);
    const MP& p = a.p;
    const int tid = threadIdx.x;
    for (int u = tid; u < (LDS_BYTES - LDSCTL_OFF) / 4; u += NTHR) ((LAS unsigned*)(L3 + LDSCTL_OFF))[u] = 0u;
    __syncthreads();
    const XcdBarrier bar = xcd_barrier_post(p.ctl + CW_BAR, MISC + 8);
    const int G = gridDim.x, bx = blockIdx.x;
    const long gs = (long)G * NTHR;
#define g0 ((long)bx * NTHR + mk_tid())
#ifndef PROBE_MASK
#define PROBE_MASK 0
#endif
#define REP(k) for (int rep_ = 0; rep_ < ((PROBE_MASK >> (k)) & 1) + 1; ++rep_)
#define GRID_BAR() do { REP(10) xcd_barrier(bar); } while (0)
#define PH_BEGIN(id) TP_BEGIN(id, L3)
#define PH_END(id) TP_END(id, L3)
    PH_BEGIN(0); REP(0) fp::prologue(p, L3, bx, G);
    GRID_BAR(); PH_END(0);
    for (int L = 0; L < DEPTH; ++L) {
        const int j = L >> 1; const bool moe = (L & 1) != 0;
        bf16* const hcur = (L & 1) ? p.HB2 : p.HB; bf16* const hnxt = (L & 1) ? p.HB : p.HB2;
        PH_BEGIN(1);
        REP(1) {
            pg8::Gemm g{hcur, p.WIN + (size_t)L * NU * D, (int)p.T, NU, D, D}; pg8::StaticOrder S; S.init((int)p.T, NU, G, bx);
            pg8::rstd_table(L3, rss_ptr(p, L, 0), S);
            pg8::EpiStore16 E{p.U, NU, (const LAS float*)(L3 + pg8::RSTD_TAB_OFF)}; pg8::gemm_phase<pg8::EpiStore16, pg8::StaticOrder, true, true>(L3, g, S, E);
            pg8::Gemm g2{p.PB16 + (size_t)L * p.T * PLE, p.WPP + (size_t)L * D * PLE, (int)p.T, D, PLE, PLE}; pg8::UpperHalfOrder S2; S2.init2((int)p.T, D, G, bx);
            pg8::EpiStore16 E2{p.PJ, D, nullptr}; pg8::gemm_phase<pg8::EpiStore16, pg8::UpperHalfOrder, true, true>(L3, g2, S2, E2);
        }
        GRID_BAR(); PH_END(1); PH_BEGIN(2);
        REP(6) { PH_BEGIN(13); fp::conv_module(p, L, L3, bx, G); PH_END(13); PH_BEGIN(14); fp::mla_proj(p, L, L3, bx, G); PH_END(14); PH_BEGIN(15); fp::ssd_a(p, L, L3, bx, G); PH_END(15); }
        GRID_BAR(); PH_END(2); PH_BEGIN(3);
        REP(7) { PH_BEGIN(16); fp::ssd_scan(p, bx, G); PH_END(16); PH_BEGIN(17); fp::attn_phase(p, L3, bx, G); PH_END(17); }
        GRID_BAR(); PH_END(3); PH_BEGIN(4);
        REP(8) fp::ssd_c(p, L, L3, bx, G);
        GRID_BAR(); PH_END(4); PH_BEGIN(5);
        {
            pg8::Gemm g{p.YC, p.WOUT + (size_t)L * D * D, (int)p.T, D, D, D}; pg8::StaticOrder S; S.init((int)p.T, D, G, bx);
            pg8::EpiAddH E{hcur, D, rss_ptr(p, L, 1)}; pg8::gemm_phase<pg8::EpiAddH, pg8::StaticOrder, true, true>(L3, g, S, E);
        }
        GRID_BAR(); PH_END(5);
        if (moe) { PH_BEGIN(6); fp::norm_phase<1>(p, L, p.ffn_g + L * D, hcur, bx, G, (LAS unsigned*)L3); GRID_BAR(); PH_END(6); PH_BEGIN(7); fp::moeplan(p, L, L3, bx, G); GRID_BAR(); PH_END(7); }
        PH_BEGIN(8);
        {
            const int rows = moe ? moe_start_of(p, j, NE) : (int)p.T;
            pg8::Gemm g{moe ? p.XB : hcur, moe ? p.MWGU + (size_t)j * NE * NGU * D : p.DWGU + (size_t)j * NGU * D, rows, NGU, D, D};
            pg8::ExpertOrder S; S.init(rows, NGU, G, bx); S.tile_e = moe ? p.TILE_E : nullptr;
            if (!moe) pg8::rstd_table(L3, rss_ptr(p, L, 1), S);
            REP(3) { pg8::EpiSwiglu E{p.ACT, DFF, moe ? (const LAS float*)nullptr : (const LAS float*)(L3 + pg8::RSTD_TAB_OFF)}; pg8::gemm_phase<pg8::EpiSwiglu, pg8::ExpertOrder, true, true>(L3, g, S, E); }
            GRID_BAR(); PH_END(8); PH_BEGIN(9);
            if (moe) {
                const int nwg = (rows >> 8) * 4, nfull = (nwg / G) * G, R = nwg - nfull; const int ksn = (R == 0) ? 1 : (R * 4 <= G && R <= 20 ? 4 : (R * 2 <= G && R <= 64 ? 2 : 1));
                const bf16* Wd = p.MWD + (size_t)j * NE * D * DFF; pg8::EpiMoeDown Ed{p.YS, hnxt, (size_t)R * 256 * 1024, (nfull >> 2) * 256};
                { pg8::Gemm gd{p.ACT, Wd, rows, D, DFF, DFF}; pg8::MoeDownOrder Sd{nwg, nfull, G, bx, 0, 0, p.TILE_E}; REP(4) pg8::gemm_phase<pg8::EpiMoeDown, pg8::MoeDownOrder, true, true>(L3, gd, Sd, Ed); }
                if (R > 0) { pg8::Gemm gd{p.ACT, Wd, rows, D, DFF / ksn, DFF}; pg8::MoeDownOrder Sd{nwg, nfull, G, bx, ksn, DFF / ksn, p.TILE_E}; pg8::gemm_phase<pg8::EpiMoeDown, pg8::MoeDownOrder, true, true>(L3, gd, Sd, Ed); }
                if (bx == 0 && mk_tid() == 0) { p.TILE_E[1000] = (nfull >> 2) * 256; p.TILE_E[1001] = ksn; p.TILE_E[1002] = R * 256; }
            } else {
                pg8::Gemm gd{p.ACT, p.DWD + (size_t)j * D * DFF, rows, D, DFF, DFF}; pg8::StaticOrder Sd; Sd.init(rows, D, G, bx);
                REP(4) { pg8::EpiAddH Ed{hcur, D, rss_ptr(p, L, 2)}; pg8::gemm_phase<pg8::EpiAddH, pg8::StaticOrder, true, true>(L3, gd, Sd, Ed); }
            }
        }
        GRID_BAR(); PH_END(9);
        if (moe) { PH_BEGIN(10); fp::norm_phase<2>(p, L, nullptr, hcur, bx, G, nullptr, hnxt); GRID_BAR(); PH_END(10); }
        PH_BEGIN(11);
        {
            pg8::Gemm g{hcur, p.WPG + (size_t)L * D * D, (int)p.T, D, D, D}; pg8::StaticOrder S; S.init((int)p.T, D, G, bx);
            pg8::rstd_table(L3, rss_ptr(p, L, 2), S);
            pg8::EpiPleF E{hcur, hnxt, p.PJ, D, (const LAS float*)(L3 + pg8::RSTD_TAB_OFF), rss_ptr(p, L + 1, 0)}; pg8::gemm_phase<pg8::EpiPleF, pg8::StaticOrder, true, true>(L3, g, S, E);
        }
        GRID_BAR(); PH_END(11);
    }
    PH_BEGIN(12); fp::norm_phase<3>(p, 0, p.fin_g, p.HB, bx, G); PH_END(12);
    if (PROBE_T && bx == 0 && tid == 0) { const unsigned long long te_ = __builtin_amdgcn_s_memrealtime() + 4ull * MISC[2]; while (__builtin_amdgcn_s_memrealtime() < te_) __builtin_amdgcn_s_sleep(8); }
}
static void fill_params(MP& p, void* const* d_in, void* d_out, void* d_ws) {
    p.x = (const float*)d_in[0]; p.p = (const float*)d_in[1]; p.pos = (const int*)d_in[2];
    const float** w = &p.attn_g; for (int i = 3; i < 32; ++i) w[i - 3] = (const float*)d_in[i];
    p.out = (float*)d_out; p.B = 8; p.S = 2048; p.T = 16384; p.NSLOT = 2 * 16384 + 8 * 256;
    carve(p, (unsigned char*)d_ws);
}
extern "C" void kernel_launch(void* const* d_in, const int* in_sizes, int n_in, void* d_out, int out_size, void* d_ws, size_t ws_size, hipStream_t stream) {
    static int grid = 0;
    if (grid == 0) {
        MP q{}; q.T = 16384; q.NSLOT = 2 * 16384 + 8 * 256; const size_t need = carve(q, nullptr);
        if (n_in != 32 || ws_size < need) { fprintf(stderr, "kernel_launch: need %zu bytes of ws, have %zu (n_in %d)\n", need, ws_size, n_in); grid = -1; return; }
        int dev = 0, cus = 0, per_cu = 0;
        if (hipGetDevice(&dev) != hipSuccess || hipDeviceGetAttribute(&cus, hipDeviceAttributeMultiprocessorCount, dev) != hipSuccess) { grid = -1; return; }
        if (hipFuncSetAttribute((const void*)mk_fwd, hipFuncAttributeMaxDynamicSharedMemorySize, LDS_BYTES) != hipSuccess) { fprintf(stderr, "kernel_launch: hipFuncSetAttribute failed\n"); grid = -1; return; }
        if (hipOccupancyMaxActiveBlocksPerMultiprocessor(&per_cu, (const void*)mk_fwd, NTHR, LDS_BYTES) != hipSuccess || per_cu < 1) { fprintf(stderr, "kernel_launch: occupancy query says %d\n", per_cu); }
        (void)hipGetLastError();
        grid = cus;
    }
    if (grid < 0) return;
    Args a{}; fill_params(a.p, d_in, d_out, d_ws); a.flags = 0;
    if (hipMemsetAsync(a.p.ctl, 0, CTL_WORDS * 4, stream) != hipSuccess) return;
    hipLaunchKernelGGL(mk_fwd, dim3(grid), dim3(NTHR), LDS_BYTES, stream, a);
}
```

```cpp
#include <hip/hip_runtime.h>
#include <cstdio>
#include <cstdint>
__device__ __forceinline__ int mk_tid() { int t = threadIdx.x; asm volatile("" : "+v"(t)); return t; }
#ifndef PROBE_T
#define PROBE_T 0
#endif
#ifndef PROBE_CK
#define PROBE_CK 0
#endif
constexpr int LDS_BYTES = 163840, LDSCTL_OFF = LDS_BYTES - 512, MISC_OFF = LDSCTL_OFF + 320;
#define TP_MISC(l3) ((volatile __attribute__((address_space(3))) unsigned*)((l3) + MISC_OFF))
#define TP_BEGIN(id, l3) do { if (((PROBE_T >> (id)) & 1) && blockIdx.x == 0 && threadIdx.x == 0) { const unsigned long long t_ = __builtin_amdgcn_s_memrealtime(); TP_MISC(l3)[0] = (unsigned)t_; TP_MISC(l3)[1] = (unsigned)(t_ >> 32); } } while (0)
#define TP_END(id, l3) do { if (((PROBE_T >> (id)) & 1) && blockIdx.x == 0 && threadIdx.x == 0) { const unsigned long long t0_ = ((unsigned long long)TP_MISC(l3)[1] << 32) | TP_MISC(l3)[0]; TP_MISC(l3)[2] += (unsigned)(__builtin_amdgcn_s_memrealtime() - t0_); } } while (0)

#include <cstring>
#include <cmath>
#include <cstdint>
#ifdef __HIPCC__
#define HD __host__ __device__ __forceinline__
#else
#define HD inline
#endif
typedef unsigned short bf16;
namespace mdl {
constexpr int D = 1024, DEPTH = 4, NU = 2560, NUO = 2472, DFF = 3584, NGU = 7168, NE = 8, PLE = 256;
constexpr int CK = 31, SCONV = 4, CHUNK = 128, NH = 8, HP = 64, NS = 128;
constexpr float RMS_EPS = 1e-6f, LN_EPS = 1e-5f;
constexpr float QSCALE = 0.10206207261596577f * 1.4426950408889634f;
constexpr int U_Z = 512, U_XBC = 1024, U_CQ = 2048, U_CKV = 2304, U_KR = 2432, U_DT = 2464;

HD float bf2f(bf16 v) { unsigned u = (unsigned)v << 16; float f; memcpy(&f, &u, 4); return f; }
HD bf16 f2bf(float f) { unsigned u; memcpy(&u, &f, 4); u += 0x7fffu + ((u >> 16) & 1u); return (bf16)(u >> 16); }
HD float sigmoidf_(float x) { return 1.0f / (1.0f + expf(-x)); }
HD float siluf_(float x) { return x / (1.0f + expf(-x)); }
HD float softplusf_(float x) { return x > 20.f ? x : log1pf(expf(x)); }
HD int ucol_src(int n) { return n < 2048 ? n : (n < U_DT ? n + 8 : (n < NUO ? n - U_DT + 2048 : -1)); }

struct MP {
    const float *x, *p; const int* pos;
    const float *attn_g, *w_in, *cdw_w, *cdw_b, *cln_g, *cln_b, *sconv_w, *sconv_b, *dt_bias, *a_log, *dskip, *snorm_g, *qn_g, *w_uq, *kvn_g, *w_ukv,
        *w_out, *ffn_g, *dwg, *dwu, *dwd, *router, *mwg, *mwu, *mwd, *ple_g, *ple_wg, *ple_wp, *fin_g;
    float* out;
    long B, S, T, NSLOT;
    unsigned* ctl;
    bf16 *WIN, *WUQ, *WUKV, *WOUT, *DWGU, *DWD, *MWGU, *MWD, *WPG, *WPP;
    float *RSSP, *H, *CS, *DT, *ACS, *ST, *CB, *YPRE, *TOPG;
    bf16 *HB2, *HB, *U, *YC, *Q, *KK, *V, *XS, *BM, *CM, *YD, *PV, *PB16, *PJ, *ACT, *XB, *YS;
    int *TOPE, *POS, *TOKSLOT, *TILE_E, *BCNT;
};
constexpr int CTL_WORDS = 65536;
HD unsigned* cnt_ptr(const MP& p, int j) { return p.ctl + 1024 + j * 64; }
HD float* rss_ptr(const MP& p, int L, int k) { return p.RSSP + (size_t)(L * 3 + k) * p.T * 16; }

inline size_t carve(MP& p, unsigned char* ws) {
    size_t o = 0; const size_t T = p.T, NSL = p.NSLOT;
    auto take = [&](size_t bytes) { size_t r = o; o += (bytes + 255) & ~(size_t)255; return ws + r; };
    p.ctl = (unsigned*)take(CTL_WORDS * 4);
    p.WIN = (bf16*)take((size_t)DEPTH * NU * D * 2); p.WUQ = (bf16*)take((size_t)DEPTH * 512 * 256 * 2); p.WUKV = (bf16*)take((size_t)DEPTH * 512 * 128 * 2);
    p.WOUT = (bf16*)take((size_t)DEPTH * D * D * 2); p.DWGU = (bf16*)take((size_t)2 * NGU * D * 2); p.DWD = (bf16*)take((size_t)2 * D * DFF * 2);
    p.MWGU = (bf16*)take((size_t)2 * NE * NGU * D * 2); p.MWD = (bf16*)take((size_t)2 * NE * D * DFF * 2);
    p.WPG = (bf16*)take((size_t)DEPTH * D * D * 2); p.WPP = (bf16*)take((size_t)DEPTH * D * PLE * 2);
    p.RSSP = (float*)take((size_t)13 * T * 16 * 4); p.H = (float*)take(T * D * 4);     p.HB = (bf16*)take(T * D * 2); p.HB2 = (bf16*)take(T * D * 2); p.CS = (float*)take(T * 32 * 4);
    p.PB16 = (bf16*)take((size_t)DEPTH * T * PLE * 2); p.PJ = (bf16*)take(T * D * 2);
    p.TOPE = (int*)take(T * 2 * 4); p.TOPG = (float*)take(T * 2 * 4); p.POS = (int*)take(T * 2 * 4); p.TOKSLOT = (int*)take(T * 2 * 4); p.TILE_E = (int*)take(1024 * 4); p.BCNT = (int*)take(1024 * NE * 4);
    p.XB = (bf16*)take(NSL * D * 2); p.YS = p.XB;
    const size_t r1 = o;
    p.U = (bf16*)take(T * NU * 2); p.YC = (bf16*)take(T * D * 2); p.Q = (bf16*)take(T * 384 * 2); p.KK = (bf16*)take(T * 384 * 2); p.V = (bf16*)take(T * 256 * 2);
    p.XS = (bf16*)take(T * 512 * 2); p.BM = (bf16*)take(T * 256 * 2); p.CM = (bf16*)take(T * 256 * 2); p.YD = (bf16*)take(T * 512 * 2);
    p.DT = (float*)take(T * 8 * 4); p.ACS = (float*)take(T * 8 * 4); p.ST = (float*)take(T / CHUNK * NH * HP * NS * 4); p.PV = (bf16*)take(T / CHUNK * NH * HP * NS * 2);
    p.CB = nullptr; p.YPRE = nullptr;
    const size_t r1end = o; o = r1;
    p.ACT = (bf16*)take(NSL * DFF * 2);
    if (o < r1end) o = r1end;
    return o;
}

HD int moe_start_of(const MP& p, int j, int E) { const unsigned* cnt = cnt_ptr(p, j); int o = 0; for (int e = 0; e < NE; ++e) if (e < E) o += (int)((cnt[e] + 255u) / 256u) * 256; return o; }
}

namespace pg8 {
#define PG8_LAS __attribute__((address_space(3)))
typedef unsigned short bf16_t;
typedef short bf16x8 __attribute__((ext_vector_type(8)));
typedef float f32x4 __attribute__((ext_vector_type(4)));
typedef unsigned u32x4 __attribute__((ext_vector_type(4)));
constexpr int BM = 256, BK = 64, HALF = 128, HTB = HALF * BK * 2  , STAGE_BYTES = 8 * HTB, NXCD = 8, WGM = 8;

__host__ __device__ __forceinline__ int lds_byte(int r, int c) { const int st = (r >> 4) * 2 + (c >> 5), rr = r & 15, cc = c & 31, ob = rr * 64 + cc * 2; return st * 1024 + (ob ^ (((ob >> 9) & 1) << 5)); }
__host__ __device__ __forceinline__ void stage_rc(int b, int& R, int& C) { const int st = b / 1024, sb = b % 1024, swz = sb ^ (((sb >> 9) & 1) << 5); R = (st >> 1) * 16 + swz / 64; C = (st & 1) * 32 + (swz % 64) / 2; }
__host__ __device__ __forceinline__ int perm32(int rho) { const int n = rho >> 4, i = rho & 15; return 8 * (i >> 2) + 4 * n + (i & 3); }

struct Unit { int pm, pn, cn, koff, ks, ui; };
struct Gemm { const bf16_t* A; const bf16_t* Bt; int M, N, K, ld; };

struct StaticOrder {
    int nM, nN, nwg, G, c;
    __host__ __device__ void init(int M, int N, int G_, int c_) { nM = M / BM; nN = N / BM; nwg = nM * nN; G = G_; c = c_; }
    __host__ __device__ bool next(int i, Unit& u) const {
        const int L = i * G + c; if (L >= nwg) return false;
        int wgid = L; { const int q = nwg / NXCD, r = nwg % NXCD, xcd = wgid % NXCD, off = wgid / NXCD; wgid = (xcd < r ? xcd * (q + 1) : r * (q + 1) + (xcd - r) * q) + off; }
        const int nig = WGM * nN, gid = wgid / nig, fm = gid * WGM, gsz = (nM - fm) < WGM ? (nM - fm) : WGM;
        u.pm = fm + ((wgid % nig) % gsz); u.pn = (wgid % nig) / gsz; u.cn = u.pn; u.koff = 0; u.ks = 0; u.ui = i; return true;
    }
    __device__ __forceinline__ void a_ready(const Unit&) const {}
    __device__ __forceinline__ void done(const Unit&) const {}
};
__device__ __forceinline__ unsigned cvt_pk_bf16(float lo, float hi) { unsigned r; asm volatile("v_cvt_pk_bf16_f32 %0, %1, %2" : "=v"(r) : "v"(lo), "v"(hi)); return r; }
typedef float f32x2 __attribute__((ext_vector_type(2)));
template <class Epi, class Sched, bool ALIGN_EPI = false, bool SP2 = false>
__device__ __forceinline__ void gemm_phase(PG8_LAS unsigned char* lds, const Gemm g, const Sched& S, const Epi& E) {
    if (Epi::TAG == PROBE_CK) TP_BEGIN(27, lds);
    const int tid = mk_tid(), wid = __builtin_amdgcn_readfirstlane(tid >> 6), lane = tid & 63, wr = wid >> 2, wc = wid & 3, fr = lane & 15, fq = lane >> 4;
    const int K = g.ld, nt = g.K / BK;
    unsigned voffA[2], voffB[2];
#pragma unroll
    for (int i = 0; i < 2; ++i) { int R, C; stage_rc(tid * 16 + i * 8192, R, C); const int Rb = Epi::PERM ? ((R & ~31) + perm32(R & 31)) : R;
        voffA[i] = (unsigned)(R * K + C) * 2u; voffB[i] = (unsigned)(Rb * K + C) * 2u; }
    const size_t kstep = (size_t)(BK * 2);
    const size_t hstep = (size_t)HALF * K * 2;
    const size_t tstep = 2 * hstep;
    const unsigned ldsw = (unsigned)wid * 1024u;
    const int aoff = lds_byte(wr * 64 + fr, fq * 8), boff = lds_byte(wc * 32 + fr, fq * 8);
#define PG8_SA(b, h) (((b) * 2 + (h)) * HTB)
#define PG8_SB(b, h) ((4 + (b) * 2 + (h)) * HTB)
#define PG8_STAGE(bufoff, gbase, voff) do { _Pragma("unroll") for (int _i = 0; _i < 2; ++_i) \
        __builtin_amdgcn_global_load_lds((const unsigned*)((const char*)(gbase) + (voff)[_i]), (PG8_LAS unsigned*)(lds + (bufoff) + ldsw + _i * 8192), 16, 0, 0); } while (0)
#define PG8_LDA(dst, b, h) do { _Pragma("unroll") for (int m = 0; m < 4; ++m) _Pragma("unroll") for (int k = 0; k < 2; ++k) dst[m][k] = *(const PG8_LAS bf16x8*)(lds + PG8_SA(b, h) + aoff + m * 2048 + k * 1024); } while (0)
#define PG8_LDB(dst, b, h) do { _Pragma("unroll") for (int n = 0; n < 2; ++n) _Pragma("unroll") for (int k = 0; k < 2; ++k) dst[n][k] = *(const PG8_LAS bf16x8*)(lds + PG8_SB(b, h) + boff + n * 2048 + k * 1024); } while (0)
#define PG8_MMA(ai, bj, At, Bt) do { __builtin_amdgcn_s_setprio(1); _Pragma("unroll") for (int m = 0; m < 4; ++m) _Pragma("unroll") for (int n = 0; n < 2; ++n) _Pragma("unroll") for (int k = 0; k < 2; ++k) \
        acc[ai][bj][m][n] = __builtin_amdgcn_mfma_f32_16x16x32_bf16(Bt[n][k], At[m][k], acc[ai][bj][m][n], 0, 0, 0); __builtin_amdgcn_s_setprio(0); } while (0)
#define PG8_WAIT_V(n) asm volatile("s_waitcnt vmcnt(" #n ")" ::: "memory")
#define PG8_WAIT_L(n) asm volatile("s_waitcnt lgkmcnt(" #n ")" ::: "memory")
#define PG8_BAR __builtin_amdgcn_s_barrier()
#define PG8_SCHED __builtin_amdgcn_sched_barrier(0)
    Unit cur, nxt; int ui = 0;
    if (!S.next(0, cur)) return;
    f32x4 acc[2][2][4][2];
#pragma unroll
    for (int a = 0; a < 2; ++a)
#pragma unroll
        for (int b = 0; b < 2; ++b)
#pragma unroll
            for (int m = 0; m < 4; ++m)
#pragma unroll
                for (int n = 0; n < 2; ++n) acc[a][b][m][n] = (f32x4){0.f, 0.f, 0.f, 0.f};
    bf16x8 At[4][2], B0[2][2], B1[2][2];
    const char* cA = (const char*)g.A + (size_t)cur.pm * tstep + (size_t)cur.koff * 2; const char* cB = (const char*)g.Bt + (size_t)cur.pn * tstep + (size_t)cur.koff * 2;
    S.a_ready(cur);
    if constexpr (SP2) {
        PG8_STAGE(PG8_SB(0, 0), cB, voffB); PG8_STAGE(PG8_SB(0, 1), cB + hstep, voffB); PG8_STAGE(PG8_SA(0, 0), cA, voffA); PG8_STAGE(PG8_SA(0, 1), cA + hstep, voffA);
        if (wr == 1) PG8_BAR;
        PG8_WAIT_V(2); PG8_BAR;
        PG8_STAGE(PG8_SB(1, 0), cB + kstep, voffB); PG8_STAGE(PG8_SA(1, 0), cA + kstep, voffA); PG8_STAGE(PG8_SB(1, 1), cB + hstep + kstep, voffB);
        PG8_WAIT_V(6); PG8_BAR;
    } else {
        PG8_STAGE(PG8_SB(0, 0), cB, voffB); PG8_STAGE(PG8_SA(0, 0), cA, voffA); PG8_STAGE(PG8_SB(0, 1), cB + hstep, voffB); PG8_STAGE(PG8_SA(0, 1), cA + hstep, voffA);
        if (wr == 1) PG8_BAR;
        PG8_WAIT_V(4); PG8_BAR;
        PG8_STAGE(PG8_SB(1, 0), cB + kstep, voffB); PG8_STAGE(PG8_SA(1, 0), cA + kstep, voffA); PG8_STAGE(PG8_SB(1, 1), cB + hstep + kstep, voffB);
        PG8_WAIT_V(6); PG8_BAR;
    }
    for (;;) {
        const bool has_next = S.next(ui + 1, nxt);
        const char* nA = has_next ? (const char*)g.A + (size_t)nxt.pm * tstep + (size_t)nxt.koff * 2 : cA; const char* nB = has_next ? (const char*)g.Bt + (size_t)nxt.pn * tstep + (size_t)nxt.koff * 2 : cB;
#pragma unroll 1
        for (int t = 0; t < nt; t += 2) {
            const bool last = (t == nt - 2);
            const char* a1 = cA + (size_t)(t + 1) * kstep;
            const char* a2 = last ? nA : cA + (size_t)(t + 2) * kstep; const char* b2 = last ? nB : cB + (size_t)(t + 2) * kstep;
            const char* a3 = a2 + kstep; const char* b3 = b2 + kstep;
            if (last && has_next) S.a_ready(nxt);
            if constexpr (SP2) {
            PG8_LDB(B0, 0, 0); PG8_LDB(B1, 0, 1); PG8_SCHED; PG8_LDA(At, 0, 0); PG8_STAGE(PG8_SA(1, 1), a1 + hstep, voffA);
            PG8_WAIT_V(8); PG8_WAIT_L(0); PG8_BAR; PG8_MMA(0, 0, At, B0); PG8_MMA(0, 1, At, B1); PG8_BAR; PG8_SCHED;
            PG8_LDA(At, 0, 1); PG8_STAGE(PG8_SB(0, 0), b2, voffB); PG8_STAGE(PG8_SB(0, 1), b2 + hstep, voffB); PG8_STAGE(PG8_SA(0, 0), a2, voffA);
            PG8_WAIT_V(8); PG8_WAIT_L(0); PG8_BAR; PG8_MMA(1, 0, At, B0); PG8_MMA(1, 1, At, B1); PG8_BAR; PG8_SCHED;
            PG8_LDB(B0, 1, 0); PG8_LDB(B1, 1, 1); PG8_SCHED; PG8_LDA(At, 1, 0); PG8_STAGE(PG8_SA(0, 1), a2 + hstep, voffA);
            PG8_WAIT_V(8); PG8_WAIT_L(0); PG8_BAR; PG8_MMA(0, 0, At, B0); PG8_MMA(0, 1, At, B1); PG8_BAR; PG8_SCHED;
            PG8_LDA(At, 1, 1); PG8_STAGE(PG8_SB(1, 0), b3, voffB); PG8_STAGE(PG8_SB(1, 1), b3 + hstep, voffB); PG8_STAGE(PG8_SA(1, 0), a3, voffA);
            PG8_WAIT_V(8); PG8_WAIT_L(0); PG8_BAR; PG8_MMA(1, 0, At, B0); PG8_MMA(1, 1, At, B1); PG8_BAR; PG8_SCHED;
            } else {
            PG8_LDB(B0, 0, 0); PG8_SCHED; PG8_LDA(At, 0, 0); PG8_STAGE(PG8_SA(1, 1), a1 + hstep, voffA);
            PG8_WAIT_L(8); PG8_BAR; PG8_WAIT_L(0); PG8_MMA(0, 0, At, B0); PG8_BAR; PG8_SCHED;
            PG8_LDB(B1, 0, 1); PG8_STAGE(PG8_SB(0, 0), b2, voffB);
            PG8_BAR; PG8_WAIT_L(0); PG8_MMA(0, 1, At, B1); PG8_BAR;
            PG8_LDA(At, 0, 1); PG8_STAGE(PG8_SA(0, 0), a2, voffA);
            PG8_BAR; PG8_WAIT_L(0); PG8_MMA(1, 0, At, B0); PG8_BAR; PG8_SCHED;
            PG8_STAGE(PG8_SB(0, 1), b2 + hstep, voffB);
            PG8_WAIT_V(6); PG8_BAR; PG8_MMA(1, 1, At, B1); PG8_BAR;
            PG8_LDB(B0, 1, 0); PG8_SCHED; PG8_LDA(At, 1, 0); PG8_STAGE(PG8_SA(0, 1), a2 + hstep, voffA);
            PG8_WAIT_L(8); PG8_BAR; PG8_WAIT_L(0); PG8_MMA(0, 0, At, B0); PG8_BAR; PG8_SCHED;
            PG8_LDB(B1, 1, 1); PG8_STAGE(PG8_SB(1, 0), b3, voffB);
            PG8_BAR; PG8_WAIT_L(0); PG8_MMA(0, 1, At, B1); PG8_BAR;
            PG8_LDA(At, 1, 1); PG8_STAGE(PG8_SA(1, 0), a3, voffA);
            PG8_BAR; PG8_WAIT_L(0); PG8_MMA(1, 0, At, B0); PG8_BAR; PG8_SCHED;
            PG8_STAGE(PG8_SB(1, 1), b3 + hstep, voffB);
            PG8_WAIT_V(6); PG8_BAR; PG8_MMA(1, 1, At, B1); PG8_BAR;
            }
        }
        TP_BEGIN(26, lds); if constexpr (ALIGN_EPI) { if (wr == 0) PG8_BAR; } TP_END(26, lds);
        if (Epi::TAG == PROBE_CK) TP_BEGIN(25, lds); if constexpr (!Epi::AFTER_DRAIN) { E(acc, cur, wr, wc, fr, fq); S.done(cur); } if (((PROBE_T >> 25) & 1) && Epi::TAG == PROBE_CK) { asm volatile("s_waitcnt vmcnt(0)" ::: "memory"); TP_END(25, lds); }
        if (!has_next) break;
#pragma unroll
        for (int a = 0; a < 2; ++a)
#pragma unroll
            for (int b = 0; b < 2; ++b)
#pragma unroll
                for (int m = 0; m < 4; ++m)
#pragma unroll
                    for (int n = 0; n < 2; ++n) acc[a][b][m][n] = (f32x4){0.f, 0.f, 0.f, 0.f};
        cur = nxt; cA = nA; cB = nB; ++ui;
        if constexpr (ALIGN_EPI) { if (wr == 1) PG8_BAR; }
    }
    PG8_WAIT_V(0);
    if constexpr (!ALIGN_EPI) { if (wr == 0) PG8_BAR; }
    PG8_BAR;
    if constexpr (Epi::AFTER_DRAIN) { E.fused(acc, cur, wr, wc, fr, fq, lds, wid, lane); S.done(cur); }
    if (Epi::TAG == PROBE_CK) TP_END(27, lds);
#undef PG8_SA
#undef PG8_SB
#undef PG8_STAGE
#undef PG8_LDA
#undef PG8_LDB
#undef PG8_MMA
#undef PG8_WAIT_V
#undef PG8_WAIT_L
#undef PG8_BAR
#undef PG8_SCHED
}
}

namespace pg8 {
__device__ __forceinline__ float fast_sigmoid(float x) { return __builtin_amdgcn_rcpf(1.0f + __builtin_amdgcn_exp2f(-1.4426950408889634f * x)); }
constexpr int RSTD_TAB_OFF = STAGE_BYTES, RSTD_MAX_UNITS = 8;
template <class Sched> __device__ __forceinline__ void rstd_table(PG8_LAS unsigned char* lds, const float* rss, const Sched& S) {
    PG8_LAS float* tab = (PG8_LAS float*)(lds + RSTD_TAB_OFF); const int tid = mk_tid(), r = tid & 255, par = __builtin_amdgcn_readfirstlane(tid >> 8);
    f32x4 q[4][4]; bool ok[4];
#pragma unroll
    for (int it = 0; it < 4; ++it) { Unit u; const int ui = 2 * it + par; ok[it] = S.next(ui, u);
        if (ok[it]) { const f32x4* src = (const f32x4*)(rss + ((size_t)u.pm * BM + r) * 16);
#pragma unroll
            for (int k = 0; k < 4; ++k) q[it][k] = src[k]; } }
#pragma unroll
    for (int it = 0; it < 4; ++it) if (ok[it]) { const f32x4 a = q[it][0], b = q[it][1], c = q[it][2], d = q[it][3];
        const float s = (((a[0] + a[1]) + (a[2] + a[3])) + ((b[0] + b[1]) + (b[2] + b[3]))) + (((c[0] + c[1]) + (c[2] + c[3])) + ((d[0] + d[1]) + (d[2] + d[3])));
        tab[(2 * it + par) * 256 + r] = 1.0f / sqrtf(s * (1.0f / 1024.f) + 1e-6f); }
    asm volatile("s_waitcnt lgkmcnt(0)" ::: "memory"); __syncthreads();
}
__device__ __forceinline__ void rstd8(const PG8_LAS float* tab, int ui, int rl0, float (&rs)[8]) {
    if (!tab) {
#pragma unroll
        for (int i = 0; i < 8; ++i) rs[i] = 1.0f;
        return; }
#pragma unroll
    for (int i = 0; i < 8; ++i) rs[i] = tab[ui * 256 + rl0 + (i >> 2) * HALF + (i & 3) * 16];
}
struct EpiStore16 {
    static constexpr bool PERM = true, AFTER_DRAIN = false; static constexpr int TAG = 3;
    bf16_t* O; int ldc; const PG8_LAS float* tab;
    __device__ __forceinline__ void operator()(const f32x4 (&acc)[2][2][4][2], const Unit& u, int wr, int wc, int fr, int fq) const {
        const int row0 = u.pm * BM + wr * 64 + fr, col0 = u.cn * BM + wc * 32 + 8 * fq;
        float rs[8]; rstd8(tab, u.ui, wr * 64 + fr, rs);
#pragma unroll
        for (int ai = 0; ai < 2; ++ai)
#pragma unroll
            for (int m = 0; m < 4; ++m) { const int row = row0 + ai * HALF + m * 16; bf16_t* rowp = O + (size_t)row * ldc + col0; const float r = rs[ai * 4 + m];
#pragma unroll
                for (int bj = 0; bj < 2; ++bj) { const f32x4 v0 = acc[ai][bj][m][0] * r, v1 = acc[ai][bj][m][1] * r;
                    u32x4 w; w.x = cvt_pk_bf16(v0[0], v0[1]); w.y = cvt_pk_bf16(v0[2], v0[3]); w.z = cvt_pk_bf16(v1[0], v1[1]); w.w = cvt_pk_bf16(v1[2], v1[3]);
                    *(u32x4*)(rowp + bj * HALF) = w; } }
    }
};
__device__ __forceinline__ float sq8(const u32x4 w) { float s = 0.f;
#pragma unroll
    for (int i = 0; i < 4; ++i) { const float a = __uint_as_float(w[i] << 16), b = __uint_as_float(w[i] & 0xffff0000u); s += a * a + b * b; } return s; }
struct EpiAddH {
    static constexpr bool PERM = true, AFTER_DRAIN = false; static constexpr int TAG = 1;
    bf16_t* Hb; int ldc; float* rss_out;
    __device__ __forceinline__ void operator()(const f32x4 (&acc)[2][2][4][2], const Unit& u, int wr, int wc, int fr, int fq) const {
        const int row0 = u.pm * BM + wr * 64 + fr, col0 = u.cn * BM + wc * 32 + 8 * fq;
        u32x4 h[2][4][2];
#pragma unroll
        for (int ai = 0; ai < 2; ++ai)
#pragma unroll
            for (int m = 0; m < 4; ++m)
#pragma unroll
                for (int bj = 0; bj < 2; ++bj) h[ai][m][bj] = *(const u32x4*)(Hb + (size_t)(row0 + ai * HALF + m * 16) * ldc + col0 + bj * HALF);
        __builtin_amdgcn_sched_barrier(0);
#pragma unroll
        for (int ai = 0; ai < 2; ++ai)
#pragma unroll
            for (int m = 0; m < 4; ++m) { const int row = row0 + ai * HALF + m * 16; float ss = 0.f;
#pragma unroll
                for (int bj = 0; bj < 2; ++bj) { const u32x4 q = h[ai][m][bj]; const f32x4 a0 = acc[ai][bj][m][0], a1 = acc[ai][bj][m][1]; u32x4 w;
                    w.x = cvt_pk_bf16(__uint_as_float(q.x << 16) + a0[0], __uint_as_float(q.x & 0xffff0000u) + a0[1]); w.y = cvt_pk_bf16(__uint_as_float(q.y << 16) + a0[2], __uint_as_float(q.y & 0xffff0000u) + a0[3]);
                    w.z = cvt_pk_bf16(__uint_as_float(q.z << 16) + a1[0], __uint_as_float(q.z & 0xffff0000u) + a1[1]); w.w = cvt_pk_bf16(__uint_as_float(q.w << 16) + a1[2], __uint_as_float(q.w & 0xffff0000u) + a1[3]);
                    *(u32x4*)(Hb + (size_t)row * ldc + col0 + bj * HALF) = w; ss += sq8(w); }
                ss += __shfl_xor(ss, 16); ss += __shfl_xor(ss, 32);
                if (fq == 0) rss_out[(size_t)row * 16 + u.cn * 4 + wc] = ss; }
    }
};
struct EpiSwiglu {
    static constexpr bool PERM = true, AFTER_DRAIN = false; static constexpr int TAG = 4;
    bf16_t* O; int ldc; const PG8_LAS float* tab;
    __device__ __forceinline__ void operator()(const f32x4 (&acc)[2][2][4][2], const Unit& u, int wr, int wc, int fr, int fq) const {
        const int row0 = u.pm * BM + wr * 64 + fr, col0 = u.cn * HALF + wc * 32 + 8 * fq;
        float rs[8]; rstd8(tab, u.ui, wr * 64 + fr, rs);
#pragma unroll
        for (int ai = 0; ai < 2; ++ai)
#pragma unroll
            for (int m = 0; m < 4; ++m) { const int row = row0 + ai * HALF + m * 16; bf16_t* rowp = O + (size_t)row * ldc + col0; float o[8]; const float r = rs[ai * 4 + m];
#pragma unroll
                for (int n = 0; n < 2; ++n)
#pragma unroll
                    for (int j = 0; j < 4; ++j) { const float gt = acc[ai][0][m][n][j] * r, up = acc[ai][1][m][n][j] * r; o[n * 4 + j] = gt * fast_sigmoid(gt) * up; }
                u32x4 w; w.x = cvt_pk_bf16(o[0], o[1]); w.y = cvt_pk_bf16(o[2], o[3]); w.z = cvt_pk_bf16(o[4], o[5]); w.w = cvt_pk_bf16(o[6], o[7]);
                *(u32x4*)rowp = w; }
    }
};
struct EpiPleF {
    static constexpr bool PERM = true, AFTER_DRAIN = false; static constexpr int TAG = 2;
    const bf16_t* Hin; bf16_t* Hout; const bf16_t* PJ; int ldc; const PG8_LAS float* tab; float* rss_out;
    __device__ __forceinline__ void operator()(const f32x4 (&acc)[2][2][4][2], const Unit& u, int wr, int wc, int fr, int fq) const {
        const int row0 = u.pm * BM + wr * 64 + fr, col0 = u.cn * BM + wc * 32 + 8 * fq;
        float rs[8]; rstd8(tab, u.ui, wr * 64 + fr, rs);
#pragma unroll
        for (int ai = 0; ai < 2; ++ai) { u32x4 h[4][2], pj[4][2];
#pragma unroll
            for (int m = 0; m < 4; ++m)
#pragma unroll
                for (int bj = 0; bj < 2; ++bj) { const size_t off = (size_t)(row0 + ai * HALF + m * 16) * ldc + col0 + bj * HALF; h[m][bj] = *(const u32x4*)(Hin + off); pj[m][bj] = *(const u32x4*)(PJ + off); }
            __builtin_amdgcn_sched_barrier(0);
#pragma unroll
            for (int m = 0; m < 4; ++m) { const int row = row0 + ai * HALF + m * 16; const float r = rs[ai * 4 + m]; float ss = 0.f;
#pragma unroll
                for (int bj = 0; bj < 2; ++bj) { const u32x4 hh = h[m][bj], q = pj[m][bj]; u32x4 w;
#pragma unroll
                    for (int i = 0; i < 4; ++i) { const float a_lo = acc[ai][bj][m][i >> 1][(i & 1) * 2] * r, a_hi = acc[ai][bj][m][i >> 1][(i & 1) * 2 + 1] * r;
                        w[i] = cvt_pk_bf16(__uint_as_float(hh[i] << 16) + __uint_as_float(q[i] << 16) * fast_sigmoid(a_lo), __uint_as_float(hh[i] & 0xffff0000u) + __uint_as_float(q[i] & 0xffff0000u) * fast_sigmoid(a_hi)); }
                    *(u32x4*)(Hout + (size_t)row * ldc + col0 + bj * HALF) = w; ss += sq8(w); }
                ss += __shfl_xor(ss, 16); ss += __shfl_xor(ss, 32);
                if (fq == 0) rss_out[(size_t)row * 16 + u.cn * 4 + wc] = ss; }
            asm volatile("" ::: "memory"); }
    }
};
struct ExpertOrder : StaticOrder {
    const int* tile_e;
    __device__ __forceinline__ bool next(int i, Unit& u) const { if (!StaticOrder::next(i, u)) return false; if (tile_e) u.pn += tile_e[u.pm] * nN; return true; }
};
struct UpperHalfOrder : StaticOrder {
    __host__ __device__ void init2(int M, int N, int G_, int c_) { init(M, N, G_ / 2, c_ - G_ / 2); if (c_ < G_ / 2) c = nwg; }
};
struct MoeDownOrder {
    int nwg, nfull, G, c, ks_n, kslice; const int* tile_e;
    __device__ __forceinline__ bool next(int i, Unit& u) const {
        const int q = i * G + c; int L;
        if (ks_n == 0) { L = q; if (L >= nfull) return false; u.koff = 0; u.ks = 0; }
        else { if (q >= (nwg - nfull) * ks_n) return false; L = nfull + q / ks_n; u.ks = q % ks_n; u.koff = u.ks * kslice; }
        u.pm = L >> 2; u.cn = L & 3; u.pn = u.cn + tile_e[u.pm] * 4; u.ui = i; return true;
    }
    __device__ __forceinline__ void a_ready(const Unit&) const {}
    __device__ __forceinline__ void done(const Unit&) const {}
};
struct EpiMoeDown {
    static constexpr bool PERM = true, AFTER_DRAIN = false; static constexpr int TAG = 5;
    bf16_t* O; bf16_t* P; size_t pstride; int row0p;
    __device__ __forceinline__ void operator()(const f32x4 (&acc)[2][2][4][2], const Unit& u, int wr, int wc, int fr, int fq) const {
        const int col0 = u.cn * BM + wc * 32 + 8 * fq; const int rowt = u.pm * BM + wr * 64 + fr;
        bf16_t* base = u.ks == 0 ? O + (size_t)rowt * 1024 : P + (size_t)(u.ks - 1) * pstride + (size_t)(rowt - row0p) * 1024;
#pragma unroll
        for (int ai = 0; ai < 2; ++ai)
#pragma unroll
            for (int m = 0; m < 4; ++m) { bf16_t* rowp = base + (size_t)(ai * HALF + m * 16) * 1024 + col0;
#pragma unroll
                for (int bj = 0; bj < 2; ++bj) { const f32x4 v0 = acc[ai][bj][m][0], v1 = acc[ai][bj][m][1];
                    u32x4 w; w.x = cvt_pk_bf16(v0[0], v0[1]); w.y = cvt_pk_bf16(v0[2], v0[3]); w.z = cvt_pk_bf16(v1[0], v1[1]); w.w = cvt_pk_bf16(v1[2], v1[3]);
                    *(u32x4*)(rowp + bj * HALF) = w; } }
    }
};
}

namespace fp {
using namespace mdl;
#define FLAS __attribute__((address_space(3)))
typedef float f32x4 __attribute__((ext_vector_type(4)));
typedef float f32x2 __attribute__((ext_vector_type(2)));
typedef unsigned u32x4 __attribute__((ext_vector_type(4)));
typedef unsigned u32x2 __attribute__((ext_vector_type(2)));
typedef __bf16 bf16x2_t __attribute__((ext_vector_type(2)));
__device__ __forceinline__ unsigned pk2(float lo, float hi) { f32x2 v = {lo, hi}; bf16x2_t b = __builtin_convertvector(v, bf16x2_t); return __builtin_bit_cast(unsigned, b); }
__device__ __forceinline__ float blo(unsigned w) { return __uint_as_float(w << 16); }
__device__ __forceinline__ float bhi(unsigned w) { return __uint_as_float(w & 0xffff0000u); }
template <int CTRL, int ROWMASK> __device__ __forceinline__ float dpp_add(float v) {
    return v + __builtin_bit_cast(float, __builtin_amdgcn_update_dpp(0, __builtin_bit_cast(int, v), CTRL, ROWMASK, 0xF, false)); }
__device__ __forceinline__ float wave_sum(float v) {
    v = dpp_add<0xB1, 0xF>(v);
    v = dpp_add<0x4E, 0xF>(v);
    v = dpp_add<0x141, 0xF>(v);
    v = dpp_add<0x140, 0xF>(v);
    v = dpp_add<0x142, 0xA>(v);
    v = dpp_add<0x143, 0xC>(v);
    return __builtin_bit_cast(float, __builtin_amdgcn_readlane(__builtin_bit_cast(int, v), 63));
}
#define FP_LDS_WAIT() asm volatile("s_waitcnt lgkmcnt(0)" ::: "memory")
template <int ROWS, int ROWB, int PB, int NTHR_> __device__ __forceinline__ void tile_out(const FLAS unsigned char* st, unsigned char* gbase, size_t gpitch, int t) {
    constexpr int CPR = ROWB / 16, N = ROWS * CPR;
#pragma unroll
    for (int i0 = 0; i0 < N; i0 += NTHR_) { const int i = i0 + t; if (N % NTHR_ == 0 || i < N) { const int r = i / CPR, c = i % CPR; *(u32x4*)(gbase + (size_t)r * gpitch + c * 16) = *(const FLAS u32x4*)(st + r * PB + c * 16); } }
}

template <class Map> __device__ __forceinline__ void tr_item(const float* W, int Nsrc, const Map& map, bf16* WT, int K, int k0, int n0, FLAS float* scr, int lane, const float* gain = nullptr) {
    const int nl = lane & 31, c = map(n0 + nl), cc = lane & 7;
    f32x4 g0 = (f32x4){1.f, 1.f, 1.f, 1.f}, g1 = g0;
    if (gain) { g0 = *(const f32x4*)(gain + k0 + 8 * cc); g1 = *(const f32x4*)(gain + k0 + 8 * cc + 4); }
    float wv[32];
#pragma unroll
    for (int i = 0; i < 32; ++i) { const int kk = 2 * i + (lane >> 5); wv[i] = c >= 0 ? W[(size_t)(k0 + kk) * Nsrc + c] : 0.f; }
    __builtin_amdgcn_sched_barrier(0);
#pragma unroll
    for (int i = 0; i < 32; ++i) { const int kk = 2 * i + (lane >> 5); scr[kk * 33 + nl] = wv[i]; }
    FP_LDS_WAIT(); asm volatile("" ::: "memory");
#pragma unroll
    for (int j = 0; j < 4; ++j) { const int n = (lane >> 3) + 8 * j; const FLAS float* s = scr + (8 * cc) * 33 + n;
        u32x4 o; o.x = pk2(s[0 * 33] * g0.x, s[1 * 33] * g0.y); o.y = pk2(s[2 * 33] * g0.z, s[3 * 33] * g0.w); o.z = pk2(s[4 * 33] * g1.x, s[5 * 33] * g1.y); o.w = pk2(s[6 * 33] * g1.z, s[7 * 33] * g1.w);
        *(u32x4*)(WT + (size_t)(n0 + n) * K + k0 + 8 * cc) = o; }
    FP_LDS_WAIT(); asm volatile("" ::: "memory");
}
struct MapId { __device__ __forceinline__ int operator()(int n) const { return n; } };
struct MapLt { int lim; __device__ __forceinline__ int operator()(int n) const { return n < lim ? n : -1; } };
struct MapU { __device__ __forceinline__ int operator()(int n) const { return ucol_src(n); } };
struct MapOff { int off; __device__ __forceinline__ int operator()(int n) const { return n + off; } };
__device__ __forceinline__ void prologue(const MP& p, FLAS unsigned char* lds, int bx, int G) {
    const int tid = mk_tid(), lane = tid & 63, wave = __builtin_amdgcn_readfirstlane(tid >> 6);
    FLAS float* scr = (FLAS float*)(lds + wave * 16384);
    const int gw = bx * 8 + wave, NGW = G * 8;
    constexpr int I_WIN = (D / 64) * (NU / 32), I_UQ = 4 * 16, I_UKV = 2 * 16, I_DD = 16 * 32, I_PP = 4 * 32, I_GU = 16 * (NGU / 32), I_DN = (DFF / 64) * 32;
    constexpr int PER_L = I_WIN + I_UQ + I_UKV + 2 * I_DD + I_PP, NITEMS = DEPTH * PER_L + 18 * (I_GU + I_DN);
    for (int it = gw; it < NITEMS; it += NGW) {
        int r = it;
        if (r < DEPTH * PER_L) { const int l = r / PER_L; r %= PER_L;
            if (r < I_WIN) { tr_item(p.w_in + (size_t)l * D * NUO, NUO, MapU{}, p.WIN + (size_t)l * NU * D, D, 64 * (r / (NU / 32)), 32 * (r % (NU / 32)), scr, lane, p.attn_g + l * D); continue; } r -= I_WIN;
            if (r < I_UQ) { tr_item(p.w_uq + (size_t)l * 256 * 384, 384, MapLt{384}, p.WUQ + (size_t)l * 512 * 256, 256, 64 * (r / 16), 32 * (r % 16), scr, lane); continue; } r -= I_UQ;
            if (r < I_UKV) { tr_item(p.w_ukv + (size_t)l * 128 * 512, 512, MapId{}, p.WUKV + (size_t)l * 512 * 128, 128, 64 * (r / 16), 32 * (r % 16), scr, lane); continue; } r -= I_UKV;
            if (r < I_DD) { tr_item(p.w_out + (size_t)l * D * D, D, MapId{}, p.WOUT + (size_t)l * D * D, D, 64 * (r / 32), 32 * (r % 32), scr, lane); continue; } r -= I_DD;
            if (r < I_DD) { tr_item(p.ple_wg + (size_t)l * D * D, D, MapId{}, p.WPG + (size_t)l * D * D, D, 64 * (r / 32), 32 * (r % 32), scr, lane, p.ple_g + l * D); continue; } r -= I_DD;
            tr_item(p.ple_wp + (size_t)l * PLE * D, D, MapId{}, p.WPP + (size_t)l * D * PLE, PLE, 64 * (r / 32), 32 * (r % 32), scr, lane); continue; }
        r -= DEPTH * PER_L;
        if (r < 18 * I_GU) { const int mt = r / I_GU; r %= I_GU; const int k0 = 64 * (r / (NGU / 32)), n0 = 32 * (r % (NGU / 32)); const int tl = n0 / 256, rr = n0 % 256;
            const float* src; bf16* dst;
            if (mt < 2) { src = (rr < 128 ? p.dwg : p.dwu) + (size_t)mt * D * DFF; dst = p.DWGU + (size_t)mt * NGU * D; } else { src = (rr < 128 ? p.mwg : p.mwu) + (size_t)(mt - 2) * D * DFF; dst = p.MWGU + (size_t)(mt - 2) * NGU * D; }
            const int Lg = mt < 2 ? 2 * mt : 2 * ((mt - 2) >> 3) + 1;
            tr_item(src, DFF, MapOff{tl * 128 + (rr & 127) - n0}, dst, D, k0, n0, scr, lane, p.ffn_g + Lg * D); continue; }
        r -= 18 * I_GU;
        { const int mt = r / I_DN; r %= I_DN; const float* src; bf16* dst;
            if (mt < 2) { src = p.dwd + (size_t)mt * DFF * D; dst = p.DWD + (size_t)mt * D * DFF; } else { src = p.mwd + (size_t)(mt - 2) * DFF * D; dst = p.MWD + (size_t)(mt - 2) * D * DFF; }
            tr_item(src, D, MapId{}, dst, DFF, 64 * (r / 32), 32 * (r % 32), scr, lane); }
    }
    const long g0 = (long)bx * 512 + tid, gs = (long)G * 512;
    for (long t = gw; t < p.T; t += NGW) { const f32x4* xr = (const f32x4*)(p.x + t * D) + lane; u32x2* o = (u32x2*)(p.HB + t * D) + lane; float ss = 0.f;
#pragma unroll
        for (int j = 0; j < 4; ++j) { const f32x4 v = xr[64 * j]; u32x2 wv; wv.x = pk2(v.x, v.y); wv.y = pk2(v.z, v.w); o[64 * j] = wv; const float a = blo(wv.x), b = bhi(wv.x), c = blo(wv.y), d = bhi(wv.y); ss += (a * a + b * b) + (c * c + d * d); }
        ss = wave_sum(ss); if (lane < 16) rss_ptr(p, 0, 0)[t * 16 + lane] = lane == 0 ? ss : 0.f; }
    for (long i = g0; i < (long)DEPTH * p.T * PLE / 4; i += gs) { const f32x4 v = ((const f32x4*)p.p)[i]; u32x2 o; o.x = pk2(v.x, v.y); o.y = pk2(v.z, v.w); ((u32x2*)p.PB16)[i] = o; }
    for (long i = g0; i < p.T * 16; i += gs) { const long t = i / 16; const int j = (int)(i % 16); const float inv = powf(10000.0f, -(float)(2 * j) / 32.0f), ang = (float)p.pos[t] * inv;
        p.CS[t * 32 + j] = cosf(ang); p.CS[t * 32 + 16 + j] = sinf(ang); }
}
__device__ __forceinline__ void unpack8(const u32x4 q, float (&v)[8]) {
#pragma unroll
    for (int i = 0; i < 4; ++i) { v[2 * i] = blo(q[i]); v[2 * i + 1] = bhi(q[i]); } }
__device__ __forceinline__ u32x4 pack8(const float (&v)[8]) { u32x4 q; q.x = pk2(v[0], v[1]); q.y = pk2(v[2], v[3]); q.z = pk2(v[4], v[5]); q.w = pk2(v[6], v[7]); return q; }
template <int MODE> __device__ __forceinline__ void norm_phase(const MP& p, int L, const float* g, bf16* hb, int bx, int G, FLAS unsigned* lcnt = nullptr, const bf16* part = nullptr) {
    const int tid = mk_tid(), lane = tid & 63, wave = __builtin_amdgcn_readfirstlane(tid >> 6);
    const int gw = bx * 8 + wave, NGW = G * 8;
    bf16* const HBN = (bf16*)p.H;
    f32x4 Rr[MODE == 1 ? 32 : 1];
    if (MODE == 1) { __syncthreads(); if (tid < NE) lcnt[tid] = 0u; __syncthreads(); const f32x4* R = (const f32x4*)(p.router + (size_t)(L >> 1) * D * NE);
#pragma unroll
        for (int c = 0; c < 2; ++c)
#pragma unroll
            for (int i = 0; i < 8; ++i) { const int idx = 512 * c + 8 * lane + i; Rr[(c * 8 + i) * 2] = R[idx * 2]; Rr[(c * 8 + i) * 2 + 1] = R[idx * 2 + 1]; } }
    constexpr int RB = 4;
    for (long tb = gw; tb < p.T; tb += (long)RB * NGW) {
        u32x4 hq[RB][2]; int sl[RB][2]; float gt[RB][2]; u32x4 yq[RB][2][2]; bool ok[RB];
#pragma unroll
        for (int r = 0; r < RB; ++r) { const long t = tb + (long)r * NGW; ok[r] = t < p.T; const long tt = ok[r] ? t : tb; const u32x4* hr = (const u32x4*)(hb + tt * D) + lane; hq[r][0] = hr[0]; hq[r][1] = hr[64];
            if (MODE == 2) { sl[r][0] = p.TOKSLOT[tt * 2]; sl[r][1] = p.TOKSLOT[tt * 2 + 1]; gt[r][0] = p.TOPG[tt * 2]; gt[r][1] = p.TOPG[tt * 2 + 1]; } }
        if (MODE == 2) {
#pragma unroll
            for (int r = 0; r < RB; ++r)
#pragma unroll
                for (int k = 0; k < 2; ++k) { const u32x4* y0 = (const u32x4*)(p.YS + (size_t)sl[r][k] * D) + lane; yq[r][k][0] = y0[0]; yq[r][k][1] = y0[64]; } }
        __builtin_amdgcn_sched_barrier(0);
#pragma unroll
        for (int r = 0; r < RB; ++r) if (ok[r]) { const long t = tb + (long)r * NGW; float v[2][8]; unpack8(hq[r][0], v[0]); unpack8(hq[r][1], v[1]);
            if (MODE == 2) { const int row0p = p.TILE_E[1000], ksn = p.TILE_E[1001]; const size_t pstride = (size_t)p.TILE_E[1002] * D;
#pragma unroll
                for (int k = 0; k < 2; ++k) { float acc[2][8]; unpack8(yq[r][k][0], acc[0]); unpack8(yq[r][k][1], acc[1]);
                    if (sl[r][k] >= row0p) for (int s = 1; s < ksn; ++s) { const u32x4* yp = (const u32x4*)(part + (size_t)(s - 1) * pstride + (size_t)(sl[r][k] - row0p) * D) + lane; float r0[8], r1[8]; unpack8(yp[0], r0); unpack8(yp[64], r1);
#pragma unroll
                        for (int i = 0; i < 8; ++i) { acc[0][i] += r0[i]; acc[1][i] += r1[i]; } }
#pragma unroll
                    for (int c = 0; c < 2; ++c)
#pragma unroll
                        for (int i = 0; i < 8; ++i) v[c][i] += gt[r][k] * acc[c][i]; }
                const u32x4 w0 = pack8(v[0]), w1 = pack8(v[1]); u32x4* hr = (u32x4*)(hb + t * D) + lane; hr[0] = w0; hr[64] = w1; unpack8(w0, v[0]); unpack8(w1, v[1]); }
            float ss = 0.f;
#pragma unroll
            for (int c = 0; c < 2; ++c)
#pragma unroll
                for (int i = 0; i < 8; ++i) ss += v[c][i] * v[c][i];
            ss = wave_sum(ss);
            const float rn = 1.0f / sqrtf(ss * (1.0f / D) + RMS_EPS);
            if (MODE == 2) { if (lane < 16) rss_ptr(p, L, 2)[t * 16 + lane] = lane == 0 ? ss : 0.f; }
            if (MODE == 1) { u32x4* o = (u32x4*)(HBN + t * D) + lane; float n0[8], n1[8];
#pragma unroll
                for (int i = 0; i < 8; ++i) { n0[i] = v[0][i] * rn; n1[i] = v[1][i] * rn; }
                o[0] = pack8(n0); o[64] = pack8(n1); }
            if (MODE == 1 || MODE == 3) {
#pragma unroll
                for (int c = 0; c < 2; ++c) { const f32x4 g0 = *(const f32x4*)(g + 512 * c + 8 * lane), g1 = *(const f32x4*)(g + 512 * c + 8 * lane + 4);
                    v[c][0] *= rn * g0.x; v[c][1] *= rn * g0.y; v[c][2] *= rn * g0.z; v[c][3] *= rn * g0.w; v[c][4] *= rn * g1.x; v[c][5] *= rn * g1.y; v[c][6] *= rn * g1.z; v[c][7] *= rn * g1.w; } }
            if (MODE == 3) {
#pragma unroll
                for (int c = 0; c < 2; ++c) { f32x4* o = (f32x4*)(p.out + t * D + 512 * c + 8 * lane); o[0] = (f32x4){v[c][0], v[c][1], v[c][2], v[c][3]}; o[1] = (f32x4){v[c][4], v[c][5], v[c][6], v[c][7]}; }
            }
            if (MODE == 1) { float lg[NE];
#pragma unroll
                for (int e = 0; e < NE; ++e) lg[e] = 0.f;
#pragma unroll
                for (int c = 0; c < 2; ++c)
#pragma unroll
                    for (int i = 0; i < 8; ++i) { const f32x4 r0 = Rr[(c * 8 + i) * 2], r1 = Rr[(c * 8 + i) * 2 + 1]; const float x = v[c][i];
                        lg[0] += x * r0.x; lg[1] += x * r0.y; lg[2] += x * r0.z; lg[3] += x * r0.w; lg[4] += x * r1.x; lg[5] += x * r1.y; lg[6] += x * r1.z; lg[7] += x * r1.w; }
#pragma unroll
                for (int e = 0; e < NE; ++e) lg[e] = wave_sum(lg[e]);
                int e0 = 0; float v0 = lg[0];
#pragma unroll
                for (int e = 1; e < NE; ++e) if (lg[e] > v0) { v0 = lg[e]; e0 = e; }
                int e1 = -1; float v1 = -3.0e38f;
#pragma unroll
                for (int e = 0; e < NE; ++e) if (e != e0 && lg[e] > v1) { v1 = lg[e]; e1 = e; }
                if (lane == 0) { const float g1 = 1.0f / (1.0f + expf(v0 - v1));
                    p.TOPE[t * 2] = e0; p.TOPE[t * 2 + 1] = e1; p.TOPG[t * 2] = 1.0f - g1; p.TOPG[t * 2 + 1] = g1;
                    p.POS[t * 2] = (int)__hip_atomic_fetch_add(lcnt + e0, 1u, __ATOMIC_RELAXED, __HIP_MEMORY_SCOPE_WORKGROUP); p.POS[t * 2 + 1] = (int)__hip_atomic_fetch_add(lcnt + e1, 1u, __ATOMIC_RELAXED, __HIP_MEMORY_SCOPE_WORKGROUP); } }
        }
    }
    if (MODE == 1) { __syncthreads(); if (tid < NE) p.BCNT[bx * NE + tid] = (int)lcnt[tid]; }
}
__device__ __forceinline__ void moeplan(const MP& p, int L, FLAS unsigned char* lds, int bx, int G) {
    const int tid = mk_tid(), lane = tid & 63, wave = __builtin_amdgcn_readfirstlane(tid >> 6), j = L >> 1;
    const int gw = bx * 8 + wave, NGW = G * 8;
    FLAS int* base = (FLAS int*)lds;
    FLAS int* pst = (FLAS int*)(lds + 16384);
    __syncthreads();
    {
        const int e = wave; int c[4], s = 0;
#pragma unroll
        for (int i = 0; i < 4; ++i) { const int b = lane * 4 + i; c[i] = b < G ? p.BCNT[b * NE + e] : 0; s += c[i]; }
        int inc = s;
#pragma unroll
        for (int o = 1; o < 64; o <<= 1) { const int t = __shfl_up(inc, o); if (lane >= o) inc += t; }
        int ex = inc - s;
#pragma unroll
        for (int i = 0; i < 4; ++i) { const int b = lane * 4 + i; if (b < G) base[b * NE + e] = ex; ex += c[i]; }
        if (lane == 63) pst[e] = inc;
    }
    __syncthreads();
    if (tid == 0) { int o = 0; for (int e = 0; e < NE; ++e) { const int cnt = pst[e]; pst[e] = o; if (bx == 0) cnt_ptr(p, j)[e] = (unsigned)cnt; o += ((cnt + 255) / 256) * 256; } pst[NE] = o; }
    __syncthreads();
    for (long i = gw; i < p.T * 2; i += NGW) { const long t = i >> 1; const int e = p.TOPE[i], blk = (int)((t % NGW) >> 3); const int slot = pst[e] + base[blk * NE + e] + p.POS[i]; if (lane == 0) p.TOKSLOT[i] = slot;
        const u32x4* s = (const u32x4*)((const bf16*)p.H + t * D) + lane; u32x4* d = (u32x4*)(p.XB + (size_t)slot * D) + lane; const u32x4 a = s[0], b = s[64]; d[0] = a; d[64] = b; }
    if (bx == 0) for (int i = tid; i < 1024; i += 512) { int e = -1; if (i * 256 < pst[NE]) { e = 0; for (int q = 1; q < NE; ++q) if (i * 256 >= pst[q]) e = q; } p.TILE_E[i] = e; }
    __syncthreads();
}
typedef short bf16x8 __attribute__((ext_vector_type(8)));
typedef short bf16x4 __attribute__((ext_vector_type(4)));
constexpr int AT_KP = 112, AT_VP = 136, AT_KBYTES = 128 * AT_KP * 2, AT_BUF = AT_KBYTES + 80 * AT_VP * 2;
__device__ __forceinline__ void attn_phase(const MP& p, FLAS unsigned char* lds, int bx, int G) {
    const int S = (int)p.S, nunits = (int)p.B * 4 * 8;
    const int vcu = (G % 8 == 0) ? (bx % 8) * (G / 8) + bx / 8 : bx;
    { const int tid0 = mk_tid(); __syncthreads();
      for (int e = tid0; e < 2 * 16 * AT_VP; e += 512) { const int bufi = e / (16 * AT_VP), r = (e % (16 * AT_VP)) / AT_VP, c = e % AT_VP; ((FLAS bf16*)(lds + bufi * AT_BUF + AT_KBYTES))[(64 + r) * AT_VP + c] = r == 0 ? (bf16)0x3f80 : (bf16)0; } }
    for (int u = vcu; u < nunits; u += G) {
        const int tid = mk_tid(), lane = tid & 63, w = __builtin_amdgcn_readfirstlane(tid >> 6), fr = lane & 15, fq = lane >> 4;
        int kro[3], kco[3];
#pragma unroll
        for (int i = 0; i < 3; ++i) { const int c = tid + 512 * i; kro[i] = c / 12; kco[i] = c % 12; }
        const int vd = tid >> 4, vkc = tid & 15;
        const int bh = u >> 3, jp = u & 7, b = bh >> 2, h = bh & 3;
        const bf16* Kg = p.KK + (size_t)b * S * 384 + h * 96; const bf16* Vg = p.V + (size_t)bh * 64 * S;
        for (int half = 0; half < 2; ++half) {
            const int qb = half ? 15 - jp : jp, q0 = qb * 128, qmin = q0 + 16 * w, qglob = qmin + fr;
            const size_t trow = (size_t)b * S + qglob;
            bf16x8 qf[3];
#pragma unroll
            for (int ks = 0; ks < 3; ++ks) qf[ks] = *(const bf16x8*)(p.Q + trow * 384 + h * 96 + ks * 32 + fq * 8);
            f32x4 o[5];
#pragma unroll
            for (int dt = 0; dt < 5; ++dt) o[dt] = (f32x4){0.f, 0.f, 0.f, 0.f};
            float m = -1e30f;
            const int nkt = qb + 1;
            u32x4 rk[3], rv[2];
#define AT_LOAD(kt_) do { const size_t kb_ = (size_t)(kt_) * 128; _Pragma("unroll") for (int i = 0; i < 3; ++i) rk[i] = *(const u32x4*)(Kg + (kb_ + kro[i]) * 384 + kco[i] * 8); \
            _Pragma("unroll") for (int i = 0; i < 2; ++i) rv[i] = *(const u32x4*)(Vg + (size_t)(vd + 32 * i) * S + kb_ + vkc * 8); } while (0)
#define AT_WRITE(buf_) do { FLAS bf16* Kw = (FLAS bf16*)(lds + (buf_) * AT_BUF); FLAS bf16* Vw = (FLAS bf16*)(lds + (buf_) * AT_BUF + AT_KBYTES); \
            _Pragma("unroll") for (int i = 0; i < 3; ++i) *(FLAS u32x4*)(Kw + kro[i] * AT_KP + kco[i] * 8) = rk[i]; \
            _Pragma("unroll") for (int i = 0; i < 2; ++i) *(FLAS u32x4*)(Vw + (vd + 32 * i) * AT_VP + vkc * 8) = rv[i]; } while (0)
            AT_LOAD(0);
            __syncthreads();
            AT_WRITE(0);
            __syncthreads();
            for (int kt = 0; kt < nkt; ++kt) {
                const bool more = kt + 1 < nkt;
                TP_BEGIN(18, lds); if (more) AT_LOAD(kt + 1); TP_END(18, lds); TP_BEGIN(19, lds);
                const FLAS bf16* Ks = (const FLAS bf16*)(lds + (kt & 1) * AT_BUF); const FLAS bf16* Vt = (const FLAS bf16*)(lds + (kt & 1) * AT_BUF + AT_KBYTES);
                f32x4 s[8];
#pragma unroll
                for (int sub = 0; sub < 8; ++sub) { s[sub] = (f32x4){0.f, 0.f, 0.f, 0.f};
#pragma unroll
                    for (int ks = 0; ks < 3; ++ks) { const bf16x8 a = *(const FLAS bf16x8*)(Ks + (sub * 16 + fr) * AT_KP + ks * 32 + fq * 8); s[sub] = __builtin_amdgcn_mfma_f32_16x16x32_bf16(a, qf[ks], s[sub], 0, 0, 0); } }
                if (kt == qb) {
#pragma unroll
                    for (int sub = 0; sub < 8; ++sub)
#pragma unroll
                        for (int j = 0; j < 4; ++j) if (16 * sub + 4 * fq + j > 16 * w + fr) s[sub][j] = -1e30f; }
                float t0 = __builtin_fmaxf(__builtin_fmaxf(s[0][0], s[0][1]), s[0][2]), t1 = __builtin_fmaxf(__builtin_fmaxf(s[0][3], s[1][0]), s[1][1]);
                t0 = __builtin_fmaxf(__builtin_fmaxf(t0, s[1][2]), s[1][3]);
#pragma unroll
                for (int sub = 2; sub < 8; sub += 2) { t0 = __builtin_fmaxf(__builtin_fmaxf(t0, s[sub][0]), s[sub][1]); t1 = __builtin_fmaxf(__builtin_fmaxf(t1, s[sub][2]), s[sub][3]);
                    t0 = __builtin_fmaxf(__builtin_fmaxf(t0, s[sub + 1][0]), s[sub + 1][1]); t1 = __builtin_fmaxf(__builtin_fmaxf(t1, s[sub + 1][2]), s[sub + 1][3]); }
                float tmax = __builtin_fmaxf(t0, t1);
                tmax = __builtin_fmaxf(tmax, __shfl_xor(tmax, 16)); tmax = __builtin_fmaxf(tmax, __shfl_xor(tmax, 32));
                const float mn = __builtin_fmaxf(m, tmax), alpha = __builtin_amdgcn_exp2f(m - mn); m = mn;
#pragma unroll
                for (int sub = 0; sub < 8; ++sub)
#pragma unroll
                    for (int j = 0; j < 4; ++j) s[sub][j] = __builtin_amdgcn_exp2f(s[sub][j] - mn);
#pragma unroll
                for (int dt = 0; dt < 5; ++dt) o[dt] *= alpha;
#pragma unroll
                for (int k2 = 0; k2 < 4; ++k2) {
                    u32x4 pw; pw.x = pk2(s[2 * k2][0], s[2 * k2][1]); pw.y = pk2(s[2 * k2][2], s[2 * k2][3]); pw.z = pk2(s[2 * k2 + 1][0], s[2 * k2 + 1][1]); pw.w = pk2(s[2 * k2 + 1][2], s[2 * k2 + 1][3]);
                    const bf16x8 pf = __builtin_bit_cast(bf16x8, pw);
#pragma unroll
                    for (int dt = 0; dt < 5; ++dt) { const FLAS bf16* vp = Vt + (dt * 16 + fr) * AT_VP + 32 * k2 + 4 * fq;
                        const u32x2 v0 = *(const FLAS u32x2*)vp, v1 = *(const FLAS u32x2*)(vp + 16); u32x4 vw; vw.x = v0.x; vw.y = v0.y; vw.z = v1.x; vw.w = v1.y;
                        o[dt] = __builtin_amdgcn_mfma_f32_16x16x32_bf16(__builtin_bit_cast(bf16x8, vw), pf, o[dt], 0, 0, 0); } }
                TP_END(19, lds); TP_BEGIN(20, lds); if (more) AT_WRITE((kt + 1) & 1);
                __syncthreads(); TP_END(20, lds);
            }
#undef AT_LOAD
#undef AT_WRITE
            const float l = __shfl(o[4][0], fr);
            const float rl = 1.0f / l;
            FLAS unsigned char* ostg = lds + 2 * AT_BUF + w * (16 * 144);
#pragma unroll
            for (int dt = 0; dt < 4; ++dt) { u32x2 ow; ow.x = pk2(o[dt][0] * rl, o[dt][1] * rl); ow.y = pk2(o[dt][2] * rl, o[dt][3] * rl); *(FLAS u32x2*)(ostg + fr * 144 + (dt * 16 + 4 * fq) * 2) = ow; }
            FP_LDS_WAIT(); asm volatile("" ::: "memory");
            tile_out<16, 128, 144, 64>(ostg, (unsigned char*)(p.YC + ((size_t)b * S + qmin) * D + 768 + h * 64), (size_t)D * 2, lane);
            FP_LDS_WAIT(); asm volatile("" ::: "memory");
        }
    }
    __syncthreads();
}
__device__ __forceinline__ void conv_module(const MP& p, int L, FLAS unsigned char* lds, int bx, int G) {
    FLAS float* Gs = (FLAS float*)lds;
    const int S = (int)p.S, nchunk = S / 64, nitems = (int)p.B * nchunk;
    for (int it = bx; it < nitems; it += G) {
        const int tid = mk_tid(), lane = tid & 63, w = __builtin_amdgcn_readfirstlane(tid >> 6);
        const int ck = it % nchunk, b = it / nchunk, s0 = ck * 64;
        __syncthreads();
        const int ch = (w & 3) * 64 + lane, tb = (w >> 2) * 32; float wj[CK];
#pragma unroll
        for (int j = 0; j < CK; ++j) wj[j] = p.cdw_w[(L * CK + j) * 256 + ch];
        const float bias = p.cdw_b[L * 256 + ch], lg = p.cln_g[L * 256 + ch], lb = p.cln_b[L * 256 + ch];
        u32x4 rv[6], rg[6];
#pragma unroll
        for (int i = 0; i < 6; ++i) { const int idx = tid + 512 * i, row = idx >> 5, c = idx & 31, sp = s0 - 30 + row; rv[i] = (u32x4){0u, 0u, 0u, 0u}; rg[i] = rv[i];
            if (idx < 94 * 32 && sp >= 0) { const bf16* u = p.U + ((size_t)b * S + sp) * NU + c * 8; rv[i] = *(const u32x4*)u; rg[i] = *(const u32x4*)(u + 256); } }
        __builtin_amdgcn_sched_barrier(0);
#pragma unroll
        for (int i = 0; i < 6; ++i) { const int idx = tid + 512 * i, row = idx >> 5, c = idx & 31;
            if (idx < 94 * 32) { const unsigned v[4] = {rv[i].x, rv[i].y, rv[i].z, rv[i].w}, g[4] = {rg[i].x, rg[i].y, rg[i].z, rg[i].w}; f32x4 o0, o1;
                o0.x = blo(v[0]) / (1.0f + __expf(-blo(g[0]))); o0.y = bhi(v[0]) / (1.0f + __expf(-bhi(g[0]))); o0.z = blo(v[1]) / (1.0f + __expf(-blo(g[1]))); o0.w = bhi(v[1]) / (1.0f + __expf(-bhi(g[1])));
                o1.x = blo(v[2]) / (1.0f + __expf(-blo(g[2]))); o1.y = bhi(v[2]) / (1.0f + __expf(-bhi(g[2]))); o1.z = blo(v[3]) / (1.0f + __expf(-blo(g[3]))); o1.w = bhi(v[3]) / (1.0f + __expf(-bhi(g[3])));
                *(FLAS f32x4*)(Gs + row * 256 + c * 8) = o0; *(FLAS f32x4*)(Gs + row * 256 + c * 8 + 4) = o1; } }
        __syncthreads();
#pragma unroll 1
        for (int i8 = 0; i8 < 4; ++i8) { const int tl0 = tb + 8 * i8; float win[38], acc[8];
#pragma unroll
            for (int r = 0; r < 38; ++r) win[r] = Gs[(tl0 + r) * 256 + ch];
#pragma unroll
            for (int q = 0; q < 8; ++q) { float a = bias;
#pragma unroll
                for (int j = 0; j < CK; ++j) a += wj[j] * win[q + j];
                acc[q] = a; }
            float mu[8], var[8];
#pragma unroll
            for (int q = 0; q < 8; ++q) { mu[q] = wave_sum(acc[q]) * (1.0f / 64.f); acc[q] -= mu[q]; }
#pragma unroll
            for (int q = 0; q < 8; ++q) var[q] = wave_sum(acc[q] * acc[q]);
#pragma unroll
            for (int q = 0; q < 8; ++q) { const float hn = acc[q] * (1.0f / sqrtf(var[q] * (1.0f / 64.f) + LN_EPS)) * lg + lb; ((FLAS bf16*)(lds + 94 * 256 * 4 + w * (32 * 144)))[(8 * i8 + q) * 72 + lane] = f2bf(hn / (1.0f + __expf(-hn))); } }
        FP_LDS_WAIT(); asm volatile("" ::: "memory");
        tile_out<32, 128, 144, 64>(lds + 94 * 256 * 4 + w * (32 * 144), (unsigned char*)(p.YC + ((size_t)b * S + s0 + tb) * D + (w & 3) * 64), (size_t)D * 2, lane);
        FP_LDS_WAIT(); asm volatile("" ::: "memory");
    }
    __syncthreads();
}
constexpr int MQ_P = 264, MK_P = 136;
__device__ __forceinline__ void mla_proj(const MP& p, int L, FLAS unsigned char* lds, int bx, int G) {
    FLAS bf16* Aq = (FLAS bf16*)lds; FLAS bf16* Ak = (FLAS bf16*)(lds + 64 * MQ_P * 2);
    const int nunits = (int)(p.T / 64);
    const bf16* Wq = p.WUQ + (size_t)L * 512 * 256; const bf16* Wk = p.WUKV + (size_t)L * 512 * 128;
    for (int u = bx; u < nunits; u += G) {
        const int tid = mk_tid(), lane = tid & 63, w = __builtin_amdgcn_readfirstlane(tid >> 6), fr = lane & 15, fq = lane >> 4;
        const size_t t0 = (size_t)u * 64;
        __syncthreads();
        bf16x8 wq0[4][3], wkf[4][4];
        {
            u32x2 rq[8]; unsigned rk[8];
#pragma unroll
            for (int i = 0; i < 8; ++i) { const bf16* urow = p.U + (t0 + w * 8 + i) * NU; rq[i] = *(const u32x2*)(urow + U_CQ + lane * 4); rk[i] = *(const unsigned*)(urow + U_CKV + lane * 2); }
            const f32x4 gq = *(const f32x4*)(p.qn_g + L * 256 + lane * 4); const f32x2 gk = *(const f32x2*)(p.kvn_g + L * 128 + lane * 2);
#pragma unroll
            for (int k4 = 0; k4 < 4; ++k4)
#pragma unroll
                for (int ct = 0; ct < 3; ++ct) wq0[k4][ct] = *(const bf16x8*)(Wq + (size_t)(48 * w + 16 * ct + fr) * 256 + k4 * 32 + fq * 8);
#pragma unroll
            for (int ks = 0; ks < 4; ++ks)
#pragma unroll
                for (int ct = 0; ct < 4; ++ct) wkf[ks][ct] = *(const bf16x8*)(Wk + (size_t)(64 * w + 16 * ct + fr) * 128 + ks * 32 + fq * 8);
            __builtin_amdgcn_sched_barrier(0);
#pragma unroll
            for (int i = 0; i < 8; ++i) { const int r = w * 8 + i;
                { const float a0 = blo(rq[i].x), a1 = bhi(rq[i].x), a2 = blo(rq[i].y), a3 = bhi(rq[i].y); const float rs = 1.0f / sqrtf(wave_sum((a0 * a0 + a1 * a1) + (a2 * a2 + a3 * a3)) * (1.0f / 256.f) + RMS_EPS);
                  u32x2 o; o.x = pk2(a0 * rs * gq.x, a1 * rs * gq.y); o.y = pk2(a2 * rs * gq.z, a3 * rs * gq.w); *(FLAS u32x2*)(Aq + r * MQ_P + lane * 4) = o; }
                { const float a0 = blo(rk[i]), a1 = bhi(rk[i]); const float rs = 1.0f / sqrtf(wave_sum(a0 * a0 + a1 * a1) * (1.0f / 128.f) + RMS_EPS); *(FLAS unsigned*)(Ak + r * MK_P + lane * 2) = pk2(a0 * rs * gk.x, a1 * rs * gk.y); } } }
#pragma unroll
        for (int e2 = 0; e2 < 2; ++e2) { const int e = tid + 512 * e2, r = e >> 4, jj = e & 15; const size_t t = t0 + r; const float x1 = bf2f(p.U[t * NU + U_KR + jj]), x2 = bf2f(p.U[t * NU + U_KR + 16 + jj]), c = p.CS[t * 32 + jj], sn = p.CS[t * 32 + 16 + jj];
            const bf16 o1 = f2bf(x1 * c - x2 * sn), o2 = f2bf(x1 * sn + x2 * c);
#pragma unroll
            for (int h = 0; h < 4; ++h) { p.KK[t * 384 + h * 96 + 64 + jj] = o1; p.KK[t * 384 + h * 96 + 80 + jj] = o2; } }
        __syncthreads();
        {
            f32x4 acc[3][4];
#pragma unroll
            for (int ct = 0; ct < 3; ++ct)
#pragma unroll
                for (int rt = 0; rt < 4; ++rt) acc[ct][rt] = (f32x4){0.f, 0.f, 0.f, 0.f};
            bf16x8 wq1[4][3];
#pragma unroll
            for (int k4 = 0; k4 < 4; ++k4)
#pragma unroll
                for (int ct = 0; ct < 3; ++ct) wq1[k4][ct] = *(const bf16x8*)(Wq + (size_t)(48 * w + 16 * ct + fr) * 256 + (4 + k4) * 32 + fq * 8);
            __builtin_amdgcn_sched_barrier(0);
#pragma unroll
            for (int k4 = 0; k4 < 4; ++k4)
#pragma unroll
                for (int rt = 0; rt < 4; ++rt) { const bf16x8 tk = *(const FLAS bf16x8*)(Aq + (rt * 16 + fr) * MQ_P + k4 * 32 + fq * 8);
#pragma unroll
                    for (int ct = 0; ct < 3; ++ct) acc[ct][rt] = __builtin_amdgcn_mfma_f32_16x16x32_bf16(wq0[k4][ct], tk, acc[ct][rt], 0, 0, 0); }
#pragma unroll
            for (int k4 = 0; k4 < 4; ++k4)
#pragma unroll
                for (int rt = 0; rt < 4; ++rt) { const bf16x8 tk = *(const FLAS bf16x8*)(Aq + (rt * 16 + fr) * MQ_P + (4 + k4) * 32 + fq * 8);
#pragma unroll
                    for (int ct = 0; ct < 3; ++ct) acc[ct][rt] = __builtin_amdgcn_mfma_f32_16x16x32_bf16(wq1[k4][ct], tk, acc[ct][rt], 0, 0, 0); }
            const bool pe = (w & 1) != 0;
#pragma unroll
            for (int rt = 0; rt < 4; ++rt) { const size_t t = t0 + rt * 16 + fr; bf16* qrow = p.Q + t * 384 + 48 * w + 4 * fq;
                f32x4 v0 = acc[0][rt], v1 = acc[1][rt], v2 = acc[2][rt];
                if (pe) { const f32x4 c = *(const f32x4*)(p.CS + t * 32 + 4 * fq), sn = *(const f32x4*)(p.CS + t * 32 + 16 + 4 * fq); const f32x4 x1 = v1, x2 = v2; v1 = x1 * c - x2 * sn; v2 = x1 * sn + x2 * c; }
                u32x2 o; o.x = pk2(v0.x * QSCALE, v0.y * QSCALE); o.y = pk2(v0.z * QSCALE, v0.w * QSCALE); *(u32x2*)qrow = o;
                o.x = pk2(v1.x * QSCALE, v1.y * QSCALE); o.y = pk2(v1.z * QSCALE, v1.w * QSCALE); *(u32x2*)(qrow + 16) = o;
                o.x = pk2(v2.x * QSCALE, v2.y * QSCALE); o.y = pk2(v2.z * QSCALE, v2.w * QSCALE); *(u32x2*)(qrow + 32) = o; }
        }
        {
            f32x4 acc[4][4];
#pragma unroll
            for (int ct = 0; ct < 4; ++ct)
#pragma unroll
                for (int rt = 0; rt < 4; ++rt) acc[ct][rt] = (f32x4){0.f, 0.f, 0.f, 0.f};
            const int h = w >> 1; const bool isv = (w & 1) != 0;
            if (!isv) {
#pragma unroll
                for (int ks = 0; ks < 4; ++ks)
#pragma unroll
                    for (int rt = 0; rt < 4; ++rt) { const bf16x8 tk = *(const FLAS bf16x8*)(Ak + (rt * 16 + fr) * MK_P + ks * 32 + fq * 8);
#pragma unroll
                        for (int ct = 0; ct < 4; ++ct) acc[ct][rt] = __builtin_amdgcn_mfma_f32_16x16x32_bf16(wkf[ks][ct], tk, acc[ct][rt], 0, 0, 0); }
#pragma unroll
                for (int rt = 0; rt < 4; ++rt) { const size_t t = t0 + rt * 16 + fr; bf16* dst = p.KK + t * 384 + h * 96 + 4 * fq;
#pragma unroll
                    for (int ct = 0; ct < 4; ++ct) { u32x2 o; o.x = pk2(acc[ct][rt].x, acc[ct][rt].y); o.y = pk2(acc[ct][rt].z, acc[ct][rt].w); *(u32x2*)(dst + 16 * ct) = o; } }
            } else {
#pragma unroll
                for (int ks = 0; ks < 4; ++ks)
#pragma unroll
                    for (int rt = 0; rt < 4; ++rt) { const bf16x8 tk = *(const FLAS bf16x8*)(Ak + (rt * 16 + fr) * MK_P + ks * 32 + fq * 8);
#pragma unroll
                        for (int ct = 0; ct < 4; ++ct) acc[ct][rt] = __builtin_amdgcn_mfma_f32_16x16x32_bf16(tk, wkf[ks][ct], acc[ct][rt], 0, 0, 0); }
                const size_t bq = t0 / p.S, sq = t0 % p.S;
#pragma unroll
                for (int ct = 0; ct < 4; ++ct) { bf16* drow = p.V + ((bq * 4 + h) * 64 + 16 * ct + fr) * p.S + sq + 4 * fq;
#pragma unroll
                    for (int rt = 0; rt < 4; ++rt) { u32x2 o; o.x = pk2(acc[ct][rt].x, acc[ct][rt].y); o.y = pk2(acc[ct][rt].z, acc[ct][rt].w); *(u32x2*)(drow + 16 * rt) = o; } }
            }
        }
    }
    __syncthreads();
}
__device__ __forceinline__ void ssd_scan(const MP& p, int bx, int G) {
    const int tid = mk_tid(); const long g0 = (long)bx * 512 + tid, gs = (long)G * 512; const int NCB = (int)(p.S / CHUNK);
    for (long i = g0; i < p.B * 8 * 64 * 32; i += gs) { const long b = i / (8 * 64 * 32), r = i % (8 * 64 * 32); const int h = (int)(r / (64 * 32)); f32x4 carry = (f32x4){0.f, 0.f, 0.f, 0.f};
        f32x4 st[16]; float dec[16];
#pragma unroll
        for (int cc = 0; cc < 16; ++cc) { const long c = b * NCB + cc; st[cc] = ((const f32x4*)p.ST)[(size_t)c * (8 * 64 * 32) + r]; dec[cc] = p.ACS[(c * CHUNK + CHUNK - 1) * 8 + h]; }
        __builtin_amdgcn_sched_barrier(0);
#pragma unroll
        for (int cc = 0; cc < 16; ++cc) { const long c = b * NCB + cc; u32x2 o; o.x = pk2(carry.x, carry.y); o.y = pk2(carry.z, carry.w); ((u32x2*)p.PV)[(size_t)c * (8 * 64 * 32) + r] = o; carry = carry * __expf(dec[cc]) + st[cc]; } }
}
constexpr int SP = 136;
constexpr int SA_DT = 0, SA_ACS = 2048, SA_CM = 4096, SA_BM = SA_CM + 128 * SP * 2, SA_XT = SA_CM, SA_BT = SA_CM + 2 * 128 * SP * 2, SA_MW = SA_BT + 128 * SP * 2, SA_END = SA_MW + 8 * 16 * SP * 2;
__device__ __forceinline__ float silu_f(float x) { return x / (1.0f + __expf(-x)); }
__device__ __forceinline__ float softplus_fast(float x) { if (x > 20.f) return x; const float e = __builtin_amdgcn_exp2f(x * 1.4426950408889634f); return e < 1e-3f ? e * (1.0f - 0.5f * e) : 0.6931471805599453f * __builtin_amdgcn_logf(1.0f + e); }
struct ConvW { f32x4 w[4][2], b[2]; };
__device__ __forceinline__ void convw_load(const MP& p, int L, int xc0, ConvW& cw) {
#pragma unroll
    for (int j = 0; j < 4; ++j) { cw.w[j][0] = *(const f32x4*)(p.sconv_w + (L * 4 + j) * 1024 + xc0); cw.w[j][1] = *(const f32x4*)(p.sconv_w + (L * 4 + j) * 1024 + xc0 + 4); }
    cw.b[0] = *(const f32x4*)(p.sconv_b + L * 1024 + xc0); cw.b[1] = *(const f32x4*)(p.sconv_b + L * 1024 + xc0 + 4);
}
__device__ __forceinline__ void conv_rows_load(const bf16* ub  , int xc0, int s0, int l0, u32x4 (&x)[11]) {
#pragma unroll
    for (int i = 0; i < 11; ++i) { const int sp = s0 + l0 - 3 + i; x[i] = (u32x4){0u, 0u, 0u, 0u}; if (i >= 3 || sp >= 0) x[i] = *(const u32x4*)(ub + (size_t)(sp < 0 ? 0 : sp) * NU + xc0); }
}
__device__ __forceinline__ float conv_elem(const u32x4 (&x)[11], const ConvW& cw, int i, int c) {
    float a = cw.b[c >> 2][c & 3];
#pragma unroll
    for (int j = 0; j < 4; ++j) { const unsigned wd = x[i + j][c >> 1]; a += cw.w[j][c >> 2][c & 3] * ((c & 1) ? bhi(wd) : blo(wd)); }
    return silu_f(a);
}
__device__ __forceinline__ void ssd_a(const MP& p, int L, FLAS unsigned char* lds, int bx, int G) {
    FLAS float* dtL = (FLAS float*)(lds + SA_DT); FLAS float* acsL = (FLAS float*)(lds + SA_ACS);
    FLAS bf16* Cm = (FLAS bf16*)(lds + SA_CM); FLAS bf16* Bm = (FLAS bf16*)(lds + SA_BM); FLAS bf16* XT = (FLAS bf16*)(lds + SA_XT); FLAS bf16* BT = (FLAS bf16*)(lds + SA_BT);
    const int S = (int)p.S, nunits = (int)(p.T / CHUNK) * 2;
    for (int u = bx; u < nunits; u += G) {
        const int tid = mk_tid(), lane = tid & 63, w = __builtin_amdgcn_readfirstlane(tid >> 6), fr = lane & 15, fq = lane >> 4;
        FLAS bf16* Mw = (FLAS bf16*)(lds + SA_MW + w * (16 * SP * 2));
        const int g = u & 1; const long c = u >> 1; const size_t t0 = (size_t)c * CHUNK; const int s0 = (int)(t0 % S); const size_t tb = t0 - s0;
        __syncthreads();
        TP_BEGIN(28, lds);
        const int cg2 = tid & 31, ts = tid >> 5, l0 = 8 * ts; const bool isC = cg2 >= 16; const int nbc = 8 * (cg2 & 15);
        const int xcb = (isC ? 768 : 512) + 128 * g + nbc, chs = 8 * cg2, xcs = 256 * g + chs;
        u32x4 xb[11], xs[11]; ConvW cwb, cws;
        const int h4 = tid >> 7, ldt = tid & 127; const bf16 dtraw = p.U[(t0 + ldt) * NU + U_DT + 4 * g + h4];
        conv_rows_load(p.U + tb * NU + U_XBC, xcb, s0, l0, xb);
        conv_rows_load(p.U + tb * NU + U_XBC, xcs, s0, l0, xs);
        convw_load(p, L, xcb, cwb); convw_load(p, L, xcs, cws);
        __builtin_amdgcn_sched_barrier(0);
        if (PROBE_CK == 11) { asm volatile("s_waitcnt vmcnt(0) lgkmcnt(0)" ::: "memory"); TP_END(28, lds); }
        dtL[h4 * 128 + ldt] = softplus_fast(bf2f(dtraw) + p.dt_bias[L * 8 + 4 * g + h4]);
        {
            FLAS bf16* rowdst = (isC ? Cm : Bm) + nbc; u32x4 colw[8];
#pragma unroll
            for (int i = 0; i < 8; ++i) { float o[8];
#pragma unroll
                for (int c = 0; c < 8; ++c) o[c] = conv_elem(xb, cwb, i, c);
                u32x4 wv; wv.x = pk2(o[0], o[1]); wv.y = pk2(o[2], o[3]); wv.z = pk2(o[4], o[5]); wv.w = pk2(o[6], o[7]); *(FLAS u32x4*)(rowdst + (l0 + i) * SP) = wv;
#pragma unroll
                for (int c = 0; c < 8; ++c) { const unsigned hv = (c & 1) ? (wv[c >> 1] >> 16) : (wv[c >> 1] & 0xffffu); if (i & 1) colw[c][i >> 1] |= hv << 16; else colw[c][i >> 1] = hv; } }
            if (!isC) {
#pragma unroll
                for (int c = 0; c < 8; ++c) *(FLAS u32x4*)(BT + (nbc + c) * SP + l0) = colw[c]; }
        }
        if (PROBE_CK == 12) { asm volatile("s_waitcnt vmcnt(0) lgkmcnt(0)" ::: "memory"); TP_END(28, lds); }
        __syncthreads();
        if (w < 4) {
            const int h = 4 * g + w; const float a = -__expf(p.a_log[L * 8 + h]); const float x0 = dtL[w * 128 + 2 * lane] * a, x1 = dtL[w * 128 + 2 * lane + 1] * a, ps = x0 + x1; float inc = ps;
#pragma unroll
            for (int o = 1; o < 64; o <<= 1) { const float t = __shfl_up(inc, o); if (lane >= o) inc += t; }
            const float ex = inc - ps, c0 = ex + x0, c1 = ex + ps; *(FLAS f32x2*)(acsL + w * 128 + 2 * lane) = (f32x2){c0, c1};
            p.ACS[(t0 + 2 * lane) * 8 + h] = c0; p.ACS[(t0 + 2 * lane + 1) * 8 + h] = c1; }
        tile_out<128, 256, SP * 2, 512>((const FLAS unsigned char*)Cm, (unsigned char*)(p.CM + t0 * 256 + g * 128), (size_t)256 * 2, tid);
        f32x4 cbT[8];
#pragma unroll
        for (int ct = 0; ct < 8; ++ct) cbT[ct] = (f32x4){0.f, 0.f, 0.f, 0.f};
#pragma unroll
        for (int ks = 0; ks < 4; ++ks) { const bf16x8 cf = *(const FLAS bf16x8*)(Cm + (16 * w + fr) * SP + ks * 32 + fq * 8);
#pragma unroll
            for (int ct = 0; ct < 8; ++ct) { const bf16x8 bfm = *(const FLAS bf16x8*)(Bm + (16 * ct + fr) * SP + ks * 32 + fq * 8); cbT[ct] = __builtin_amdgcn_mfma_f32_16x16x32_bf16(bfm, cf, cbT[ct], 0, 0, 0); } }
        __syncthreads();
        if (PROBE_CK == 13) { asm volatile("s_waitcnt vmcnt(0) lgkmcnt(0)" ::: "memory"); TP_END(28, lds); }
        {   const FLAS float* dts = dtL + (chs >> 6) * 128 + l0; const f32x4 d0 = *(const FLAS f32x4*)dts, d1 = *(const FLAS f32x4*)(dts + 4);
            const float dtv[8] = {d0.x, d0.y, d0.z, d0.w, d1.x, d1.y, d1.z, d1.w};
#pragma unroll
            for (int c = 0; c < 8; ++c) { float o[8];
#pragma unroll
                for (int i = 0; i < 8; ++i) o[i] = bf2f(f2bf(conv_elem(xs, cws, i, c))) * dtv[i];
                u32x4 wv; wv.x = pk2(o[0], o[1]); wv.y = pk2(o[2], o[3]); wv.z = pk2(o[4], o[5]); wv.w = pk2(o[6], o[7]); *(FLAS u32x4*)(XT + (chs + c) * SP + l0) = wv; } }
        if (PROBE_CK == 14) { asm volatile("s_waitcnt vmcnt(0) lgkmcnt(0)" ::: "memory"); TP_END(28, lds); }
        __syncthreads();
#pragma unroll 1
        for (int r = 0; r < 4; ++r) {
            const FLAS float* ac = acsL + r * 128; const int h = 4 * g + r; const float al = ac[16 * w + fr];
            const float dsd = p.dskip[L * 8 + h] / dtL[r * 128 + 16 * w + fr];
#pragma unroll
            for (int ct = 0; ct < 8; ++ct) { const f32x4 as = *(const FLAS f32x4*)(ac + 16 * ct + 4 * fq); const int sb = 16 * ct + 4 * fq, l = 16 * w + fr; float m0, m1, m2, m3;
                m0 = (sb + 0 <= l) ? cbT[ct].x * __expf(al - as.x) : 0.f; m1 = (sb + 1 <= l) ? cbT[ct].y * __expf(al - as.y) : 0.f; m2 = (sb + 2 <= l) ? cbT[ct].z * __expf(al - as.z) : 0.f; m3 = (sb + 3 <= l) ? cbT[ct].w * __expf(al - as.w) : 0.f;
                m0 += (sb + 0 == l) ? dsd : 0.f; m1 += (sb + 1 == l) ? dsd : 0.f; m2 += (sb + 2 == l) ? dsd : 0.f; m3 += (sb + 3 == l) ? dsd : 0.f;
                u32x2 o; o.x = pk2(m0, m1); o.y = pk2(m2, m3); *(FLAS u32x2*)(Mw + fr * SP + sb) = o; }
            FP_LDS_WAIT(); asm volatile("" ::: "memory");
            f32x4 yd[4], st[4];
#pragma unroll
            for (int pt = 0; pt < 4; ++pt) { yd[pt] = (f32x4){0.f, 0.f, 0.f, 0.f}; st[pt] = (f32x4){0.f, 0.f, 0.f, 0.f}; }
            const float alast = ac[127];
#pragma unroll
            for (int ks = 0; ks < 4; ++ks) { const bf16x8 am = *(const FLAS bf16x8*)(Mw + fr * SP + ks * 32 + fq * 8);
                const u32x4 braw = *(const FLAS u32x4*)(BT + (16 * w + fr) * SP + ks * 32 + fq * 8); const f32x4 e0 = *(const FLAS f32x4*)(ac + ks * 32 + fq * 8), e1 = *(const FLAS f32x4*)(ac + ks * 32 + fq * 8 + 4); u32x4 bs;
                bs.x = pk2(blo(braw.x) * __expf(alast - e0.x), bhi(braw.x) * __expf(alast - e0.y)); bs.y = pk2(blo(braw.y) * __expf(alast - e0.z), bhi(braw.y) * __expf(alast - e0.w));
                bs.z = pk2(blo(braw.z) * __expf(alast - e1.x), bhi(braw.z) * __expf(alast - e1.y)); bs.w = pk2(blo(braw.w) * __expf(alast - e1.z), bhi(braw.w) * __expf(alast - e1.w));
                const bf16x8 bsf = __builtin_bit_cast(bf16x8, bs);
#pragma unroll
                for (int pt = 0; pt < 4; ++pt) { const bf16x8 x = *(const FLAS bf16x8*)(XT + (r * 64 + 16 * pt + fr) * SP + ks * 32 + fq * 8);
                    yd[pt] = __builtin_amdgcn_mfma_f32_16x16x32_bf16(x, am, yd[pt], 0, 0, 0); st[pt] = __builtin_amdgcn_mfma_f32_16x16x32_bf16(bsf, x, st[pt], 0, 0, 0); } }
#pragma unroll
            for (int pt = 0; pt < 4; ++pt) { u32x2 o; o.x = pk2(yd[pt].x, yd[pt].y); o.y = pk2(yd[pt].z, yd[pt].w); *(FLAS u32x2*)((FLAS unsigned char*)Mw + fr * 144 + (16 * pt + 4 * fq) * 2) = o;
                *(f32x4*)(p.ST + (((size_t)c * 8 + h) * 64 + 16 * pt + fr) * 128 + 16 * w + 4 * fq) = st[pt]; }
            FP_LDS_WAIT(); asm volatile("" ::: "memory");
            tile_out<16, 128, 144, 64>((const FLAS unsigned char*)Mw, (unsigned char*)(p.YD + (t0 + 16 * w) * 512 + h * 64), (size_t)512 * 2, lane);
            FP_LDS_WAIT(); asm volatile("" ::: "memory");
            if (r == 0) {if (PROBE_CK == 15) { asm volatile("s_waitcnt vmcnt(0) lgkmcnt(0)" ::: "memory"); TP_END(28, lds); } }
        }
        if (PROBE_CK == 16) { asm volatile("s_waitcnt vmcnt(0) lgkmcnt(0)" ::: "memory"); TP_END(28, lds); }
    }
    __syncthreads();
}
__device__ __forceinline__ void ssd_c(const MP& p, int L, FLAS unsigned char* lds, int bx, int G) {
    const int nunits = (int)(p.T / CHUNK) * 2;
    for (int u = bx; u < nunits; u += G) {
        const int tid = mk_tid(), lane = tid & 63, w = __builtin_amdgcn_readfirstlane(tid >> 6), fr = lane & 15, fq = lane >> 4;
        const int g = u & 1; const long c = u >> 1; const size_t t0 = (size_t)c * CHUNK, t = t0 + 16 * w + fr;
        FLAS float* gnl = (FLAS float*)(lds + 8 * (16 * 528));
        __syncthreads();
        if (tid < 64) *(FLAS f32x4*)(gnl + 4 * tid) = *(const f32x4*)(p.snorm_g + L * 512 + g * 256 + 4 * tid);
        __syncthreads();
        TP_BEGIN(24, lds);
        bf16x8 cf[4];
#pragma unroll
        for (int ks = 0; ks < 4; ++ks) cf[ks] = *(const bf16x8*)(p.CM + t * 256 + g * 128 + ks * 32 + fq * 8);
        if (PROBE_CK == 1) { asm volatile("s_waitcnt vmcnt(0) lgkmcnt(0)" ::: "memory"); TP_END(24, lds); }
        f32x4 y[4][4]; float ssq = 0.f;
#pragma unroll
        for (int hp = 0; hp < 2; ++hp) { bf16x8 pvf[2][4][4];
#pragma unroll
            for (int rr = 0; rr < 2; ++rr) { const bf16* pv = p.PV + (((size_t)c * 8 + 4 * g + 2 * hp + rr) * 64) * 128;
#pragma unroll
                for (int pt = 0; pt < 4; ++pt)
#pragma unroll
                    for (int ks = 0; ks < 4; ++ks) pvf[rr][pt][ks] = *(const bf16x8*)(pv + (size_t)(32 * (pt >> 1) + 8 * (fr >> 2) + 4 * (pt & 1) + (fr & 3)) * 128 + ks * 32 + fq * 8); }
            __builtin_amdgcn_sched_barrier(0);
#pragma unroll
            for (int rr = 0; rr < 2; ++rr)
#pragma unroll
                for (int pt = 0; pt < 4; ++pt) { f32x4 acc = (f32x4){0.f, 0.f, 0.f, 0.f};
#pragma unroll
                    for (int ks = 0; ks < 4; ++ks) acc = __builtin_amdgcn_mfma_f32_16x16x32_bf16(pvf[rr][pt][ks], cf[ks], acc, 0, 0, 0);
                    y[2 * hp + rr][pt] = acc; }
            __builtin_amdgcn_sched_barrier(0); }
        if (PROBE_CK == 2) { asm volatile("s_waitcnt vmcnt(0) lgkmcnt(0)" ::: "memory"); TP_END(24, lds); }
        u32x4 ryd[4][2], rz[4][2]; float ea[4];
#pragma unroll
        for (int r = 0; r < 4; ++r) { const int h = 4 * g + r; ea[r] = p.ACS[t * 8 + h];
#pragma unroll
            for (int k = 0; k < 2; ++k) { const int ch = h * 64 + 32 * k + 8 * fq; ryd[r][k] = *(const u32x4*)(p.YD + t * 512 + ch); rz[r][k] = *(const u32x4*)(p.U + t * NU + U_Z + ch); } }
        __builtin_amdgcn_sched_barrier(0);
        if (PROBE_CK == 3) { asm volatile("s_waitcnt vmcnt(0) lgkmcnt(0)" ::: "memory"); TP_END(24, lds); }
#pragma unroll
        for (int r = 0; r < 4; ++r) { const float e = __expf(ea[r]);
#pragma unroll
            for (int pt = 0; pt < 4; ++pt) { const f32x4 acc = y[r][pt]; const unsigned d0 = ryd[r][pt >> 1][2 * (pt & 1)], d1 = ryd[r][pt >> 1][2 * (pt & 1) + 1], z0 = rz[r][pt >> 1][2 * (pt & 1)], z1 = rz[r][pt >> 1][2 * (pt & 1) + 1]; f32x4 yv;
                yv.x = (acc.x * e + blo(d0)) * silu_f(blo(z0)); yv.y = (acc.y * e + bhi(d0)) * silu_f(bhi(z0));
                yv.z = (acc.z * e + blo(d1)) * silu_f(blo(z1)); yv.w = (acc.w * e + bhi(d1)) * silu_f(bhi(z1));
                y[r][pt] = yv; ssq += (yv.x * yv.x + yv.y * yv.y) + (yv.z * yv.z + yv.w * yv.w); } }
        if (PROBE_CK == 4) { asm volatile("s_waitcnt vmcnt(0) lgkmcnt(0)" ::: "memory"); TP_END(24, lds); }
        ssq += __shfl_xor(ssq, 16); ssq += __shfl_xor(ssq, 32);
        const float rs = 1.0f / sqrtf(ssq * (1.0f / 256.f) + RMS_EPS);
        FLAS unsigned char* stg = lds + w * (16 * 528);
#pragma unroll
        for (int r = 0; r < 4; ++r)
#pragma unroll
            for (int k = 0; k < 2; ++k) { const int cl = r * 64 + 32 * k + 8 * fq; const f32x4 g0 = *(const FLAS f32x4*)(gnl + cl), g1 = *(const FLAS f32x4*)(gnl + cl + 4); const f32x4 v0 = y[r][2 * k], v1 = y[r][2 * k + 1];
                u32x4 o; o.x = pk2(v0.x * rs * g0.x, v0.y * rs * g0.y); o.y = pk2(v0.z * rs * g0.z, v0.w * rs * g0.w); o.z = pk2(v1.x * rs * g1.x, v1.y * rs * g1.y); o.w = pk2(v1.z * rs * g1.z, v1.w * rs * g1.w); *(FLAS u32x4*)(stg + fr * 528 + cl * 2) = o; }
        if (PROBE_CK == 5) { asm volatile("s_waitcnt vmcnt(0) lgkmcnt(0)" ::: "memory"); TP_END(24, lds); }
        FP_LDS_WAIT(); asm volatile("" ::: "memory");
        tile_out<16, 512, 528, 64>(stg, (unsigned char*)(p.YC + (t0 + 16 * w) * D + 256 + g * 256), (size_t)D * 2, lane);
        FP_LDS_WAIT(); asm volatile("" ::: "memory");
        if (PROBE_CK == 6) { asm volatile("s_waitcnt vmcnt(0) lgkmcnt(0)" ::: "memory"); TP_END(24, lds); }
    }
}
}

using namespace mdl;
#define LAS __attribute__((address_space(3)))
constexpr int NWAVES = 8, NTHR = NWAVES * 64;
constexpr int CW_BAR = 4096;
#define XB_TMO      128
#define XB_XCNT(j)  (256  + 64 * (j))
#define XB_XSUB(j)  (1280 + 64 * (j))
#define XB_XGEN(j)  (2304 + 64 * (j))
#define XB_TOP      3328
#define XB_TOPGEN   3392
#define XCD_BAR_WORDS 3456
#define XB_SPIN_CAP (1u << 18)

__device__ __forceinline__ unsigned xb_ld(unsigned* p)              { return __hip_atomic_load(p, __ATOMIC_RELAXED, __HIP_MEMORY_SCOPE_AGENT); }
__device__ __forceinline__ unsigned xb_add(unsigned* p, unsigned v) { return __hip_atomic_fetch_add(p, v, __ATOMIC_RELAXED, __HIP_MEMORY_SCOPE_AGENT); }
__device__ __forceinline__ unsigned xb_xcc_id() { return (unsigned)__builtin_amdgcn_s_getreg((3 << 11) | 20) & 0xFu; }
#define XB_SPIN(cond, bar) do { unsigned _sp = 0; while (cond) { __builtin_amdgcn_s_sleep(1); \
    if ((++_sp & 255u) == 0u) { if (xb_ld(&(bar)[XB_TMO])) break; if (_sp > XB_SPIN_CAP) { atomicAdd(&(bar)[XB_TMO], 1u); break; } } } } while (0)

struct XcdBarrier {
    unsigned* bar; unsigned x;
    volatile LAS unsigned* st;
};

__device__ __forceinline__ XcdBarrier xcd_barrier_post(unsigned* bar, volatile LAS unsigned* st) {
    XcdBarrier b; b.bar = bar; b.x = xb_xcc_id(); b.st = st;
    if (threadIdx.x == 0) (void)xb_add(&bar[XB_XCNT(b.x)], 1u);
    return b;
}
__device__ __forceinline__ void xcd_barrier_complete(unsigned* bar, unsigned x, unsigned& nloc, unsigned& nx) {
    const unsigned G = gridDim.x * gridDim.y * gridDim.z;
    unsigned sum, cnt, mine, sp = 0u;
    for (;;) {
        sum = 0u; cnt = 0u; mine = 0u;
#pragma unroll
        for (unsigned j = 0; j < 16; ++j) { const unsigned c = xb_ld(&bar[XB_XCNT(j)]); sum += c; cnt += (c > 0u) ? 1u : 0u; mine = (j == x) ? c : mine; }
        if (sum == G) break;
        __builtin_amdgcn_s_sleep(1);
        if ((++sp & 255u) == 0u) { if (xb_ld(&bar[XB_TMO])) break; if (sp > XB_SPIN_CAP) { atomicAdd(&bar[XB_TMO], 1u); break; } }
    }
    nloc = mine > 0u ? mine : 1u; nx = cnt > 0u ? cnt : 1u;
}

__device__ __forceinline__ void xcd_barrier(const XcdBarrier& b) {
    asm volatile("s_waitcnt vmcnt(0)" ::: "memory");
    __syncthreads();
    if (threadIdx.x == 0) {
        unsigned* bar = b.bar;
        __builtin_amdgcn_s_waitcnt(0);
        unsigned nloc = b.st[0], nx = b.st[1];
        if (nloc == 0u) { xcd_barrier_complete(bar, b.x, nloc, nx); b.st[0] = nloc; b.st[1] = nx; }
        const unsigned old = xb_add(&bar[XB_XSUB(b.x)], 1u);
        const unsigned gen = old / nloc;
        if (old + 1u == (gen + 1u) * nloc) {
            __builtin_amdgcn_fence(__ATOMIC_RELEASE, "agent");
            asm volatile("s_waitcnt vmcnt(0)" ::: "memory");
            const unsigned og = xb_add(&bar[XB_TOP], 1u);
            const unsigned tg = og / nx;
            if (og + 1u == (tg + 1u) * nx) xb_add(&bar[XB_TOPGEN], 1u);
            else XB_SPIN(xb_ld(&bar[XB_TOPGEN]) == tg, bar);
            __builtin_amdgcn_fence(__ATOMIC_ACQUIRE, "agent");
            xb_add(&bar[XB_XGEN(b.x)], 1u);
            asm volatile("s_waitcnt vmcnt(0)" ::: "memory");
        } else {
            XB_SPIN(xb_ld(&bar[XB_XGEN(b.x)]) == gen, bar);
            __builtin_amdgcn_fence(__ATOMIC_ACQUIRE, "agent");
            asm volatile("s_waitcnt vmcnt(0)" ::: "memory");
        }
    }
    __syncthreads();
}

struct Args { MP p; long flags; };
__global__ void __launch_bounds__(NTHR, 2) mk_fwd(Args a) {
    extern __shared__ __attribute__((aligned(16))) unsigned char lds[];
    LAS unsigned char* const L3 = (LAS unsigned char*)lds;
    volatile LAS unsigned* MISC = (volatile LAS unsigned*)(L3 + MISC_OFF);
    const MP& p = a.p;
    const int tid = threadIdx.x;
    for (int u = tid; u < (LDS_BYTES - LDSCTL_OFF) / 4; u += NTHR) ((LAS unsigned*)(L3 + LDSCTL_OFF))[u] = 0u;
    __syncthreads();
    const XcdBarrier bar = xcd_barrier_post(p.ctl + CW_BAR, MISC + 8);
    const int G = gridDim.x, bx = blockIdx.x;
    const long gs = (long)G * NTHR;
#define g0 ((long)bx * NTHR + mk_tid())
#ifndef PROBE_MASK
#define PROBE_MASK 0
#endif
#define REP(k) for (int rep_ = 0; rep_ < ((PROBE_MASK >> (k)) & 1) + 1; ++rep_)
#define GRID_BAR() do { REP(10) xcd_barrier(bar); } while (0)
#define PH_BEGIN(id) TP_BEGIN(id, L3)
#define PH_END(id) TP_END(id, L3)
    PH_BEGIN(0); REP(0) fp::prologue(p, L3, bx, G);
    GRID_BAR(); PH_END(0);
    for (int L = 0; L < DEPTH; ++L) {
        const int j = L >> 1; const bool moe = (L & 1) != 0;
        bf16* const hcur = (L & 1) ? p.HB2 : p.HB; bf16* const hnxt = (L & 1) ? p.HB : p.HB2;
        PH_BEGIN(1);
        REP(1) {
            pg8::Gemm g{hcur, p.WIN + (size_t)L * NU * D, (int)p.T, NU, D, D}; pg8::StaticOrder S; S.init((int)p.T, NU, G, bx);
            pg8::rstd_table(L3, rss_ptr(p, L, 0), S);
            pg8::EpiStore16 E{p.U, NU, (const LAS float*)(L3 + pg8::RSTD_TAB_OFF)}; pg8::gemm_phase<pg8::EpiStore16, pg8::StaticOrder, true, true>(L3, g, S, E);
            pg8::Gemm g2{p.PB16 + (size_t)L * p.T * PLE, p.WPP + (size_t)L * D * PLE, (int)p.T, D, PLE, PLE}; pg8::UpperHalfOrder S2; S2.init2((int)p.T, D, G, bx);
            pg8::EpiStore16 E2{p.PJ, D, nullptr}; pg8::gemm_phase<pg8::EpiStore16, pg8::UpperHalfOrder, true, true>(L3, g2, S2, E2);
        }
        GRID_BAR(); PH_END(1); PH_BEGIN(2);
        REP(6) { PH_BEGIN(13); fp::conv_module(p, L, L3, bx, G); PH_END(13); PH_BEGIN(14); fp::mla_proj(p, L, L3, bx, G); PH_END(14); PH_BEGIN(15); fp::ssd_a(p, L, L3, bx, G); PH_END(15); }
        GRID_BAR(); PH_END(2); PH_BEGIN(3);
        REP(7) { PH_BEGIN(16); fp::ssd_scan(p, bx, G); PH_END(16); PH_BEGIN(17); fp::attn_phase(p, L3, bx, G); PH_END(17); }
        GRID_BAR(); PH_END(3); PH_BEGIN(4);
        REP(8) fp::ssd_c(p, L, L3, bx, G);
        GRID_BAR(); PH_END(4); PH_BEGIN(5);
        {
            pg8::Gemm g{p.YC, p.WOUT + (size_t)L * D * D, (int)p.T, D, D, D}; pg8::StaticOrder S; S.init((int)p.T, D, G, bx);
            pg8::EpiAddH E{hcur, D, rss_ptr(p, L, 1)}; pg8::gemm_phase<pg8::EpiAddH, pg8::StaticOrder, true, true>(L3, g, S, E);
        }
        GRID_BAR(); PH_END(5);
        if (moe) { PH_BEGIN(6); fp::norm_phase<1>(p, L, p.ffn_g + L * D, hcur, bx, G, (LAS unsigned*)L3); GRID_BAR(); PH_END(6); PH_BEGIN(7); fp::moeplan(p, L, L3, bx, G); GRID_BAR(); PH_END(7); }
        PH_BEGIN(8);
        {
            const int rows = moe ? moe_start_of(p, j, NE) : (int)p.T;
            pg8::Gemm g{moe ? p.XB : hcur, moe ? p.MWGU + (size_t)j * NE * NGU * D : p.DWGU + (size_t)j * NGU * D, rows, NGU, D, D};
            pg8::ExpertOrder S; S.init(rows, NGU, G, bx); S.tile_e = moe ? p.TILE_E : nullptr;
            if (!moe) pg8::rstd_table(L3, rss_ptr(p, L, 1), S);
            REP(3) { pg8::EpiSwiglu E{p.ACT, DFF, moe ? (const LAS float*)nullptr : (const LAS float*)(L3 + pg8::RSTD_TAB_OFF)}; pg8::gemm_phase<pg8::EpiSwiglu, pg8::ExpertOrder, true, true>(L3, g, S, E); }
            GRID_BAR(); PH_END(8); PH_BEGIN(9);
            if (moe) {
                const int nwg = (rows >> 8) * 4, nfull = (nwg / G) * G, R = nwg - nfull; const int ksn = (R == 0) ? 1 : (R * 4 <= G && R <= 20 ? 4 : (R * 2 <= G && R <= 64 ? 2 : 1));
                const bf16* Wd = p.MWD + (size_t)j * NE * D * DFF; pg8::EpiMoeDown Ed{p.YS, hnxt, (size_t)R * 256 * 1024, (nfull >> 2) * 256};
                { pg8::Gemm gd{p.ACT, Wd, rows, D, DFF, DFF}; pg8::MoeDownOrder Sd{nwg, nfull, G, bx, 0, 0, p.TILE_E}; REP(4) pg8::gemm_phase<pg8::EpiMoeDown, pg8::MoeDownOrder, true, true>(L3, gd, Sd, Ed); }
                if (R > 0) { pg8::Gemm gd{p.ACT, Wd, rows, D, DFF / ksn, DFF}; pg8::MoeDownOrder Sd{nwg, nfull, G, bx, ksn, DFF / ksn, p.TILE_E}; pg8::gemm_phase<pg8::EpiMoeDown, pg8::MoeDownOrder, true, true>(L3, gd, Sd, Ed); }
                if (bx == 0 && mk_tid() == 0) { p.TILE_E[1000] = (nfull >> 2) * 256; p.TILE_E[1001] = ksn; p.TILE_E[1002] = R * 256; }
            } else {
                pg8::Gemm gd{p.ACT, p.DWD + (size_t)j * D * DFF, rows, D, DFF, DFF}; pg8::StaticOrder Sd; Sd.init(rows, D, G, bx);
                REP(4) { pg8::EpiAddH Ed{hcur, D, rss_ptr(p, L, 2)}; pg8::gemm_phase<pg8::EpiAddH, pg8::StaticOrder, true, true>(L3, gd, Sd, Ed); }
            }
        }
        GRID_BAR(); PH_END(9);
        if (moe) { PH_BEGIN(10); fp::norm_phase<2>(p, L, nullptr, hcur, bx, G, nullptr, hnxt); GRID_BAR(); PH_END(10); }
        PH_BEGIN(11);
        {
            pg8::Gemm g{hcur, p.WPG + (size_t)L * D * D, (int)p.T, D, D, D}; pg8::StaticOrder S; S.init((int)p.T, D, G, bx);
            pg8::rstd_table(L3, rss_ptr(p, L, 2), S);
            pg8::EpiPleF E{hcur, hnxt, p.PJ, D, (const LAS float*)(L3 + pg8::RSTD_TAB_OFF), rss_ptr(p, L + 1, 0)}; pg8::gemm_phase<pg8::EpiPleF, pg8::StaticOrder, true, true>(L3, g, S, E);
        }
        GRID_BAR(); PH_END(11);
    }
    PH_BEGIN(12); fp::norm_phase<3>(p, 0, p.fin_g, p.HB, bx, G); PH_END(12);
    if (PROBE_T && bx == 0 && tid == 0) { const unsigned long long te_ = __builtin_amdgcn_s_memrealtime() + 4ull * MISC[2]; while (__builtin_amdgcn_s_memrealtime() < te_) __builtin_amdgcn_s_sleep(8); }
}
static void fill_params(MP& p, void* const* d_in, void* d_out, void* d_ws) {
    p.x = (const float*)d_in[0]; p.p = (const float*)d_in[1]; p.pos = (const int*)d_in[2];
    const float** w = &p.attn_g; for (int i = 3; i < 32; ++i) w[i - 3] = (const float*)d_in[i];
    p.out = (float*)d_out; p.B = 8; p.S = 2048; p.T = 16384; p.NSLOT = 2 * 16384 + 8 * 256;
    carve(p, (unsigned char*)d_ws);
}
extern "C" void kernel_launch(void* const* d_in, const int* in_sizes, int n_in, void* d_out, int out_size, void* d_ws, size_t ws_size, hipStream_t stream) {
    static int grid = 0;
    if (grid == 0) {
        MP q{}; q.T = 16384; q.NSLOT = 2 * 16384 + 8 * 256; const size_t need = carve(q, nullptr);
        if (n_in != 32 || ws_size < need) { fprintf(stderr, "kernel_launch: need %zu bytes of ws, have %zu (n_in %d)\n", need, ws_size, n_in); grid = -1; return; }
        int dev = 0, cus = 0, per_cu = 0;
        if (hipGetDevice(&dev) != hipSuccess || hipDeviceGetAttribute(&cus, hipDeviceAttributeMultiprocessorCount, dev) != hipSuccess) { grid = -1; return; }
        if (hipFuncSetAttribute((const void*)mk_fwd, hipFuncAttributeMaxDynamicSharedMemorySize, LDS_BYTES) != hipSuccess) { fprintf(stderr, "kernel_launch: hipFuncSetAttribute failed\n"); grid = -1; return; }
        if (hipOccupancyMaxActiveBlocksPerMultiprocessor(&per_cu, (const void*)mk_fwd, NTHR, LDS_BYTES) != hipSuccess || per_cu < 1) { fprintf(stderr, "kernel_launch: occupancy query says %d\n", per_cu); }
        (void)hipGetLastError();
        grid = cus;
    }
    if (grid < 0) return;
    Args a{}; fill_params(a.p, d_in, d_out, d_ws); a.flags = 0;
    if (hipMemsetAsync(a.p.ctl, 0, CTL_WORDS * 4, stream) != hipSuccess) return;
    hipLaunchKernelGGL(mk_fwd, dim3(grid), dim3(NTHR), LDS_BYTES, stream, a);
}
```

```cpp
#include <hip/hip_runtime.h>
#include <cstdio>
#include <cstdint>
__device__ __forceinline__ int mk_tid() { int t = threadIdx.x; asm volatile("" : "+v"(t)); return t; }
#ifndef PROBE_T
#define PROBE_T 0
#endif
#ifndef PROBE_CK
#define PROBE_CK 0
#endif
constexpr int LDS_BYTES = 163840, LDSCTL_OFF = LDS_BYTES - 512, MISC_OFF = LDSCTL_OFF + 320;
#define TP_MISC(l3) ((volatile __attribute__((address_space(3))) unsigned*)((l3) + MISC_OFF))
#define TP_BEGIN(id, l3) do { if (((PROBE_T >> (id)) & 1) && blockIdx.x == 0 && threadIdx.x == 0) { const unsigned long long t_ = __builtin_amdgcn_s_memrealtime(); TP_MISC(l3)[0] = (unsigned)t_; TP_MISC(l3)[1] = (unsigned)(t_ >> 32); } } while (0)
#define TP_END(id, l3) do { if (((PROBE_T >> (id)) & 1) && blockIdx.x == 0 && threadIdx.x == 0) { const unsigned long long t0_ = ((unsigned long long)TP_MISC(l3)[1] << 32) | TP_MISC(l3)[0]; TP_MISC(l3)[2] += (unsigned)(__builtin_amdgcn_s_memrealtime() - t0_); } } while (0)

#include <cstring>
#include <cmath>
#include <cstdint>
#ifdef __HIPCC__
#define HD __host__ __device__ __forceinline__
#else
#define HD inline
#endif
typedef unsigned short bf16;
namespace mdl {
constexpr int D = 1024, DEPTH = 4, NU = 2560, NUO = 2472, DFF = 3584, NGU = 7168, NE = 8, PLE = 256;
constexpr int CK = 31, SCONV = 4, CHUNK = 128, NH = 8, HP = 64, NS = 128;
constexpr float RMS_EPS = 1e-6f, LN_EPS = 1e-5f;
constexpr float QSCALE = 0.10206207261596577f * 1.4426950408889634f;
constexpr int U_Z = 512, U_XBC = 1024, U_CQ = 2048, U_CKV = 2304, U_KR = 2432, U_DT = 2464;

HD float bf2f(bf16 v) { unsigned u = (unsigned)v << 16; float f; memcpy(&f, &u, 4); return f; }
HD bf16 f2bf(float f) { unsigned u; memcpy(&u, &f, 4); u += 0x7fffu + ((u >> 16) & 1u); return (bf16)(u >> 16); }
HD float sigmoidf_(float x) { return 1.0f / (1.0f + expf(-x)); }
HD float siluf_(float x) { return x / (1.0f + expf(-x)); }
HD float softplusf_(float x) { return x > 20.f ? x : log1pf(expf(x)); }
HD int ucol_src(int n) { return n < 2048 ? n : (n < U_DT ? n + 8 : (n < NUO ? n - U_DT + 2048 : -1)); }

struct MP {
    const float *x, *p; const int* pos;
    const float *attn_g, *w_in, *cdw_w, *cdw_b, *cln_g, *cln_b, *sconv_w, *sconv_b, *dt_bias, *a_log, *dskip, *snorm_g, *qn_g, *w_uq, *kvn_g, *w_ukv,
        *w_out, *ffn_g, *dwg, *dwu, *dwd, *router, *mwg, *mwu, *mwd, *ple_g, *ple_wg, *ple_wp, *fin_g;
    float* out;
    long B, S, T, NSLOT;
    unsigned* ctl;
    bf16 *WIN, *WUQ, *WUKV, *WOUT, *DWGU, *DWD, *MWGU, *MWD, *WPG, *WPP;
    float *RSSP, *H, *CS, *DT, *ACS, *ST, *CB, *YPRE, *TOPG;
    bf16 *HB2, *HB, *U, *YC, *Q, *KK, *V, *XS, *BM, *CM, *YD, *PV, *PB16, *PJ, *ACT, *XB, *YS;
    int *TOPE, *POS, *TOKSLOT, *TILE_E, *BCNT, *TOKIDX;
};
constexpr int CTL_WORDS = 65536;
HD unsigned* cnt_ptr(const MP& p, int j) { return p.ctl + 1024 + j * 64; }
HD float* rss_ptr(const MP& p, int L, int k) { return p.RSSP + (size_t)(L * 3 + k) * p.T * 16; }

inline size_t carve(MP& p, unsigned char* ws) {
    size_t o = 0; const size_t T = p.T, NSL = p.NSLOT;
    auto take = [&](size_t bytes) { size_t r = o; o += (bytes + 255) & ~(size_t)255; return ws + r; };
    p.ctl = (unsigned*)take(CTL_WORDS * 4);
    p.WIN = (bf16*)take((size_t)DEPTH * NU * D * 2); p.WUQ = (bf16*)take((size_t)DEPTH * 512 * 256 * 2); p.WUKV = (bf16*)take((size_t)DEPTH * 512 * 128 * 2);
    p.WOUT = (bf16*)take((size_t)DEPTH * D * D * 2); p.DWGU = (bf16*)take((size_t)2 * NGU * D * 2); p.DWD = (bf16*)take((size_t)2 * D * DFF * 2);
    p.MWGU = (bf16*)take((size_t)2 * NE * NGU * D * 2); p.MWD = (bf16*)take((size_t)2 * NE * D * DFF * 2);
    p.WPG = (bf16*)take((size_t)DEPTH * D * D * 2); p.WPP = (bf16*)take((size_t)DEPTH * D * PLE * 2);
    p.RSSP = (float*)take((size_t)13 * T * 16 * 4); p.H = (float*)take(T * D * 4);     p.HB = (bf16*)take(T * D * 2); p.HB2 = (bf16*)take(T * D * 2); p.CS = (float*)take(T * 32 * 4);
    p.PB16 = (bf16*)take((size_t)DEPTH * T * PLE * 2); p.PJ = (bf16*)take(T * D * 2);
    p.TOPE = (int*)take(T * 2 * 4); p.TOPG = (float*)take(T * 2 * 4); p.POS = (int*)take(T * 2 * 4); p.TOKSLOT = (int*)take(T * 2 * 4); p.TILE_E = (int*)take(1024 * 4); p.BCNT = (int*)take(1024 * NE * 4);
    p.XB = (bf16*)take(NSL * D * 2); p.YS = p.XB; p.TOKIDX = (int*)p.XB;
    const size_t r1 = o;
    p.U = (bf16*)take(T * NU * 2); p.YC = (bf16*)take(T * D * 2); p.Q = (bf16*)take(T * 384 * 2); p.KK = (bf16*)take(T * 384 * 2); p.V = (bf16*)take(T * 256 * 2);
    p.XS = (bf16*)take(T * 512 * 2); p.BM = (bf16*)take(T * 256 * 2); p.CM = (bf16*)take(T * 256 * 2); p.YD = (bf16*)take(T * 512 * 2);
    p.DT = (float*)take(T * 8 * 4); p.ACS = (float*)take(T * 8 * 4); p.ST = (float*)take(T / CHUNK * NH * HP * NS * 4); p.PV = (bf16*)take(T / CHUNK * NH * HP * NS * 2);
    p.CB = nullptr; p.YPRE = nullptr;
    const size_t r1end = o; o = r1;
    p.ACT = (bf16*)take(NSL * DFF * 2);
    if (o < r1end) o = r1end;
    return o;
}

HD int moe_start_of(const MP& p, int j, int E) { const unsigned* cnt = cnt_ptr(p, j); int o = 0; for (int e = 0; e < NE; ++e) if (e < E) o += (int)((cnt[e] + 255u) / 256u) * 256; return o; }
}

namespace pg8 {
#define PG8_LAS __attribute__((address_space(3)))
typedef unsigned short bf16_t;
typedef short bf16x8 __attribute__((ext_vector_type(8)));
typedef float f32x4 __attribute__((ext_vector_type(4)));
typedef unsigned u32x4 __attribute__((ext_vector_type(4)));
constexpr int BM = 256, BK = 64, HALF = 128, HTB = HALF * BK * 2  , STAGE_BYTES = 8 * HTB, NXCD = 8, WGM = 8;

__host__ __device__ __forceinline__ int lds_byte(int r, int c) { const int st = (r >> 4) * 2 + (c >> 5), rr = r & 15, cc = c & 31, ob = rr * 64 + cc * 2; return st * 1024 + (ob ^ (((ob >> 9) & 1) << 5)); }
__host__ __device__ __forceinline__ void stage_rc(int b, int& R, int& C) { const int st = b / 1024, sb = b % 1024, swz = sb ^ (((sb >> 9) & 1) << 5); R = (st >> 1) * 16 + swz / 64; C = (st & 1) * 32 + (swz % 64) / 2; }
__host__ __device__ __forceinline__ int perm32(int rho) { const int n = rho >> 4, i = rho & 15; return 8 * (i >> 2) + 4 * n + (i & 3); }

struct Unit { int pm, pn, cn, koff, ks, ui; };
struct Gemm { const bf16_t* A; const bf16_t* Bt; int M, N, K, ld; };

struct StaticOrder {
    static constexpr bool GATHER = false;
    int nM, nN, nwg, G, c;
    __host__ __device__ void init(int M, int N, int G_, int c_) { nM = M / BM; nN = N / BM; nwg = nM * nN; G = G_; c = c_; }
    __host__ __device__ bool next(int i, Unit& u) const {
        const int L = i * G + c; if (L >= nwg) return false;
        int wgid = L; { const int q = nwg / NXCD, r = nwg % NXCD, xcd = wgid % NXCD, off = wgid / NXCD; wgid = (xcd < r ? xcd * (q + 1) : r * (q + 1) + (xcd - r) * q) + off; }
        const int nig = WGM * nN, gid = wgid / nig, fm = gid * WGM, gsz = (nM - fm) < WGM ? (nM - fm) : WGM;
        u.pm = fm + ((wgid % nig) % gsz); u.pn = (wgid % nig) / gsz; u.cn = u.pn; u.koff = 0; u.ks = 0; u.ui = i; return true;
    }
    __device__ __forceinline__ void a_ready(const Unit&) const {}
    __device__ __forceinline__ void done(const Unit&) const {}
};
__device__ __forceinline__ unsigned cvt_pk_bf16(float lo, float hi) { unsigned r; asm volatile("v_cvt_pk_bf16_f32 %0, %1, %2" : "=v"(r) : "v"(lo), "v"(hi)); return r; }
typedef float f32x2 __attribute__((ext_vector_type(2)));
struct NoPre { __device__ __forceinline__ void operator()() const {} };
template <class Epi, class Sched, bool ALIGN_EPI = false, bool SP2 = false, class Pre = NoPre>
__device__ __forceinline__ void gemm_phase(PG8_LAS unsigned char* lds, const Gemm g, const Sched& S, const Epi& E, const Pre& pre = Pre()) {
    static_assert(!Sched::GATHER || SP2, "the gathered A stage is written for the SP2 loop only");
    if (Epi::TAG == PROBE_CK) TP_BEGIN(27, lds);
    const int tid = mk_tid(), wid = __builtin_amdgcn_readfirstlane(tid >> 6), lane = tid & 63, wr = wid >> 2, wc = wid & 3, fr = lane & 15, fq = lane >> 4;
    const int K = g.ld, nt = g.K / BK;
    unsigned voffA[2], voffB[2];
#pragma unroll
    for (int i = 0; i < 2; ++i) { int R, C; stage_rc(tid * 16 + i * 8192, R, C); const int Rb = Epi::PERM ? ((R & ~31) + perm32(R & 31)) : R;
        voffA[i] = Sched::GATHER ? (unsigned)C * 2u : (unsigned)(R * K + C) * 2u; voffB[i] = (unsigned)(Rb * K + C) * 2u; }
    unsigned ga[2][2];
#define PG8_GA_LOAD(uidx) do { if constexpr (Sched::GATHER) { const int _t = mk_tid(); _Pragma("unroll") for (int _i = 0; _i < 2; ++_i) { int _R, _C; stage_rc(_t * 16 + _i * 8192, _R, _C); \
        _Pragma("unroll") for (int _h = 0; _h < 2; ++_h) ga[_h][_i] = S.rowtab[(uidx) * 256 + _h * 128 + _R] + (unsigned)_C * 2u; } } } while (0)
#define PG8_STAGE_A(bufoff, gbase, h) do { if constexpr (Sched::GATHER) PG8_STAGE(bufoff, gbase, ga[h]); else PG8_STAGE(bufoff, (gbase) + (h) * hstep, voffA); } while (0)
    const size_t kstep = (size_t)(BK * 2);
    const size_t hstep = (size_t)HALF * K * 2;
    const size_t tstep = 2 * hstep;
    const unsigned ldsw = (unsigned)wid * 1024u;
    const int aoff = lds_byte(wr * 64 + fr, fq * 8), boff = lds_byte(wc * 32 + fr, fq * 8);
#define PG8_SA(b, h) (((b) * 2 + (h)) * HTB)
#define PG8_SB(b, h) ((4 + (b) * 2 + (h)) * HTB)
#define PG8_STAGE(bufoff, gbase, voff) do { _Pragma("unroll") for (int _i = 0; _i < 2; ++_i) \
        __builtin_amdgcn_global_load_lds((const unsigned*)((const char*)(gbase) + (voff)[_i]), (PG8_LAS unsigned*)(lds + (bufoff) + ldsw + _i * 8192), 16, 0, 0); } while (0)
#define PG8_LDA(dst, b, h) do { _Pragma("unroll") for (int m = 0; m < 4; ++m) _Pragma("unroll") for (int k = 0; k < 2; ++k) dst[m][k] = *(const PG8_LAS bf16x8*)(lds + PG8_SA(b, h) + aoff + m * 2048 + k * 1024); } while (0)
#define PG8_LDB(dst, b, h) do { _Pragma("unroll") for (int n = 0; n < 2; ++n) _Pragma("unroll") for (int k = 0; k < 2; ++k) dst[n][k] = *(const PG8_LAS bf16x8*)(lds + PG8_SB(b, h) + boff + n * 2048 + k * 1024); } while (0)
#define PG8_MMA(ai, bj, At, Bt) do { __builtin_amdgcn_s_setprio(1); _Pragma("unroll") for (int m = 0; m < 4; ++m) _Pragma("unroll") for (int n = 0; n < 2; ++n) _Pragma("unroll") for (int k = 0; k < 2; ++k) \
        acc[ai][bj][m][n] = __builtin_amdgcn_mfma_f32_16x16x32_bf16(Bt[n][k], At[m][k], acc[ai][bj][m][n], 0, 0, 0); __builtin_amdgcn_s_setprio(0); } while (0)
#define PG8_WAIT_V(n) asm volatile("s_waitcnt vmcnt(" #n ")" ::: "memory")
#define PG8_WAIT_L(n) asm volatile("s_waitcnt lgkmcnt(" #n ")" ::: "memory")
#define PG8_BAR __builtin_amdgcn_s_barrier()
#define PG8_SCHED __builtin_amdgcn_sched_barrier(0)
#define PG8_ZERO_ACC do { _Pragma("unroll") for (int a = 0; a < 2; ++a) _Pragma("unroll") for (int b = 0; b < 2; ++b) _Pragma("unroll") for (int m = 0; m < 4; ++m) _Pragma("unroll") for (int n = 0; n < 2; ++n) acc[a][b][m][n] = (f32x4){0.f, 0.f, 0.f, 0.f}; } while (0)
    Unit cur, nxt; int ui = 0;
    if (!S.next(0, cur)) return;
    f32x4 acc[2][2][4][2];
    bf16x8 At[4][2], B0[2][2], B1[2][2];
    const char* cA = (const char*)g.A + (Sched::GATHER ? (size_t)0 : (size_t)cur.pm * tstep) + (size_t)cur.koff * 2; const char* cB = (const char*)g.Bt + (size_t)cur.pn * tstep + (size_t)cur.koff * 2;
    S.a_ready(cur);
    PG8_GA_LOAD(0);
    if constexpr (SP2) {
        PG8_STAGE(PG8_SB(0, 0), cB, voffB); PG8_STAGE(PG8_SB(0, 1), cB + hstep, voffB); PG8_STAGE_A(PG8_SA(0, 0), cA, 0); PG8_STAGE_A(PG8_SA(0, 1), cA, 1);
        pre(); PG8_SCHED; PG8_ZERO_ACC;
        if (wr == 1) PG8_BAR;
        PG8_WAIT_V(2); PG8_BAR;
        PG8_STAGE(PG8_SB(1, 0), cB + kstep, voffB); PG8_STAGE_A(PG8_SA(1, 0), cA + kstep, 0); PG8_STAGE(PG8_SB(1, 1), cB + hstep + kstep, voffB);
        PG8_WAIT_V(6); PG8_BAR;
    } else {
        PG8_STAGE(PG8_SB(0, 0), cB, voffB); PG8_STAGE(PG8_SA(0, 0), cA, voffA); PG8_STAGE(PG8_SB(0, 1), cB + hstep, voffB); PG8_STAGE(PG8_SA(0, 1), cA + hstep, voffA);
        pre(); PG8_SCHED; PG8_ZERO_ACC;
        if (wr == 1) PG8_BAR;
        PG8_WAIT_V(4); PG8_BAR;
        PG8_STAGE(PG8_SB(1, 0), cB + kstep, voffB); PG8_STAGE(PG8_SA(1, 0), cA + kstep, voffA); PG8_STAGE(PG8_SB(1, 1), cB + hstep + kstep, voffB);
        PG8_WAIT_V(6); PG8_BAR;
    }
    for (;;) {
        const bool has_next = S.next(ui + 1, nxt);
        const char* nA = has_next ? (const char*)g.A + (Sched::GATHER ? (size_t)0 : (size_t)nxt.pm * tstep) + (size_t)nxt.koff * 2 : cA; const char* nB = has_next ? (const char*)g.Bt + (size_t)nxt.pn * tstep + (size_t)nxt.koff * 2 : cB;
#pragma unroll 1
        for (int t = 0; t < nt; t += 2) {
            const bool last = (t == nt - 2);
            const char* a1 = cA + (size_t)(t + 1) * kstep;
            const char* a2 = last ? nA : cA + (size_t)(t + 2) * kstep; const char* b2 = last ? nB : cB + (size_t)(t + 2) * kstep;
            const char* a3 = a2 + kstep; const char* b3 = b2 + kstep;
            if (last && has_next) S.a_ready(nxt);
            if constexpr (SP2) {
            PG8_LDB(B0, 0, 0); PG8_LDB(B1, 0, 1); PG8_SCHED; PG8_LDA(At, 0, 0); PG8_STAGE_A(PG8_SA(1, 1), a1, 1);
            PG8_WAIT_V(8); PG8_WAIT_L(0); PG8_BAR; PG8_MMA(0, 0, At, B0); PG8_MMA(0, 1, At, B1); PG8_BAR; PG8_SCHED;
            if constexpr (Sched::GATHER) { if (last && has_next) { PG8_GA_LOAD(ui + 1); } PG8_SCHED; }
            PG8_LDA(At, 0, 1); PG8_STAGE(PG8_SB(0, 0), b2, voffB); PG8_STAGE(PG8_SB(0, 1), b2 + hstep, voffB); PG8_STAGE_A(PG8_SA(0, 0), a2, 0);
            PG8_WAIT_V(8); PG8_WAIT_L(0); PG8_BAR; PG8_MMA(1, 0, At, B0); PG8_MMA(1, 1, At, B1); PG8_BAR; PG8_SCHED;
            PG8_LDB(B0, 1, 0); PG8_LDB(B1, 1, 1); PG8_SCHED; PG8_LDA(At, 1, 0); PG8_STAGE_A(PG8_SA(0, 1), a2, 1);
            PG8_WAIT_V(8); PG8_WAIT_L(0); PG8_BAR; PG8_MMA(0, 0, At, B0); PG8_MMA(0, 1, At, B1); PG8_BAR; PG8_SCHED;
            PG8_LDA(At, 1, 1); PG8_STAGE(PG8_SB(1, 0), b3, voffB); PG8_STAGE(PG8_SB(1, 1), b3 + hstep, voffB); PG8_STAGE_A(PG8_SA(1, 0), a3, 0);
            PG8_WAIT_V(8); PG8_WAIT_L(0); PG8_BAR; PG8_MMA(1, 0, At, B0); PG8_MMA(1, 1, At, B1); PG8_BAR; PG8_SCHED;
            } else {
            PG8_LDB(B0, 0, 0); PG8_SCHED; PG8_LDA(At, 0, 0); PG8_STAGE(PG8_SA(1, 1), a1 + hstep, voffA);
            PG8_WAIT_L(8); PG8_BAR; PG8_WAIT_L(0); PG8_MMA(0, 0, At, B0); PG8_BAR; PG8_SCHED;
            PG8_LDB(B1, 0, 1); PG8_STAGE(PG8_SB(0, 0), b2, voffB);
            PG8_BAR; PG8_WAIT_L(0); PG8_MMA(0, 1, At, B1); PG8_BAR;
            PG8_LDA(At, 0, 1); PG8_STAGE(PG8_SA(0, 0), a2, voffA);
            PG8_BAR; PG8_WAIT_L(0); PG8_MMA(1, 0, At, B0); PG8_BAR; PG8_SCHED;
            PG8_STAGE(PG8_SB(0, 1), b2 + hstep, voffB);
            PG8_WAIT_V(6); PG8_BAR; PG8_MMA(1, 1, At, B1); PG8_BAR;
            PG8_LDB(B0, 1, 0); PG8_SCHED; PG8_LDA(At, 1, 0); PG8_STAGE(PG8_SA(0, 1), a2 + hstep, voffA);
            PG8_WAIT_L(8); PG8_BAR; PG8_WAIT_L(0); PG8_MMA(0, 0, At, B0); PG8_BAR; PG8_SCHED;
            PG8_LDB(B1, 1, 1); PG8_STAGE(PG8_SB(1, 0), b3, voffB);
            PG8_BAR; PG8_WAIT_L(0); PG8_MMA(0, 1, At, B1); PG8_BAR;
            PG8_LDA(At, 1, 1); PG8_STAGE(PG8_SA(1, 0), a3, voffA);
            PG8_BAR; PG8_WAIT_L(0); PG8_MMA(1, 0, At, B0); PG8_BAR; PG8_SCHED;
            PG8_STAGE(PG8_SB(1, 1), b3 + hstep, voffB);
            PG8_WAIT_V(6); PG8_BAR; PG8_MMA(1, 1, At, B1); PG8_BAR;
            }
        }
        TP_BEGIN(26, lds); if constexpr (ALIGN_EPI) { if (wr == 0) PG8_BAR; } TP_END(26, lds);
        if (Epi::TAG == PROBE_CK) TP_BEGIN(25, lds); if constexpr (!Epi::AFTER_DRAIN) { E(acc, cur, wr, wc, fr, fq); S.done(cur); } if (((PROBE_T >> 25) & 1) && Epi::TAG == PROBE_CK) { asm volatile("s_waitcnt vmcnt(0)" ::: "memory"); TP_END(25, lds); }
        if (!has_next) break;
#pragma unroll
        for (int a = 0; a < 2; ++a)
#pragma unroll
            for (int b = 0; b < 2; ++b)
#pragma unroll
                for (int m = 0; m < 4; ++m)
#pragma unroll
                    for (int n = 0; n < 2; ++n) acc[a][b][m][n] = (f32x4){0.f, 0.f, 0.f, 0.f};
        cur = nxt; cA = nA; cB = nB; ++ui;
        if constexpr (ALIGN_EPI) { if (wr == 1) PG8_BAR; }
    }
    PG8_WAIT_V(0);
    if constexpr (!ALIGN_EPI) { if (wr == 0) PG8_BAR; }
    PG8_BAR;
    if constexpr (Epi::AFTER_DRAIN) { E.fused(acc, cur, wr, wc, fr, fq, lds, wid, lane); S.done(cur); }
    if (Epi::TAG == PROBE_CK) TP_END(27, lds);
#undef PG8_SA
#undef PG8_SB
#undef PG8_STAGE
#undef PG8_STAGE_A
#undef PG8_GA_LOAD
#undef PG8_LDA
#undef PG8_LDB
#undef PG8_MMA
#undef PG8_WAIT_V
#undef PG8_WAIT_L
#undef PG8_BAR
#undef PG8_SCHED
#undef PG8_ZERO_ACC
}
}

namespace pg8 {
__device__ __forceinline__ void store16_wt(void* base, unsigned off, u32x4 v) { const __amdgpu_buffer_rsrc_t r = __builtin_amdgcn_make_buffer_rsrc(base, (short)0, (int)0x7fffffff, 0x00020000); __builtin_amdgcn_raw_buffer_store_b128(v, r, (int)off, 0, 16); }
__device__ __forceinline__ float fast_sigmoid(float x) { return __builtin_amdgcn_rcpf(1.0f + __builtin_amdgcn_exp2f(-1.4426950408889634f * x)); }
constexpr int RSTD_TAB_OFF = STAGE_BYTES, RSTD_MAX_UNITS = 8;
template <class Sched> __device__ __forceinline__ void rstd_table(PG8_LAS unsigned char* lds, const float* rss, const Sched& S) {
    PG8_LAS float* tab = (PG8_LAS float*)(lds + RSTD_TAB_OFF); const int tid = mk_tid(), r = tid & 255, par = __builtin_amdgcn_readfirstlane(tid >> 8);
    f32x4 q[4][4]; bool ok[4];
#pragma unroll
    for (int it = 0; it < 4; ++it) { Unit u; const int ui = 2 * it + par; ok[it] = S.next(ui, u);
        if (ok[it]) { const f32x4* src = (const f32x4*)(rss + ((size_t)u.pm * BM + r) * 16);
#pragma unroll
            for (int k = 0; k < 4; ++k) q[it][k] = src[k]; } }
#pragma unroll
    for (int it = 0; it < 4; ++it) if (ok[it]) { const f32x4 a = q[it][0], b = q[it][1], c = q[it][2], d = q[it][3];
        const float s = (((a[0] + a[1]) + (a[2] + a[3])) + ((b[0] + b[1]) + (b[2] + b[3]))) + (((c[0] + c[1]) + (c[2] + c[3])) + ((d[0] + d[1]) + (d[2] + d[3])));
        tab[(2 * it + par) * 256 + r] = 1.0f / sqrtf(s * (1.0f / 1024.f) + 1e-6f); }
    asm volatile("s_waitcnt lgkmcnt(0)" ::: "memory"); __syncthreads();
}
__device__ __forceinline__ void rstd8(const PG8_LAS float* tab, int ui, int rl0, float (&rs)[8]) {
    if (!tab) {
#pragma unroll
        for (int i = 0; i < 8; ++i) rs[i] = 1.0f;
        return; }
#pragma unroll
    for (int i = 0; i < 8; ++i) rs[i] = tab[ui * 256 + rl0 + (i >> 2) * HALF + (i & 3) * 16];
}
struct EpiStore16 {
    static constexpr bool PERM = true, AFTER_DRAIN = false; static constexpr int TAG = 3;
    bf16_t* O; int ldc; const PG8_LAS float* tab;
    __device__ __forceinline__ void operator()(const f32x4 (&acc)[2][2][4][2], const Unit& u, int wr, int wc, int fr, int fq) const {
        const int row0 = u.pm * BM + wr * 64 + fr, col0 = u.cn * BM + wc * 32 + 8 * fq;
        float rs[8]; rstd8(tab, u.ui, wr * 64 + fr, rs);
#pragma unroll
        for (int ai = 0; ai < 2; ++ai)
#pragma unroll
            for (int m = 0; m < 4; ++m) { const int row = row0 + ai * HALF + m * 16; bf16_t* rowp = O + (size_t)row * ldc + col0; const float r = rs[ai * 4 + m];
#pragma unroll
                for (int bj = 0; bj < 2; ++bj) { const f32x4 v0 = acc[ai][bj][m][0] * r, v1 = acc[ai][bj][m][1] * r;
                    u32x4 w; w.x = cvt_pk_bf16(v0[0], v0[1]); w.y = cvt_pk_bf16(v0[2], v0[3]); w.z = cvt_pk_bf16(v1[0], v1[1]); w.w = cvt_pk_bf16(v1[2], v1[3]);
                    *(u32x4*)(rowp + bj * HALF) = w; } }
    }
};
__device__ __forceinline__ float sq8(const u32x4 w) { float s = 0.f;
#pragma unroll
    for (int i = 0; i < 4; ++i) { const float a = __uint_as_float(w[i] << 16), b = __uint_as_float(w[i] & 0xffff0000u); s += a * a + b * b; } return s; }
struct EpiAddH {
    static constexpr bool PERM = true, AFTER_DRAIN = false; static constexpr int TAG = 1;
    bf16_t* Hb; int ldc; float* rss_out;
    __device__ __forceinline__ void operator()(const f32x4 (&acc)[2][2][4][2], const Unit& u, int wr, int wc, int fr, int fq) const {
        const int row0 = u.pm * BM + wr * 64 + fr, col0 = u.cn * BM + wc * 32 + 8 * fq;
        u32x4 h[2][4][2];
#pragma unroll
        for (int ai = 0; ai < 2; ++ai)
#pragma unroll
            for (int m = 0; m < 4; ++m)
#pragma unroll
                for (int bj = 0; bj < 2; ++bj) h[ai][m][bj] = *(const u32x4*)(Hb + (size_t)(row0 + ai * HALF + m * 16) * ldc + col0 + bj * HALF);
        __builtin_amdgcn_sched_barrier(0);
#pragma unroll
        for (int ai = 0; ai < 2; ++ai)
#pragma unroll
            for (int m = 0; m < 4; ++m) { const int row = row0 + ai * HALF + m * 16; float ss = 0.f;
#pragma unroll
                for (int bj = 0; bj < 2; ++bj) { const u32x4 q = h[ai][m][bj]; const f32x4 a0 = acc[ai][bj][m][0], a1 = acc[ai][bj][m][1]; u32x4 w;
                    w.x = cvt_pk_bf16(__uint_as_float(q.x << 16) + a0[0], __uint_as_float(q.x & 0xffff0000u) + a0[1]); w.y = cvt_pk_bf16(__uint_as_float(q.y << 16) + a0[2], __uint_as_float(q.y & 0xffff0000u) + a0[3]);
                    w.z = cvt_pk_bf16(__uint_as_float(q.z << 16) + a1[0], __uint_as_float(q.z & 0xffff0000u) + a1[1]); w.w = cvt_pk_bf16(__uint_as_float(q.w << 16) + a1[2], __uint_as_float(q.w & 0xffff0000u) + a1[3]);
                    *(u32x4*)(Hb + (size_t)row * ldc + col0 + bj * HALF) = w; ss += sq8(w); }
                ss += __shfl_xor(ss, 16); ss += __shfl_xor(ss, 32);
                if (fq == 0) rss_out[(size_t)row * 16 + u.cn * 4 + wc] = ss; }
    }
};
template <bool SCALE> struct EpiSwigluT {
    static constexpr bool PERM = true, AFTER_DRAIN = false; static constexpr int TAG = 4;
    bf16_t* O; int ldc; const PG8_LAS float* tab;
    __device__ __forceinline__ void operator()(const f32x4 (&acc)[2][2][4][2], const Unit& u, int wr, int wc, int fr, int fq) const {
        const int row0 = u.pm * BM + wr * 64 + fr, col0 = u.cn * HALF + wc * 32 + 8 * fq;
        float rs[8]; if (SCALE) rstd8(tab, u.ui, wr * 64 + fr, rs);
#pragma unroll
        for (int ai = 0; ai < 2; ++ai)
#pragma unroll
            for (int m = 0; m < 4; ++m) { const int row = row0 + ai * HALF + m * 16; const unsigned roff = ((unsigned)row * (unsigned)ldc + (unsigned)col0) * 2u; float o[8]; const float r = SCALE ? rs[ai * 4 + m] : 1.0f;
#pragma unroll
                for (int n = 0; n < 2; ++n)
#pragma unroll
                    for (int j = 0; j < 4; ++j) { const float gt = SCALE ? acc[ai][0][m][n][j] * r : acc[ai][0][m][n][j], up = SCALE ? acc[ai][1][m][n][j] * r : acc[ai][1][m][n][j];
                        o[n * 4 + j] = gt * __builtin_amdgcn_rcpf(1.0f + __builtin_amdgcn_exp2f(-gt)) * up; }
                u32x4 w; w.x = cvt_pk_bf16(o[0], o[1]); w.y = cvt_pk_bf16(o[2], o[3]); w.z = cvt_pk_bf16(o[4], o[5]); w.w = cvt_pk_bf16(o[6], o[7]);
                store16_wt(O, roff, w); }
    }
};
typedef EpiSwigluT<true> EpiSwiglu; typedef EpiSwigluT<false> EpiSwigluN;
struct EpiPleF {
    static constexpr bool PERM = true, AFTER_DRAIN = false; static constexpr int TAG = 2;
    const bf16_t* Hin; bf16_t* Hout; const bf16_t* PJ; int ldc; const PG8_LAS float* tab; float* rss_out;
    __device__ __forceinline__ void load_grp(int row0, int col0, int grp, u32x4 (&h)[2][2], u32x4 (&pj)[2][2]) const {
#pragma unroll
        for (int mm = 0; mm < 2; ++mm)
#pragma unroll
            for (int bj = 0; bj < 2; ++bj) { const size_t off = (size_t)(row0 + (grp >> 1) * HALF + ((grp & 1) * 2 + mm) * 16) * ldc + col0 + bj * HALF; h[mm][bj] = *(const u32x4*)(Hin + off); pj[mm][bj] = *(const u32x4*)(PJ + off); }
    }
    __device__ __forceinline__ void operator()(const f32x4 (&acc)[2][2][4][2], const Unit& u, int wr, int wc, int fr, int fq) const {
        const int row0 = u.pm * BM + wr * 64 + fr, col0 = u.cn * BM + wc * 32 + 8 * fq;
        float rs[8]; rstd8(tab, u.ui, wr * 64 + fr, rs);
        u32x4 hA[2][2], pA[2][2], hB[2][2], pB[2][2];
        load_grp(row0, col0, 0, hA, pA);
#pragma unroll
        for (int grp = 0; grp < 4; ++grp) { const int ai = grp >> 1;
            if (grp < 3) { if (grp & 1) load_grp(row0, col0, grp + 1, hA, pA); else load_grp(row0, col0, grp + 1, hB, pB); }
            __builtin_amdgcn_sched_barrier(0);
#pragma unroll
            for (int mm = 0; mm < 2; ++mm) { const int m = (grp & 1) * 2 + mm, row = row0 + ai * HALF + m * 16; const float r = rs[ai * 4 + m]; float ss = 0.f;
#pragma unroll
                for (int bj = 0; bj < 2; ++bj) { const u32x4 hh = (grp & 1) ? hB[mm][bj] : hA[mm][bj], q = (grp & 1) ? pB[mm][bj] : pA[mm][bj]; u32x4 w;
#pragma unroll
                    for (int i = 0; i < 4; ++i) { const float a_lo = acc[ai][bj][m][i >> 1][(i & 1) * 2] * r, a_hi = acc[ai][bj][m][i >> 1][(i & 1) * 2 + 1] * r;
                        w[i] = cvt_pk_bf16(__uint_as_float(hh[i] << 16) + __uint_as_float(q[i] << 16) * fast_sigmoid(a_lo), __uint_as_float(hh[i] & 0xffff0000u) + __uint_as_float(q[i] & 0xffff0000u) * fast_sigmoid(a_hi)); }
                    *(u32x4*)(Hout + (size_t)row * ldc + col0 + bj * HALF) = w; ss += sq8(w); }
                ss += __shfl_xor(ss, 16); ss += __shfl_xor(ss, 32);
                if (fq == 0) rss_out[(size_t)row * 16 + u.cn * 4 + wc] = ss; }
            asm volatile("" ::: "memory"); }
    }
};
struct ExpertOrder : StaticOrder {
    const int* tile_e;
    __device__ __forceinline__ bool next(int i, Unit& u) const { if (!StaticOrder::next(i, u)) return false; if (tile_e) u.pn += tile_e[u.pm] * nN; return true; }
};
template <class Sched> struct RstdPre { PG8_LAS unsigned char* lds; const float* rss; const Sched& S; __device__ __forceinline__ void operator()() const { rstd_table(lds, rss, S); } };
constexpr int GATHER_TAB_OFF = STAGE_BYTES, GATHER_MAX_UNITS = 16;
template <class Sched> __device__ __forceinline__ void gather_table(PG8_LAS unsigned char* lds, const int* tokidx, int rowbytes, const Sched& S) {
    PG8_LAS unsigned* tab = (PG8_LAS unsigned*)(lds + GATHER_TAB_OFF); const int tid = mk_tid(), r = tid & 255, par = __builtin_amdgcn_readfirstlane(tid >> 8);
    __syncthreads();
    unsigned v[8]; bool ok[8];
#pragma unroll
    for (int it = 0; it < 8; ++it) { Unit u; ok[it] = S.StaticOrder::next(2 * it + par, u); v[it] = 0u; if (ok[it]) v[it] = (unsigned)tokidx[u.pm * 256 + r]; }
    __builtin_amdgcn_sched_barrier(0);
#pragma unroll
    for (int it = 0; it < 8; ++it) if (ok[it]) tab[(2 * it + par) * 256 + r] = v[it] * (unsigned)rowbytes;
    asm volatile("s_waitcnt lgkmcnt(0)" ::: "memory"); __syncthreads();
}
struct GatherOrder : ExpertOrder {
    static constexpr bool GATHER = true;
    const PG8_LAS unsigned* rowtab;
};
struct UpperHalfOrder : StaticOrder {
    __host__ __device__ void init2(int M, int N, int G_, int c_) { init(M, N, G_ / 2, c_ - G_ / 2); if (c_ < G_ / 2) c = nwg; }
};
struct MoeDownOrder {
    static constexpr bool GATHER = false;
    int nwg, nfull, G, c, ks_n, kslice; const int* tile_e;
    __device__ __forceinline__ bool next(int i, Unit& u) const {
        const int q = i * G + c; int L;
        if (ks_n == 0) { L = q; if (L >= nfull) return false; u.koff = 0; u.ks = 0; }
        else { if (q >= (nwg - nfull) * ks_n) return false; L = nfull + q / ks_n; u.ks = q % ks_n; u.koff = u.ks * kslice; }
        u.pm = L >> 2; u.cn = L & 3; u.pn = u.cn + tile_e[u.pm] * 4; u.ui = i; return true;
    }
    __device__ __forceinline__ void a_ready(const Unit&) const {}
    __device__ __forceinline__ void done(const Unit&) const {}
};
struct EpiMoeDown {
    static constexpr bool PERM = true, AFTER_DRAIN = false; static constexpr int TAG = 5;
    bf16_t* O; bf16_t* P; size_t pstride; int row0p;
    __device__ __forceinline__ void operator()(const f32x4 (&acc)[2][2][4][2], const Unit& u, int wr, int wc, int fr, int fq) const {
        const int col0 = u.cn * BM + wc * 32 + 8 * fq; const int rowt = u.pm * BM + wr * 64 + fr;
        bf16_t* base = u.ks == 0 ? O + (size_t)rowt * 1024 : P + (size_t)(u.ks - 1) * pstride + (size_t)(rowt - row0p) * 1024;
#pragma unroll
        for (int ai = 0; ai < 2; ++ai)
#pragma unroll
            for (int m = 0; m < 4; ++m) { bf16_t* rowp = base + (size_t)(ai * HALF + m * 16) * 1024 + col0;
#pragma unroll
                for (int bj = 0; bj < 2; ++bj) { const f32x4 v0 = acc[ai][bj][m][0], v1 = acc[ai][bj][m][1];
                    u32x4 w; w.x = cvt_pk_bf16(v0[0], v0[1]); w.y = cvt_pk_bf16(v0[2], v0[3]); w.z = cvt_pk_bf16(v1[0], v1[1]); w.w = cvt_pk_bf16(v1[2], v1[3]);
                    *(u32x4*)(rowp + bj * HALF) = w; } }
    }
};
}

namespace fp {
using namespace mdl;
#define FLAS __attribute__((address_space(3)))
typedef float f32x4 __attribute__((ext_vector_type(4)));
typedef float f32x2 __attribute__((ext_vector_type(2)));
typedef unsigned u32x4 __attribute__((ext_vector_type(4)));
typedef unsigned u32x2 __attribute__((ext_vector_type(2)));
typedef __bf16 bf16x2_t __attribute__((ext_vector_type(2)));
__device__ __forceinline__ unsigned pk2(float lo, float hi) { f32x2 v = {lo, hi}; bf16x2_t b = __builtin_convertvector(v, bf16x2_t); return __builtin_bit_cast(unsigned, b); }
__device__ __forceinline__ float blo(unsigned w) { return __uint_as_float(w << 16); }
__device__ __forceinline__ float bhi(unsigned w) { return __uint_as_float(w & 0xffff0000u); }
template <int CTRL, int ROWMASK> __device__ __forceinline__ float dpp_add(float v) {
    return v + __builtin_bit_cast(float, __builtin_amdgcn_update_dpp(0, __builtin_bit_cast(int, v), CTRL, ROWMASK, 0xF, false)); }
__device__ __forceinline__ float wave_sum(float v) {
    v = dpp_add<0xB1, 0xF>(v);
    v = dpp_add<0x4E, 0xF>(v);
    v = dpp_add<0x141, 0xF>(v);
    v = dpp_add<0x140, 0xF>(v);
    v = dpp_add<0x142, 0xA>(v);
    v = dpp_add<0x143, 0xC>(v);
    return __builtin_bit_cast(float, __builtin_amdgcn_readlane(__builtin_bit_cast(int, v), 63));
}
#define FP_LDS_WAIT() asm volatile("s_waitcnt lgkmcnt(0)" ::: "memory")
__device__ __forceinline__ void unpack8(const u32x4 q, float (&v)[8]) {
#pragma unroll
    for (int i = 0; i < 4; ++i) { v[2 * i] = blo(q[i]); v[2 * i + 1] = bhi(q[i]); } }
__device__ __forceinline__ u32x4 pack8(const float (&v)[8]) { u32x4 q; q.x = pk2(v[0], v[1]); q.y = pk2(v[2], v[3]); q.z = pk2(v[4], v[5]); q.w = pk2(v[6], v[7]); return q; }
__device__ __forceinline__ float fsig(float x) { return __builtin_amdgcn_rcpf(1.0f + __builtin_amdgcn_exp2f(-1.4426950408889634f * x)); }
template <int ROWS, int ROWB, int PB, int NTHR_> __device__ __forceinline__ void tile_out(const FLAS unsigned char* st, unsigned char* gbase, size_t gpitch, int t) {
    constexpr int CPR = ROWB / 16, N = ROWS * CPR;
#pragma unroll
    for (int i0 = 0; i0 < N; i0 += NTHR_) { const int i = i0 + t; if (N % NTHR_ == 0 || i < N) { const int r = i / CPR, c = i % CPR; *(u32x4*)(gbase + (size_t)r * gpitch + c * 16) = *(const FLAS u32x4*)(st + r * PB + c * 16); } }
}

template <class Map> __device__ __forceinline__ void tr_item(const float* W, int Nsrc, const Map& map, bf16* WT, int K, int k0, int n0, FLAS float* scr, int lane, const float* gain = nullptr, float gscale = 1.0f) {
    const int c = map(n0 + lane), cc = lane & 7;
    f32x4 g0 = (f32x4){1.f, 1.f, 1.f, 1.f}, g1 = g0;
    if (gain) { g0 = *(const f32x4*)(gain + k0 + 8 * cc) * gscale; g1 = *(const f32x4*)(gain + k0 + 8 * cc + 4) * gscale; }
    float wv[64];
#pragma unroll
    for (int i = 0; i < 64; ++i) wv[i] = c >= 0 ? W[(size_t)(k0 + i) * Nsrc + c] : 0.f;
    __builtin_amdgcn_sched_barrier(0);
#pragma unroll
    for (int i = 0; i < 64; ++i) scr[i * 65 + lane] = wv[i];
    FP_LDS_WAIT(); asm volatile("" ::: "memory");
#pragma unroll
    for (int j = 0; j < 8; ++j) { const int n = (lane >> 3) + 8 * j; const FLAS float* s = scr + (8 * cc) * 65 + n;
        u32x4 o; o.x = pk2(s[0 * 65] * g0.x, s[1 * 65] * g0.y); o.y = pk2(s[2 * 65] * g0.z, s[3 * 65] * g0.w); o.z = pk2(s[4 * 65] * g1.x, s[5 * 65] * g1.y); o.w = pk2(s[6 * 65] * g1.z, s[7 * 65] * g1.w);
        *(u32x4*)(WT + (size_t)(n0 + n) * K + k0 + 8 * cc) = o; }
    FP_LDS_WAIT(); asm volatile("" ::: "memory");
}
struct MapId { __device__ __forceinline__ int operator()(int n) const { return n; } };
struct MapLt { int lim; __device__ __forceinline__ int operator()(int n) const { return n < lim ? n : -1; } };
struct MapU { __device__ __forceinline__ int operator()(int n) const { return ucol_src(n); } };
struct MapOff { int off; __device__ __forceinline__ int operator()(int n) const { return n + off; } };
__device__ __forceinline__ void prologue(const MP& p, FLAS unsigned char* lds, int bx, int G) {
    const int tid = mk_tid(), lane = tid & 63, wave = __builtin_amdgcn_readfirstlane(tid >> 6);
    FLAS float* scr = (FLAS float*)(lds + wave * (64 * 65 * 4));
    const int gw = bx * 8 + wave, NGW = G * 8;
    constexpr int I_WIN = (D / 64) * (NU / 64), I_UQ = 4 * 8, I_UKV = 2 * 8, I_DD = 16 * 16, I_PP = 4 * 16, I_GU = 16 * (NGU / 64), I_DN = (DFF / 64) * 16;
    constexpr int PER_L = I_WIN + I_UQ + I_UKV + 2 * I_DD + I_PP, NITEMS = DEPTH * PER_L + 18 * (I_GU + I_DN);
    TP_BEGIN(21, lds);
    for (int it = gw; it < NITEMS; it += NGW) {
        int r = it;
        if (r < DEPTH * PER_L) { const int l = r / PER_L; r %= PER_L;
            if (r < I_WIN) { tr_item(p.w_in + (size_t)l * D * NUO, NUO, MapU{}, p.WIN + (size_t)l * NU * D, D, 64 * (r / (NU / 64)), 64 * (r % (NU / 64)), scr, lane, p.attn_g + l * D); continue; } r -= I_WIN;
            if (r < I_UQ) { tr_item(p.w_uq + (size_t)l * 256 * 384, 384, MapLt{384}, p.WUQ + (size_t)l * 512 * 256, 256, 64 * (r / 8), 64 * (r % 8), scr, lane); continue; } r -= I_UQ;
            if (r < I_UKV) { tr_item(p.w_ukv + (size_t)l * 128 * 512, 512, MapId{}, p.WUKV + (size_t)l * 512 * 128, 128, 64 * (r / 8), 64 * (r % 8), scr, lane); continue; } r -= I_UKV;
            if (r < I_DD) { tr_item(p.w_out + (size_t)l * D * D, D, MapId{}, p.WOUT + (size_t)l * D * D, D, 64 * (r / 16), 64 * (r % 16), scr, lane); continue; } r -= I_DD;
            if (r < I_DD) { tr_item(p.ple_wg + (size_t)l * D * D, D, MapId{}, p.WPG + (size_t)l * D * D, D, 64 * (r / 16), 64 * (r % 16), scr, lane, p.ple_g + l * D); continue; } r -= I_DD;
            tr_item(p.ple_wp + (size_t)l * PLE * D, D, MapId{}, p.WPP + (size_t)l * D * PLE, PLE, 64 * (r / 16), 64 * (r % 16), scr, lane); continue; }
        r -= DEPTH * PER_L;
        if (r < 18 * I_GU) { const int mt = r / I_GU; r %= I_GU; const int k0 = 64 * (r / (NGU / 64)), n0 = 64 * (r % (NGU / 64)); const int tl = n0 / 256, rr = n0 % 256;
            const float* src; bf16* dst;
            if (mt < 2) { src = (rr < 128 ? p.dwg : p.dwu) + (size_t)mt * D * DFF; dst = p.DWGU + (size_t)mt * NGU * D; } else { src = (rr < 128 ? p.mwg : p.mwu) + (size_t)(mt - 2) * D * DFF; dst = p.MWGU + (size_t)(mt - 2) * NGU * D; }
            const int Lg = mt < 2 ? 2 * mt : 2 * ((mt - 2) >> 3) + 1;
            tr_item(src, DFF, MapOff{tl * 128 + (rr & 127) - n0}, dst, D, k0, n0, scr, lane, p.ffn_g + Lg * D, rr < 128 ? 1.4426950408889634f : 0.6931471805599453f); continue; }
        r -= 18 * I_GU;
        { const int mt = r / I_DN; r %= I_DN; const float* src; bf16* dst;
            if (mt < 2) { src = p.dwd + (size_t)mt * DFF * D; dst = p.DWD + (size_t)mt * D * DFF; } else { src = p.mwd + (size_t)(mt - 2) * DFF * D; dst = p.MWD + (size_t)(mt - 2) * D * DFF; }
            tr_item(src, D, MapId{}, dst, DFF, 64 * (r / 16), 64 * (r % 16), scr, lane); }
    }
    TP_END(21, lds); TP_BEGIN(22, lds);
    const long g0 = (long)bx * 512 + tid, gs = (long)G * 512;
    for (long tb = gw; tb < p.T; tb += 4L * NGW) { f32x4 xv[4][4];
#pragma unroll
        for (int r = 0; r < 4; ++r) { const long t = tb + (long)r * NGW < p.T ? tb + (long)r * NGW : tb; const f32x4* xr = (const f32x4*)(p.x + t * D) + 2 * lane; xv[r][0] = xr[0]; xv[r][1] = xr[1]; xv[r][2] = xr[128]; xv[r][3] = xr[129]; }
        __builtin_amdgcn_sched_barrier(0);
#pragma unroll
        for (int r = 0; r < 4; ++r) { const long t = tb + (long)r * NGW; if (t < p.T) { u32x4* o = (u32x4*)(p.HB + t * D) + lane; float ss = 0.f;
#pragma unroll
            for (int hh = 0; hh < 2; ++hh) { const f32x4 v0 = xv[r][2 * hh], v1 = xv[r][2 * hh + 1]; u32x4 wv; wv.x = pk2(v0.x, v0.y); wv.y = pk2(v0.z, v0.w); wv.z = pk2(v1.x, v1.y); wv.w = pk2(v1.z, v1.w); o[64 * hh] = wv;
                float e[8]; unpack8(wv, e);
#pragma unroll
                for (int i = 0; i < 8; ++i) ss += e[i] * e[i]; }
            ss = wave_sum(ss); if (lane < 16) rss_ptr(p, 0, 0)[t * 16 + lane] = lane == 0 ? ss : 0.f; } } }
    { const long N8 = (long)DEPTH * p.T * PLE / 8;
      for (long base = g0; base < N8; base += 8 * gs) { f32x4 pv[8][2];
#pragma unroll
        for (int k = 0; k < 8; ++k) { const long i = base + k * gs < N8 ? base + k * gs : base; pv[k][0] = ((const f32x4*)p.p)[2 * i]; pv[k][1] = ((const f32x4*)p.p)[2 * i + 1]; }
        __builtin_amdgcn_sched_barrier(0);
#pragma unroll
        for (int k = 0; k < 8; ++k) { const long i = base + k * gs; if (i < N8) { u32x4 o; o.x = pk2(pv[k][0].x, pv[k][0].y); o.y = pk2(pv[k][0].z, pv[k][0].w); o.z = pk2(pv[k][1].x, pv[k][1].y); o.w = pk2(pv[k][1].z, pv[k][1].w); ((u32x4*)p.PB16)[i] = o; } } } }
    if ((PROBE_T >> 22) & 1) { asm volatile("s_waitcnt vmcnt(0)" ::: "memory"); } TP_END(22, lds); TP_BEGIN(23, lds);
    for (long i = g0; i < p.T * 16; i += gs) { const long t = i / 16; const int j = (int)(i % 16); const float inv = __builtin_amdgcn_exp2f(-(float)j * 0.8304820237218406f), ang = (float)p.pos[t] * inv;
        const float rev = __builtin_amdgcn_fractf(ang * 0.15915494309189535f);
        p.CS[t * 32 + j] = __builtin_amdgcn_cosf(rev); p.CS[t * 32 + 16 + j] = __builtin_amdgcn_sinf(rev); }
    if ((PROBE_T >> 23) & 1) { asm volatile("s_waitcnt vmcnt(0)" ::: "memory"); } TP_END(23, lds);
}
template <int MODE> __device__ __forceinline__ void norm_phase(const MP& p, int L, const float* g, bf16* hb, int bx, int G, FLAS unsigned* lcnt = nullptr, const bf16* part = nullptr) {
    const int tid = mk_tid(), lane = tid & 63, wave = __builtin_amdgcn_readfirstlane(tid >> 6);
    const int gw = bx * 8 + wave, NGW = G * 8;
    bf16* const HBN = (bf16*)p.H;
    f32x4 Rr[MODE == 1 ? 32 : 1];
    const int rpw = MODE == 1 ? ((int)p.T + NGW - 1) / NGW : 0, nent = 8 * rpw * 2; FLAS int* const ent = (FLAS int*)lcnt + 64;
    if (MODE == 1) { __syncthreads(); for (int i = tid; i < nent; i += 512) ent[i] = -1; if (tid < 64) lcnt[tid] = 0u; __syncthreads(); const f32x4* R = (const f32x4*)(p.router + (size_t)(L >> 1) * D * NE);
#pragma unroll
        for (int c = 0; c < 2; ++c)
#pragma unroll
            for (int i = 0; i < 8; ++i) { const int idx = 512 * c + 8 * lane + i; Rr[(c * 8 + i) * 2] = R[idx * 2]; Rr[(c * 8 + i) * 2 + 1] = R[idx * 2 + 1]; } }
    constexpr int RB = MODE == 3 ? 8 : 4;
    f32x4 gq[2][2]; if (MODE == 1 || MODE == 3) {
#pragma unroll
        for (int c = 0; c < 2; ++c) { gq[c][0] = *(const f32x4*)(g + 512 * c + 8 * lane); gq[c][1] = *(const f32x4*)(g + 512 * c + 8 * lane + 4); } }
    int row0p = 0, ksn = 1; size_t pstride = 0; if (MODE == 2) { row0p = p.TILE_E[1000]; ksn = p.TILE_E[1001]; pstride = (size_t)p.TILE_E[1002] * D; }
    int jgrp = 0;
    for (long tb = gw; tb < p.T; tb += (long)RB * NGW, ++jgrp) {
        u32x4 hq[RB][2]; int sl[RB][2]; float gt[RB][2]; u32x4 yq[RB][2][2]; bool ok[RB];
#pragma unroll
        for (int r = 0; r < RB; ++r) { const long t = tb + (long)r * NGW; ok[r] = t < p.T; const long tt = ok[r] ? t : tb; const u32x4* hr = (const u32x4*)(hb + tt * D) + lane; hq[r][0] = hr[0]; hq[r][1] = hr[64];
            if (MODE == 2) { sl[r][0] = p.TOKSLOT[tt * 2]; sl[r][1] = p.TOKSLOT[tt * 2 + 1]; gt[r][0] = p.TOPG[tt * 2]; gt[r][1] = p.TOPG[tt * 2 + 1]; } }
        if (MODE == 2) {
#pragma unroll
            for (int r = 0; r < RB; ++r)
#pragma unroll
                for (int k = 0; k < 2; ++k) { const u32x4* y0 = (const u32x4*)(p.YS + (size_t)sl[r][k] * D) + lane; yq[r][k][0] = y0[0]; yq[r][k][1] = y0[64]; } }
        __builtin_amdgcn_sched_barrier(0);
#pragma unroll
        for (int r = 0; r < RB; ++r) if (ok[r]) { const long t = tb + (long)r * NGW; float v[2][8]; unpack8(hq[r][0], v[0]); unpack8(hq[r][1], v[1]);
            if (MODE == 2) {
#pragma unroll
                for (int k = 0; k < 2; ++k) { float acc[2][8]; unpack8(yq[r][k][0], acc[0]); unpack8(yq[r][k][1], acc[1]);
                    if (sl[r][k] >= row0p) for (int s = 1; s < ksn; s += 3) {
                        u32x4 pq[3][2];
#pragma unroll
                        for (int j = 0; j < 3; ++j) { const int sj = s + j < ksn ? s + j : s; const u32x4* yp = (const u32x4*)(part + (size_t)(sj - 1) * pstride + (size_t)(sl[r][k] - row0p) * D) + lane; pq[j][0] = yp[0]; pq[j][1] = yp[64]; }
                        __builtin_amdgcn_sched_barrier(0);
#pragma unroll
                        for (int j = 0; j < 3; ++j) if (s + j < ksn) { float r0[8], r1[8]; unpack8(pq[j][0], r0); unpack8(pq[j][1], r1);
#pragma unroll
                            for (int i = 0; i < 8; ++i) { acc[0][i] += r0[i]; acc[1][i] += r1[i]; } } }
#pragma unroll
                    for (int c = 0; c < 2; ++c)
#pragma unroll
                        for (int i = 0; i < 8; ++i) v[c][i] += gt[r][k] * acc[c][i]; }
                const u32x4 w0 = pack8(v[0]), w1 = pack8(v[1]); u32x4* hr = (u32x4*)(hb + t * D) + lane; hr[0] = w0; hr[64] = w1; unpack8(w0, v[0]); unpack8(w1, v[1]); }
            float ss = 0.f;
#pragma unroll
            for (int c = 0; c < 2; ++c)
#pragma unroll
                for (int i = 0; i < 8; ++i) ss += v[c][i] * v[c][i];
            ss = wave_sum(ss);
            const float rn = 1.0f / sqrtf(ss * (1.0f / D) + RMS_EPS);
            if (MODE == 2) { if (lane < 16) rss_ptr(p, L, 2)[t * 16 + lane] = lane == 0 ? ss : 0.f; }
            if (MODE == 1) { u32x4* o = (u32x4*)(HBN + t * D) + lane; float n0[8], n1[8];
#pragma unroll
                for (int i = 0; i < 8; ++i) { n0[i] = v[0][i] * rn; n1[i] = v[1][i] * rn; }
                o[0] = pack8(n0); o[64] = pack8(n1); }
            if (MODE == 1 || MODE == 3) {
#pragma unroll
                for (int c = 0; c < 2; ++c) { const f32x4 g0 = gq[c][0], g1 = gq[c][1];
                    v[c][0] *= rn * g0.x; v[c][1] *= rn * g0.y; v[c][2] *= rn * g0.z; v[c][3] *= rn * g0.w; v[c][4] *= rn * g1.x; v[c][5] *= rn * g1.y; v[c][6] *= rn * g1.z; v[c][7] *= rn * g1.w; } }
            if (MODE == 3) {
#pragma unroll
                for (int c = 0; c < 2; ++c) { f32x4* o = (f32x4*)(p.out + t * D + 512 * c + 8 * lane); o[0] = (f32x4){v[c][0], v[c][1], v[c][2], v[c][3]}; o[1] = (f32x4){v[c][4], v[c][5], v[c][6], v[c][7]}; }
            }
            if (MODE == 1) { float lg[NE];
#pragma unroll
                for (int e = 0; e < NE; ++e) lg[e] = 0.f;
#pragma unroll
                for (int c = 0; c < 2; ++c)
#pragma unroll
                    for (int i = 0; i < 8; ++i) { const f32x4 r0 = Rr[(c * 8 + i) * 2], r1 = Rr[(c * 8 + i) * 2 + 1]; const float x = v[c][i];
                        lg[0] += x * r0.x; lg[1] += x * r0.y; lg[2] += x * r0.z; lg[3] += x * r0.w; lg[4] += x * r1.x; lg[5] += x * r1.y; lg[6] += x * r1.z; lg[7] += x * r1.w; }
#pragma unroll
                for (int e = 0; e < NE; ++e) lg[e] = wave_sum(lg[e]);
                int e0 = 0; float v0 = lg[0];
#pragma unroll
                for (int e = 1; e < NE; ++e) if (lg[e] > v0) { v0 = lg[e]; e0 = e; }
                int e1 = -1; float v1 = -3.0e38f;
#pragma unroll
                for (int e = 0; e < NE; ++e) if (e != e0 && lg[e] > v1) { v1 = lg[e]; e1 = e; }
                if (lane == 0) { const float g1 = 1.0f / (1.0f + expf(v0 - v1));
                    p.TOPE[t * 2] = e0; p.TOPE[t * 2 + 1] = e1; p.TOPG[t * 2] = 1.0f - g1; p.TOPG[t * 2 + 1] = g1;
                    ent[((jgrp * RB + r) * 8 + wave) * 2] = e0; ent[((jgrp * RB + r) * 8 + wave) * 2 + 1] = e1; } }
        }
    }
    if (MODE == 1) {
        __syncthreads();
        const int e = tid < nent ? ent[tid] : -1; int pos = 0;
#pragma unroll
        for (int x = 0; x < NE; ++x) { const unsigned long long mk = __builtin_amdgcn_ballot_w64(e == x); if (e == x) pos = __builtin_popcountll(mk & ((1ull << lane) - 1ull)); if (lane == 0) lcnt[8 + wave * 8 + x] = (unsigned)__builtin_popcountll(mk); }
        __syncthreads();
        if (e >= 0) { int off = 0; for (int w2 = 0; w2 < wave; ++w2) off += (int)lcnt[8 + w2 * 8 + e];
            const int lr = tid >> 1, wv = lr & 7, j = lr >> 3; const long t = (long)(bx * 8 + wv) + (long)j * NGW; p.POS[t * 2 + (tid & 1)] = off + pos; }
        if (tid < NE) { int s = 0; for (int w2 = 0; w2 < 8; ++w2) s += (int)lcnt[8 + w2 * 8 + tid]; p.BCNT[bx * NE + tid] = s; } }
}
__device__ __forceinline__ void moeplan(const MP& p, int L, FLAS unsigned char* lds, int bx, int G) {
    const int tid = mk_tid(), lane = tid & 63, wave = __builtin_amdgcn_readfirstlane(tid >> 6), j = L >> 1;
    const int gw = bx * 8 + wave, NGW = G * 8;
    FLAS int* base = (FLAS int*)lds;
    FLAS int* pst = (FLAS int*)(lds + 16384);
    const long i0 = (long)bx * 512 + tid; const bool has0 = i0 < p.T * 2; int e0v = 0, pos0v = 0; if (has0) { e0v = p.TOPE[i0]; pos0v = p.POS[i0]; }
    __syncthreads();
    {
        const int e = wave; int c[4], s = 0;
#define PLAN_BLK(q_) (G == 256 ? (int)(__brev((unsigned)(q_)) >> 24) : (q_))
#pragma unroll
        for (int i = 0; i < 4; ++i) { const int b = PLAN_BLK(lane * 4 + i); c[i] = lane * 4 + i < G ? p.BCNT[b * NE + e] : 0; s += c[i]; }
        int inc = s;
#pragma unroll
        for (int o = 1; o < 64; o <<= 1) { const int t = __shfl_up(inc, o); if (lane >= o) inc += t; }
        int ex = inc - s;
#pragma unroll
        for (int i = 0; i < 4; ++i) { const int b = PLAN_BLK(lane * 4 + i); if (lane * 4 + i < G) base[b * NE + e] = ex; ex += c[i]; }
#undef PLAN_BLK
        if (lane == 63) pst[e] = inc;
    }
    __syncthreads();
    if (tid == 0) { int o = 0; for (int e = 0; e < NE; ++e) { const int cnt = pst[e]; pst[16 + e] = cnt; pst[e] = o; if (bx == 0) cnt_ptr(p, j)[e] = (unsigned)cnt; o += ((cnt + 255) / 256) * 256; } pst[NE] = o; }
    __syncthreads();
    for (long i = i0; i < p.T * 2; i += (long)G * 512) { const long t = i >> 1; const int e = i == i0 ? e0v : p.TOPE[i], blk = (int)((t % NGW) >> 3); const int slot = pst[e] + base[blk * NE + e] + (i == i0 ? pos0v : p.POS[i]); p.TOKSLOT[i] = slot; p.TOKIDX[slot] = (int)t; }
    if (bx == 0) {
#pragma unroll 1
        for (int e = 0; e < NE; ++e) for (int q = pst[e] + pst[16 + e] + tid; q < pst[e + 1]; q += 512) p.TOKIDX[q] = 0; }
    if (bx == 0) for (int i = tid; i < 1024; i += 512) { int e = -1; if (i * 256 < pst[NE]) { e = 0; for (int q = 1; q < NE; ++q) if (i * 256 >= pst[q]) e = q; } p.TILE_E[i] = e; }
    __syncthreads();
}
typedef short bf16x8 __attribute__((ext_vector_type(8)));
typedef short bf16x4 __attribute__((ext_vector_type(4)));
constexpr int AT_KP = 112, AT_VP = 136, AT_KBYTES = 128 * AT_KP * 2, AT_BUF = AT_KBYTES + 80 * AT_VP * 2;
__device__ __forceinline__ void ssd_scan(const MP& p, int bx, int G) {
    const int tid = mk_tid(); const long g0 = (long)bx * 512 + tid, gs = (long)G * 512; const int NCB = (int)(p.S / CHUNK);
    for (long i = g0; i < p.B * 8 * 64 * 32; i += gs) { const long b = i / (8 * 64 * 32), r = i % (8 * 64 * 32); const int h = (int)(r / (64 * 32)); float zz; asm volatile("v_mov_b32 %0, 0" : "=v"(zz)); f32x4 carry = (f32x4){zz, zz, zz, zz};
        f32x4 st[16]; float dec[16];
#pragma unroll
        for (int cc = 0; cc < 16; ++cc) { const long c = b * NCB + cc; st[cc] = ((const f32x4*)p.ST)[(size_t)c * (8 * 64 * 32) + r]; dec[cc] = p.ACS[(c * CHUNK + CHUNK - 1) * 8 + h]; }
        __builtin_amdgcn_sched_barrier(0);
#pragma unroll
        for (int cc = 0; cc < 16; ++cc) { const long c = b * NCB + cc; u32x2 o; o.x = pk2(carry.x, carry.y); o.y = pk2(carry.z, carry.w); ((u32x2*)p.PV)[(size_t)c * (8 * 64 * 32) + r] = o; carry = carry * __expf(dec[cc]) + st[cc]; } }
}
__device__ __forceinline__ void attn_phase(const MP& p, FLAS unsigned char* lds, int bx, int G) {
    const int S = (int)p.S, nunits = (int)p.B * 4 * 8;
    const int vcu = (G % 8 == 0) ? (bx % 8) * (G / 8) + bx / 8 : bx;
    { const int tid0 = mk_tid(); __syncthreads();
      for (int e = tid0; e < 2 * 16 * AT_VP; e += 512) { const int bufi = e / (16 * AT_VP), r = (e % (16 * AT_VP)) / AT_VP, c = e % AT_VP; ((FLAS bf16*)(lds + bufi * AT_BUF + AT_KBYTES))[(64 + r) * AT_VP + c] = r == 0 ? (bf16)0x3f80 : (bf16)0; } }
    bool scanned = false;
    for (int u = vcu; u < nunits; u += G) {
        const int tid = mk_tid(), lane = tid & 63, w = __builtin_amdgcn_readfirstlane(tid >> 6), fr = lane & 15, fq = lane >> 4;
        int kro[3], kco[3];
#pragma unroll
        for (int i = 0; i < 3; ++i) { const int c = tid + 512 * i; kro[i] = c / 12; kco[i] = c % 12; }
        const int vd = tid >> 4, vkc = tid & 15;
        const int bh = u >> 3, jp = u & 7, b = bh >> 2, h = bh & 3;
        const bf16* Kg = p.KK + (size_t)b * S * 384 + h * 96; const bf16* Vg = p.V + (size_t)bh * 64 * S;
        const int qg = w & 3, kh = w >> 2;
        bf16x8 qf[2][3], qn[2][3];
#define AT_QLOAD(dst_, qb_) do { _Pragma("unroll") for (int qi = 0; qi < 2; ++qi) { const size_t trow_ = (size_t)b * S + (qb_) * 128 + 32 * qg + 16 * qi + fr; \
            _Pragma("unroll") for (int ks = 0; ks < 3; ++ks) dst_[qi][ks] = *(const bf16x8*)(p.Q + trow_ * 384 + h * 96 + ks * 32 + fq * 8); } } while (0)
        AT_QLOAD(qf, jp);
        for (int half = 0; half < 2; ++half) {
            const int qb = half ? 15 - jp : jp, q0 = qb * 128, qmin = q0 + 32 * qg;
            const int par = half ? ((jp + 1) & 1) : 0;
            if (half) {
#pragma unroll
                for (int qi = 0; qi < 2; ++qi)
#pragma unroll
                    for (int ks = 0; ks < 3; ++ks) qf[qi][ks] = qn[qi][ks]; }
            f32x4 o[2][5];
#pragma unroll
            for (int qi = 0; qi < 2; ++qi)
#pragma unroll
                for (int dt = 0; dt < 5; ++dt) o[qi][dt] = (f32x4){0.f, 0.f, 0.f, 0.f};
            float m[2] = {-1e30f, -1e30f};
            const int nkt = qb + 1;
            u32x4 rk[3], rv[2];
#define AT_LOAD(kt_) do { const size_t kb_ = (size_t)(kt_) * 128; _Pragma("unroll") for (int i = 0; i < 3; ++i) rk[i] = *(const u32x4*)(Kg + (kb_ + kro[i]) * 384 + kco[i] * 8); \
            _Pragma("unroll") for (int i = 0; i < 2; ++i) rv[i] = *(const u32x4*)(Vg + (size_t)(vd + 32 * i) * S + kb_ + vkc * 8); } while (0)
#define AT_WRITE(buf_) do { FLAS bf16* Kw = (FLAS bf16*)(lds + (buf_) * AT_BUF); FLAS bf16* Vw = (FLAS bf16*)(lds + (buf_) * AT_BUF + AT_KBYTES); \
            _Pragma("unroll") for (int i = 0; i < 3; ++i) *(FLAS u32x4*)(Kw + kro[i] * AT_KP + kco[i] * 8) = rk[i]; \
            _Pragma("unroll") for (int i = 0; i < 2; ++i) *(FLAS u32x4*)(Vw + (vd + 32 * i) * AT_VP + vkc * 8) = rv[i]; } while (0)
            if (half == 0) {
                AT_LOAD(0);
                if (!scanned) { ssd_scan(p, bx, G); scanned = true; }
                __syncthreads();
                AT_WRITE(0);
                __syncthreads(); }
            for (int kt = 0; kt < nkt; ++kt) {
                const bool more = kt + 1 < nkt, pre = !more && half == 0;
                TP_BEGIN(18, lds); if (more) AT_LOAD(kt + 1); else if (pre) { AT_LOAD(0); AT_QLOAD(qn, 15 - jp); } TP_END(18, lds); TP_BEGIN(19, lds);
                if (!(kt == qb && kh == 1 && qg < 2)) {
                const FLAS bf16* Ks = (const FLAS bf16*)(lds + ((kt + par) & 1) * AT_BUF) + kh * 64 * AT_KP; const FLAS bf16* Vt = (const FLAS bf16*)(lds + ((kt + par) & 1) * AT_BUF + AT_KBYTES) + kh * 64;
                f32x4 s[2][4];
#pragma unroll
                for (int sub = 0; sub < 4; ++sub) { s[0][sub] = (f32x4){0.f, 0.f, 0.f, 0.f}; s[1][sub] = (f32x4){0.f, 0.f, 0.f, 0.f};
#pragma unroll
                    for (int ks = 0; ks < 3; ++ks) { const bf16x8 a = *(const FLAS bf16x8*)(Ks + (sub * 16 + fr) * AT_KP + ks * 32 + fq * 8);
                        s[0][sub] = __builtin_amdgcn_mfma_f32_16x16x32_bf16(a, qf[0][ks], s[0][sub], 0, 0, 0); s[1][sub] = __builtin_amdgcn_mfma_f32_16x16x32_bf16(a, qf[1][ks], s[1][sub], 0, 0, 0); } }
                if (kt == qb) {
#pragma unroll
                    for (int qi = 0; qi < 2; ++qi)
#pragma unroll
                        for (int sub = 0; sub < 4; ++sub)
#pragma unroll
                            for (int j = 0; j < 4; ++j) if (64 * kh + 16 * sub + 4 * fq + j > 32 * qg + 16 * qi + fr) s[qi][sub][j] = -1e30f; }
#pragma unroll
                for (int qi = 0; qi < 2; ++qi) {
                    float t0 = __builtin_fmaxf(__builtin_fmaxf(s[qi][0][0], s[qi][0][1]), s[qi][0][2]), t1 = __builtin_fmaxf(__builtin_fmaxf(s[qi][0][3], s[qi][1][0]), s[qi][1][1]);
                    t0 = __builtin_fmaxf(__builtin_fmaxf(t0, s[qi][1][2]), s[qi][1][3]);
                    t0 = __builtin_fmaxf(__builtin_fmaxf(t0, s[qi][2][0]), s[qi][2][1]); t1 = __builtin_fmaxf(__builtin_fmaxf(t1, s[qi][2][2]), s[qi][2][3]);
                    t0 = __builtin_fmaxf(__builtin_fmaxf(t0, s[qi][3][0]), s[qi][3][1]); t1 = __builtin_fmaxf(__builtin_fmaxf(t1, s[qi][3][2]), s[qi][3][3]);
                    float tmax = __builtin_fmaxf(t0, t1);
                    tmax = __builtin_fmaxf(tmax, __shfl_xor(tmax, 16)); tmax = __builtin_fmaxf(tmax, __shfl_xor(tmax, 32));
                    const float mn = __builtin_fmaxf(m[qi], tmax), alpha = __builtin_amdgcn_exp2f(m[qi] - mn); m[qi] = mn;
#pragma unroll
                    for (int sub = 0; sub < 4; ++sub)
#pragma unroll
                        for (int j = 0; j < 4; ++j) s[qi][sub][j] = __builtin_amdgcn_exp2f(s[qi][sub][j] - mn);
                    if (__builtin_amdgcn_ballot_w64(alpha != 1.0f) != 0ull) {
#pragma unroll
                        for (int dt = 0; dt < 5; ++dt) o[qi][dt] *= alpha; }
                }
#pragma unroll
                for (int k2 = 0; k2 < 2; ++k2) {
                    bf16x8 pf[2];
#pragma unroll
                    for (int qi = 0; qi < 2; ++qi) { u32x4 pw; pw.x = pk2(s[qi][2 * k2][0], s[qi][2 * k2][1]); pw.y = pk2(s[qi][2 * k2][2], s[qi][2 * k2][3]); pw.z = pk2(s[qi][2 * k2 + 1][0], s[qi][2 * k2 + 1][1]); pw.w = pk2(s[qi][2 * k2 + 1][2], s[qi][2 * k2 + 1][3]);
                        pf[qi] = __builtin_bit_cast(bf16x8, pw); }
#pragma unroll
                    for (int dt = 0; dt < 5; ++dt) { const FLAS bf16* vp = Vt + (dt * 16 + fr) * AT_VP + 32 * k2 + 4 * fq;
                        const u32x2 v0 = *(const FLAS u32x2*)vp, v1 = *(const FLAS u32x2*)(vp + 16); u32x4 vw; vw.x = v0.x; vw.y = v0.y; vw.z = v1.x; vw.w = v1.y;
                        const bf16x8 vf = __builtin_bit_cast(bf16x8, vw);
                        o[0][dt] = __builtin_amdgcn_mfma_f32_16x16x32_bf16(vf, pf[0], o[0][dt], 0, 0, 0); o[1][dt] = __builtin_amdgcn_mfma_f32_16x16x32_bf16(vf, pf[1], o[1][dt], 0, 0, 0); } }
                }
                TP_END(19, lds); TP_BEGIN(20, lds); if (more || pre) AT_WRITE((kt + 1 + par) & 1);
                __syncthreads(); TP_END(20, lds);
            }
#undef AT_LOAD
#undef AT_WRITE
            FLAS float* xch = (FLAS float*)(lds + 2 * AT_BUF + 4 * (32 * 144)) + qg * (42 * 64) + lane;
            if (kh == 1) {
#pragma unroll
                for (int qi = 0; qi < 2; ++qi) { xch[(qi * 21 + 20) * 64] = m[qi];
#pragma unroll
                    for (int dt = 0; dt < 5; ++dt)
#pragma unroll
                        for (int j = 0; j < 4; ++j) xch[(qi * 21 + dt * 4 + j) * 64] = o[qi][dt][j]; } }
            __syncthreads();
            if (kh == 0) {
                FLAS unsigned char* ostg = lds + 2 * AT_BUF + qg * (32 * 144);
#pragma unroll
                for (int qi = 0; qi < 2; ++qi) { const float m2 = xch[(qi * 21 + 20) * 64], mn = __builtin_fmaxf(m[qi], m2), a1 = __builtin_amdgcn_exp2f(m[qi] - mn), a2 = __builtin_amdgcn_exp2f(m2 - mn);
#pragma unroll
                    for (int dt = 0; dt < 5; ++dt)
#pragma unroll
                        for (int j = 0; j < 4; ++j) o[qi][dt][j] = o[qi][dt][j] * a1 + xch[(qi * 21 + dt * 4 + j) * 64] * a2;
                    const float l = __shfl(o[qi][4][0], fr);
                    const float rl = __builtin_amdgcn_rcpf(l);
#pragma unroll
                    for (int dt = 0; dt < 4; ++dt) { u32x2 ow; ow.x = pk2(o[qi][dt][0] * rl, o[qi][dt][1] * rl); ow.y = pk2(o[qi][dt][2] * rl, o[qi][dt][3] * rl); *(FLAS u32x2*)(ostg + (16 * qi + fr) * 144 + (dt * 16 + 4 * fq) * 2) = ow; } }
                FP_LDS_WAIT(); asm volatile("" ::: "memory");
                tile_out<32, 128, 144, 64>(ostg, (unsigned char*)(p.YC + ((size_t)b * S + qmin) * D + 768 + h * 64), (size_t)D * 2, lane);
                FP_LDS_WAIT(); asm volatile("" ::: "memory");
            }
        }
    }
#undef AT_QLOAD
    if (!scanned) ssd_scan(p, bx, G);
    __syncthreads();
}
__device__ __forceinline__ void conv_module(const MP& p, int L, FLAS unsigned char* lds, int bx, int G) {
    FLAS float* Gs = (FLAS float*)lds;
    const int S = (int)p.S, nchunk = S / 64, nitems = (int)p.B * nchunk;
    for (int it = bx; it < nitems; it += G) {
        const int tid = mk_tid(), lane = tid & 63, w = __builtin_amdgcn_readfirstlane(tid >> 6);
        const int ck = it % nchunk, b = it / nchunk, s0 = ck * 64;
        __syncthreads();
        const int ch = (w & 3) * 64 + lane, tb = (w >> 2) * 32; float wj[CK];
        u32x4 rv[6], rg[6];
#pragma unroll
        for (int i = 0; i < 6; ++i) { const int idx = tid + 512 * i, row = idx >> 5, c = idx & 31, sp = s0 - 30 + row; rv[i] = (u32x4){0u, 0u, 0u, 0u}; rg[i] = rv[i];
            if (idx < 94 * 32 && sp >= 0) { const bf16* u = p.U + ((size_t)b * S + sp) * NU + c * 8; rv[i] = *(const u32x4*)u; rg[i] = *(const u32x4*)(u + 256); } }
#pragma unroll
        for (int j = 0; j < CK; ++j) wj[j] = p.cdw_w[(L * CK + j) * 256 + ch];
        const float bias = p.cdw_b[L * 256 + ch], lg = p.cln_g[L * 256 + ch], lb = p.cln_b[L * 256 + ch];
        __builtin_amdgcn_sched_barrier(0);
#pragma unroll
        for (int i = 0; i < 6; ++i) { const int idx = tid + 512 * i, row = idx >> 5, c = idx & 31;
            if (idx < 94 * 32) { const unsigned v[4] = {rv[i].x, rv[i].y, rv[i].z, rv[i].w}, g[4] = {rg[i].x, rg[i].y, rg[i].z, rg[i].w}; f32x4 o0, o1;
                o0.x = blo(v[0]) * fsig(blo(g[0])); o0.y = bhi(v[0]) * fsig(bhi(g[0])); o0.z = blo(v[1]) * fsig(blo(g[1])); o0.w = bhi(v[1]) * fsig(bhi(g[1]));
                o1.x = blo(v[2]) * fsig(blo(g[2])); o1.y = bhi(v[2]) * fsig(bhi(g[2])); o1.z = blo(v[3]) * fsig(blo(g[3])); o1.w = bhi(v[3]) * fsig(bhi(g[3]));
                *(FLAS f32x4*)(Gs + row * 256 + c * 8) = o0; *(FLAS f32x4*)(Gs + row * 256 + c * 8 + 4) = o1; } }
        __syncthreads();
#pragma unroll 1
        for (int i8 = 0; i8 < 4; ++i8) { const int tl0 = tb + 8 * i8; float win[38], acc[8];
#pragma unroll
            for (int r = 0; r < 38; ++r) win[r] = Gs[(tl0 + r) * 256 + ch];
#pragma unroll
            for (int q = 0; q < 8; ++q) { float a = bias;
#pragma unroll
                for (int j = 0; j < CK; ++j) a += wj[j] * win[q + j];
                acc[q] = a; }
            float mu[8], var[8];
#pragma unroll
            for (int q = 0; q < 8; ++q) { mu[q] = wave_sum(acc[q]) * (1.0f / 64.f); acc[q] -= mu[q]; }
#pragma unroll
            for (int q = 0; q < 8; ++q) var[q] = wave_sum(acc[q] * acc[q]);
#pragma unroll
            for (int q = 0; q < 8; ++q) { const float hn = acc[q] * __builtin_amdgcn_rsqf(var[q] * (1.0f / 64.f) + LN_EPS) * lg + lb; ((FLAS bf16*)(lds + 94 * 256 * 4 + w * (32 * 144)))[(8 * i8 + q) * 72 + lane] = f2bf(hn * fsig(hn)); } }
        FP_LDS_WAIT(); asm volatile("" ::: "memory");
        tile_out<32, 128, 144, 64>(lds + 94 * 256 * 4 + w * (32 * 144), (unsigned char*)(p.YC + ((size_t)b * S + s0 + tb) * D + (w & 3) * 64), (size_t)D * 2, lane);
        FP_LDS_WAIT(); asm volatile("" ::: "memory");
    }
    __syncthreads();
}
constexpr int MQ_P = 264, MK_P = 136;
__device__ __forceinline__ int prow(int t, int i) { return 32 * (t >> 1) + 8 * (i >> 2) + 4 * (t & 1) + (i & 3); }
__device__ __forceinline__ void mla_proj(const MP& p, int L, FLAS unsigned char* lds, int bx, int G) {
    FLAS bf16* Aq = (FLAS bf16*)lds; FLAS bf16* Ak = (FLAS bf16*)(lds + 64 * MQ_P * 2); FLAS float* CSL = (FLAS float*)(lds + 64 * MQ_P * 2 + 64 * MK_P * 2);
    const int nunits = (int)(p.T / 64);
    const bf16* Wq = p.WUQ + (size_t)L * 512 * 256; const bf16* Wk = p.WUKV + (size_t)L * 512 * 128;
    for (int u = bx; u < nunits; u += G) {
        const int tid = mk_tid(), lane = tid & 63, w = __builtin_amdgcn_readfirstlane(tid >> 6), fr = lane & 15, fq = lane >> 4;
        const size_t t0 = (size_t)u * 64;
        __syncthreads();
        TP_BEGIN(29, lds);
        bf16x8 wq0[4][3], wkf[4][4];
        u32x4 kX1, kX2; f32x4 kc0, kc1, ks0, ks1;
        {
            u32x2 rq[8]; unsigned rk[8];
#pragma unroll
            for (int i = 0; i < 8; ++i) { const bf16* urow = p.U + (t0 + w * 8 + i) * NU; rq[i] = *(const u32x2*)(urow + U_CQ + lane * 4); rk[i] = *(const unsigned*)(urow + U_CKV + lane * 2); }
            const f32x4 gq = *(const f32x4*)(p.qn_g + L * 256 + lane * 4); const f32x2 gk = *(const f32x2*)(p.kvn_g + L * 128 + lane * 2);
            { const int r_ = tid >> 3, j0_ = ((tid >> 1) & 1) * 8; const size_t t_ = t0 + r_;
              kX1 = *(const u32x4*)(p.U + t_ * NU + U_KR + j0_); kX2 = *(const u32x4*)(p.U + t_ * NU + U_KR + 16 + j0_);
              kc0 = *(const f32x4*)(p.CS + t_ * 32 + j0_); kc1 = *(const f32x4*)(p.CS + t_ * 32 + j0_ + 4); ks0 = *(const f32x4*)(p.CS + t_ * 32 + 16 + j0_); ks1 = *(const f32x4*)(p.CS + t_ * 32 + 16 + j0_ + 4); }
#pragma unroll
            for (int k4 = 0; k4 < 4; ++k4)
#pragma unroll
                for (int ct = 0; ct < 3; ++ct) wq0[k4][ct] = *(const bf16x8*)(Wq + (size_t)(48 * w + ((w & 1) == 0 && ct < 2 ? prow(ct, fr) : 16 * ct + fr)) * 256 + k4 * 32 + fq * 8);
#pragma unroll
            for (int ks = 0; ks < 4; ++ks)
#pragma unroll
                for (int ct = 0; ct < 4; ++ct) wkf[ks][ct] = *(const bf16x8*)(Wk + (size_t)(64 * w + prow(ct, fr)) * 128 + ks * 32 + fq * 8);
            __builtin_amdgcn_sched_barrier(0);
#pragma unroll
            for (int i = 0; i < 8; ++i) { const int r = w * 8 + i;
                { const float a0 = blo(rq[i].x), a1 = bhi(rq[i].x), a2 = blo(rq[i].y), a3 = bhi(rq[i].y); const float rs = __builtin_amdgcn_rsqf(wave_sum((a0 * a0 + a1 * a1) + (a2 * a2 + a3 * a3)) * (1.0f / 256.f) + RMS_EPS);
                  u32x2 o; o.x = pk2(a0 * rs * gq.x, a1 * rs * gq.y); o.y = pk2(a2 * rs * gq.z, a3 * rs * gq.w); *(FLAS u32x2*)(Aq + r * MQ_P + lane * 4) = o; }
                { const float a0 = blo(rk[i]), a1 = bhi(rk[i]); const float rs = __builtin_amdgcn_rsqf(wave_sum(a0 * a0 + a1 * a1) * (1.0f / 128.f) + RMS_EPS); *(FLAS unsigned*)(Ak + r * MK_P + lane * 2) = pk2(a0 * rs * gk.x, a1 * rs * gk.y); } } }
        { const int r = tid >> 3, c = (tid >> 1) & 3, hp = tid & 1; const size_t t = t0 + r;
            const f32x4 c0 = kc0, c1 = kc1, s0 = ks0, s1 = ks1;
            if (hp == 0 && c < 2) { FLAS float* cr = CSL + r * 32 + (c & 1) * 8; *(FLAS f32x4*)cr = c0; *(FLAS f32x4*)(cr + 4) = c1; *(FLAS f32x4*)(cr + 16) = s0; *(FLAS f32x4*)(cr + 20) = s1; }
            float x1[8], x2[8], o[8]; unpack8(kX1, x1); unpack8(kX2, x2);
            const float cs[8] = {c0.x, c0.y, c0.z, c0.w, c1.x, c1.y, c1.z, c1.w}, sn[8] = {s0.x, s0.y, s0.z, s0.w, s1.x, s1.y, s1.z, s1.w};
#pragma unroll
            for (int i = 0; i < 8; ++i) o[i] = c < 2 ? x1[i] * cs[i] - x2[i] * sn[i] : x1[i] * sn[i] + x2[i] * cs[i];
            const u32x4 ov = pack8(o);
#pragma unroll
            for (int hh = 0; hh < 2; ++hh) *(u32x4*)(p.KK + t * 384 + (2 * hp + hh) * 96 + 64 + 8 * c) = ov; }
        __syncthreads();
        TP_END(29, lds); TP_BEGIN(30, lds);
        {
            f32x4 acc[3][4];
#pragma unroll
            for (int ct = 0; ct < 3; ++ct)
#pragma unroll
                for (int rt = 0; rt < 4; ++rt) acc[ct][rt] = (f32x4){0.f, 0.f, 0.f, 0.f};
            bf16x8 wq1[4][3];
#pragma unroll
            for (int k4 = 0; k4 < 4; ++k4)
#pragma unroll
                for (int ct = 0; ct < 3; ++ct) wq1[k4][ct] = *(const bf16x8*)(Wq + (size_t)(48 * w + ((w & 1) == 0 && ct < 2 ? prow(ct, fr) : 16 * ct + fr)) * 256 + (4 + k4) * 32 + fq * 8);
            const bool pe = (w & 1) != 0;
            __builtin_amdgcn_sched_barrier(0);
#pragma unroll
            for (int k4 = 0; k4 < 4; ++k4)
#pragma unroll
                for (int rt = 0; rt < 4; ++rt) { const bf16x8 tk = *(const FLAS bf16x8*)(Aq + (rt * 16 + fr) * MQ_P + k4 * 32 + fq * 8);
#pragma unroll
                    for (int ct = 0; ct < 3; ++ct) acc[ct][rt] = __builtin_amdgcn_mfma_f32_16x16x32_bf16(wq0[k4][ct], tk, acc[ct][rt], 0, 0, 0); }
#pragma unroll
            for (int k4 = 0; k4 < 4; ++k4)
#pragma unroll
                for (int rt = 0; rt < 4; ++rt) { const bf16x8 tk = *(const FLAS bf16x8*)(Aq + (rt * 16 + fr) * MQ_P + (4 + k4) * 32 + fq * 8);
#pragma unroll
                    for (int ct = 0; ct < 3; ++ct) acc[ct][rt] = __builtin_amdgcn_mfma_f32_16x16x32_bf16(wq1[k4][ct], tk, acc[ct][rt], 0, 0, 0); }
#pragma unroll
            for (int rt = 0; rt < 4; ++rt) { const size_t t = t0 + rt * 16 + fr;
                f32x4 v0 = acc[0][rt], v1 = acc[1][rt], v2 = acc[2][rt];
                if (pe) { bf16* qrow = p.Q + t * 384 + 48 * w + 4 * fq;
                    const f32x4 c = *(const FLAS f32x4*)(CSL + (rt * 16 + fr) * 32 + 4 * fq), sn = *(const FLAS f32x4*)(CSL + (rt * 16 + fr) * 32 + 16 + 4 * fq); const f32x4 x1 = v1, x2 = v2; v1 = x1 * c - x2 * sn; v2 = x1 * sn + x2 * c;
                    u32x2 o; o.x = pk2(v0.x * QSCALE, v0.y * QSCALE); o.y = pk2(v0.z * QSCALE, v0.w * QSCALE); *(u32x2*)qrow = o;
                    o.x = pk2(v1.x * QSCALE, v1.y * QSCALE); o.y = pk2(v1.z * QSCALE, v1.w * QSCALE); *(u32x2*)(qrow + 16) = o;
                    o.x = pk2(v2.x * QSCALE, v2.y * QSCALE); o.y = pk2(v2.z * QSCALE, v2.w * QSCALE); *(u32x2*)(qrow + 32) = o;
                } else {
                    bf16* qrow = p.Q + t * 384 + 48 * w;
                    u32x4 o4; o4.x = pk2(v0.x * QSCALE, v0.y * QSCALE); o4.y = pk2(v0.z * QSCALE, v0.w * QSCALE); o4.z = pk2(v1.x * QSCALE, v1.y * QSCALE); o4.w = pk2(v1.z * QSCALE, v1.w * QSCALE); *(u32x4*)(qrow + 8 * fq) = o4;
                    u32x2 o; o.x = pk2(v2.x * QSCALE, v2.y * QSCALE); o.y = pk2(v2.z * QSCALE, v2.w * QSCALE); *(u32x2*)(qrow + 32 + 4 * fq) = o; } }
        }
        if ((PROBE_T >> 30) & 1) asm volatile("s_waitcnt vmcnt(0)" ::: "memory"); TP_END(30, lds);
        {
            f32x4 acc[4][4];
#pragma unroll
            for (int ct = 0; ct < 4; ++ct)
#pragma unroll
                for (int rt = 0; rt < 4; ++rt) acc[ct][rt] = (f32x4){0.f, 0.f, 0.f, 0.f};
            const int h = w >> 1; const bool isv = (w & 1) != 0;
            if (!isv) {
#pragma unroll
                for (int ks = 0; ks < 4; ++ks)
#pragma unroll
                    for (int rt = 0; rt < 4; ++rt) { const bf16x8 tk = *(const FLAS bf16x8*)(Ak + (rt * 16 + fr) * MK_P + ks * 32 + fq * 8);
#pragma unroll
                        for (int ct = 0; ct < 4; ++ct) acc[ct][rt] = __builtin_amdgcn_mfma_f32_16x16x32_bf16(wkf[ks][ct], tk, acc[ct][rt], 0, 0, 0); }
#pragma unroll
                for (int rt = 0; rt < 4; ++rt) { const size_t t = t0 + rt * 16 + fr; bf16* dst = p.KK + t * 384 + h * 96 + 8 * fq;
#pragma unroll
                    for (int c2 = 0; c2 < 2; ++c2) { u32x4 o; o.x = pk2(acc[2 * c2][rt].x, acc[2 * c2][rt].y); o.y = pk2(acc[2 * c2][rt].z, acc[2 * c2][rt].w); o.z = pk2(acc[2 * c2 + 1][rt].x, acc[2 * c2 + 1][rt].y); o.w = pk2(acc[2 * c2 + 1][rt].z, acc[2 * c2 + 1][rt].w); *(u32x4*)(dst + 32 * c2) = o; } }
            } else {
#pragma unroll
                for (int ks = 0; ks < 4; ++ks)
#pragma unroll
                    for (int rt = 0; rt < 4; ++rt) { const bf16x8 tk = *(const FLAS bf16x8*)(Ak + prow(rt, fr) * MK_P + ks * 32 + fq * 8);
#pragma unroll
                        for (int ct = 0; ct < 4; ++ct) acc[ct][rt] = __builtin_amdgcn_mfma_f32_16x16x32_bf16(tk, wkf[ks][ct], acc[ct][rt], 0, 0, 0); }
                const size_t bq = t0 / p.S, sq = t0 % p.S;
#pragma unroll
                for (int ct = 0; ct < 4; ++ct) { bf16* drow = p.V + ((bq * 4 + h) * 64 + prow(ct, fr)) * p.S + sq + 8 * fq;
#pragma unroll
                    for (int r2 = 0; r2 < 2; ++r2) { u32x4 o; o.x = pk2(acc[ct][2 * r2].x, acc[ct][2 * r2].y); o.y = pk2(acc[ct][2 * r2].z, acc[ct][2 * r2].w); o.z = pk2(acc[ct][2 * r2 + 1].x, acc[ct][2 * r2 + 1].y); o.w = pk2(acc[ct][2 * r2 + 1].z, acc[ct][2 * r2 + 1].w); *(u32x4*)(drow + 32 * r2) = o; } }
            }
        }
    }
    __syncthreads();
}
constexpr int SP = 136;
constexpr int SA_DT = 0, SA_ACS = 2048, SA_CM = 4096, SA_BM = SA_CM + 128 * SP * 2, SA_XT = SA_CM, SA_BT = SA_CM + 2 * 128 * SP * 2, SA_MW = SA_BT + 128 * SP * 2, SA_END = SA_MW + 8 * 16 * SP * 2;
__device__ __forceinline__ float silu_f(float x) { return x * fsig(x); }
__device__ __forceinline__ float softplus_fast(float x) { if (x > 20.f) return x; const float e = __builtin_amdgcn_exp2f(x * 1.4426950408889634f); return e < 1e-3f ? e * (1.0f - 0.5f * e) : 0.6931471805599453f * __builtin_amdgcn_logf(1.0f + e); }
struct ConvW { f32x4 w[4][2], b[2]; };
__device__ __forceinline__ void convw_load(const MP& p, int L, int xc0, ConvW& cw) {
#pragma unroll
    for (int j = 0; j < 4; ++j) { cw.w[j][0] = *(const f32x4*)(p.sconv_w + (L * 4 + j) * 1024 + xc0); cw.w[j][1] = *(const f32x4*)(p.sconv_w + (L * 4 + j) * 1024 + xc0 + 4); }
    cw.b[0] = *(const f32x4*)(p.sconv_b + L * 1024 + xc0); cw.b[1] = *(const f32x4*)(p.sconv_b + L * 1024 + xc0 + 4);
}
__device__ __forceinline__ void conv_rows_load(const bf16* ub  , int xc0, int s0, int l0, u32x4 (&x)[11]) {
#pragma unroll
    for (int i = 0; i < 11; ++i) { const int sp = s0 + l0 - 3 + i; x[i] = (u32x4){0u, 0u, 0u, 0u}; if (i >= 3 || sp >= 0) x[i] = *(const u32x4*)(ub + (size_t)(sp < 0 ? 0 : sp) * NU + xc0); }
}
__device__ __forceinline__ float conv_elem(const u32x4 (&x)[11], const ConvW& cw, int i, int c) {
    float a = cw.b[c >> 2][c & 3];
#pragma unroll
    for (int j = 0; j < 4; ++j) { const unsigned wd = x[i + j][c >> 1]; a += cw.w[j][c >> 2][c & 3] * ((c & 1) ? bhi(wd) : blo(wd)); }
    return silu_f(a);
}
__device__ __forceinline__ void ssd_a(const MP& p, int L, FLAS unsigned char* lds, int bx, int G) {
    FLAS float* dtL = (FLAS float*)(lds + SA_DT); FLAS float* acsL = (FLAS float*)(lds + SA_ACS);
    FLAS bf16* Cm = (FLAS bf16*)(lds + SA_CM); FLAS bf16* Bm = (FLAS bf16*)(lds + SA_BM); FLAS bf16* XT = (FLAS bf16*)(lds + SA_XT); FLAS bf16* BT = (FLAS bf16*)(lds + SA_BT);
    const int S = (int)p.S, nunits = (int)(p.T / CHUNK) * 2;
    for (int u = bx; u < nunits; u += G) {
        const int tid = mk_tid(), lane = tid & 63, w = __builtin_amdgcn_readfirstlane(tid >> 6), fr = lane & 15, fq = lane >> 4;
        FLAS bf16* Mw = (FLAS bf16*)(lds + SA_MW + w * (16 * SP * 2));
        const int g = u & 1; const long c = u >> 1; const size_t t0 = (size_t)c * CHUNK; const int s0 = (int)(t0 % S); const size_t tb = t0 - s0;
        __syncthreads();
        TP_BEGIN(28, lds);
        const int cg2 = tid & 31, ts = tid >> 5, l0 = 8 * ts; const bool isC = cg2 >= 16; const int nbc = 8 * (cg2 & 15);
        const int xcb = (isC ? 768 : 512) + 128 * g + nbc, chs = 8 * cg2, xcs = 256 * g + chs;
        u32x4 xb[11], xs[11]; ConvW cwb, cws;
        const int h4 = tid >> 7, ldt = tid & 127; const bf16 dtraw = p.U[(t0 + ldt) * NU + U_DT + 4 * g + h4];
        const float dtb = p.dt_bias[L * 8 + 4 * g + h4], alg = p.a_log[L * 8 + 4 * g + (w & 3)];
        conv_rows_load(p.U + tb * NU + U_XBC, xcb, s0, l0, xb);
        convw_load(p, L, xcb, cwb);
        conv_rows_load(p.U + tb * NU + U_XBC, xcs, s0, l0, xs);
        __builtin_amdgcn_sched_barrier(0);
        if (PROBE_CK == 11) { asm volatile("s_waitcnt vmcnt(0) lgkmcnt(0)" ::: "memory"); TP_END(28, lds); }
        dtL[h4 * 128 + ldt] = softplus_fast(bf2f(dtraw) + dtb);
        {
            FLAS bf16* rowdst = (isC ? Cm : Bm) + nbc; u32x4 colw[8];
#pragma unroll
            for (int i = 0; i < 8; ++i) { float o[8];
#pragma unroll
                for (int c = 0; c < 8; ++c) o[c] = conv_elem(xb, cwb, i, c);
                u32x4 wv; wv.x = pk2(o[0], o[1]); wv.y = pk2(o[2], o[3]); wv.z = pk2(o[4], o[5]); wv.w = pk2(o[6], o[7]); *(FLAS u32x4*)(rowdst + (l0 + i) * SP) = wv;
#pragma unroll
                for (int c = 0; c < 8; ++c) { const unsigned hv = (c & 1) ? (wv[c >> 1] >> 16) : (wv[c >> 1] & 0xffffu); if (i & 1) colw[c][i >> 1] |= hv << 16; else colw[c][i >> 1] = hv; } }
            if (!isC) {
#pragma unroll
                for (int c = 0; c < 8; ++c) *(FLAS u32x4*)(BT + (nbc + c) * SP + l0) = colw[c]; }
        }
        if (PROBE_CK == 12) { asm volatile("s_waitcnt vmcnt(0) lgkmcnt(0)" ::: "memory"); TP_END(28, lds); }
        convw_load(p, L, xcs, cws);
        __builtin_amdgcn_sched_barrier(0);
        __syncthreads();
        if (w < 4) {
            const int h = 4 * g + w; const float a = -__expf(alg); const float x0 = dtL[w * 128 + 2 * lane] * a, x1 = dtL[w * 128 + 2 * lane + 1] * a, ps = x0 + x1; float inc = ps;
#pragma unroll
            for (int o = 1; o < 64; o <<= 1) { const float t = __shfl_up(inc, o); if (lane >= o) inc += t; }
            const float ex = inc - ps, c0 = ex + x0, c1 = ex + ps; *(FLAS f32x2*)(acsL + w * 128 + 2 * lane) = (f32x2){c0, c1};
            p.ACS[(t0 + 2 * lane) * 8 + h] = c0; p.ACS[(t0 + 2 * lane + 1) * 8 + h] = c1; }
        tile_out<128, 256, SP * 2, 512>((const FLAS unsigned char*)Cm, (unsigned char*)(p.CM + t0 * 256 + g * 128), (size_t)256 * 2, tid);
        f32x4 cbT[8];
#pragma unroll
        for (int ct = 0; ct < 8; ++ct) cbT[ct] = (f32x4){0.f, 0.f, 0.f, 0.f};
#pragma unroll
        for (int ks = 0; ks < 4; ++ks) { const bf16x8 cf = *(const FLAS bf16x8*)(Cm + (16 * w + fr) * SP + ks * 32 + fq * 8);
#pragma unroll
            for (int ct = 0; ct < 8; ++ct) { const bf16x8 bfm = *(const FLAS bf16x8*)(Bm + (16 * ct + fr) * SP + ks * 32 + fq * 8); cbT[ct] = __builtin_amdgcn_mfma_f32_16x16x32_bf16(bfm, cf, cbT[ct], 0, 0, 0); } }
        __syncthreads();
        if (PROBE_CK == 13) { asm volatile("s_waitcnt vmcnt(0) lgkmcnt(0)" ::: "memory"); TP_END(28, lds); }
        { FLAS float* dlL = (FLAS float*)(lds + SA_END); dlL[tid] = __expf(acsL[(tid >> 7) * 128 + 127] - acsL[tid]);
          dlL[512 + tid] = __expf(acsL[(tid & ~15) + 15] - acsL[tid]); }
        {   const FLAS float* dts = dtL + (chs >> 6) * 128 + l0; const f32x4 d0 = *(const FLAS f32x4*)dts, d1 = *(const FLAS f32x4*)(dts + 4);
            const float dtv[8] = {d0.x, d0.y, d0.z, d0.w, d1.x, d1.y, d1.z, d1.w};
#pragma unroll
            for (int c = 0; c < 8; ++c) { float o[8];
#pragma unroll
                for (int i = 0; i < 8; i += 2) { const unsigned pr = pk2(conv_elem(xs, cws, i, c), conv_elem(xs, cws, i + 1, c)); o[i] = blo(pr) * dtv[i]; o[i + 1] = bhi(pr) * dtv[i + 1]; }
                u32x4 wv; wv.x = pk2(o[0], o[1]); wv.y = pk2(o[2], o[3]); wv.z = pk2(o[4], o[5]); wv.w = pk2(o[6], o[7]); *(FLAS u32x4*)(XT + (chs + c) * SP + l0) = wv; } }
        if (PROBE_CK == 14) { asm volatile("s_waitcnt vmcnt(0) lgkmcnt(0)" ::: "memory"); TP_END(28, lds); }
        __syncthreads();
        const f32x4 dsk4 = *(const f32x4*)(p.dskip + L * 8 + 4 * g);
#pragma unroll 1
        for (int r = 0; r < 4; ++r) {
            const FLAS float* ac = acsL + r * 128; const int h = 4 * g + r; const float al = ac[16 * w + fr];
            const float dsd = (r == 0 ? dsk4.x : r == 1 ? dsk4.y : r == 2 ? dsk4.z : dsk4.w) * __builtin_amdgcn_rcpf(dtL[r * 128 + 16 * w + fr]);
            const FLAS float* fsL = (const FLAS float*)(lds + SA_END) + 512 + r * 128;
#pragma unroll
            for (int ct = 0; ct < 8; ++ct) { const int sb = 16 * ct + 4 * fq, l = 16 * w + fr; u32x2 o;
                if (ct != w) { const float fl = ct < w ? __expf(al - ac[16 * ct + 15]) : 0.f; const f32x4 fs = *(const FLAS f32x4*)(fsL + sb);
                    o.x = pk2(cbT[ct].x * fl * fs.x, cbT[ct].y * fl * fs.y); o.y = pk2(cbT[ct].z * fl * fs.z, cbT[ct].w * fl * fs.w); }
                else { const f32x4 as = *(const FLAS f32x4*)(ac + sb); float m0, m1, m2, m3;
                    m0 = (sb + 0 <= l) ? cbT[ct].x * __expf(al - as.x) : 0.f; m1 = (sb + 1 <= l) ? cbT[ct].y * __expf(al - as.y) : 0.f; m2 = (sb + 2 <= l) ? cbT[ct].z * __expf(al - as.z) : 0.f; m3 = (sb + 3 <= l) ? cbT[ct].w * __expf(al - as.w) : 0.f;
                    m0 += (sb + 0 == l) ? dsd : 0.f; m1 += (sb + 1 == l) ? dsd : 0.f; m2 += (sb + 2 == l) ? dsd : 0.f; m3 += (sb + 3 == l) ? dsd : 0.f;
                    o.x = pk2(m0, m1); o.y = pk2(m2, m3); }
                *(FLAS u32x2*)(Mw + fr * SP + sb) = o; }
            FP_LDS_WAIT(); asm volatile("" ::: "memory");
            f32x4 yd[4], st[4];
#pragma unroll
            for (int pt = 0; pt < 4; ++pt) { yd[pt] = (f32x4){0.f, 0.f, 0.f, 0.f}; st[pt] = (f32x4){0.f, 0.f, 0.f, 0.f}; }
            const FLAS float* dl = (const FLAS float*)(lds + SA_END) + r * 128;
#pragma unroll
            for (int ks = 0; ks < 4; ++ks) { const bool dg = 2 * ks <= w;
                const bf16x8 am = *(const FLAS bf16x8*)(Mw + fr * SP + ks * 32 + fq * 8);
                const u32x4 braw = *(const FLAS u32x4*)(BT + (16 * w + fr) * SP + ks * 32 + fq * 8); const f32x4 e0 = *(const FLAS f32x4*)(dl + ks * 32 + fq * 8), e1 = *(const FLAS f32x4*)(dl + ks * 32 + fq * 8 + 4); u32x4 bs;
                bs.x = pk2(blo(braw.x) * e0.x, bhi(braw.x) * e0.y); bs.y = pk2(blo(braw.y) * e0.z, bhi(braw.y) * e0.w);
                bs.z = pk2(blo(braw.z) * e1.x, bhi(braw.z) * e1.y); bs.w = pk2(blo(braw.w) * e1.z, bhi(braw.w) * e1.w);
                const bf16x8 bsf = __builtin_bit_cast(bf16x8, bs);
#pragma unroll
                for (int pt = 0; pt < 4; ++pt) { const bf16x8 x = *(const FLAS bf16x8*)(XT + (r * 64 + 16 * pt + fr) * SP + ks * 32 + fq * 8);
                    if (dg) yd[pt] = __builtin_amdgcn_mfma_f32_16x16x32_bf16(x, am, yd[pt], 0, 0, 0); st[pt] = __builtin_amdgcn_mfma_f32_16x16x32_bf16(bsf, x, st[pt], 0, 0, 0); } }
#pragma unroll
            for (int pt = 0; pt < 4; ++pt) { u32x2 o; o.x = pk2(yd[pt].x, yd[pt].y); o.y = pk2(yd[pt].z, yd[pt].w); *(FLAS u32x2*)((FLAS unsigned char*)Mw + fr * 144 + (16 * pt + 4 * fq) * 2) = o;
                *(f32x4*)(p.ST + (((size_t)c * 8 + h) * 64 + 16 * pt + fr) * 128 + 16 * w + 4 * fq) = st[pt]; }
            FP_LDS_WAIT(); asm volatile("" ::: "memory");
            tile_out<16, 128, 144, 64>((const FLAS unsigned char*)Mw, (unsigned char*)(p.YD + (t0 + 16 * w) * 512 + h * 64), (size_t)512 * 2, lane);
            FP_LDS_WAIT(); asm volatile("" ::: "memory");
            if (r == 0) {if (PROBE_CK == 15) { asm volatile("s_waitcnt vmcnt(0) lgkmcnt(0)" ::: "memory"); TP_END(28, lds); } }
        }
        if (PROBE_CK == 16) { asm volatile("s_waitcnt vmcnt(0) lgkmcnt(0)" ::: "memory"); TP_END(28, lds); }
    }
    __syncthreads();
}
__device__ __forceinline__ void ssd_c(const MP& p, int L, FLAS unsigned char* lds, int bx, int G) {
    const int nunits = (int)(p.T / CHUNK) * 2;
    FLAS bf16* PVL = (FLAS bf16*)lds;
    FLAS float* gnl = (FLAS float*)(lds + 4 * 64 * SP * 2);
    for (int u = bx; u < nunits; u += G) {
        const int tid = mk_tid(), lane = tid & 63, w = __builtin_amdgcn_readfirstlane(tid >> 6), fr = lane & 15, fq = lane >> 4;
        const int g = u & 1; const long c = u >> 1; const size_t t0 = (size_t)c * CHUNK, t = t0 + 16 * w + fr;
        __syncthreads();
        TP_BEGIN(24, lds);
        u32x4 pvr[8];
#pragma unroll
        for (int k = 0; k < 8; ++k) { const int id = tid + 512 * k; pvr[k] = *(const u32x4*)(p.PV + (((size_t)c * 8 + 4 * g) * 64 + (id >> 4)) * 128 + (id & 15) * 8); }
        f32x4 gv = (f32x4){0.f, 0.f, 0.f, 0.f}; if (tid < 64) gv = *(const f32x4*)(p.snorm_g + L * 512 + g * 256 + 4 * tid);
        bf16x8 cf[4];
#pragma unroll
        for (int ks = 0; ks < 4; ++ks) cf[ks] = *(const bf16x8*)(p.CM + t * 256 + g * 128 + ks * 32 + fq * 8);
        u32x4 ryd[4][2], rz[4][2]; float ea[4];
#pragma unroll
        for (int r = 0; r < 4; ++r) { const int h = 4 * g + r; ea[r] = p.ACS[t * 8 + h];
#pragma unroll
            for (int k = 0; k < 2; ++k) { const int ch = h * 64 + 32 * k + 8 * fq; ryd[r][k] = *(const u32x4*)(p.YD + t * 512 + ch); rz[r][k] = *(const u32x4*)(p.U + t * NU + U_Z + ch); } }
        __builtin_amdgcn_sched_barrier(0);
#pragma unroll
        for (int k = 0; k < 8; ++k) { const int id = tid + 512 * k, row = id >> 4; *(FLAS u32x4*)(PVL + row * SP + (((id & 15) ^ (4 * ((row >> 4) & 1))) * 8)) = pvr[k]; }
        if (tid < 64) *(FLAS f32x4*)(gnl + 4 * tid) = gv;
        __syncthreads();
        if (PROBE_CK == 1) { asm volatile("s_waitcnt vmcnt(0) lgkmcnt(0)" ::: "memory"); TP_END(24, lds); }
        f32x4 y[4][4]; float ssq = 0.f;
#pragma unroll
        for (int r = 0; r < 4; ++r)
#pragma unroll
            for (int pt = 0; pt < 4; ++pt) { f32x4 acc = (f32x4){0.f, 0.f, 0.f, 0.f};
#pragma unroll
                for (int ks = 0; ks < 4; ++ks) { const bf16x8 a = *(const FLAS bf16x8*)(PVL + (r * 64 + 32 * (pt >> 1) + 8 * (fr >> 2) + 4 * (pt & 1) + (fr & 3)) * SP + (((ks * 4 + fq) ^ (4 * (fr >> 3))) * 8)); acc = __builtin_amdgcn_mfma_f32_16x16x32_bf16(a, cf[ks], acc, 0, 0, 0); }
                y[r][pt] = acc; }
        if (PROBE_CK == 2) { asm volatile("s_waitcnt vmcnt(0) lgkmcnt(0)" ::: "memory"); TP_END(24, lds); }
#pragma unroll
        for (int r = 0; r < 4; ++r) { const float e = __expf(ea[r]);
#pragma unroll
            for (int pt = 0; pt < 4; ++pt) { const f32x4 acc = y[r][pt]; const unsigned d0 = ryd[r][pt >> 1][2 * (pt & 1)], d1 = ryd[r][pt >> 1][2 * (pt & 1) + 1], z0 = rz[r][pt >> 1][2 * (pt & 1)], z1 = rz[r][pt >> 1][2 * (pt & 1) + 1]; f32x4 yv;
                yv.x = (acc.x * e + blo(d0)) * silu_f(blo(z0)); yv.y = (acc.y * e + bhi(d0)) * silu_f(bhi(z0));
                yv.z = (acc.z * e + blo(d1)) * silu_f(blo(z1)); yv.w = (acc.w * e + bhi(d1)) * silu_f(bhi(z1));
                y[r][pt] = yv; ssq += (yv.x * yv.x + yv.y * yv.y) + (yv.z * yv.z + yv.w * yv.w); } }
        ssq += __shfl_xor(ssq, 16); ssq += __shfl_xor(ssq, 32);
        const float rs = __builtin_amdgcn_rsqf(ssq * (1.0f / 256.f) + RMS_EPS);
        __syncthreads();
        FLAS unsigned char* stg = lds + w * (16 * 528);
#pragma unroll
        for (int r = 0; r < 4; ++r)
#pragma unroll
            for (int k = 0; k < 2; ++k) { const int cl = r * 64 + 32 * k + 8 * fq; const f32x4 g0 = *(const FLAS f32x4*)(gnl + cl), g1 = *(const FLAS f32x4*)(gnl + cl + 4); const f32x4 v0 = y[r][2 * k], v1 = y[r][2 * k + 1];
                u32x4 o; o.x = pk2(v0.x * rs * g0.x, v0.y * rs * g0.y); o.y = pk2(v0.z * rs * g0.z, v0.w * rs * g0.w); o.z = pk2(v1.x * rs * g1.x, v1.y * rs * g1.y); o.w = pk2(v1.z * rs * g1.z, v1.w * rs * g1.w); *(FLAS u32x4*)(stg + fr * 528 + cl * 2) = o; }
        FP_LDS_WAIT(); asm volatile("" ::: "memory");
        tile_out<16, 512, 528, 64>(stg, (unsigned char*)(p.YC + (t0 + 16 * w) * D + 256 + g * 256), (size_t)D * 2, lane);
        FP_LDS_WAIT(); asm volatile("" ::: "memory");
        if (PROBE_CK == 6) { asm volatile("s_waitcnt vmcnt(0) lgkmcnt(0)" ::: "memory"); TP_END(24, lds); }
    }
}
}

using namespace mdl;
#define LAS __attribute__((address_space(3)))
constexpr int NWAVES = 8, NTHR = NWAVES * 64;
constexpr int CW_BAR = 4096;
#define XB_TMO      128
#define XB_XCNT(j)  (256  + 64 * (j))
#define XB_XSUB(j)  (1280 + 64 * (j))
#define XB_XGEN(j)  (2304 + 64 * (j))
#define XB_TOP      3328
#define XB_TOPGEN   3392
#define XCD_BAR_WORDS 3456
#define XB_SPIN_CAP (1u << 18)

__device__ __forceinline__ unsigned xb_ld(unsigned* p)              { return __hip_atomic_load(p, __ATOMIC_RELAXED, __HIP_MEMORY_SCOPE_AGENT); }
__device__ __forceinline__ unsigned xb_add(unsigned* p, unsigned v) { return __hip_atomic_fetch_add(p, v, __ATOMIC_RELAXED, __HIP_MEMORY_SCOPE_AGENT); }
__device__ __forceinline__ unsigned xb_xcc_id() { return (unsigned)__builtin_amdgcn_s_getreg((3 << 11) | 20) & 0xFu; }
#define XB_SPIN(cond, bar) do { unsigned _sp = 0; while (cond) { __builtin_amdgcn_s_sleep(1); \
    if ((++_sp & 255u) == 0u) { if (xb_ld(&(bar)[XB_TMO])) break; if (_sp > XB_SPIN_CAP) { atomicAdd(&(bar)[XB_TMO], 1u); break; } } } } while (0)

struct XcdBarrier {
    unsigned* bar; unsigned x;
    volatile LAS unsigned* st;
};

__device__ __forceinline__ XcdBarrier xcd_barrier_post(unsigned* bar, volatile LAS unsigned* st) {
    XcdBarrier b; b.bar = bar; b.x = xb_xcc_id(); b.st = st;
    if (threadIdx.x == 0) (void)xb_add(&bar[XB_XCNT(b.x)], 1u);
    return b;
}
__device__ __forceinline__ void xcd_barrier_complete(unsigned* bar, unsigned x, unsigned& nloc, unsigned& nx) {
    const unsigned G = gridDim.x * gridDim.y * gridDim.z;
    unsigned sum, cnt, mine, sp = 0u;
    for (;;) {
        sum = 0u; cnt = 0u; mine = 0u;
#pragma unroll
        for (unsigned j = 0; j < 16; ++j) { const unsigned c = xb_ld(&bar[XB_XCNT(j)]); sum += c; cnt += (c > 0u) ? 1u : 0u; mine = (j == x) ? c : mine; }
        if (sum == G) break;
        __builtin_amdgcn_s_sleep(1);
        if ((++sp & 255u) == 0u) { if (xb_ld(&bar[XB_TMO])) break; if (sp > XB_SPIN_CAP) { atomicAdd(&bar[XB_TMO], 1u); break; } }
    }
    nloc = mine > 0u ? mine : 1u; nx = cnt > 0u ? cnt : 1u;
}

__device__ __forceinline__ void xcd_barrier(const XcdBarrier& b) {
    asm volatile("s_waitcnt vmcnt(0)" ::: "memory");
    __syncthreads();
    if (threadIdx.x == 0) {
        unsigned* bar = b.bar;
        __builtin_amdgcn_s_waitcnt(0);
        unsigned nloc = b.st[0], nx = b.st[1];
        if (nloc == 0u) { xcd_barrier_complete(bar, b.x, nloc, nx); b.st[0] = nloc; b.st[1] = nx; }
        const unsigned old = xb_add(&bar[XB_XSUB(b.x)], 1u);
        const unsigned gen = old / nloc;
        if (old + 1u == (gen + 1u) * nloc) {
            __builtin_amdgcn_fence(__ATOMIC_RELEASE, "agent");
            asm volatile("s_waitcnt vmcnt(0)" ::: "memory");
            const unsigned og = xb_add(&bar[XB_TOP], 1u);
            const unsigned tg = og / nx;
            if (og + 1u == (tg + 1u) * nx) xb_add(&bar[XB_TOPGEN], 1u);
            else XB_SPIN(xb_ld(&bar[XB_TOPGEN]) == tg, bar);
            __builtin_amdgcn_fence(__ATOMIC_ACQUIRE, "agent");
            xb_add(&bar[XB_XGEN(b.x)], 1u);
            asm volatile("s_waitcnt vmcnt(0)" ::: "memory");
        } else {
            XB_SPIN(xb_ld(&bar[XB_XGEN(b.x)]) == gen, bar);
            __builtin_amdgcn_fence(__ATOMIC_ACQUIRE, "agent");
            asm volatile("s_waitcnt vmcnt(0)" ::: "memory");
        }
    }
    __syncthreads();
}

struct Args { MP p; long flags; };
__global__ void __launch_bounds__(NTHR, 2) mk_fwd(Args a) {
    extern __shared__ __attribute__((aligned(16))) unsigned char lds[];
    LAS unsigned char* const L3 = (LAS unsigned char*)lds;
    volatile LAS unsigned* MISC = (volatile LAS unsigned*)(L3 + MISC_OFF);
    const MP& p = a.p;
    const int tid = threadIdx.x;
    for (int u = tid; u < (LDS_BYTES - LDSCTL_OFF) / 4; u += NTHR) ((LAS unsigned*)(L3 + LDSCTL_OFF))[u] = 0u;
    __syncthreads();
    const XcdBarrier bar = xcd_barrier_post(p.ctl + CW_BAR, MISC + 8);
    const int G = gridDim.x, bx0 = blockIdx.x;
    int bx = bx0;
    const long gs = (long)G * NTHR;
#define g0 ((long)bx * NTHR + mk_tid())
#ifndef PROBE_MASK
#define PROBE_MASK 0
#endif
#define REP(k) for (int rep_ = 0; rep_ < ((PROBE_MASK >> (k)) & 1) + 1; ++rep_)
#define GRID_BAR() do { REP(10) xcd_barrier(bar); } while (0)
#define PH_BEGIN(id) TP_BEGIN(id, L3)
#define PH_END(id) TP_END(id, L3)
    PH_BEGIN(0); REP(0) fp::prologue(p, L3, bx, G);
    GRID_BAR(); PH_END(0);
    for (int L = 0; L < DEPTH; ++L) {
        { int t_ = bx0; asm volatile("" : "+s"(t_)); bx = t_; }
        const int j = L >> 1; const bool moe = (L & 1) != 0;
        bf16* const hcur = (L & 1) ? p.HB2 : p.HB; bf16* const hnxt = (L & 1) ? p.HB : p.HB2;
        PH_BEGIN(1);
        REP(1) {
            pg8::Gemm g{hcur, p.WIN + (size_t)L * NU * D, (int)p.T, NU, D, D}; pg8::StaticOrder S; S.init((int)p.T, NU, G, bx);
            pg8::EpiStore16 E{p.U, NU, (const LAS float*)(L3 + pg8::RSTD_TAB_OFF)}; pg8::gemm_phase<pg8::EpiStore16, pg8::StaticOrder, true, true>(L3, g, S, E, pg8::RstdPre<pg8::StaticOrder>{L3, rss_ptr(p, L, 0), S});
            pg8::Gemm g2{p.PB16 + (size_t)L * p.T * PLE, p.WPP + (size_t)L * D * PLE, (int)p.T, D, PLE, PLE}; pg8::UpperHalfOrder S2; S2.init2((int)p.T, D, G, bx);
            pg8::EpiStore16 E2{p.PJ, D, nullptr}; pg8::gemm_phase<pg8::EpiStore16, pg8::UpperHalfOrder, true, true>(L3, g2, S2, E2);
        }
        GRID_BAR(); PH_END(1); PH_BEGIN(2);
        REP(6) { PH_BEGIN(15); fp::ssd_a(p, L, L3, bx, G); PH_END(15); PH_BEGIN(13); fp::conv_module(p, L, L3, bx, G); PH_END(13); PH_BEGIN(14); fp::mla_proj(p, L, L3, bx, G); PH_END(14); }
        GRID_BAR(); PH_END(2); PH_BEGIN(3);
        REP(7) { PH_BEGIN(17); fp::attn_phase(p, L3, bx, G); PH_END(17); }
        GRID_BAR(); PH_END(3); PH_BEGIN(4);
        REP(8) fp::ssd_c(p, L, L3, bx, G);
        GRID_BAR(); PH_END(4); PH_BEGIN(5);
        {
            pg8::Gemm g{p.YC, p.WOUT + (size_t)L * D * D, (int)p.T, D, D, D}; pg8::StaticOrder S; S.init((int)p.T, D, G, bx);
            pg8::EpiAddH E{hcur, D, rss_ptr(p, L, 1)}; pg8::gemm_phase<pg8::EpiAddH, pg8::StaticOrder, true, true>(L3, g, S, E);
        }
        GRID_BAR(); PH_END(5);
        if (moe) { PH_BEGIN(6); fp::norm_phase<1>(p, L, p.ffn_g + L * D, hcur, bx, G, (LAS unsigned*)L3); GRID_BAR(); PH_END(6); PH_BEGIN(7); fp::moeplan(p, L, L3, bx, G); GRID_BAR(); PH_END(7); }
        PH_BEGIN(8);
        {
            const int rows = moe ? moe_start_of(p, j, NE) : (int)p.T;
            if (moe) {
                pg8::Gemm g{(const bf16*)p.H, p.MWGU + (size_t)j * NE * NGU * D, rows, NGU, D, D};
                pg8::GatherOrder S; S.init(rows, NGU, G, bx); S.tile_e = p.TILE_E; S.rowtab = (const LAS unsigned*)(L3 + pg8::GATHER_TAB_OFF);
                pg8::gather_table(L3, p.TOKIDX, D * 2, S);
                REP(3) { pg8::EpiSwigluN E{p.ACT, DFF, (const LAS float*)nullptr}; pg8::gemm_phase<pg8::EpiSwigluN, pg8::GatherOrder, true, true>(L3, g, S, E); }
            } else {
                pg8::Gemm g{hcur, p.DWGU + (size_t)j * NGU * D, rows, NGU, D, D};
                pg8::ExpertOrder S; S.init(rows, NGU, G, bx); S.tile_e = nullptr;
                REP(3) { pg8::EpiSwiglu E{p.ACT, DFF, (const LAS float*)(L3 + pg8::RSTD_TAB_OFF)}; pg8::gemm_phase<pg8::EpiSwiglu, pg8::ExpertOrder, true, true>(L3, g, S, E, pg8::RstdPre<pg8::ExpertOrder>{L3, rss_ptr(p, L, 1), S}); }
            }
            GRID_BAR(); PH_END(8); PH_BEGIN(9);
            if (moe) {
                const int nwg = (rows >> 8) * 4, nfull = (nwg / G) * G, R = nwg - nfull; const int ksn = (R == 0) ? 1 : (R * 7 <= G ? 7 : R * 4 <= G ? 4 : R * 2 <= G ? 2 : 1);
                const bf16* Wd = p.MWD + (size_t)j * NE * D * DFF; pg8::EpiMoeDown Ed{p.YS, hnxt, (size_t)R * 64 * 1024, (nfull >> 2) * 256};
                const int vbx = (G % 8 == 0) ? (bx % 8) * (G / 8) + bx / 8 : bx;
                { pg8::Gemm gd{p.ACT, Wd, rows, D, DFF, DFF}; pg8::MoeDownOrder Sd{nwg, nfull, G, vbx, 0, 0, p.TILE_E}; REP(4) pg8::gemm_phase<pg8::EpiMoeDown, pg8::MoeDownOrder, true, true>(L3, gd, Sd, Ed); }
                if (R > 0) { pg8::Gemm gd{p.ACT, Wd, rows, D, DFF / ksn, DFF}; pg8::MoeDownOrder Sd{nwg, nfull, G, vbx, ksn, DFF / ksn, p.TILE_E}; pg8::gemm_phase<pg8::EpiMoeDown, pg8::MoeDownOrder, true, true>(L3, gd, Sd, Ed); }
                if (bx == 0 && mk_tid() == 0) { p.TILE_E[1000] = (nfull >> 2) * 256; p.TILE_E[1001] = ksn; p.TILE_E[1002] = R * 64; }
            } else {
                pg8::Gemm gd{p.ACT, p.DWD + (size_t)j * D * DFF, rows, D, DFF, DFF}; pg8::StaticOrder Sd; Sd.init(rows, D, G, bx);
                REP(4) { pg8::EpiAddH Ed{hcur, D, rss_ptr(p, L, 2)}; pg8::gemm_phase<pg8::EpiAddH, pg8::StaticOrder, true, true>(L3, gd, Sd, Ed); }
            }
        }
        GRID_BAR(); PH_END(9);
        if (moe) { PH_BEGIN(10); fp::norm_phase<2>(p, L, nullptr, hcur, bx, G, nullptr, hnxt); GRID_BAR(); PH_END(10); }
        PH_BEGIN(11);
        {
            pg8::Gemm g{hcur, p.WPG + (size_t)L * D * D, (int)p.T, D, D, D}; pg8::StaticOrder S; S.init((int)p.T, D, G, bx);
            pg8::EpiPleF E{hcur, hnxt, p.PJ, D, (const LAS float*)(L3 + pg8::RSTD_TAB_OFF), rss_ptr(p, L + 1, 0)}; pg8::gemm_phase<pg8::EpiPleF, pg8::StaticOrder, true, true>(L3, g, S, E, pg8::RstdPre<pg8::StaticOrder>{L3, rss_ptr(p, L, 2), S});
        }
        GRID_BAR(); PH_END(11);
    }
    PH_BEGIN(12); fp::norm_phase<3>(p, 0, p.fin_g, p.HB, bx, G); PH_END(12);
    if (PROBE_T && bx == 0 && tid == 0) { const unsigned long long te_ = __builtin_amdgcn_s_memrealtime() + 4ull * MISC[2]; while (__builtin_amdgcn_s_memrealtime() < te_) __builtin_amdgcn_s_sleep(8); }
}
static void fill_params(MP& p, void* const* d_in, void* d_out, void* d_ws) {
    p.x = (const float*)d_in[0]; p.p = (const float*)d_in[1]; p.pos = (const int*)d_in[2];
    const float** w = &p.attn_g; for (int i = 3; i < 32; ++i) w[i - 3] = (const float*)d_in[i];
    p.out = (float*)d_out; p.B = 8; p.S = 2048; p.T = 16384; p.NSLOT = 2 * 16384 + 8 * 256;
    carve(p, (unsigned char*)d_ws);
}
extern "C" void kernel_launch(void* const* d_in, const int* in_sizes, int n_in, void* d_out, int out_size, void* d_ws, size_t ws_size, hipStream_t stream) {
    static int grid = 0;
    if (grid == 0) {
        MP q{}; q.T = 16384; q.NSLOT = 2 * 16384 + 8 * 256; const size_t need = carve(q, nullptr);
        if (n_in != 32 || ws_size < need) { fprintf(stderr, "kernel_launch: need %zu bytes of ws, have %zu (n_in %d)\n", need, ws_size, n_in); grid = -1; return; }
        int dev = 0, cus = 0, per_cu = 0;
        if (hipGetDevice(&dev) != hipSuccess || hipDeviceGetAttribute(&cus, hipDeviceAttributeMultiprocessorCount, dev) != hipSuccess) { grid = -1; return; }
        if (hipFuncSetAttribute((const void*)mk_fwd, hipFuncAttributeMaxDynamicSharedMemorySize, LDS_BYTES) != hipSuccess) { fprintf(stderr, "kernel_launch: hipFuncSetAttribute failed\n"); grid = -1; return; }
        if (hipOccupancyMaxActiveBlocksPerMultiprocessor(&per_cu, (const void*)mk_fwd, NTHR, LDS_BYTES) != hipSuccess || per_cu < 1) { fprintf(stderr, "kernel_launch: occupancy query says %d\n", per_cu); }
        (void)hipGetLastError();
        grid = cus;
    }
    if (grid < 0) return;
    Args a{}; fill_params(a.p, d_in, d_out, d_ws); a.flags = 0;
    if (hipMemsetAsync(a.p.ctl, 0, CTL_WORDS * 4, stream) != hipSuccess) return;
    hipLaunchKernelGGL(mk_fwd, dim3(grid), dim3(NTHR), LDS_BYTES, stream, a);
}
```
